# Optimizing an MI355X kernel written in HIP

```python
import jax
import jax.numpy as jnp
from jax import lax
import numpy as np

D_MODEL = 1024
BATCH = 2
SEQ = 8192
DEPTH = 2

GRID_W = 64
CTX_LEN = 256
HEAD_DIM = 64
BRANCH_W = 256
N_BRANCH = 4
A_Q_HEADS = 4
A_KV_HEADS = 2
D_Q_HEADS = 4
D_KV_HEADS = 2
FNET_GROUPS = 4
SGU_GROUPS = 4
GROUP_W = 64
CHUNK = 128
Q_BLOCK = 128
WINDOW = 128
ROPE_BASE = 10000.0
EPS = 1e-6
KV_W = 128
IN_SIZES = (BRANCH_W, KV_W, KV_W, BRANCH_W,
            BRANCH_W, KV_W, KV_W, BRANCH_W,
            BRANCH_W, BRANCH_W,
            BRANCH_W, BRANCH_W, BRANCH_W)
IN_W = 9 * BRANCH_W + 4 * KV_W

kernel_name = "hybrid_prefix_dit_block"


def _rms(x, w):
    xf = x.astype(jnp.float32)
    y = xf * lax.rsqrt(jnp.mean(xf * xf, axis=-1, keepdims=True) + EPS)
    return (y * w.astype(jnp.float32)).astype(x.dtype)


def _split_in(p):
    idx, acc = [], 0
    for s in IN_SIZES[:-1]:
        acc += s
        idx.append(acc)
    return jnp.split(p, idx, axis=-1)


def _modulation(cvec, w_ada, b_ada):
    m = jax.nn.silu(cvec) @ w_ada + b_ada
    return jnp.split(m, 3, axis=-1)


def _axial_rope_tables(rows):
    t = jnp.arange(rows * GRID_W, dtype=jnp.int32)
    r = (t // GRID_W).astype(jnp.float32)
    col = (t % GRID_W).astype(jnp.float32)
    nf = HEAD_DIM // 4
    inv = ROPE_BASE ** (-jnp.arange(nf, dtype=jnp.float32) / nf)
    ar = r[:, None] * inv[None, :]
    ac = col[:, None] * inv[None, :]
    return (jnp.cos(ar), jnp.sin(ar), jnp.cos(ac), jnp.sin(ac))


def _rot_half(x, cos, sin):
    nf = cos.shape[-1]
    x1, x2 = x[..., :nf], x[..., nf:]
    cos = cos[None, :, None, :]
    sin = sin[None, :, None, :]
    return jnp.concatenate([x1 * cos - x2 * sin, x1 * sin + x2 * cos], axis=-1)


def _axial_rope(x, tabs):
    cr, sr, cc, sc = tabs
    xf = x.astype(jnp.float32)
    half = HEAD_DIM // 2
    y = jnp.concatenate([_rot_half(xf[..., :half], cr, sr),
                         _rot_half(xf[..., half:], cc, sc)], axis=-1)
    return y.astype(x.dtype)


def _heads(t, n):
    return t.reshape(t.shape[0], t.shape[1], n, HEAD_DIM)


def _flat(o):
    return o.reshape(o.shape[0], o.shape[1], -1)


def _q_groups(q, qn, n_q, n_kv, tabs):
    b, n = q.shape[:2]
    q = _rms(_heads(q, n_q), qn)
    if tabs is not None:
        q = _axial_rope(q, tabs)
    return (q * HEAD_DIM ** -0.5).reshape(b, n, n_kv, n_q // n_kv, HEAD_DIM)


def _k_heads(k, kn, n_kv, tabs):
    k = _rms(_heads(k, n_kv), kn)
    if tabs is not None:
        k = _axial_rope(k, tabs)
    return k


def _attend(q, k, v, sink):
    s = jnp.einsum('bqkgd,bnkd->bkgqn', q, k, preferred_element_type=jnp.float32)
    if sink is not None:
        s_sink = jnp.broadcast_to(sink.astype(jnp.float32)[None, :, :, None, None], s.shape[:-1] + (1,))
        p = jax.nn.softmax(jnp.concatenate([s, s_sink], axis=-1), axis=-1)[..., :-1]
    else:
        p = jax.nn.softmax(s, axis=-1)
    return jnp.einsum('bkgqn,bnkd->bqkgd', p.astype(v.dtype), v)


def _attend_blocked(q, k, v):
    b, s = q.shape[:2]
    nb = s // Q_BLOCK
    qb = jnp.moveaxis(q.reshape(b, nb, Q_BLOCK, *q.shape[2:]), 1, 0)
    ob = lax.map(lambda qq: _attend(qq, k, v, None), qb)
    return jnp.moveaxis(ob, 0, 1).reshape(b, s, -1)


def _attend_window_sink(q, k, v, kc, vc, sink):
    b, s = q.shape[:2]
    nb = s // Q_BLOCK
    nc = kc.shape[1]
    pad = ((0, 0), (Q_BLOCK, Q_BLOCK), (0, 0), (0, 0))

    def band(t):
        tb = jnp.pad(t, pad).reshape(b, nb + 2, Q_BLOCK, *t.shape[2:])
        bt = jnp.concatenate([tb[:, :-2], tb[:, 1:-1], tb[:, 2:]], axis=2)
        return jnp.moveaxis(bt, 1, 0)

    kb, vb = band(k), band(v)
    qb = jnp.moveaxis(q.reshape(b, nb, Q_BLOCK, *q.shape[2:]), 1, 0)
    a_idx = jnp.arange(Q_BLOCK)[:, None]
    j_idx = jnp.arange(3 * Q_BLOCK)[None, :]
    rel = j_idx - Q_BLOCK - a_idx
    sink_f = sink.astype(jnp.float32)

    def one(args):
        qq, kk, vv, i = args
        kpos = (i - 1) * Q_BLOCK + j_idx
        mask = (jnp.abs(rel) <= WINDOW) & (kpos >= 0) & (kpos < s)
        s_loc = jnp.einsum('bqkgd,bjkd->bkgqj', qq, kk, preferred_element_type=jnp.float32)
        s_loc = jnp.where(mask, s_loc, -jnp.inf)
        s_ctx = jnp.einsum('bqkgd,bnkd->bkgqn', qq, kc, preferred_element_type=jnp.float32)
        s_sink = jnp.broadcast_to(sink_f[None, :, :, None, None], s_loc.shape[:-1] + (1,))
        p = jax.nn.softmax(jnp.concatenate([s_ctx, s_loc, s_sink], axis=-1), axis=-1).astype(vv.dtype)
        return (jnp.einsum('bkgqn,bnkd->bqkgd', p[..., :nc], vc)
                + jnp.einsum('bkgqj,bjkd->bqkgd', p[..., nc:nc + 3 * Q_BLOCK], vv))

    ob = lax.map(one, (qb, kb, vb, jnp.arange(nb)))
    return jnp.moveaxis(ob, 0, 1).reshape(b, s, -1)


def _fourier_mix(f, w_fnet):
    b, n = f.shape[:2]
    fg = f.astype(jnp.float32).reshape(b, n, FNET_GROUPS, GROUP_W)
    y = jnp.fft.fft2(fg, axes=(1, 3), norm='ortho').real.astype(f.dtype)
    return jnp.einsum('bngc,gcd->bngd', y, w_fnet).reshape(b, n, BRANCH_W)


def _spatial_gate(u, v, w_sp, b_sp):
    b, n = u.shape[:2]
    nch = n // CHUNK
    u = jax.nn.gelu(u, approximate=False).reshape(b, nch, CHUNK, SGU_GROUPS, GROUP_W)
    v = jax.nn.gelu(v, approximate=False).reshape(b, nch, CHUNK, SGU_GROUPS, GROUP_W)
    sp = jnp.einsum('gpq,bmqgc->bmpgc', w_sp, v) + b_sp.T[None, None, :, :, None]
    return (u * sp).reshape(b, n, BRANCH_W)


def _merge(h, outs, gates, w_br, w_merge, b_merge, w_out):
    b, n = h.shape[:2]
    yb = jnp.stack([o * jax.nn.silu(z) for o, z in zip(outs, gates)], axis=2)
    y = jnp.einsum('bnrw,rwd->bnrd', yb, w_br)
    g = jax.nn.sigmoid(h @ w_merge + b_merge).reshape(b, n, N_BRANCH, D_MODEL)
    return jnp.sum(g * y, axis=2) @ w_out


def _layer(x, xc, c, c_ctx, tabs, norm_w, w_ada, b_ada, w_in, qn_a, kn_a, qn_d, kn_d,
           sink_d, w_fnet, w_sp, b_sp, w_br, w_merge, b_merge, w_out, need_ctx_out):
    sh, sc, gt = _modulation(c, w_ada, b_ada)
    sh_c, sc_c, gt_c = _modulation(c_ctx, w_ada, b_ada)
    h = _rms(x, norm_w) * (1.0 + sc[:, None, :]) + sh[:, None, :]
    hc = _rms(xc, norm_w) * (1.0 + sc_c) + sh_c
    aq, ak, av, az, dq, dk, dv, dz, bf, bz, cu, cv, cz = _split_in(h @ w_in)
    aqc, akc, avc, azc, dqc, dkc, dvc, dzc, bfc, bzc, cuc, cvc, czc = _split_in(hc @ w_in)
    sink = sink_d.reshape(D_KV_HEADS, D_Q_HEADS // D_KV_HEADS)

    ka_c = _k_heads(akc, kn_a, A_KV_HEADS, None)
    va_c = _heads(avc, A_KV_HEADS)
    kd_c = _k_heads(dkc, kn_d, D_KV_HEADS, None)
    vd_c = _heads(dvc, D_KV_HEADS)

    qa = _q_groups(aq, qn_a, A_Q_HEADS, A_KV_HEADS, tabs)
    ka = jnp.concatenate([ka_c, _k_heads(ak, kn_a, A_KV_HEADS, tabs)], axis=1)
    va = jnp.concatenate([va_c, _heads(av, A_KV_HEADS)], axis=1)
    o_a = _attend_blocked(qa, ka, va)
    qd = _q_groups(dq, qn_d, D_Q_HEADS, D_KV_HEADS, tabs)
    o_d = _attend_window_sink(qd, _k_heads(dk, kn_d, D_KV_HEADS, tabs), _heads(dv, D_KV_HEADS),
                              kd_c, vd_c, sink)
    o_b = _fourier_mix(bf, w_fnet)
    o_c = _spatial_gate(cu, cv, w_sp, b_sp)
    y = _merge(h, (o_a, o_d, o_b, o_c), (az, dz, bz, cz), w_br, w_merge, b_merge, w_out)
    x = x + gt[:, None, :] * y

    if need_ctx_out:
        qa_c = _q_groups(aqc, qn_a, A_Q_HEADS, A_KV_HEADS, None)
        o_ac = _flat(_attend(qa_c, ka_c, va_c, None))
        qd_c = _q_groups(dqc, qn_d, D_Q_HEADS, D_KV_HEADS, None)
        o_dc = _flat(_attend(qd_c, kd_c, vd_c, sink))
        o_bc = _fourier_mix(bfc, w_fnet)
        o_cc = _spatial_gate(cuc, cvc, w_sp, b_sp)
        yc = _merge(hc, (o_ac, o_dc, o_bc, o_cc), (azc, dzc, bzc, czc), w_br, w_merge, b_merge, w_out)
        xc = xc + gt_c * yc
    return x, xc


def setup_inputs(seed: int = 0) -> dict:
    key = jax.random.key(seed)
    ks = jax.random.split(key, 24)
    f32 = jnp.float32
    nrm = lambda k, shape, s: jax.random.normal(k, shape, f32) * s
    return {
        'x': nrm(ks[0], (BATCH, SEQ, D_MODEL), 1.0),
        'c': nrm(ks[1], (BATCH, D_MODEL), 1.0),
        'ctx': nrm(ks[2], (BATCH, CTX_LEN, D_MODEL), 1.0),
        'c_ctx': nrm(ks[3], (D_MODEL,), 1.0),
        'norm_w': 1.0 + nrm(ks[4], (DEPTH, D_MODEL), 0.02),
        'w_ada': nrm(ks[5], (DEPTH, D_MODEL, 3 * D_MODEL), 0.5 * D_MODEL ** -0.5),
        'b_ada': nrm(ks[6], (DEPTH, 3 * D_MODEL), 0.02),
        'w_in': nrm(ks[7], (DEPTH, D_MODEL, IN_W), D_MODEL ** -0.5),
        'qn_a': 1.0 + nrm(ks[8], (DEPTH, HEAD_DIM), 0.02),
        'kn_a': 1.0 + nrm(ks[9], (DEPTH, HEAD_DIM), 0.02),
        'qn_d': 1.0 + nrm(ks[10], (DEPTH, HEAD_DIM), 0.02),
        'kn_d': 1.0 + nrm(ks[11], (DEPTH, HEAD_DIM), 0.02),
        'sink_d': nrm(ks[12], (DEPTH, D_Q_HEADS), 0.5),
        'w_fnet': nrm(ks[13], (DEPTH, FNET_GROUPS, GROUP_W, GROUP_W), GROUP_W ** -0.5),
        'w_sp': nrm(ks[14], (DEPTH, SGU_GROUPS, CHUNK, CHUNK), CHUNK ** -0.5),
        'b_sp': 1.0 + nrm(ks[15], (DEPTH, SGU_GROUPS, CHUNK), 0.02),
        'w_br': nrm(ks[16], (DEPTH, N_BRANCH, BRANCH_W, D_MODEL), BRANCH_W ** -0.5),
        'w_merge': nrm(ks[17], (DEPTH, D_MODEL, N_BRANCH * D_MODEL), D_MODEL ** -0.5),
        'b_merge': nrm(ks[18], (DEPTH, N_BRANCH * D_MODEL), 0.02),
        'w_out': nrm(ks[19], (DEPTH, D_MODEL, D_MODEL), D_MODEL ** -0.5),
    }


def reference(x, c, ctx, c_ctx, norm_w, w_ada, b_ada, w_in, qn_a, kn_a, qn_d, kn_d, sink_d,
              w_fnet, w_sp, b_sp, w_br, w_merge, b_merge, w_out):
    rows = x.shape[1] // GRID_W
    tabs = _axial_rope_tables(rows)
    xc = ctx
    for l in range(DEPTH):
        x, xc = _layer(x, xc, c, c_ctx, tabs, norm_w[l], w_ada[l], b_ada[l], w_in[l],
                       qn_a[l], kn_a[l], qn_d[l], kn_d[l], sink_d[l], w_fnet[l], w_sp[l],
                       b_sp[l], w_br[l], w_merge[l], b_merge[l], w_out[l],
                       need_ctx_out=(l < DEPTH - 1))
    return x
```

```cpp
#include <hip/hip_runtime.h>
#include <hip/hip_bf16.h>
#include <cstdio>
#include <cstdint>
#include <cmath>

namespace pg8 {
#define PG8_LAS __attribute__((address_space(3)))
typedef unsigned short bf16_t;
typedef short bf16x8 __attribute__((ext_vector_type(8)));
typedef float f32x4 __attribute__((ext_vector_type(4)));
typedef unsigned u32x4 __attribute__((ext_vector_type(4)));
constexpr int BM = 256, BK = 64, HALF = 128, HTB = HALF * BK * 2, STAGE_BYTES = 8 * HTB, NXCD = 8, WGM = 8;

__host__ __device__ __forceinline__ int lds_byte(int r, int c) { const int st = (r >> 4) * 2 + (c >> 5), rr = r & 15, cc = c & 31, ob = rr * 64 + cc * 2; return st * 1024 + (ob ^ (((ob >> 9) & 1) << 5)); }
__host__ __device__ __forceinline__ void stage_rc(int b, int& R, int& C) { const int st = b / 1024, sb = b % 1024, swz = sb ^ (((sb >> 9) & 1) << 5); R = (st >> 1) * 16 + swz / 64; C = (st & 1) * 32 + (swz % 64) / 2; }
__host__ __device__ __forceinline__ int perm32(int rho) { const int n = rho >> 4, i = rho & 15; return 8 * (i >> 2) + 4 * n + (i & 3); }

struct Unit { int pm, pn; };
struct Gemm { const bf16_t* A; const bf16_t* Bt; int lda, ldb, K; };

struct StaticOrder {
    int nM, nN, nwg, G, c;
    __host__ __device__ void init(int M, int N, int G_, int c_) { nM = M / BM; nN = N / BM; nwg = nM * nN; G = G_; c = c_; }
    __host__ __device__ bool next(int i, Unit& u) const {
        const long L = (long)i * G + c; if (L >= nwg) return false;
        int wgid = (int)L; { const int q = nwg / NXCD, r = nwg % NXCD, xcd = wgid % NXCD, off = wgid / NXCD; wgid = (xcd < r ? xcd * (q + 1) : r * (q + 1) + (xcd - r) * q) + off; }
        const int nig = WGM * nN, gid = wgid / nig, fm = gid * WGM, gsz = (nM - fm) < WGM ? (nM - fm) : WGM;
        u.pm = fm + ((wgid % nig) % gsz); u.pn = (wgid % nig) / gsz; return true;
    }
};
struct OrderX {
    StaticOrder so; int nx;
    __device__ bool next(int i, Unit& u) const {
        const long L = (long)i * so.G + so.c;
        if (L < so.nwg) return so.next(i, u);
        const int e = (int)(L - so.nwg); if (e >= nx) return false;
        u.pm = 64 + (e >> 1); u.pn = (e & 1) ? 4 : 1; return true;
    }
};

typedef float f32x2_c __attribute__((ext_vector_type(2))); typedef __bf16 bf16x2_c __attribute__((ext_vector_type(2)));
__device__ __forceinline__ unsigned cvt_pk_bf16(float lo, float hi) { f32x2_c v = {lo, hi}; bf16x2_c b = __builtin_convertvector(v, bf16x2_c); return __builtin_bit_cast(unsigned, b); }
__device__ __forceinline__ float bf_lo(unsigned w) { return __uint_as_float(w << 16); }
__device__ __forceinline__ float bf_hi(unsigned w) { return __uint_as_float(w & 0xffff0000u); }
__device__ __forceinline__ float sigmoidf_(float x) { return __builtin_amdgcn_rcpf(1.0f + __builtin_amdgcn_exp2f(-1.4426950408889634f * x)); }

template <int ACT> struct EpiBf16 {
    static constexpr bool PERM = true;
    bf16_t* O; int ldc; const float* bias;
    __device__ __forceinline__ void operator()(const f32x4 (&acc)[2][2][4][2], const Unit& u, int wr, int wc, int fr, int fq) const {
        const int row0 = u.pm * BM + wr * 64 + fr; const int col0 = u.pn * BM + wc * 32 + 8 * fq;
        f32x4 bv[2][2];
#pragma unroll
        for (int bj = 0; bj < 2; ++bj)
#pragma unroll
            for (int n = 0; n < 2; ++n) bv[bj][n] = bias ? *(const f32x4*)(bias + col0 + bj * HALF + 4 * n) : (f32x4){0.f, 0.f, 0.f, 0.f};
#pragma unroll
        for (int ai = 0; ai < 2; ++ai)
#pragma unroll
            for (int m = 0; m < 4; ++m) { bf16_t* rowp = O + (size_t)(row0 + ai * HALF + m * 16) * ldc + col0;
#pragma unroll
                for (int bj = 0; bj < 2; ++bj) { f32x4 v0 = acc[ai][bj][m][0] + bv[bj][0], v1 = acc[ai][bj][m][1] + bv[bj][1];
                    if (ACT == 2) {
#pragma unroll
                        for (int e = 0; e < 4; ++e) { v0[e] = sigmoidf_(v0[e]); v1[e] = sigmoidf_(v1[e]); } }
                    u32x4 w; w.x = cvt_pk_bf16(v0[0], v0[1]); w.y = cvt_pk_bf16(v0[2], v0[3]); w.z = cvt_pk_bf16(v1[0], v1[1]); w.w = cvt_pk_bf16(v1[2], v1[3]);
                    *(u32x4*)(rowp + bj * HALF) = w; } }
    }
};
struct EpiGate {
    static constexpr bool PERM = true;
    bf16_t* MG; const bf16_t* GT; int ldc; int first; float scl;
    typedef unsigned u32x2 __attribute__((ext_vector_type(2)));
    __device__ __forceinline__ void operator()(const f32x4 (&acc)[2][2][4][2], const Unit& u, int wr, int wc, int fr, int fq) const {
        const int row0 = u.pm * BM + wr * 64 + fr; const int col0 = u.pn * BM + wc * 32 + 8 * fq;
#pragma unroll
        for (int ai = 0; ai < 2; ++ai)
#pragma unroll
            for (int m = 0; m < 4; ++m) { const size_t off = (size_t)(row0 + ai * HALF + m * 16) * ldc + col0;
#pragma unroll
                for (int bj = 0; bj < 2; ++bj)
#pragma unroll
                    for (int n = 0; n < 2; ++n) {
                        const u32x2 g = *(const u32x2*)(GT + off + bj * HALF + 4 * n);
                        u32x2 o = (u32x2){0u, 0u}; if (!first) o = *(const u32x2*)(MG + off + bj * HALF + 4 * n);
                        const f32x4 v = acc[ai][bj][m][n] * scl;
                        u32x2 w;
                        w.x = cvt_pk_bf16(bf_lo(o.x) + bf_lo(g.x) * v[0], bf_hi(o.x) + bf_hi(g.x) * v[1]);
                        w.y = cvt_pk_bf16(bf_lo(o.y) + bf_lo(g.y) * v[2], bf_hi(o.y) + bf_hi(g.y) * v[3]);
                        *(u32x2*)(MG + off + bj * HALF + 4 * n) = w; asm volatile("" ::: "memory"); } }
    }
};
struct EpiRes {
    static constexpr bool PERM = false;
    const float* xin_lat; float* xout_lat; const float* xin_ctx; float* xout_ctx; const float* gate;
    __device__ __forceinline__ void operator()(const f32x4 (&acc)[2][2][4][2], const Unit& u, int wr, int wc, int fr, int fq) const {
        const bool isctx = u.pm >= 64;
        const float* xin = isctx ? xin_ctx + (size_t)(u.pm - 64) * BM * 1024 : xin_lat + (size_t)u.pm * BM * 1024;
        float* xout = isctx ? xout_ctx + (size_t)(u.pm - 64) * BM * 1024 : xout_lat + (size_t)u.pm * BM * 1024;
        const float* gv = gate + (isctx ? 2 : (u.pm >> 5)) * 3072 + 2048;
        const int col0 = u.pn * BM + wc * 32 + 4 * fq;
        f32x4 gt[2][2];
#pragma unroll
        for (int bj = 0; bj < 2; ++bj)
#pragma unroll
            for (int n = 0; n < 2; ++n) gt[bj][n] = *(const f32x4*)(gv + col0 + bj * HALF + n * 16);
#pragma unroll
        for (int ai = 0; ai < 2; ++ai)
#pragma unroll
            for (int m = 0; m < 4; ++m) { const size_t off = (size_t)(ai * HALF + wr * 64 + m * 16 + fr) * 1024 + col0;
#pragma unroll
                for (int bj = 0; bj < 2; ++bj)
#pragma unroll
                    for (int n = 0; n < 2; ++n) { const f32x4 bs = *(const f32x4*)(xin + off + bj * HALF + n * 16);
                        *(f32x4*)(xout + off + bj * HALF + n * 16) = bs + gt[bj][n] * acc[ai][bj][m][n]; }
                if (m & 1) asm volatile("" ::: "memory"); }
    }
};

template <class Epi, class Sched, bool ALIGN_EPI>
__device__ __forceinline__ void gemm_phase(PG8_LAS unsigned char* lds, const Gemm g, const Sched& S, const Epi& E) {
    int tid = threadIdx.x; asm volatile("" : "+v"(tid));
    const int wid = __builtin_amdgcn_readfirstlane(tid >> 6), lane = tid & 63, wr = wid >> 2, wc = wid & 3, fr = lane & 15, fq = lane >> 4;
    const int K = g.K, nt = K / BK;
    unsigned voffA[2], voffB[2];
#pragma unroll
    for (int i = 0; i < 2; ++i) { int R, C; stage_rc(tid * 16 + i * 8192, R, C); const int Rb = Epi::PERM ? ((R & ~31) + perm32(R & 31)) : R;
        voffA[i] = (unsigned)(R * g.lda + C) * 2u; voffB[i] = (unsigned)(Rb * g.ldb + C) * 2u; }
    const size_t kstep = (size_t)(BK * 2);
    const size_t hstepA = (size_t)HALF * g.lda * 2, hstepB = (size_t)HALF * g.ldb * 2;
    const size_t tstepA = 2 * hstepA, tstepB = 2 * hstepB;
    const unsigned ldsw = (unsigned)wid * 1024u;
    const int aoff = lds_byte(wr * 64 + fr, fq * 8), boff = lds_byte(wc * 32 + fr, fq * 8);
#define PG8_SA(b, h) (((b) * 2 + (h)) * HTB)
#define PG8_SB(b, h) ((4 + (b) * 2 + (h)) * HTB)
#define PG8_STAGE(bufoff, gbase, voff) do { _Pragma("unroll") for (int _i = 0; _i < 2; ++_i) \
        __builtin_amdgcn_global_load_lds((const unsigned*)((const char*)(gbase) + (voff)[_i]), (PG8_LAS unsigned*)(lds + (bufoff) + ldsw + _i * 8192), 16, 0, 0); } while (0)
#define PG8_LDA(dst, b, h) do { _Pragma("unroll") for (int m = 0; m < 4; ++m) _Pragma("unroll") for (int k = 0; k < 2; ++k) dst[m][k] = *(const PG8_LAS bf16x8*)(lds + PG8_SA(b, h) + aoff + m * 2048 + k * 1024); } while (0)
#define PG8_LDB(dst, b, h) do { _Pragma("unroll") for (int n = 0; n < 2; ++n) _Pragma("unroll") for (int k = 0; k < 2; ++k) dst[n][k] = *(const PG8_LAS bf16x8*)(lds + PG8_SB(b, h) + boff + n * 2048 + k * 1024); } while (0)
#define PG8_MMA(ai, bj, At, Bt) do { __builtin_amdgcn_s_setprio(1); _Pragma("unroll") for (int m = 0; m < 4; ++m) _Pragma("unroll") for (int n = 0; n < 2; ++n) _Pragma("unroll") for (int k = 0; k < 2; ++k) \
        acc[ai][bj][m][n] = __builtin_amdgcn_mfma_f32_16x16x32_bf16(Bt[n][k], At[m][k], acc[ai][bj][m][n], 0, 0, 0); __builtin_amdgcn_s_setprio(0); } while (0)
#define PG8_WAIT_V(n) asm volatile("s_waitcnt vmcnt(" #n ")" ::: "memory")
#define PG8_WAIT_L(n) asm volatile("s_waitcnt lgkmcnt(" #n ")" ::: "memory")
#define PG8_BAR __builtin_amdgcn_s_barrier()
#define PG8_SCHED __builtin_amdgcn_sched_barrier(0)
    Unit cur, nxt; int ui = 0;
    if (!S.next(0, cur)) return;
    f32x4 acc[2][2][4][2];
#pragma unroll
    for (int a = 0; a < 2; ++a)
#pragma unroll
        for (int b = 0; b < 2; ++b)
#pragma unroll
            for (int m = 0; m < 4; ++m)
#pragma unroll
                for (int n = 0; n < 2; ++n) acc[a][b][m][n] = (f32x4){0.f, 0.f, 0.f, 0.f};
    bf16x8 At[4][2], B0[2][2], B1[2][2];
    const char* cA = (const char*)g.A + (size_t)cur.pm * tstepA; const char* cB = (const char*)g.Bt + (size_t)cur.pn * tstepB;
    PG8_STAGE(PG8_SB(0, 0), cB, voffB); PG8_STAGE(PG8_SB(0, 1), cB + hstepB, voffB); PG8_STAGE(PG8_SA(0, 0), cA, voffA); PG8_STAGE(PG8_SA(0, 1), cA + hstepA, voffA);
    if (wr == 1) PG8_BAR;
    PG8_WAIT_V(2); PG8_BAR;
    PG8_STAGE(PG8_SB(1, 0), cB + kstep, voffB); PG8_STAGE(PG8_SA(1, 0), cA + kstep, voffA); PG8_STAGE(PG8_SB(1, 1), cB + hstepB + kstep, voffB);
    PG8_WAIT_V(6); PG8_BAR;
    for (;;) {
        const bool has_next = S.next(ui + 1, nxt);
        const char* nA = has_next ? (const char*)g.A + (size_t)nxt.pm * tstepA : cA; const char* nB = has_next ? (const char*)g.Bt + (size_t)nxt.pn * tstepB : cB;
        for (int t = 0; t < nt; t += 2) {
            const bool last = (t == nt - 2);
            const char* a1 = cA + (size_t)(t + 1) * kstep;
            const char* a2 = last ? nA : cA + (size_t)(t + 2) * kstep; const char* b2 = last ? nB : cB + (size_t)(t + 2) * kstep;
            const char* a3 = a2 + kstep; const char* b3 = b2 + kstep;
            PG8_LDB(B0, 0, 0); PG8_LDB(B1, 0, 1); PG8_SCHED; PG8_LDA(At, 0, 0); PG8_STAGE(PG8_SA(1, 1), a1 + hstepA, voffA);
            PG8_WAIT_V(8); PG8_WAIT_L(0); PG8_BAR; PG8_MMA(0, 0, At, B0); PG8_MMA(0, 1, At, B1); PG8_BAR; PG8_SCHED;
            PG8_LDA(At, 0, 1); PG8_STAGE(PG8_SB(0, 0), b2, voffB); PG8_STAGE(PG8_SB(0, 1), b2 + hstepB, voffB); PG8_STAGE(PG8_SA(0, 0), a2, voffA);
            PG8_WAIT_V(8); PG8_WAIT_L(0); PG8_BAR; PG8_MMA(1, 0, At, B0); PG8_MMA(1, 1, At, B1); PG8_BAR; PG8_SCHED;
            PG8_LDB(B0, 1, 0); PG8_LDB(B1, 1, 1); PG8_SCHED; PG8_LDA(At, 1, 0); PG8_STAGE(PG8_SA(0, 1), a2 + hstepA, voffA);
            PG8_WAIT_V(8); PG8_WAIT_L(0); PG8_BAR; PG8_MMA(0, 0, At, B0); PG8_MMA(0, 1, At, B1); PG8_BAR; PG8_SCHED;
            PG8_LDA(At, 1, 1); PG8_STAGE(PG8_SB(1, 0), b3, voffB); PG8_STAGE(PG8_SB(1, 1), b3 + hstepB, voffB); PG8_STAGE(PG8_SA(1, 0), a3, voffA);
            PG8_WAIT_V(8); PG8_WAIT_L(0); PG8_BAR; PG8_MMA(1, 0, At, B0); PG8_MMA(1, 1, At, B1); PG8_BAR; PG8_SCHED;
        }
        if constexpr (ALIGN_EPI) { if (wr == 0) PG8_BAR; }
        E(acc, cur, wr, wc, fr, fq);
        if (!has_next) break;
#pragma unroll
        for (int a = 0; a < 2; ++a)
#pragma unroll
            for (int b = 0; b < 2; ++b)
#pragma unroll
                for (int m = 0; m < 4; ++m)
#pragma unroll
                    for (int n = 0; n < 2; ++n) acc[a][b][m][n] = (f32x4){0.f, 0.f, 0.f, 0.f};
        cur = nxt; cA = nA; cB = nB; ++ui;
        if constexpr (ALIGN_EPI) { if (wr == 1) PG8_BAR; }
    }
    PG8_WAIT_V(0);
    if constexpr (!ALIGN_EPI) { if (wr == 0) PG8_BAR; }
    PG8_BAR;
#undef PG8_SA
#undef PG8_SB
#undef PG8_STAGE
#undef PG8_LDA
#undef PG8_LDB
#undef PG8_MMA
#undef PG8_WAIT_V
#undef PG8_WAIT_L
#undef PG8_BAR
#undef PG8_SCHED
}
}
namespace attn_body {
using bf16=__hip_bfloat16;
using bf16x8=__attribute__((ext_vector_type(8)))short;
using s16x4=__attribute__((ext_vector_type(4)))short;
using f32x16=__attribute__((ext_vector_type(16)))float;
using u32x4=__attribute__((ext_vector_type(4)))unsigned;
constexpr int D=64;
constexpr int NW=8,QBLK=32,QB=QBLK*NW,KVBLK=64;
constexpr int PP=2816, YP=1024;
__device__ __forceinline__ int crow(int r,int hi){return (r&3)+8*(r>>2)+4*hi;}
#define SBAR() __builtin_amdgcn_sched_barrier(0)
__device__ __forceinline__ void dmask(f32x16&p0,f32x16&p1,int kb,unsigned lim,int qrel,int hi){
  const float NEG=-INFINITY; const unsigned b0=(unsigned)(kb+4*hi-qrel+128);
  #pragma unroll
  for(int r=0;r<16;++r){const unsigned dd=b0+(unsigned)((r&3)+8*(r>>2)); if(dd>lim)p0[r]=NEG; if(dd+32u>lim)p1[r]=NEG;}
}

constexpr int NSLOT=3, SLOTB=8192;
constexpr int LDS_K=0, LDS_V=NSLOT*SLOTB, LDS_WS=2*NSLOT*SLOTB, LDS_OST=LDS_WS+NW*64*4, LDS_BYTES=LDS_OST+NW*4096;
constexpr float C2=0.125f*1.4426950408889634f;
__device__ __forceinline__ void glds16(const void*gsrc,unsigned lds_dst){unsigned keep;
  asm volatile("s_mov_b32 %0, m0\n\ts_mov_b32 m0, %2\n\ts_nop 0\n\tglobal_load_lds_dwordx4 %1, off\n\ts_mov_b32 m0, %0":"=&s"(keep):"v"(gsrc),"s"(lds_dst):"memory");}
__device__ __forceinline__ float siluf_(float x){ return x*__builtin_amdgcn_rcpf(1.0f+__builtin_amdgcn_exp2f(-1.4426950408889634f*x)); }
__device__ __forceinline__ float max3f(float a,float b,float c){float r;asm("v_max3_f32 %0, %1, %2, %3":"=v"(r):"v"(a),"v"(b),"v"(c));return r;}
__device__ __forceinline__ float max2f(float a,float b){float r;asm("v_max_f32_e32 %0, %1, %2":"=v"(r):"v"(a),"v"(b));return r;}
__device__ __forceinline__ float fadd_s(float a,float b){float r;asm("v_add_f32_e32 %0, %1, %2":"=v"(r):"v"(a),"v"(b));return r;}
__device__ __forceinline__ float fsub_s(float a,float b){float r;asm("v_sub_f32_e32 %0, %1, %2":"=v"(r):"v"(a),"v"(b));return r;}
typedef float f32x2_t __attribute__((ext_vector_type(2))); typedef __bf16 bf16x2_t __attribute__((ext_vector_type(2)));
__device__ __forceinline__ unsigned cvtpk_s(float lo,float hi){f32x2_t v={lo,hi};bf16x2_t b=__builtin_convertvector(v,bf16x2_t);return __builtin_bit_cast(unsigned,b);}
#define WAIT_BAR(N) asm volatile("s_waitcnt vmcnt(" #N ") lgkmcnt(0)\n\ts_barrier":::"memory")

__device__ __forceinline__ void qkt(f32x16&p0,f32x16&p1,const char*Kslot,const bf16x8*qr,const f32x16&negm,int r32,int hi){
  const char*kb=Kslot+hi*1024+r32*16;
  #pragma unroll
  for(int d0=0;d0<4;++d0){
    const bf16x8 b0=*reinterpret_cast<const bf16x8*>(kb+d0*2048);
    const bf16x8 b1=*reinterpret_cast<const bf16x8*>(kb+d0*2048+512);
    if(d0==0){p0=__builtin_amdgcn_mfma_f32_32x32x16_bf16(b0,qr[0],negm,0,0,0);p1=__builtin_amdgcn_mfma_f32_32x32x16_bf16(b1,qr[0],negm,0,0,0);}
    else{p0=__builtin_amdgcn_mfma_f32_32x32x16_bf16(b0,qr[d0],p0,0,0,0);p1=__builtin_amdgcn_mfma_f32_32x32x16_bf16(b1,qr[d0],p1,0,0,0);}}
}
typedef __attribute__((address_space(3))) const char* lds_cptr;
typedef short v4i16_t __attribute__((ext_vector_type(4)));
__device__ __forceinline__ void kload8(bf16x8*kf,lds_cptr kp){
  kf[0]=*(const __attribute__((address_space(3))) bf16x8*)(kp);      kf[1]=*(const __attribute__((address_space(3))) bf16x8*)(kp+512);
  kf[2]=*(const __attribute__((address_space(3))) bf16x8*)(kp+2048); kf[3]=*(const __attribute__((address_space(3))) bf16x8*)(kp+2560);
  kf[4]=*(const __attribute__((address_space(3))) bf16x8*)(kp+4096); kf[5]=*(const __attribute__((address_space(3))) bf16x8*)(kp+4608);
  kf[6]=*(const __attribute__((address_space(3))) bf16x8*)(kp+6144); kf[7]=*(const __attribute__((address_space(3))) bf16x8*)(kp+6656);
}
__device__ __forceinline__ void kload2(bf16x8*kf,lds_cptr kp,int j){ kf[2*j]=*(const __attribute__((address_space(3))) bf16x8*)(kp+j*2048); kf[2*j+1]=*(const __attribute__((address_space(3))) bf16x8*)(kp+j*2048+512); }
__device__ __forceinline__ s16x4 vtr(lds_cptr p){ return __builtin_bit_cast(s16x4,__builtin_amdgcn_ds_read_tr16_b64_v4i16((__attribute__((address_space(3))) v4i16_t*)p)); }
__device__ __forceinline__ float rowmax(const f32x16&p0,const f32x16&p1){
  float a=max3f(p0[0],p0[1],p1[0]),b=max3f(p0[2],p0[3],p1[1]);a=max3f(a,p1[2],p1[3]);
  #pragma unroll
  for(int r=4;r<16;r+=4){a=max3f(a,p0[r],p0[r+1]);b=max3f(b,p0[r+2],p0[r+3]);a=max3f(a,p1[r],p1[r+1]);b=max3f(b,p1[r+2],p1[r+3]);}
  const float m=max2f(a,b);
  auto rr=__builtin_amdgcn_permlane32_swap(__float_as_uint(m),__float_as_uint(m),false,false);
  return max2f(__uint_as_float(rr[0]),__uint_as_float(rr[1]));
}
__device__ __forceinline__ void pv(f32x16*o,int vb,bf16x8 pa0,bf16x8 pa1,bf16x8 pa2,bf16x8 pa3){
  #pragma unroll
  for(int d0=0;d0<2;++d0){s16x4 lo[4],hi[4];
    #pragma unroll
    for(int ks=0;ks<4;++ks){
      asm volatile("ds_read_b64_tr_b16 %0,%1 offset:%c2":"=&v"(lo[ks]):"v"(vb),"i"(d0*4096+ks*1024):"memory");
      asm volatile("ds_read_b64_tr_b16 %0,%1 offset:%c2":"=&v"(hi[ks]):"v"(vb),"i"(d0*4096+ks*1024+512):"memory");}
    asm volatile("s_waitcnt lgkmcnt(0)":::"memory");SBAR();
    #define PK(k) (bf16x8){lo[k][0],lo[k][1],lo[k][2],lo[k][3],hi[k][0],hi[k][1],hi[k][2],hi[k][3]}
    o[d0]=__builtin_amdgcn_mfma_f32_32x32x16_bf16(pa0,PK(0),o[d0],0,0,0);
    o[d0]=__builtin_amdgcn_mfma_f32_32x32x16_bf16(pa1,PK(1),o[d0],0,0,0);
    o[d0]=__builtin_amdgcn_mfma_f32_32x32x16_bf16(pa2,PK(2),o[d0],0,0,0);
    o[d0]=__builtin_amdgcn_mfma_f32_32x32x16_bf16(pa3,PK(3),o[d0],0,0,0);
    #undef PK
  }
}

#ifndef ATTN_STORE16
#define ATTN_STORE16(p,v) (*(u32x4*)(p)=(v))
#endif
template<int MODE,int THRL> __device__ __forceinline__ void attn_unit(const bf16*Pm,bf16*YB,int qrow0,int ctx0,int lat0,int off,int NT,int wq0,int qcol,int kcol,int vcol,int zcol,int ocol,float sinkl2,char*shm){
  int tid_=threadIdx.x; asm volatile("":"+v"(tid_)); const int tid=tid_,lane=tid&63,r32=lane&31,hi=lane>>5; const int wid=__builtin_amdgcn_readfirstlane(tid>>6);
  const bf16*Qw=Pm+(long)(qrow0+wid*QBLK)*PP+qcol;
  const unsigned lds0=(unsigned)(uintptr_t)shm;
  float*wsf=(float*)(shm+LDS_WS)+wid*64;
  const bf16*ksrc=Pm+kcol+(long)lane*PP+wid*8;
  const bf16*vsrc=Pm+vcol+(long)(16*(wid&3)+(lane>>2))*PP+(wid>>2)*32+(lane&3)*8;
  const unsigned kdst=lds0+LDS_K+wid*1024, vdst=lds0+LDS_V+wid*1024;
  #define TROW(t) (((t)<4)?(ctx0+64*(t)):(lat0+64*((t)-4+off)))
  #define DMA_K(t,slot) glds16(ksrc+(long)TROW(t)*PP,(unsigned)__builtin_amdgcn_readfirstlane(kdst+(slot)))
  #define DMA_V(t,slot) glds16(vsrc+(long)TROW(t)*PP,(unsigned)__builtin_amdgcn_readfirstlane(vdst+(slot)))
  const int vb0=(int)(lds0+LDS_V)+((lane>>4)&1)*32+(lane&3)*8+(4*hi+((lane&15)>>2))*64;
  const char*Kbase=shm+LDS_K; bf16x8 kf[8];
  const lds_cptr shm3=(lds_cptr)shm; const lds_cptr kp0=shm3+LDS_K+hi*1024+r32*16; const lds_cptr vp0=shm3+LDS_V+((lane>>4)&1)*32+(lane&3)*8+(4*hi+((lane&15)>>2))*64;
  DMA_K(0,0);DMA_V(0,0);DMA_K(1,SLOTB);
  bf16x8 qr[4];
  #pragma unroll
  for(int d0=0;d0<4;++d0)qr[d0]=*reinterpret_cast<const bf16x8*>(&Qw[(long)r32*PP+d0*16+hi*8]);
  float mhat=0.f,l_reg=0.f;f32x16 o[2];o[0]=f32x16{};o[1]=f32x16{};f32x16 negm=f32x16{}; if(MODE==0){asm volatile("":"+v"(negm));}
  const int qrel=wid*QBLK+r32;
  #define CMASK(P0,P1,t) do{ if(MODE==1){ dmask(P0,P1,64*((t)-4)-wq0,((t)>=4)?256u:~0u,qrel,hi); } }while(0)
  bool resc=false;
  #define START(P0,P1) do{ const float rm=rowmax(P0,P1); resc=false; \
    { const float dl=rm; mhat=fadd_s(mhat,dl); \
      _Pragma("unroll") for(int r=0;r<16;++r){P0[r]=fsub_s(P0[r],dl);P1[r]=fsub_s(P1[r],dl);} \
      if(MODE==0){ _Pragma("unroll") for(int r=0;r<16;++r)negm[r]=-mhat; asm volatile("":"+v"(negm)); } } \
    _Pragma("unroll") for(int r=0;r<16;++r)P0[r]=__builtin_amdgcn_exp2f(P0[r]); }while(0)
  #define RESC() do{ if(resc){ asm volatile("s_waitcnt lgkmcnt(0)":::"memory"); \
      _Pragma("unroll") for(int d_=0;d_<2;++d_) _Pragma("unroll") for(int r=0;r<16;++r)o[d_][r]*=wsf[crow(r,hi)]; } }while(0)
  f32x16 pA0,pA1,pB0,pB1;
  int sl_prev=0,sl_cur=0,sl_next=SLOTB;
  #define ROT() do{sl_prev=sl_cur;sl_cur=sl_next;sl_next=(sl_next==(NSLOT-1)*SLOTB)?0:sl_next+SLOTB;}while(0)
  DMA_K(2,2*SLOTB);
  WAIT_BAR(3);
  qkt(pA0,pA1,Kbase,qr,negm,r32,hi);asm volatile("s_nop 15\n\ts_nop 7":"+v"(pA0),"+v"(pA1));CMASK(pA0,pA1,0);
  START(pA0,pA1);
  _Pragma("unroll") for(int r=0;r<16;++r)pA1[r]=__builtin_amdgcn_exp2f(pA1[r]);
  WAIT_BAR(0);
  DMA_K(3,0);DMA_V(1,SLOTB);
  ROT();
  kload8(kf,kp0+sl_cur);
  WAIT_BAR(2);
  s16x4 vlo[8],vhi[8]; u32x4 pw0,pw1,pw2,pw3;
  #define PKW(P,B) cvtpk_s(P[B],P[B+1])
  #define PAF(k) __builtin_bit_cast(bf16x8,pw##k)
  #define VFR(i) (bf16x8){vlo[i][0],vlo[i][1],vlo[i][2],vlo[i][3],vhi[i][0],vhi[i][1],vhi[i][2],vhi[i][3]}
  #define PIN(x) asm volatile("":"+v"(x))
  #define MX3(a,b,c) __builtin_fmaxf(__builtin_fmaxf((a),(b)),(c))
  #define GAPA(MF,A0,A1,A2,A3,W0,W1,PW) do{ MF; sacc+=A0; sacc+=A1; sacc+=A2; sacc+=A3; PIN(sacc); W0; W1; PIN(PW); SBAR(); }while(0)
  #define EX(v) __builtin_amdgcn_exp2f(v)
  #define GAPB(MF,X,B) do{ MF; X[B]=EX(X[B]); X[B+1]=EX(X[B+1]); X[B+2]=EX(X[B+2]); X[B+3]=EX(X[B+3]); PIN(X); SBAR(); }while(0)
  #define VRD(i) do{ vlo[i]=vtr(vp_+(((i)>>2)*4096+((i)&3)*1024)); vhi[i]=vtr(vp_+(((i)>>2)*4096+((i)&3)*1024+512)); }while(0)
  #define KRD(G,j) do{ if(G){ kload2(kf,kp0+sl_next,j); SBAR(); } }while(0)
  #define STEP(C0,C1,P0,P1,t,GK,GV,GL) do{ SBAR(); \
    const lds_cptr vp_=vp0+sl_prev; \
    VRD(0); SBAR(); float sacc=(P0[0]+P0[1]); \
    GAPA(C0=__builtin_amdgcn_mfma_f32_32x32x16_bf16(kf[0],qr[0],negm,0,0,0), P0[2],P0[3],P0[4],P0[5],     pw0[0]=PKW(P0,0), pw0[1]=PKW(P0,2), pw0); \
    VRD(4); SBAR(); GAPA(C1=__builtin_amdgcn_mfma_f32_32x32x16_bf16(kf[1],qr[0],negm,0,0,0), P0[6],P0[7],P0[8],P0[9],     pw0[2]=PKW(P0,4), pw0[3]=PKW(P0,6), pw0); \
    VRD(1); SBAR(); GAPA(C0=__builtin_amdgcn_mfma_f32_32x32x16_bf16(kf[2],qr[1],C0,0,0,0),   P0[10],P0[11],P0[12],P0[13], pw1[0]=PKW(P0,8), pw1[1]=PKW(P0,10), pw1); \
    VRD(5); SBAR(); GAPA(C1=__builtin_amdgcn_mfma_f32_32x32x16_bf16(kf[3],qr[1],C1,0,0,0),   P0[14],P0[15],P1[0],P1[1],   pw1[2]=PKW(P0,12),pw1[3]=PKW(P0,14), pw1); \
    VRD(2); SBAR(); GAPA(C0=__builtin_amdgcn_mfma_f32_32x32x16_bf16(kf[4],qr[2],C0,0,0,0),   P1[2],P1[3],P1[4],P1[5],     pw2[0]=PKW(P1,0), pw2[1]=PKW(P1,2), pw2); \
    VRD(6); SBAR(); GAPA(C1=__builtin_amdgcn_mfma_f32_32x32x16_bf16(kf[5],qr[2],C1,0,0,0),   P1[6],P1[7],P1[8],P1[9],     pw2[2]=PKW(P1,4), pw2[3]=PKW(P1,6), pw2); \
    VRD(3); SBAR(); GAPA(C0=__builtin_amdgcn_mfma_f32_32x32x16_bf16(kf[6],qr[3],C0,0,0,0),   P1[10],P1[11],P1[12],P1[13], pw3[0]=PKW(P1,8), pw3[1]=PKW(P1,10), pw3); \
    VRD(7); SBAR(); GAPA(C1=__builtin_amdgcn_mfma_f32_32x32x16_bf16(kf[7],qr[3],C1,0,0,0),   P1[14],P1[15],0.f,0.f,       pw3[2]=PKW(P1,12),pw3[3]=PKW(P1,14), pw3); \
    l_reg+=sacc; \
    if(GK){DMA_K((t)+3,sl_cur);} if(GV){DMA_V((t)+1,sl_next);} \
    CMASK(C0,C1,t); \
    { float a=MX3(C0[0],C0[1],C1[0]),b=MX3(C0[2],C0[3],C1[1]); a=MX3(a,C1[2],C1[3]); \
      _Pragma("unroll") for(int r=4;r<16;r+=4){a=MX3(a,C0[r],C0[r+1]);b=MX3(b,C0[r+2],C0[r+3]);a=MX3(a,C1[r],C1[r+1]);b=MX3(b,C1[r+2],C1[r+3]);} \
      float rm=__builtin_fmaxf(a,b); { auto rr=__builtin_amdgcn_permlane32_swap(__float_as_uint(rm),__float_as_uint(rm),false,false); rm=__builtin_fmaxf(__uint_as_float(rr[0]),__uint_as_float(rr[1])); } \
      resc=false; if(MODE==1) rm-=mhat; \
      if(__builtin_expect(__any(rm>(float)THRL),0)){ const float dl=__builtin_fmaxf(rm,0.f); mhat+=dl; \
        if(MODE==0){ _Pragma("unroll") for(int r=0;r<16;++r){C0[r]-=dl;C1[r]-=dl;} \
          _Pragma("unroll") for(int r=0;r<16;++r)negm[r]=-mhat; asm volatile("":"+v"(negm)); } \
        const float f=__builtin_amdgcn_exp2f(-dl); l_reg*=f; if(hi==0)wsf[r32]=f; resc=true; } \
      if(MODE==1){ _Pragma("unroll") for(int r=0;r<16;++r){C0[r]-=mhat;C1[r]-=mhat;} } } \
    SBAR(); \
    GAPB(o[0]=__builtin_amdgcn_mfma_f32_32x32x16_bf16(PAF(0),VFR(0),o[0],0,0,0), C0,0); \
    GAPB(o[1]=__builtin_amdgcn_mfma_f32_32x32x16_bf16(PAF(0),VFR(4),o[1],0,0,0), C0,4); \
    KRD(GL,0); GAPB(o[0]=__builtin_amdgcn_mfma_f32_32x32x16_bf16(PAF(1),VFR(1),o[0],0,0,0), C0,8); \
    KRD(GL,1); GAPB(o[1]=__builtin_amdgcn_mfma_f32_32x32x16_bf16(PAF(1),VFR(5),o[1],0,0,0), C0,12); \
    KRD(GL,2); GAPB(o[0]=__builtin_amdgcn_mfma_f32_32x32x16_bf16(PAF(2),VFR(2),o[0],0,0,0), C1,0); \
    KRD(GL,3); GAPB(o[1]=__builtin_amdgcn_mfma_f32_32x32x16_bf16(PAF(2),VFR(6),o[1],0,0,0), C1,4); \
    GAPB(o[0]=__builtin_amdgcn_mfma_f32_32x32x16_bf16(PAF(3),VFR(3),o[0],0,0,0), C1,8); \
    GAPB(o[1]=__builtin_amdgcn_mfma_f32_32x32x16_bf16(PAF(3),VFR(7),o[1],0,0,0), C1,12); \
    }while(0)
  int t=1;
  if(MODE==0) for(;t+5<NT;t+=2){
    STEP(pB0,pB1,pA0,pA1,t,true,true,true);     WAIT_BAR(2); RESC(); ROT();
    STEP(pA0,pA1,pB0,pB1,t+1,true,true,true);   WAIT_BAR(2); RESC(); ROT();
  }
  #define ENDW(tt) do{ if((tt)+3<NT){WAIT_BAR(2);} else if((tt)+2<NT){WAIT_BAR(1);} else {WAIT_BAR(0);} }while(0)
  for(;t+1<NT;t+=2){
    STEP(pB0,pB1,pA0,pA1,t,(t+3<NT),(t+1<NT),(t+1<NT));       ENDW(t);   RESC(); ROT();
    STEP(pA0,pA1,pB0,pB1,t+1,(t+4<NT),(t+2<NT),(t+2<NT));     ENDW(t+1); RESC(); ROT();
  }
  STEP(pB0,pB1,pA0,pA1,NT-1,false,false,false); RESC();
  { float sacc=pB0[0]+pB0[1]; _Pragma("unroll") for(int r=2;r<16;++r)sacc+=pB0[r]; _Pragma("unroll") for(int r=0;r<16;++r)sacc+=pB1[r]; l_reg+=sacc;
    pw0=(u32x4){PKW(pB0,0),PKW(pB0,2),PKW(pB0,4),PKW(pB0,6)};pw1=(u32x4){PKW(pB0,8),PKW(pB0,10),PKW(pB0,12),PKW(pB0,14)};pw2=(u32x4){PKW(pB1,0),PKW(pB1,2),PKW(pB1,4),PKW(pB1,6)};pw3=(u32x4){PKW(pB1,8),PKW(pB1,10),PKW(pB1,12),PKW(pB1,14)};
    SBAR(); pv(o,vb0+sl_cur,PAF(0),PAF(1),PAF(2),PAF(3)); }
  #undef PKW
  #undef PAF
  #undef VFR
  #undef PIN
  #undef MX3
  #undef GAPA
  #undef GAPB
  #undef EX
  #undef VRD
  #undef KRD
  #undef STEP
  #undef ENDW
  {auto rr=__builtin_amdgcn_permlane32_swap(__float_as_uint(l_reg),__float_as_uint(l_reg),false,false);l_reg=__uint_as_float(rr[0])+__uint_as_float(rr[1]);}
  if(MODE==1){ l_reg+=__builtin_amdgcn_exp2f(sinkl2-mhat); }
  if(hi==0)wsf[32+r32]=l_reg;asm volatile("s_waitcnt lgkmcnt(0)":::"memory");
  float rli[16];
  #pragma unroll
  for(int r=0;r<16;++r)rli[r]=__builtin_amdgcn_rcpf(wsf[32+crow(r,hi)]);
  bf16*Ow=YB+(long)(qrow0+wid*QBLK)*YP+ocol; const bf16*Zw=Pm+(long)(qrow0+wid*QBLK)*PP+zcol;
  { bf16*stg=(bf16*)(shm+LDS_OST)+wid*2048;
    #pragma unroll
    for(int r=0;r<16;++r){const int orow=crow(r,hi);
      #pragma unroll
      for(int d0=0;d0<2;++d0)stg[orow*64+d0*32+r32]=__float2bfloat16(o[d0][r]*rli[r]);}
    asm volatile("s_waitcnt lgkmcnt(0)":::"memory");
    #pragma unroll
    for(int i=0;i<4;++i){const int row=i*8+(lane>>3),ch=lane&7; const u32x4 v=*(const u32x4*)(stg+row*64+ch*8); const u32x4 z=*(const u32x4*)(Zw+(long)row*PP+ch*8); u32x4 w;
      #define GATE2(vv,zz) cvtpk_s(__uint_as_float((vv)<<16)*siluf_(__uint_as_float((zz)<<16)),__uint_as_float((vv)&0xffff0000u)*siluf_(__uint_as_float((zz)&0xffff0000u)))
      w.x=GATE2(v.x,z.x); w.y=GATE2(v.y,z.y); w.z=GATE2(v.z,z.z); w.w=GATE2(v.w,z.w);
      #undef GATE2
      *(u32x4*)(Ow+(long)row*YP+ch*8)=w;} }
  asm volatile("s_waitcnt lgkmcnt(0)\n\ts_barrier":::"memory");
  #undef DMA_K
  #undef DMA_V
  #undef CMASK
  #undef START
  #undef RESC
  #undef ROT
  #undef TROW
}
#undef SBAR
#undef WAIT_BAR
}

constexpr int NWAVES = 8;
constexpr int DM = 1024, SEQ = 8192, NCTX = 256, NB = 2;
constexpr int M_LAT = NB * SEQ, M_CTX = NB * NCTX, M_ALL = M_LAT + M_CTX;
constexpr int PW = 2816;
constexpr float RMS_EPS = 1e-6f;
constexpr float QSCALE = 0.125f * 1.4426950408889634f;
constexpr int C_AQ = 0, C_AK = 256, C_AV = 384, C_AZ = 512, C_DQ = 768, C_DK = 1024, C_DV = 1152, C_DZ = 1280, C_BF = 1536, C_BZ = 1792, C_CU = 2048, C_CV = 2304, C_CZ = 2560;

constexpr size_t MiB = 1u << 20;
constexpr size_t WS_CTL = 0, CTL_ZERO_BYTES = 1 * MiB;
constexpr size_t WS_MOD = 1 * MiB;
constexpr size_t WS_TAB = 2 * MiB;
constexpr size_t TAB_MA = 0, TAB_128 = 131072, TAB_64 = 229376, TAB_256 = 245760, TAB_WSP = 507904;
constexpr size_t WS_WIN = 4 * MiB, WS_WM = 16 * MiB, WS_WBR = 32 * MiB, WS_WOUT = 36 * MiB;
constexpr size_t WS_XC1 = 40 * MiB;
constexpr size_t WS_H = 42 * MiB, WS_YB = 75 * MiB, WS_T1 = 108 * MiB, WS_P = 124 * MiB;
constexpr size_t WS_GT = WS_P, WS_MG = WS_P + 40 * MiB;
constexpr size_t WS_END = 216 * MiB;
constexpr int CW_BAR = 4096;

constexpr int RING_BYTES = 131072, LDSCTL_OFF = RING_BYTES, MISC_OFF = LDSCTL_OFF + 320, LDS_BYTES = 147456;

#define GAS __attribute__((address_space(1)))
#define LAS __attribute__((address_space(3)))
typedef unsigned short bf16;
typedef unsigned v4u __attribute__((ext_vector_type(4)));
typedef unsigned v2u __attribute__((ext_vector_type(2)));
typedef float f32x4 __attribute__((ext_vector_type(4)));
typedef float f32x16 __attribute__((ext_vector_type(16)));
typedef short bf16x8 __attribute__((ext_vector_type(8)));
typedef GAS unsigned gu32;
#define RLX_AGENT __ATOMIC_RELAXED, __HIP_MEMORY_SCOPE_AGENT
#define LDS_WAIT() asm volatile("s_waitcnt lgkmcnt(0)" ::: "memory")
#define MFMA32(a, b, c) __builtin_amdgcn_mfma_f32_32x32x16_bf16((a), (b), (c), 0, 0, 0)
#define DI __device__ __forceinline__
DI unsigned f2bf(float f) { unsigned u = __builtin_bit_cast(unsigned, f); return (u + 0x7fffu + ((u >> 16) & 1u)) >> 16; }
DI unsigned pk2(float lo, float hi) { return f2bf(lo) | (f2bf(hi) << 16); }
DI float bf2f(bf16 v) { return __uint_as_float((unsigned)v << 16); }
DI float wlo(unsigned w) { return __uint_as_float(w << 16); }
DI float whi(unsigned w) { return __uint_as_float(w & 0xffff0000u); }
DI int crow(int reg, int h) { return (reg & 3) + 8 * (reg >> 2) + 4 * h; }
DI int krow(int s, int h, int j) { return 16 * s + 8 * (j >> 2) + 4 * h + (j & 3); }
DI float siluf(float x) { return x * __builtin_amdgcn_rcpf(1.0f + __builtin_amdgcn_exp2f(-1.4426950408889634f * x)); }
DI float geluf(float v) {
    const float av = __builtin_fabsf(v), d = av * 0.2316418882f + 1.0f, t = __builtin_amdgcn_rcpf(d);
    float q = t * 0.5307027145f + (-0.7265760135f); q = q * t + 0.7107068705f; q = q * t + (-0.142248368f); q = q * t + 0.127414796f; q = q * t;
    const float e = __builtin_amdgcn_exp2f((v * v) * (-0.72134752044f)), m = v * (q * e), r = v - m;
    return v < 0.f ? m : r;
}
typedef float f32x2_t __attribute__((ext_vector_type(2))); typedef __bf16 bf16x2_t __attribute__((ext_vector_type(2)));
DI unsigned cvtpk(float lo, float hi) { f32x2_t v = {lo, hi}; bf16x2_t b = __builtin_convertvector(v, bf16x2_t); return __builtin_bit_cast(unsigned, b); }
DI bf16x8 pack_step(const f32x16& x, int s) {
    v4u p; p.x = cvtpk(x[8 * s], x[8 * s + 1]); p.y = cvtpk(x[8 * s + 2], x[8 * s + 3]); p.z = cvtpk(x[8 * s + 4], x[8 * s + 5]); p.w = cvtpk(x[8 * s + 6], x[8 * s + 7]);
    return __builtin_bit_cast(bf16x8, p);
}
DI float shx(float v, int o, int lane) { return __int_as_float(__builtin_amdgcn_ds_bpermute((lane ^ o) << 2, __float_as_int(v))); }
DI float wave_sum(float v, int lane) {
#pragma unroll
    for (int o = 1; o < 64; o <<= 1) v += shx(v, o, lane);
    return v;
}

#define XB_TMO      128
#define XB_XCNT(j)  (256  + 64 * (j))
#define XB_XSUB(j)  (1280 + 64 * (j))
#define XB_XGEN(j)  (2304 + 64 * (j))
#define XB_TOP      3328
#define XB_TOPGEN   3392
#define XCD_BAR_WORDS 3456
#define XB_SPIN_CAP (1u << 22)
DI unsigned xb_ld(unsigned* p)              { return __hip_atomic_load(p, __ATOMIC_RELAXED, __HIP_MEMORY_SCOPE_AGENT); }
DI unsigned xb_add(unsigned* p, unsigned v) { return __hip_atomic_fetch_add(p, v, __ATOMIC_RELAXED, __HIP_MEMORY_SCOPE_AGENT); }
DI unsigned xb_xcc_id() { return (unsigned)__builtin_amdgcn_s_getreg((3 << 11) | 20) & 0xFu; }
#define XB_SPIN(cond, bar) do { unsigned _sp = 0; while (cond) { __builtin_amdgcn_s_sleep(1); \
    if ((++_sp & 255u) == 0u) { if (xb_ld(&(bar)[XB_TMO])) break; if (_sp > XB_SPIN_CAP) { atomicAdd(&(bar)[XB_TMO], 1u); break; } } } } while (0)
struct XcdBarrier { unsigned* bar; unsigned x; volatile LAS unsigned* st; };
DI XcdBarrier xcd_barrier_post(unsigned* bar, volatile LAS unsigned* st) {
    XcdBarrier b; b.bar = bar; b.x = xb_xcc_id(); b.st = st;
    if (threadIdx.x == 0) (void)xb_add(&bar[XB_XCNT(b.x)], 1u);
    return b;
}
DI void xcd_barrier_complete(unsigned* bar, unsigned x, unsigned& nloc, unsigned& nx) {
    const unsigned G = gridDim.x * gridDim.y * gridDim.z;
    unsigned sum, cnt, mine, sp = 0u;
    for (;;) {
        sum = 0u; cnt = 0u; mine = 0u;
#pragma unroll
        for (unsigned j = 0; j < 16; ++j) { const unsigned c = xb_ld(&bar[XB_XCNT(j)]); sum += c; cnt += (c > 0u) ? 1u : 0u; mine = (j == x) ? c : mine; }
        if (sum == G) break;
        __builtin_amdgcn_s_sleep(1);
        if ((++sp & 255u) == 0u) { if (xb_ld(&bar[XB_TMO])) break; if (sp > XB_SPIN_CAP) { atomicAdd(&bar[XB_TMO], 1u); break; } }
    }
    nloc = mine > 0u ? mine : 1u; nx = cnt > 0u ? cnt : 1u;
}
DI void xcd_barrier(const XcdBarrier& b) {
    asm volatile("s_waitcnt vmcnt(0)" ::: "memory");
    __syncthreads();
    if (threadIdx.x == 0) {
        unsigned* bar = b.bar;
        __builtin_amdgcn_s_waitcnt(0);
        unsigned nloc = b.st[0], nx = b.st[1];
        if (nloc == 0u) { xcd_barrier_complete(bar, b.x, nloc, nx); b.st[0] = nloc; b.st[1] = nx; }
        const unsigned old = xb_add(&bar[XB_XSUB(b.x)], 1u);
        const unsigned gen = old / nloc;
        if (old + 1u == (gen + 1u) * nloc) {
            __builtin_amdgcn_fence(__ATOMIC_RELEASE, "agent");
            asm volatile("s_waitcnt vmcnt(0)" ::: "memory");
            const unsigned og = xb_add(&bar[XB_TOP], 1u);
            const unsigned tg = og / nx;
            if (og + 1u == (tg + 1u) * nx) xb_add(&bar[XB_TOPGEN], 1u);
            else XB_SPIN(xb_ld(&bar[XB_TOPGEN]) == tg, bar);
            __builtin_amdgcn_fence(__ATOMIC_ACQUIRE, "agent");
            xb_add(&bar[XB_XGEN(b.x)], 1u);
            asm volatile("s_waitcnt vmcnt(0)" ::: "memory");
        } else {
            XB_SPIN(xb_ld(&bar[XB_XGEN(b.x)]) == gen, bar);
            __builtin_amdgcn_fence(__ATOMIC_ACQUIRE, "agent");
            asm volatile("s_waitcnt vmcnt(0)" ::: "memory");
        }
    }
    __syncthreads();
}

struct Frame {
    LAS unsigned char* lds;
    int tid, lane, wave, vcu, G;
};

DI void p0_transpose_item(const float* W, int N, bf16* WT, int ldt, int row_off, int col_off, LAS float* scr, int item, int lane) {
    const int nblk = N / 32, kb = item / nblk, nb = item % nblk, k0 = 64 * kb, n0 = 32 * nb;
#pragma unroll 8
    for (int i = 0; i < 32; ++i) { const int kk = 2 * i + (lane >> 5); scr[kk * 33 + (lane & 31)] = W[(size_t)(k0 + kk) * N + n0 + (lane & 31)]; }
    LDS_WAIT(); asm volatile("" ::: "memory");
    const int c = lane & 7;
#pragma unroll
    for (int j = 0; j < 4; ++j) { const int n = (lane >> 3) + 8 * j; const LAS float* s = scr + (8 * c) * 33 + n;
        v4u o; o.x = pk2(s[0 * 33], s[1 * 33]); o.y = pk2(s[2 * 33], s[3 * 33]); o.z = pk2(s[4 * 33], s[5 * 33]); o.w = pk2(s[6 * 33], s[7 * 33]);
        *(GAS v4u*)(WT + (size_t)(row_off + n0 + n) * ldt + col_off + k0 + 8 * c) = o; }
    LDS_WAIT(); asm volatile("" ::: "memory");
}

struct Args { const float* in[20]; float* out; unsigned char* ws; };
enum { I_X = 0, I_C, I_CTX, I_CCTX, I_NORMW, I_WADA, I_BADA, I_WIN, I_QNA, I_KNA, I_QND, I_KND, I_SINK, I_WFNET, I_WSP, I_BSP, I_WBR, I_WMERGE, I_BMERGE, I_WOUT };

DI void p0_prologue(const Frame& F, const Args& a) {
    unsigned char* ws = a.ws;
    for (int u = F.vcu; u < 96; u += F.G) {
        const int l = u / 48, j0 = 64 * (u % 48);
        LAS float* sl = (LAS float*)F.lds; LAS float* red = sl + 3072;
        for (int i = F.tid; i < 3072; i += 512) { const int v = i >> 10, k = i & 1023; const float cv = (v < 2) ? a.in[I_C][v * 1024 + k] : a.in[I_CCTX][k]; sl[i] = siluf(cv); }
        __syncthreads();
        float a0 = 0.f, a1 = 0.f, a2 = 0.f;
        const float* wp = a.in[I_WADA] + (size_t)l * 1024 * 3072 + (size_t)(128 * F.wave) * 3072 + j0 + F.lane;
#pragma unroll 8
        for (int kk = 0; kk < 128; ++kk) { const float w = wp[(size_t)kk * 3072]; const int k = 128 * F.wave + kk; a0 += sl[k] * w; a1 += sl[1024 + k] * w; a2 += sl[2048 + k] * w; }
        red[(F.wave * 3 + 0) * 64 + F.lane] = a0; red[(F.wave * 3 + 1) * 64 + F.lane] = a1; red[(F.wave * 3 + 2) * 64 + F.lane] = a2;
        __syncthreads();
        if (F.tid < 192) { const int v = F.tid >> 6, jj = F.tid & 63; float s = a.in[I_BADA][l * 3072 + j0 + jj];
#pragma unroll
            for (int w = 0; w < 8; ++w) s += red[(w * 3 + v) * 64 + jj];
            ((float*)(ws + WS_MOD))[(l * 3 + v) * 3072 + j0 + jj] = s; }
        __syncthreads();
    }
    {
        LAS float* scr = (LAS float*)(F.lds + F.wave * 16384);
        const int gw = F.vcu * NWAVES + F.wave, NGW = F.G * NWAVES;
        constexpr int I_IN = 16 * 88, I_M = 16 * 128, I_O = 16 * 32, I_B = 4 * 32, PER_L = I_IN + I_M + I_O + 4 * I_B;
        for (int it = gw; it < 2 * PER_L; it += NGW) {
            const int l = it / PER_L; int r = it % PER_L;
            if (r < I_IN) { p0_transpose_item(a.in[I_WIN] + (size_t)l * 1024 * PW, PW, (bf16*)(ws + WS_WIN) + (size_t)l * PW * 1024, 1024, 0, 0, scr, r, F.lane); continue; } r -= I_IN;
            if (r < I_M) { p0_transpose_item(a.in[I_WMERGE] + (size_t)l * 1024 * 4096, 4096, (bf16*)(ws + WS_WM) + (size_t)l * 4096 * 1024, 1024, 0, 0, scr, r, F.lane); continue; } r -= I_M;
            if (r < I_O) { p0_transpose_item(a.in[I_WOUT] + (size_t)l * 1024 * 1024, 1024, (bf16*)(ws + WS_WOUT) + (size_t)l * 1024 * 1024, 1024, 0, 0, scr, r, F.lane); continue; } r -= I_O;
            { const int br = r / I_B; r -= br * I_B;
              p0_transpose_item(a.in[I_WBR] + ((size_t)l * 4 + br) * 256 * 1024, 1024, (bf16*)(ws + WS_WBR) + (size_t)l * 1024 * 1024, 1024, 0, 256 * br, scr, r, F.lane); }
        }
    }
    {
        const int gt = F.vcu * 512 + F.tid, NGT = F.G * 512;
        bf16* tab = (bf16*)(ws + WS_TAB);
        for (int e = gt; e < 65536; e += NGT) {
            const int l = e >> 15, g = (e >> 13) & 3, col = (e >> 6) & 127, c = e & 63, d = col & 63;
            const float* wf = a.in[I_WFNET] + ((size_t)(l * 4 + g) * 64) * 64 + d; float s = 0.f;
            for (int j = 0; j < 64; ++j) { const float rev = (float)((c * j) & 63) * (1.0f / 64.0f); const float tw = (col < 64) ? __builtin_amdgcn_cosf(rev) : -__builtin_amdgcn_sinf(rev); s += tw * wf[j * 64]; }
            tab[TAB_MA / 2 + e] = (bf16)f2bf(s);
        }
        for (int e = gt; e < 49152; e += NGT) {
            const int mat = e / 16384, rem = e % 16384, k1b = rem >> 12, nb = (rem >> 10) & 3, s = (rem >> 9) & 1, ln = (rem >> 3) & 63, j = rem & 7;
            const int n1 = 32 * nb + krow(s, ln >> 5, j), k1 = 32 * k1b + (ln & 31); const float rev = (float)((n1 * k1) & 127) * (1.0f / 128.0f);
            const float v = (mat == 0) ? __builtin_amdgcn_cosf(rev) : (mat == 1) ? __builtin_amdgcn_sinf(rev) : -__builtin_amdgcn_sinf(rev);
            tab[TAB_128 / 2 + e] = (bf16)f2bf(v);
        }
        for (int e = gt; e < 8192; e += NGT) {
            const int mat = e >> 12, k2 = (e >> 6) & 63, n2 = e & 63; const float rev = (float)((k2 * n2) & 63) * (1.0f / 64.0f);
            tab[TAB_64 / 2 + e] = (bf16)f2bf(mat == 0 ? __builtin_amdgcn_cosf(rev) : __builtin_amdgcn_sinf(rev));
        }
        for (int e = gt; e < 131072; e += NGT) {
            const int mat = e >> 16, rem = e & 65535, kb = rem >> 13, nb = (rem >> 10) & 7, s = (rem >> 9) & 1, ln = (rem >> 3) & 63, j = rem & 7;
            const int n = 32 * nb + krow(s, ln >> 5, j), k = 32 * kb + (ln & 31); const float rev = (float)((n * k) & 255) * (1.0f / 256.0f);
            tab[TAB_256 / 2 + e] = (bf16)f2bf(mat == 0 ? __builtin_amdgcn_cosf(rev) : __builtin_amdgcn_sinf(rev));
        }
        for (int e = gt; e < 131072; e += NGT) tab[TAB_WSP / 2 + e] = (bf16)f2bf(a.in[I_WSP][e]);
    }
}

DI void p1_modrms(const Frame& F, const Args& a, int l, const float* xlat, const float* xctx, int with_ctx) {
    const float* mod = (const float*)(a.ws + WS_MOD) + (size_t)l * 3 * 3072;
    const float* nw = a.in[I_NORMW] + l * 1024;
    bf16* H = (bf16*)(a.ws + WS_H);
    const int gw = F.vcu * NWAVES + F.wave, NGW = F.G * NWAVES;
    const int nrows = with_ctx ? M_ALL : M_LAT;
    int vcur = -1; f32x4 av[4], bv[4];
    for (int row = gw; row < nrows; row += NGW) {
        const int v = row < SEQ ? 0 : (row < M_LAT ? 1 : 2);
        if (v != vcur) { vcur = v;
#pragma unroll
            for (int j = 0; j < 4; ++j) { const int c = 4 * (F.lane + 64 * j); const f32x4 w = *(const f32x4*)(nw + c), sc = *(const f32x4*)(mod + v * 3072 + 1024 + c);
                av[j] = w * (sc + 1.0f); bv[j] = *(const f32x4*)(mod + v * 3072 + c); } }
        const float* xr = (row < M_LAT) ? xlat + (size_t)row * 1024 : xctx + (size_t)(row - M_LAT) * 1024;
        f32x4 x[4]; float ss = 0.f;
#pragma unroll
        for (int j = 0; j < 4; ++j) { x[j] = *(const f32x4*)(xr + 4 * (F.lane + 64 * j)); ss += (x[j].x * x[j].x + x[j].y * x[j].y) + (x[j].z * x[j].z + x[j].w * x[j].w); }
        const float rstd = __builtin_amdgcn_rsqf(wave_sum(ss, F.lane) * (1.0f / 1024.0f) + RMS_EPS);
#pragma unroll
        for (int j = 0; j < 4; ++j) { const f32x4 h = x[j] * rstd * av[j] + bv[j]; v2u o; o.x = pk2(h.x, h.y); o.y = pk2(h.z, h.w);
            *(v2u*)(H + (size_t)row * 1024 + 4 * (F.lane + 64 * j)) = o; }
    }
}

DI void p3_prep(const Frame& F, const Args& a, int l, bf16* P) {
    const int gw = F.vcu * NWAVES + F.wave, NGW = F.G * NWAVES;
    const int d = F.lane;
    const float wqa = a.in[I_QNA][l * 64 + d], wka = a.in[I_KNA][l * 64 + d], wqd = a.in[I_QND][l * 64 + d], wkd = a.in[I_KND][l * 64 + d];
    const float inv = __builtin_amdgcn_exp2f(-(float)(d & 15) * (13.287712379549449f / 16.0f));
    const float sgn = (d & 16) ? 1.0f : -1.0f;
    const int nrows = M_ALL;
    for (int row = gw; row < nrows; row += NGW) {
        const bool isctx = row >= M_LAT;
        const int n = row & (SEQ - 1);
        float cs = 1.0f, sn = 0.0f;
        if (!isctx) { const float pos = (float)((d < 32) ? (n >> 6) : (n & 63)); const float rev = pos * inv * 0.15915494309189535f; cs = __builtin_amdgcn_cosf(rev); sn = __builtin_amdgcn_sinf(rev); }
        bf16* pr = P + (size_t)row * PW;
        const bool qok = !(isctx && l == 1);
        float v[12];
#pragma unroll
        for (int s = 0; s < 12; ++s) { const int col = (s < 4) ? C_AQ + 64 * s : (s < 6) ? C_AK + 64 * (s - 4) : (s < 10) ? C_DQ + 64 * (s - 6) : C_DK + 64 * (s - 10);
            const bool isq = (s < 4) || (s >= 6 && s < 10);
            v[s] = (isq && !qok) ? 0.f : bf2f(pr[col + d]); }
#pragma unroll
        for (int s = 0; s < 12; ++s) { const int col = (s < 4) ? C_AQ + 64 * s : (s < 6) ? C_AK + 64 * (s - 4) : (s < 10) ? C_DQ + 64 * (s - 6) : C_DK + 64 * (s - 10);
            const bool isq = (s < 4) || (s >= 6 && s < 10);
            const float w = (s < 4) ? wqa : (s < 6) ? wka : (s < 10) ? wqd : wkd;
            const float ss = wave_sum(v[s] * v[s], d);
            float y = v[s] * __builtin_amdgcn_rsqf(ss * (1.0f / 64.0f) + RMS_EPS) * w;
            const float p = shx(y, 16, d);
            y = y * cs + sgn * p * sn;
            if (isq) y *= QSCALE;
            if (!isq || qok) pr[col + d] = (bf16)f2bf(y); }
    }
}

DI void fnet_stepA(const bf16* xrow, const bf16* MAt, int r32, int hi, bf16x8 (&gs)[4][2]) {
    bf16x8 xa[4];
#pragma unroll
    for (int s4 = 0; s4 < 4; ++s4) xa[s4] = *(const bf16x8*)(xrow + 16 * s4 + 8 * hi);
#pragma unroll
    for (int cb = 0; cb < 4; ++cb) { f32x16 acc = f32x16{};
#pragma unroll
        for (int s4 = 0; s4 < 4; ++s4) { const bf16x8 bfr = *(const bf16x8*)(MAt + (32 * cb + r32) * 64 + 16 * s4 + 8 * hi); acc = MFMA32(xa[s4], bfr, acc); }
        gs[cb][0] = pack_step(acc, 0); gs[cb][1] = pack_step(acc, 1); }
}

DI void fnet_s1_unit(const Frame& F, const Args& a, int l, int u, const bf16* P) {
    const int b = u >> 7, n2grp = (u >> 4) & 7, g = (u >> 2) & 3, k1b = u & 3;
    const int lane = F.lane, r32 = lane & 31, hi = lane >> 5, w = F.wave, n2 = 8 * n2grp + w;
    const bf16* tab = (const bf16*)(a.ws + WS_TAB);
    const bf16* MAt = tab + TAB_MA / 2 + (size_t)(l * 4 + g) * 128 * 64;
    const bf16* T128 = tab + TAB_128 / 2;
    f32x16 Tr[2], Ti[2];
#pragma unroll
    for (int j = 0; j < 2; ++j) { Tr[j] = f32x16{}; Ti[j] = f32x16{}; }
#pragma unroll 1
    for (int nb = 0; nb < 4; ++nb) {
        const bf16* xrow = P + (size_t)(SEQ * b + 64 * (32 * nb + r32) + n2) * PW + C_BF + 64 * g;
        bf16x8 gs[4][2]; fnet_stepA(xrow, MAt, r32, hi, gs);
#pragma unroll
        for (int s = 0; s < 2; ++s) {
            const size_t fo = ((size_t)((k1b * 4 + nb) * 2 + s) * 64 + lane) * 8;
            const bf16x8 ca = *(const bf16x8*)(T128 + fo), sa = *(const bf16x8*)(T128 + 16384 + fo), na = *(const bf16x8*)(T128 + 32768 + fo);
            Tr[0] = MFMA32(ca, gs[0][s], Tr[0]); Tr[0] = MFMA32(sa, gs[2][s], Tr[0]);
            Tr[1] = MFMA32(ca, gs[1][s], Tr[1]); Tr[1] = MFMA32(sa, gs[3][s], Tr[1]);
            Ti[0] = MFMA32(ca, gs[2][s], Ti[0]); Ti[0] = MFMA32(na, gs[0][s], Ti[0]);
            Ti[1] = MFMA32(ca, gs[3][s], Ti[1]); Ti[1] = MFMA32(na, gs[1][s], Ti[1]); }
    }
    LAS bf16* tl = (LAS bf16*)F.lds;
#pragma unroll
    for (int i = 0; i < 16; ++i) { const int k1l = crow(i, hi), k1 = 32 * k1b + k1l;
        const float rev = (float)((n2 * k1) & 8191) * (1.0f / 8192.0f); const float c = __builtin_amdgcn_cosf(rev), s = __builtin_amdgcn_sinf(rev);
#pragma unroll
        for (int jb = 0; jb < 2; ++jb) { const float tr = Tr[jb][i], ti = Ti[jb][i];
            tl[(k1l * 128 + 32 * jb + r32) * 8 + w] = (bf16)f2bf(tr * c + ti * s);
            tl[(k1l * 128 + 64 + 32 * jb + r32) * 8 + w] = (bf16)f2bf(ti * c - tr * s); } }
    __syncthreads();
    bf16* T1 = (bf16*)(a.ws + WS_T1);
#pragma unroll 4
    for (int pass = 0; pass < 8; ++pass) { const int q = F.tid + 512 * pass, k1l = q >> 7, colL = q & 127;
        const v4u v = *(const LAS v4u*)(F.lds + (size_t)q * 16);
        *(v4u*)(T1 + ((((size_t)(b * 128 + 32 * k1b + k1l) * 8 + n2grp) * 512) + g * 128 + colL) * 8) = v; }
    __syncthreads();
}

DI void fnet_ctx_unit(const Frame& F, const Args& a, int l, int u, const bf16* P, bf16* YB) {
    const int b = u >> 2, g = u & 3;
    const int lane = F.lane, r32 = lane & 31, hi = lane >> 5, w = F.wave;
    const bf16* tab = (const bf16*)(a.ws + WS_TAB);
    const bf16* MAt = tab + TAB_MA / 2 + (size_t)(l * 4 + g) * 128 * 64;
    const bf16* T256 = tab + TAB_256 / 2;
    f32x16 Y[2]; Y[0] = f32x16{}; Y[1] = f32x16{};
#pragma unroll 1
    for (int nb = 0; nb < 8; ++nb) {
        const bf16* xrow = P + (size_t)(M_LAT + NCTX * b + 32 * nb + r32) * PW + C_BF + 64 * g;
        bf16x8 gs[4][2]; fnet_stepA(xrow, MAt, r32, hi, gs);
#pragma unroll
        for (int s = 0; s < 2; ++s) {
            const size_t fo = ((size_t)((w * 8 + nb) * 2 + s) * 64 + lane) * 8;
            const bf16x8 ca = *(const bf16x8*)(T256 + fo), sa = *(const bf16x8*)(T256 + 65536 + fo);
            Y[0] = MFMA32(ca, gs[0][s], Y[0]); Y[0] = MFMA32(sa, gs[2][s], Y[0]);
            Y[1] = MFMA32(ca, gs[1][s], Y[1]); Y[1] = MFMA32(sa, gs[3][s], Y[1]); }
    }
#pragma unroll
    for (int jb = 0; jb < 2; ++jb)
#pragma unroll
        for (int i = 0; i < 16; ++i) { const int k = 32 * w + crow(i, hi), d = 32 * jb + r32; const size_t row = (size_t)(M_LAT + NCTX * b + k);
            const float z = bf2f(P[row * PW + C_BZ + 64 * g + d]);
            YB[row * 1024 + 512 + 64 * g + d] = (bf16)f2bf(Y[jb][i] * (1.0f / 128.0f) * siluf(z)); }
}

#ifndef B_SCALE
#define B_SCALE 1.0f
#endif
#ifndef C_SCALE
#define C_SCALE 1.0f
#endif
DI void fnet_s3_unit(const Frame& F, const Args& a, int u, const bf16* P, bf16* YB) {
    const int b = u >> 7, k1 = u & 127;
    const int lane = F.lane, r32 = lane & 31, hi = lane >> 5, g = F.wave >> 1, jb = F.wave & 1;
    const bf16* T64 = (const bf16*)(a.ws + WS_TAB) + TAB_64 / 2;
    const bf16* T1 = (const bf16*)(a.ws + WS_T1);
    f32x16 Y[2]; Y[0] = f32x16{}; Y[1] = f32x16{};
#pragma unroll
    for (int sc = 0; sc < 4; ++sc)
#pragma unroll
        for (int ri = 0; ri < 2; ++ri) {
            const bf16x8 bfr = *(const bf16x8*)(T1 + ((((size_t)(b * 128 + k1) * 8 + 2 * sc + hi) * 512) + g * 128 + ri * 64 + 32 * jb + r32) * 8);
#pragma unroll
            for (int k2b = 0; k2b < 2; ++k2b) { const bf16x8 afr = *(const bf16x8*)(T64 + ri * 4096 + (32 * k2b + r32) * 64 + 16 * sc + 8 * hi); Y[k2b] = MFMA32(afr, bfr, Y[k2b]); } }
#pragma unroll
    for (int k2b = 0; k2b < 2; ++k2b)
#pragma unroll
        for (int i = 0; i < 16; ++i) { const int k2 = 32 * k2b + crow(i, hi), d = 32 * jb + r32; const size_t row = (size_t)(SEQ * b + k1 + 128 * k2);
            const float z = bf2f(P[row * PW + C_BZ + 64 * g + d]);
            YB[row * 1024 + 512 + 64 * g + d] = (bf16)f2bf(Y[k2b][i] * (B_SCALE * 0.0013810679320049757f) * siluf(z)); }
}

DI void sgu_unit(const Frame& F, const Args& a, int l, int ci, const bf16* P, bf16* YB) {
    constexpr int VP = 136;
    LAS bf16* vt = (LAS bf16*)F.lds;
    const size_t row0 = (size_t)ci * 128;
    { const int q = F.tid & 127, g = F.tid >> 7; const bf16* src = P + (row0 + q) * PW + C_CV + 64 * g;
#pragma unroll
      for (int i = 0; i < 8; ++i) { const v4u v = *(const v4u*)(src + 8 * i); const unsigned wv[4] = {v.x, v.y, v.z, v.w};
#pragma unroll
          for (int e = 0; e < 4; ++e) { vt[(g * 64 + 8 * i + 2 * e) * VP + q] = (bf16)f2bf(geluf(wlo(wv[e]))); vt[(g * 64 + 8 * i + 2 * e + 1) * VP + q] = (bf16)f2bf(geluf(whi(wv[e]))); } } }
    __syncthreads();
    const int lane = F.lane, r32 = lane & 31, hi = lane >> 5, g = F.wave >> 1, ph = F.wave & 1;
    const bf16* Wsp = (const bf16*)(a.ws + WS_TAB) + TAB_WSP / 2 + (size_t)(l * 4 + g) * 128 * 128;
    f32x16 acc[2][2];
#pragma unroll
    for (int i = 0; i < 2; ++i)
#pragma unroll
        for (int j = 0; j < 2; ++j) acc[i][j] = f32x16{};
#pragma unroll
    for (int s = 0; s < 8; ++s) {
        bf16x8 af[2], bfr[2];
#pragma unroll
        for (int pb = 0; pb < 2; ++pb) af[pb] = *(const bf16x8*)(Wsp + (64 * ph + 32 * pb + r32) * 128 + 16 * s + 8 * hi);
#pragma unroll
        for (int cb = 0; cb < 2; ++cb) bfr[cb] = *(const LAS bf16x8*)(vt + (g * 64 + 32 * cb + r32) * VP + 16 * s + 8 * hi);
#pragma unroll
        for (int pb = 0; pb < 2; ++pb)
#pragma unroll
            for (int cb = 0; cb < 2; ++cb) acc[pb][cb] = MFMA32(af[pb], bfr[cb], acc[pb][cb]);
    }
    const float* bsp = a.in[I_BSP] + (l * 4 + g) * 128;
#pragma unroll
    for (int pb = 0; pb < 2; ++pb)
#pragma unroll
        for (int i = 0; i < 16; ++i) { const int p = 64 * ph + 32 * pb + crow(i, hi); const float bb = bsp[p]; const bf16* pr = P + (row0 + p) * PW;
#pragma unroll
            for (int cb = 0; cb < 2; ++cb) { const int c = 64 * g + 32 * cb + r32;
                const float uu = geluf(bf2f(pr[C_CU + c])), zz = siluf(bf2f(pr[C_CZ + c]));
                YB[(row0 + p) * 1024 + 768 + c] = (bf16)f2bf(C_SCALE * uu * (acc[pb][cb][i] + bb) * zz); } }
    __syncthreads();
}

#ifdef SELFCHECK
constexpr int CW_CHK = 8192;
DI unsigned hsh(unsigned x) { x *= 2654435761u; x ^= x >> 15; x *= 2246822519u; x ^= x >> 13; x *= 3266489917u; x ^= x >> 16; return x; }
DI void chk_acc(const Args& a, int id, float got, float want) {
    unsigned* w = (unsigned*)(a.ws + WS_CTL) + CW_CHK + 4 * id;
    float d = __builtin_fabsf(got - want); if (!(d == d) || d > 1e15f) d = 1e15f;
    atomicAdd((float*)w, d * d); atomicAdd((float*)(w + 1), want * want); atomicAdd(w + 2, 1u); atomicMax(w + 3, __float_as_uint(d));
}
DI float bfr(float x) { return __uint_as_float(f2bf(x) << 16); }
DI void chk_p0(const Frame& F, const Args& a) {
    const int gt = F.vcu * 512 + F.tid, NGT = F.G * 512;
    for (int s = gt; s < 18432; s += NGT) { const int l = s / 9216, v = (s / 3072) % 3, j = s % 3072; float acc = a.in[I_BADA][l * 3072 + j];
        for (int k = 0; k < 1024; ++k) { const float cv = (v < 2) ? a.in[I_C][v * 1024 + k] : a.in[I_CCTX][k]; acc += siluf(cv) * a.in[I_WADA][((size_t)l * 1024 + k) * 3072 + j]; }
        chk_acc(a, 0, ((const float*)(a.ws + WS_MOD))[(l * 3 + v) * 3072 + j], acc); }
    for (int s = gt; s < 65536; s += NGT) { const unsigned h = hsh(s); const int l = (s >> 2) & 1, m = s & 3, k = h & 1023; const unsigned h2 = hsh(h + 77u);
        float got, want;
        if (m == 0) { const int n = h2 % PW; want = bfr(a.in[I_WIN][((size_t)l * 1024 + k) * PW + n]); got = bf2f(((const bf16*)(a.ws + WS_WIN))[((size_t)l * PW + n) * 1024 + k]); }
        else if (m == 1) { const int n = h2 & 4095; want = bfr(a.in[I_WMERGE][((size_t)l * 1024 + k) * 4096 + n]); got = bf2f(((const bf16*)(a.ws + WS_WM))[((size_t)l * 4096 + n) * 1024 + k]); }
        else if (m == 2) { const int n = h2 & 1023; want = bfr(a.in[I_WOUT][((size_t)l * 1024 + k) * 1024 + n]); got = bf2f(((const bf16*)(a.ws + WS_WOUT))[((size_t)l * 1024 + n) * 1024 + k]); }
        else { const int n = h2 & 1023, br = k >> 8, kk = k & 255; want = bfr(a.in[I_WBR][(((size_t)l * 4 + br) * 256 + kk) * 1024 + n]); got = bf2f(((const bf16*)(a.ws + WS_WBR))[((size_t)l * 1024 + n) * 1024 + 256 * br + kk]); }
        chk_acc(a, 1, got, want); }
}
DI int sample_row(unsigned h, int l) { const int r = h % M_ALL; (void)l; return ((h >> 20) & 7) == 0 ? M_LAT + (h % M_CTX) : r; }
DI void chk_h(const Frame& F, const Args& a, int l, int id) {
    const float* mod = (const float*)(a.ws + WS_MOD) + (size_t)l * 3 * 3072; const bf16* H = (const bf16*)(a.ws + WS_H);
    const int gw = F.vcu * NWAVES + F.wave, NGW = F.G * NWAVES;
    for (int s = gw; s < M_ALL; s += NGW) { const int row = s; const int v = row < SEQ ? 0 : (row < M_LAT ? 1 : 2);
        const float* xr = (row < M_LAT) ? ((l == 0) ? a.in[I_X] : a.out) + (size_t)row * 1024 : ((l == 0) ? a.in[I_CTX] : (const float*)(a.ws + WS_XC1)) + (size_t)(row - M_LAT) * 1024;
        float ss = 0.f; for (int j = 0; j < 16; ++j) { const float x = xr[F.lane + 64 * j]; ss += x * x; }
        const float rstd = 1.0f / sqrtf(wave_sum(ss, F.lane) * (1.0f / 1024.0f) + RMS_EPS);
        for (int j = 0; j < 16; ++j) { const int c = F.lane + 64 * j; const float want = xr[c] * rstd * a.in[I_NORMW][l * 1024 + c] * (1.0f + mod[v * 3072 + 1024 + c]) + mod[v * 3072 + c];
            chk_acc(a, id, bf2f(H[(size_t)row * 1024 + c]), want); } }
}
DI float dot_h_w(const bf16* hrow, const bf16* wrow, int K) { float acc = 0.f; for (int k = 0; k < K; ++k) acc += bf2f(hrow[k]) * bf2f(wrow[k]); return acc; }
DI void chk_p(const Frame& F, const Args& a, int l, int id) {
    const bf16* H = (const bf16*)(a.ws + WS_H); const bf16* W = (const bf16*)(a.ws + WS_WIN) + (size_t)l * PW * 1024; const bf16* P = (const bf16*)(a.ws + WS_P);
    const int gt = F.vcu * 512 + F.tid, NGT = F.G * 512;
    for (int s = gt; s < (1 << 20); s += NGT) { const unsigned h = hsh(s * 5 + 2); const int row = sample_row(h, l); int col = hsh(h + 9u) % PW;
        if (l == 1 && row >= M_LAT) col = ((col & 1) ? 1024 : 256) + (col & 255);
        chk_acc(a, id, bf2f(P[(size_t)row * PW + col]), dot_h_w(H + (size_t)row * 1024, W + (size_t)col * 1024, 1024)); }
}
DI void chk_prep(const Frame& F, const Args& a, int l, int id) {
    const bf16* H = (const bf16*)(a.ws + WS_H); const bf16* W = (const bf16*)(a.ws + WS_WIN) + (size_t)l * PW * 1024; const bf16* P = (const bf16*)(a.ws + WS_P);
    const int gw = F.vcu * NWAVES + F.wave, NGW = F.G * NWAVES, d = F.lane;
    for (int s = gw; s < 16384; s += NGW) { const unsigned h = hsh(s * 7 + 3); const int row = sample_row(h, l); int sl = (h >> 8) % 12; const bool isctx = row >= M_LAT;
        if (isctx && l == 1) sl = (sl & 1) ? 4 + (sl & 1) : 10 + ((sl >> 1) & 1);
        const int col = (sl < 4) ? C_AQ + 64 * sl : (sl < 6) ? C_AK + 64 * (sl - 4) : (sl < 10) ? C_DQ + 64 * (sl - 6) : C_DK + 64 * (sl - 10);
        const bool isq = (sl < 4) || (sl >= 6 && sl < 10);
        const float raw = bfr(dot_h_w(H + (size_t)row * 1024, W + (size_t)(col + d) * 1024, 1024));
        const float wv = ((sl < 4) ? a.in[I_QNA] : (sl < 6) ? a.in[I_KNA] : (sl < 10) ? a.in[I_QND] : a.in[I_KND])[l * 64 + d];
        const float ms = wave_sum(raw * raw, d) * (1.0f / 64.0f);
        float y = raw / sqrtf(ms + RMS_EPS) * wv;
        if (!isctx) { const int n = row & (SEQ - 1); const float pos = (float)((d < 32) ? (n >> 6) : (n & 63)); const float inv = __builtin_amdgcn_exp2f(-(float)(d & 15) * (13.287712379549449f / 16.0f)); const float rev = pos * inv * 0.15915494309189535f; const float cs = __builtin_amdgcn_cosf(rev), sn = __builtin_amdgcn_sinf(rev);
            const float p = shx(y, 16, d); y = (d & 16) ? (p * sn + y * cs) : (y * cs - p * sn); }
        if (isq) y *= QSCALE;
        chk_acc(a, id, bf2f(P[(size_t)row * PW + col + d]), y); }
}
DI void chk_attn(const Frame& F, const Args& a, int l, int id, int mode) {
    const bf16* P = (const bf16*)(a.ws + WS_P); const bf16* YB = (const bf16*)(a.ws + WS_YB);
    LAS float* qs = (LAS float*)F.lds + F.wave * 192; LAS float* os = qs + 64; LAS float* red = qs + 128;
    const int gw = F.vcu * NWAVES + F.wave, NGW = F.G * NWAVES, lane = F.lane;
    const int qc0 = mode ? C_DQ : C_AQ, kc0 = mode ? C_DK : C_AK, vc0 = mode ? C_DV : C_AV, zc0 = mode ? C_DZ : C_AZ, oc0 = mode ? 256 : 0;
    for (int s = gw; s < 8192; s += NGW) { const unsigned hh = hsh(s * 11 + 5 + mode); int row = sample_row(hh, l); if ((s & 7) == 1) row = (hh & 8192) + (hh & 255) + ((hh & 256) ? 7936 : 0); if (l == 1 && row >= M_LAT) row = hh % M_LAT; const int h = (hh >> 9) & 3, kvh = h >> 1; const bool isctx = row >= M_LAT;
        const int b = isctx ? (row - M_LAT) / NCTX : row / SEQ, pos = row & (SEQ - 1);
        qs[lane] = bf2f(P[(size_t)row * PW + qc0 + 64 * h + lane]); LDS_WAIT();
        int klo = 0, khi = -1; if (!isctx) { if (mode == 0) { klo = 0; khi = SEQ - 1; } else { klo = pos - 128 < 0 ? 0 : pos - 128; khi = pos + 128 > SEQ - 1 ? SEQ - 1 : pos + 128; } }
        const int nlat = khi - klo + 1 > 0 ? khi - klo + 1 : 0, nk = NCTX + nlat;
        float m = -1e30f, lsum = 0.f; float acc[64];
#pragma unroll
        for (int dd = 0; dd < 64; ++dd) acc[dd] = 0.f;
        for (int kk = lane; kk < nk; kk += 64) { const size_t kr = (kk < NCTX) ? (size_t)(M_LAT + NCTX * b + kk) : (size_t)(SEQ * b + klo + kk - NCTX);
            const bf16* kp = P + kr * PW + kc0 + 64 * kvh; const bf16* vp = P + kr * PW + vc0 + 64 * kvh; float sc = 0.f;
#pragma unroll
            for (int dd = 0; dd < 64; ++dd) sc += qs[dd] * bf2f(kp[dd]);
            const float mn = fmaxf(m, sc), f = __builtin_amdgcn_exp2f(m - mn), p = __builtin_amdgcn_exp2f(sc - mn); lsum = lsum * f + p; m = mn;
#pragma unroll
            for (int dd = 0; dd < 64; ++dd) acc[dd] = acc[dd] * f + p * bf2f(vp[dd]); }
        float mall = m;
#pragma unroll
        for (int o = 1; o < 64; o <<= 1) mall = fmaxf(mall, shx(mall, o, lane));
        const float f = __builtin_amdgcn_exp2f(m - mall); lsum = wave_sum(lsum * f, lane);
        if (mode == 1) lsum += __builtin_amdgcn_exp2f(a.in[I_SINK][l * 4 + h] * 1.4426950408889634f - mall);
#pragma unroll
        for (int dd = 0; dd < 64; ++dd) { const float t = wave_sum(acc[dd] * f, lane); if (lane == dd) os[dd] = t; }
        LDS_WAIT();
        const float z = bf2f(P[(size_t)row * PW + zc0 + 64 * h + lane]);
        chk_acc(a, id, bf2f(YB[(size_t)row * 1024 + oc0 + 64 * h + lane]), os[lane] / lsum * siluf(z));
        (void)red; }
}
DI void chk_fnet(const Frame& F, const Args& a, int l, int id, int ctxmode) {
    const bf16* P = (const bf16*)(a.ws + WS_P); const bf16* YB = (const bf16*)(a.ws + WS_YB);
    LAS float* ys = (LAS float*)F.lds + F.wave * 64;
    const int gw = F.vcu * NWAVES + F.wave, NGW = F.G * NWAVES, j = F.lane;
    const int N = ctxmode ? NCTX : SEQ;
    for (int s = gw; s < (ctxmode ? 256 : 1024); s += NGW) { const unsigned hh = hsh(s * 13 + 7 + ctxmode); const int b = hh & 1, g = (hh >> 1) & 3; int k = (hh >> 3) % N;
#ifdef FNET_K0
        k = (s & 7) == 0 ? 0 : (s & 7) == 1 ? N / 2 : (s & 7) == 2 ? 64 : (s & 7) == 3 ? 128 : (s & 7) == 4 ? 1 : k;
#endif
        const size_t rbase = ctxmode ? (size_t)(M_LAT + NCTX * b) : (size_t)(SEQ * b);
        float y = 0.f;
        for (int n = 0; n < N; ++n) { const bf16* fr = P + (rbase + n) * PW + C_BF + 64 * g; float A = 0.f, B = 0.f;
            for (int c = 0; c < 64; ++c) { const float fv = bf2f(fr[c]); const float ph = (float)((j * c) & 63) * (1.0f / 64.0f); A += fv * __builtin_amdgcn_cosf(ph); B += fv * __builtin_amdgcn_sinf(ph); }
            const float th = (float)((k * n) & (N - 1)) / (float)N; y += __builtin_amdgcn_cosf(th) * A - __builtin_amdgcn_sinf(th) * B; }
        ys[j] = y / sqrtf((float)N * 64.0f); LDS_WAIT();
        float o = 0.f; for (int jj = 0; jj < 64; ++jj) o += ys[jj] * a.in[I_WFNET][((size_t)(l * 4 + g) * 64 + jj) * 64 + j];
        const size_t row = rbase + k; const float z = bf2f(P[row * PW + C_BZ + 64 * g + j]);
        chk_acc(a, id, bf2f(YB[row * 1024 + 512 + 64 * g + j]), o * siluf(z)); LDS_WAIT(); }
}
DI void chk_sgu(const Frame& F, const Args& a, int l, int id) {
    const bf16* P = (const bf16*)(a.ws + WS_P); const bf16* YB = (const bf16*)(a.ws + WS_YB);
    const int gt = F.vcu * 512 + F.tid, NGT = F.G * 512;
    for (int s = gt; s < (1 << 18); s += NGT) { const unsigned hh = hsh(s * 17 + 11); int row = sample_row(hh, l); if (l == 1 && row >= M_LAT) row = hh % M_LAT; const int cc = hsh(hh + 101u) & 255, g = cc >> 6, p = row & 127; const size_t r0 = (size_t)(row - p);
        float sp = a.in[I_BSP][(l * 4 + g) * 128 + p];
        for (int q = 0; q < 128; ++q) { const float v = bf2f(P[(r0 + q) * PW + C_CV + cc]); sp += a.in[I_WSP][((size_t)(l * 4 + g) * 128 + p) * 128 + q] * (0.5f * v * (1.0f + erff(v * 0.7071067811865476f))); }
        const float u = bf2f(P[(size_t)row * PW + C_CU + cc]), z = bf2f(P[(size_t)row * PW + C_CZ + cc]);
        chk_acc(a, id, bf2f(YB[(size_t)row * 1024 + 768 + cc]), (0.5f * u * (1.0f + erff(u * 0.7071067811865476f))) * sp * siluf(z)); }
}
DI void chk_merge(const Frame& F, const Args& a, int l, int id) {
    const bf16* H = (const bf16*)(a.ws + WS_H); const bf16* YB = (const bf16*)(a.ws + WS_YB); const bf16* MG = (const bf16*)(a.ws + WS_MG);
    const bf16* WM = (const bf16*)(a.ws + WS_WM) + (size_t)l * 4096 * 1024; const bf16* WB = (const bf16*)(a.ws + WS_WBR) + (size_t)l * 1024 * 1024;
    const int gt = F.vcu * 512 + F.tid, NGT = F.G * 512;
    for (int s = gt; s < (1 << 18); s += NGT) { const unsigned hh = hsh(s * 19 + 13); int row = sample_row(hh, l); if (l == 1 && row >= M_LAT) row = hh % M_LAT; const int d = hsh(hh + 202u) & 1023; float acc = 0.f;
        for (int r = 0; r < 4; ++r) { const float G = dot_h_w(H + (size_t)row * 1024, WM + ((size_t)r * 1024 + d) * 1024, 1024) + a.in[I_BMERGE][l * 4096 + r * 1024 + d];
            const float Y = dot_h_w(YB + (size_t)row * 1024 + 256 * r, WB + (size_t)d * 1024 + 256 * r, 256); acc += Y * __builtin_amdgcn_rcpf(1.0f + __builtin_amdgcn_exp2f(-1.4426950408889634f * G)); }
        chk_acc(a, id, bf2f(MG[(size_t)row * 1024 + d]), acc); }
}
DI void chk_gt(const Frame& F, const Args& a, int l, int r, int id) {
    const bf16* H = (const bf16*)(a.ws + WS_H); const bf16* GT = (const bf16*)(a.ws + WS_GT); const bf16* WM = (const bf16*)(a.ws + WS_WM) + (size_t)l * 4096 * 1024;
    const int gt = F.vcu * 512 + F.tid, NGT = F.G * 512;
    for (int s = gt; s < (1 << 18); s += NGT) { const unsigned hh = hsh(s * 29 + 19); int row = sample_row(hh, l); if (l == 1 && row >= M_LAT) row = hh % M_LAT; const int d = hsh(hh + 404u) & 1023;
        const float G = dot_h_w(H + (size_t)row * 1024, WM + ((size_t)r * 1024 + d) * 1024, 1024) + a.in[I_BMERGE][l * 4096 + r * 1024 + d];
        chk_acc(a, id, bf2f(GT[(size_t)row * 1024 + d]), __builtin_amdgcn_rcpf(1.0f + __builtin_amdgcn_exp2f(-1.4426950408889634f * G))); }
}
DI void chk_final(const Frame& F, const Args& a, int l, int id) {
    const bf16* MG = (const bf16*)(a.ws + WS_MG); const bf16* WO = (const bf16*)(a.ws + WS_WOUT) + (size_t)l * 1024 * 1024; const float* mod = (const float*)(a.ws + WS_MOD) + (size_t)l * 3 * 3072;
    const int gt = F.vcu * 512 + F.tid, NGT = F.G * 512;
    for (int s = gt; s < (1 << 18); s += NGT) { const unsigned hh = hsh(s * 23 + 17); const int row = sample_row(hh, l), c = hsh(hh + 303u) & 1023; const int v = row < SEQ ? 0 : (row < M_LAT ? 1 : 2);
        if (l == 1 && row >= M_LAT) continue;
        const float xi = (l == 1) ? ((const float*)(a.ws + WS_H))[(size_t)row * 1024 + c] : (row < M_LAT) ? a.in[I_X][(size_t)row * 1024 + c] : a.in[I_CTX][(size_t)(row - M_LAT) * 1024 + c];
        const float got = (row < M_LAT) ? a.out[(size_t)row * 1024 + c] : ((const float*)(a.ws + WS_XC1))[(size_t)(row - M_LAT) * 1024 + c];
        chk_acc(a, id, got - xi, mod[v * 3072 + 2048 + c] * dot_h_w(MG + (size_t)row * 1024, WO + (size_t)c * 1024, 1024)); }
}
#ifdef CHECK_MAX
#define CHK_ERR(md, ss, n, mx) ((mx) / (sqrtf((ss) / (float)(n)) + 1e-20f))
#else
#define CHK_ERR(md, ss, n, mx) sqrtf((md) / ((ss) + 1e-30f))
#endif
DI void chk_report(const Frame& F, const Args& a) {
    const unsigned* w = (const unsigned*)(a.ws + WS_CTL) + CW_CHK; int first = -1; float ferr = 0.f;
#ifdef CHECK_ONLY
    { const int id = CHECK_ONLY; const float md = __uint_as_float(w[4 * id]), ss = ((const float*)w)[4 * id + 1]; const unsigned n = w[4 * id + 2]; first = id; ferr = n ? CHK_ERR(md, ss, n, __uint_as_float(w[4 * id + 3])) : 1e3f; }
#else
    for (int id = 0; id < 24; ++id) { const float md = __uint_as_float(w[4 * id]), ss = ((const float*)w)[4 * id + 1]; const unsigned n = w[4 * id + 2]; if (!n) continue;
        const float e = CHK_ERR(md, ss, n, __uint_as_float(w[4 * id + 3])); if (e > CHECK_TOL && first < 0) { first = id; ferr = e; } }
#endif
    const float V = first >= 0 ? 10.0f * (float)(1 + first) : 0.f; const float W = first >= 0 ? 4.0f + log10f(fminf(fmaxf(ferr, 1e-3f), 1e3f)) : 0.f;
    const size_t gt = (size_t)F.vcu * 512 + F.tid, NGT = (size_t)F.G * 512;
#ifdef KEEP_OUT
    if (gt == 0) a.out[0] += V; (void)W; (void)NGT;
#else
    for (size_t i = gt; i < (size_t)M_LAT * 1024; i += NGT) { float v = a.in[I_X][i]; if (i == 0) v += V; if (i >= (1u << 20) && i < (2u << 20)) v += W; a.out[i] = v; }
#endif
}
DI void chk_copy_out(const Frame& F, const Args& a) {
    const size_t gt = (size_t)F.vcu * 512 + F.tid, NGT = (size_t)F.G * 512; float* dst = (float*)(a.ws + WS_H);
    for (size_t i = gt; i < (size_t)M_LAT * 1024; i += NGT) dst[i] = a.out[i];
}
#endif

typedef const __attribute__((address_space(4))) Args* CArgsP;
DI Args fresh_args() { CArgsP p = (CArgsP)__builtin_amdgcn_kernarg_segment_ptr(); asm volatile("" : "+s"(p)); Args r;
#pragma unroll
    for (int i = 0; i < 20; ++i) r.in[i] = p->in[i];
    r.out = p->out; r.ws = p->ws; return r; }
DI Frame fresh_frame(unsigned char* lds) {
    Frame F; int t_ = threadIdx.x; asm volatile("" : "+v"(t_));
    F.lds = (LAS unsigned char*)lds; F.tid = t_; F.lane = t_ & 63; F.wave = __builtin_amdgcn_readfirstlane(t_ >> 6);
    F.G = gridDim.x; { const int bx = blockIdx.x; F.vcu = (F.G % 8 == 0) ? (bx % 8) * (F.G / 8) + bx / 8 : bx; }
    return F;
}
DI void grid_bar(unsigned char* lds) {
    const Args a = fresh_args();
    XcdBarrier b; b.bar = (unsigned*)(a.ws + WS_CTL) + CW_BAR; b.x = xb_xcc_id(); b.st = (volatile LAS unsigned*)((LAS unsigned char*)lds + MISC_OFF) + 8;
    xcd_barrier(b);
}

__global__ void __launch_bounds__(NWAVES * 64, 2) hybrid_fwd(Args args) {
    extern __shared__ __attribute__((aligned(16))) unsigned char lds[];
    for (int u = threadIdx.x; u < (LDS_BYTES - LDSCTL_OFF) / 4; u += NWAVES * 64) ((LAS unsigned*)((LAS unsigned char*)lds + LDSCTL_OFF))[u] = 0u;
    __syncthreads();
    { const Args a = fresh_args(); (void)xcd_barrier_post((unsigned*)(a.ws + WS_CTL) + CW_BAR, (volatile LAS unsigned*)((LAS unsigned char*)lds + MISC_OFF) + 8); }
#define GRID_BAR() grid_bar(lds)
#ifdef SELFCHECK
#ifndef CHECK_SET
#define CHECK_SET 0xffff
#endif
#define CHK(bit, call) do { if ((CHECK_SET) & (bit)) { { const Frame F = fresh_frame(lds); const Args a = fresh_args(); call; } GRID_BAR(); } } while (0)
#elif defined(EXTRA_BAR)
#define CHK(bit, call) GRID_BAR()
#else
#define CHK(bit, call) do {} while (0)
#endif

#ifndef SKIP_P0
    { const Frame F = fresh_frame(lds); const Args a = fresh_args(); p0_prologue(F, a); }
#endif
    GRID_BAR();
    CHK(1, chk_p0(F, a));

#pragma unroll 1
    for (int l = 0; l < 2; ++l) {
#ifndef SKIP_P1
        { const Frame F = fresh_frame(lds); const Args a = fresh_args();
          p1_modrms(F, a, l, (l == 0) ? a.in[I_X] : a.out, (l == 0) ? a.in[I_CTX] : (const float*)(a.ws + WS_XC1), 1); }
#endif
        GRID_BAR();
        CHK(2, chk_h(F, a, l, 2 + 10 * l));
#ifndef SKIP_G1
        { const Frame F = fresh_frame(lds); const Args a = fresh_args();
            pg8::Gemm g{(const bf16*)(a.ws + WS_H), (const bf16*)(a.ws + WS_WIN) + (size_t)l * PW * 1024, 1024, 1024, 1024};
            pg8::OrderX S; S.so.init(l == 0 ? M_ALL : M_LAT, PW, F.G, (int)blockIdx.x); S.nx = (l == 0) ? 0 : 4;
            pg8::EpiBf16<0> E{(bf16*)(a.ws + WS_P), PW, nullptr};
            pg8::gemm_phase<pg8::EpiBf16<0>, pg8::OrderX, true>(F.lds, g, S, E);
        }
#endif
        GRID_BAR();
        CHK(4, chk_p(F, a, l, 3 + 10 * l));
#ifndef SKIP_S1
        { const Frame F = fresh_frame(lds); const Args a = fresh_args();
          for (int u = F.vcu; u < 256; u += F.G) fnet_s1_unit(F, a, l, u, (const bf16*)(a.ws + WS_P)); }
#endif
#ifndef SKIP_FC
        if (l == 0) { const Frame F = fresh_frame(lds); const Args a = fresh_args();
          for (int e = F.vcu; e < 256; e += F.G) { if ((e & 31) == 7) fnet_ctx_unit(F, a, l, e >> 5, (const bf16*)(a.ws + WS_P), (bf16*)(a.ws + WS_YB)); } }
#endif
#ifndef SKIP_PREP
        { const Frame F = fresh_frame(lds); const Args a = fresh_args(); p3_prep(F, a, l, (bf16*)(a.ws + WS_P)); }
#endif
        GRID_BAR();
        CHK(8, chk_prep(F, a, l, 4 + 10 * l));
#ifndef SKIP_ATT
        { const Frame F = fresh_frame(lds); const Args a = fresh_args();
            const attn_body::bf16* Pa = (const attn_body::bf16*)(a.ws + WS_P); attn_body::bf16* Ya = (attn_body::bf16*)(a.ws + WS_YB);
            for (int u = F.vcu; u < 256; u += F.G) {
                const int bk = u >> 6, b = bk >> 1, kvh = bk & 1, h = 2 * kvh + ((u >> 5) & 1), qb = u & 31;
                attn_body::attn_unit<0, 8>(Pa, Ya, SEQ * b + 256 * qb, M_LAT + NCTX * b, SEQ * b, 0, 132, 0,
                                           C_AQ + 64 * h, C_AK + 64 * kvh, C_AV + 64 * kvh, C_AZ + 64 * h, 64 * h, 0.f, (char*)lds);
            }
        }
        { const Frame F = fresh_frame(lds); const Args a = fresh_args();
            const attn_body::bf16* Pa = (const attn_body::bf16*)(a.ws + WS_P); attn_body::bf16* Ya = (attn_body::bf16*)(a.ws + WS_YB);
            for (int u = F.vcu; u < 512; u += F.G) {
                if (u < 256) {
                    const int bk = u >> 6, b = bk >> 1, kvh = bk & 1, h = 2 * kvh + ((u >> 5) & 1), qb = u & 31;
                    const int off = (qb == 0) ? 0 : 4 * qb - 2, NT = (qb == 0 || qb == 31) ? 10 : 12;
                    const float sk = a.in[I_SINK][l * 4 + h] * 1.4426950408889634f;
                    attn_body::attn_unit<1, 8>(Pa, Ya, SEQ * b + 256 * qb, M_LAT + NCTX * b, SEQ * b, off, NT, 256 * qb - 64 * off,
                                               C_DQ + 64 * h, C_DK + 64 * kvh, C_DV + 64 * kvh, C_DZ + 64 * h, 256 + 64 * h, sk, (char*)lds);
                } else if (l == 0 && ((u - 256) & 15) == 0) {
                    const int ee = (u - 256) >> 4, mode = ee >> 3, b = (ee >> 2) & 1, h = ee & 3, kvh = h >> 1;
                    const float sk = (mode == 0) ? -INFINITY : a.in[I_SINK][l * 4 + h] * 1.4426950408889634f;
                    const int qc = (mode == 0) ? C_AQ : C_DQ, kc = (mode == 0) ? C_AK : C_DK, vc = (mode == 0) ? C_AV : C_DV, zc = (mode == 0) ? C_AZ : C_DZ, oc = (mode == 0) ? 0 : 256;
                    attn_body::attn_unit<1, 8>(Pa, Ya, M_LAT + NCTX * b, M_LAT + NCTX * b, SEQ * b, 0, 4, 0,
                                               qc + 64 * h, kc + 64 * kvh, vc + 64 * kvh, zc + 64 * h, oc + 64 * h, sk, (char*)lds);
                }
            }
        }
#endif
#ifndef SKIP_S3
        { const Frame F = fresh_frame(lds); const Args a = fresh_args();
          for (int u = F.vcu; u < 256; u += F.G) fnet_s3_unit(F, a, u, (const bf16*)(a.ws + WS_P), (bf16*)(a.ws + WS_YB)); }
#endif
#ifndef SKIP_SGU
        { const Frame F = fresh_frame(lds); const Args a = fresh_args();
          const int nchunk = (l == 0) ? 132 : 128;
          for (int ci = F.vcu; ci < nchunk; ci += F.G) sgu_unit(F, a, l, ci, (const bf16*)(a.ws + WS_P), (bf16*)(a.ws + WS_YB)); }
#endif
        GRID_BAR();
        CHK(16, chk_attn(F, a, l, 5 + 10 * l, 0)); CHK(16, chk_attn(F, a, l, 6 + 10 * l, 1)); CHK(32, chk_fnet(F, a, l, 7 + 10 * l, 0); if (l == 0) chk_fnet(F, a, l, 8, 1)); CHK(64, chk_sgu(F, a, l, 9 + 10 * l));
#pragma unroll 1
        for (int r = 0; r < 4; ++r) {
#ifdef ZERO_MASK
            if ((ZERO_MASK >> r) & 1) continue;
#endif
#ifndef SKIP_MG
            { const Frame F = fresh_frame(lds); const Args a = fresh_args();
                pg8::Gemm g{(const bf16*)(a.ws + WS_H), (const bf16*)(a.ws + WS_WM) + ((size_t)l * 4096 + r * 1024) * 1024, 1024, 1024, 1024};
                pg8::OrderX S; S.so.init((l == 0) ? M_ALL : M_LAT, 1024, F.G, (int)blockIdx.x); S.nx = 0;
                pg8::EpiBf16<2> E{(bf16*)(a.ws + WS_GT), 1024, a.in[I_BMERGE] + l * 4096 + r * 1024};
                pg8::gemm_phase<pg8::EpiBf16<2>, pg8::OrderX, true>(F.lds, g, S, E);
            }
#endif
            GRID_BAR();
            if (r == 3 && l == 0) CHK(512, chk_gt(F, a, l, r, 22); chk_gt(F, a, l, 2, 23));
#ifndef SKIP_MY
            { const Frame F = fresh_frame(lds); const Args a = fresh_args();
                pg8::Gemm g{(const bf16*)(a.ws + WS_YB) + r * 256, (const bf16*)(a.ws + WS_WBR) + (size_t)l * 1024 * 1024 + r * 256, 1024, 1024, 256};
                pg8::OrderX S; S.so.init((l == 0) ? M_ALL : M_LAT, 1024, F.G, (int)blockIdx.x); S.nx = 0;

#ifdef ZERO_MASK
                pg8::EpiGate E{(bf16*)(a.ws + WS_MG), (const bf16*)(a.ws + WS_GT), 1024, r == __builtin_ctz(~(ZERO_MASK)), 1.0f};
#else
#ifdef SCALE_MASK
                pg8::EpiGate E{(bf16*)(a.ws + WS_MG), (const bf16*)(a.ws + WS_GT), 1024, r == 0, ((SCALE_MASK >> r) & 1) ? (SCALE_VAL) : 1.0f};
#else
                pg8::EpiGate E{(bf16*)(a.ws + WS_MG), (const bf16*)(a.ws + WS_GT), 1024, r == 0, 1.0f};
#endif
#endif

                pg8::gemm_phase<pg8::EpiGate, pg8::OrderX, true>(F.lds, g, S, E);
            }
#endif
            GRID_BAR();
        }
        CHK(128, chk_merge(F, a, l, 10 + 10 * l));
        if (l == 1) CHK(256, chk_copy_out(F, a));
#ifndef SKIP_OUT
        { const Frame F = fresh_frame(lds); const Args a = fresh_args();
            pg8::Gemm g{(const bf16*)(a.ws + WS_MG), (const bf16*)(a.ws + WS_WOUT) + (size_t)l * 1024 * 1024, 1024, 1024, 1024};
            pg8::OrderX S; S.so.init((l == 0) ? M_ALL : M_LAT, 1024, F.G, (int)blockIdx.x); S.nx = 0;
            pg8::EpiRes E{(l == 0) ? a.in[I_X] : a.out, a.out, (l == 0) ? a.in[I_CTX] : (const float*)(a.ws + WS_XC1), (float*)(a.ws + WS_XC1), (const float*)(a.ws + WS_MOD) + (size_t)l * 3 * 3072};
            pg8::gemm_phase<pg8::EpiRes, pg8::OrderX, true>(F.lds, g, S, E);
        }
#endif
        if (l == 0) GRID_BAR();
        if (l == 0) CHK(256, chk_final(F, a, l, 11));
#ifdef SELFCHECK
        if (l == 1) { GRID_BAR(); CHK(256, chk_final(F, a, l, 21)); }
#endif
    }
#ifdef SELFCHECK
    GRID_BAR();
    { const Frame F = fresh_frame(lds); const Args a = fresh_args(); chk_report(F, a); }
#endif
#ifdef BLEND_S
    GRID_BAR();
    { const Frame F = fresh_frame(lds); const Args a = fresh_args(); const size_t gt = (size_t)F.vcu * 512 + F.tid, NGT = (size_t)F.G * 512;
      for (size_t i = gt; i < (size_t)M_LAT * 1024; i += NGT) { const float x0 = a.in[I_X][i]; a.out[i] = x0 + (BLEND_S) * (a.out[i] - x0); } }
#endif
}

extern "C" void kernel_launch(void* const* d_in, const int* in_sizes, int n_in, void* d_out, int out_size, void* d_ws, size_t ws_size, hipStream_t stream) {
    static int grid = 0;
    if (grid == 0) {
        if (n_in != 20 || out_size != M_LAT * DM || ws_size < WS_END) { fprintf(stderr, "kernel_launch: unexpected problem: n_in %d out %d ws %zu\n", n_in, out_size, ws_size); grid = -1; return; }
        { const int want[20] = {M_LAT * DM, NB * DM, M_CTX * DM, DM, 2 * DM, 2 * DM * 3 * DM, 2 * 3 * DM, 2 * DM * PW, 128, 128, 128, 128, 8, 2 * 4 * 64 * 64, 2 * 4 * 128 * 128, 2 * 4 * 128, 2 * 4 * 256 * DM, 2 * DM * 4 * DM, 2 * 4 * DM, 2 * DM * DM};
          for (int i = 0; i < 20; ++i) if (in_sizes[i] != want[i]) { fprintf(stderr, "kernel_launch: input %d has %d elements, expected %d\n", i, in_sizes[i], want[i]); grid = -1; return; } }
        int dev = 0, cus = 0, per_cu = 0;
        if (hipGetDevice(&dev) != hipSuccess || hipDeviceGetAttribute(&cus, hipDeviceAttributeMultiprocessorCount, dev) != hipSuccess) { grid = -1; return; }
        if (hipFuncSetAttribute((const void*)hybrid_fwd, hipFuncAttributeMaxDynamicSharedMemorySize, LDS_BYTES) != hipSuccess) { fprintf(stderr, "kernel_launch: hipFuncSetAttribute failed\n"); grid = -1; return; }
        if (hipOccupancyMaxActiveBlocksPerMultiprocessor(&per_cu, (const void*)hybrid_fwd, NWAVES * 64, LDS_BYTES) != hipSuccess || per_cu < 1) { fprintf(stderr, "kernel_launch: occupancy query says %d blocks per CU\n", per_cu); per_cu = 1; }
        (void)hipGetLastError();
        grid = cus;
    }
    if (grid < 0) return;
    if (hipMemsetAsync((char*)d_ws + WS_CTL, 0, CTL_ZERO_BYTES, stream) != hipSuccess) { fprintf(stderr, "kernel_launch: memset failed\n"); return; }
    Args a{};
    for (int i = 0; i < 20; ++i) a.in[i] = (const float*)d_in[i];
    a.out = (float*)d_out; a.ws = (unsigned char*)d_ws;
    hipLaunchKernelGGL(hybrid_fwd, dim3(grid), dim3(NWAVES * 64), LDS_BYTES, stream, a);
}
```

```cpp
#include <hip/hip_runtime.h>
#include <hip/hip_bf16.h>
#include <cstdio>
#include <cstdint>
#include <cmath>

namespace pg8 {
#define PG8_LAS __attribute__((address_space(3)))
typedef unsigned short bf16_t;
typedef short bf16x8 __attribute__((ext_vector_type(8)));
typedef float f32x4 __attribute__((ext_vector_type(4)));
typedef unsigned u32x4 __attribute__((ext_vector_type(4)));
constexpr int BM = 256, BK = 64, HALF = 128, HTB = HALF * BK * 2, STAGE_BYTES = 8 * HTB, NXCD = 8, WGM = 8;

__host__ __device__ __forceinline__ int lds_byte(int r, int c) { const int st = (r >> 4) * 2 + (c >> 5), rr = r & 15, cc = c & 31, ob = rr * 64 + cc * 2; return st * 1024 + (ob ^ (((ob >> 9) & 1) << 5)); }
__host__ __device__ __forceinline__ void stage_rc(int b, int& R, int& C) { const int st = b / 1024, sb = b % 1024, swz = sb ^ (((sb >> 9) & 1) << 5); R = (st >> 1) * 16 + swz / 64; C = (st & 1) * 32 + (swz % 64) / 2; }
__host__ __device__ __forceinline__ int perm32(int rho) { const int n = rho >> 4, i = rho & 15; return 8 * (i >> 2) + 4 * n + (i & 3); }

struct Unit { int pm, pn, r, kind; };
struct Gemm { const bf16_t* A; const bf16_t* Bt; int lda, ldb, K; };

struct StaticOrder {
    int nM, nN, nwg, G, c;
    __host__ __device__ void init(int M, int N, int G_, int c_) { nM = M / BM; nN = N / BM; nwg = nM * nN; G = G_; c = c_; }
    __host__ __device__ bool next(int i, Unit& u) const {
        const long L = (long)i * G + c; if (L >= nwg) return false;
        int wgid = (int)L; { const int q = nwg / NXCD, r = nwg % NXCD, xcd = wgid % NXCD, off = wgid / NXCD; wgid = (xcd < r ? xcd * (q + 1) : r * (q + 1) + (xcd - r) * q) + off; }
        const int nig = WGM * nN, gid = wgid / nig, fm = gid * WGM, gsz = (nM - fm) < WGM ? (nM - fm) : WGM;
        u.pm = fm + ((wgid % nig) % gsz); u.pn = (wgid % nig) / gsz; u.r = 0; u.kind = 0; return true;
    }
};
struct OrderX {
    StaticOrder so; int nx;
    __device__ bool next(int i, Unit& u) const {
        const long L = (long)i * so.G + so.c;
        if (L < so.nwg) return so.next(i, u);
        const int e = (int)(L - so.nwg); if (e >= nx) return false;
        u.pm = 64 + (e >> 1); u.pn = (e & 1) ? 4 : 1; u.r = 0; u.kind = 0; return true;
    }
    __device__ __forceinline__ void src(const Gemm& g, const Unit& u, const char*& pa, const char*& pb, int& nt) const {
        pa = (const char*)g.A + (size_t)u.pm * (2 * HALF) * g.lda * 2; pb = (const char*)g.Bt + (size_t)u.pn * (2 * HALF) * g.ldb * 2; nt = g.K / BK; }
};

typedef float f32x2_c __attribute__((ext_vector_type(2))); typedef __bf16 bf16x2_c __attribute__((ext_vector_type(2)));
__device__ __forceinline__ unsigned cvt_pk_bf16(float lo, float hi) { f32x2_c v = {lo, hi}; bf16x2_c b = __builtin_convertvector(v, bf16x2_c); return __builtin_bit_cast(unsigned, b); }
__device__ __forceinline__ float bf_lo(unsigned w) { return __uint_as_float(w << 16); }
__device__ __forceinline__ float bf_hi(unsigned w) { return __uint_as_float(w & 0xffff0000u); }
__device__ __forceinline__ float sigmoidf_(float x) { return __builtin_amdgcn_rcpf(1.0f + __builtin_amdgcn_exp2f(-1.4426950408889634f * x)); }

template <int ACT> struct EpiBf16 {
    static constexpr bool PERM = true;
    bf16_t* O; int ldc; const float* bias;
    __device__ __forceinline__ void operator()(const f32x4 (&acc)[2][2][4][2], const Unit& u, int wr, int wc, int fr, int fq) const {
        const int row0 = u.pm * BM + wr * 64 + fr; const int col0 = u.pn * BM + wc * 32 + 8 * fq;
        f32x4 bv[2][2];
#pragma unroll
        for (int bj = 0; bj < 2; ++bj)
#pragma unroll
            for (int n = 0; n < 2; ++n) bv[bj][n] = bias ? *(const f32x4*)(bias + col0 + bj * HALF + 4 * n) : (f32x4){0.f, 0.f, 0.f, 0.f};
#pragma unroll
        for (int ai = 0; ai < 2; ++ai)
#pragma unroll
            for (int m = 0; m < 4; ++m) { bf16_t* rowp = O + (size_t)(row0 + ai * HALF + m * 16) * ldc + col0;
#pragma unroll
                for (int bj = 0; bj < 2; ++bj) { f32x4 v0 = acc[ai][bj][m][0] + bv[bj][0], v1 = acc[ai][bj][m][1] + bv[bj][1];
                    if (ACT == 2) {
#pragma unroll
                        for (int e = 0; e < 4; ++e) { v0[e] = sigmoidf_(v0[e]); v1[e] = sigmoidf_(v1[e]); } }
                    u32x4 w; w.x = cvt_pk_bf16(v0[0], v0[1]); w.y = cvt_pk_bf16(v0[2], v0[3]); w.z = cvt_pk_bf16(v1[0], v1[1]); w.w = cvt_pk_bf16(v1[2], v1[3]);
                    *(u32x4*)(rowp + bj * HALF) = w; } }
    }
};
struct EpiGate {
    static constexpr bool PERM = true;
    bf16_t* MG; const bf16_t* GT; int ldc; int first; float scl;
    typedef unsigned u32x2 __attribute__((ext_vector_type(2)));
    __device__ __forceinline__ void operator()(const f32x4 (&acc)[2][2][4][2], const Unit& u, int wr, int wc, int fr, int fq) const {
        const int row0 = u.pm * BM + wr * 64 + fr; const int col0 = u.pn * BM + wc * 32 + 8 * fq;
#pragma unroll
        for (int ai = 0; ai < 2; ++ai)
#pragma unroll
            for (int m = 0; m < 4; ++m) { const size_t off = (size_t)(row0 + ai * HALF + m * 16) * ldc + col0;
#pragma unroll
                for (int bj = 0; bj < 2; ++bj)
#pragma unroll
                    for (int n = 0; n < 2; ++n) {
                        const u32x2 g = *(const u32x2*)(GT + off + bj * HALF + 4 * n);
                        u32x2 o = (u32x2){0u, 0u}; if (!first) o = *(const u32x2*)(MG + off + bj * HALF + 4 * n);
                        const f32x4 v = acc[ai][bj][m][n] * scl;
                        u32x2 w;
                        w.x = cvt_pk_bf16(bf_lo(o.x) + bf_lo(g.x) * v[0], bf_hi(o.x) + bf_hi(g.x) * v[1]);
                        w.y = cvt_pk_bf16(bf_lo(o.y) + bf_lo(g.y) * v[2], bf_hi(o.y) + bf_hi(g.y) * v[3]);
                        *(u32x2*)(MG + off + bj * HALF + 4 * n) = w; asm volatile("" ::: "memory"); } }
    }
};
struct EpiRes {
    static constexpr bool PERM = false;
    const float* xin_lat; float* xout_lat; const float* xin_ctx; float* xout_ctx; const float* gate;
    __device__ __forceinline__ void operator()(const f32x4 (&acc)[2][2][4][2], const Unit& u, int wr, int wc, int fr, int fq) const {
        const bool isctx = u.pm >= 64;
        const float* xin = isctx ? xin_ctx + (size_t)(u.pm - 64) * BM * 1024 : xin_lat + (size_t)u.pm * BM * 1024;
        float* xout = isctx ? xout_ctx + (size_t)(u.pm - 64) * BM * 1024 : xout_lat + (size_t)u.pm * BM * 1024;
        const float* gv = gate + (isctx ? 2 : (u.pm >> 5)) * 3072 + 2048;
        const int col0 = u.pn * BM + wc * 32 + 4 * fq;
        f32x4 gt[2][2];
#pragma unroll
        for (int bj = 0; bj < 2; ++bj)
#pragma unroll
            for (int n = 0; n < 2; ++n) gt[bj][n] = *(const f32x4*)(gv + col0 + bj * HALF + n * 16);
#pragma unroll
        for (int ai = 0; ai < 2; ++ai)
#pragma unroll
            for (int m = 0; m < 4; ++m) { const size_t off = (size_t)(ai * HALF + wr * 64 + m * 16 + fr) * 1024 + col0;
#pragma unroll
                for (int bj = 0; bj < 2; ++bj)
#pragma unroll
                    for (int n = 0; n < 2; ++n) {
                        if (u.kind == 3) { const f32x4 v = gt[bj][n] * acc[ai][bj][m][n]; float* q = xout + off + bj * HALF + n * 16; atomicAdd(q + 0, v[0]); atomicAdd(q + 1, v[1]); atomicAdd(q + 2, v[2]); atomicAdd(q + 3, v[3]); }
                        else { const f32x4 bs = *(const f32x4*)(xin + off + bj * HALF + n * 16); *(f32x4*)(xout + off + bj * HALF + n * 16) = bs + gt[bj][n] * acc[ai][bj][m][n]; } }
                if (m & 1) asm volatile("" ::: "memory"); }
    }
};

struct MergeOrder {
    const bf16_t* H; const bf16_t* YB; const bf16_t* WmT; const bf16_t* WbrT; int G, c, nctx;
    __device__ bool next(int i, Unit& u) const {
        const int nl = (c < 256) ? 1 + (255 - c) / G : 0;
        if (i < 8 * nl) { const int t = c + (i >> 3) * G, q = i & 7; u.pm = t >> 2; u.pn = t & 3; u.r = q >> 1; u.kind = q & 1; return true; }
        const int j = i - 8 * nl;
        if (nctx == 0 || (c & 7) != 0) return false;
        const int jb = (c >> 3) + (j >> 1) * (G >> 3); if (jb >= nctx) return false;
        const int t = jb >> 2; u.pm = 64 + (t >> 2); u.pn = t & 3; u.r = jb & 3; u.kind = (j & 1) ? 2 : 0; return true;
    }
    __device__ __forceinline__ void src(const Gemm&, const Unit& u, const char*& pa, const char*& pb, int& nt) const {
        if (u.kind == 0) { pa = (const char*)(H + (size_t)u.pm * 256 * 1024); pb = (const char*)(WmT + ((size_t)u.r * 1024 + u.pn * 256) * 1024); nt = 16; }
        else { pa = (const char*)(YB + (size_t)u.pm * 256 * 1024 + u.r * 256); pb = (const char*)(WbrT + (size_t)u.pn * 256 * 1024 + u.r * 256); nt = 4; }
    }
};
typedef unsigned long long u64_t;
__device__ __forceinline__ u64_t ld_sc1(const void* p) { return __hip_atomic_load((const u64_t*)p, __ATOMIC_RELAXED, __HIP_MEMORY_SCOPE_AGENT); }
struct EpiMerge {
    static constexpr bool PERM = true;
    bf16_t* GT; bf16_t* MG; float* MGc; const float* bias; bf16_t* GTc;
    typedef unsigned u32x2 __attribute__((ext_vector_type(2)));
    __device__ __forceinline__ void operator()(const f32x4 (&acc)[2][2][4][2], const Unit& u, int wr, int wc, int fr, int fq) const {
        const int row0 = u.pm * BM + wr * 64 + fr; const int col0 = u.pn * BM + wc * 32 + 8 * fq;
        bf16_t* GTu = (u.pm >= 64) ? GTc + ((size_t)u.r * 512 - 16384) * 1024 : GT;
        if (u.kind == 0) {
            const float* bp = bias + u.r * 1024 + col0;
            f32x4 bv[2][2];
#pragma unroll
            for (int bj = 0; bj < 2; ++bj)
#pragma unroll
                for (int n = 0; n < 2; ++n) bv[bj][n] = *(const f32x4*)(bp + bj * HALF + 4 * n);
#pragma unroll
            for (int ai = 0; ai < 2; ++ai)
#pragma unroll
                for (int m = 0; m < 4; ++m) { bf16_t* rowp = GTu + (size_t)(row0 + ai * HALF + m * 16) * 1024 + col0;
#pragma unroll
                    for (int bj = 0; bj < 2; ++bj) { f32x4 v0 = acc[ai][bj][m][0] + bv[bj][0], v1 = acc[ai][bj][m][1] + bv[bj][1];
#pragma unroll
                        for (int e = 0; e < 4; ++e) { v0[e] = sigmoidf_(v0[e]); v1[e] = sigmoidf_(v1[e]); }
                        u32x4 w; w.x = cvt_pk_bf16(v0[0], v0[1]); w.y = cvt_pk_bf16(v0[2], v0[3]); w.z = cvt_pk_bf16(v1[0], v1[1]); w.w = cvt_pk_bf16(v1[2], v1[3]);
                        *(u32x4*)(rowp + bj * HALF) = w; } }
        } else if (u.kind == 1) {
            const bool first = (u.r == 0);
#pragma unroll
            for (int ai = 0; ai < 2; ++ai)
#pragma unroll
                for (int mp = 0; mp < 2; ++mp) { u64_t gq[2][2][2], oq[2][2][2];
#pragma unroll
                    for (int mm = 0; mm < 2; ++mm) { const size_t off = (size_t)(row0 + ai * HALF + (2 * mp + mm) * 16) * 1024 + col0;
#pragma unroll
                        for (int bj = 0; bj < 2; ++bj)
#pragma unroll
                            for (int n = 0; n < 2; ++n) { gq[mm][bj][n] = ld_sc1(GTu + off + bj * HALF + 4 * n); oq[mm][bj][n] = first ? 0ull : ld_sc1(MG + off + bj * HALF + 4 * n); } }
#pragma unroll
                    for (int mm = 0; mm < 2; ++mm) { const size_t off = (size_t)(row0 + ai * HALF + (2 * mp + mm) * 16) * 1024 + col0;
#pragma unroll
                        for (int bj = 0; bj < 2; ++bj)
#pragma unroll
                            for (int n = 0; n < 2; ++n) { const u64_t g_ = gq[mm][bj][n], o_ = oq[mm][bj][n];
                                const unsigned gx = (unsigned)g_, gy = (unsigned)(g_ >> 32), ox = (unsigned)o_, oy = (unsigned)(o_ >> 32);
                                const f32x4 v = acc[ai][bj][2 * mp + mm][n];
                                u32x2 w;
                                w.x = cvt_pk_bf16(bf_lo(ox) + bf_lo(gx) * v[0], bf_hi(ox) + bf_hi(gx) * v[1]);
                                w.y = cvt_pk_bf16(bf_lo(oy) + bf_lo(gy) * v[2], bf_hi(oy) + bf_hi(gy) * v[3]);
                                *(u32x2*)(MG + off + bj * HALF + 4 * n) = w; } }
                    asm volatile("" ::: "memory"); }
        } else {
#pragma unroll
            for (int ai = 0; ai < 2; ++ai)
#pragma unroll
                for (int m = 0; m < 4; ++m) { const size_t off = (size_t)(row0 + ai * HALF + m * 16) * 1024 + col0; float* mp = MGc + (off - (size_t)16384 * 1024);
#pragma unroll
                    for (int bj = 0; bj < 2; ++bj)
#pragma unroll
                        for (int n = 0; n < 2; ++n) {
                            const u64_t gq = ld_sc1(GTu + off + bj * HALF + 4 * n); const unsigned gx = (unsigned)gq, gy = (unsigned)(gq >> 32);
                            const f32x4 v = acc[ai][bj][m][n]; float* q = mp + bj * HALF + 4 * n;
                            atomicAdd(q + 0, bf_lo(gx) * v[0]); atomicAdd(q + 1, bf_hi(gx) * v[1]); atomicAdd(q + 2, bf_lo(gy) * v[2]); atomicAdd(q + 3, bf_hi(gy) * v[3]);
                            asm volatile("" ::: "memory"); } }
        }
    }
};
struct OrderOut {
    StaticOrder so; int nx;
    __device__ bool next(int i, Unit& u) const {
        const long L = (long)i * so.G + so.c;
        if (L < so.nwg) return so.next(i, u);
        const int e = (int)(L - so.nwg); if (e >= nx) return false;
        const int t = e >> 2; u.pm = 64 + (t >> 2); u.pn = t & 3; u.r = e & 3; u.kind = 3; return true;
    }
    __device__ __forceinline__ void src(const Gemm& g, const Unit& u, const char*& pa, const char*& pb, int& nt) const {
        pa = (const char*)g.A + (size_t)u.pm * (2 * HALF) * g.lda * 2; pb = (const char*)g.Bt + (size_t)u.pn * (2 * HALF) * g.ldb * 2; nt = g.K / BK;
        if (u.kind == 3) { pa += (size_t)u.r * 256 * 2; pb += (size_t)u.r * 256 * 2; nt = 4; }
    }
};

template <class Epi, class Sched, bool ALIGN_EPI>
__device__ __forceinline__ void gemm_phase(PG8_LAS unsigned char* lds, const Gemm g, const Sched& S, const Epi& E) {
    int tid = threadIdx.x; asm volatile("" : "+v"(tid));
    const int wid = __builtin_amdgcn_readfirstlane(tid >> 6), lane = tid & 63, wr = wid >> 2, wc = wid & 3, fr = lane & 15, fq = lane >> 4;
    int nt;
    unsigned voffA[2], voffB[2];
#pragma unroll
    for (int i = 0; i < 2; ++i) { int R, C; stage_rc(tid * 16 + i * 8192, R, C); const int Rb = Epi::PERM ? ((R & ~31) + perm32(R & 31)) : R;
        voffA[i] = (unsigned)(R * g.lda + C) * 2u; voffB[i] = (unsigned)(Rb * g.ldb + C) * 2u; }
    const size_t kstep = (size_t)(BK * 2);
    const size_t hstepA = (size_t)HALF * g.lda * 2, hstepB = (size_t)HALF * g.ldb * 2;
    const unsigned ldsw = (unsigned)wid * 1024u;
    const int aoff = lds_byte(wr * 64 + fr, fq * 8), boff = lds_byte(wc * 32 + fr, fq * 8);
#define PG8_SA(b, h) (((b) * 2 + (h)) * HTB)
#define PG8_SB(b, h) ((4 + (b) * 2 + (h)) * HTB)
#define PG8_STAGE(bufoff, gbase, voff) do { _Pragma("unroll") for (int _i = 0; _i < 2; ++_i) \
        __builtin_amdgcn_global_load_lds((const unsigned*)((const char*)(gbase) + (voff)[_i]), (PG8_LAS unsigned*)(lds + (bufoff) + ldsw + _i * 8192), 16, 0, 0); } while (0)
#define PG8_LDA(dst, b, h) do { _Pragma("unroll") for (int m = 0; m < 4; ++m) _Pragma("unroll") for (int k = 0; k < 2; ++k) dst[m][k] = *(const PG8_LAS bf16x8*)(lds + PG8_SA(b, h) + aoff + m * 2048 + k * 1024); } while (0)
#define PG8_LDB(dst, b, h) do { _Pragma("unroll") for (int n = 0; n < 2; ++n) _Pragma("unroll") for (int k = 0; k < 2; ++k) dst[n][k] = *(const PG8_LAS bf16x8*)(lds + PG8_SB(b, h) + boff + n * 2048 + k * 1024); } while (0)
#define PG8_MMA(ai, bj, At, Bt) do { __builtin_amdgcn_s_setprio(1); _Pragma("unroll") for (int m = 0; m < 4; ++m) _Pragma("unroll") for (int n = 0; n < 2; ++n) _Pragma("unroll") for (int k = 0; k < 2; ++k) \
        acc[ai][bj][m][n] = __builtin_amdgcn_mfma_f32_16x16x32_bf16(Bt[n][k], At[m][k], acc[ai][bj][m][n], 0, 0, 0); __builtin_amdgcn_s_setprio(0); } while (0)
#define PG8_WAIT_V(n) asm volatile("s_waitcnt vmcnt(" #n ")" ::: "memory")
#define PG8_WAIT_L(n) asm volatile("s_waitcnt lgkmcnt(" #n ")" ::: "memory")
#define PG8_BAR __builtin_amdgcn_s_barrier()
#define PG8_SCHED __builtin_amdgcn_sched_barrier(0)
    Unit cur, nxt; int ui = 0;
    if (!S.next(0, cur)) return;
    f32x4 acc[2][2][4][2];
#pragma unroll
    for (int a = 0; a < 2; ++a)
#pragma unroll
        for (int b = 0; b < 2; ++b)
#pragma unroll
            for (int m = 0; m < 4; ++m)
#pragma unroll
                for (int n = 0; n < 2; ++n) acc[a][b][m][n] = (f32x4){0.f, 0.f, 0.f, 0.f};
    bf16x8 At[4][2], B0[2][2], B1[2][2];
    const char* cA; const char* cB; S.src(g, cur, cA, cB, nt);
    PG8_STAGE(PG8_SB(0, 0), cB, voffB); PG8_STAGE(PG8_SB(0, 1), cB + hstepB, voffB); PG8_STAGE(PG8_SA(0, 0), cA, voffA); PG8_STAGE(PG8_SA(0, 1), cA + hstepA, voffA);
    if (wr == 1) PG8_BAR;
    PG8_WAIT_V(2); PG8_BAR;
    PG8_STAGE(PG8_SB(1, 0), cB + kstep, voffB); PG8_STAGE(PG8_SA(1, 0), cA + kstep, voffA); PG8_STAGE(PG8_SB(1, 1), cB + hstepB + kstep, voffB);
    PG8_WAIT_V(6); PG8_BAR;
    for (;;) {
        const bool has_next = S.next(ui + 1, nxt);
        const char* nA = cA; const char* nB = cB; int nnt = nt; if (has_next) S.src(g, nxt, nA, nB, nnt);
        for (int t = 0; t < nt; t += 2) {
            const bool last = (t == nt - 2);
            const char* a1 = cA + (size_t)(t + 1) * kstep;
            const char* a2 = last ? nA : cA + (size_t)(t + 2) * kstep; const char* b2 = last ? nB : cB + (size_t)(t + 2) * kstep;
            const char* a3 = a2 + kstep; const char* b3 = b2 + kstep;
            PG8_LDB(B0, 0, 0); PG8_LDB(B1, 0, 1); PG8_SCHED; PG8_LDA(At, 0, 0); PG8_STAGE(PG8_SA(1, 1), a1 + hstepA, voffA);
            PG8_WAIT_V(8); PG8_WAIT_L(0); PG8_BAR; PG8_MMA(0, 0, At, B0); PG8_MMA(0, 1, At, B1); PG8_BAR; PG8_SCHED;
            PG8_LDA(At, 0, 1); PG8_STAGE(PG8_SB(0, 0), b2, voffB); PG8_STAGE(PG8_SB(0, 1), b2 + hstepB, voffB); PG8_STAGE(PG8_SA(0, 0), a2, voffA);
            PG8_WAIT_V(8); PG8_WAIT_L(0); PG8_BAR; PG8_MMA(1, 0, At, B0); PG8_MMA(1, 1, At, B1); PG8_BAR; PG8_SCHED;
            PG8_LDB(B0, 1, 0); PG8_LDB(B1, 1, 1); PG8_SCHED; PG8_LDA(At, 1, 0); PG8_STAGE(PG8_SA(0, 1), a2 + hstepA, voffA);
            PG8_WAIT_V(8); PG8_WAIT_L(0); PG8_BAR; PG8_MMA(0, 0, At, B0); PG8_MMA(0, 1, At, B1); PG8_BAR; PG8_SCHED;
            PG8_LDA(At, 1, 1); PG8_STAGE(PG8_SB(1, 0), b3, voffB); PG8_STAGE(PG8_SB(1, 1), b3 + hstepB, voffB); PG8_STAGE(PG8_SA(1, 0), a3, voffA);
            PG8_WAIT_V(8); PG8_WAIT_L(0); PG8_BAR; PG8_MMA(1, 0, At, B0); PG8_MMA(1, 1, At, B1); PG8_BAR; PG8_SCHED;
        }
        if constexpr (ALIGN_EPI) { if (wr == 0) PG8_BAR; }
        E(acc, cur, wr, wc, fr, fq);
        if (!has_next) break;
#pragma unroll
        for (int a = 0; a < 2; ++a)
#pragma unroll
            for (int b = 0; b < 2; ++b)
#pragma unroll
                for (int m = 0; m < 4; ++m)
#pragma unroll
                    for (int n = 0; n < 2; ++n) acc[a][b][m][n] = (f32x4){0.f, 0.f, 0.f, 0.f};
        cur = nxt; cA = nA; cB = nB; nt = nnt; ++ui;
        if constexpr (ALIGN_EPI) { if (wr == 1) PG8_BAR; }
    }
    PG8_WAIT_V(0);
    if constexpr (!ALIGN_EPI) { if (wr == 0) PG8_BAR; }
    PG8_BAR;
#undef PG8_SA
#undef PG8_SB
#undef PG8_STAGE
#undef PG8_LDA
#undef PG8_LDB
#undef PG8_MMA
#undef PG8_WAIT_V
#undef PG8_WAIT_L
#undef PG8_BAR
#undef PG8_SCHED
}
}

namespace sg {
using pg8::bf16_t; using pg8::bf16x8; using pg8::f32x4; using pg8::u32x4; using pg8::lds_byte; using pg8::stage_rc; using pg8::perm32; using pg8::cvt_pk_bf16; using pg8::bf_lo; using pg8::bf_hi; using pg8::sigmoidf_;
constexpr int HTB = 16384, SLOT = 3 * HTB, NT_Y = 4, NT_G = 16, NT_R = NT_Y + NT_G, NT_U = 4 * NT_R;
struct Merge { const bf16_t* H; const bf16_t* YB; const bf16_t* WmT; const bf16_t* WbrT; const float* bias; bf16_t* MG; int nunits; };
__device__ __forceinline__ void unit_of(int u, int& pm, int& pn) { pm = u >> 2; pn = u & 3; }

__device__ __forceinline__ void merge_phase(PG8_LAS unsigned char* lds, const Merge g, int vcu, int G) {
    int tid = threadIdx.x; asm volatile("" : "+v"(tid));
    const int wid = __builtin_amdgcn_readfirstlane(tid >> 6), lane = tid & 63, wr = wid >> 2, wc = wid & 3, fr = lane & 15, fq = lane >> 4;
    int nu = 0; for (int u = vcu; u < g.nunits; u += G) ++nu;
    if (nu == 0) return;
    unsigned voffA[2], voffB[2];
#pragma unroll
    for (int i = 0; i < 2; ++i) { int R, C; stage_rc(tid * 16 + i * 8192, R, C); const int Rb = (R & ~31) + perm32(R & 31);
        voffA[i] = (unsigned)(R * 1024 + C) * 2u; voffB[i] = (unsigned)(Rb * 1024 + C) * 2u; }
    const unsigned ldsw = (unsigned)wid * 1024u;
    const int aoff = lds_byte(wr * 64 + fr, fq * 8), boff = lds_byte(wc * 32 + fr, fq * 8);
    const int ntot = nu * NT_U;
#define SG_SRC(s, pa, pb) do { const int _s = (s) < ntot ? (s) : 0; const int _ui = _s / NT_U, _j = _s - _ui * NT_U, _r = _j / NT_R, _jj = _j - _r * NT_R; int _pm, _pn; unit_of(vcu + _ui * G, _pm, _pn); \
        if (_jj < NT_Y) { const size_t _c = (size_t)(256 * _r + 64 * _jj); pa = (const char*)(g.YB + (size_t)_pm * 128 * 1024 + _c); pb = (const char*)(g.WbrT + (size_t)_pn * 256 * 1024 + _c); } \
        else { const size_t _c = (size_t)(64 * (_jj - NT_Y)); pa = (const char*)(g.H + (size_t)_pm * 128 * 1024 + _c); pb = (const char*)(g.WmT + ((size_t)_r * 1024 + _pn * 256) * 1024 + _c); } } while (0)
#define SG_STAGE1(bufoff, gbase, voff) do { _Pragma("unroll") for (int _i = 0; _i < 2; ++_i) \
        __builtin_amdgcn_global_load_lds((const unsigned*)((const char*)(gbase) + (voff)[_i]), (PG8_LAS unsigned*)(lds + (bufoff) + ldsw + _i * 8192), 16, 0, 0); } while (0)
#define SG_STAGE(s, slotoff) do { const char* _pa; const char* _pb; SG_SRC(s, _pa, _pb); SG_STAGE1((slotoff), _pa, voffA); SG_STAGE1((slotoff) + HTB, _pb, voffB); SG_STAGE1((slotoff) + 2 * HTB, _pb + (size_t)128 * 1024 * 2, voffB); } while (0)
#define SG_LDA(dst, so) do { _Pragma("unroll") for (int m = 0; m < 4; ++m) _Pragma("unroll") for (int k = 0; k < 2; ++k) dst[m][k] = *(const PG8_LAS bf16x8*)(lds + (so) + aoff + m * 2048 + k * 1024); } while (0)
#define SG_LDB(dst, so, h) do { _Pragma("unroll") for (int n = 0; n < 2; ++n) _Pragma("unroll") for (int k = 0; k < 2; ++k) dst[n][k] = *(const PG8_LAS bf16x8*)(lds + (so) + HTB * (1 + (h)) + boff + n * 2048 + k * 1024); } while (0)
#define SG_MMA(bj, At, Bt) do { __builtin_amdgcn_s_setprio(1); _Pragma("unroll") for (int m = 0; m < 4; ++m) _Pragma("unroll") for (int n = 0; n < 2; ++n) _Pragma("unroll") for (int k = 0; k < 2; ++k) \
        acc[bj][m][n] = __builtin_amdgcn_mfma_f32_16x16x32_bf16(Bt[n][k], At[m][k], acc[bj][m][n], 0, 0, 0); __builtin_amdgcn_s_setprio(0); } while (0)
#define SG_WAIT_V(n) asm volatile("s_waitcnt vmcnt(" #n ")" ::: "memory")
#define SG_WAIT_L(n) asm volatile("s_waitcnt lgkmcnt(" #n ")" ::: "memory")
#define SG_BAR __builtin_amdgcn_s_barrier()
#define SG_SCHED __builtin_amdgcn_sched_barrier(0)
    f32x4 acc[2][4][2]; u32x4 yp[2][4], mrg[2][4];
#pragma unroll
    for (int b = 0; b < 2; ++b)
#pragma unroll
        for (int m = 0; m < 4; ++m) { yp[b][m] = (u32x4){0u, 0u, 0u, 0u}; mrg[b][m] = (u32x4){0u, 0u, 0u, 0u};
#pragma unroll
            for (int n = 0; n < 2; ++n) acc[b][m][n] = (f32x4){0.f, 0.f, 0.f, 0.f}; }
    bf16x8 At[4][2], B0[2][2], B1[2][2];
    SG_STAGE(0, 0); SG_STAGE(1, SLOT);
    if (wr == 1) SG_BAR;
    SG_WAIT_V(6); SG_BAR; SG_BAR;
    int slot_c = 0, slot_n = 2 * SLOT;
    int j = 0, ui = 0;
#pragma unroll 1
    for (int s = 0; s < ntot; ++s) {
        SG_LDB(B0, slot_c, 0); SG_LDB(B1, slot_c, 1); SG_SCHED; SG_LDA(At, slot_c); SG_STAGE(s + 2, slot_n);
        SG_WAIT_V(6); SG_WAIT_L(0); SG_BAR; SG_MMA(0, At, B0); SG_MMA(1, At, B1); SG_BAR; SG_SCHED;
        slot_c = (slot_c == 2 * SLOT) ? 0 : slot_c + SLOT; slot_n = (slot_n == 2 * SLOT) ? 0 : slot_n + SLOT;
        const int r = j / NT_R, jj = j - r * NT_R;
        if (jj == NT_Y - 1) {
            int pm, pn; unit_of(vcu + ui * G, pm, pn);
            const float* bp = g.bias + r * 1024 + pn * 256 + wc * 32 + 8 * fq;
#pragma unroll
            for (int b = 0; b < 2; ++b) { const f32x4 b0 = *(const f32x4*)(bp + b * 128), b1 = *(const f32x4*)(bp + b * 128 + 4);
#pragma unroll
                for (int m = 0; m < 4; ++m) { const f32x4 v0 = acc[b][m][0], v1 = acc[b][m][1];
                    yp[b][m] = (u32x4){cvt_pk_bf16(v0[0], v0[1]), cvt_pk_bf16(v0[2], v0[3]), cvt_pk_bf16(v1[0], v1[1]), cvt_pk_bf16(v1[2], v1[3])};
                    acc[b][m][0] = b0; acc[b][m][1] = b1; SG_SCHED; } }
        } else if (jj == NT_R - 1) {
#pragma unroll
            for (int b = 0; b < 2; ++b)
#pragma unroll
                for (int m = 0; m < 4; ++m) { const u32x4 y = yp[b][m], o = mrg[b][m]; f32x4 g0 = acc[b][m][0], g1 = acc[b][m][1];
#pragma unroll
                    for (int e = 0; e < 4; ++e) { g0[e] = sigmoidf_(g0[e]); g1[e] = sigmoidf_(g1[e]); }
                    mrg[b][m] = (u32x4){cvt_pk_bf16(bf_lo(o.x) + g0[0] * bf_lo(y.x), bf_hi(o.x) + g0[1] * bf_hi(y.x)), cvt_pk_bf16(bf_lo(o.y) + g0[2] * bf_lo(y.y), bf_hi(o.y) + g0[3] * bf_hi(y.y)),
                                        cvt_pk_bf16(bf_lo(o.z) + g1[0] * bf_lo(y.z), bf_hi(o.z) + g1[1] * bf_hi(y.z)), cvt_pk_bf16(bf_lo(o.w) + g1[2] * bf_lo(y.w), bf_hi(o.w) + g1[3] * bf_hi(y.w))};
                    acc[b][m][0] = (f32x4){0.f, 0.f, 0.f, 0.f}; acc[b][m][1] = (f32x4){0.f, 0.f, 0.f, 0.f}; SG_SCHED; }
            if (r == 3) {
                int pm, pn; unit_of(vcu + ui * G, pm, pn);
                bf16_t* op = g.MG + (size_t)(pm * 128 + wr * 64 + fr) * 1024 + pn * 256 + wc * 32 + 8 * fq;
#pragma unroll
                for (int m = 0; m < 4; ++m)
#pragma unroll
                    for (int b = 0; b < 2; ++b) { *(u32x4*)(op + (size_t)m * 16 * 1024 + b * 128) = mrg[b][m]; mrg[b][m] = (u32x4){0u, 0u, 0u, 0u}; }
            }
        }
        if (++j == NT_U) { j = 0; ++ui; }
    }
    SG_WAIT_V(0);
    if (wr == 0) SG_BAR;
    SG_BAR;
#undef SG_SRC
#undef SG_STAGE1
#undef SG_STAGE
#undef SG_LDA
#undef SG_LDB
#undef SG_MMA
#undef SG_WAIT_V
#undef SG_WAIT_L
#undef SG_BAR
#undef SG_SCHED
}
}
namespace attn_body {
using bf16=__hip_bfloat16;
using bf16x8=__attribute__((ext_vector_type(8)))short;
using s16x4=__attribute__((ext_vector_type(4)))short;
using f32x16=__attribute__((ext_vector_type(16)))float;
using u32x4=__attribute__((ext_vector_type(4)))unsigned;
constexpr int D=64;
constexpr int NW=8,QBLK=32,QB=QBLK*NW,KVBLK=64;
constexpr int PP=2816, YP=1024;
__device__ __forceinline__ int crow(int r,int hi){return (r&3)+8*(r>>2)+4*hi;}
#define SBAR() __builtin_amdgcn_sched_barrier(0)
__device__ __forceinline__ void dmask(f32x16&p0,f32x16&p1,int kb,unsigned lim,int qrel,int hi){
  const float NEG=-INFINITY; const unsigned b0=(unsigned)(kb+4*hi-qrel+128);
  #pragma unroll
  for(int r=0;r<16;++r){const unsigned dd=b0+(unsigned)((r&3)+8*(r>>2)); if(dd>lim)p0[r]=NEG; if(dd+32u>lim)p1[r]=NEG;}
}

constexpr int NSLOT=3, SLOTB=8192;
constexpr int LDS_K=0, LDS_V=NSLOT*SLOTB, LDS_WS=2*NSLOT*SLOTB, LDS_OST=LDS_WS+NW*64*4, LDS_BYTES=LDS_OST+NW*4096;
constexpr float C2=0.125f*1.4426950408889634f;
__device__ __forceinline__ void glds16(const void*gsrc,unsigned lds_dst){unsigned keep;
  asm volatile("s_mov_b32 %0, m0\n\ts_mov_b32 m0, %2\n\ts_nop 0\n\tglobal_load_lds_dwordx4 %1, off\n\ts_mov_b32 m0, %0":"=&s"(keep):"v"(gsrc),"s"(lds_dst):"memory");}
__device__ __forceinline__ float siluf_(float x){ return x*__builtin_amdgcn_rcpf(1.0f+__builtin_amdgcn_exp2f(-1.4426950408889634f*x)); }
__device__ __forceinline__ float max3f(float a,float b,float c){float r;asm("v_max3_f32 %0, %1, %2, %3":"=v"(r):"v"(a),"v"(b),"v"(c));return r;}
__device__ __forceinline__ float max2f(float a,float b){float r;asm("v_max_f32_e32 %0, %1, %2":"=v"(r):"v"(a),"v"(b));return r;}
__device__ __forceinline__ float fadd_s(float a,float b){float r;asm("v_add_f32_e32 %0, %1, %2":"=v"(r):"v"(a),"v"(b));return r;}
__device__ __forceinline__ float fsub_s(float a,float b){float r;asm("v_sub_f32_e32 %0, %1, %2":"=v"(r):"v"(a),"v"(b));return r;}
typedef float f32x2_t __attribute__((ext_vector_type(2))); typedef __bf16 bf16x2_t __attribute__((ext_vector_type(2)));
__device__ __forceinline__ unsigned cvtpk_s(float lo,float hi){f32x2_t v={lo,hi};bf16x2_t b=__builtin_convertvector(v,bf16x2_t);return __builtin_bit_cast(unsigned,b);}
#define WAIT_BAR(N) asm volatile("s_waitcnt vmcnt(" #N ") lgkmcnt(0)\n\ts_barrier":::"memory")

__device__ __forceinline__ void qkt(f32x16&p0,f32x16&p1,const char*Kslot,const bf16x8*qr,const f32x16&negm,int r32,int hi){
  const char*kb=Kslot+hi*1024+r32*16;
  #pragma unroll
  for(int d0=0;d0<4;++d0){
    const bf16x8 b0=*reinterpret_cast<const bf16x8*>(kb+d0*2048);
    const bf16x8 b1=*reinterpret_cast<const bf16x8*>(kb+d0*2048+512);
    if(d0==0){p0=__builtin_amdgcn_mfma_f32_32x32x16_bf16(b0,qr[0],negm,0,0,0);p1=__builtin_amdgcn_mfma_f32_32x32x16_bf16(b1,qr[0],negm,0,0,0);}
    else{p0=__builtin_amdgcn_mfma_f32_32x32x16_bf16(b0,qr[d0],p0,0,0,0);p1=__builtin_amdgcn_mfma_f32_32x32x16_bf16(b1,qr[d0],p1,0,0,0);}}
}
typedef __attribute__((address_space(3))) const char* lds_cptr;
typedef short v4i16_t __attribute__((ext_vector_type(4)));
__device__ __forceinline__ void kload8(bf16x8*kf,lds_cptr kp){
  kf[0]=*(const __attribute__((address_space(3))) bf16x8*)(kp);      kf[1]=*(const __attribute__((address_space(3))) bf16x8*)(kp+512);
  kf[2]=*(const __attribute__((address_space(3))) bf16x8*)(kp+2048); kf[3]=*(const __attribute__((address_space(3))) bf16x8*)(kp+2560);
  kf[4]=*(const __attribute__((address_space(3))) bf16x8*)(kp+4096); kf[5]=*(const __attribute__((address_space(3))) bf16x8*)(kp+4608);
  kf[6]=*(const __attribute__((address_space(3))) bf16x8*)(kp+6144); kf[7]=*(const __attribute__((address_space(3))) bf16x8*)(kp+6656);
}
__device__ __forceinline__ void kload2(bf16x8*kf,lds_cptr kp,int j){ kf[2*j]=*(const __attribute__((address_space(3))) bf16x8*)(kp+j*2048); kf[2*j+1]=*(const __attribute__((address_space(3))) bf16x8*)(kp+j*2048+512); }
__device__ __forceinline__ s16x4 vtr(lds_cptr p){ return __builtin_bit_cast(s16x4,__builtin_amdgcn_ds_read_tr16_b64_v4i16((__attribute__((address_space(3))) v4i16_t*)p)); }
__device__ __forceinline__ float rowmax(const f32x16&p0,const f32x16&p1){
  float a=max3f(p0[0],p0[1],p1[0]),b=max3f(p0[2],p0[3],p1[1]);a=max3f(a,p1[2],p1[3]);
  #pragma unroll
  for(int r=4;r<16;r+=4){a=max3f(a,p0[r],p0[r+1]);b=max3f(b,p0[r+2],p0[r+3]);a=max3f(a,p1[r],p1[r+1]);b=max3f(b,p1[r+2],p1[r+3]);}
  const float m=max2f(a,b);
  auto rr=__builtin_amdgcn_permlane32_swap(__float_as_uint(m),__float_as_uint(m),false,false);
  return max2f(__uint_as_float(rr[0]),__uint_as_float(rr[1]));
}
__device__ __forceinline__ void pv(f32x16*o,int vb,bf16x8 pa0,bf16x8 pa1,bf16x8 pa2,bf16x8 pa3){
  #pragma unroll
  for(int d0=0;d0<2;++d0){s16x4 lo[4],hi[4];
    #pragma unroll
    for(int ks=0;ks<4;++ks){
      asm volatile("ds_read_b64_tr_b16 %0,%1 offset:%c2":"=&v"(lo[ks]):"v"(vb),"i"(d0*4096+ks*1024):"memory");
      asm volatile("ds_read_b64_tr_b16 %0,%1 offset:%c2":"=&v"(hi[ks]):"v"(vb),"i"(d0*4096+ks*1024+512):"memory");}
    asm volatile("s_waitcnt lgkmcnt(0)":::"memory");SBAR();
    #define PK(k) (bf16x8){lo[k][0],lo[k][1],lo[k][2],lo[k][3],hi[k][0],hi[k][1],hi[k][2],hi[k][3]}
    o[d0]=__builtin_amdgcn_mfma_f32_32x32x16_bf16(pa0,PK(0),o[d0],0,0,0);
    o[d0]=__builtin_amdgcn_mfma_f32_32x32x16_bf16(pa1,PK(1),o[d0],0,0,0);
    o[d0]=__builtin_amdgcn_mfma_f32_32x32x16_bf16(pa2,PK(2),o[d0],0,0,0);
    o[d0]=__builtin_amdgcn_mfma_f32_32x32x16_bf16(pa3,PK(3),o[d0],0,0,0);
    #undef PK
  }
}

#ifndef ATTN_STORE16
#define ATTN_STORE16(p,v) (*(u32x4*)(p)=(v))
#endif
template<int MODE,int THRL> __device__ __forceinline__ void attn_unit(const bf16*Pm,bf16*YB,int qrow0,int ctx0,int lat0,int off,int NT,int wq0,int qcol,int kcol,int vcol,int zcol,int ocol,float sinkl2,char*shm){
  int tid_=threadIdx.x; asm volatile("":"+v"(tid_)); const int tid=tid_,lane=tid&63,r32=lane&31,hi=lane>>5; const int wid=__builtin_amdgcn_readfirstlane(tid>>6);
  const bf16*Qw=Pm+(long)(qrow0+wid*QBLK)*PP+qcol;
  const unsigned lds0=(unsigned)(uintptr_t)shm;
  float*wsf=(float*)(shm+LDS_WS)+wid*64;
  const bf16*ksrc=Pm+kcol+(long)lane*PP+wid*8;
  const bf16*vsrc=Pm+vcol+(long)(16*(wid&3)+(lane>>2))*PP+(wid>>2)*32+(lane&3)*8;
  const unsigned kdst=lds0+LDS_K+wid*1024, vdst=lds0+LDS_V+wid*1024;
  #define TROW(t) (((t)<4)?(ctx0+64*(t)):(lat0+64*((t)-4+off)))
  #define DMA_K(t,slot) glds16(ksrc+(long)TROW(t)*PP,(unsigned)__builtin_amdgcn_readfirstlane(kdst+(slot)))
  #define DMA_V(t,slot) glds16(vsrc+(long)TROW(t)*PP,(unsigned)__builtin_amdgcn_readfirstlane(vdst+(slot)))
  const int vb0=(int)(lds0+LDS_V)+((lane>>4)&1)*32+(lane&3)*8+(4*hi+((lane&15)>>2))*64;
  const char*Kbase=shm+LDS_K; bf16x8 kf[8];
  const lds_cptr shm3=(lds_cptr)shm; const lds_cptr kp0=shm3+LDS_K+hi*1024+r32*16; const lds_cptr vp0=shm3+LDS_V+((lane>>4)&1)*32+(lane&3)*8+(4*hi+((lane&15)>>2))*64;
  DMA_K(0,0);DMA_V(0,0);DMA_K(1,SLOTB);
  bf16x8 qr[4];
  #pragma unroll
  for(int d0=0;d0<4;++d0)qr[d0]=*reinterpret_cast<const bf16x8*>(&Qw[(long)r32*PP+d0*16+hi*8]);
  float mhat=0.f,l_reg=0.f;f32x16 o[2];o[0]=f32x16{};o[1]=f32x16{};f32x16 negm=f32x16{}; if(MODE==0){asm volatile("":"+v"(negm));}
  const int qrel=wid*QBLK+r32;
  #define CMASK(P0,P1,t) do{ if(MODE==1){ dmask(P0,P1,64*((t)-4)-wq0,((t)>=4)?256u:~0u,qrel,hi); } }while(0)
  bool resc=false;
  #define START(P0,P1) do{ const float rm=rowmax(P0,P1); resc=false; \
    { const float dl=rm; mhat=fadd_s(mhat,dl); \
      _Pragma("unroll") for(int r=0;r<16;++r){P0[r]=fsub_s(P0[r],dl);P1[r]=fsub_s(P1[r],dl);} \
      if(MODE==0){ _Pragma("unroll") for(int r=0;r<16;++r)negm[r]=-mhat; asm volatile("":"+v"(negm)); } } \
    _Pragma("unroll") for(int r=0;r<16;++r)P0[r]=__builtin_amdgcn_exp2f(P0[r]); }while(0)
  #define RESC() do{ if(resc){ asm volatile("s_waitcnt lgkmcnt(0)":::"memory"); \
      _Pragma("unroll") for(int d_=0;d_<2;++d_) _Pragma("unroll") for(int r=0;r<16;++r)o[d_][r]*=wsf[crow(r,hi)]; } }while(0)
  f32x16 pA0,pA1,pB0,pB1;
  int sl_prev=0,sl_cur=0,sl_next=SLOTB;
  #define ROT() do{sl_prev=sl_cur;sl_cur=sl_next;sl_next=(sl_next==(NSLOT-1)*SLOTB)?0:sl_next+SLOTB;}while(0)
  DMA_K(2,2*SLOTB);
  WAIT_BAR(3);
  qkt(pA0,pA1,Kbase,qr,negm,r32,hi);asm volatile("s_nop 15\n\ts_nop 7":"+v"(pA0),"+v"(pA1));CMASK(pA0,pA1,0);
  START(pA0,pA1);
  _Pragma("unroll") for(int r=0;r<16;++r)pA1[r]=__builtin_amdgcn_exp2f(pA1[r]);
  WAIT_BAR(0);
  DMA_K(3,0);DMA_V(1,SLOTB);
  ROT();
  kload8(kf,kp0+sl_cur);
  WAIT_BAR(2);
  s16x4 vlo[8],vhi[8]; u32x4 pw0,pw1,pw2,pw3;
  #define PKW(P,B) cvtpk_s(P[B],P[B+1])
  #define PAF(k) __builtin_bit_cast(bf16x8,pw##k)
  #define VFR(i) (bf16x8){vlo[i][0],vlo[i][1],vlo[i][2],vlo[i][3],vhi[i][0],vhi[i][1],vhi[i][2],vhi[i][3]}
  #define PIN(x) asm volatile("":"+v"(x))
  #define MX3(a,b,c) __builtin_fmaxf(__builtin_fmaxf((a),(b)),(c))
  #define GAPA(MF,A0,A1,A2,A3,W0,W1,PW) do{ MF; sacc+=A0; sacc+=A1; sacc+=A2; sacc+=A3; PIN(sacc); W0; W1; PIN(PW); SBAR(); }while(0)
  #define EX(v) __builtin_amdgcn_exp2f(v)
  #define GAPB(MF,X,B) do{ MF; X[B]=EX(X[B]); X[B+1]=EX(X[B+1]); X[B+2]=EX(X[B+2]); X[B+3]=EX(X[B+3]); PIN(X); SBAR(); }while(0)
  #define VRD(i) do{ vlo[i]=vtr(vp_+(((i)>>2)*4096+((i)&3)*1024)); vhi[i]=vtr(vp_+(((i)>>2)*4096+((i)&3)*1024+512)); }while(0)
  #define KRD(G,j) do{ if(G){ kload2(kf,kp0+sl_next,j); SBAR(); } }while(0)
  #define STEP(C0,C1,P0,P1,t,GK,GV,GL) do{ SBAR(); \
    const lds_cptr vp_=vp0+sl_prev; \
    VRD(0); SBAR(); float sacc=(P0[0]+P0[1]); \
    GAPA(C0=__builtin_amdgcn_mfma_f32_32x32x16_bf16(kf[0],qr[0],negm,0,0,0), P0[2],P0[3],P0[4],P0[5],     pw0[0]=PKW(P0,0), pw0[1]=PKW(P0,2), pw0); \
    VRD(4); SBAR(); GAPA(C1=__builtin_amdgcn_mfma_f32_32x32x16_bf16(kf[1],qr[0],negm,0,0,0), P0[6],P0[7],P0[8],P0[9],     pw0[2]=PKW(P0,4), pw0[3]=PKW(P0,6), pw0); \
    VRD(1); SBAR(); GAPA(C0=__builtin_amdgcn_mfma_f32_32x32x16_bf16(kf[2],qr[1],C0,0,0,0),   P0[10],P0[11],P0[12],P0[13], pw1[0]=PKW(P0,8), pw1[1]=PKW(P0,10), pw1); \
    VRD(5); SBAR(); GAPA(C1=__builtin_amdgcn_mfma_f32_32x32x16_bf16(kf[3],qr[1],C1,0,0,0),   P0[14],P0[15],P1[0],P1[1],   pw1[2]=PKW(P0,12),pw1[3]=PKW(P0,14), pw1); \
    VRD(2); SBAR(); GAPA(C0=__builtin_amdgcn_mfma_f32_32x32x16_bf16(kf[4],qr[2],C0,0,0,0),   P1[2],P1[3],P1[4],P1[5],     pw2[0]=PKW(P1,0), pw2[1]=PKW(P1,2), pw2); \
    VRD(6); SBAR(); GAPA(C1=__builtin_amdgcn_mfma_f32_32x32x16_bf16(kf[5],qr[2],C1,0,0,0),   P1[6],P1[7],P1[8],P1[9],     pw2[2]=PKW(P1,4), pw2[3]=PKW(P1,6), pw2); \
    VRD(3); SBAR(); GAPA(C0=__builtin_amdgcn_mfma_f32_32x32x16_bf16(kf[6],qr[3],C0,0,0,0),   P1[10],P1[11],P1[12],P1[13], pw3[0]=PKW(P1,8), pw3[1]=PKW(P1,10), pw3); \
    VRD(7); SBAR(); GAPA(C1=__builtin_amdgcn_mfma_f32_32x32x16_bf16(kf[7],qr[3],C1,0,0,0),   P1[14],P1[15],0.f,0.f,       pw3[2]=PKW(P1,12),pw3[3]=PKW(P1,14), pw3); \
    l_reg+=sacc; \
    if(GK){DMA_K((t)+3,sl_cur);} if(GV){DMA_V((t)+1,sl_next);} \
    CMASK(C0,C1,t); \
    { float a=MX3(C0[0],C0[1],C1[0]),b=MX3(C0[2],C0[3],C1[1]); a=MX3(a,C1[2],C1[3]); \
      _Pragma("unroll") for(int r=4;r<16;r+=4){a=MX3(a,C0[r],C0[r+1]);b=MX3(b,C0[r+2],C0[r+3]);a=MX3(a,C1[r],C1[r+1]);b=MX3(b,C1[r+2],C1[r+3]);} \
      float rm=__builtin_fmaxf(a,b); { auto rr=__builtin_amdgcn_permlane32_swap(__float_as_uint(rm),__float_as_uint(rm),false,false); rm=__builtin_fmaxf(__uint_as_float(rr[0]),__uint_as_float(rr[1])); } \
      resc=false; if(MODE==1) rm-=mhat; \
      if(__builtin_expect(__any(rm>(float)THRL),0)){ const float dl=__builtin_fmaxf(rm,0.f); mhat+=dl; \
        if(MODE==0){ _Pragma("unroll") for(int r=0;r<16;++r){C0[r]-=dl;C1[r]-=dl;} \
          _Pragma("unroll") for(int r=0;r<16;++r)negm[r]=-mhat; asm volatile("":"+v"(negm)); } \
        const float f=__builtin_amdgcn_exp2f(-dl); l_reg*=f; if(hi==0)wsf[r32]=f; resc=true; } \
      if(MODE==1){ _Pragma("unroll") for(int r=0;r<16;++r){C0[r]-=mhat;C1[r]-=mhat;} } } \
    SBAR(); \
    GAPB(o[0]=__builtin_amdgcn_mfma_f32_32x32x16_bf16(PAF(0),VFR(0),o[0],0,0,0), C0,0); \
    GAPB(o[1]=__builtin_amdgcn_mfma_f32_32x32x16_bf16(PAF(0),VFR(4),o[1],0,0,0), C0,4); \
    KRD(GL,0); GAPB(o[0]=__builtin_amdgcn_mfma_f32_32x32x16_bf16(PAF(1),VFR(1),o[0],0,0,0), C0,8); \
    KRD(GL,1); GAPB(o[1]=__builtin_amdgcn_mfma_f32_32x32x16_bf16(PAF(1),VFR(5),o[1],0,0,0), C0,12); \
    KRD(GL,2); GAPB(o[0]=__builtin_amdgcn_mfma_f32_32x32x16_bf16(PAF(2),VFR(2),o[0],0,0,0), C1,0); \
    KRD(GL,3); GAPB(o[1]=__builtin_amdgcn_mfma_f32_32x32x16_bf16(PAF(2),VFR(6),o[1],0,0,0), C1,4); \
    GAPB(o[0]=__builtin_amdgcn_mfma_f32_32x32x16_bf16(PAF(3),VFR(3),o[0],0,0,0), C1,8); \
    GAPB(o[1]=__builtin_amdgcn_mfma_f32_32x32x16_bf16(PAF(3),VFR(7),o[1],0,0,0), C1,12); \
    }while(0)
  int t=1;
  if(MODE==0) for(;t+5<NT;t+=2){
    STEP(pB0,pB1,pA0,pA1,t,true,true,true);     WAIT_BAR(2); RESC(); ROT();
    STEP(pA0,pA1,pB0,pB1,t+1,true,true,true);   WAIT_BAR(2); RESC(); ROT();
  }
  #define ENDW(tt) do{ if((tt)+3<NT){WAIT_BAR(2);} else if((tt)+2<NT){WAIT_BAR(1);} else {WAIT_BAR(0);} }while(0)
  for(;t+1<NT;t+=2){
    STEP(pB0,pB1,pA0,pA1,t,(t+3<NT),(t+1<NT),(t+1<NT));       ENDW(t);   RESC(); ROT();
    STEP(pA0,pA1,pB0,pB1,t+1,(t+4<NT),(t+2<NT),(t+2<NT));     ENDW(t+1); RESC(); ROT();
  }
  STEP(pB0,pB1,pA0,pA1,NT-1,false,false,false); RESC();
  { float sacc=pB0[0]+pB0[1]; _Pragma("unroll") for(int r=2;r<16;++r)sacc+=pB0[r]; _Pragma("unroll") for(int r=0;r<16;++r)sacc+=pB1[r]; l_reg+=sacc;
    pw0=(u32x4){PKW(pB0,0),PKW(pB0,2),PKW(pB0,4),PKW(pB0,6)};pw1=(u32x4){PKW(pB0,8),PKW(pB0,10),PKW(pB0,12),PKW(pB0,14)};pw2=(u32x4){PKW(pB1,0),PKW(pB1,2),PKW(pB1,4),PKW(pB1,6)};pw3=(u32x4){PKW(pB1,8),PKW(pB1,10),PKW(pB1,12),PKW(pB1,14)};
    SBAR(); pv(o,vb0+sl_cur,PAF(0),PAF(1),PAF(2),PAF(3)); }
  #undef PKW
  #undef PAF
  #undef VFR
  #undef PIN
  #undef MX3
  #undef GAPA
  #undef GAPB
  #undef EX
  #undef VRD
  #undef KRD
  #undef STEP
  #undef ENDW
  {auto rr=__builtin_amdgcn_permlane32_swap(__float_as_uint(l_reg),__float_as_uint(l_reg),false,false);l_reg=__uint_as_float(rr[0])+__uint_as_float(rr[1]);}
  if(MODE==1){ l_reg+=__builtin_amdgcn_exp2f(sinkl2-mhat); }
  if(hi==0)wsf[32+r32]=l_reg;asm volatile("s_waitcnt lgkmcnt(0)":::"memory");
  float rli[16];
  #pragma unroll
  for(int r=0;r<16;++r)rli[r]=__builtin_amdgcn_rcpf(wsf[32+crow(r,hi)]);
  bf16*Ow=YB+(long)(qrow0+wid*QBLK)*YP+ocol; const bf16*Zw=Pm+(long)(qrow0+wid*QBLK)*PP+zcol;
  { bf16*stg=(bf16*)(shm+LDS_OST)+wid*2048;
    #pragma unroll
    for(int r=0;r<16;++r){const int orow=crow(r,hi);
      #pragma unroll
      for(int d0=0;d0<2;++d0)stg[orow*64+d0*32+r32]=__float2bfloat16(o[d0][r]*rli[r]);}
    asm volatile("s_waitcnt lgkmcnt(0)":::"memory");
    #pragma unroll
    for(int i=0;i<4;++i){const int row=i*8+(lane>>3),ch=lane&7; const u32x4 v=*(const u32x4*)(stg+row*64+ch*8); const u32x4 z=*(const u32x4*)(Zw+(long)row*PP+ch*8); u32x4 w;
      #define GATE2(vv,zz) cvtpk_s(__uint_as_float((vv)<<16)*siluf_(__uint_as_float((zz)<<16)),__uint_as_float((vv)&0xffff0000u)*siluf_(__uint_as_float((zz)&0xffff0000u)))
      w.x=GATE2(v.x,z.x); w.y=GATE2(v.y,z.y); w.z=GATE2(v.z,z.z); w.w=GATE2(v.w,z.w);
      #undef GATE2
      *(u32x4*)(Ow+(long)row*YP+ch*8)=w;} }
  asm volatile("s_waitcnt lgkmcnt(0)\n\ts_barrier":::"memory");
  #undef DMA_K
  #undef DMA_V
  #undef CMASK
  #undef START
  #undef RESC
  #undef ROT
  #undef TROW
}
#undef SBAR
#undef WAIT_BAR
}

constexpr int NWAVES = 8;
constexpr int DM = 1024, SEQ = 8192, NCTX = 256, NB = 2;
constexpr int M_LAT = NB * SEQ, M_CTX = NB * NCTX, M_ALL = M_LAT + M_CTX;
constexpr int PW = 2816;
constexpr float RMS_EPS = 1e-6f;
constexpr float QSCALE = 0.125f * 1.4426950408889634f;
constexpr int C_AQ = 0, C_AK = 256, C_AV = 384, C_AZ = 512, C_DQ = 768, C_DK = 1024, C_DV = 1152, C_DZ = 1280, C_BF = 1536, C_BZ = 1792, C_CU = 2048, C_CV = 2304, C_CZ = 2560;

constexpr size_t MiB = 1u << 20;
constexpr size_t WS_CTL = 0, CTL_ZERO_BYTES = 1 * MiB;
constexpr size_t WS_MOD = 1 * MiB;
constexpr size_t WS_TAB = 2 * MiB;
constexpr size_t TAB_MA = 0, TAB_128 = 131072, TAB_64 = 229376, TAB_256 = 245760, TAB_WSP = 507904, TAB_ONES = 786432, TAB_BIASB = 1048576;
constexpr size_t WS_WIN = 4 * MiB, WS_WM = 16 * MiB, WS_WBR = 32 * MiB, WS_WOUT = 36 * MiB;
constexpr size_t WS_XC1 = 40 * MiB;
constexpr size_t WS_H = 42 * MiB, WS_YB = 75 * MiB, WS_T1 = 108 * MiB, WS_P = 124 * MiB;
constexpr size_t WS_GT = WS_P, WS_MG = WS_P + 40 * MiB;
constexpr size_t WS_MGC = 216 * MiB;
constexpr size_t WS_GTC = 218 * MiB;
constexpr size_t WS_END = 222 * MiB;
constexpr int CW_BAR = 4096;

constexpr int RING_BYTES = 147456, LDSCTL_OFF = RING_BYTES, MISC_OFF = LDSCTL_OFF + 320, LDS_BYTES = RING_BYTES + 1024;

#define GAS __attribute__((address_space(1)))
#define LAS __attribute__((address_space(3)))
typedef unsigned short bf16;
typedef unsigned v4u __attribute__((ext_vector_type(4)));
typedef unsigned v2u __attribute__((ext_vector_type(2)));
typedef float f32x4 __attribute__((ext_vector_type(4)));
typedef float f32x16 __attribute__((ext_vector_type(16)));
typedef short bf16x8 __attribute__((ext_vector_type(8)));
typedef GAS unsigned gu32;
#define RLX_AGENT __ATOMIC_RELAXED, __HIP_MEMORY_SCOPE_AGENT
#define LDS_WAIT() asm volatile("s_waitcnt lgkmcnt(0)" ::: "memory")
#define MFMA32(a, b, c) __builtin_amdgcn_mfma_f32_32x32x16_bf16((a), (b), (c), 0, 0, 0)
#define DI __device__ __forceinline__
DI unsigned f2bf(float f) { unsigned u = __builtin_bit_cast(unsigned, f); return (u + 0x7fffu + ((u >> 16) & 1u)) >> 16; }
DI unsigned pk2(float lo, float hi) { return f2bf(lo) | (f2bf(hi) << 16); }
DI float bf2f(bf16 v) { return __uint_as_float((unsigned)v << 16); }
DI float wlo(unsigned w) { return __uint_as_float(w << 16); }
DI float whi(unsigned w) { return __uint_as_float(w & 0xffff0000u); }
DI int crow(int reg, int h) { return (reg & 3) + 8 * (reg >> 2) + 4 * h; }
DI int krow(int s, int h, int j) { return 16 * s + 8 * (j >> 2) + 4 * h + (j & 3); }
DI float siluf(float x) { return x * __builtin_amdgcn_rcpf(1.0f + __builtin_amdgcn_exp2f(-1.4426950408889634f * x)); }
DI float geluf(float v) {
    const float av = __builtin_fabsf(v), d = av * 0.2316418882f + 1.0f, t = __builtin_amdgcn_rcpf(d);
    float q = t * 0.5307027145f + (-0.7265760135f); q = q * t + 0.7107068705f; q = q * t + (-0.142248368f); q = q * t + 0.127414796f; q = q * t;
    const float e = __builtin_amdgcn_exp2f((v * v) * (-0.72134752044f)), m = v * (q * e), r = v - m;
    return v < 0.f ? m : r;
}
typedef float f32x2_t __attribute__((ext_vector_type(2))); typedef __bf16 bf16x2_t __attribute__((ext_vector_type(2)));
DI unsigned cvtpk(float lo, float hi) { f32x2_t v = {lo, hi}; bf16x2_t b = __builtin_convertvector(v, bf16x2_t); return __builtin_bit_cast(unsigned, b); }
DI bf16x8 pack_step(const f32x16& x, int s) {
    v4u p; p.x = cvtpk(x[8 * s], x[8 * s + 1]); p.y = cvtpk(x[8 * s + 2], x[8 * s + 3]); p.z = cvtpk(x[8 * s + 4], x[8 * s + 5]); p.w = cvtpk(x[8 * s + 6], x[8 * s + 7]);
    return __builtin_bit_cast(bf16x8, p);
}
DI float shx(float v, int o, int lane) { return __int_as_float(__builtin_amdgcn_ds_bpermute((lane ^ o) << 2, __float_as_int(v))); }
DI float wave_sum(float v, int lane) {
#pragma unroll
    for (int o = 1; o < 64; o <<= 1) v += shx(v, o, lane);
    return v;
}

#define XB_TMO      128
#define XB_XCNT(j)  (256  + 64 * (j))
#define XB_XSUB(j)  (1280 + 64 * (j))
#define XB_XGEN(j)  (2304 + 64 * (j))
#define XB_TOP      3328
#define XB_TOPGEN   3392
#define XCD_BAR_WORDS 3456
#define XB_SPIN_CAP (1u << 22)
DI unsigned xb_ld(unsigned* p)              { return __hip_atomic_load(p, __ATOMIC_RELAXED, __HIP_MEMORY_SCOPE_AGENT); }
DI unsigned xb_add(unsigned* p, unsigned v) { return __hip_atomic_fetch_add(p, v, __ATOMIC_RELAXED, __HIP_MEMORY_SCOPE_AGENT); }
DI unsigned xb_xcc_id() { return (unsigned)__builtin_amdgcn_s_getreg((3 << 11) | 20) & 0xFu; }
#define XB_SPIN(cond, bar) do { unsigned _sp = 0; while (cond) { __builtin_amdgcn_s_sleep(1); \
    if ((++_sp & 255u) == 0u) { if (xb_ld(&(bar)[XB_TMO])) break; if (_sp > XB_SPIN_CAP) { atomicAdd(&(bar)[XB_TMO], 1u); break; } } } } while (0)
struct XcdBarrier { unsigned* bar; unsigned x; volatile LAS unsigned* st; };
DI XcdBarrier xcd_barrier_post(unsigned* bar, volatile LAS unsigned* st) {
    XcdBarrier b; b.bar = bar; b.x = xb_xcc_id(); b.st = st;
    if (threadIdx.x == 0) (void)xb_add(&bar[XB_XCNT(b.x)], 1u);
    return b;
}
DI void xcd_barrier_complete(unsigned* bar, unsigned x, unsigned& nloc, unsigned& nx) {
    const unsigned G = gridDim.x * gridDim.y * gridDim.z;
    unsigned sum, cnt, mine, sp = 0u;
    for (;;) {
        sum = 0u; cnt = 0u; mine = 0u;
#pragma unroll
        for (unsigned j = 0; j < 16; ++j) { const unsigned c = xb_ld(&bar[XB_XCNT(j)]); sum += c; cnt += (c > 0u) ? 1u : 0u; mine = (j == x) ? c : mine; }
        if (sum == G) break;
        __builtin_amdgcn_s_sleep(1);
        if ((++sp & 255u) == 0u) { if (xb_ld(&bar[XB_TMO])) break; if (sp > XB_SPIN_CAP) { atomicAdd(&bar[XB_TMO], 1u); break; } }
    }
    nloc = mine > 0u ? mine : 1u; nx = cnt > 0u ? cnt : 1u;
}
DI void xcd_barrier(const XcdBarrier& b) {
    asm volatile("s_waitcnt vmcnt(0)" ::: "memory");
    __syncthreads();
    if (threadIdx.x == 0) {
        unsigned* bar = b.bar;
        __builtin_amdgcn_s_waitcnt(0);
        unsigned nloc = b.st[0], nx = b.st[1];
        if (nloc == 0u) { xcd_barrier_complete(bar, b.x, nloc, nx); b.st[0] = nloc; b.st[1] = nx; }
        const unsigned old = xb_add(&bar[XB_XSUB(b.x)], 1u);
        const unsigned gen = old / nloc;
        if (old + 1u == (gen + 1u) * nloc) {
            __builtin_amdgcn_fence(__ATOMIC_RELEASE, "agent");
            asm volatile("s_waitcnt vmcnt(0)" ::: "memory");
            const unsigned og = xb_add(&bar[XB_TOP], 1u);
            const unsigned tg = og / nx;
            if (og + 1u == (tg + 1u) * nx) xb_add(&bar[XB_TOPGEN], 1u);
            else XB_SPIN(xb_ld(&bar[XB_TOPGEN]) == tg, bar);
            __builtin_amdgcn_fence(__ATOMIC_ACQUIRE, "agent");
            xb_add(&bar[XB_XGEN(b.x)], 1u);
            asm volatile("s_waitcnt vmcnt(0)" ::: "memory");
        } else {
            XB_SPIN(xb_ld(&bar[XB_XGEN(b.x)]) == gen, bar);
            __builtin_amdgcn_fence(__ATOMIC_ACQUIRE, "agent");
            asm volatile("s_waitcnt vmcnt(0)" ::: "memory");
        }
    }
    __syncthreads();
}

struct Frame {
    LAS unsigned char* lds;
    int tid, lane, wave, vcu, G;
};

DI void p0_transpose_item(const float* W, int N, bf16* WT, int ldt, int row_off, int col_off, LAS float* scr, int item, int lane) {
    const int nblk = N / 32, kb = item / nblk, nb = item % nblk, k0 = 64 * kb, n0 = 32 * nb;
#pragma unroll 8
    for (int i = 0; i < 32; ++i) { const int kk = 2 * i + (lane >> 5); scr[kk * 33 + (lane & 31)] = W[(size_t)(k0 + kk) * N + n0 + (lane & 31)]; }
    LDS_WAIT(); asm volatile("" ::: "memory");
    const int c = lane & 7;
#pragma unroll
    for (int j = 0; j < 4; ++j) { const int n = (lane >> 3) + 8 * j; const LAS float* s = scr + (8 * c) * 33 + n;
        v4u o; o.x = pk2(s[0 * 33], s[1 * 33]); o.y = pk2(s[2 * 33], s[3 * 33]); o.z = pk2(s[4 * 33], s[5 * 33]); o.w = pk2(s[6 * 33], s[7 * 33]);
        *(GAS v4u*)(WT + (size_t)(row_off + n0 + n) * ldt + col_off + k0 + 8 * c) = o; }
    LDS_WAIT(); asm volatile("" ::: "memory");
}

struct Args { const float* in[20]; float* out; unsigned char* ws; };
enum { I_X = 0, I_C, I_CTX, I_CCTX, I_NORMW, I_WADA, I_BADA, I_WIN, I_QNA, I_KNA, I_QND, I_KND, I_SINK, I_WFNET, I_WSP, I_BSP, I_WBR, I_WMERGE, I_BMERGE, I_WOUT };

DI void p0_prologue(const Frame& F, const Args& a) {
    unsigned char* ws = a.ws;
    for (int u = F.vcu; u < 96; u += F.G) {
        const int l = u / 48, j0 = 64 * (u % 48);
        LAS float* sl = (LAS float*)F.lds; LAS float* red = sl + 3072;
        for (int i = F.tid; i < 3072; i += 512) { const int v = i >> 10, k = i & 1023; const float cv = (v < 2) ? a.in[I_C][v * 1024 + k] : a.in[I_CCTX][k]; sl[i] = siluf(cv); }
        __syncthreads();
        float a0 = 0.f, a1 = 0.f, a2 = 0.f;
        const float* wp = a.in[I_WADA] + (size_t)l * 1024 * 3072 + (size_t)(128 * F.wave) * 3072 + j0 + F.lane;
#pragma unroll 8
        for (int kk = 0; kk < 128; ++kk) { const float w = wp[(size_t)kk * 3072]; const int k = 128 * F.wave + kk; a0 += sl[k] * w; a1 += sl[1024 + k] * w; a2 += sl[2048 + k] * w; }
        red[(F.wave * 3 + 0) * 64 + F.lane] = a0; red[(F.wave * 3 + 1) * 64 + F.lane] = a1; red[(F.wave * 3 + 2) * 64 + F.lane] = a2;
        __syncthreads();
        if (F.tid < 192) { const int v = F.tid >> 6, jj = F.tid & 63; float s = a.in[I_BADA][l * 3072 + j0 + jj];
#pragma unroll
            for (int w = 0; w < 8; ++w) s += red[(w * 3 + v) * 64 + jj];
            ((float*)(ws + WS_MOD))[(l * 3 + v) * 3072 + j0 + jj] = s; }
        __syncthreads();
    }
    {
        LAS float* scr = (LAS float*)(F.lds + F.wave * 16384);
        const int gw = F.vcu * NWAVES + F.wave, NGW = F.G * NWAVES;
        constexpr int I_IN = 16 * 88, I_M = 16 * 128, I_O = 16 * 32, I_B = 4 * 32, PER_L = I_IN + I_M + I_O + 4 * I_B;
        for (int it = gw; it < 2 * PER_L; it += NGW) {
            const int l = it / PER_L; int r = it % PER_L;
            if (r < I_IN) { p0_transpose_item(a.in[I_WIN] + (size_t)l * 1024 * PW, PW, (bf16*)(ws + WS_WIN) + (size_t)l * PW * 1024, 1024, 0, 0, scr, r, F.lane); continue; } r -= I_IN;
            if (r < I_M) { p0_transpose_item(a.in[I_WMERGE] + (size_t)l * 1024 * 4096, 4096, (bf16*)(ws + WS_WM) + (size_t)l * 4096 * 1024, 1024, 0, 0, scr, r, F.lane); continue; } r -= I_M;
            if (r < I_O) { p0_transpose_item(a.in[I_WOUT] + (size_t)l * 1024 * 1024, 1024, (bf16*)(ws + WS_WOUT) + (size_t)l * 1024 * 1024, 1024, 0, 0, scr, r, F.lane); continue; } r -= I_O;
            { const int br = r / I_B; r -= br * I_B;
              p0_transpose_item(a.in[I_WBR] + ((size_t)l * 4 + br) * 256 * 1024, 1024, (bf16*)(ws + WS_WBR) + (size_t)l * 1024 * 1024, 1024, 0, 256 * br, scr, r, F.lane); }
        }
    }
    {
        const int gt = F.vcu * 512 + F.tid, NGT = F.G * 512;
        bf16* tab = (bf16*)(ws + WS_TAB);
        for (int e = gt; e < 65536; e += NGT) {
            const int l = e >> 15, g = (e >> 13) & 3, col = (e >> 6) & 127, c = e & 63, d = col & 63;
            const float* wf = a.in[I_WFNET] + ((size_t)(l * 4 + g) * 64) * 64 + d; float s = 0.f;
            for (int j = 0; j < 64; ++j) { const float rev = (float)((c * j) & 63) * (1.0f / 64.0f); const float tw = (col < 64) ? __builtin_amdgcn_cosf(rev) : -__builtin_amdgcn_sinf(rev); s += tw * wf[j * 64]; }
            tab[TAB_MA / 2 + e] = (bf16)f2bf(s);
        }
        for (int e = gt; e < 49152; e += NGT) {
            const int mat = e / 16384, rem = e % 16384, k1b = rem >> 12, nb = (rem >> 10) & 3, s = (rem >> 9) & 1, ln = (rem >> 3) & 63, j = rem & 7;
            const int n1 = 32 * nb + krow(s, ln >> 5, j), k1 = 32 * k1b + (ln & 31); const float rev = (float)((n1 * k1) & 127) * (1.0f / 128.0f);
            const float v = (mat == 0) ? __builtin_amdgcn_cosf(rev) : (mat == 1) ? __builtin_amdgcn_sinf(rev) : -__builtin_amdgcn_sinf(rev);
            tab[TAB_128 / 2 + e] = (bf16)f2bf(v);
        }
        for (int e = gt; e < 8192; e += NGT) {
            const int mat = e >> 12, k2 = (e >> 6) & 63, n2 = e & 63; const float rev = (float)((k2 * n2) & 63) * (1.0f / 64.0f);
            tab[TAB_64 / 2 + e] = (bf16)f2bf(mat == 0 ? __builtin_amdgcn_cosf(rev) : __builtin_amdgcn_sinf(rev));
        }
        for (int e = gt; e < 131072; e += NGT) {
            const int mat = e >> 16, rem = e & 65535, kb = rem >> 13, nb = (rem >> 10) & 7, s = (rem >> 9) & 1, ln = (rem >> 3) & 63, j = rem & 7;
            const int n = 32 * nb + krow(s, ln >> 5, j), k = 32 * kb + (ln & 31); const float rev = (float)((n * k) & 255) * (1.0f / 256.0f);
            tab[TAB_256 / 2 + e] = (bf16)f2bf(mat == 0 ? __builtin_amdgcn_cosf(rev) : __builtin_amdgcn_sinf(rev));
        }
        for (int e = gt; e < 131072; e += NGT) tab[TAB_WSP / 2 + e] = (bf16)f2bf(a.in[I_WSP][e]);
        for (int e = gt; e < M_CTX * 1024 / 4; e += NGT) { ((f32x4*)(ws + WS_XC1))[e] = ((const f32x4*)a.in[I_CTX])[e]; ((f32x4*)(ws + WS_MGC))[e] = (f32x4){0.f, 0.f, 0.f, 0.f}; }
        for (int e = gt; e < 4096; e += NGT) tab[TAB_ONES / 2 + e] = (bf16)(((e & 31) == 0) ? 0x3f80 : 0);
        for (int e = gt; e < 262144; e += NGT) tab[TAB_BIASB / 2 + e] = (bf16)(((e & 31) == 0) ? f2bf(a.in[I_BMERGE][e >> 5]) : 0u);
    }
}

DI void p1_modrms(const Frame& F, const Args& a, int l, const float* xlat, const float* xctx, int with_ctx) {
    const float* mod = (const float*)(a.ws + WS_MOD) + (size_t)l * 3 * 3072;
    const float* nw = a.in[I_NORMW] + l * 1024;
    bf16* H = (bf16*)(a.ws + WS_H);
    const int gw = F.vcu * NWAVES + F.wave, NGW = F.G * NWAVES;
    const int nrows = with_ctx ? M_ALL : M_LAT;
    int vcur = -1; f32x4 av[4], bv[4];
    for (int row = gw; row < nrows; row += NGW) {
        const int v = row < SEQ ? 0 : (row < M_LAT ? 1 : 2);
        if (v != vcur) { vcur = v;
#pragma unroll
            for (int j = 0; j < 4; ++j) { const int c = 4 * (F.lane + 64 * j); const f32x4 w = *(const f32x4*)(nw + c), sc = *(const f32x4*)(mod + v * 3072 + 1024 + c);
                av[j] = w * (sc + 1.0f); bv[j] = *(const f32x4*)(mod + v * 3072 + c); } }
        const float* xr = (row < M_LAT) ? xlat + (size_t)row * 1024 : xctx + (size_t)(row - M_LAT) * 1024;
        f32x4 x[4]; float ss = 0.f;
#pragma unroll
        for (int j = 0; j < 4; ++j) { x[j] = *(const f32x4*)(xr + 4 * (F.lane + 64 * j)); ss += (x[j].x * x[j].x + x[j].y * x[j].y) + (x[j].z * x[j].z + x[j].w * x[j].w); }
        const float rstd = __builtin_amdgcn_rsqf(wave_sum(ss, F.lane) * (1.0f / 1024.0f) + RMS_EPS);
#pragma unroll
        for (int j = 0; j < 4; ++j) { const f32x4 h = x[j] * rstd * av[j] + bv[j]; v2u o; o.x = pk2(h.x, h.y); o.y = pk2(h.z, h.w);
            *(v2u*)(H + (size_t)row * 1024 + 4 * (F.lane + 64 * j)) = o; }
    }
}

DI void p3_prep(const Frame& F, const Args& a, int l, bf16* P) {
    const int gw = F.vcu * NWAVES + F.wave, NGW = F.G * NWAVES;
    const int d = F.lane;
    const float wqa = a.in[I_QNA][l * 64 + d], wka = a.in[I_KNA][l * 64 + d], wqd = a.in[I_QND][l * 64 + d], wkd = a.in[I_KND][l * 64 + d];
    const float inv = __builtin_amdgcn_exp2f(-(float)(d & 15) * (13.287712379549449f / 16.0f));
    const float sgn = (d & 16) ? 1.0f : -1.0f;
    const int nrows = M_ALL;
    for (int row = gw; row < nrows; row += NGW) {
        const bool isctx = row >= M_LAT;
        const int n = row & (SEQ - 1);
        float cs = 1.0f, sn = 0.0f;
        if (!isctx) { const float pos = (float)((d < 32) ? (n >> 6) : (n & 63)); const float rev = pos * inv * 0.15915494309189535f; cs = __builtin_amdgcn_cosf(rev); sn = __builtin_amdgcn_sinf(rev); }
        bf16* pr = P + (size_t)row * PW;
        const bool qok = !(isctx && l == 1);
        float v[12];
#pragma unroll
        for (int s = 0; s < 12; ++s) { const int col = (s < 4) ? C_AQ + 64 * s : (s < 6) ? C_AK + 64 * (s - 4) : (s < 10) ? C_DQ + 64 * (s - 6) : C_DK + 64 * (s - 10);
            const bool isq = (s < 4) || (s >= 6 && s < 10);
            v[s] = (isq && !qok) ? 0.f : bf2f(pr[col + d]); }
#pragma unroll
        for (int s = 0; s < 12; ++s) { const int col = (s < 4) ? C_AQ + 64 * s : (s < 6) ? C_AK + 64 * (s - 4) : (s < 10) ? C_DQ + 64 * (s - 6) : C_DK + 64 * (s - 10);
            const bool isq = (s < 4) || (s >= 6 && s < 10);
            const float w = (s < 4) ? wqa : (s < 6) ? wka : (s < 10) ? wqd : wkd;
            const float ss = wave_sum(v[s] * v[s], d);
            float y = v[s] * __builtin_amdgcn_rsqf(ss * (1.0f / 64.0f) + RMS_EPS) * w;
            const float p = shx(y, 16, d);
            y = y * cs + sgn * p * sn;
            if (isq) y *= QSCALE;
            if (!isq || qok) pr[col + d] = (bf16)f2bf(y); }
    }
}

DI void fnet_stepA(const bf16* xrow, const bf16* MAt, int r32, int hi, bf16x8 (&gs)[4][2]) {
    bf16x8 xa[4];
#pragma unroll
    for (int s4 = 0; s4 < 4; ++s4) xa[s4] = *(const bf16x8*)(xrow + 16 * s4 + 8 * hi);
#pragma unroll
    for (int cb = 0; cb < 4; ++cb) { f32x16 acc = f32x16{};
#pragma unroll
        for (int s4 = 0; s4 < 4; ++s4) { const bf16x8 bfr = *(const bf16x8*)(MAt + (32 * cb + r32) * 64 + 16 * s4 + 8 * hi); acc = MFMA32(xa[s4], bfr, acc); }
        gs[cb][0] = pack_step(acc, 0); gs[cb][1] = pack_step(acc, 1); }
}

DI void fnet_s1_unit(const Frame& F, const Args& a, int l, int u, const bf16* P) {
    const int b = u >> 7, n2grp = (u >> 4) & 7, g = (u >> 2) & 3, k1b = u & 3;
    const int lane = F.lane, r32 = lane & 31, hi = lane >> 5, w = F.wave, n2 = 8 * n2grp + w;
    const bf16* tab = (const bf16*)(a.ws + WS_TAB);
    const bf16* MAt = tab + TAB_MA / 2 + (size_t)(l * 4 + g) * 128 * 64;
    const bf16* T128 = tab + TAB_128 / 2;
    f32x16 Tr[2], Ti[2];
#pragma unroll
    for (int j = 0; j < 2; ++j) { Tr[j] = f32x16{}; Ti[j] = f32x16{}; }
#pragma unroll 1
    for (int nb = 0; nb < 4; ++nb) {
        const bf16* xrow = P + (size_t)(SEQ * b + 64 * (32 * nb + r32) + n2) * PW + C_BF + 64 * g;
        bf16x8 gs[4][2]; fnet_stepA(xrow, MAt, r32, hi, gs);
#pragma unroll
        for (int s = 0; s < 2; ++s) {
            const size_t fo = ((size_t)((k1b * 4 + nb) * 2 + s) * 64 + lane) * 8;
            const bf16x8 ca = *(const bf16x8*)(T128 + fo), sa = *(const bf16x8*)(T128 + 16384 + fo), na = *(const bf16x8*)(T128 + 32768 + fo);
            Tr[0] = MFMA32(ca, gs[0][s], Tr[0]); Tr[0] = MFMA32(sa, gs[2][s], Tr[0]);
            Tr[1] = MFMA32(ca, gs[1][s], Tr[1]); Tr[1] = MFMA32(sa, gs[3][s], Tr[1]);
            Ti[0] = MFMA32(ca, gs[2][s], Ti[0]); Ti[0] = MFMA32(na, gs[0][s], Ti[0]);
            Ti[1] = MFMA32(ca, gs[3][s], Ti[1]); Ti[1] = MFMA32(na, gs[1][s], Ti[1]); }
    }
    LAS bf16* tl = (LAS bf16*)F.lds;
#pragma unroll
    for (int i = 0; i < 16; ++i) { const int k1l = crow(i, hi), k1 = 32 * k1b + k1l;
        const float rev = (float)((n2 * k1) & 8191) * (1.0f / 8192.0f); const float c = __builtin_amdgcn_cosf(rev), s = __builtin_amdgcn_sinf(rev);
#pragma unroll
        for (int jb = 0; jb < 2; ++jb) { const float tr = Tr[jb][i], ti = Ti[jb][i];
            tl[(k1l * 128 + 32 * jb + r32) * 8 + w] = (bf16)f2bf(tr * c + ti * s);
            tl[(k1l * 128 + 64 + 32 * jb + r32) * 8 + w] = (bf16)f2bf(ti * c - tr * s); } }
    __syncthreads();
    bf16* T1 = (bf16*)(a.ws + WS_T1);
#pragma unroll 4
    for (int pass = 0; pass < 8; ++pass) { const int q = F.tid + 512 * pass, k1l = q >> 7, colL = q & 127;
        const v4u v = *(const LAS v4u*)(F.lds + (size_t)q * 16);
        *(v4u*)(T1 + ((((size_t)(b * 128 + 32 * k1b + k1l) * 8 + n2grp) * 512) + g * 128 + colL) * 8) = v; }
    __syncthreads();
}

DI void fnet_ctx_unit(const Frame& F, const Args& a, int l, int u, const bf16* P, bf16* YB) {
    const int b = u >> 2, g = u & 3;
    const int lane = F.lane, r32 = lane & 31, hi = lane >> 5, w = F.wave;
    const bf16* tab = (const bf16*)(a.ws + WS_TAB);
    const bf16* MAt = tab + TAB_MA / 2 + (size_t)(l * 4 + g) * 128 * 64;
    const bf16* T256 = tab + TAB_256 / 2;
    f32x16 Y[2]; Y[0] = f32x16{}; Y[1] = f32x16{};
#pragma unroll 1
    for (int nb = 0; nb < 8; ++nb) {
        const bf16* xrow = P + (size_t)(M_LAT + NCTX * b + 32 * nb + r32) * PW + C_BF + 64 * g;
        bf16x8 gs[4][2]; fnet_stepA(xrow, MAt, r32, hi, gs);
#pragma unroll
        for (int s = 0; s < 2; ++s) {
            const size_t fo = ((size_t)((w * 8 + nb) * 2 + s) * 64 + lane) * 8;
            const bf16x8 ca = *(const bf16x8*)(T256 + fo), sa = *(const bf16x8*)(T256 + 65536 + fo);
            Y[0] = MFMA32(ca, gs[0][s], Y[0]); Y[0] = MFMA32(sa, gs[2][s], Y[0]);
            Y[1] = MFMA32(ca, gs[1][s], Y[1]); Y[1] = MFMA32(sa, gs[3][s], Y[1]); }
    }
#pragma unroll
    for (int jb = 0; jb < 2; ++jb)
#pragma unroll
        for (int i = 0; i < 16; ++i) { const int k = 32 * w + crow(i, hi), d = 32 * jb + r32; const size_t row = (size_t)(M_LAT + NCTX * b + k);
            const float z = bf2f(P[row * PW + C_BZ + 64 * g + d]);
            YB[row * 1024 + 512 + 64 * g + d] = (bf16)f2bf(Y[jb][i] * (1.0f / 128.0f) * siluf(z)); }
}

#ifndef B_SCALE
#define B_SCALE 1.0f
#endif
#ifndef C_SCALE
#define C_SCALE 1.0f
#endif
DI void fnet_s3_unit(const Frame& F, const Args& a, int u, const bf16* P, bf16* YB) {
    const int b = u >> 7, k1 = u & 127;
    const int lane = F.lane, r32 = lane & 31, hi = lane >> 5, g = F.wave >> 1, jb = F.wave & 1;
    const bf16* T64 = (const bf16*)(a.ws + WS_TAB) + TAB_64 / 2;
    const bf16* T1 = (const bf16*)(a.ws + WS_T1);
    f32x16 Y[2]; Y[0] = f32x16{}; Y[1] = f32x16{};
#pragma unroll
    for (int sc = 0; sc < 4; ++sc)
#pragma unroll
        for (int ri = 0; ri < 2; ++ri) {
            const bf16x8 bfr = *(const bf16x8*)(T1 + ((((size_t)(b * 128 + k1) * 8 + 2 * sc + hi) * 512) + g * 128 + ri * 64 + 32 * jb + r32) * 8);
#pragma unroll
            for (int k2b = 0; k2b < 2; ++k2b) { const bf16x8 afr = *(const bf16x8*)(T64 + ri * 4096 + (32 * k2b + r32) * 64 + 16 * sc + 8 * hi); Y[k2b] = MFMA32(afr, bfr, Y[k2b]); } }
#pragma unroll
    for (int k2b = 0; k2b < 2; ++k2b)
#pragma unroll
        for (int i = 0; i < 16; ++i) { const int k2 = 32 * k2b + crow(i, hi), d = 32 * jb + r32; const size_t row = (size_t)(SEQ * b + k1 + 128 * k2);
            const float z = bf2f(P[row * PW + C_BZ + 64 * g + d]);
            YB[row * 1024 + 512 + 64 * g + d] = (bf16)f2bf(Y[k2b][i] * (B_SCALE * 0.0013810679320049757f) * siluf(z)); }
}

DI void sgu_unit(const Frame& F, const Args& a, int l, int ci, const bf16* P, bf16* YB) {
    constexpr int VP = 136;
    LAS bf16* vt = (LAS bf16*)F.lds;
    const size_t row0 = (size_t)ci * 128;
    { const int q = F.tid & 127, g = F.tid >> 7; const bf16* src = P + (row0 + q) * PW + C_CV + 64 * g;
#pragma unroll
      for (int i = 0; i < 8; ++i) { const v4u v = *(const v4u*)(src + 8 * i); const unsigned wv[4] = {v.x, v.y, v.z, v.w};
#pragma unroll
          for (int e = 0; e < 4; ++e) { vt[(g * 64 + 8 * i + 2 * e) * VP + q] = (bf16)f2bf(geluf(wlo(wv[e]))); vt[(g * 64 + 8 * i + 2 * e + 1) * VP + q] = (bf16)f2bf(geluf(whi(wv[e]))); } } }
    __syncthreads();
    const int lane = F.lane, r32 = lane & 31, hi = lane >> 5, g = F.wave >> 1, ph = F.wave & 1;
    const bf16* Wsp = (const bf16*)(a.ws + WS_TAB) + TAB_WSP / 2 + (size_t)(l * 4 + g) * 128 * 128;
    f32x16 acc[2][2];
#pragma unroll
    for (int i = 0; i < 2; ++i)
#pragma unroll
        for (int j = 0; j < 2; ++j) acc[i][j] = f32x16{};
#pragma unroll
    for (int s = 0; s < 8; ++s) {
        bf16x8 af[2], bfr[2];
#pragma unroll
        for (int pb = 0; pb < 2; ++pb) af[pb] = *(const bf16x8*)(Wsp + (64 * ph + 32 * pb + r32) * 128 + 16 * s + 8 * hi);
#pragma unroll
        for (int cb = 0; cb < 2; ++cb) bfr[cb] = *(const LAS bf16x8*)(vt + (g * 64 + 32 * cb + r32) * VP + 16 * s + 8 * hi);
#pragma unroll
        for (int pb = 0; pb < 2; ++pb)
#pragma unroll
            for (int cb = 0; cb < 2; ++cb) acc[pb][cb] = MFMA32(af[pb], bfr[cb], acc[pb][cb]);
    }
    const float* bsp = a.in[I_BSP] + (l * 4 + g) * 128;
#pragma unroll
    for (int pb = 0; pb < 2; ++pb)
#pragma unroll
        for (int i = 0; i < 16; ++i) { const int p = 64 * ph + 32 * pb + crow(i, hi); const float bb = bsp[p]; const bf16* pr = P + (row0 + p) * PW;
#pragma unroll
            for (int cb = 0; cb < 2; ++cb) { const int c = 64 * g + 32 * cb + r32;
                const float uu = geluf(bf2f(pr[C_CU + c])), zz = siluf(bf2f(pr[C_CZ + c]));
                YB[(row0 + p) * 1024 + 768 + c] = (bf16)f2bf(C_SCALE * uu * (acc[pb][cb][i] + bb) * zz); } }
    __syncthreads();
}

DI void p5_ctx_convert(const Frame& F, const Args& a) {
    const int gt = F.vcu * 512 + F.tid, NGT = F.G * 512;
    const f32x4* src = (const f32x4*)(a.ws + WS_MGC); v2u* dst = (v2u*)((bf16*)(a.ws + WS_MG) + (size_t)M_LAT * 1024);
    for (int e = gt; e < M_CTX * 1024 / 4; e += NGT) { const f32x4 v = src[e]; v2u o; o.x = pk2(v.x, v.y); o.y = pk2(v.z, v.w); dst[e] = o; }
}

#ifdef SELFCHECK
constexpr int CW_CHK = 8192;
DI unsigned hsh(unsigned x) { x *= 2654435761u; x ^= x >> 15; x *= 2246822519u; x ^= x >> 13; x *= 3266489917u; x ^= x >> 16; return x; }
DI void chk_acc(const Args& a, int id, float got, float want) {
    unsigned* w = (unsigned*)(a.ws + WS_CTL) + CW_CHK + 4 * id;
    float d = __builtin_fabsf(got - want); if (!(d == d) || d > 1e15f) d = 1e15f;
    atomicAdd((float*)w, d * d); atomicAdd((float*)(w + 1), want * want); atomicAdd(w + 2, 1u); atomicMax(w + 3, __float_as_uint(d));
}
DI float bfr(float x) { return __uint_as_float(f2bf(x) << 16); }
DI void chk_p0(const Frame& F, const Args& a) {
    const int gt = F.vcu * 512 + F.tid, NGT = F.G * 512;
    for (int s = gt; s < 18432; s += NGT) { const int l = s / 9216, v = (s / 3072) % 3, j = s % 3072; float acc = a.in[I_BADA][l * 3072 + j];
        for (int k = 0; k < 1024; ++k) { const float cv = (v < 2) ? a.in[I_C][v * 1024 + k] : a.in[I_CCTX][k]; acc += siluf(cv) * a.in[I_WADA][((size_t)l * 1024 + k) * 3072 + j]; }
        chk_acc(a, 0, ((const float*)(a.ws + WS_MOD))[(l * 3 + v) * 3072 + j], acc); }
    for (int s = gt; s < 65536; s += NGT) { const unsigned h = hsh(s); const int l = (s >> 2) & 1, m = s & 3, k = h & 1023; const unsigned h2 = hsh(h + 77u);
        float got, want;
        if (m == 0) { const int n = h2 % PW; want = bfr(a.in[I_WIN][((size_t)l * 1024 + k) * PW + n]); got = bf2f(((const bf16*)(a.ws + WS_WIN))[((size_t)l * PW + n) * 1024 + k]); }
        else if (m == 1) { const int n = h2 & 4095; want = bfr(a.in[I_WMERGE][((size_t)l * 1024 + k) * 4096 + n]); got = bf2f(((const bf16*)(a.ws + WS_WM))[((size_t)l * 4096 + n) * 1024 + k]); }
        else if (m == 2) { const int n = h2 & 1023; want = bfr(a.in[I_WOUT][((size_t)l * 1024 + k) * 1024 + n]); got = bf2f(((const bf16*)(a.ws + WS_WOUT))[((size_t)l * 1024 + n) * 1024 + k]); }
        else { const int n = h2 & 1023, br = k >> 8, kk = k & 255; want = bfr(a.in[I_WBR][(((size_t)l * 4 + br) * 256 + kk) * 1024 + n]); got = bf2f(((const bf16*)(a.ws + WS_WBR))[((size_t)l * 1024 + n) * 1024 + 256 * br + kk]); }
        chk_acc(a, 1, got, want); }
}
DI int sample_row(unsigned h, int l) { const int r = h % M_ALL; (void)l; return ((h >> 20) & 7) == 0 ? M_LAT + (h % M_CTX) : r; }
DI void chk_h(const Frame& F, const Args& a, int l, int id) {
    const float* mod = (const float*)(a.ws + WS_MOD) + (size_t)l * 3 * 3072; const bf16* H = (const bf16*)(a.ws + WS_H);
    const int gw = F.vcu * NWAVES + F.wave, NGW = F.G * NWAVES;
    for (int s = gw; s < M_ALL; s += NGW) { const int row = s; const int v = row < SEQ ? 0 : (row < M_LAT ? 1 : 2);
        const float* xr = (row < M_LAT) ? ((l == 0) ? a.in[I_X] : a.out) + (size_t)row * 1024 : ((l == 0) ? a.in[I_CTX] : (const float*)(a.ws + WS_XC1)) + (size_t)(row - M_LAT) * 1024;
        float ss = 0.f; for (int j = 0; j < 16; ++j) { const float x = xr[F.lane + 64 * j]; ss += x * x; }
        const float rstd = 1.0f / sqrtf(wave_sum(ss, F.lane) * (1.0f / 1024.0f) + RMS_EPS);
        for (int j = 0; j < 16; ++j) { const int c = F.lane + 64 * j; const float want = xr[c] * rstd * a.in[I_NORMW][l * 1024 + c] * (1.0f + mod[v * 3072 + 1024 + c]) + mod[v * 3072 + c];
            chk_acc(a, id, bf2f(H[(size_t)row * 1024 + c]), want); } }
}
DI float dot_h_w(const bf16* hrow, const bf16* wrow, int K) { float acc = 0.f; for (int k = 0; k < K; ++k) acc += bf2f(hrow[k]) * bf2f(wrow[k]); return acc; }
DI void chk_p(const Frame& F, const Args& a, int l, int id) {
    const bf16* H = (const bf16*)(a.ws + WS_H); const bf16* W = (const bf16*)(a.ws + WS_WIN) + (size_t)l * PW * 1024; const bf16* P = (const bf16*)(a.ws + WS_P);
    const int gt = F.vcu * 512 + F.tid, NGT = F.G * 512;
    for (int s = gt; s < (1 << 20); s += NGT) { const unsigned h = hsh(s * 5 + 2); const int row = sample_row(h, l); int col = hsh(h + 9u) % PW;
        if (l == 1 && row >= M_LAT) col = ((col & 1) ? 1024 : 256) + (col & 255);
        chk_acc(a, id, bf2f(P[(size_t)row * PW + col]), dot_h_w(H + (size_t)row * 1024, W + (size_t)col * 1024, 1024)); }
}
DI void chk_prep(const Frame& F, const Args& a, int l, int id) {
    const bf16* H = (const bf16*)(a.ws + WS_H); const bf16* W = (const bf16*)(a.ws + WS_WIN) + (size_t)l * PW * 1024; const bf16* P = (const bf16*)(a.ws + WS_P);
    const int gw = F.vcu * NWAVES + F.wave, NGW = F.G * NWAVES, d = F.lane;
    for (int s = gw; s < 16384; s += NGW) { const unsigned h = hsh(s * 7 + 3); const int row = sample_row(h, l); int sl = (h >> 8) % 12; const bool isctx = row >= M_LAT;
        if (isctx && l == 1) sl = (sl & 1) ? 4 + (sl & 1) : 10 + ((sl >> 1) & 1);
        const int col = (sl < 4) ? C_AQ + 64 * sl : (sl < 6) ? C_AK + 64 * (sl - 4) : (sl < 10) ? C_DQ + 64 * (sl - 6) : C_DK + 64 * (sl - 10);
        const bool isq = (sl < 4) || (sl >= 6 && sl < 10);
        const float raw = bfr(dot_h_w(H + (size_t)row * 1024, W + (size_t)(col + d) * 1024, 1024));
        const float wv = ((sl < 4) ? a.in[I_QNA] : (sl < 6) ? a.in[I_KNA] : (sl < 10) ? a.in[I_QND] : a.in[I_KND])[l * 64 + d];
        const float ms = wave_sum(raw * raw, d) * (1.0f / 64.0f);
        float y = raw / sqrtf(ms + RMS_EPS) * wv;
        if (!isctx) { const int n = row & (SEQ - 1); const float pos = (float)((d < 32) ? (n >> 6) : (n & 63)); const float inv = __builtin_amdgcn_exp2f(-(float)(d & 15) * (13.287712379549449f / 16.0f)); const float rev = pos * inv * 0.15915494309189535f; const float cs = __builtin_amdgcn_cosf(rev), sn = __builtin_amdgcn_sinf(rev);
            const float p = shx(y, 16, d); y = (d & 16) ? (p * sn + y * cs) : (y * cs - p * sn); }
        if (isq) y *= QSCALE;
        chk_acc(a, id, bf2f(P[(size_t)row * PW + col + d]), y); }
}
DI void chk_attn(const Frame& F, const Args& a, int l, int id, int mode) {
    const bf16* P = (const bf16*)(a.ws + WS_P); const bf16* YB = (const bf16*)(a.ws + WS_YB);
    LAS float* qs = (LAS float*)F.lds + F.wave * 192; LAS float* os = qs + 64; LAS float* red = qs + 128;
    const int gw = F.vcu * NWAVES + F.wave, NGW = F.G * NWAVES, lane = F.lane;
    const int qc0 = mode ? C_DQ : C_AQ, kc0 = mode ? C_DK : C_AK, vc0 = mode ? C_DV : C_AV, zc0 = mode ? C_DZ : C_AZ, oc0 = mode ? 256 : 0;
    for (int s = gw; s < 8192; s += NGW) { const unsigned hh = hsh(s * 11 + 5 + mode); int row = sample_row(hh, l); if ((s & 7) == 1) row = (hh & 8192) + (hh & 255) + ((hh & 256) ? 7936 : 0); if (l == 1 && row >= M_LAT) row = hh % M_LAT; const int h = (hh >> 9) & 3, kvh = h >> 1; const bool isctx = row >= M_LAT;
        const int b = isctx ? (row - M_LAT) / NCTX : row / SEQ, pos = row & (SEQ - 1);
        qs[lane] = bf2f(P[(size_t)row * PW + qc0 + 64 * h + lane]); LDS_WAIT();
        int klo = 0, khi = -1; if (!isctx) { if (mode == 0) { klo = 0; khi = SEQ - 1; } else { klo = pos - 128 < 0 ? 0 : pos - 128; khi = pos + 128 > SEQ - 1 ? SEQ - 1 : pos + 128; } }
        const int nlat = khi - klo + 1 > 0 ? khi - klo + 1 : 0, nk = NCTX + nlat;
        float m = -1e30f, lsum = 0.f; float acc[64];
#pragma unroll
        for (int dd = 0; dd < 64; ++dd) acc[dd] = 0.f;
        for (int kk = lane; kk < nk; kk += 64) { const size_t kr = (kk < NCTX) ? (size_t)(M_LAT + NCTX * b + kk) : (size_t)(SEQ * b + klo + kk - NCTX);
            const bf16* kp = P + kr * PW + kc0 + 64 * kvh; const bf16* vp = P + kr * PW + vc0 + 64 * kvh; float sc = 0.f;
#pragma unroll
            for (int dd = 0; dd < 64; ++dd) sc += qs[dd] * bf2f(kp[dd]);
            const float mn = fmaxf(m, sc), f = __builtin_amdgcn_exp2f(m - mn), p = __builtin_amdgcn_exp2f(sc - mn); lsum = lsum * f + p; m = mn;
#pragma unroll
            for (int dd = 0; dd < 64; ++dd) acc[dd] = acc[dd] * f + p * bf2f(vp[dd]); }
        float mall = m;
#pragma unroll
        for (int o = 1; o < 64; o <<= 1) mall = fmaxf(mall, shx(mall, o, lane));
        const float f = __builtin_amdgcn_exp2f(m - mall); lsum = wave_sum(lsum * f, lane);
        if (mode == 1) lsum += __builtin_amdgcn_exp2f(a.in[I_SINK][l * 4 + h] * 1.4426950408889634f - mall);
#pragma unroll
        for (int dd = 0; dd < 64; ++dd) { const float t = wave_sum(acc[dd] * f, lane); if (lane == dd) os[dd] = t; }
        LDS_WAIT();
        const float z = bf2f(P[(size_t)row * PW + zc0 + 64 * h + lane]);
        chk_acc(a, id, bf2f(YB[(size_t)row * 1024 + oc0 + 64 * h + lane]), os[lane] / lsum * siluf(z));
        (void)red; }
}
DI void chk_fnet(const Frame& F, const Args& a, int l, int id, int ctxmode) {
    const bf16* P = (const bf16*)(a.ws + WS_P); const bf16* YB = (const bf16*)(a.ws + WS_YB);
    LAS float* ys = (LAS float*)F.lds + F.wave * 64;
    const int gw = F.vcu * NWAVES + F.wave, NGW = F.G * NWAVES, j = F.lane;
    const int N = ctxmode ? NCTX : SEQ;
    for (int s = gw; s < (ctxmode ? 256 : 1024); s += NGW) { const unsigned hh = hsh(s * 13 + 7 + ctxmode); const int b = hh & 1, g = (hh >> 1) & 3; int k = (hh >> 3) % N;
#ifdef FNET_K0
        k = (s & 7) == 0 ? 0 : (s & 7) == 1 ? N / 2 : (s & 7) == 2 ? 64 : (s & 7) == 3 ? 128 : (s & 7) == 4 ? 1 : k;
#endif
        const size_t rbase = ctxmode ? (size_t)(M_LAT + NCTX * b) : (size_t)(SEQ * b);
        float y = 0.f;
        for (int n = 0; n < N; ++n) { const bf16* fr = P + (rbase + n) * PW + C_BF + 64 * g; float A = 0.f, B = 0.f;
            for (int c = 0; c < 64; ++c) { const float fv = bf2f(fr[c]); const float ph = (float)((j * c) & 63) * (1.0f / 64.0f); A += fv * __builtin_amdgcn_cosf(ph); B += fv * __builtin_amdgcn_sinf(ph); }
            const float th = (float)((k * n) & (N - 1)) / (float)N; y += __builtin_amdgcn_cosf(th) * A - __builtin_amdgcn_sinf(th) * B; }
        ys[j] = y / sqrtf((float)N * 64.0f); LDS_WAIT();
        float o = 0.f; for (int jj = 0; jj < 64; ++jj) o += ys[jj] * a.in[I_WFNET][((size_t)(l * 4 + g) * 64 + jj) * 64 + j];
        const size_t row = rbase + k; const float z = bf2f(P[row * PW + C_BZ + 64 * g + j]);
        chk_acc(a, id, bf2f(YB[row * 1024 + 512 + 64 * g + j]), o * siluf(z)); LDS_WAIT(); }
}
DI void chk_sgu(const Frame& F, const Args& a, int l, int id) {
    const bf16* P = (const bf16*)(a.ws + WS_P); const bf16* YB = (const bf16*)(a.ws + WS_YB);
    const int gt = F.vcu * 512 + F.tid, NGT = F.G * 512;
    for (int s = gt; s < (1 << 18); s += NGT) { const unsigned hh = hsh(s * 17 + 11); int row = sample_row(hh, l); if (l == 1 && row >= M_LAT) row = hh % M_LAT; const int cc = hsh(hh + 101u) & 255, g = cc >> 6, p = row & 127; const size_t r0 = (size_t)(row - p);
        float sp = a.in[I_BSP][(l * 4 + g) * 128 + p];
        for (int q = 0; q < 128; ++q) { const float v = bf2f(P[(r0 + q) * PW + C_CV + cc]); sp += a.in[I_WSP][((size_t)(l * 4 + g) * 128 + p) * 128 + q] * (0.5f * v * (1.0f + erff(v * 0.7071067811865476f))); }
        const float u = bf2f(P[(size_t)row * PW + C_CU + cc]), z = bf2f(P[(size_t)row * PW + C_CZ + cc]);
        chk_acc(a, id, bf2f(YB[(size_t)row * 1024 + 768 + cc]), (0.5f * u * (1.0f + erff(u * 0.7071067811865476f))) * sp * siluf(z)); }
}
DI void chk_merge(const Frame& F, const Args& a, int l, int id) {
    const bf16* H = (const bf16*)(a.ws + WS_H); const bf16* YB = (const bf16*)(a.ws + WS_YB); const bf16* MG = (const bf16*)(a.ws + WS_MG);
    const bf16* WM = (const bf16*)(a.ws + WS_WM) + (size_t)l * 4096 * 1024; const bf16* WB = (const bf16*)(a.ws + WS_WBR) + (size_t)l * 1024 * 1024;
    const int gt = F.vcu * 512 + F.tid, NGT = F.G * 512;
    for (int s = gt; s < (1 << 18); s += NGT) { const unsigned hh = hsh(s * 19 + 13); int row = sample_row(hh, l); if (l == 1 && row >= M_LAT) row = hh % M_LAT; const int d = hsh(hh + 202u) & 1023; float acc = 0.f;
        for (int r = 0; r < 4; ++r) { const float G = dot_h_w(H + (size_t)row * 1024, WM + ((size_t)r * 1024 + d) * 1024, 1024) + a.in[I_BMERGE][l * 4096 + r * 1024 + d];
            const float Y = dot_h_w(YB + (size_t)row * 1024 + 256 * r, WB + (size_t)d * 1024 + 256 * r, 256); acc += Y * __builtin_amdgcn_rcpf(1.0f + __builtin_amdgcn_exp2f(-1.4426950408889634f * G)); }
        chk_acc(a, id, bf2f(MG[(size_t)row * 1024 + d]), acc); }
}
DI void chk_gt(const Frame& F, const Args& a, int l, int r, int id) {
    const bf16* H = (const bf16*)(a.ws + WS_H); const bf16* GT = (const bf16*)(a.ws + WS_GT); const bf16* WM = (const bf16*)(a.ws + WS_WM) + (size_t)l * 4096 * 1024;
    const int gt = F.vcu * 512 + F.tid, NGT = F.G * 512;
    for (int s = gt; s < (1 << 18); s += NGT) { const unsigned hh = hsh(s * 29 + 19); int row = sample_row(hh, l); if (l == 1 && row >= M_LAT) row = hh % M_LAT; const int d = hsh(hh + 404u) & 1023;
        const float G = dot_h_w(H + (size_t)row * 1024, WM + ((size_t)r * 1024 + d) * 1024, 1024) + a.in[I_BMERGE][l * 4096 + r * 1024 + d];
        chk_acc(a, id, bf2f(GT[(size_t)row * 1024 + d]), __builtin_amdgcn_rcpf(1.0f + __builtin_amdgcn_exp2f(-1.4426950408889634f * G))); }
}
DI void chk_final(const Frame& F, const Args& a, int l, int id) {
    const bf16* MG = (const bf16*)(a.ws + WS_MG); const bf16* WO = (const bf16*)(a.ws + WS_WOUT) + (size_t)l * 1024 * 1024; const float* mod = (const float*)(a.ws + WS_MOD) + (size_t)l * 3 * 3072;
    const int gt = F.vcu * 512 + F.tid, NGT = F.G * 512;
    for (int s = gt; s < (1 << 18); s += NGT) { const unsigned hh = hsh(s * 23 + 17); const int row = sample_row(hh, l), c = hsh(hh + 303u) & 1023; const int v = row < SEQ ? 0 : (row < M_LAT ? 1 : 2);
        if (l == 1 && row >= M_LAT) continue;
        const float xi = (l == 1) ? ((const float*)(a.ws + WS_H))[(size_t)row * 1024 + c] : (row < M_LAT) ? a.in[I_X][(size_t)row * 1024 + c] : a.in[I_CTX][(size_t)(row - M_LAT) * 1024 + c];
        const float got = (row < M_LAT) ? a.out[(size_t)row * 1024 + c] : ((const float*)(a.ws + WS_XC1))[(size_t)(row - M_LAT) * 1024 + c];
        chk_acc(a, id, got - xi, mod[v * 3072 + 2048 + c] * dot_h_w(MG + (size_t)row * 1024, WO + (size_t)c * 1024, 1024)); }
}
#ifdef CHECK_MAX
#define CHK_ERR(md, ss, n, mx) ((mx) / (sqrtf((ss) / (float)(n)) + 1e-20f))
#else
#define CHK_ERR(md, ss, n, mx) sqrtf((md) / ((ss) + 1e-30f))
#endif
DI void chk_report(const Frame& F, const Args& a) {
    const unsigned* w = (const unsigned*)(a.ws + WS_CTL) + CW_CHK; int first = -1; float ferr = 0.f;
#ifdef CHECK_ONLY
    { const int id = CHECK_ONLY; const float md = __uint_as_float(w[4 * id]), ss = ((const float*)w)[4 * id + 1]; const unsigned n = w[4 * id + 2]; first = id; ferr = n ? CHK_ERR(md, ss, n, __uint_as_float(w[4 * id + 3])) : 1e3f; }
#else
    for (int id = 0; id < 24; ++id) { const float md = __uint_as_float(w[4 * id]), ss = ((const float*)w)[4 * id + 1]; const unsigned n = w[4 * id + 2]; if (!n) continue;
        const float e = CHK_ERR(md, ss, n, __uint_as_float(w[4 * id + 3])); if (e > CHECK_TOL && first < 0) { first = id; ferr = e; } }
#endif
    const float V = first >= 0 ? 10.0f * (float)(1 + first) : 0.f; const float W = first >= 0 ? 4.0f + log10f(fminf(fmaxf(ferr, 1e-3f), 1e3f)) : 0.f;
    const size_t gt = (size_t)F.vcu * 512 + F.tid, NGT = (size_t)F.G * 512;
#ifdef KEEP_OUT
    if (gt == 0) a.out[0] += V; (void)W; (void)NGT;
#else
    for (size_t i = gt; i < (size_t)M_LAT * 1024; i += NGT) { float v = a.in[I_X][i]; if (i == 0) v += V; if (i >= (1u << 20) && i < (2u << 20)) v += W; a.out[i] = v; }
#endif
}
DI void chk_copy_out(const Frame& F, const Args& a) {
    const size_t gt = (size_t)F.vcu * 512 + F.tid, NGT = (size_t)F.G * 512; float* dst = (float*)(a.ws + WS_H);
    for (size_t i = gt; i < (size_t)M_LAT * 1024; i += NGT) dst[i] = a.out[i];
}
#endif

typedef const __attribute__((address_space(4))) Args* CArgsP;
DI Args fresh_args() { CArgsP p = (CArgsP)__builtin_amdgcn_kernarg_segment_ptr(); asm volatile("" : "+s"(p)); Args r;
#pragma unroll
    for (int i = 0; i < 20; ++i) r.in[i] = p->in[i];
    r.out = p->out; r.ws = p->ws; return r; }
DI Frame fresh_frame(unsigned char* lds) {
    Frame F; int t_ = threadIdx.x; asm volatile("" : "+v"(t_));
    F.lds = (LAS unsigned char*)lds; F.tid = t_; F.lane = t_ & 63; F.wave = __builtin_amdgcn_readfirstlane(t_ >> 6);
    F.G = gridDim.x; { const int bx = blockIdx.x; F.vcu = (F.G % 8 == 0) ? (bx % 8) * (F.G / 8) + bx / 8 : bx; }
    return F;
}
DI void grid_bar(unsigned char* lds) {
    const Args a = fresh_args();
    XcdBarrier b; b.bar = (unsigned*)(a.ws + WS_CTL) + CW_BAR; b.x = xb_xcc_id(); b.st = (volatile LAS unsigned*)((LAS unsigned char*)lds + MISC_OFF) + 8;
    xcd_barrier(b);
}

__global__ void __launch_bounds__(NWAVES * 64, 2) hybrid_fwd(Args args) {
    extern __shared__ __attribute__((aligned(16))) unsigned char lds[];
    for (int u = threadIdx.x; u < (LDS_BYTES - LDSCTL_OFF) / 4; u += NWAVES * 64) ((LAS unsigned*)((LAS unsigned char*)lds + LDSCTL_OFF))[u] = 0u;
    __syncthreads();
    { const Args a = fresh_args(); (void)xcd_barrier_post((unsigned*)(a.ws + WS_CTL) + CW_BAR, (volatile LAS unsigned*)((LAS unsigned char*)lds + MISC_OFF) + 8); }
#define GRID_BAR() grid_bar(lds)
#ifndef DUP_MASK
#define DUP_MASK 0
#endif
#define DUP(bit) for (int rep_ = 0; rep_ < 1 + (((DUP_MASK) >> (bit)) & 1); ++rep_)
#ifdef SELFCHECK
#ifndef CHECK_SET
#define CHECK_SET 0xffff
#endif
#define CHK(bit, call) do { if ((CHECK_SET) & (bit)) { { const Frame F = fresh_frame(lds); const Args a = fresh_args(); call; } GRID_BAR(); } } while (0)
#elif defined(EXTRA_BAR)
#define CHK(bit, call) GRID_BAR()
#else
#define CHK(bit, call) do {} while (0)
#endif

#ifndef SKIP_P0
    DUP(0) { const Frame F = fresh_frame(lds); const Args a = fresh_args(); p0_prologue(F, a); }
#endif
    GRID_BAR();
    CHK(1, chk_p0(F, a));

#pragma unroll 1
    for (int l = 0; l < 2; ++l) {
#ifndef SKIP_P1
        DUP(1) { const Frame F = fresh_frame(lds); const Args a = fresh_args();
          p1_modrms(F, a, l, (l == 0) ? a.in[I_X] : a.out, (l == 0) ? a.in[I_CTX] : (const float*)(a.ws + WS_XC1), 1); }
#endif
        GRID_BAR();
        CHK(2, chk_h(F, a, l, 2 + 10 * l));
#ifndef SKIP_G1
        DUP(2) { const Frame F = fresh_frame(lds); const Args a = fresh_args();
            pg8::Gemm g{(const bf16*)(a.ws + WS_H), (const bf16*)(a.ws + WS_WIN) + (size_t)l * PW * 1024, 1024, 1024, 1024};
            pg8::OrderX S; S.so.init(l == 0 ? M_ALL : M_LAT, PW, F.G, (int)blockIdx.x); S.nx = (l == 0) ? 0 : 4;
            pg8::EpiBf16<0> E{(bf16*)(a.ws + WS_P), PW, nullptr};
            pg8::gemm_phase<pg8::EpiBf16<0>, pg8::OrderX, true>(F.lds, g, S, E);
        }
#endif
        GRID_BAR();
        CHK(4, chk_p(F, a, l, 3 + 10 * l));
#ifndef SKIP_S1
        DUP(3) { const Frame F = fresh_frame(lds); const Args a = fresh_args();
          for (int u = F.vcu; u < 256; u += F.G) fnet_s1_unit(F, a, l, u, (const bf16*)(a.ws + WS_P)); }
#endif
#ifndef SKIP_FC
        if (l == 0) { const Frame F = fresh_frame(lds); const Args a = fresh_args();
          for (int e = F.vcu; e < 256; e += F.G) { if ((e & 31) == 7) fnet_ctx_unit(F, a, l, e >> 5, (const bf16*)(a.ws + WS_P), (bf16*)(a.ws + WS_YB)); } }
#endif
#ifndef SKIP_PREP
        { const Frame F = fresh_frame(lds); const Args a = fresh_args(); p3_prep(F, a, l, (bf16*)(a.ws + WS_P)); }
#endif
        GRID_BAR();
        CHK(8, chk_prep(F, a, l, 4 + 10 * l));
#ifndef SKIP_ATT
        DUP(4) { const Frame F = fresh_frame(lds); const Args a = fresh_args();
            const attn_body::bf16* Pa = (const attn_body::bf16*)(a.ws + WS_P); attn_body::bf16* Ya = (attn_body::bf16*)(a.ws + WS_YB);
            for (int u = F.vcu; u < 256; u += F.G) {
                const int bk = u >> 6, b = bk >> 1, kvh = bk & 1, h = 2 * kvh + ((u >> 5) & 1), qb = u & 31;
                attn_body::attn_unit<0, 8>(Pa, Ya, SEQ * b + 256 * qb, M_LAT + NCTX * b, SEQ * b, 0, 132, 0,
                                           C_AQ + 64 * h, C_AK + 64 * kvh, C_AV + 64 * kvh, C_AZ + 64 * h, 64 * h, 0.f, (char*)lds);
            }
        }
        DUP(5) { const Frame F = fresh_frame(lds); const Args a = fresh_args();
            const attn_body::bf16* Pa = (const attn_body::bf16*)(a.ws + WS_P); attn_body::bf16* Ya = (attn_body::bf16*)(a.ws + WS_YB);
            for (int u = F.vcu; u < 512; u += F.G) {
                if (u < 256) {
                    const int bk = u >> 6, b = bk >> 1, kvh = bk & 1, h = 2 * kvh + ((u >> 5) & 1), qb = u & 31;
                    const int off = (qb == 0) ? 0 : 4 * qb - 2, NT = (qb == 0 || qb == 31) ? 10 : 12;
                    const float sk = a.in[I_SINK][l * 4 + h] * 1.4426950408889634f;
                    attn_body::attn_unit<1, 8>(Pa, Ya, SEQ * b + 256 * qb, M_LAT + NCTX * b, SEQ * b, off, NT, 256 * qb - 64 * off,
                                               C_DQ + 64 * h, C_DK + 64 * kvh, C_DV + 64 * kvh, C_DZ + 64 * h, 256 + 64 * h, sk, (char*)lds);
                } else if (l == 0 && ((u - 256) & 15) == 0) {
                    const int ee = (u - 256) >> 4, mode = ee >> 3, b = (ee >> 2) & 1, h = ee & 3, kvh = h >> 1;
                    const float sk = (mode == 0) ? -INFINITY : a.in[I_SINK][l * 4 + h] * 1.4426950408889634f;
                    const int qc = (mode == 0) ? C_AQ : C_DQ, kc = (mode == 0) ? C_AK : C_DK, vc = (mode == 0) ? C_AV : C_DV, zc = (mode == 0) ? C_AZ : C_DZ, oc = (mode == 0) ? 0 : 256;
                    attn_body::attn_unit<1, 8>(Pa, Ya, M_LAT + NCTX * b, M_LAT + NCTX * b, SEQ * b, 0, 4, 0,
                                               qc + 64 * h, kc + 64 * kvh, vc + 64 * kvh, zc + 64 * h, oc + 64 * h, sk, (char*)lds);
                }
            }
        }
#endif
#ifndef SKIP_S3
        DUP(6) { const Frame F = fresh_frame(lds); const Args a = fresh_args();
          for (int u = F.vcu; u < 256; u += F.G) fnet_s3_unit(F, a, u, (const bf16*)(a.ws + WS_P), (bf16*)(a.ws + WS_YB)); }
#endif
#ifndef SKIP_SGU
        DUP(7) { const Frame F = fresh_frame(lds); const Args a = fresh_args();
          const int nchunk = (l == 0) ? 132 : 128;
          for (int ci = F.vcu; ci < nchunk; ci += F.G) sgu_unit(F, a, l, ci, (const bf16*)(a.ws + WS_P), (bf16*)(a.ws + WS_YB)); }
#endif
        GRID_BAR();
        CHK(16, chk_attn(F, a, l, 5 + 10 * l, 0)); CHK(16, chk_attn(F, a, l, 6 + 10 * l, 1)); CHK(32, chk_fnet(F, a, l, 7 + 10 * l, 0); if (l == 0) chk_fnet(F, a, l, 8, 1)); CHK(64, chk_sgu(F, a, l, 9 + 10 * l));
#ifndef MERGE_V1
        for (int rep_ = 0; rep_ < 1 + ((((DUP_MASK) >> 8) & 1) && l == 1); ++rep_) { const Frame F = fresh_frame(lds); const Args a = fresh_args();
            pg8::Gemm g{(const bf16*)(a.ws + WS_H), (const bf16*)(a.ws + WS_WM), 1024, 1024, 1024};
            pg8::MergeOrder S{(const bf16*)(a.ws + WS_H), (const bf16*)(a.ws + WS_YB), (const bf16*)(a.ws + WS_WM) + (size_t)l * 4096 * 1024, (const bf16*)(a.ws + WS_WBR) + (size_t)l * 1024 * 1024, F.G, F.vcu, (l == 0) ? 32 : 0};
            pg8::EpiMerge E{(bf16*)(a.ws + WS_GT), (bf16*)(a.ws + WS_MG), (float*)(a.ws + WS_MGC), a.in[I_BMERGE] + l * 4096, (bf16*)(a.ws + WS_GTC)};
            pg8::gemm_phase<pg8::EpiMerge, pg8::MergeOrder, true>(F.lds, g, S, E);
        }
        GRID_BAR();
        if (l == 0) { { const Frame F = fresh_frame(lds); const Args a = fresh_args(); p5_ctx_convert(F, a); } GRID_BAR(); }
#else
#pragma unroll 1
        for (int r = 0; r < 4; ++r) {
#ifdef ZERO_MASK
            if ((ZERO_MASK >> r) & 1) continue;
#endif
#ifndef SKIP_MG
            { const Frame F = fresh_frame(lds); const Args a = fresh_args();
                pg8::Gemm g{(const bf16*)(a.ws + WS_H), (const bf16*)(a.ws + WS_WM) + ((size_t)l * 4096 + r * 1024) * 1024, 1024, 1024, 1024};
                pg8::OrderX S; S.so.init((l == 0) ? M_ALL : M_LAT, 1024, F.G, (int)blockIdx.x); S.nx = 0;
                pg8::EpiBf16<2> E{(bf16*)(a.ws + WS_GT), 1024, a.in[I_BMERGE] + l * 4096 + r * 1024};
                pg8::gemm_phase<pg8::EpiBf16<2>, pg8::OrderX, true>(F.lds, g, S, E);
            }
#endif
            GRID_BAR();
            if (r == 3 && l == 0) CHK(512, chk_gt(F, a, l, r, 22); chk_gt(F, a, l, 2, 23));
#ifndef SKIP_MY
            { const Frame F = fresh_frame(lds); const Args a = fresh_args();
                pg8::Gemm g{(const bf16*)(a.ws + WS_YB) + r * 256, (const bf16*)(a.ws + WS_WBR) + (size_t)l * 1024 * 1024 + r * 256, 1024, 1024, 256};
                pg8::OrderX S; S.so.init((l == 0) ? M_ALL : M_LAT, 1024, F.G, (int)blockIdx.x); S.nx = 0;

#ifdef ZERO_MASK
                pg8::EpiGate E{(bf16*)(a.ws + WS_MG), (const bf16*)(a.ws + WS_GT), 1024, r == __builtin_ctz(~(ZERO_MASK)), 1.0f};
#else
#ifdef SCALE_MASK
                pg8::EpiGate E{(bf16*)(a.ws + WS_MG), (const bf16*)(a.ws + WS_GT), 1024, r == 0, ((SCALE_MASK >> r) & 1) ? (SCALE_VAL) : 1.0f};
#else
                pg8::EpiGate E{(bf16*)(a.ws + WS_MG), (const bf16*)(a.ws + WS_GT), 1024, r == 0, 1.0f};
#endif
#endif

                pg8::gemm_phase<pg8::EpiGate, pg8::OrderX, true>(F.lds, g, S, E);
            }
#endif
            GRID_BAR();
        }
#endif
        CHK(128, chk_merge(F, a, l, 10 + 10 * l));
        if (l == 1) CHK(256, chk_copy_out(F, a));
#ifndef SKIP_OUT
        { const Frame F = fresh_frame(lds); const Args a = fresh_args();
            pg8::Gemm g{(const bf16*)(a.ws + WS_MG), (const bf16*)(a.ws + WS_WOUT) + (size_t)l * 1024 * 1024, 1024, 1024, 1024};
            pg8::OrderOut S; S.so.init(M_LAT, 1024, F.G, (int)blockIdx.x); S.nx = (l == 0) ? 32 : 0;
            pg8::EpiRes E{(l == 0) ? a.in[I_X] : a.out, a.out, (l == 0) ? a.in[I_CTX] : (const float*)(a.ws + WS_XC1), (float*)(a.ws + WS_XC1), (const float*)(a.ws + WS_MOD) + (size_t)l * 3 * 3072};
            pg8::gemm_phase<pg8::EpiRes, pg8::OrderOut, true>(F.lds, g, S, E);
        }
#endif
        if (l == 0) GRID_BAR();
        if (l == 0) CHK(256, chk_final(F, a, l, 11));
#ifdef SELFCHECK
        if (l == 1) { GRID_BAR(); CHK(256, chk_final(F, a, l, 21)); }
#endif
    }
#ifdef SELFCHECK
    GRID_BAR();
    { const Frame F = fresh_frame(lds); const Args a = fresh_args(); chk_report(F, a); }
#endif
#ifdef BLEND_S
    GRID_BAR();
    { const Frame F = fresh_frame(lds); const Args a = fresh_args(); const size_t gt = (size_t)F.vcu * 512 + F.tid, NGT = (size_t)F.G * 512;
      for (size_t i = gt; i < (size_t)M_LAT * 1024; i += NGT) { const float x0 = a.in[I_X][i]; a.out[i] = x0 + (BLEND_S) * (a.out[i] - x0); } }
#endif
}

extern "C" void kernel_launch(void* const* d_in, const int* in_sizes, int n_in, void* d_out, int out_size, void* d_ws, size_t ws_size, hipStream_t stream) {
    static int grid = 0;
    if (grid == 0) {
        if (n_in != 20 || out_size != M_LAT * DM || ws_size < WS_END) { fprintf(stderr, "kernel_launch: unexpected problem: n_in %d out %d ws %zu\n", n_in, out_size, ws_size); grid = -1; return; }
        { const int want[20] = {M_LAT * DM, NB * DM, M_CTX * DM, DM, 2 * DM, 2 * DM * 3 * DM, 2 * 3 * DM, 2 * DM * PW, 128, 128, 128, 128, 8, 2 * 4 * 64 * 64, 2 * 4 * 128 * 128, 2 * 4 * 128, 2 * 4 * 256 * DM, 2 * DM * 4 * DM, 2 * 4 * DM, 2 * DM * DM};
          for (int i = 0; i < 20; ++i) if (in_sizes[i] != want[i]) { fprintf(stderr, "kernel_launch: input %d has %d elements, expected %d\n", i, in_sizes[i], want[i]); grid = -1; return; } }
        int dev = 0, cus = 0, per_cu = 0;
        if (hipGetDevice(&dev) != hipSuccess || hipDeviceGetAttribute(&cus, hipDeviceAttributeMultiprocessorCount, dev) != hipSuccess) { grid = -1; return; }
        if (hipFuncSetAttribute((const void*)hybrid_fwd, hipFuncAttributeMaxDynamicSharedMemorySize, LDS_BYTES) != hipSuccess) { fprintf(stderr, "kernel_launch: hipFuncSetAttribute failed\n"); grid = -1; return; }
        if (hipOccupancyMaxActiveBlocksPerMultiprocessor(&per_cu, (const void*)hybrid_fwd, NWAVES * 64, LDS_BYTES) != hipSuccess || per_cu < 1) { fprintf(stderr, "kernel_launch: occupancy query says %d blocks per CU\n", per_cu); per_cu = 1; }
        (void)hipGetLastError();
        grid = cus;
    }
    if (grid < 0) return;
    if (hipMemsetAsync((char*)d_ws + WS_CTL, 0, CTL_ZERO_BYTES, stream) != hipSuccess) { fprintf(stderr, "kernel_launch: memset failed\n"); return; }
    Args a{};
    for (int i = 0; i < 20; ++i) a.in[i] = (const float*)d_in[i];
    a.out = (float*)d_out; a.ws = (unsigned char*)d_ws;
    hipLaunchKernelGGL(hybrid_fwd, dim3(grid), dim3(NWAVES * 64), LDS_BYTES, stream, a);
}
```

```cpp
#include <hip/hip_runtime.h>
#include <hip/hip_bf16.h>
#include <cstdio>
#include <cstdint>
#include <cmath>

namespace pg8 {
#define PG8_LAS __attribute__((address_space(3)))
typedef unsigned short bf16_t;
typedef short bf16x8 __attribute__((ext_vector_type(8)));
typedef float f32x4 __attribute__((ext_vector_type(4)));
typedef unsigned u32x4 __attribute__((ext_vector_type(4)));
constexpr int BM = 256, BK = 64, HALF = 128, HTB = HALF * BK * 2, STAGE_BYTES = 8 * HTB, NXCD = 8, WGM = 8;

__host__ __device__ __forceinline__ int lds_byte(int r, int c) { const int st = (r >> 4) * 2 + (c >> 5), rr = r & 15, cc = c & 31, ob = rr * 64 + cc * 2; return st * 1024 + (ob ^ (((ob >> 9) & 1) << 5)); }
__host__ __device__ __forceinline__ void stage_rc(int b, int& R, int& C) { const int st = b / 1024, sb = b % 1024, swz = sb ^ (((sb >> 9) & 1) << 5); R = (st >> 1) * 16 + swz / 64; C = (st & 1) * 32 + (swz % 64) / 2; }
__host__ __device__ __forceinline__ int perm32(int rho) { const int n = rho >> 4, i = rho & 15; return 8 * (i >> 2) + 4 * n + (i & 3); }

struct Unit { int pm, pn, r, kind; };
struct Gemm { const bf16_t* A; const bf16_t* Bt; int lda, ldb, K; };

struct StaticOrder {
    int nM, nN, nwg, G, c;
    __host__ __device__ void init(int M, int N, int G_, int c_) { nM = M / BM; nN = N / BM; nwg = nM * nN; G = G_; c = c_; }
    __host__ __device__ bool next(int i, Unit& u) const {
        const long L = (long)i * G + c; if (L >= nwg) return false;
        int wgid = (int)L; { const int q = nwg / NXCD, r = nwg % NXCD, xcd = wgid % NXCD, off = wgid / NXCD; wgid = (xcd < r ? xcd * (q + 1) : r * (q + 1) + (xcd - r) * q) + off; }
        const int nig = WGM * nN, gid = wgid / nig, fm = gid * WGM, gsz = (nM - fm) < WGM ? (nM - fm) : WGM;
        u.pm = fm + ((wgid % nig) % gsz); u.pn = (wgid % nig) / gsz; u.r = 0; u.kind = 0; return true;
    }
};
struct OrderX {
    StaticOrder so; int nx;
    __device__ bool next(int i, Unit& u) const {
        const long L = (long)i * so.G + so.c;
        if (L < so.nwg) return so.next(i, u);
        const int e = (int)(L - so.nwg); if (e >= nx) return false;
        u.pm = 64 + (e >> 1); u.pn = (e & 1) ? 4 : 1; u.r = 0; u.kind = 0; return true;
    }
    __device__ __forceinline__ void src(const Gemm& g, const Unit& u, const char*& pa, const char*& pb, int& nt) const {
        pa = (const char*)g.A + (size_t)u.pm * (2 * HALF) * g.lda * 2; pb = (const char*)g.Bt + (size_t)u.pn * (2 * HALF) * g.ldb * 2; nt = g.K / BK; }
};

typedef float f32x2_c __attribute__((ext_vector_type(2))); typedef __bf16 bf16x2_c __attribute__((ext_vector_type(2)));
__device__ __forceinline__ unsigned cvt_pk_bf16(float lo, float hi) { f32x2_c v = {lo, hi}; bf16x2_c b = __builtin_convertvector(v, bf16x2_c); return __builtin_bit_cast(unsigned, b); }
__device__ __forceinline__ float bf_lo(unsigned w) { return __uint_as_float(w << 16); }
__device__ __forceinline__ float bf_hi(unsigned w) { return __uint_as_float(w & 0xffff0000u); }
__device__ __forceinline__ float sigmoidf_(float x) { return __builtin_amdgcn_rcpf(1.0f + __builtin_amdgcn_exp2f(-1.4426950408889634f * x)); }

template <int ACT> struct EpiBf16 {
    static constexpr bool PERM = true;
    bf16_t* O; int ldc; const float* bias;
    __device__ __forceinline__ void operator()(const f32x4 (&acc)[2][2][4][2], const Unit& u, int wr, int wc, int fr, int fq) const {
        const int row0 = u.pm * BM + wr * 64 + fr; const int col0 = u.pn * BM + wc * 32 + 8 * fq;
        f32x4 bv[2][2];
#pragma unroll
        for (int bj = 0; bj < 2; ++bj)
#pragma unroll
            for (int n = 0; n < 2; ++n) bv[bj][n] = bias ? *(const f32x4*)(bias + col0 + bj * HALF + 4 * n) : (f32x4){0.f, 0.f, 0.f, 0.f};
#pragma unroll
        for (int ai = 0; ai < 2; ++ai)
#pragma unroll
            for (int m = 0; m < 4; ++m) { bf16_t* rowp = O + (size_t)(row0 + ai * HALF + m * 16) * ldc + col0;
#pragma unroll
                for (int bj = 0; bj < 2; ++bj) { f32x4 v0 = acc[ai][bj][m][0] + bv[bj][0], v1 = acc[ai][bj][m][1] + bv[bj][1];
                    if (ACT == 2) {
#pragma unroll
                        for (int e = 0; e < 4; ++e) { v0[e] = sigmoidf_(v0[e]); v1[e] = sigmoidf_(v1[e]); } }
                    u32x4 w; w.x = cvt_pk_bf16(v0[0], v0[1]); w.y = cvt_pk_bf16(v0[2], v0[3]); w.z = cvt_pk_bf16(v1[0], v1[1]); w.w = cvt_pk_bf16(v1[2], v1[3]);
                    *(u32x4*)(rowp + bj * HALF) = w; } }
    }
};
struct EpiGate {
    static constexpr bool PERM = true;
    bf16_t* MG; const bf16_t* GT; int ldc; int first; float scl;
    typedef unsigned u32x2 __attribute__((ext_vector_type(2)));
    __device__ __forceinline__ void operator()(const f32x4 (&acc)[2][2][4][2], const Unit& u, int wr, int wc, int fr, int fq) const {
        const int row0 = u.pm * BM + wr * 64 + fr; const int col0 = u.pn * BM + wc * 32 + 8 * fq;
#pragma unroll
        for (int ai = 0; ai < 2; ++ai)
#pragma unroll
            for (int m = 0; m < 4; ++m) { const size_t off = (size_t)(row0 + ai * HALF + m * 16) * ldc + col0;
#pragma unroll
                for (int bj = 0; bj < 2; ++bj)
#pragma unroll
                    for (int n = 0; n < 2; ++n) {
                        const u32x2 g = *(const u32x2*)(GT + off + bj * HALF + 4 * n);
                        u32x2 o = (u32x2){0u, 0u}; if (!first) o = *(const u32x2*)(MG + off + bj * HALF + 4 * n);
                        const f32x4 v = acc[ai][bj][m][n] * scl;
                        u32x2 w;
                        w.x = cvt_pk_bf16(bf_lo(o.x) + bf_lo(g.x) * v[0], bf_hi(o.x) + bf_hi(g.x) * v[1]);
                        w.y = cvt_pk_bf16(bf_lo(o.y) + bf_lo(g.y) * v[2], bf_hi(o.y) + bf_hi(g.y) * v[3]);
                        *(u32x2*)(MG + off + bj * HALF + 4 * n) = w; asm volatile("" ::: "memory"); } }
    }
};
struct EpiRes {
    static constexpr bool PERM = false;
    const float* xin_lat; float* xout_lat; const float* xin_ctx; float* xout_ctx; const float* gate;
    __device__ __forceinline__ void operator()(const f32x4 (&acc)[2][2][4][2], const Unit& u, int wr, int wc, int fr, int fq) const {
        const bool isctx = u.pm >= 64;
        const float* xin = isctx ? xin_ctx + (size_t)(u.pm - 64) * BM * 1024 : xin_lat + (size_t)u.pm * BM * 1024;
        float* xout = isctx ? xout_ctx + (size_t)(u.pm - 64) * BM * 1024 : xout_lat + (size_t)u.pm * BM * 1024;
        const float* gv = gate + (isctx ? 2 : (u.pm >> 5)) * 3072 + 2048;
        const int col0 = u.pn * BM + wc * 32 + 4 * fq;
        f32x4 gt[2][2];
#pragma unroll
        for (int bj = 0; bj < 2; ++bj)
#pragma unroll
            for (int n = 0; n < 2; ++n) gt[bj][n] = *(const f32x4*)(gv + col0 + bj * HALF + n * 16);
#pragma unroll
        for (int ai = 0; ai < 2; ++ai)
#pragma unroll
            for (int m = 0; m < 4; ++m) { const size_t off = (size_t)(ai * HALF + wr * 64 + m * 16 + fr) * 1024 + col0;
#pragma unroll
                for (int bj = 0; bj < 2; ++bj)
#pragma unroll
                    for (int n = 0; n < 2; ++n) {
                        if (u.kind == 3) { const f32x4 v = gt[bj][n] * acc[ai][bj][m][n]; float* q = xout + off + bj * HALF + n * 16; atomicAdd(q + 0, v[0]); atomicAdd(q + 1, v[1]); atomicAdd(q + 2, v[2]); atomicAdd(q + 3, v[3]); }
                        else { const f32x4 bs = *(const f32x4*)(xin + off + bj * HALF + n * 16); *(f32x4*)(xout + off + bj * HALF + n * 16) = bs + gt[bj][n] * acc[ai][bj][m][n]; } }
                if (m & 1) asm volatile("" ::: "memory"); }
    }
};

struct MergeOrder {
    const bf16_t* H; const bf16_t* YB; const bf16_t* WmT; const bf16_t* WbrT; int G, c, nctx;
    __device__ bool next(int i, Unit& u) const {
        const int nl = (c < 256) ? 1 + (255 - c) / G : 0;
        if (i < 8 * nl) { const int t = c + (i >> 3) * G, q = i & 7; u.pm = t >> 2; u.pn = t & 3; u.r = q >> 1; u.kind = (q & 1) ? 0 : 1; return true; }
        const int j = i - 8 * nl;
        if (nctx == 0 || (c & 7) != 0) return false;
        const int jb = (c >> 3) + (j >> 1) * (G >> 3); if (jb >= nctx) return false;
        const int t = jb >> 2; u.pm = 64 + (t >> 2); u.pn = t & 3; u.r = jb & 3; u.kind = (j & 1) ? 2 : 1; return true;
    }
    __device__ __forceinline__ void src(const Gemm&, const Unit& u, const char*& pa, const char*& pb, int& nt) const {
        if (u.kind != 1) { pa = (const char*)(H + (size_t)u.pm * 256 * 1024); pb = (const char*)(WmT + ((size_t)u.r * 1024 + u.pn * 256) * 1024); nt = 16; }
        else { pa = (const char*)(YB + (size_t)u.pm * 256 * 1024 + u.r * 256); pb = (const char*)(WbrT + (size_t)u.pn * 256 * 1024 + u.r * 256); nt = 4; }
    }
};
typedef unsigned long long u64_t;
__device__ __forceinline__ u64_t ld_sc1(const void* p) { return __hip_atomic_load((const u64_t*)p, __ATOMIC_RELAXED, __HIP_MEMORY_SCOPE_AGENT); }
struct EpiMerge {
    static constexpr bool PERM = true;
    bf16_t* GT; bf16_t* MG; float* MGc; const float* bias; bf16_t* GTc;
    typedef unsigned u32x2 __attribute__((ext_vector_type(2)));
    __device__ __forceinline__ void operator()(const f32x4 (&acc)[2][2][4][2], const Unit& u, int wr, int wc, int fr, int fq) const {
        const int row0 = u.pm * BM + wr * 64 + fr; const int col0 = u.pn * BM + wc * 32 + 8 * fq;
        bf16_t* Yu = (u.pm >= 64) ? GTc + ((size_t)u.r * 512 - 16384) * 1024 : GT;
        if (u.kind == 1) {
#pragma unroll
            for (int ai = 0; ai < 2; ++ai)
#pragma unroll
                for (int m = 0; m < 4; ++m) { bf16_t* rowp = Yu + (size_t)(row0 + ai * HALF + m * 16) * 1024 + col0;
#pragma unroll
                    for (int bj = 0; bj < 2; ++bj) { const f32x4 v0 = acc[ai][bj][m][0], v1 = acc[ai][bj][m][1];
                        u32x4 w; w.x = cvt_pk_bf16(v0[0], v0[1]); w.y = cvt_pk_bf16(v0[2], v0[3]); w.z = cvt_pk_bf16(v1[0], v1[1]); w.w = cvt_pk_bf16(v1[2], v1[3]);
                        *(u32x4*)(rowp + bj * HALF) = w; } }
        } else {
            const bool isctx = (u.kind == 2), first = (u.r == 0) || isctx;
            bf16_t* Ou = isctx ? Yu : MG;
            const float* bp = bias + u.r * 1024 + col0;
            f32x4 bv[2][2];
#pragma unroll
            for (int bj = 0; bj < 2; ++bj)
#pragma unroll
                for (int n = 0; n < 2; ++n) bv[bj][n] = *(const f32x4*)(bp + bj * HALF + 4 * n);
#pragma unroll
            for (int ai = 0; ai < 2; ++ai) { u64_t yq[4][2][2], oq[4][2][2];
#pragma unroll
                for (int mm = 0; mm < 4; ++mm) { const size_t off = (size_t)(row0 + ai * HALF + mm * 16) * 1024 + col0;
#pragma unroll
                    for (int bj = 0; bj < 2; ++bj)
#pragma unroll
                        for (int n = 0; n < 2; ++n) { yq[mm][bj][n] = ld_sc1(Yu + off + bj * HALF + 4 * n); oq[mm][bj][n] = first ? 0ull : ld_sc1(MG + off + bj * HALF + 4 * n); } }
#pragma unroll
                for (int mm = 0; mm < 4; ++mm) { const size_t off = (size_t)(row0 + ai * HALF + mm * 16) * 1024 + col0;
#pragma unroll
                    for (int bj = 0; bj < 2; ++bj)
#pragma unroll
                        for (int n = 0; n < 2; ++n) { f32x4 gv = acc[ai][bj][mm][n] + bv[bj][n];
#pragma unroll
                            for (int e = 0; e < 4; ++e) gv[e] = sigmoidf_(gv[e]);
                            const u64_t y_ = yq[mm][bj][n], o_ = oq[mm][bj][n];
                            const unsigned yx = (unsigned)y_, yy = (unsigned)(y_ >> 32), ox = (unsigned)o_, oy = (unsigned)(o_ >> 32);
                            u32x2 w;
                            w.x = cvt_pk_bf16(bf_lo(ox) + gv[0] * bf_lo(yx), bf_hi(ox) + gv[1] * bf_hi(yx));
                            w.y = cvt_pk_bf16(bf_lo(oy) + gv[2] * bf_lo(yy), bf_hi(oy) + gv[3] * bf_hi(yy));
                            *(u32x2*)(Ou + off + bj * HALF + 4 * n) = w; } }
                asm volatile("" ::: "memory"); }
        }
    }
};
struct OrderOut {
    StaticOrder so; int nx; const bf16_t* TERM;
    __device__ bool next(int i, Unit& u) const {
        const long L = (long)i * so.G + so.c;
        if (L < so.nwg) return so.next(i, u);
        const int e = (int)(L - so.nwg); if (e >= nx) return false;
        const int t = e >> 4; u.pm = 64 + (t >> 2); u.pn = t & 3; u.r = e & 15; u.kind = 3; return true;
    }
    __device__ __forceinline__ void src(const Gemm& g, const Unit& u, const char*& pa, const char*& pb, int& nt) const {
        pa = (const char*)g.A + (size_t)u.pm * (2 * HALF) * g.lda * 2; pb = (const char*)g.Bt + (size_t)u.pn * (2 * HALF) * g.ldb * 2; nt = g.K / BK;
        if (u.kind == 3) { const int br = u.r >> 2, kq = u.r & 3; pa = (const char*)(TERM + ((size_t)br * 512 + (u.pm - 64) * 256) * 1024 + kq * 256); pb += (size_t)kq * 256 * 2; nt = 4; }
    }
};

template <class Epi, class Sched, bool ALIGN_EPI>
__device__ __forceinline__ void gemm_phase(PG8_LAS unsigned char* lds, const Gemm g, const Sched& S, const Epi& E) {
    int tid = threadIdx.x; asm volatile("" : "+v"(tid));
    const int wid = __builtin_amdgcn_readfirstlane(tid >> 6), lane = tid & 63, wr = wid >> 2, wc = wid & 3, fr = lane & 15, fq = lane >> 4;
    int nt;
    unsigned voffA[2], voffB[2];
#pragma unroll
    for (int i = 0; i < 2; ++i) { int R, C; stage_rc(tid * 16 + i * 8192, R, C); const int Rb = Epi::PERM ? ((R & ~31) + perm32(R & 31)) : R;
        voffA[i] = (unsigned)(R * g.lda + C) * 2u; voffB[i] = (unsigned)(Rb * g.ldb + C) * 2u; }
    const size_t kstep = (size_t)(BK * 2);
    const size_t hstepA = (size_t)HALF * g.lda * 2, hstepB = (size_t)HALF * g.ldb * 2;
    const unsigned ldsw = (unsigned)wid * 1024u;
    const int aoff = lds_byte(wr * 64 + fr, fq * 8), boff = lds_byte(wc * 32 + fr, fq * 8);
#define PG8_SA(b, h) (((b) * 2 + (h)) * HTB)
#define PG8_SB(b, h) ((4 + (b) * 2 + (h)) * HTB)
#define PG8_STAGE(bufoff, gbase, voff) do { _Pragma("unroll") for (int _i = 0; _i < 2; ++_i) \
        __builtin_amdgcn_global_load_lds((const unsigned*)((const char*)(gbase) + (voff)[_i]), (PG8_LAS unsigned*)(lds + (bufoff) + ldsw + _i * 8192), 16, 0, 0); } while (0)
#define PG8_LDA(dst, b, h) do { _Pragma("unroll") for (int m = 0; m < 4; ++m) _Pragma("unroll") for (int k = 0; k < 2; ++k) dst[m][k] = *(const PG8_LAS bf16x8*)(lds + PG8_SA(b, h) + aoff + m * 2048 + k * 1024); } while (0)
#define PG8_LDB(dst, b, h) do { _Pragma("unroll") for (int n = 0; n < 2; ++n) _Pragma("unroll") for (int k = 0; k < 2; ++k) dst[n][k] = *(const PG8_LAS bf16x8*)(lds + PG8_SB(b, h) + boff + n * 2048 + k * 1024); } while (0)
#define PG8_MMA(ai, bj, At, Bt) do { __builtin_amdgcn_s_setprio(1); _Pragma("unroll") for (int m = 0; m < 4; ++m) _Pragma("unroll") for (int n = 0; n < 2; ++n) _Pragma("unroll") for (int k = 0; k < 2; ++k) \
        acc[ai][bj][m][n] = __builtin_amdgcn_mfma_f32_16x16x32_bf16(Bt[n][k], At[m][k], acc[ai][bj][m][n], 0, 0, 0); __builtin_amdgcn_s_setprio(0); } while (0)
#define PG8_WAIT_V(n) asm volatile("s_waitcnt vmcnt(" #n ")" ::: "memory")
#define PG8_WAIT_L(n) asm volatile("s_waitcnt lgkmcnt(" #n ")" ::: "memory")
#define PG8_BAR __builtin_amdgcn_s_barrier()
#define PG8_SCHED __builtin_amdgcn_sched_barrier(0)
    Unit cur, nxt; int ui = 0;
    if (!S.next(0, cur)) return;
    f32x4 acc[2][2][4][2];
#pragma unroll
    for (int a = 0; a < 2; ++a)
#pragma unroll
        for (int b = 0; b < 2; ++b)
#pragma unroll
            for (int m = 0; m < 4; ++m)
#pragma unroll
                for (int n = 0; n < 2; ++n) acc[a][b][m][n] = (f32x4){0.f, 0.f, 0.f, 0.f};
    bf16x8 At[4][2], B0[2][2], B1[2][2];
    const char* cA; const char* cB; S.src(g, cur, cA, cB, nt);
    PG8_STAGE(PG8_SB(0, 0), cB, voffB); PG8_STAGE(PG8_SB(0, 1), cB + hstepB, voffB); PG8_STAGE(PG8_SA(0, 0), cA, voffA); PG8_STAGE(PG8_SA(0, 1), cA + hstepA, voffA);
    if (wr == 1) PG8_BAR;
    PG8_WAIT_V(2); PG8_BAR;
    PG8_STAGE(PG8_SB(1, 0), cB + kstep, voffB); PG8_STAGE(PG8_SA(1, 0), cA + kstep, voffA); PG8_STAGE(PG8_SB(1, 1), cB + hstepB + kstep, voffB);
    PG8_WAIT_V(6); PG8_BAR;
    for (;;) {
        const bool has_next = S.next(ui + 1, nxt);
        const char* nA = cA; const char* nB = cB; int nnt = nt; if (has_next) S.src(g, nxt, nA, nB, nnt);
        for (int t = 0; t < nt; t += 2) {
            const bool last = (t == nt - 2);
            const char* a1 = cA + (size_t)(t + 1) * kstep;
            const char* a2 = last ? nA : cA + (size_t)(t + 2) * kstep; const char* b2 = last ? nB : cB + (size_t)(t + 2) * kstep;
            const char* a3 = a2 + kstep; const char* b3 = b2 + kstep;
            PG8_LDB(B0, 0, 0); PG8_LDB(B1, 0, 1); PG8_SCHED; PG8_LDA(At, 0, 0); PG8_STAGE(PG8_SA(1, 1), a1 + hstepA, voffA);
            PG8_WAIT_V(8); PG8_WAIT_L(0); PG8_BAR; PG8_MMA(0, 0, At, B0); PG8_MMA(0, 1, At, B1); PG8_BAR; PG8_SCHED;
            PG8_LDA(At, 0, 1); PG8_STAGE(PG8_SB(0, 0), b2, voffB); PG8_STAGE(PG8_SB(0, 1), b2 + hstepB, voffB); PG8_STAGE(PG8_SA(0, 0), a2, voffA);
            PG8_WAIT_V(8); PG8_WAIT_L(0); PG8_BAR; PG8_MMA(1, 0, At, B0); PG8_MMA(1, 1, At, B1); PG8_BAR; PG8_SCHED;
            PG8_LDB(B0, 1, 0); PG8_LDB(B1, 1, 1); PG8_SCHED; PG8_LDA(At, 1, 0); PG8_STAGE(PG8_SA(0, 1), a2 + hstepA, voffA);
            PG8_WAIT_V(8); PG8_WAIT_L(0); PG8_BAR; PG8_MMA(0, 0, At, B0); PG8_MMA(0, 1, At, B1); PG8_BAR; PG8_SCHED;
            PG8_LDA(At, 1, 1); PG8_STAGE(PG8_SB(1, 0), b3, voffB); PG8_STAGE(PG8_SB(1, 1), b3 + hstepB, voffB); PG8_STAGE(PG8_SA(1, 0), a3, voffA);
            PG8_WAIT_V(8); PG8_WAIT_L(0); PG8_BAR; PG8_MMA(1, 0, At, B0); PG8_MMA(1, 1, At, B1); PG8_BAR; PG8_SCHED;
        }
        if constexpr (ALIGN_EPI) { if (wr == 0) PG8_BAR; }
        E(acc, cur, wr, wc, fr, fq);
        if (!has_next) break;
#pragma unroll
        for (int a = 0; a < 2; ++a)
#pragma unroll
            for (int b = 0; b < 2; ++b)
#pragma unroll
                for (int m = 0; m < 4; ++m)
#pragma unroll
                    for (int n = 0; n < 2; ++n) acc[a][b][m][n] = (f32x4){0.f, 0.f, 0.f, 0.f};
        cur = nxt; cA = nA; cB = nB; nt = nnt; ++ui;
        if constexpr (ALIGN_EPI) { if (wr == 1) PG8_BAR; }
    }
    PG8_WAIT_V(0);
    if constexpr (!ALIGN_EPI) { if (wr == 0) PG8_BAR; }
    PG8_BAR;
#undef PG8_SA
#undef PG8_SB
#undef PG8_STAGE
#undef PG8_LDA
#undef PG8_LDB
#undef PG8_MMA
#undef PG8_WAIT_V
#undef PG8_WAIT_L
#undef PG8_BAR
#undef PG8_SCHED
}
}

namespace sg {
using pg8::bf16_t; using pg8::bf16x8; using pg8::f32x4; using pg8::u32x4; using pg8::lds_byte; using pg8::stage_rc; using pg8::perm32; using pg8::cvt_pk_bf16; using pg8::bf_lo; using pg8::bf_hi; using pg8::sigmoidf_;
constexpr int HTB = 16384, SLOT = 3 * HTB, NT_Y = 4, NT_G = 16, NT_R = NT_Y + NT_G, NT_U = 4 * NT_R;
struct Merge { const bf16_t* H; const bf16_t* YB; const bf16_t* WmT; const bf16_t* WbrT; const float* bias; bf16_t* MG; int nunits; };
__device__ __forceinline__ void unit_of(int u, int& pm, int& pn) { pm = u >> 2; pn = u & 3; }

__device__ __forceinline__ void merge_phase(PG8_LAS unsigned char* lds, const Merge g, int vcu, int G) {
    int tid = threadIdx.x; asm volatile("" : "+v"(tid));
    const int wid = __builtin_amdgcn_readfirstlane(tid >> 6), lane = tid & 63, wr = wid >> 2, wc = wid & 3, fr = lane & 15, fq = lane >> 4;
    int nu = 0; for (int u = vcu; u < g.nunits; u += G) ++nu;
    if (nu == 0) return;
    unsigned voffA[2], voffB[2];
#pragma unroll
    for (int i = 0; i < 2; ++i) { int R, C; stage_rc(tid * 16 + i * 8192, R, C); const int Rb = (R & ~31) + perm32(R & 31);
        voffA[i] = (unsigned)(R * 1024 + C) * 2u; voffB[i] = (unsigned)(Rb * 1024 + C) * 2u; }
    const unsigned ldsw = (unsigned)wid * 1024u;
    const int aoff = lds_byte(wr * 64 + fr, fq * 8), boff = lds_byte(wc * 32 + fr, fq * 8);
    const int ntot = nu * NT_U;
#define SG_SRC(s, pa, pb) do { const int _s = (s) < ntot ? (s) : 0; const int _ui = _s / NT_U, _j = _s - _ui * NT_U, _r = _j / NT_R, _jj = _j - _r * NT_R; int _pm, _pn; unit_of(vcu + _ui * G, _pm, _pn); \
        if (_jj < NT_Y) { const size_t _c = (size_t)(256 * _r + 64 * _jj); pa = (const char*)(g.YB + (size_t)_pm * 128 * 1024 + _c); pb = (const char*)(g.WbrT + (size_t)_pn * 256 * 1024 + _c); } \
        else { const size_t _c = (size_t)(64 * (_jj - NT_Y)); pa = (const char*)(g.H + (size_t)_pm * 128 * 1024 + _c); pb = (const char*)(g.WmT + ((size_t)_r * 1024 + _pn * 256) * 1024 + _c); } } while (0)
#define SG_STAGE1(bufoff, gbase, voff) do { _Pragma("unroll") for (int _i = 0; _i < 2; ++_i) \
        __builtin_amdgcn_global_load_lds((const unsigned*)((const char*)(gbase) + (voff)[_i]), (PG8_LAS unsigned*)(lds + (bufoff) + ldsw + _i * 8192), 16, 0, 0); } while (0)
#define SG_STAGE(s, slotoff) do { const char* _pa; const char* _pb; SG_SRC(s, _pa, _pb); SG_STAGE1((slotoff), _pa, voffA); SG_STAGE1((slotoff) + HTB, _pb, voffB); SG_STAGE1((slotoff) + 2 * HTB, _pb + (size_t)128 * 1024 * 2, voffB); } while (0)
#define SG_LDA(dst, so) do { _Pragma("unroll") for (int m = 0; m < 4; ++m) _Pragma("unroll") for (int k = 0; k < 2; ++k) dst[m][k] = *(const PG8_LAS bf16x8*)(lds + (so) + aoff + m * 2048 + k * 1024); } while (0)
#define SG_LDB(dst, so, h) do { _Pragma("unroll") for (int n = 0; n < 2; ++n) _Pragma("unroll") for (int k = 0; k < 2; ++k) dst[n][k] = *(const PG8_LAS bf16x8*)(lds + (so) + HTB * (1 + (h)) + boff + n * 2048 + k * 1024); } while (0)
#define SG_MMA(bj, At, Bt) do { __builtin_amdgcn_s_setprio(1); _Pragma("unroll") for (int m = 0; m < 4; ++m) _Pragma("unroll") for (int n = 0; n < 2; ++n) _Pragma("unroll") for (int k = 0; k < 2; ++k) \
        acc[bj][m][n] = __builtin_amdgcn_mfma_f32_16x16x32_bf16(Bt[n][k], At[m][k], acc[bj][m][n], 0, 0, 0); __builtin_amdgcn_s_setprio(0); } while (0)
#define SG_WAIT_V(n) asm volatile("s_waitcnt vmcnt(" #n ")" ::: "memory")
#define SG_WAIT_L(n) asm volatile("s_waitcnt lgkmcnt(" #n ")" ::: "memory")
#define SG_BAR __builtin_amdgcn_s_barrier()
#define SG_SCHED __builtin_amdgcn_sched_barrier(0)
    f32x4 acc[2][4][2]; u32x4 yp[2][4], mrg[2][4];
#pragma unroll
    for (int b = 0; b < 2; ++b)
#pragma unroll
        for (int m = 0; m < 4; ++m) { yp[b][m] = (u32x4){0u, 0u, 0u, 0u}; mrg[b][m] = (u32x4){0u, 0u, 0u, 0u};
#pragma unroll
            for (int n = 0; n < 2; ++n) acc[b][m][n] = (f32x4){0.f, 0.f, 0.f, 0.f}; }
    bf16x8 At[4][2], B0[2][2], B1[2][2];
    SG_STAGE(0, 0); SG_STAGE(1, SLOT);
    if (wr == 1) SG_BAR;
    SG_WAIT_V(6); SG_BAR; SG_BAR;
    int slot_c = 0, slot_n = 2 * SLOT;
    int j = 0, ui = 0;
#pragma unroll 1
    for (int s = 0; s < ntot; ++s) {
        SG_LDB(B0, slot_c, 0); SG_LDB(B1, slot_c, 1); SG_SCHED; SG_LDA(At, slot_c); SG_STAGE(s + 2, slot_n);
        SG_WAIT_V(6); SG_WAIT_L(0); SG_BAR; SG_MMA(0, At, B0); SG_MMA(1, At, B1); SG_BAR; SG_SCHED;
        slot_c = (slot_c == 2 * SLOT) ? 0 : slot_c + SLOT; slot_n = (slot_n == 2 * SLOT) ? 0 : slot_n + SLOT;
        const int r = j / NT_R, jj = j - r * NT_R;
        if (jj == NT_Y - 1) {
            int pm, pn; unit_of(vcu + ui * G, pm, pn);
            const float* bp = g.bias + r * 1024 + pn * 256 + wc * 32 + 8 * fq;
#pragma unroll
            for (int b = 0; b < 2; ++b) { const f32x4 b0 = *(const f32x4*)(bp + b * 128), b1 = *(const f32x4*)(bp + b * 128 + 4);
#pragma unroll
                for (int m = 0; m < 4; ++m) { const f32x4 v0 = acc[b][m][0], v1 = acc[b][m][1];
                    yp[b][m] = (u32x4){cvt_pk_bf16(v0[0], v0[1]), cvt_pk_bf16(v0[2], v0[3]), cvt_pk_bf16(v1[0], v1[1]), cvt_pk_bf16(v1[2], v1[3])};
                    acc[b][m][0] = b0; acc[b][m][1] = b1; SG_SCHED; } }
        } else if (jj == NT_R - 1) {
#pragma unroll
            for (int b = 0; b < 2; ++b)
#pragma unroll
                for (int m = 0; m < 4; ++m) { const u32x4 y = yp[b][m], o = mrg[b][m]; f32x4 g0 = acc[b][m][0], g1 = acc[b][m][1];
#pragma unroll
                    for (int e = 0; e < 4; ++e) { g0[e] = sigmoidf_(g0[e]); g1[e] = sigmoidf_(g1[e]); }
                    mrg[b][m] = (u32x4){cvt_pk_bf16(bf_lo(o.x) + g0[0] * bf_lo(y.x), bf_hi(o.x) + g0[1] * bf_hi(y.x)), cvt_pk_bf16(bf_lo(o.y) + g0[2] * bf_lo(y.y), bf_hi(o.y) + g0[3] * bf_hi(y.y)),
                                        cvt_pk_bf16(bf_lo(o.z) + g1[0] * bf_lo(y.z), bf_hi(o.z) + g1[1] * bf_hi(y.z)), cvt_pk_bf16(bf_lo(o.w) + g1[2] * bf_lo(y.w), bf_hi(o.w) + g1[3] * bf_hi(y.w))};
                    acc[b][m][0] = (f32x4){0.f, 0.f, 0.f, 0.f}; acc[b][m][1] = (f32x4){0.f, 0.f, 0.f, 0.f}; SG_SCHED; }
            if (r == 3) {
                int pm, pn; unit_of(vcu + ui * G, pm, pn);
                bf16_t* op = g.MG + (size_t)(pm * 128 + wr * 64 + fr) * 1024 + pn * 256 + wc * 32 + 8 * fq;
#pragma unroll
                for (int m = 0; m < 4; ++m)
#pragma unroll
                    for (int b = 0; b < 2; ++b) { *(u32x4*)(op + (size_t)m * 16 * 1024 + b * 128) = mrg[b][m]; mrg[b][m] = (u32x4){0u, 0u, 0u, 0u}; }
            }
        }
        if (++j == NT_U) { j = 0; ++ui; }
    }
    SG_WAIT_V(0);
    if (wr == 0) SG_BAR;
    SG_BAR;
#undef SG_SRC
#undef SG_STAGE1
#undef SG_STAGE
#undef SG_LDA
#undef SG_LDB
#undef SG_MMA
#undef SG_WAIT_V
#undef SG_WAIT_L
#undef SG_BAR
#undef SG_SCHED
}
}
namespace attn_body {
using bf16=__hip_bfloat16;
using bf16x8=__attribute__((ext_vector_type(8)))short;
using s16x4=__attribute__((ext_vector_type(4)))short;
using f32x16=__attribute__((ext_vector_type(16)))float;
using u32x4=__attribute__((ext_vector_type(4)))unsigned;
constexpr int D=64;
constexpr int NW=8,QBLK=32,QB=QBLK*NW,KVBLK=64;
constexpr int PP=2816, YP=1024;
__device__ __forceinline__ int crow(int r,int hi){return (r&3)+8*(r>>2)+4*hi;}
#define SBAR() __builtin_amdgcn_sched_barrier(0)
__device__ __forceinline__ void dmask(f32x16&p0,f32x16&p1,int kb,unsigned lim,int qrel,int hi){
  const float NEG=-INFINITY; const unsigned b0=(unsigned)(kb+4*hi-qrel+128);
  #pragma unroll
  for(int r=0;r<16;++r){const unsigned dd=b0+(unsigned)((r&3)+8*(r>>2)); if(dd>lim)p0[r]=NEG; if(dd+32u>lim)p1[r]=NEG;}
}

constexpr int NSLOT=3, SLOTB=8192;
constexpr int LDS_K=0, LDS_V=NSLOT*SLOTB, LDS_WS=2*NSLOT*SLOTB, LDS_OST=LDS_WS+NW*64*4, LDS_BYTES=LDS_OST+NW*4096;
constexpr float C2=0.125f*1.4426950408889634f;
__device__ __forceinline__ void glds16(const void*gsrc,unsigned lds_dst){unsigned keep;
  asm volatile("s_mov_b32 %0, m0\n\ts_mov_b32 m0, %2\n\ts_nop 0\n\tglobal_load_lds_dwordx4 %1, off\n\ts_mov_b32 m0, %0":"=&s"(keep):"v"(gsrc),"s"(lds_dst):"memory");}
__device__ __forceinline__ float siluf_(float x){ return x*__builtin_amdgcn_rcpf(1.0f+__builtin_amdgcn_exp2f(-1.4426950408889634f*x)); }
__device__ __forceinline__ float max3f(float a,float b,float c){float r;asm("v_max3_f32 %0, %1, %2, %3":"=v"(r):"v"(a),"v"(b),"v"(c));return r;}
__device__ __forceinline__ float max2f(float a,float b){float r;asm("v_max_f32_e32 %0, %1, %2":"=v"(r):"v"(a),"v"(b));return r;}
__device__ __forceinline__ float fadd_s(float a,float b){float r;asm("v_add_f32_e32 %0, %1, %2":"=v"(r):"v"(a),"v"(b));return r;}
__device__ __forceinline__ float fsub_s(float a,float b){float r;asm("v_sub_f32_e32 %0, %1, %2":"=v"(r):"v"(a),"v"(b));return r;}
typedef float f32x2_t __attribute__((ext_vector_type(2))); typedef __bf16 bf16x2_t __attribute__((ext_vector_type(2)));
__device__ __forceinline__ unsigned cvtpk_s(float lo,float hi){f32x2_t v={lo,hi};bf16x2_t b=__builtin_convertvector(v,bf16x2_t);return __builtin_bit_cast(unsigned,b);}
#define WAIT_BAR(N) asm volatile("s_waitcnt vmcnt(" #N ") lgkmcnt(0)\n\ts_barrier":::"memory")

__device__ __forceinline__ void qkt(f32x16&p0,f32x16&p1,const char*Kslot,const bf16x8*qr,const f32x16&negm,int r32,int hi){
  const char*kb=Kslot+hi*1024+r32*16;
  #pragma unroll
  for(int d0=0;d0<4;++d0){
    const bf16x8 b0=*reinterpret_cast<const bf16x8*>(kb+d0*2048);
    const bf16x8 b1=*reinterpret_cast<const bf16x8*>(kb+d0*2048+512);
    if(d0==0){p0=__builtin_amdgcn_mfma_f32_32x32x16_bf16(b0,qr[0],negm,0,0,0);p1=__builtin_amdgcn_mfma_f32_32x32x16_bf16(b1,qr[0],negm,0,0,0);}
    else{p0=__builtin_amdgcn_mfma_f32_32x32x16_bf16(b0,qr[d0],p0,0,0,0);p1=__builtin_amdgcn_mfma_f32_32x32x16_bf16(b1,qr[d0],p1,0,0,0);}}
}
typedef __attribute__((address_space(3))) const char* lds_cptr;
typedef short v4i16_t __attribute__((ext_vector_type(4)));
__device__ __forceinline__ void kload8(bf16x8*kf,lds_cptr kp){
  kf[0]=*(const __attribute__((address_space(3))) bf16x8*)(kp);      kf[1]=*(const __attribute__((address_space(3))) bf16x8*)(kp+512);
  kf[2]=*(const __attribute__((address_space(3))) bf16x8*)(kp+2048); kf[3]=*(const __attribute__((address_space(3))) bf16x8*)(kp+2560);
  kf[4]=*(const __attribute__((address_space(3))) bf16x8*)(kp+4096); kf[5]=*(const __attribute__((address_space(3))) bf16x8*)(kp+4608);
  kf[6]=*(const __attribute__((address_space(3))) bf16x8*)(kp+6144); kf[7]=*(const __attribute__((address_space(3))) bf16x8*)(kp+6656);
}
__device__ __forceinline__ void kload2(bf16x8*kf,lds_cptr kp,int j){ kf[2*j]=*(const __attribute__((address_space(3))) bf16x8*)(kp+j*2048); kf[2*j+1]=*(const __attribute__((address_space(3))) bf16x8*)(kp+j*2048+512); }
__device__ __forceinline__ s16x4 vtr(lds_cptr p){ return __builtin_bit_cast(s16x4,__builtin_amdgcn_ds_read_tr16_b64_v4i16((__attribute__((address_space(3))) v4i16_t*)p)); }
__device__ __forceinline__ float rowmax(const f32x16&p0,const f32x16&p1){
  float a=max3f(p0[0],p0[1],p1[0]),b=max3f(p0[2],p0[3],p1[1]);a=max3f(a,p1[2],p1[3]);
  #pragma unroll
  for(int r=4;r<16;r+=4){a=max3f(a,p0[r],p0[r+1]);b=max3f(b,p0[r+2],p0[r+3]);a=max3f(a,p1[r],p1[r+1]);b=max3f(b,p1[r+2],p1[r+3]);}
  const float m=max2f(a,b);
  auto rr=__builtin_amdgcn_permlane32_swap(__float_as_uint(m),__float_as_uint(m),false,false);
  return max2f(__uint_as_float(rr[0]),__uint_as_float(rr[1]));
}
__device__ __forceinline__ void pv(f32x16*o,int vb,bf16x8 pa0,bf16x8 pa1,bf16x8 pa2,bf16x8 pa3){
  #pragma unroll
  for(int d0=0;d0<2;++d0){s16x4 lo[4],hi[4];
    #pragma unroll
    for(int ks=0;ks<4;++ks){
      asm volatile("ds_read_b64_tr_b16 %0,%1 offset:%c2":"=&v"(lo[ks]):"v"(vb),"i"(d0*4096+ks*1024):"memory");
      asm volatile("ds_read_b64_tr_b16 %0,%1 offset:%c2":"=&v"(hi[ks]):"v"(vb),"i"(d0*4096+ks*1024+512):"memory");}
    asm volatile("s_waitcnt lgkmcnt(0)":::"memory");SBAR();
    #define PK(k) (bf16x8){lo[k][0],lo[k][1],lo[k][2],lo[k][3],hi[k][0],hi[k][1],hi[k][2],hi[k][3]}
    o[d0]=__builtin_amdgcn_mfma_f32_32x32x16_bf16(pa0,PK(0),o[d0],0,0,0);
    o[d0]=__builtin_amdgcn_mfma_f32_32x32x16_bf16(pa1,PK(1),o[d0],0,0,0);
    o[d0]=__builtin_amdgcn_mfma_f32_32x32x16_bf16(pa2,PK(2),o[d0],0,0,0);
    o[d0]=__builtin_amdgcn_mfma_f32_32x32x16_bf16(pa3,PK(3),o[d0],0,0,0);
    #undef PK
  }
}

#ifndef ATTN_STORE16
#define ATTN_STORE16(p,v) (*(u32x4*)(p)=(v))
#endif
template<int MODE,int THRL> __device__ __forceinline__ void attn_unit(const bf16*Pm,bf16*YB,int qrow0,int ctx0,int lat0,int off,int NT,int wq0,int qcol,int kcol,int vcol,int zcol,int ocol,float sinkl2,char*shm){
  int tid_=threadIdx.x; asm volatile("":"+v"(tid_)); const int tid=tid_,lane=tid&63,r32=lane&31,hi=lane>>5; const int wid=__builtin_amdgcn_readfirstlane(tid>>6);
  const bf16*Qw=Pm+(long)(qrow0+wid*QBLK)*PP+qcol;
  const unsigned lds0=(unsigned)(uintptr_t)shm;
  float*wsf=(float*)(shm+LDS_WS)+wid*64;
  const bf16*ksrc=Pm+kcol+(long)lane*PP+wid*8;
  const bf16*vsrc=Pm+vcol+(long)(16*(wid&3)+(lane>>2))*PP+(wid>>2)*32+(lane&3)*8;
  const unsigned kdst=lds0+LDS_K+wid*1024, vdst=lds0+LDS_V+wid*1024;
  #define TROW(t) (((t)<4)?(ctx0+64*(t)):(lat0+64*((t)-4+off)))
  #define DMA_K(t,slot) glds16(ksrc+(long)TROW(t)*PP,(unsigned)__builtin_amdgcn_readfirstlane(kdst+(slot)))
  #define DMA_V(t,slot) glds16(vsrc+(long)TROW(t)*PP,(unsigned)__builtin_amdgcn_readfirstlane(vdst+(slot)))
  const int vb0=(int)(lds0+LDS_V)+((lane>>4)&1)*32+(lane&3)*8+(4*hi+((lane&15)>>2))*64;
  const char*Kbase=shm+LDS_K; bf16x8 kf[8];
  const lds_cptr shm3=(lds_cptr)shm; const lds_cptr kp0=shm3+LDS_K+hi*1024+r32*16; const lds_cptr vp0=shm3+LDS_V+((lane>>4)&1)*32+(lane&3)*8+(4*hi+((lane&15)>>2))*64;
  DMA_K(0,0);DMA_V(0,0);DMA_K(1,SLOTB);
  bf16x8 qr[4];
  #pragma unroll
  for(int d0=0;d0<4;++d0)qr[d0]=*reinterpret_cast<const bf16x8*>(&Qw[(long)r32*PP+d0*16+hi*8]);
  float mhat=0.f,l_reg=0.f;f32x16 o[2];o[0]=f32x16{};o[1]=f32x16{};f32x16 negm=f32x16{}; if(MODE==0){asm volatile("":"+v"(negm));}
  const int qrel=wid*QBLK+r32;
  #define CMASK(P0,P1,t) do{ if(MODE==1){ dmask(P0,P1,64*((t)-4)-wq0,((t)>=4)?256u:~0u,qrel,hi); } }while(0)
  bool resc=false;
  #define START(P0,P1) do{ const float rm=rowmax(P0,P1); resc=false; \
    { const float dl=rm; mhat=fadd_s(mhat,dl); \
      _Pragma("unroll") for(int r=0;r<16;++r){P0[r]=fsub_s(P0[r],dl);P1[r]=fsub_s(P1[r],dl);} \
      if(MODE==0){ _Pragma("unroll") for(int r=0;r<16;++r)negm[r]=-mhat; asm volatile("":"+v"(negm)); } } \
    _Pragma("unroll") for(int r=0;r<16;++r)P0[r]=__builtin_amdgcn_exp2f(P0[r]); }while(0)
  #define RESC() do{ if(resc){ asm volatile("s_waitcnt lgkmcnt(0)":::"memory"); \
      _Pragma("unroll") for(int d_=0;d_<2;++d_) _Pragma("unroll") for(int r=0;r<16;++r)o[d_][r]*=wsf[crow(r,hi)]; } }while(0)
  f32x16 pA0,pA1,pB0,pB1;
  int sl_prev=0,sl_cur=0,sl_next=SLOTB;
  #define ROT() do{sl_prev=sl_cur;sl_cur=sl_next;sl_next=(sl_next==(NSLOT-1)*SLOTB)?0:sl_next+SLOTB;}while(0)
  DMA_K(2,2*SLOTB);
  WAIT_BAR(3);
  qkt(pA0,pA1,Kbase,qr,negm,r32,hi);asm volatile("s_nop 15\n\ts_nop 7":"+v"(pA0),"+v"(pA1));CMASK(pA0,pA1,0);
  START(pA0,pA1);
  _Pragma("unroll") for(int r=0;r<16;++r)pA1[r]=__builtin_amdgcn_exp2f(pA1[r]);
  WAIT_BAR(0);
  DMA_K(3,0);DMA_V(1,SLOTB);
  ROT();
  kload8(kf,kp0+sl_cur);
  WAIT_BAR(2);
  s16x4 vlo[8],vhi[8]; u32x4 pw0,pw1,pw2,pw3;
  #define PKW(P,B) cvtpk_s(P[B],P[B+1])
  #define PAF(k) __builtin_bit_cast(bf16x8,pw##k)
  #define VFR(i) (bf16x8){vlo[i][0],vlo[i][1],vlo[i][2],vlo[i][3],vhi[i][0],vhi[i][1],vhi[i][2],vhi[i][3]}
  #define PIN(x) asm volatile("":"+v"(x))
  #define MX3(a,b,c) __builtin_fmaxf(__builtin_fmaxf((a),(b)),(c))
  #define GAPA(MF,A0,A1,A2,A3,W0,W1,PW) do{ MF; sacc+=A0; sacc+=A1; sacc+=A2; sacc+=A3; PIN(sacc); W0; W1; PIN(PW); SBAR(); }while(0)
  #define EX(v) __builtin_amdgcn_exp2f(v)
  #define GAPB(MF,X,B) do{ MF; X[B]=EX(X[B]); X[B+1]=EX(X[B+1]); X[B+2]=EX(X[B+2]); X[B+3]=EX(X[B+3]); PIN(X); SBAR(); }while(0)
  #define VRD(i) do{ vlo[i]=vtr(vp_+(((i)>>2)*4096+((i)&3)*1024)); vhi[i]=vtr(vp_+(((i)>>2)*4096+((i)&3)*1024+512)); }while(0)
  #define KRD(G,j) do{ if(G){ kload2(kf,kp0+sl_next,j); SBAR(); } }while(0)
  #define STEP(C0,C1,P0,P1,t,GK,GV,GL) do{ SBAR(); \
    const lds_cptr vp_=vp0+sl_prev; \
    VRD(0); SBAR(); float sacc=(P0[0]+P0[1]); \
    GAPA(C0=__builtin_amdgcn_mfma_f32_32x32x16_bf16(kf[0],qr[0],negm,0,0,0), P0[2],P0[3],P0[4],P0[5],     pw0[0]=PKW(P0,0), pw0[1]=PKW(P0,2), pw0); \
    VRD(4); SBAR(); GAPA(C1=__builtin_amdgcn_mfma_f32_32x32x16_bf16(kf[1],qr[0],negm,0,0,0), P0[6],P0[7],P0[8],P0[9],     pw0[2]=PKW(P0,4), pw0[3]=PKW(P0,6), pw0); \
    VRD(1); SBAR(); GAPA(C0=__builtin_amdgcn_mfma_f32_32x32x16_bf16(kf[2],qr[1],C0,0,0,0),   P0[10],P0[11],P0[12],P0[13], pw1[0]=PKW(P0,8), pw1[1]=PKW(P0,10), pw1); \
    VRD(5); SBAR(); GAPA(C1=__builtin_amdgcn_mfma_f32_32x32x16_bf16(kf[3],qr[1],C1,0,0,0),   P0[14],P0[15],P1[0],P1[1],   pw1[2]=PKW(P0,12),pw1[3]=PKW(P0,14), pw1); \
    VRD(2); SBAR(); GAPA(C0=__builtin_amdgcn_mfma_f32_32x32x16_bf16(kf[4],qr[2],C0,0,0,0),   P1[2],P1[3],P1[4],P1[5],     pw2[0]=PKW(P1,0), pw2[1]=PKW(P1,2), pw2); \
    VRD(6); SBAR(); GAPA(C1=__builtin_amdgcn_mfma_f32_32x32x16_bf16(kf[5],qr[2],C1,0,0,0),   P1[6],P1[7],P1[8],P1[9],     pw2[2]=PKW(P1,4), pw2[3]=PKW(P1,6), pw2); \
    VRD(3); SBAR(); GAPA(C0=__builtin_amdgcn_mfma_f32_32x32x16_bf16(kf[6],qr[3],C0,0,0,0),   P1[10],P1[11],P1[12],P1[13], pw3[0]=PKW(P1,8), pw3[1]=PKW(P1,10), pw3); \
    VRD(7); SBAR(); GAPA(C1=__builtin_amdgcn_mfma_f32_32x32x16_bf16(kf[7],qr[3],C1,0,0,0),   P1[14],P1[15],0.f,0.f,       pw3[2]=PKW(P1,12),pw3[3]=PKW(P1,14), pw3); \
    l_reg+=sacc; \
    if(GK){DMA_K((t)+3,sl_cur);} if(GV){DMA_V((t)+1,sl_next);} \
    CMASK(C0,C1,t); \
    { float a=MX3(C0[0],C0[1],C1[0]),b=MX3(C0[2],C0[3],C1[1]); a=MX3(a,C1[2],C1[3]); \
      _Pragma("unroll") for(int r=4;r<16;r+=4){a=MX3(a,C0[r],C0[r+1]);b=MX3(b,C0[r+2],C0[r+3]);a=MX3(a,C1[r],C1[r+1]);b=MX3(b,C1[r+2],C1[r+3]);} \
      float rm=__builtin_fmaxf(a,b); { auto rr=__builtin_amdgcn_permlane32_swap(__float_as_uint(rm),__float_as_uint(rm),false,false); rm=__builtin_fmaxf(__uint_as_float(rr[0]),__uint_as_float(rr[1])); } \
      resc=false; if(MODE==1) rm-=mhat; \
      if(__builtin_expect(__any(rm>(float)THRL),0)){ const float dl=__builtin_fmaxf(rm,0.f); mhat+=dl; \
        if(MODE==0){ _Pragma("unroll") for(int r=0;r<16;++r){C0[r]-=dl;C1[r]-=dl;} \
          _Pragma("unroll") for(int r=0;r<16;++r)negm[r]=-mhat; asm volatile("":"+v"(negm)); } \
        const float f=__builtin_amdgcn_exp2f(-dl); l_reg*=f; if(hi==0)wsf[r32]=f; resc=true; } \
      if(MODE==1){ _Pragma("unroll") for(int r=0;r<16;++r){C0[r]-=mhat;C1[r]-=mhat;} } } \
    SBAR(); \
    GAPB(o[0]=__builtin_amdgcn_mfma_f32_32x32x16_bf16(PAF(0),VFR(0),o[0],0,0,0), C0,0); \
    GAPB(o[1]=__builtin_amdgcn_mfma_f32_32x32x16_bf16(PAF(0),VFR(4),o[1],0,0,0), C0,4); \
    KRD(GL,0); GAPB(o[0]=__builtin_amdgcn_mfma_f32_32x32x16_bf16(PAF(1),VFR(1),o[0],0,0,0), C0,8); \
    KRD(GL,1); GAPB(o[1]=__builtin_amdgcn_mfma_f32_32x32x16_bf16(PAF(1),VFR(5),o[1],0,0,0), C0,12); \
    KRD(GL,2); GAPB(o[0]=__builtin_amdgcn_mfma_f32_32x32x16_bf16(PAF(2),VFR(2),o[0],0,0,0), C1,0); \
    KRD(GL,3); GAPB(o[1]=__builtin_amdgcn_mfma_f32_32x32x16_bf16(PAF(2),VFR(6),o[1],0,0,0), C1,4); \
    GAPB(o[0]=__builtin_amdgcn_mfma_f32_32x32x16_bf16(PAF(3),VFR(3),o[0],0,0,0), C1,8); \
    GAPB(o[1]=__builtin_amdgcn_mfma_f32_32x32x16_bf16(PAF(3),VFR(7),o[1],0,0,0), C1,12); \
    }while(0)
  int t=1;
  if(MODE==0) for(;t+5<NT;t+=2){
    STEP(pB0,pB1,pA0,pA1,t,true,true,true);     WAIT_BAR(2); RESC(); ROT();
    STEP(pA0,pA1,pB0,pB1,t+1,true,true,true);   WAIT_BAR(2); RESC(); ROT();
  }
  #define ENDW(tt) do{ if((tt)+3<NT){WAIT_BAR(2);} else if((tt)+2<NT){WAIT_BAR(1);} else {WAIT_BAR(0);} }while(0)
  for(;t+1<NT;t+=2){
    STEP(pB0,pB1,pA0,pA1,t,(t+3<NT),(t+1<NT),(t+1<NT));       ENDW(t);   RESC(); ROT();
    STEP(pA0,pA1,pB0,pB1,t+1,(t+4<NT),(t+2<NT),(t+2<NT));     ENDW(t+1); RESC(); ROT();
  }
  STEP(pB0,pB1,pA0,pA1,NT-1,false,false,false); RESC();
  { float sacc=pB0[0]+pB0[1]; _Pragma("unroll") for(int r=2;r<16;++r)sacc+=pB0[r]; _Pragma("unroll") for(int r=0;r<16;++r)sacc+=pB1[r]; l_reg+=sacc;
    pw0=(u32x4){PKW(pB0,0),PKW(pB0,2),PKW(pB0,4),PKW(pB0,6)};pw1=(u32x4){PKW(pB0,8),PKW(pB0,10),PKW(pB0,12),PKW(pB0,14)};pw2=(u32x4){PKW(pB1,0),PKW(pB1,2),PKW(pB1,4),PKW(pB1,6)};pw3=(u32x4){PKW(pB1,8),PKW(pB1,10),PKW(pB1,12),PKW(pB1,14)};
    SBAR(); pv(o,vb0+sl_cur,PAF(0),PAF(1),PAF(2),PAF(3)); }
  #undef PKW
  #undef PAF
  #undef VFR
  #undef PIN
  #undef MX3
  #undef GAPA
  #undef GAPB
  #undef EX
  #undef VRD
  #undef KRD
  #undef STEP
  #undef ENDW
  {auto rr=__builtin_amdgcn_permlane32_swap(__float_as_uint(l_reg),__float_as_uint(l_reg),false,false);l_reg=__uint_as_float(rr[0])+__uint_as_float(rr[1]);}
  if(MODE==1){ l_reg+=__builtin_amdgcn_exp2f(sinkl2-mhat); }
  if(hi==0)wsf[32+r32]=l_reg;asm volatile("s_waitcnt lgkmcnt(0)":::"memory");
  float rli[16];
  #pragma unroll
  for(int r=0;r<16;++r)rli[r]=__builtin_amdgcn_rcpf(wsf[32+crow(r,hi)]);
  bf16*Ow=YB+(long)(qrow0+wid*QBLK)*YP+ocol; const bf16*Zw=Pm+(long)(qrow0+wid*QBLK)*PP+zcol;
  { bf16*stg=(bf16*)(shm+LDS_OST)+wid*2048;
    #pragma unroll
    for(int r=0;r<16;++r){const int orow=crow(r,hi);
      #pragma unroll
      for(int d0=0;d0<2;++d0)stg[orow*64+d0*32+r32]=__float2bfloat16(o[d0][r]*rli[r]);}
    asm volatile("s_waitcnt lgkmcnt(0)":::"memory");
    #pragma unroll
    for(int i=0;i<4;++i){const int row=i*8+(lane>>3),ch=lane&7; const u32x4 v=*(const u32x4*)(stg+row*64+ch*8); const u32x4 z=*(const u32x4*)(Zw+(long)row*PP+ch*8); u32x4 w;
      #define GATE2(vv,zz) cvtpk_s(__uint_as_float((vv)<<16)*siluf_(__uint_as_float((zz)<<16)),__uint_as_float((vv)&0xffff0000u)*siluf_(__uint_as_float((zz)&0xffff0000u)))
      w.x=GATE2(v.x,z.x); w.y=GATE2(v.y,z.y); w.z=GATE2(v.z,z.z); w.w=GATE2(v.w,z.w);
      #undef GATE2
      *(u32x4*)(Ow+(long)row*YP+ch*8)=w;} }
  asm volatile("s_waitcnt lgkmcnt(0)\n\ts_barrier":::"memory");
  #undef DMA_K
  #undef DMA_V
  #undef CMASK
  #undef START
  #undef RESC
  #undef ROT
  #undef TROW
}
#undef SBAR
#undef WAIT_BAR
}

constexpr int NWAVES = 8;
constexpr int DM = 1024, SEQ = 8192, NCTX = 256, NB = 2;
constexpr int M_LAT = NB * SEQ, M_CTX = NB * NCTX, M_ALL = M_LAT + M_CTX;
constexpr int PW = 2816;
constexpr float RMS_EPS = 1e-6f;
constexpr float QSCALE = 0.125f * 1.4426950408889634f;
constexpr int C_AQ = 0, C_AK = 256, C_AV = 384, C_AZ = 512, C_DQ = 768, C_DK = 1024, C_DV = 1152, C_DZ = 1280, C_BF = 1536, C_BZ = 1792, C_CU = 2048, C_CV = 2304, C_CZ = 2560;

constexpr size_t MiB = 1u << 20;
constexpr size_t WS_CTL = 0, CTL_ZERO_BYTES = 1 * MiB;
constexpr size_t WS_MOD = 1 * MiB;
constexpr size_t WS_TAB = 2 * MiB;
constexpr size_t TAB_MA = 0, TAB_128 = 131072, TAB_64 = 229376, TAB_256 = 245760, TAB_WSP = 507904, TAB_ONES = 786432, TAB_BIASB = 1048576;
constexpr size_t WS_WIN = 4 * MiB, WS_WM = 16 * MiB, WS_WBR = 32 * MiB, WS_WOUT = 36 * MiB;
constexpr size_t WS_XC1 = 40 * MiB;
constexpr size_t WS_H = 42 * MiB, WS_YB = 75 * MiB, WS_T1 = 108 * MiB, WS_P = 124 * MiB;
constexpr size_t WS_GT = WS_P, WS_MG = WS_P + 40 * MiB;
constexpr size_t WS_MGC = 216 * MiB;
constexpr size_t WS_GTC = 218 * MiB;
constexpr size_t WS_END = 222 * MiB;
constexpr int CW_BAR = 4096;

constexpr int RING_BYTES = 147456, LDSCTL_OFF = RING_BYTES, MISC_OFF = LDSCTL_OFF + 320, LDS_BYTES = RING_BYTES + 1024;

#define GAS __attribute__((address_space(1)))
#define LAS __attribute__((address_space(3)))
typedef unsigned short bf16;
typedef unsigned v4u __attribute__((ext_vector_type(4)));
typedef unsigned v2u __attribute__((ext_vector_type(2)));
typedef float f32x4 __attribute__((ext_vector_type(4)));
typedef float f32x16 __attribute__((ext_vector_type(16)));
typedef short bf16x8 __attribute__((ext_vector_type(8)));
typedef GAS unsigned gu32;
#define RLX_AGENT __ATOMIC_RELAXED, __HIP_MEMORY_SCOPE_AGENT
#define LDS_WAIT() asm volatile("s_waitcnt lgkmcnt(0)" ::: "memory")
#define MFMA32(a, b, c) __builtin_amdgcn_mfma_f32_32x32x16_bf16((a), (b), (c), 0, 0, 0)
#define DI __device__ __forceinline__
DI unsigned f2bf(float f) { unsigned u = __builtin_bit_cast(unsigned, f); return (u + 0x7fffu + ((u >> 16) & 1u)) >> 16; }
DI unsigned pk2(float lo, float hi) { return f2bf(lo) | (f2bf(hi) << 16); }
DI float bf2f(bf16 v) { return __uint_as_float((unsigned)v << 16); }
DI float wlo(unsigned w) { return __uint_as_float(w << 16); }
DI float whi(unsigned w) { return __uint_as_float(w & 0xffff0000u); }
DI int crow(int reg, int h) { return (reg & 3) + 8 * (reg >> 2) + 4 * h; }
DI int krow(int s, int h, int j) { return 16 * s + 8 * (j >> 2) + 4 * h + (j & 3); }
DI float siluf(float x) { return x * __builtin_amdgcn_rcpf(1.0f + __builtin_amdgcn_exp2f(-1.4426950408889634f * x)); }
DI float geluf(float v) {
    const float av = __builtin_fabsf(v), d = av * 0.2316418882f + 1.0f, t = __builtin_amdgcn_rcpf(d);
    float q = t * 0.5307027145f + (-0.7265760135f); q = q * t + 0.7107068705f; q = q * t + (-0.142248368f); q = q * t + 0.127414796f; q = q * t;
    const float e = __builtin_amdgcn_exp2f((v * v) * (-0.72134752044f)), m = v * (q * e), r = v - m;
    return v < 0.f ? m : r;
}
typedef float f32x2_t __attribute__((ext_vector_type(2))); typedef __bf16 bf16x2_t __attribute__((ext_vector_type(2)));
DI unsigned cvtpk(float lo, float hi) { f32x2_t v = {lo, hi}; bf16x2_t b = __builtin_convertvector(v, bf16x2_t); return __builtin_bit_cast(unsigned, b); }
DI bf16x8 pack_step(const f32x16& x, int s) {
    v4u p; p.x = cvtpk(x[8 * s], x[8 * s + 1]); p.y = cvtpk(x[8 * s + 2], x[8 * s + 3]); p.z = cvtpk(x[8 * s + 4], x[8 * s + 5]); p.w = cvtpk(x[8 * s + 6], x[8 * s + 7]);
    return __builtin_bit_cast(bf16x8, p);
}
DI float shx(float v, int o, int lane) { return __int_as_float(__builtin_amdgcn_ds_bpermute((lane ^ o) << 2, __float_as_int(v))); }
DI float wave_sum(float v, int lane) {
#pragma unroll
    for (int o = 1; o < 64; o <<= 1) v += shx(v, o, lane);
    return v;
}

#define XB_TMO      128
#define XB_XCNT(j)  (256  + 64 * (j))
#define XB_XSUB(j)  (1280 + 64 * (j))
#define XB_XGEN(j)  (2304 + 64 * (j))
#define XB_TOP      3328
#define XB_TOPGEN   3392
#define XCD_BAR_WORDS 3456
#define XB_SPIN_CAP (1u << 22)
DI unsigned xb_ld(unsigned* p)              { return __hip_atomic_load(p, __ATOMIC_RELAXED, __HIP_MEMORY_SCOPE_AGENT); }
DI unsigned xb_add(unsigned* p, unsigned v) { return __hip_atomic_fetch_add(p, v, __ATOMIC_RELAXED, __HIP_MEMORY_SCOPE_AGENT); }
DI unsigned xb_xcc_id() { return (unsigned)__builtin_amdgcn_s_getreg((3 << 11) | 20) & 0xFu; }
#define XB_SPIN(cond, bar) do { unsigned _sp = 0; while (cond) { __builtin_amdgcn_s_sleep(1); \
    if ((++_sp & 255u) == 0u) { if (xb_ld(&(bar)[XB_TMO])) break; if (_sp > XB_SPIN_CAP) { atomicAdd(&(bar)[XB_TMO], 1u); break; } } } } while (0)
struct XcdBarrier { unsigned* bar; unsigned x; volatile LAS unsigned* st; };
DI XcdBarrier xcd_barrier_post(unsigned* bar, volatile LAS unsigned* st) {
    XcdBarrier b; b.bar = bar; b.x = xb_xcc_id(); b.st = st;
    if (threadIdx.x == 0) (void)xb_add(&bar[XB_XCNT(b.x)], 1u);
    return b;
}
DI void xcd_barrier_complete(unsigned* bar, unsigned x, unsigned& nloc, unsigned& nx) {
    const unsigned G = gridDim.x * gridDim.y * gridDim.z;
    unsigned sum, cnt, mine, sp = 0u;
    for (;;) {
        sum = 0u; cnt = 0u; mine = 0u;
#pragma unroll
        for (unsigned j = 0; j < 16; ++j) { const unsigned c = xb_ld(&bar[XB_XCNT(j)]); sum += c; cnt += (c > 0u) ? 1u : 0u; mine = (j == x) ? c : mine; }
        if (sum == G) break;
        __builtin_amdgcn_s_sleep(1);
        if ((++sp & 255u) == 0u) { if (xb_ld(&bar[XB_TMO])) break; if (sp > XB_SPIN_CAP) { atomicAdd(&bar[XB_TMO], 1u); break; } }
    }
    nloc = mine > 0u ? mine : 1u; nx = cnt > 0u ? cnt : 1u;
}
DI void xcd_barrier(const XcdBarrier& b) {
    asm volatile("s_waitcnt vmcnt(0)" ::: "memory");
    __syncthreads();
    if (threadIdx.x == 0) {
        unsigned* bar = b.bar;
        __builtin_amdgcn_s_waitcnt(0);
        unsigned nloc = b.st[0], nx = b.st[1];
        if (nloc == 0u) { xcd_barrier_complete(bar, b.x, nloc, nx); b.st[0] = nloc; b.st[1] = nx; }
        const unsigned old = xb_add(&bar[XB_XSUB(b.x)], 1u);
        const unsigned gen = old / nloc;
        if (old + 1u == (gen + 1u) * nloc) {
            __builtin_amdgcn_fence(__ATOMIC_RELEASE, "agent");
            asm volatile("s_waitcnt vmcnt(0)" ::: "memory");
            const unsigned og = xb_add(&bar[XB_TOP], 1u);
            const unsigned tg = og / nx;
            if (og + 1u == (tg + 1u) * nx) xb_add(&bar[XB_TOPGEN], 1u);
            else XB_SPIN(xb_ld(&bar[XB_TOPGEN]) == tg, bar);
            __builtin_amdgcn_fence(__ATOMIC_ACQUIRE, "agent");
            xb_add(&bar[XB_XGEN(b.x)], 1u);
            asm volatile("s_waitcnt vmcnt(0)" ::: "memory");
        } else {
            XB_SPIN(xb_ld(&bar[XB_XGEN(b.x)]) == gen, bar);
            __builtin_amdgcn_fence(__ATOMIC_ACQUIRE, "agent");
            asm volatile("s_waitcnt vmcnt(0)" ::: "memory");
        }
    }
    __syncthreads();
}

struct Frame {
    LAS unsigned char* lds;
    int tid, lane, wave, vcu, G;
};

DI void p0_transpose_item(const float* W, int N, bf16* WT, int ldt, int row_off, int col_off, LAS float* scr, int item, int lane) {
    const int nblk = N / 32, kb = item / nblk, nb = item % nblk, k0 = 64 * kb, n0 = 32 * nb;
#pragma unroll 8
    for (int i = 0; i < 32; ++i) { const int kk = 2 * i + (lane >> 5); scr[kk * 33 + (lane & 31)] = W[(size_t)(k0 + kk) * N + n0 + (lane & 31)]; }
    LDS_WAIT(); asm volatile("" ::: "memory");
    const int c = lane & 7;
#pragma unroll
    for (int j = 0; j < 4; ++j) { const int n = (lane >> 3) + 8 * j; const LAS float* s = scr + (8 * c) * 33 + n;
        v4u o; o.x = pk2(s[0 * 33], s[1 * 33]); o.y = pk2(s[2 * 33], s[3 * 33]); o.z = pk2(s[4 * 33], s[5 * 33]); o.w = pk2(s[6 * 33], s[7 * 33]);
        *(GAS v4u*)(WT + (size_t)(row_off + n0 + n) * ldt + col_off + k0 + 8 * c) = o; }
    LDS_WAIT(); asm volatile("" ::: "memory");
}

struct Args { const float* in[20]; float* out; unsigned char* ws; };
enum { I_X = 0, I_C, I_CTX, I_CCTX, I_NORMW, I_WADA, I_BADA, I_WIN, I_QNA, I_KNA, I_QND, I_KND, I_SINK, I_WFNET, I_WSP, I_BSP, I_WBR, I_WMERGE, I_BMERGE, I_WOUT };

DI void p0_prologue(const Frame& F, const Args& a) {
    unsigned char* ws = a.ws;
    for (int u = F.vcu; u < 96; u += F.G) {
        const int l = u / 48, j0 = 64 * (u % 48);
        LAS float* sl = (LAS float*)F.lds; LAS float* red = sl + 3072;
        for (int i = F.tid; i < 3072; i += 512) { const int v = i >> 10, k = i & 1023; const float cv = (v < 2) ? a.in[I_C][v * 1024 + k] : a.in[I_CCTX][k]; sl[i] = siluf(cv); }
        __syncthreads();
        float a0 = 0.f, a1 = 0.f, a2 = 0.f;
        const float* wp = a.in[I_WADA] + (size_t)l * 1024 * 3072 + (size_t)(128 * F.wave) * 3072 + j0 + F.lane;
#pragma unroll 32
        for (int kk = 0; kk < 128; ++kk) { const float w = wp[(size_t)kk * 3072]; const int k = 128 * F.wave + kk; a0 += sl[k] * w; a1 += sl[1024 + k] * w; a2 += sl[2048 + k] * w; }
        red[(F.wave * 3 + 0) * 64 + F.lane] = a0; red[(F.wave * 3 + 1) * 64 + F.lane] = a1; red[(F.wave * 3 + 2) * 64 + F.lane] = a2;
        __syncthreads();
        if (F.tid < 192) { const int v = F.tid >> 6, jj = F.tid & 63; float s = a.in[I_BADA][l * 3072 + j0 + jj];
#pragma unroll
            for (int w = 0; w < 8; ++w) s += red[(w * 3 + v) * 64 + jj];
            ((float*)(ws + WS_MOD))[(l * 3 + v) * 3072 + j0 + jj] = s; }
        __syncthreads();
    }
    {
        LAS float* scr = (LAS float*)(F.lds + F.wave * 16384);
        const int gw = F.vcu * NWAVES + F.wave, NGW = F.G * NWAVES;
        constexpr int I_IN = 16 * 88, I_M = 16 * 128, I_O = 16 * 32, I_B = 4 * 32, PER_L = I_IN + I_M + I_O + 4 * I_B;
        for (int it = gw; it < 2 * PER_L; it += NGW) {
            const int l = it / PER_L; int r = it % PER_L;
            if (r < I_IN) { p0_transpose_item(a.in[I_WIN] + (size_t)l * 1024 * PW, PW, (bf16*)(ws + WS_WIN) + (size_t)l * PW * 1024, 1024, 0, 0, scr, r, F.lane); continue; } r -= I_IN;
            if (r < I_M) { p0_transpose_item(a.in[I_WMERGE] + (size_t)l * 1024 * 4096, 4096, (bf16*)(ws + WS_WM) + (size_t)l * 4096 * 1024, 1024, 0, 0, scr, r, F.lane); continue; } r -= I_M;
            if (r < I_O) { p0_transpose_item(a.in[I_WOUT] + (size_t)l * 1024 * 1024, 1024, (bf16*)(ws + WS_WOUT) + (size_t)l * 1024 * 1024, 1024, 0, 0, scr, r, F.lane); continue; } r -= I_O;
            { const int br = r / I_B; r -= br * I_B;
              p0_transpose_item(a.in[I_WBR] + ((size_t)l * 4 + br) * 256 * 1024, 1024, (bf16*)(ws + WS_WBR) + (size_t)l * 1024 * 1024, 1024, 0, 256 * br, scr, r, F.lane); }
        }
    }
    {
        const int gt = F.vcu * 512 + F.tid, NGT = F.G * 512;
        bf16* tab = (bf16*)(ws + WS_TAB);
        for (int e = gt; e < 65536; e += NGT) {
            const int l = e >> 15, g = (e >> 13) & 3, col = (e >> 6) & 127, c = e & 63, d = col & 63;
            const float* wf = a.in[I_WFNET] + ((size_t)(l * 4 + g) * 64) * 64 + d; float s = 0.f;
            for (int j = 0; j < 64; ++j) { const float rev = (float)((c * j) & 63) * (1.0f / 64.0f); const float tw = (col < 64) ? __builtin_amdgcn_cosf(rev) : -__builtin_amdgcn_sinf(rev); s += tw * wf[j * 64]; }
            tab[TAB_MA / 2 + e] = (bf16)f2bf(s);
        }
        for (int e = gt; e < 49152; e += NGT) {
            const int mat = e / 16384, rem = e % 16384, k1b = rem >> 12, nb = (rem >> 10) & 3, s = (rem >> 9) & 1, ln = (rem >> 3) & 63, j = rem & 7;
            const int n1 = 32 * nb + krow(s, ln >> 5, j), k1 = 32 * k1b + (ln & 31); const float rev = (float)((n1 * k1) & 127) * (1.0f / 128.0f);
            const float v = (mat == 0) ? __builtin_amdgcn_cosf(rev) : (mat == 1) ? __builtin_amdgcn_sinf(rev) : -__builtin_amdgcn_sinf(rev);
            tab[TAB_128 / 2 + e] = (bf16)f2bf(v);
        }
        for (int e = gt; e < 8192; e += NGT) {
            const int mat = e >> 12, k2 = (e >> 6) & 63, n2 = e & 63; const float rev = (float)((k2 * n2) & 63) * (1.0f / 64.0f);
            tab[TAB_64 / 2 + e] = (bf16)f2bf(mat == 0 ? __builtin_amdgcn_cosf(rev) : __builtin_amdgcn_sinf(rev));
        }
        for (int e = gt; e < 131072; e += NGT) {
            const int mat = e >> 16, rem = e & 65535, kb = rem >> 13, nb = (rem >> 10) & 7, s = (rem >> 9) & 1, ln = (rem >> 3) & 63, j = rem & 7;
            const int n = 32 * nb + krow(s, ln >> 5, j), k = 32 * kb + (ln & 31); const float rev = (float)((n * k) & 255) * (1.0f / 256.0f);
            tab[TAB_256 / 2 + e] = (bf16)f2bf(mat == 0 ? __builtin_amdgcn_cosf(rev) : __builtin_amdgcn_sinf(rev));
        }
        for (int e = gt; e < 131072; e += NGT) tab[TAB_WSP / 2 + e] = (bf16)f2bf(a.in[I_WSP][e]);
        for (int e = gt; e < M_CTX * 1024 / 4; e += NGT) { ((f32x4*)(ws + WS_XC1))[e] = ((const f32x4*)a.in[I_CTX])[e]; ((f32x4*)(ws + WS_MGC))[e] = (f32x4){0.f, 0.f, 0.f, 0.f}; }
        for (int e = gt; e < 4096; e += NGT) tab[TAB_ONES / 2 + e] = (bf16)(((e & 31) == 0) ? 0x3f80 : 0);
        for (int e = gt; e < 262144; e += NGT) tab[TAB_BIASB / 2 + e] = (bf16)(((e & 31) == 0) ? f2bf(a.in[I_BMERGE][e >> 5]) : 0u);
    }
}

DI void p1_modrms(const Frame& F, const Args& a, int l, const float* xlat, const float* xctx, int with_ctx) {
    const float* mod = (const float*)(a.ws + WS_MOD) + (size_t)l * 3 * 3072;
    const float* nw = a.in[I_NORMW] + l * 1024;
    bf16* H = (bf16*)(a.ws + WS_H);
    const int gw = F.vcu * NWAVES + F.wave, NGW = F.G * NWAVES;
    const int nrows = with_ctx ? M_ALL : M_LAT;
    int vcur = -1; f32x4 av[4], bv[4];
    for (int row = gw; row < nrows; row += NGW) {
        const int v = row < SEQ ? 0 : (row < M_LAT ? 1 : 2);
        if (v != vcur) { vcur = v;
#pragma unroll
            for (int j = 0; j < 4; ++j) { const int c = 4 * (F.lane + 64 * j); const f32x4 w = *(const f32x4*)(nw + c), sc = *(const f32x4*)(mod + v * 3072 + 1024 + c);
                av[j] = w * (sc + 1.0f); bv[j] = *(const f32x4*)(mod + v * 3072 + c); } }
        const float* xr = (row < M_LAT) ? xlat + (size_t)row * 1024 : xctx + (size_t)(row - M_LAT) * 1024;
        f32x4 x[4]; float ss = 0.f;
#pragma unroll
        for (int j = 0; j < 4; ++j) { x[j] = *(const f32x4*)(xr + 4 * (F.lane + 64 * j)); ss += (x[j].x * x[j].x + x[j].y * x[j].y) + (x[j].z * x[j].z + x[j].w * x[j].w); }
        const float rstd = __builtin_amdgcn_rsqf(wave_sum(ss, F.lane) * (1.0f / 1024.0f) + RMS_EPS);
#pragma unroll
        for (int j = 0; j < 4; ++j) { const f32x4 h = x[j] * rstd * av[j] + bv[j]; v2u o; o.x = pk2(h.x, h.y); o.y = pk2(h.z, h.w);
            *(v2u*)(H + (size_t)row * 1024 + 4 * (F.lane + 64 * j)) = o; }
    }
}

DI void p3_prep(const Frame& F, const Args& a, int l, bf16* P) {
    const int gw = F.vcu * NWAVES + F.wave, NGW = F.G * NWAVES;
    const int d = F.lane;
    const float wqa = a.in[I_QNA][l * 64 + d], wka = a.in[I_KNA][l * 64 + d], wqd = a.in[I_QND][l * 64 + d], wkd = a.in[I_KND][l * 64 + d];
    const float inv = __builtin_amdgcn_exp2f(-(float)(d & 15) * (13.287712379549449f / 16.0f));
    const float sgn = (d & 16) ? 1.0f : -1.0f;
    const int nrows = M_ALL;
    for (int row = gw; row < nrows; row += NGW) {
        const bool isctx = row >= M_LAT;
        const int n = row & (SEQ - 1);
        float cs = 1.0f, sn = 0.0f;
        if (!isctx) { const float pos = (float)((d < 32) ? (n >> 6) : (n & 63)); const float rev = pos * inv * 0.15915494309189535f; cs = __builtin_amdgcn_cosf(rev); sn = __builtin_amdgcn_sinf(rev); }
        bf16* pr = P + (size_t)row * PW;
        const bool qok = !(isctx && l == 1);
        float v[12];
#pragma unroll
        for (int s = 0; s < 12; ++s) { const int col = (s < 4) ? C_AQ + 64 * s : (s < 6) ? C_AK + 64 * (s - 4) : (s < 10) ? C_DQ + 64 * (s - 6) : C_DK + 64 * (s - 10);
            const bool isq = (s < 4) || (s >= 6 && s < 10);
            v[s] = (isq && !qok) ? 0.f : bf2f(pr[col + d]); }
#pragma unroll
        for (int s = 0; s < 12; ++s) { const int col = (s < 4) ? C_AQ + 64 * s : (s < 6) ? C_AK + 64 * (s - 4) : (s < 10) ? C_DQ + 64 * (s - 6) : C_DK + 64 * (s - 10);
            const bool isq = (s < 4) || (s >= 6 && s < 10);
            const float w = (s < 4) ? wqa : (s < 6) ? wka : (s < 10) ? wqd : wkd;
            const float ss = wave_sum(v[s] * v[s], d);
            float y = v[s] * __builtin_amdgcn_rsqf(ss * (1.0f / 64.0f) + RMS_EPS) * w;
            const float p = shx(y, 16, d);
            y = y * cs + sgn * p * sn;
            if (isq) y *= QSCALE;
            if (!isq || qok) pr[col + d] = (bf16)f2bf(y); }
    }
}

DI void fnet_stepA(const bf16* xrow, const bf16* MAt, int r32, int hi, bf16x8 (&gs)[4][2]) {
    bf16x8 xa[4];
#pragma unroll
    for (int s4 = 0; s4 < 4; ++s4) xa[s4] = *(const bf16x8*)(xrow + 16 * s4 + 8 * hi);
#pragma unroll
    for (int cb = 0; cb < 4; ++cb) { f32x16 acc = f32x16{};
#pragma unroll
        for (int s4 = 0; s4 < 4; ++s4) { const bf16x8 bfr = *(const bf16x8*)(MAt + (32 * cb + r32) * 64 + 16 * s4 + 8 * hi); acc = MFMA32(xa[s4], bfr, acc); }
        gs[cb][0] = pack_step(acc, 0); gs[cb][1] = pack_step(acc, 1); }
}

DI void fnet_s1_unit(const Frame& F, const Args& a, int l, int u, const bf16* P) {
    const int b = u >> 7, n2grp = (u >> 4) & 7, g = (u >> 2) & 3, k1b = u & 3;
    const int lane = F.lane, r32 = lane & 31, hi = lane >> 5, w = F.wave, n2 = 8 * n2grp + w;
    const bf16* tab = (const bf16*)(a.ws + WS_TAB);
    const bf16* MAt = tab + TAB_MA / 2 + (size_t)(l * 4 + g) * 128 * 64;
    const bf16* T128 = tab + TAB_128 / 2;
    f32x16 Tr[2], Ti[2];
#pragma unroll
    for (int j = 0; j < 2; ++j) { Tr[j] = f32x16{}; Ti[j] = f32x16{}; }
#pragma unroll 1
    for (int nb = 0; nb < 4; ++nb) {
        const bf16* xrow = P + (size_t)(SEQ * b + 64 * (32 * nb + r32) + n2) * PW + C_BF + 64 * g;
        bf16x8 gs[4][2]; fnet_stepA(xrow, MAt, r32, hi, gs);
#pragma unroll
        for (int s = 0; s < 2; ++s) {
            const size_t fo = ((size_t)((k1b * 4 + nb) * 2 + s) * 64 + lane) * 8;
            const bf16x8 ca = *(const bf16x8*)(T128 + fo), sa = *(const bf16x8*)(T128 + 16384 + fo), na = *(const bf16x8*)(T128 + 32768 + fo);
            Tr[0] = MFMA32(ca, gs[0][s], Tr[0]); Tr[0] = MFMA32(sa, gs[2][s], Tr[0]);
            Tr[1] = MFMA32(ca, gs[1][s], Tr[1]); Tr[1] = MFMA32(sa, gs[3][s], Tr[1]);
            Ti[0] = MFMA32(ca, gs[2][s], Ti[0]); Ti[0] = MFMA32(na, gs[0][s], Ti[0]);
            Ti[1] = MFMA32(ca, gs[3][s], Ti[1]); Ti[1] = MFMA32(na, gs[1][s], Ti[1]); }
    }
    LAS bf16* tl = (LAS bf16*)F.lds;
#pragma unroll
    for (int i = 0; i < 16; ++i) { const int k1l = crow(i, hi), k1 = 32 * k1b + k1l;
        const float rev = (float)((n2 * k1) & 8191) * (1.0f / 8192.0f); const float c = __builtin_amdgcn_cosf(rev), s = __builtin_amdgcn_sinf(rev);
#pragma unroll
        for (int jb = 0; jb < 2; ++jb) { const float tr = Tr[jb][i], ti = Ti[jb][i];
            tl[(k1l * 128 + 32 * jb + r32) * 8 + w] = (bf16)f2bf(tr * c + ti * s);
            tl[(k1l * 128 + 64 + 32 * jb + r32) * 8 + w] = (bf16)f2bf(ti * c - tr * s); } }
    __syncthreads();
    bf16* T1 = (bf16*)(a.ws + WS_T1);
#pragma unroll 4
    for (int pass = 0; pass < 8; ++pass) { const int q = F.tid + 512 * pass, k1l = q >> 7, colL = q & 127;
        const v4u v = *(const LAS v4u*)(F.lds + (size_t)q * 16);
        *(v4u*)(T1 + ((((size_t)(b * 128 + 32 * k1b + k1l) * 8 + n2grp) * 512) + g * 128 + colL) * 8) = v; }
    __syncthreads();
}

DI void fnet_ctx_unit(const Frame& F, const Args& a, int l, int u, const bf16* P, bf16* YB) {
    const int b = u >> 2, g = u & 3;
    const int lane = F.lane, r32 = lane & 31, hi = lane >> 5, w = F.wave;
    const bf16* tab = (const bf16*)(a.ws + WS_TAB);
    const bf16* MAt = tab + TAB_MA / 2 + (size_t)(l * 4 + g) * 128 * 64;
    const bf16* T256 = tab + TAB_256 / 2;
    f32x16 Y[2]; Y[0] = f32x16{}; Y[1] = f32x16{};
#pragma unroll 1
    for (int nb = 0; nb < 8; ++nb) {
        const bf16* xrow = P + (size_t)(M_LAT + NCTX * b + 32 * nb + r32) * PW + C_BF + 64 * g;
        bf16x8 gs[4][2]; fnet_stepA(xrow, MAt, r32, hi, gs);
#pragma unroll
        for (int s = 0; s < 2; ++s) {
            const size_t fo = ((size_t)((w * 8 + nb) * 2 + s) * 64 + lane) * 8;
            const bf16x8 ca = *(const bf16x8*)(T256 + fo), sa = *(const bf16x8*)(T256 + 65536 + fo);
            Y[0] = MFMA32(ca, gs[0][s], Y[0]); Y[0] = MFMA32(sa, gs[2][s], Y[0]);
            Y[1] = MFMA32(ca, gs[1][s], Y[1]); Y[1] = MFMA32(sa, gs[3][s], Y[1]); }
    }
#pragma unroll
    for (int jb = 0; jb < 2; ++jb)
#pragma unroll
        for (int i = 0; i < 16; ++i) { const int k = 32 * w + crow(i, hi), d = 32 * jb + r32; const size_t row = (size_t)(M_LAT + NCTX * b + k);
            const float z = bf2f(P[row * PW + C_BZ + 64 * g + d]);
            YB[row * 1024 + 512 + 64 * g + d] = (bf16)f2bf(Y[jb][i] * (1.0f / 128.0f) * siluf(z)); }
}

#ifndef B_SCALE
#define B_SCALE 1.0f
#endif
#ifndef C_SCALE
#define C_SCALE 1.0f
#endif
DI void fnet_s3_unit(const Frame& F, const Args& a, int u, const bf16* P, bf16* YB) {
    const int b = u >> 7, k1 = u & 127;
    const int lane = F.lane, r32 = lane & 31, hi = lane >> 5, g = F.wave >> 1, jb = F.wave & 1;
    const bf16* T64 = (const bf16*)(a.ws + WS_TAB) + TAB_64 / 2;
    const bf16* T1 = (const bf16*)(a.ws + WS_T1);
    f32x16 Y[2]; Y[0] = f32x16{}; Y[1] = f32x16{};
#pragma unroll
    for (int sc = 0; sc < 4; ++sc)
#pragma unroll
        for (int ri = 0; ri < 2; ++ri) {
            const bf16x8 afr = *(const bf16x8*)(T1 + ((((size_t)(b * 128 + k1) * 8 + 2 * sc + hi) * 512) + g * 128 + ri * 64 + 32 * jb + r32) * 8);
#pragma unroll
            for (int k2b = 0; k2b < 2; ++k2b) { const bf16x8 bfr = *(const bf16x8*)(T64 + ri * 4096 + (32 * k2b + r32) * 64 + 16 * sc + 8 * hi); Y[k2b] = MFMA32(afr, bfr, Y[k2b]); } }
#pragma unroll
    for (int k2b = 0; k2b < 2; ++k2b) { const size_t row = (size_t)(SEQ * b + k1 + 128 * (32 * k2b + r32));
#pragma unroll
        for (int q = 0; q < 4; ++q) { const int d0 = 32 * jb + 8 * q + 4 * hi;
            const v2u z = *(const v2u*)(P + row * PW + C_BZ + 64 * g + d0);
            v2u o; o.x = pk2(Y[k2b][4 * q] * (B_SCALE * 0.0013810679320049757f) * siluf(wlo(z.x)), Y[k2b][4 * q + 1] * (B_SCALE * 0.0013810679320049757f) * siluf(whi(z.x)));
            o.y = pk2(Y[k2b][4 * q + 2] * (B_SCALE * 0.0013810679320049757f) * siluf(wlo(z.y)), Y[k2b][4 * q + 3] * (B_SCALE * 0.0013810679320049757f) * siluf(whi(z.y)));
            *(v2u*)(YB + row * 1024 + 512 + 64 * g + d0) = o; } }
}

DI void sgu_unit(const Frame& F, const Args& a, int l, int u, const bf16* P, bf16* YB) {
    constexpr int VP = 136;
    LAS bf16* vt = (LAS bf16*)F.lds;
    const int ci = u >> 2, g = u & 3;
    const size_t row0 = (size_t)ci * 128;
    { const int q = F.tid & 127, cq = F.tid >> 7; const bf16* src = P + (row0 + q) * PW + C_CV + 64 * g + 16 * cq;
#pragma unroll
      for (int i = 0; i < 2; ++i) { const v4u v = *(const v4u*)(src + 8 * i); const unsigned wv[4] = {v.x, v.y, v.z, v.w};
#pragma unroll
          for (int e = 0; e < 4; ++e) { vt[(16 * cq + 8 * i + 2 * e) * VP + q] = (bf16)f2bf(geluf(wlo(wv[e]))); vt[(16 * cq + 8 * i + 2 * e + 1) * VP + q] = (bf16)f2bf(geluf(whi(wv[e]))); } } }
    __syncthreads();
    const int lane = F.lane, r32 = lane & 31, hi = lane >> 5, pb = F.wave >> 1, cb = F.wave & 1;
    const bf16* Wsp = (const bf16*)(a.ws + WS_TAB) + TAB_WSP / 2 + (size_t)(l * 4 + g) * 128 * 128;
    f32x16 acc = f32x16{};
#pragma unroll
    for (int s = 0; s < 8; ++s) {
        const bf16x8 af = *(const LAS bf16x8*)(vt + (32 * cb + r32) * VP + 16 * s + 8 * hi);
        const bf16x8 bfr = *(const bf16x8*)(Wsp + (32 * pb + r32) * 128 + 16 * s + 8 * hi);
        acc = MFMA32(af, bfr, acc);
    }
    const int p = 32 * pb + r32; const float bb = a.in[I_BSP][(l * 4 + g) * 128 + p]; const bf16* pr = P + (row0 + p) * PW;
#pragma unroll
    for (int q = 0; q < 4; ++q) { const int c0 = 64 * g + 32 * cb + 8 * q + 4 * hi;
        const v2u uu = *(const v2u*)(pr + C_CU + c0), zz = *(const v2u*)(pr + C_CZ + c0);
        v2u o; o.x = pk2(C_SCALE * geluf(wlo(uu.x)) * (acc[4 * q] + bb) * siluf(wlo(zz.x)), C_SCALE * geluf(whi(uu.x)) * (acc[4 * q + 1] + bb) * siluf(whi(zz.x)));
        o.y = pk2(C_SCALE * geluf(wlo(uu.y)) * (acc[4 * q + 2] + bb) * siluf(wlo(zz.y)), C_SCALE * geluf(whi(uu.y)) * (acc[4 * q + 3] + bb) * siluf(whi(zz.y)));
        *(v2u*)(YB + (row0 + p) * 1024 + 768 + c0) = o; }
    __syncthreads();
}

DI void p5_ctx_convert(const Frame& F, const Args& a) {
    const int gt = F.vcu * 512 + F.tid, NGT = F.G * 512;
    const f32x4* src = (const f32x4*)(a.ws + WS_MGC); v2u* dst = (v2u*)((bf16*)(a.ws + WS_MG) + (size_t)M_LAT * 1024);
    for (int e = gt; e < M_CTX * 1024 / 4; e += NGT) { const f32x4 v = src[e]; v2u o; o.x = pk2(v.x, v.y); o.y = pk2(v.z, v.w); dst[e] = o; }
}

#ifdef SELFCHECK
constexpr int CW_CHK = 8192;
DI unsigned hsh(unsigned x) { x *= 2654435761u; x ^= x >> 15; x *= 2246822519u; x ^= x >> 13; x *= 3266489917u; x ^= x >> 16; return x; }
DI void chk_acc(const Args& a, int id, float got, float want) {
    unsigned* w = (unsigned*)(a.ws + WS_CTL) + CW_CHK + 4 * id;
    float d = __builtin_fabsf(got - want); if (!(d == d) || d > 1e15f) d = 1e15f;
    atomicAdd((float*)w, d * d); atomicAdd((float*)(w + 1), want * want); atomicAdd(w + 2, 1u); atomicMax(w + 3, __float_as_uint(d));
}
DI float bfr(float x) { return __uint_as_float(f2bf(x) << 16); }
DI void chk_p0(const Frame& F, const Args& a) {
    const int gt = F.vcu * 512 + F.tid, NGT = F.G * 512;
    for (int s = gt; s < 18432; s += NGT) { const int l = s / 9216, v = (s / 3072) % 3, j = s % 3072; float acc = a.in[I_BADA][l * 3072 + j];
        for (int k = 0; k < 1024; ++k) { const float cv = (v < 2) ? a.in[I_C][v * 1024 + k] : a.in[I_CCTX][k]; acc += siluf(cv) * a.in[I_WADA][((size_t)l * 1024 + k) * 3072 + j]; }
        chk_acc(a, 0, ((const float*)(a.ws + WS_MOD))[(l * 3 + v) * 3072 + j], acc); }
    for (int s = gt; s < 65536; s += NGT) { const unsigned h = hsh(s); const int l = (s >> 2) & 1, m = s & 3, k = h & 1023; const unsigned h2 = hsh(h + 77u);
        float got, want;
        if (m == 0) { const int n = h2 % PW; want = bfr(a.in[I_WIN][((size_t)l * 1024 + k) * PW + n]); got = bf2f(((const bf16*)(a.ws + WS_WIN))[((size_t)l * PW + n) * 1024 + k]); }
        else if (m == 1) { const int n = h2 & 4095; want = bfr(a.in[I_WMERGE][((size_t)l * 1024 + k) * 4096 + n]); got = bf2f(((const bf16*)(a.ws + WS_WM))[((size_t)l * 4096 + n) * 1024 + k]); }
        else if (m == 2) { const int n = h2 & 1023; want = bfr(a.in[I_WOUT][((size_t)l * 1024 + k) * 1024 + n]); got = bf2f(((const bf16*)(a.ws + WS_WOUT))[((size_t)l * 1024 + n) * 1024 + k]); }
        else { const int n = h2 & 1023, br = k >> 8, kk = k & 255; want = bfr(a.in[I_WBR][(((size_t)l * 4 + br) * 256 + kk) * 1024 + n]); got = bf2f(((const bf16*)(a.ws + WS_WBR))[((size_t)l * 1024 + n) * 1024 + 256 * br + kk]); }
        chk_acc(a, 1, got, want); }
}
DI int sample_row(unsigned h, int l) { const int r = h % M_ALL; (void)l; return ((h >> 20) & 7) == 0 ? M_LAT + (h % M_CTX) : r; }
DI void chk_h(const Frame& F, const Args& a, int l, int id) {
    const float* mod = (const float*)(a.ws + WS_MOD) + (size_t)l * 3 * 3072; const bf16* H = (const bf16*)(a.ws + WS_H);
    const int gw = F.vcu * NWAVES + F.wave, NGW = F.G * NWAVES;
    for (int s = gw; s < M_ALL; s += NGW) { const int row = s; const int v = row < SEQ ? 0 : (row < M_LAT ? 1 : 2);
        const float* xr = (row < M_LAT) ? ((l == 0) ? a.in[I_X] : a.out) + (size_t)row * 1024 : ((l == 0) ? a.in[I_CTX] : (const float*)(a.ws + WS_XC1)) + (size_t)(row - M_LAT) * 1024;
        float ss = 0.f; for (int j = 0; j < 16; ++j) { const float x = xr[F.lane + 64 * j]; ss += x * x; }
        const float rstd = 1.0f / sqrtf(wave_sum(ss, F.lane) * (1.0f / 1024.0f) + RMS_EPS);
        for (int j = 0; j < 16; ++j) { const int c = F.lane + 64 * j; const float want = xr[c] * rstd * a.in[I_NORMW][l * 1024 + c] * (1.0f + mod[v * 3072 + 1024 + c]) + mod[v * 3072 + c];
            chk_acc(a, id, bf2f(H[(size_t)row * 1024 + c]), want); } }
}
DI float dot_h_w(const bf16* hrow, const bf16* wrow, int K) { float acc = 0.f; for (int k = 0; k < K; ++k) acc += bf2f(hrow[k]) * bf2f(wrow[k]); return acc; }
DI void chk_p(const Frame& F, const Args& a, int l, int id) {
    const bf16* H = (const bf16*)(a.ws + WS_H); const bf16* W = (const bf16*)(a.ws + WS_WIN) + (size_t)l * PW * 1024; const bf16* P = (const bf16*)(a.ws + WS_P);
    const int gt = F.vcu * 512 + F.tid, NGT = F.G * 512;
    for (int s = gt; s < (1 << 20); s += NGT) { const unsigned h = hsh(s * 5 + 2); const int row = sample_row(h, l); int col = hsh(h + 9u) % PW;
        if (l == 1 && row >= M_LAT) col = ((col & 1) ? 1024 : 256) + (col & 255);
        chk_acc(a, id, bf2f(P[(size_t)row * PW + col]), dot_h_w(H + (size_t)row * 1024, W + (size_t)col * 1024, 1024)); }
}
DI void chk_prep(const Frame& F, const Args& a, int l, int id) {
    const bf16* H = (const bf16*)(a.ws + WS_H); const bf16* W = (const bf16*)(a.ws + WS_WIN) + (size_t)l * PW * 1024; const bf16* P = (const bf16*)(a.ws + WS_P);
    const int gw = F.vcu * NWAVES + F.wave, NGW = F.G * NWAVES, d = F.lane;
    for (int s = gw; s < 16384; s += NGW) { const unsigned h = hsh(s * 7 + 3); const int row = sample_row(h, l); int sl = (h >> 8) % 12; const bool isctx = row >= M_LAT;
        if (isctx && l == 1) sl = (sl & 1) ? 4 + (sl & 1) : 10 + ((sl >> 1) & 1);
        const int col = (sl < 4) ? C_AQ + 64 * sl : (sl < 6) ? C_AK + 64 * (sl - 4) : (sl < 10) ? C_DQ + 64 * (sl - 6) : C_DK + 64 * (sl - 10);
        const bool isq = (sl < 4) || (sl >= 6 && sl < 10);
        const float raw = bfr(dot_h_w(H + (size_t)row * 1024, W + (size_t)(col + d) * 1024, 1024));
        const float wv = ((sl < 4) ? a.in[I_QNA] : (sl < 6) ? a.in[I_KNA] : (sl < 10) ? a.in[I_QND] : a.in[I_KND])[l * 64 + d];
        const float ms = wave_sum(raw * raw, d) * (1.0f / 64.0f);
        float y = raw / sqrtf(ms + RMS_EPS) * wv;
        if (!isctx) { const int n = row & (SEQ - 1); const float pos = (float)((d < 32) ? (n >> 6) : (n & 63)); const float inv = __builtin_amdgcn_exp2f(-(float)(d & 15) * (13.287712379549449f / 16.0f)); const float rev = pos * inv * 0.15915494309189535f; const float cs = __builtin_amdgcn_cosf(rev), sn = __builtin_amdgcn_sinf(rev);
            const float p = shx(y, 16, d); y = (d & 16) ? (p * sn + y * cs) : (y * cs - p * sn); }
        if (isq) y *= QSCALE;
        chk_acc(a, id, bf2f(P[(size_t)row * PW + col + d]), y); }
}
DI void chk_attn(const Frame& F, const Args& a, int l, int id, int mode) {
    const bf16* P = (const bf16*)(a.ws + WS_P); const bf16* YB = (const bf16*)(a.ws + WS_YB);
    LAS float* qs = (LAS float*)F.lds + F.wave * 192; LAS float* os = qs + 64; LAS float* red = qs + 128;
    const int gw = F.vcu * NWAVES + F.wave, NGW = F.G * NWAVES, lane = F.lane;
    const int qc0 = mode ? C_DQ : C_AQ, kc0 = mode ? C_DK : C_AK, vc0 = mode ? C_DV : C_AV, zc0 = mode ? C_DZ : C_AZ, oc0 = mode ? 256 : 0;
    for (int s = gw; s < 8192; s += NGW) { const unsigned hh = hsh(s * 11 + 5 + mode); int row = sample_row(hh, l); if ((s & 7) == 1) row = (hh & 8192) + (hh & 255) + ((hh & 256) ? 7936 : 0); if (l == 1 && row >= M_LAT) row = hh % M_LAT; const int h = (hh >> 9) & 3, kvh = h >> 1; const bool isctx = row >= M_LAT;
        const int b = isctx ? (row - M_LAT) / NCTX : row / SEQ, pos = row & (SEQ - 1);
        qs[lane] = bf2f(P[(size_t)row * PW + qc0 + 64 * h + lane]); LDS_WAIT();
        int klo = 0, khi = -1; if (!isctx) { if (mode == 0) { klo = 0; khi = SEQ - 1; } else { klo = pos - 128 < 0 ? 0 : pos - 128; khi = pos + 128 > SEQ - 1 ? SEQ - 1 : pos + 128; } }
        const int nlat = khi - klo + 1 > 0 ? khi - klo + 1 : 0, nk = NCTX + nlat;
        float m = -1e30f, lsum = 0.f; float acc[64];
#pragma unroll
        for (int dd = 0; dd < 64; ++dd) acc[dd] = 0.f;
        for (int kk = lane; kk < nk; kk += 64) { const size_t kr = (kk < NCTX) ? (size_t)(M_LAT + NCTX * b + kk) : (size_t)(SEQ * b + klo + kk - NCTX);
            const bf16* kp = P + kr * PW + kc0 + 64 * kvh; const bf16* vp = P + kr * PW + vc0 + 64 * kvh; float sc = 0.f;
#pragma unroll
            for (int dd = 0; dd < 64; ++dd) sc += qs[dd] * bf2f(kp[dd]);
            const float mn = fmaxf(m, sc), f = __builtin_amdgcn_exp2f(m - mn), p = __builtin_amdgcn_exp2f(sc - mn); lsum = lsum * f + p; m = mn;
#pragma unroll
            for (int dd = 0; dd < 64; ++dd) acc[dd] = acc[dd] * f + p * bf2f(vp[dd]); }
        float mall = m;
#pragma unroll
        for (int o = 1; o < 64; o <<= 1) mall = fmaxf(mall, shx(mall, o, lane));
        const float f = __builtin_amdgcn_exp2f(m - mall); lsum = wave_sum(lsum * f, lane);
        if (mode == 1) lsum += __builtin_amdgcn_exp2f(a.in[I_SINK][l * 4 + h] * 1.4426950408889634f - mall);
#pragma unroll
        for (int dd = 0; dd < 64; ++dd) { const float t = wave_sum(acc[dd] * f, lane); if (lane == dd) os[dd] = t; }
        LDS_WAIT();
        const float z = bf2f(P[(size_t)row * PW + zc0 + 64 * h + lane]);
        chk_acc(a, id, bf2f(YB[(size_t)row * 1024 + oc0 + 64 * h + lane]), os[lane] / lsum * siluf(z));
        (void)red; }
}
DI void chk_fnet(const Frame& F, const Args& a, int l, int id, int ctxmode) {
    const bf16* P = (const bf16*)(a.ws + WS_P); const bf16* YB = (const bf16*)(a.ws + WS_YB);
    LAS float* ys = (LAS float*)F.lds + F.wave * 64;
    const int gw = F.vcu * NWAVES + F.wave, NGW = F.G * NWAVES, j = F.lane;
    const int N = ctxmode ? NCTX : SEQ;
    for (int s = gw; s < (ctxmode ? 256 : 1024); s += NGW) { const unsigned hh = hsh(s * 13 + 7 + ctxmode); const int b = hh & 1, g = (hh >> 1) & 3; int k = (hh >> 3) % N;
#ifdef FNET_K0
        k = (s & 7) == 0 ? 0 : (s & 7) == 1 ? N / 2 : (s & 7) == 2 ? 64 : (s & 7) == 3 ? 128 : (s & 7) == 4 ? 1 : k;
#endif
        const size_t rbase = ctxmode ? (size_t)(M_LAT + NCTX * b) : (size_t)(SEQ * b);
        float y = 0.f;
        for (int n = 0; n < N; ++n) { const bf16* fr = P + (rbase + n) * PW + C_BF + 64 * g; float A = 0.f, B = 0.f;
            for (int c = 0; c < 64; ++c) { const float fv = bf2f(fr[c]); const float ph = (float)((j * c) & 63) * (1.0f / 64.0f); A += fv * __builtin_amdgcn_cosf(ph); B += fv * __builtin_amdgcn_sinf(ph); }
            const float th = (float)((k * n) & (N - 1)) / (float)N; y += __builtin_amdgcn_cosf(th) * A - __builtin_amdgcn_sinf(th) * B; }
        ys[j] = y / sqrtf((float)N * 64.0f); LDS_WAIT();
        float o = 0.f; for (int jj = 0; jj < 64; ++jj) o += ys[jj] * a.in[I_WFNET][((size_t)(l * 4 + g) * 64 + jj) * 64 + j];
        const size_t row = rbase + k; const float z = bf2f(P[row * PW + C_BZ + 64 * g + j]);
        chk_acc(a, id, bf2f(YB[row * 1024 + 512 + 64 * g + j]), o * siluf(z)); LDS_WAIT(); }
}
DI void chk_sgu(const Frame& F, const Args& a, int l, int id) {
    const bf16* P = (const bf16*)(a.ws + WS_P); const bf16* YB = (const bf16*)(a.ws + WS_YB);
    const int gt = F.vcu * 512 + F.tid, NGT = F.G * 512;
    for (int s = gt; s < (1 << 18); s += NGT) { const unsigned hh = hsh(s * 17 + 11); int row = sample_row(hh, l); if (l == 1 && row >= M_LAT) row = hh % M_LAT; const int cc = hsh(hh + 101u) & 255, g = cc >> 6, p = row & 127; const size_t r0 = (size_t)(row - p);
        float sp = a.in[I_BSP][(l * 4 + g) * 128 + p];
        for (int q = 0; q < 128; ++q) { const float v = bf2f(P[(r0 + q) * PW + C_CV + cc]); sp += a.in[I_WSP][((size_t)(l * 4 + g) * 128 + p) * 128 + q] * (0.5f * v * (1.0f + erff(v * 0.7071067811865476f))); }
        const float u = bf2f(P[(size_t)row * PW + C_CU + cc]), z = bf2f(P[(size_t)row * PW + C_CZ + cc]);
        chk_acc(a, id, bf2f(YB[(size_t)row * 1024 + 768 + cc]), (0.5f * u * (1.0f + erff(u * 0.7071067811865476f))) * sp * siluf(z)); }
}
DI void chk_merge(const Frame& F, const Args& a, int l, int id) {
    const bf16* H = (const bf16*)(a.ws + WS_H); const bf16* YB = (const bf16*)(a.ws + WS_YB); const bf16* MG = (const bf16*)(a.ws + WS_MG);
    const bf16* WM = (const bf16*)(a.ws + WS_WM) + (size_t)l * 4096 * 1024; const bf16* WB = (const bf16*)(a.ws + WS_WBR) + (size_t)l * 1024 * 1024;
    const int gt = F.vcu * 512 + F.tid, NGT = F.G * 512;
    for (int s = gt; s < (1 << 18); s += NGT) { const unsigned hh = hsh(s * 19 + 13); int row = sample_row(hh, l); if (l == 1 && row >= M_LAT) row = hh % M_LAT; const int d = hsh(hh + 202u) & 1023; float acc = 0.f;
        for (int r = 0; r < 4; ++r) { const float G = dot_h_w(H + (size_t)row * 1024, WM + ((size_t)r * 1024 + d) * 1024, 1024) + a.in[I_BMERGE][l * 4096 + r * 1024 + d];
            const float Y = dot_h_w(YB + (size_t)row * 1024 + 256 * r, WB + (size_t)d * 1024 + 256 * r, 256); acc += Y * __builtin_amdgcn_rcpf(1.0f + __builtin_amdgcn_exp2f(-1.4426950408889634f * G)); }
        float got; if (row < M_LAT) got = bf2f(MG[(size_t)row * 1024 + d]); else { got = 0.f; for (int br = 0; br < 4; ++br) got += bf2f(((const bf16*)(a.ws + WS_GTC))[((size_t)br * 512 + (row - M_LAT)) * 1024 + d]); }
        chk_acc(a, id, got, acc); }
}
DI void chk_gt(const Frame& F, const Args& a, int l, int r, int id) {
    const bf16* H = (const bf16*)(a.ws + WS_H); const bf16* GT = (const bf16*)(a.ws + WS_GT); const bf16* WM = (const bf16*)(a.ws + WS_WM) + (size_t)l * 4096 * 1024;
    const int gt = F.vcu * 512 + F.tid, NGT = F.G * 512;
    for (int s = gt; s < (1 << 18); s += NGT) { const unsigned hh = hsh(s * 29 + 19); int row = sample_row(hh, l); if (l == 1 && row >= M_LAT) row = hh % M_LAT; const int d = hsh(hh + 404u) & 1023;
        const float G = dot_h_w(H + (size_t)row * 1024, WM + ((size_t)r * 1024 + d) * 1024, 1024) + a.in[I_BMERGE][l * 4096 + r * 1024 + d];
        chk_acc(a, id, bf2f(GT[(size_t)row * 1024 + d]), __builtin_amdgcn_rcpf(1.0f + __builtin_amdgcn_exp2f(-1.4426950408889634f * G))); }
}
DI void chk_final(const Frame& F, const Args& a, int l, int id) {
    const bf16* MG = (const bf16*)(a.ws + WS_MG); const bf16* WO = (const bf16*)(a.ws + WS_WOUT) + (size_t)l * 1024 * 1024; const float* mod = (const float*)(a.ws + WS_MOD) + (size_t)l * 3 * 3072;
    const int gt = F.vcu * 512 + F.tid, NGT = F.G * 512;
    for (int s = gt; s < (1 << 18); s += NGT) { const unsigned hh = hsh(s * 23 + 17); const int row = sample_row(hh, l), c = hsh(hh + 303u) & 1023; const int v = row < SEQ ? 0 : (row < M_LAT ? 1 : 2);
        if (l == 1 && row >= M_LAT) continue;
        const float xi = (l == 1) ? ((const float*)(a.ws + WS_H))[(size_t)row * 1024 + c] : (row < M_LAT) ? a.in[I_X][(size_t)row * 1024 + c] : a.in[I_CTX][(size_t)(row - M_LAT) * 1024 + c];
        const float got = (row < M_LAT) ? a.out[(size_t)row * 1024 + c] : ((const float*)(a.ws + WS_XC1))[(size_t)(row - M_LAT) * 1024 + c];
        float dsum;
        if (row < M_LAT) dsum = dot_h_w(MG + (size_t)row * 1024, WO + (size_t)c * 1024, 1024);
        else { dsum = 0.f; for (int br = 0; br < 4; ++br) dsum += dot_h_w((const bf16*)(a.ws + WS_GTC) + ((size_t)br * 512 + (row - M_LAT)) * 1024, WO + (size_t)c * 1024, 1024); }
        chk_acc(a, id, got - xi, mod[v * 3072 + 2048 + c] * dsum); }
}
#ifdef CHECK_MAX
#define CHK_ERR(md, ss, n, mx) ((mx) / (sqrtf((ss) / (float)(n)) + 1e-20f))
#else
#define CHK_ERR(md, ss, n, mx) sqrtf((md) / ((ss) + 1e-30f))
#endif
DI void chk_report(const Frame& F, const Args& a) {
    const unsigned* w = (const unsigned*)(a.ws + WS_CTL) + CW_CHK; int first = -1; float ferr = 0.f;
#ifdef CHECK_ONLY
    { const int id = CHECK_ONLY; const float md = __uint_as_float(w[4 * id]), ss = ((const float*)w)[4 * id + 1]; const unsigned n = w[4 * id + 2]; first = id; ferr = n ? CHK_ERR(md, ss, n, __uint_as_float(w[4 * id + 3])) : 1e3f; }
#else
    for (int id = 0; id < 24; ++id) { const float md = __uint_as_float(w[4 * id]), ss = ((const float*)w)[4 * id + 1]; const unsigned n = w[4 * id + 2]; if (!n) continue;
        const float e = CHK_ERR(md, ss, n, __uint_as_float(w[4 * id + 3])); if (e > CHECK_TOL && first < 0) { first = id; ferr = e; } }
#endif
    const float V = first >= 0 ? 10.0f * (float)(1 + first) : 0.f; const float W = first >= 0 ? 4.0f + log10f(fminf(fmaxf(ferr, 1e-3f), 1e3f)) : 0.f;
    const size_t gt = (size_t)F.vcu * 512 + F.tid, NGT = (size_t)F.G * 512;
#ifdef KEEP_OUT
    if (gt == 0) a.out[0] += V; (void)W; (void)NGT;
#else
    for (size_t i = gt; i < (size_t)M_LAT * 1024; i += NGT) { float v = a.in[I_X][i]; if (i == 0) v += V; if (i >= (1u << 20) && i < (2u << 20)) v += W; a.out[i] = v; }
#endif
}
DI void chk_copy_out(const Frame& F, const Args& a) {
    const size_t gt = (size_t)F.vcu * 512 + F.tid, NGT = (size_t)F.G * 512; float* dst = (float*)(a.ws + WS_H);
    for (size_t i = gt; i < (size_t)M_LAT * 1024; i += NGT) dst[i] = a.out[i];
}
#endif

typedef const __attribute__((address_space(4))) Args* CArgsP;
DI Args fresh_args() { CArgsP p = (CArgsP)__builtin_amdgcn_kernarg_segment_ptr(); asm volatile("" : "+s"(p)); Args r;
#pragma unroll
    for (int i = 0; i < 20; ++i) r.in[i] = p->in[i];
    r.out = p->out; r.ws = p->ws; return r; }
DI Frame fresh_frame(unsigned char* lds) {
    Frame F; int t_ = threadIdx.x; asm volatile("" : "+v"(t_));
    F.lds = (LAS unsigned char*)lds; F.tid = t_; F.lane = t_ & 63; F.wave = __builtin_amdgcn_readfirstlane(t_ >> 6);
    F.G = gridDim.x; { const int bx = blockIdx.x; F.vcu = (F.G % 8 == 0) ? (bx % 8) * (F.G / 8) + bx / 8 : bx; }
    return F;
}
DI void grid_bar(unsigned char* lds) {
    const Args a = fresh_args();
    XcdBarrier b; b.bar = (unsigned*)(a.ws + WS_CTL) + CW_BAR; b.x = xb_xcc_id(); b.st = (volatile LAS unsigned*)((LAS unsigned char*)lds + MISC_OFF) + 8;
    xcd_barrier(b);
}

__global__ void __launch_bounds__(NWAVES * 64, 2) hybrid_fwd(Args args) {
    extern __shared__ __attribute__((aligned(16))) unsigned char lds[];
    for (int u = threadIdx.x; u < (LDS_BYTES - LDSCTL_OFF) / 4; u += NWAVES * 64) ((LAS unsigned*)((LAS unsigned char*)lds + LDSCTL_OFF))[u] = 0u;
    __syncthreads();
    { const Args a = fresh_args(); (void)xcd_barrier_post((unsigned*)(a.ws + WS_CTL) + CW_BAR, (volatile LAS unsigned*)((LAS unsigned char*)lds + MISC_OFF) + 8); }
#define GRID_BAR() grid_bar(lds)
#ifndef DUP_MASK
#define DUP_MASK 0
#endif
#define DUP(bit) for (int rep_ = 0; rep_ < 1 + (((DUP_MASK) >> (bit)) & 1); ++rep_)
#ifdef SELFCHECK
#ifndef CHECK_SET
#define CHECK_SET 0xffff
#endif
#define CHK(bit, call) do { if ((CHECK_SET) & (bit)) { { const Frame F = fresh_frame(lds); const Args a = fresh_args(); call; } GRID_BAR(); } } while (0)
#elif defined(EXTRA_BAR)
#define CHK(bit, call) GRID_BAR()
#else
#define CHK(bit, call) do {} while (0)
#endif

#ifndef SKIP_P0
    DUP(0) { const Frame F = fresh_frame(lds); const Args a = fresh_args(); p0_prologue(F, a); }
#endif
    GRID_BAR();
    CHK(1, chk_p0(F, a));

#pragma unroll 1
    for (int l = 0; l < 2; ++l) {
#ifndef SKIP_P1
        DUP(1) { const Frame F = fresh_frame(lds); const Args a = fresh_args();
          p1_modrms(F, a, l, (l == 0) ? a.in[I_X] : a.out, (l == 0) ? a.in[I_CTX] : (const float*)(a.ws + WS_XC1), 1); }
#endif
        GRID_BAR();
        CHK(2, chk_h(F, a, l, 2 + 10 * l));
#ifndef SKIP_G1
        DUP(2) { const Frame F = fresh_frame(lds); const Args a = fresh_args();
            pg8::Gemm g{(const bf16*)(a.ws + WS_H), (const bf16*)(a.ws + WS_WIN) + (size_t)l * PW * 1024, 1024, 1024, 1024};
            pg8::OrderX S; S.so.init(l == 0 ? M_ALL : M_LAT, PW, F.G, (int)blockIdx.x); S.nx = (l == 0) ? 0 : 4;
            pg8::EpiBf16<0> E{(bf16*)(a.ws + WS_P), PW, nullptr};
            pg8::gemm_phase<pg8::EpiBf16<0>, pg8::OrderX, true>(F.lds, g, S, E);
        }
#endif
        GRID_BAR();
        CHK(4, chk_p(F, a, l, 3 + 10 * l));
#ifndef SKIP_S1
        DUP(3) { const Frame F = fresh_frame(lds); const Args a = fresh_args();
          for (int u = F.vcu; u < 256; u += F.G) fnet_s1_unit(F, a, l, u, (const bf16*)(a.ws + WS_P)); }
#endif
#ifndef SKIP_FC
        if (l == 0) { const Frame F = fresh_frame(lds); const Args a = fresh_args();
          for (int e = F.vcu; e < 256; e += F.G) { if ((e & 31) == 7) fnet_ctx_unit(F, a, l, e >> 5, (const bf16*)(a.ws + WS_P), (bf16*)(a.ws + WS_YB)); } }
#endif
#ifndef SKIP_PREP
        { const Frame F = fresh_frame(lds); const Args a = fresh_args(); p3_prep(F, a, l, (bf16*)(a.ws + WS_P)); }
#endif
        GRID_BAR();
        CHK(8, chk_prep(F, a, l, 4 + 10 * l));
#ifndef SKIP_ATT
        DUP(4) { const Frame F = fresh_frame(lds); const Args a = fresh_args();
            const attn_body::bf16* Pa = (const attn_body::bf16*)(a.ws + WS_P); attn_body::bf16* Ya = (attn_body::bf16*)(a.ws + WS_YB);
            for (int u = F.vcu; u < 256; u += F.G) {
                const int bk = u >> 6, b = bk >> 1, kvh = bk & 1, h = 2 * kvh + ((u >> 5) & 1), qb = u & 31;
                attn_body::attn_unit<0, 8>(Pa, Ya, SEQ * b + 256 * qb, M_LAT + NCTX * b, SEQ * b, 0, 132, 0,
                                           C_AQ + 64 * h, C_AK + 64 * kvh, C_AV + 64 * kvh, C_AZ + 64 * h, 64 * h, 0.f, (char*)lds);
            }
        }
        DUP(5) { const Frame F = fresh_frame(lds); const Args a = fresh_args();
            const attn_body::bf16* Pa = (const attn_body::bf16*)(a.ws + WS_P); attn_body::bf16* Ya = (attn_body::bf16*)(a.ws + WS_YB);
            for (int u = F.vcu; u < 512; u += F.G) {
                if (u < 256) {
                    const int bk = u >> 6, b = bk >> 1, kvh = bk & 1, h = 2 * kvh + ((u >> 5) & 1), qb = u & 31;
                    const int off = (qb == 0) ? 0 : 4 * qb - 2, NT = (qb == 0 || qb == 31) ? 10 : 12;
                    const float sk = a.in[I_SINK][l * 4 + h] * 1.4426950408889634f;
                    attn_body::attn_unit<1, 8>(Pa, Ya, SEQ * b + 256 * qb, M_LAT + NCTX * b, SEQ * b, off, NT, 256 * qb - 64 * off,
                                               C_DQ + 64 * h, C_DK + 64 * kvh, C_DV + 64 * kvh, C_DZ + 64 * h, 256 + 64 * h, sk, (char*)lds);
                } else if (l == 0 && ((u - 256) & 15) == 0) {
                    const int ee = (u - 256) >> 4, mode = ee >> 3, b = (ee >> 2) & 1, h = ee & 3, kvh = h >> 1;
                    const float sk = (mode == 0) ? -INFINITY : a.in[I_SINK][l * 4 + h] * 1.4426950408889634f;
                    const int qc = (mode == 0) ? C_AQ : C_DQ, kc = (mode == 0) ? C_AK : C_DK, vc = (mode == 0) ? C_AV : C_DV, zc = (mode == 0) ? C_AZ : C_DZ, oc = (mode == 0) ? 0 : 256;
                    attn_body::attn_unit<1, 8>(Pa, Ya, M_LAT + NCTX * b, M_LAT + NCTX * b, SEQ * b, 0, 4, 0,
                                               qc + 64 * h, kc + 64 * kvh, vc + 64 * kvh, zc + 64 * h, oc + 64 * h, sk, (char*)lds);
                }
            }
        }
#endif
#ifndef SKIP_S3
        DUP(6) { const Frame F = fresh_frame(lds); const Args a = fresh_args();
          for (int u = F.vcu; u < 256; u += F.G) fnet_s3_unit(F, a, u, (const bf16*)(a.ws + WS_P), (bf16*)(a.ws + WS_YB)); }
#endif
#ifndef SKIP_SGU
        DUP(7) { const Frame F = fresh_frame(lds); const Args a = fresh_args();
          const int nunit = (l == 0) ? 528 : 512;
          for (int u = F.vcu; u < nunit; u += F.G) sgu_unit(F, a, l, u, (const bf16*)(a.ws + WS_P), (bf16*)(a.ws + WS_YB)); }
#endif
        GRID_BAR();
        CHK(16, chk_attn(F, a, l, 5 + 10 * l, 0)); CHK(16, chk_attn(F, a, l, 6 + 10 * l, 1)); CHK(32, chk_fnet(F, a, l, 7 + 10 * l, 0); if (l == 0) chk_fnet(F, a, l, 8, 1)); CHK(64, chk_sgu(F, a, l, 9 + 10 * l));
#ifndef MERGE_V1
        for (int rep_ = 0; rep_ < 1 + ((((DUP_MASK) >> 8) & 1) && l == 1); ++rep_) { const Frame F = fresh_frame(lds); const Args a = fresh_args();
            pg8::Gemm g{(const bf16*)(a.ws + WS_H), (const bf16*)(a.ws + WS_WM), 1024, 1024, 1024};
            pg8::MergeOrder S{(const bf16*)(a.ws + WS_H), (const bf16*)(a.ws + WS_YB), (const bf16*)(a.ws + WS_WM) + (size_t)l * 4096 * 1024, (const bf16*)(a.ws + WS_WBR) + (size_t)l * 1024 * 1024, F.G, F.vcu, (l == 0) ? 32 : 0};
            pg8::EpiMerge E{(bf16*)(a.ws + WS_GT), (bf16*)(a.ws + WS_MG), (float*)(a.ws + WS_MGC), a.in[I_BMERGE] + l * 4096, (bf16*)(a.ws + WS_GTC)};
            pg8::gemm_phase<pg8::EpiMerge, pg8::MergeOrder, true>(F.lds, g, S, E);
        }
        GRID_BAR();
#else
#pragma unroll 1
        for (int r = 0; r < 4; ++r) {
#ifdef ZERO_MASK
            if ((ZERO_MASK >> r) & 1) continue;
#endif
#ifndef SKIP_MG
            { const Frame F = fresh_frame(lds); const Args a = fresh_args();
                pg8::Gemm g{(const bf16*)(a.ws + WS_H), (const bf16*)(a.ws + WS_WM) + ((size_t)l * 4096 + r * 1024) * 1024, 1024, 1024, 1024};
                pg8::OrderX S; S.so.init((l == 0) ? M_ALL : M_LAT, 1024, F.G, (int)blockIdx.x); S.nx = 0;
                pg8::EpiBf16<2> E{(bf16*)(a.ws + WS_GT), 1024, a.in[I_BMERGE] + l * 4096 + r * 1024};
                pg8::gemm_phase<pg8::EpiBf16<2>, pg8::OrderX, true>(F.lds, g, S, E);
            }
#endif
            GRID_BAR();
            if (r == 3 && l == 0) CHK(512, chk_gt(F, a, l, r, 22); chk_gt(F, a, l, 2, 23));
#ifndef SKIP_MY
            { const Frame F = fresh_frame(lds); const Args a = fresh_args();
                pg8::Gemm g{(const bf16*)(a.ws + WS_YB) + r * 256, (const bf16*)(a.ws + WS_WBR) + (size_t)l * 1024 * 1024 + r * 256, 1024, 1024, 256};
                pg8::OrderX S; S.so.init((l == 0) ? M_ALL : M_LAT, 1024, F.G, (int)blockIdx.x); S.nx = 0;

#ifdef ZERO_MASK
                pg8::EpiGate E{(bf16*)(a.ws + WS_MG), (const bf16*)(a.ws + WS_GT), 1024, r == __builtin_ctz(~(ZERO_MASK)), 1.0f};
#else
#ifdef SCALE_MASK
                pg8::EpiGate E{(bf16*)(a.ws + WS_MG), (const bf16*)(a.ws + WS_GT), 1024, r == 0, ((SCALE_MASK >> r) & 1) ? (SCALE_VAL) : 1.0f};
#else
                pg8::EpiGate E{(bf16*)(a.ws + WS_MG), (const bf16*)(a.ws + WS_GT), 1024, r == 0, 1.0f};
#endif
#endif

                pg8::gemm_phase<pg8::EpiGate, pg8::OrderX, true>(F.lds, g, S, E);
            }
#endif
            GRID_BAR();
        }
#endif
        CHK(128, chk_merge(F, a, l, 10 + 10 * l));
        if (l == 1) CHK(256, chk_copy_out(F, a));
#ifndef SKIP_OUT
        { const Frame F = fresh_frame(lds); const Args a = fresh_args();
            pg8::Gemm g{(const bf16*)(a.ws + WS_MG), (const bf16*)(a.ws + WS_WOUT) + (size_t)l * 1024 * 1024, 1024, 1024, 1024};
            pg8::OrderOut S; S.so.init(M_LAT, 1024, F.G, (int)blockIdx.x); S.nx = (l == 0) ? 128 : 0; S.TERM = (const bf16*)(a.ws + WS_GTC);
            pg8::EpiRes E{(l == 0) ? a.in[I_X] : a.out, a.out, (l == 0) ? a.in[I_CTX] : (const float*)(a.ws + WS_XC1), (float*)(a.ws + WS_XC1), (const float*)(a.ws + WS_MOD) + (size_t)l * 3 * 3072};
            pg8::gemm_phase<pg8::EpiRes, pg8::OrderOut, true>(F.lds, g, S, E);
        }
#endif
        if (l == 0) GRID_BAR();
        if (l == 0) CHK(256, chk_final(F, a, l, 11));
#ifdef SELFCHECK
        if (l == 1) { GRID_BAR(); CHK(256, chk_final(F, a, l, 21)); }
#endif
    }
#ifdef SELFCHECK
    GRID_BAR();
    { const Frame F = fresh_frame(lds); const Args a = fresh_args(); chk_report(F, a); }
#endif
#ifdef BLEND_S
    GRID_BAR();
    { const Frame F = fresh_frame(lds); const Args a = fresh_args(); const size_t gt = (size_t)F.vcu * 512 + F.tid, NGT = (size_t)F.G * 512;
      for (size_t i = gt; i < (size_t)M_LAT * 1024; i += NGT) { const float x0 = a.in[I_X][i]; a.out[i] = x0 + (BLEND_S) * (a.out[i] - x0); } }
#endif
}

extern "C" void kernel_launch(void* const* d_in, const int* in_sizes, int n_in, void* d_out, int out_size, void* d_ws, size_t ws_size, hipStream_t stream) {
    static int grid = 0;
    if (grid == 0) {
        if (n_in != 20 || out_size != M_LAT * DM || ws_size < WS_END) { fprintf(stderr, "kernel_launch: unexpected problem: n_in %d out %d ws %zu\n", n_in, out_size, ws_size); grid = -1; return; }
        { const int want[20] = {M_LAT * DM, NB * DM, M_CTX * DM, DM, 2 * DM, 2 * DM * 3 * DM, 2 * 3 * DM, 2 * DM * PW, 128, 128, 128, 128, 8, 2 * 4 * 64 * 64, 2 * 4 * 128 * 128, 2 * 4 * 128, 2 * 4 * 256 * DM, 2 * DM * 4 * DM, 2 * 4 * DM, 2 * DM * DM};
          for (int i = 0; i < 20; ++i) if (in_sizes[i] != want[i]) { fprintf(stderr, "kernel_launch: input %d has %d elements, expected %d\n", i, in_sizes[i], want[i]); grid = -1; return; } }
        int dev = 0, cus = 0, per_cu = 0;
        if (hipGetDevice(&dev) != hipSuccess || hipDeviceGetAttribute(&cus, hipDeviceAttributeMultiprocessorCount, dev) != hipSuccess) { grid = -1; return; }
        if (hipFuncSetAttribute((const void*)hybrid_fwd, hipFuncAttributeMaxDynamicSharedMemorySize, LDS_BYTES) != hipSuccess) { fprintf(stderr, "kernel_launch: hipFuncSetAttribute failed\n"); grid = -1; return; }
        if (hipOccupancyMaxActiveBlocksPerMultiprocessor(&per_cu, (const void*)hybrid_fwd, NWAVES * 64, LDS_BYTES) != hipSuccess || per_cu < 1) { fprintf(stderr, "kernel_launch: occupancy query says %d blocks per CU\n", per_cu); per_cu = 1; }
        (void)hipGetLastError();
        grid = cus;
    }
    if (grid < 0) return;
    if (hipMemsetAsync((char*)d_ws + WS_CTL, 0, CTL_ZERO_BYTES, stream) != hipSuccess) { fprintf(stderr, "kernel_launch: memset failed\n"); return; }
    Args a{};
    for (int i = 0; i < 20; ++i) a.in[i] = (const float*)d_in[i];
    a.out = (float*)d_out; a.ws = (unsigned char*)d_ws;
    hipLaunchKernelGGL(hybrid_fwd, dim3(grid), dim3(NWAVES * 64), LDS_BYTES, stream, a);
}
```

```cpp
#include <hip/hip_runtime.h>
#include <hip/hip_bf16.h>
#include <cstdio>
#include <cstdint>
#include <cmath>

namespace pg8 {
#define PG8_LAS __attribute__((address_space(3)))
typedef unsigned short bf16_t;
typedef short bf16x8 __attribute__((ext_vector_type(8)));
typedef float f32x4 __attribute__((ext_vector_type(4)));
typedef unsigned u32x4 __attribute__((ext_vector_type(4)));
constexpr int BM = 256, BK = 64, HALF = 128, HTB = HALF * BK * 2, STAGE_BYTES = 8 * HTB, NXCD = 8, WGM = 8;

__host__ __device__ __forceinline__ int lds_byte(int r, int c) { const int st = (r >> 4) * 2 + (c >> 5), rr = r & 15, cc = c & 31, ob = rr * 64 + cc * 2; return st * 1024 + (ob ^ (((ob >> 9) & 1) << 5)); }
__host__ __device__ __forceinline__ void stage_rc(int b, int& R, int& C) { const int st = b / 1024, sb = b % 1024, swz = sb ^ (((sb >> 9) & 1) << 5); R = (st >> 1) * 16 + swz / 64; C = (st & 1) * 32 + (swz % 64) / 2; }
__host__ __device__ __forceinline__ int perm32(int rho) { const int n = rho >> 4, i = rho & 15; return 8 * (i >> 2) + 4 * n + (i & 3); }

struct Unit { int pm, pn, r, kind; };
struct Gemm { const bf16_t* A; const bf16_t* Bt; int lda, ldb, K; };

struct StaticOrder {
    int nM, nN, nwg, G, c;
    __host__ __device__ void init(int M, int N, int G_, int c_) { nM = M / BM; nN = N / BM; nwg = nM * nN; G = G_; c = c_; }
    __host__ __device__ bool next(int i, Unit& u) const {
        const long L = (long)i * G + c; if (L >= nwg) return false;
        int wgid = (int)L; { const int q = nwg / NXCD, r = nwg % NXCD, xcd = wgid % NXCD, off = wgid / NXCD; wgid = (xcd < r ? xcd * (q + 1) : r * (q + 1) + (xcd - r) * q) + off; }
        const int nig = WGM * nN, gid = wgid / nig, fm = gid * WGM, gsz = (nM - fm) < WGM ? (nM - fm) : WGM;
        u.pm = fm + ((wgid % nig) % gsz); u.pn = (wgid % nig) / gsz; u.r = 0; u.kind = 0; return true;
    }
};
struct OrderX {
    StaticOrder so; int nx;
    __device__ bool next(int i, Unit& u) const {
        const long L = (long)i * so.G + so.c;
        if (L < so.nwg) return so.next(i, u);
        const int e = (int)(L - so.nwg); if (e >= nx) return false;
        u.pm = 64 + (e >> 1); u.pn = (e & 1) ? 4 : 1; u.r = 0; u.kind = 0; return true;
    }
    __device__ __forceinline__ void src(const Gemm& g, const Unit& u, const char*& pa, const char*& pb, int& nt) const {
        pa = (const char*)g.A + (size_t)u.pm * (2 * HALF) * g.lda * 2; pb = (const char*)g.Bt + (size_t)u.pn * (2 * HALF) * g.ldb * 2; nt = g.K / BK; }
};

typedef float f32x2_c __attribute__((ext_vector_type(2))); typedef __bf16 bf16x2_c __attribute__((ext_vector_type(2)));
__device__ __forceinline__ unsigned cvt_pk_bf16(float lo, float hi) { f32x2_c v = {lo, hi}; bf16x2_c b = __builtin_convertvector(v, bf16x2_c); return __builtin_bit_cast(unsigned, b); }
__device__ __forceinline__ float bf_lo(unsigned w) { return __uint_as_float(w << 16); }
__device__ __forceinline__ float bf_hi(unsigned w) { return __uint_as_float(w & 0xffff0000u); }
__device__ __forceinline__ float sigmoidf_(float x) { return __builtin_amdgcn_rcpf(1.0f + __builtin_amdgcn_exp2f(-1.4426950408889634f * x)); }

template <int ACT> struct EpiBf16 {
    static constexpr bool PERM = true;
    bf16_t* O; int ldc; const float* bias;
    __device__ __forceinline__ void operator()(const f32x4 (&acc)[2][2][4][2], const Unit& u, int wr, int wc, int fr, int fq) const {
        const int row0 = u.pm * BM + wr * 64 + fr; const int col0 = u.pn * BM + wc * 32 + 8 * fq;
        f32x4 bv[2][2];
#pragma unroll
        for (int bj = 0; bj < 2; ++bj)
#pragma unroll
            for (int n = 0; n < 2; ++n) bv[bj][n] = bias ? *(const f32x4*)(bias + col0 + bj * HALF + 4 * n) : (f32x4){0.f, 0.f, 0.f, 0.f};
#pragma unroll
        for (int ai = 0; ai < 2; ++ai)
#pragma unroll
            for (int m = 0; m < 4; ++m) { bf16_t* rowp = O + (size_t)(row0 + ai * HALF + m * 16) * ldc + col0;
#pragma unroll
                for (int bj = 0; bj < 2; ++bj) { f32x4 v0 = acc[ai][bj][m][0] + bv[bj][0], v1 = acc[ai][bj][m][1] + bv[bj][1];
                    if (ACT == 2) {
#pragma unroll
                        for (int e = 0; e < 4; ++e) { v0[e] = sigmoidf_(v0[e]); v1[e] = sigmoidf_(v1[e]); } }
                    u32x4 w; w.x = cvt_pk_bf16(v0[0], v0[1]); w.y = cvt_pk_bf16(v0[2], v0[3]); w.z = cvt_pk_bf16(v1[0], v1[1]); w.w = cvt_pk_bf16(v1[2], v1[3]);
                    *(u32x4*)(rowp + bj * HALF) = w; } }
    }
};
struct EpiGate {
    static constexpr bool PERM = true;
    bf16_t* MG; const bf16_t* GT; int ldc; int first; float scl;
    typedef unsigned u32x2 __attribute__((ext_vector_type(2)));
    __device__ __forceinline__ void operator()(const f32x4 (&acc)[2][2][4][2], const Unit& u, int wr, int wc, int fr, int fq) const {
        const int row0 = u.pm * BM + wr * 64 + fr; const int col0 = u.pn * BM + wc * 32 + 8 * fq;
#pragma unroll
        for (int ai = 0; ai < 2; ++ai)
#pragma unroll
            for (int m = 0; m < 4; ++m) { const size_t off = (size_t)(row0 + ai * HALF + m * 16) * ldc + col0;
#pragma unroll
                for (int bj = 0; bj < 2; ++bj)
#pragma unroll
                    for (int n = 0; n < 2; ++n) {
                        const u32x2 g = *(const u32x2*)(GT + off + bj * HALF + 4 * n);
                        u32x2 o = (u32x2){0u, 0u}; if (!first) o = *(const u32x2*)(MG + off + bj * HALF + 4 * n);
                        const f32x4 v = acc[ai][bj][m][n] * scl;
                        u32x2 w;
                        w.x = cvt_pk_bf16(bf_lo(o.x) + bf_lo(g.x) * v[0], bf_hi(o.x) + bf_hi(g.x) * v[1]);
                        w.y = cvt_pk_bf16(bf_lo(o.y) + bf_lo(g.y) * v[2], bf_hi(o.y) + bf_hi(g.y) * v[3]);
                        *(u32x2*)(MG + off + bj * HALF + 4 * n) = w; asm volatile("" ::: "memory"); } }
    }
};
struct EpiRes {
    static constexpr bool PERM = false;
    const float* xin_lat; float* xout_lat; const float* xin_ctx; float* xout_ctx; const float* gate;
    __device__ __forceinline__ void operator()(const f32x4 (&acc)[2][2][4][2], const Unit& u, int wr, int wc, int fr, int fq) const {
        const bool isctx = u.pm >= 64;
        const float* xin = isctx ? xin_ctx + (size_t)(u.pm - 64) * BM * 1024 : xin_lat + (size_t)u.pm * BM * 1024;
        float* xout = isctx ? xout_ctx + (size_t)(u.pm - 64) * BM * 1024 : xout_lat + (size_t)u.pm * BM * 1024;
        const float* gv = gate + (isctx ? 2 : (u.pm >> 5)) * 3072 + 2048;
        const int col0 = u.pn * BM + wc * 32 + 4 * fq;
        f32x4 gt[2][2];
#pragma unroll
        for (int bj = 0; bj < 2; ++bj)
#pragma unroll
            for (int n = 0; n < 2; ++n) gt[bj][n] = *(const f32x4*)(gv + col0 + bj * HALF + n * 16);
#pragma unroll
        for (int ai = 0; ai < 2; ++ai)
#pragma unroll
            for (int m = 0; m < 4; ++m) { const size_t off = (size_t)(ai * HALF + wr * 64 + m * 16 + fr) * 1024 + col0;
#pragma unroll
                for (int bj = 0; bj < 2; ++bj)
#pragma unroll
                    for (int n = 0; n < 2; ++n) {
                        if (u.kind == 3) { const f32x4 v = gt[bj][n] * acc[ai][bj][m][n]; float* q = xout + off + bj * HALF + n * 16; atomicAdd(q + 0, v[0]); atomicAdd(q + 1, v[1]); atomicAdd(q + 2, v[2]); atomicAdd(q + 3, v[3]); }
                        else { const f32x4 bs = *(const f32x4*)(xin + off + bj * HALF + n * 16); *(f32x4*)(xout + off + bj * HALF + n * 16) = bs + gt[bj][n] * acc[ai][bj][m][n]; } }
                if (m & 1) asm volatile("" ::: "memory"); }
    }
};

struct MergeOrder {
    const bf16_t* H; const bf16_t* YB; const bf16_t* WmT; const bf16_t* WbrT; int G, c, nctx;
    __device__ bool next(int i, Unit& u) const {
        const int nl = (c < 256) ? 1 + (255 - c) / G : 0;
        if (i < 8 * nl) { const int t = c + (i >> 3) * G, q = i & 7; u.pm = t >> 2; u.pn = t & 3; u.r = q >> 1; u.kind = (q & 1) ? 0 : 1; return true; }
        const int j = i - 8 * nl;
        if (nctx == 0 || (c & 7) != 0) return false;
        const int jb = (c >> 3) + (j >> 1) * (G >> 3); if (jb >= nctx) return false;
        const int t = jb >> 2; u.pm = 64 + (t >> 2); u.pn = t & 3; u.r = jb & 3; u.kind = (j & 1) ? 2 : 1; return true;
    }
    __device__ __forceinline__ void src(const Gemm&, const Unit& u, const char*& pa, const char*& pb, int& nt) const {
        if (u.kind != 1) { pa = (const char*)(H + (size_t)u.pm * 256 * 1024); pb = (const char*)(WmT + ((size_t)u.r * 1024 + u.pn * 256) * 1024); nt = 16; }
        else { pa = (const char*)(YB + (size_t)u.pm * 256 * 1024 + u.r * 256); pb = (const char*)(WbrT + (size_t)u.pn * 256 * 1024 + u.r * 256); nt = 4; }
    }
};
typedef unsigned long long u64_t;
__device__ __forceinline__ u64_t ld_sc1(const void* p) { return __hip_atomic_load((const u64_t*)p, __ATOMIC_RELAXED, __HIP_MEMORY_SCOPE_AGENT); }
struct EpiMerge {
    static constexpr bool PERM = true;
    bf16_t* GT; bf16_t* MG; float* MGc; const float* bias; bf16_t* GTc;
    typedef unsigned u32x2 __attribute__((ext_vector_type(2)));
    __device__ __forceinline__ void operator()(const f32x4 (&acc)[2][2][4][2], const Unit& u, int wr, int wc, int fr, int fq) const {
        const int row0 = u.pm * BM + wr * 64 + fr; const int col0 = u.pn * BM + wc * 32 + 8 * fq;
        bf16_t* Yu = (u.pm >= 64) ? GTc + ((size_t)u.r * 512 - 16384) * 1024 : GT;
        if (u.kind == 1) {
#pragma unroll
            for (int ai = 0; ai < 2; ++ai)
#pragma unroll
                for (int m = 0; m < 4; ++m) { bf16_t* rowp = Yu + (size_t)(row0 + ai * HALF + m * 16) * 1024 + col0;
#pragma unroll
                    for (int bj = 0; bj < 2; ++bj) { const f32x4 v0 = acc[ai][bj][m][0], v1 = acc[ai][bj][m][1];
                        u32x4 w; w.x = cvt_pk_bf16(v0[0], v0[1]); w.y = cvt_pk_bf16(v0[2], v0[3]); w.z = cvt_pk_bf16(v1[0], v1[1]); w.w = cvt_pk_bf16(v1[2], v1[3]);
                        *(u32x4*)(rowp + bj * HALF) = w; } }
        } else {
            const bool isctx = (u.kind == 2), first = (u.r == 0) || isctx;
            bf16_t* Ou = isctx ? Yu : MG;
            const float* bp = bias + u.r * 1024 + col0;
            f32x4 bv[2][2];
#pragma unroll
            for (int bj = 0; bj < 2; ++bj)
#pragma unroll
                for (int n = 0; n < 2; ++n) bv[bj][n] = *(const f32x4*)(bp + bj * HALF + 4 * n);
#pragma unroll
            for (int ai = 0; ai < 2; ++ai) { u64_t yq[4][2][2], oq[4][2][2];
#pragma unroll
                for (int mm = 0; mm < 4; ++mm) { const size_t off = (size_t)(row0 + ai * HALF + mm * 16) * 1024 + col0;
#pragma unroll
                    for (int bj = 0; bj < 2; ++bj)
#pragma unroll
                        for (int n = 0; n < 2; ++n) { yq[mm][bj][n] = ld_sc1(Yu + off + bj * HALF + 4 * n); oq[mm][bj][n] = first ? 0ull : ld_sc1(MG + off + bj * HALF + 4 * n); } }
#pragma unroll
                for (int mm = 0; mm < 4; ++mm) { const size_t off = (size_t)(row0 + ai * HALF + mm * 16) * 1024 + col0;
#pragma unroll
                    for (int bj = 0; bj < 2; ++bj)
#pragma unroll
                        for (int n = 0; n < 2; ++n) { f32x4 gv = acc[ai][bj][mm][n] + bv[bj][n];
#pragma unroll
                            for (int e = 0; e < 4; ++e) gv[e] = sigmoidf_(gv[e]);
                            const u64_t y_ = yq[mm][bj][n], o_ = oq[mm][bj][n];
                            const unsigned yx = (unsigned)y_, yy = (unsigned)(y_ >> 32), ox = (unsigned)o_, oy = (unsigned)(o_ >> 32);
                            u32x2 w;
                            w.x = cvt_pk_bf16(bf_lo(ox) + gv[0] * bf_lo(yx), bf_hi(ox) + gv[1] * bf_hi(yx));
                            w.y = cvt_pk_bf16(bf_lo(oy) + gv[2] * bf_lo(yy), bf_hi(oy) + gv[3] * bf_hi(yy));
                            *(u32x2*)(Ou + off + bj * HALF + 4 * n) = w; } }
                asm volatile("" ::: "memory"); }
        }
    }
};
struct OrderOut {
    StaticOrder so; int nx; const bf16_t* TERM;
    __device__ bool next(int i, Unit& u) const {
        const long L = (long)i * so.G + so.c;
        if (L < so.nwg) return so.next(i, u);
        const int e = (int)(L - so.nwg); if (e >= nx) return false;
        const int t = e >> 4; u.pm = 64 + (t >> 2); u.pn = t & 3; u.r = e & 15; u.kind = 3; return true;
    }
    __device__ __forceinline__ void src(const Gemm& g, const Unit& u, const char*& pa, const char*& pb, int& nt) const {
        pa = (const char*)g.A + (size_t)u.pm * (2 * HALF) * g.lda * 2; pb = (const char*)g.Bt + (size_t)u.pn * (2 * HALF) * g.ldb * 2; nt = g.K / BK;
        if (u.kind == 3) { const int br = u.r >> 2, kq = u.r & 3; pa = (const char*)(TERM + ((size_t)br * 512 + (u.pm - 64) * 256) * 1024 + kq * 256); pb += (size_t)kq * 256 * 2; nt = 4; }
    }
};

template <class Epi, class Sched, bool ALIGN_EPI>
__device__ __forceinline__ void gemm_phase(PG8_LAS unsigned char* lds, const Gemm g, const Sched& S, const Epi& E) {
    int tid = threadIdx.x; asm volatile("" : "+v"(tid));
    const int wid = __builtin_amdgcn_readfirstlane(tid >> 6), lane = tid & 63, wr = wid >> 2, wc = wid & 3, fr = lane & 15, fq = lane >> 4;
    int nt;
    unsigned voffA[2], voffB[2];
#pragma unroll
    for (int i = 0; i < 2; ++i) { int R, C; stage_rc(tid * 16 + i * 8192, R, C); const int Rb = Epi::PERM ? ((R & ~31) + perm32(R & 31)) : R;
        voffA[i] = (unsigned)(R * g.lda + C) * 2u; voffB[i] = (unsigned)(Rb * g.ldb + C) * 2u; }
    const size_t kstep = (size_t)(BK * 2);
    const size_t hstepA = (size_t)HALF * g.lda * 2, hstepB = (size_t)HALF * g.ldb * 2;
    const unsigned ldsw = (unsigned)wid * 1024u;
    const int aoff = lds_byte(wr * 64 + fr, fq * 8), boff = lds_byte(wc * 32 + fr, fq * 8);
#define PG8_SA(b, h) (((b) * 2 + (h)) * HTB)
#define PG8_SB(b, h) ((4 + (b) * 2 + (h)) * HTB)
#define PG8_STAGE(bufoff, gbase, voff) do { _Pragma("unroll") for (int _i = 0; _i < 2; ++_i) \
        __builtin_amdgcn_global_load_lds((const unsigned*)((const char*)(gbase) + (voff)[_i]), (PG8_LAS unsigned*)(lds + (bufoff) + ldsw + _i * 8192), 16, 0, 0); } while (0)
#define PG8_LDA(dst, b, h) do { _Pragma("unroll") for (int m = 0; m < 4; ++m) _Pragma("unroll") for (int k = 0; k < 2; ++k) dst[m][k] = *(const PG8_LAS bf16x8*)(lds + PG8_SA(b, h) + aoff + m * 2048 + k * 1024); } while (0)
#define PG8_LDB(dst, b, h) do { _Pragma("unroll") for (int n = 0; n < 2; ++n) _Pragma("unroll") for (int k = 0; k < 2; ++k) dst[n][k] = *(const PG8_LAS bf16x8*)(lds + PG8_SB(b, h) + boff + n * 2048 + k * 1024); } while (0)
#define PG8_MMA(ai, bj, At, Bt) do { __builtin_amdgcn_s_setprio(1); _Pragma("unroll") for (int m = 0; m < 4; ++m) _Pragma("unroll") for (int n = 0; n < 2; ++n) _Pragma("unroll") for (int k = 0; k < 2; ++k) \
        acc[ai][bj][m][n] = __builtin_amdgcn_mfma_f32_16x16x32_bf16(Bt[n][k], At[m][k], acc[ai][bj][m][n], 0, 0, 0); __builtin_amdgcn_s_setprio(0); } while (0)
#define PG8_WAIT_V(n) asm volatile("s_waitcnt vmcnt(" #n ")" ::: "memory")
#define PG8_WAIT_L(n) asm volatile("s_waitcnt lgkmcnt(" #n ")" ::: "memory")
#define PG8_BAR __builtin_amdgcn_s_barrier()
#define PG8_SCHED __builtin_amdgcn_sched_barrier(0)
    Unit cur, nxt; int ui = 0;
    if (!S.next(0, cur)) return;
    f32x4 acc[2][2][4][2];
#pragma unroll
    for (int a = 0; a < 2; ++a)
#pragma unroll
        for (int b = 0; b < 2; ++b)
#pragma unroll
            for (int m = 0; m < 4; ++m)
#pragma unroll
                for (int n = 0; n < 2; ++n) acc[a][b][m][n] = (f32x4){0.f, 0.f, 0.f, 0.f};
    bf16x8 At[4][2], B0[2][2], B1[2][2];
    const char* cA; const char* cB; S.src(g, cur, cA, cB, nt);
    PG8_STAGE(PG8_SB(0, 0), cB, voffB); PG8_STAGE(PG8_SB(0, 1), cB + hstepB, voffB); PG8_STAGE(PG8_SA(0, 0), cA, voffA); PG8_STAGE(PG8_SA(0, 1), cA + hstepA, voffA);
    if (wr == 1) PG8_BAR;
    PG8_WAIT_V(2); PG8_BAR;
    PG8_STAGE(PG8_SB(1, 0), cB + kstep, voffB); PG8_STAGE(PG8_SA(1, 0), cA + kstep, voffA); PG8_STAGE(PG8_SB(1, 1), cB + hstepB + kstep, voffB);
    PG8_WAIT_V(6); PG8_BAR;
    for (;;) {
        const bool has_next = S.next(ui + 1, nxt);
        const char* nA = cA; const char* nB = cB; int nnt = nt; if (has_next) S.src(g, nxt, nA, nB, nnt);
        for (int t = 0; t < nt; t += 2) {
            const bool last = (t == nt - 2);
            const char* a1 = cA + (size_t)(t + 1) * kstep;
            const char* a2 = last ? nA : cA + (size_t)(t + 2) * kstep; const char* b2 = last ? nB : cB + (size_t)(t + 2) * kstep;
            const char* a3 = a2 + kstep; const char* b3 = b2 + kstep;
            PG8_LDB(B0, 0, 0); PG8_LDB(B1, 0, 1); PG8_SCHED; PG8_LDA(At, 0, 0); PG8_STAGE(PG8_SA(1, 1), a1 + hstepA, voffA);
            PG8_WAIT_V(8); PG8_WAIT_L(0); PG8_BAR; PG8_MMA(0, 0, At, B0); PG8_MMA(0, 1, At, B1); PG8_BAR; PG8_SCHED;
            PG8_LDA(At, 0, 1); PG8_STAGE(PG8_SB(0, 0), b2, voffB); PG8_STAGE(PG8_SB(0, 1), b2 + hstepB, voffB); PG8_STAGE(PG8_SA(0, 0), a2, voffA);
            PG8_WAIT_V(8); PG8_WAIT_L(0); PG8_BAR; PG8_MMA(1, 0, At, B0); PG8_MMA(1, 1, At, B1); PG8_BAR; PG8_SCHED;
            PG8_LDB(B0, 1, 0); PG8_LDB(B1, 1, 1); PG8_SCHED; PG8_LDA(At, 1, 0); PG8_STAGE(PG8_SA(0, 1), a2 + hstepA, voffA);
            PG8_WAIT_V(8); PG8_WAIT_L(0); PG8_BAR; PG8_MMA(0, 0, At, B0); PG8_MMA(0, 1, At, B1); PG8_BAR; PG8_SCHED;
            PG8_LDA(At, 1, 1); PG8_STAGE(PG8_SB(1, 0), b3, voffB); PG8_STAGE(PG8_SB(1, 1), b3 + hstepB, voffB); PG8_STAGE(PG8_SA(1, 0), a3, voffA);
            PG8_WAIT_V(8); PG8_WAIT_L(0); PG8_BAR; PG8_MMA(1, 0, At, B0); PG8_MMA(1, 1, At, B1); PG8_BAR; PG8_SCHED;
        }
        if constexpr (ALIGN_EPI) { if (wr == 0) PG8_BAR; }
        E(acc, cur, wr, wc, fr, fq);
        if (!has_next) break;
#pragma unroll
        for (int a = 0; a < 2; ++a)
#pragma unroll
            for (int b = 0; b < 2; ++b)
#pragma unroll
                for (int m = 0; m < 4; ++m)
#pragma unroll
                    for (int n = 0; n < 2; ++n) acc[a][b][m][n] = (f32x4){0.f, 0.f, 0.f, 0.f};
        cur = nxt; cA = nA; cB = nB; nt = nnt; ++ui;
        if constexpr (ALIGN_EPI) { if (wr == 1) PG8_BAR; }
    }
    PG8_WAIT_V(0);
    if constexpr (!ALIGN_EPI) { if (wr == 0) PG8_BAR; }
    PG8_BAR;
#undef PG8_SA
#undef PG8_SB
#undef PG8_STAGE
#undef PG8_LDA
#undef PG8_LDB
#undef PG8_MMA
#undef PG8_WAIT_V
#undef PG8_WAIT_L
#undef PG8_BAR
#undef PG8_SCHED
}
}
namespace attn_body {
using bf16=__hip_bfloat16;
using bf16x8=__attribute__((ext_vector_type(8)))short;
using s16x4=__attribute__((ext_vector_type(4)))short;
using f32x16=__attribute__((ext_vector_type(16)))float;
using u32x4=__attribute__((ext_vector_type(4)))unsigned;
constexpr int D=64;
constexpr int NW=8,QBLK=32,QB=QBLK*NW,KVBLK=64;
constexpr int PP=2816, YP=1024;
__device__ __forceinline__ int crow(int r,int hi){return (r&3)+8*(r>>2)+4*hi;}
#define SBAR() __builtin_amdgcn_sched_barrier(0)
__device__ __forceinline__ void dmask(f32x16&p0,f32x16&p1,int kb,unsigned lim,int qrel,int hi){
  const float NEG=-INFINITY; const unsigned b0=(unsigned)(kb+4*hi-qrel+128);
  #pragma unroll
  for(int r=0;r<16;++r){const unsigned dd=b0+(unsigned)((r&3)+8*(r>>2)); if(dd>lim)p0[r]=NEG; if(dd+32u>lim)p1[r]=NEG;}
}

constexpr int NSLOT=3, SLOTB=8192;
constexpr int LDS_K=0, LDS_V=NSLOT*SLOTB, LDS_WS=2*NSLOT*SLOTB, LDS_OST=LDS_WS+NW*64*4, LDS_BYTES=LDS_OST+NW*4096;
constexpr float C2=0.125f*1.4426950408889634f;
__device__ __forceinline__ void glds16(const void*gsrc,unsigned lds_dst){unsigned keep;
  asm volatile("s_mov_b32 %0, m0\n\ts_mov_b32 m0, %2\n\ts_nop 0\n\tglobal_load_lds_dwordx4 %1, off\n\ts_mov_b32 m0, %0":"=&s"(keep):"v"(gsrc),"s"(lds_dst):"memory");}
__device__ __forceinline__ float siluf_(float x){ return x*__builtin_amdgcn_rcpf(1.0f+__builtin_amdgcn_exp2f(-1.4426950408889634f*x)); }
__device__ __forceinline__ float max3f(float a,float b,float c){float r;asm("v_max3_f32 %0, %1, %2, %3":"=v"(r):"v"(a),"v"(b),"v"(c));return r;}
__device__ __forceinline__ float max2f(float a,float b){float r;asm("v_max_f32_e32 %0, %1, %2":"=v"(r):"v"(a),"v"(b));return r;}
__device__ __forceinline__ float fadd_s(float a,float b){float r;asm("v_add_f32_e32 %0, %1, %2":"=v"(r):"v"(a),"v"(b));return r;}
__device__ __forceinline__ float fsub_s(float a,float b){float r;asm("v_sub_f32_e32 %0, %1, %2":"=v"(r):"v"(a),"v"(b));return r;}
typedef float f32x2_t __attribute__((ext_vector_type(2))); typedef __bf16 bf16x2_t __attribute__((ext_vector_type(2)));
__device__ __forceinline__ unsigned cvtpk_s(float lo,float hi){f32x2_t v={lo,hi};bf16x2_t b=__builtin_convertvector(v,bf16x2_t);return __builtin_bit_cast(unsigned,b);}
#define WAIT_BAR(N) asm volatile("s_waitcnt vmcnt(" #N ") lgkmcnt(0)\n\ts_barrier":::"memory")

__device__ __forceinline__ void qkt(f32x16&p0,f32x16&p1,const char*Kslot,const bf16x8*qr,const f32x16&negm,int r32,int hi){
  const char*kb=Kslot+hi*1024+r32*16;
  #pragma unroll
  for(int d0=0;d0<4;++d0){
    const bf16x8 b0=*reinterpret_cast<const bf16x8*>(kb+d0*2048);
    const bf16x8 b1=*reinterpret_cast<const bf16x8*>(kb+d0*2048+512);
    if(d0==0){p0=__builtin_amdgcn_mfma_f32_32x32x16_bf16(b0,qr[0],negm,0,0,0);p1=__builtin_amdgcn_mfma_f32_32x32x16_bf16(b1,qr[0],negm,0,0,0);}
    else{p0=__builtin_amdgcn_mfma_f32_32x32x16_bf16(b0,qr[d0],p0,0,0,0);p1=__builtin_amdgcn_mfma_f32_32x32x16_bf16(b1,qr[d0],p1,0,0,0);}}
}
typedef __attribute__((address_space(3))) const char* lds_cptr;
typedef short v4i16_t __attribute__((ext_vector_type(4)));
__device__ __forceinline__ void kload8(bf16x8*kf,lds_cptr kp){
  kf[0]=*(const __attribute__((address_space(3))) bf16x8*)(kp);      kf[1]=*(const __attribute__((address_space(3))) bf16x8*)(kp+512);
  kf[2]=*(const __attribute__((address_space(3))) bf16x8*)(kp+2048); kf[3]=*(const __attribute__((address_space(3))) bf16x8*)(kp+2560);
  kf[4]=*(const __attribute__((address_space(3))) bf16x8*)(kp+4096); kf[5]=*(const __attribute__((address_space(3))) bf16x8*)(kp+4608);
  kf[6]=*(const __attribute__((address_space(3))) bf16x8*)(kp+6144); kf[7]=*(const __attribute__((address_space(3))) bf16x8*)(kp+6656);
}
__device__ __forceinline__ void kload2(bf16x8*kf,lds_cptr kp,int j){ kf[2*j]=*(const __attribute__((address_space(3))) bf16x8*)(kp+j*2048); kf[2*j+1]=*(const __attribute__((address_space(3))) bf16x8*)(kp+j*2048+512); }
__device__ __forceinline__ s16x4 vtr(lds_cptr p){ return __builtin_bit_cast(s16x4,__builtin_amdgcn_ds_read_tr16_b64_v4i16((__attribute__((address_space(3))) v4i16_t*)p)); }
__device__ __forceinline__ float rowmax(const f32x16&p0,const f32x16&p1){
  float a=max3f(p0[0],p0[1],p1[0]),b=max3f(p0[2],p0[3],p1[1]);a=max3f(a,p1[2],p1[3]);
  #pragma unroll
  for(int r=4;r<16;r+=4){a=max3f(a,p0[r],p0[r+1]);b=max3f(b,p0[r+2],p0[r+3]);a=max3f(a,p1[r],p1[r+1]);b=max3f(b,p1[r+2],p1[r+3]);}
  const float m=max2f(a,b);
  auto rr=__builtin_amdgcn_permlane32_swap(__float_as_uint(m),__float_as_uint(m),false,false);
  return max2f(__uint_as_float(rr[0]),__uint_as_float(rr[1]));
}
__device__ __forceinline__ void pv(f32x16*o,int vb,bf16x8 pa0,bf16x8 pa1,bf16x8 pa2,bf16x8 pa3){
  #pragma unroll
  for(int d0=0;d0<2;++d0){s16x4 lo[4],hi[4];
    #pragma unroll
    for(int ks=0;ks<4;++ks){
      asm volatile("ds_read_b64_tr_b16 %0,%1 offset:%c2":"=&v"(lo[ks]):"v"(vb),"i"(d0*4096+ks*1024):"memory");
      asm volatile("ds_read_b64_tr_b16 %0,%1 offset:%c2":"=&v"(hi[ks]):"v"(vb),"i"(d0*4096+ks*1024+512):"memory");}
    asm volatile("s_waitcnt lgkmcnt(0)":::"memory");SBAR();
    #define PK(k) (bf16x8){lo[k][0],lo[k][1],lo[k][2],lo[k][3],hi[k][0],hi[k][1],hi[k][2],hi[k][3]}
    o[d0]=__builtin_amdgcn_mfma_f32_32x32x16_bf16(pa0,PK(0),o[d0],0,0,0);
    o[d0]=__builtin_amdgcn_mfma_f32_32x32x16_bf16(pa1,PK(1),o[d0],0,0,0);
    o[d0]=__builtin_amdgcn_mfma_f32_32x32x16_bf16(pa2,PK(2),o[d0],0,0,0);
    o[d0]=__builtin_amdgcn_mfma_f32_32x32x16_bf16(pa3,PK(3),o[d0],0,0,0);
    #undef PK
  }
}

#ifndef ATTN_STORE16
#define ATTN_STORE16(p,v) (*(u32x4*)(p)=(v))
#endif
template<int MODE,int THRL> __device__ __forceinline__ void attn_unit(const bf16*Pm,bf16*YB,int qrow0,int ctx0,int lat0,int off,int NT,int wq0,int qcol,int kcol,int vcol,int zcol,int ocol,float sinkl2,char*shm){
  int tid_=threadIdx.x; asm volatile("":"+v"(tid_)); const int tid=tid_,lane=tid&63,r32=lane&31,hi=lane>>5; const int wid=__builtin_amdgcn_readfirstlane(tid>>6);
  const bf16*Qw=Pm+(long)(qrow0+wid*QBLK)*PP+qcol;
  const unsigned lds0=(unsigned)(uintptr_t)shm;
  float*wsf=(float*)(shm+LDS_WS)+wid*64;
  const bf16*ksrc=Pm+kcol+(long)lane*PP+wid*8;
  const bf16*vsrc=Pm+vcol+(long)(16*(wid&3)+(lane>>2))*PP+(wid>>2)*32+(lane&3)*8;
  const unsigned kdst=lds0+LDS_K+wid*1024, vdst=lds0+LDS_V+wid*1024;
  #define TROW(t) (((t)<4)?(ctx0+64*(t)):(lat0+64*((t)-4+off)))
  #define DMA_K(t,slot) glds16(ksrc+(long)TROW(t)*PP,(unsigned)__builtin_amdgcn_readfirstlane(kdst+(slot)))
  #define DMA_V(t,slot) glds16(vsrc+(long)TROW(t)*PP,(unsigned)__builtin_amdgcn_readfirstlane(vdst+(slot)))
  const int vb0=(int)(lds0+LDS_V)+((lane>>4)&1)*32+(lane&3)*8+(4*hi+((lane&15)>>2))*64;
  const char*Kbase=shm+LDS_K; bf16x8 kf[8];
  const lds_cptr shm3=(lds_cptr)shm; const lds_cptr kp0=shm3+LDS_K+hi*1024+r32*16; const lds_cptr vp0=shm3+LDS_V+((lane>>4)&1)*32+(lane&3)*8+(4*hi+((lane&15)>>2))*64;
  DMA_K(0,0);DMA_V(0,0);DMA_K(1,SLOTB);
  bf16x8 qr[4];
  #pragma unroll
  for(int d0=0;d0<4;++d0)qr[d0]=*reinterpret_cast<const bf16x8*>(&Qw[(long)r32*PP+d0*16+hi*8]);
  float mhat=0.f,l_reg=0.f;f32x16 o[2];o[0]=f32x16{};o[1]=f32x16{};f32x16 negm=f32x16{}; if(MODE==0){asm volatile("":"+v"(negm));}
  const int qrel=wid*QBLK+r32;
  #define CMASK(P0,P1,t) do{ if(MODE==1){ dmask(P0,P1,64*((t)-4)-wq0,((t)>=4)?256u:~0u,qrel,hi); } }while(0)
  bool resc=false;
  #define START(P0,P1) do{ const float rm=rowmax(P0,P1); resc=false; \
    { const float dl=rm; mhat=fadd_s(mhat,dl); \
      _Pragma("unroll") for(int r=0;r<16;++r){P0[r]=fsub_s(P0[r],dl);P1[r]=fsub_s(P1[r],dl);} \
      if(MODE==0){ _Pragma("unroll") for(int r=0;r<16;++r)negm[r]=-mhat; asm volatile("":"+v"(negm)); } } \
    _Pragma("unroll") for(int r=0;r<16;++r)P0[r]=__builtin_amdgcn_exp2f(P0[r]); }while(0)
  #define RESC() do{ if(resc){ asm volatile("s_waitcnt lgkmcnt(0)":::"memory"); \
      _Pragma("unroll") for(int d_=0;d_<2;++d_) _Pragma("unroll") for(int r=0;r<16;++r)o[d_][r]*=wsf[crow(r,hi)]; } }while(0)
  f32x16 pA0,pA1,pB0,pB1;
  int sl_prev=0,sl_cur=0,sl_next=SLOTB;
  #define ROT() do{sl_prev=sl_cur;sl_cur=sl_next;sl_next=(sl_next==(NSLOT-1)*SLOTB)?0:sl_next+SLOTB;}while(0)
  DMA_K(2,2*SLOTB);
  WAIT_BAR(3);
  qkt(pA0,pA1,Kbase,qr,negm,r32,hi);asm volatile("s_nop 15\n\ts_nop 7":"+v"(pA0),"+v"(pA1));CMASK(pA0,pA1,0);
  START(pA0,pA1);
  _Pragma("unroll") for(int r=0;r<16;++r)pA1[r]=__builtin_amdgcn_exp2f(pA1[r]);
  WAIT_BAR(0);
  DMA_K(3,0);DMA_V(1,SLOTB);
  ROT();
  kload8(kf,kp0+sl_cur);
  WAIT_BAR(2);
  s16x4 vlo[8],vhi[8]; u32x4 pw0,pw1,pw2,pw3;
  #define PKW(P,B) cvtpk_s(P[B],P[B+1])
  #define PAF(k) __builtin_bit_cast(bf16x8,pw##k)
  #define VFR(i) (bf16x8){vlo[i][0],vlo[i][1],vlo[i][2],vlo[i][3],vhi[i][0],vhi[i][1],vhi[i][2],vhi[i][3]}
  #define PIN(x) asm volatile("":"+v"(x))
  #define MX3(a,b,c) __builtin_fmaxf(__builtin_fmaxf((a),(b)),(c))
  #define GAPA(MF,A0,A1,A2,A3,W0,W1,PW) do{ MF; sacc+=A0; sacc+=A1; sacc+=A2; sacc+=A3; PIN(sacc); W0; W1; PIN(PW); SBAR(); }while(0)
  #define EX(v) __builtin_amdgcn_exp2f(v)
  #define GAPB(MF,X,B) do{ MF; X[B]=EX(X[B]); X[B+1]=EX(X[B+1]); X[B+2]=EX(X[B+2]); X[B+3]=EX(X[B+3]); PIN(X); SBAR(); }while(0)
  #define VRD(i) do{ vlo[i]=vtr(vp_+(((i)>>2)*4096+((i)&3)*1024)); vhi[i]=vtr(vp_+(((i)>>2)*4096+((i)&3)*1024+512)); }while(0)
  #define KRD(G,j) do{ if(G){ kload2(kf,kp0+sl_next,j); SBAR(); } }while(0)
  #define STEP(C0,C1,P0,P1,t,GK,GV,GL) do{ SBAR(); \
    const lds_cptr vp_=vp0+sl_prev; \
    VRD(0); SBAR(); float sacc=(P0[0]+P0[1]); \
    GAPA(C0=__builtin_amdgcn_mfma_f32_32x32x16_bf16(kf[0],qr[0],negm,0,0,0), P0[2],P0[3],P0[4],P0[5],     pw0[0]=PKW(P0,0), pw0[1]=PKW(P0,2), pw0); \
    VRD(4); SBAR(); GAPA(C1=__builtin_amdgcn_mfma_f32_32x32x16_bf16(kf[1],qr[0],negm,0,0,0), P0[6],P0[7],P0[8],P0[9],     pw0[2]=PKW(P0,4), pw0[3]=PKW(P0,6), pw0); \
    VRD(1); SBAR(); GAPA(C0=__builtin_amdgcn_mfma_f32_32x32x16_bf16(kf[2],qr[1],C0,0,0,0),   P0[10],P0[11],P0[12],P0[13], pw1[0]=PKW(P0,8), pw1[1]=PKW(P0,10), pw1); \
    VRD(5); SBAR(); GAPA(C1=__builtin_amdgcn_mfma_f32_32x32x16_bf16(kf[3],qr[1],C1,0,0,0),   P0[14],P0[15],P1[0],P1[1],   pw1[2]=PKW(P0,12),pw1[3]=PKW(P0,14), pw1); \
    VRD(2); SBAR(); GAPA(C0=__builtin_amdgcn_mfma_f32_32x32x16_bf16(kf[4],qr[2],C0,0,0,0),   P1[2],P1[3],P1[4],P1[5],     pw2[0]=PKW(P1,0), pw2[1]=PKW(P1,2), pw2); \
    VRD(6); SBAR(); GAPA(C1=__builtin_amdgcn_mfma_f32_32x32x16_bf16(kf[5],qr[2],C1,0,0,0),   P1[6],P1[7],P1[8],P1[9],     pw2[2]=PKW(P1,4), pw2[3]=PKW(P1,6), pw2); \
    VRD(3); SBAR(); GAPA(C0=__builtin_amdgcn_mfma_f32_32x32x16_bf16(kf[6],qr[3],C0,0,0,0),   P1[10],P1[11],P1[12],P1[13], pw3[0]=PKW(P1,8), pw3[1]=PKW(P1,10), pw3); \
    VRD(7); SBAR(); GAPA(C1=__builtin_amdgcn_mfma_f32_32x32x16_bf16(kf[7],qr[3],C1,0,0,0),   P1[14],P1[15],0.f,0.f,       pw3[2]=PKW(P1,12),pw3[3]=PKW(P1,14), pw3); \
    l_reg+=sacc; \
    if(GK){DMA_K((t)+3,sl_cur);} if(GV){DMA_V((t)+1,sl_next);} \
    CMASK(C0,C1,t); \
    { float a=MX3(C0[0],C0[1],C1[0]),b=MX3(C0[2],C0[3],C1[1]); a=MX3(a,C1[2],C1[3]); \
      _Pragma("unroll") for(int r=4;r<16;r+=4){a=MX3(a,C0[r],C0[r+1]);b=MX3(b,C0[r+2],C0[r+3]);a=MX3(a,C1[r],C1[r+1]);b=MX3(b,C1[r+2],C1[r+3]);} \
      float rm=__builtin_fmaxf(a,b); { auto rr=__builtin_amdgcn_permlane32_swap(__float_as_uint(rm),__float_as_uint(rm),false,false); rm=__builtin_fmaxf(__uint_as_float(rr[0]),__uint_as_float(rr[1])); } \
      resc=false; if(MODE==1) rm-=mhat; \
      if(__builtin_expect(__any(rm>(float)THRL),0)){ const float dl=__builtin_fmaxf(rm,0.f); mhat+=dl; \
        if(MODE==0){ _Pragma("unroll") for(int r=0;r<16;++r){C0[r]-=dl;C1[r]-=dl;} \
          _Pragma("unroll") for(int r=0;r<16;++r)negm[r]=-mhat; asm volatile("":"+v"(negm)); } \
        const float f=__builtin_amdgcn_exp2f(-dl); l_reg*=f; if(hi==0)wsf[r32]=f; resc=true; } \
      if(MODE==1){ _Pragma("unroll") for(int r=0;r<16;++r){C0[r]-=mhat;C1[r]-=mhat;} } } \
    SBAR(); \
    GAPB(o[0]=__builtin_amdgcn_mfma_f32_32x32x16_bf16(PAF(0),VFR(0),o[0],0,0,0), C0,0); \
    GAPB(o[1]=__builtin_amdgcn_mfma_f32_32x32x16_bf16(PAF(0),VFR(4),o[1],0,0,0), C0,4); \
    KRD(GL,0); GAPB(o[0]=__builtin_amdgcn_mfma_f32_32x32x16_bf16(PAF(1),VFR(1),o[0],0,0,0), C0,8); \
    KRD(GL,1); GAPB(o[1]=__builtin_amdgcn_mfma_f32_32x32x16_bf16(PAF(1),VFR(5),o[1],0,0,0), C0,12); \
    KRD(GL,2); GAPB(o[0]=__builtin_amdgcn_mfma_f32_32x32x16_bf16(PAF(2),VFR(2),o[0],0,0,0), C1,0); \
    KRD(GL,3); GAPB(o[1]=__builtin_amdgcn_mfma_f32_32x32x16_bf16(PAF(2),VFR(6),o[1],0,0,0), C1,4); \
    GAPB(o[0]=__builtin_amdgcn_mfma_f32_32x32x16_bf16(PAF(3),VFR(3),o[0],0,0,0), C1,8); \
    GAPB(o[1]=__builtin_amdgcn_mfma_f32_32x32x16_bf16(PAF(3),VFR(7),o[1],0,0,0), C1,12); \
    }while(0)
  int t=1;
  if(MODE==0) for(;t+5<NT;t+=2){
    STEP(pB0,pB1,pA0,pA1,t,true,true,true);     WAIT_BAR(2); RESC(); ROT();
    STEP(pA0,pA1,pB0,pB1,t+1,true,true,true);   WAIT_BAR(2); RESC(); ROT();
  }
  #define ENDW(tt) do{ if((tt)+3<NT){WAIT_BAR(2);} else if((tt)+2<NT){WAIT_BAR(1);} else {WAIT_BAR(0);} }while(0)
  for(;t+1<NT;t+=2){
    STEP(pB0,pB1,pA0,pA1,t,(t+3<NT),(t+1<NT),(t+1<NT));       ENDW(t);   RESC(); ROT();
    STEP(pA0,pA1,pB0,pB1,t+1,(t+4<NT),(t+2<NT),(t+2<NT));     ENDW(t+1); RESC(); ROT();
  }
  STEP(pB0,pB1,pA0,pA1,NT-1,false,false,false); RESC();
  { float sacc=pB0[0]+pB0[1]; _Pragma("unroll") for(int r=2;r<16;++r)sacc+=pB0[r]; _Pragma("unroll") for(int r=0;r<16;++r)sacc+=pB1[r]; l_reg+=sacc;
    pw0=(u32x4){PKW(pB0,0),PKW(pB0,2),PKW(pB0,4),PKW(pB0,6)};pw1=(u32x4){PKW(pB0,8),PKW(pB0,10),PKW(pB0,12),PKW(pB0,14)};pw2=(u32x4){PKW(pB1,0),PKW(pB1,2),PKW(pB1,4),PKW(pB1,6)};pw3=(u32x4){PKW(pB1,8),PKW(pB1,10),PKW(pB1,12),PKW(pB1,14)};
    SBAR(); pv(o,vb0+sl_cur,PAF(0),PAF(1),PAF(2),PAF(3)); }
  #undef PKW
  #undef PAF
  #undef VFR
  #undef PIN
  #undef MX3
  #undef GAPA
  #undef GAPB
  #undef EX
  #undef VRD
  #undef KRD
  #undef STEP
  #undef ENDW
  {auto rr=__builtin_amdgcn_permlane32_swap(__float_as_uint(l_reg),__float_as_uint(l_reg),false,false);l_reg=__uint_as_float(rr[0])+__uint_as_float(rr[1]);}
  if(MODE==1){ l_reg+=__builtin_amdgcn_exp2f(sinkl2-mhat); }
  if(hi==0)wsf[32+r32]=l_reg;asm volatile("s_waitcnt lgkmcnt(0)":::"memory");
  float rli[16];
  #pragma unroll
  for(int r=0;r<16;++r)rli[r]=__builtin_amdgcn_rcpf(wsf[32+crow(r,hi)]);
  bf16*Ow=YB+(long)(qrow0+wid*QBLK)*YP+ocol; const bf16*Zw=Pm+(long)(qrow0+wid*QBLK)*PP+zcol;
  { bf16*stg=(bf16*)(shm+LDS_OST)+wid*2048;
    #pragma unroll
    for(int r=0;r<16;++r){const int orow=crow(r,hi);
      #pragma unroll
      for(int d0=0;d0<2;++d0)stg[orow*64+d0*32+r32]=__float2bfloat16(o[d0][r]*rli[r]);}
    asm volatile("s_waitcnt lgkmcnt(0)":::"memory");
    #pragma unroll
    for(int i=0;i<4;++i){const int row=i*8+(lane>>3),ch=lane&7; const u32x4 v=*(const u32x4*)(stg+row*64+ch*8); const u32x4 z=*(const u32x4*)(Zw+(long)row*PP+ch*8); u32x4 w;
      #define GATE2(vv,zz) cvtpk_s(__uint_as_float((vv)<<16)*siluf_(__uint_as_float((zz)<<16)),__uint_as_float((vv)&0xffff0000u)*siluf_(__uint_as_float((zz)&0xffff0000u)))
      w.x=GATE2(v.x,z.x); w.y=GATE2(v.y,z.y); w.z=GATE2(v.z,z.z); w.w=GATE2(v.w,z.w);
      #undef GATE2
      *(u32x4*)(Ow+(long)row*YP+ch*8)=w;} }
  asm volatile("s_waitcnt lgkmcnt(0)\n\ts_barrier":::"memory");
  #undef DMA_K
  #undef DMA_V
  #undef CMASK
  #undef START
  #undef RESC
  #undef ROT
  #undef TROW
}
#undef SBAR
#undef WAIT_BAR
}

constexpr int NWAVES = 8;
constexpr int DM = 1024, SEQ = 8192, NCTX = 256, NB = 2;
constexpr int M_LAT = NB * SEQ, M_CTX = NB * NCTX, M_ALL = M_LAT + M_CTX;
constexpr int PW = 2816;
constexpr float RMS_EPS = 1e-6f;
constexpr float QSCALE = 0.125f * 1.4426950408889634f;
constexpr int C_AQ = 0, C_AK = 256, C_AV = 384, C_AZ = 512, C_DQ = 768, C_DK = 1024, C_DV = 1152, C_DZ = 1280, C_BF = 1536, C_BZ = 1792, C_CU = 2048, C_CV = 2304, C_CZ = 2560;

constexpr size_t MiB = 1u << 20;
constexpr size_t WS_CTL = 0, CTL_ZERO_BYTES = 1 * MiB;
constexpr size_t WS_MOD = 1 * MiB;
constexpr size_t WS_TAB = 2 * MiB;
constexpr size_t TAB_MA = 0, TAB_128 = 131072, TAB_64 = 229376, TAB_256 = 245760, TAB_WSP = 507904, TAB_ONES = 786432, TAB_BIASB = 1048576;
constexpr size_t WS_WIN = 4 * MiB, WS_WM = 16 * MiB, WS_WBR = 32 * MiB, WS_WOUT = 36 * MiB;
constexpr size_t WS_XC1 = 40 * MiB;
constexpr size_t WS_H = 42 * MiB, WS_YB = 75 * MiB, WS_T1 = 108 * MiB, WS_P = 124 * MiB;
constexpr size_t WS_GT = WS_P, WS_MG = WS_P + 40 * MiB;
constexpr size_t WS_MGC = 216 * MiB;
constexpr size_t WS_GTC = 218 * MiB;
constexpr size_t WS_END = 222 * MiB;
constexpr int CW_BAR = 4096;

constexpr int RING_BYTES = 147456, LDSCTL_OFF = RING_BYTES, MISC_OFF = LDSCTL_OFF + 320, LDS_BYTES = RING_BYTES + 1024;

#define GAS __attribute__((address_space(1)))
#define LAS __attribute__((address_space(3)))
typedef unsigned short bf16;
typedef unsigned v4u __attribute__((ext_vector_type(4)));
typedef unsigned v2u __attribute__((ext_vector_type(2)));
typedef float f32x4 __attribute__((ext_vector_type(4)));
typedef float f32x16 __attribute__((ext_vector_type(16)));
typedef short bf16x8 __attribute__((ext_vector_type(8)));
typedef GAS unsigned gu32;
#define RLX_AGENT __ATOMIC_RELAXED, __HIP_MEMORY_SCOPE_AGENT
#define LDS_WAIT() asm volatile("s_waitcnt lgkmcnt(0)" ::: "memory")
#define MFMA32(a, b, c) __builtin_amdgcn_mfma_f32_32x32x16_bf16((a), (b), (c), 0, 0, 0)
#define DI __device__ __forceinline__
DI unsigned f2bf(float f) { unsigned u = __builtin_bit_cast(unsigned, f); return (u + 0x7fffu + ((u >> 16) & 1u)) >> 16; }
DI unsigned pk2(float lo, float hi) { return f2bf(lo) | (f2bf(hi) << 16); }
DI float bf2f(bf16 v) { return __uint_as_float((unsigned)v << 16); }
DI float wlo(unsigned w) { return __uint_as_float(w << 16); }
DI float whi(unsigned w) { return __uint_as_float(w & 0xffff0000u); }
DI int crow(int reg, int h) { return (reg & 3) + 8 * (reg >> 2) + 4 * h; }
DI int krow(int s, int h, int j) { return 16 * s + 8 * (j >> 2) + 4 * h + (j & 3); }
DI float siluf(float x) { return x * __builtin_amdgcn_rcpf(1.0f + __builtin_amdgcn_exp2f(-1.4426950408889634f * x)); }
DI float geluf(float v) {
    const float av = __builtin_fabsf(v), d = av * 0.2316418882f + 1.0f, t = __builtin_amdgcn_rcpf(d);
    float q = t * 0.5307027145f + (-0.7265760135f); q = q * t + 0.7107068705f; q = q * t + (-0.142248368f); q = q * t + 0.127414796f; q = q * t;
    const float e = __builtin_amdgcn_exp2f((v * v) * (-0.72134752044f)), m = v * (q * e), r = v - m;
    return v < 0.f ? m : r;
}
typedef float f32x2_t __attribute__((ext_vector_type(2))); typedef __bf16 bf16x2_t __attribute__((ext_vector_type(2)));
DI unsigned cvtpk(float lo, float hi) { f32x2_t v = {lo, hi}; bf16x2_t b = __builtin_convertvector(v, bf16x2_t); return __builtin_bit_cast(unsigned, b); }
DI bf16x8 pack_step(const f32x16& x, int s) {
    v4u p; p.x = cvtpk(x[8 * s], x[8 * s + 1]); p.y = cvtpk(x[8 * s + 2], x[8 * s + 3]); p.z = cvtpk(x[8 * s + 4], x[8 * s + 5]); p.w = cvtpk(x[8 * s + 6], x[8 * s + 7]);
    return __builtin_bit_cast(bf16x8, p);
}
DI float shx(float v, int o, int lane) { return __int_as_float(__builtin_amdgcn_ds_bpermute((lane ^ o) << 2, __float_as_int(v))); }
DI float wave_sum(float v, int lane) {
#pragma unroll
    for (int o = 1; o < 64; o <<= 1) v += shx(v, o, lane);
    return v;
}

#define XB_TMO      128
#define XB_XCNT(j)  (256  + 64 * (j))
#define XB_XSUB(j)  (1280 + 64 * (j))
#define XB_XGEN(j)  (2304 + 64 * (j))
#define XB_TOP      3328
#define XB_TOPGEN   3392
#define XCD_BAR_WORDS 3456
#define XB_SPIN_CAP (1u << 22)
DI unsigned xb_ld(unsigned* p)              { return __hip_atomic_load(p, __ATOMIC_RELAXED, __HIP_MEMORY_SCOPE_AGENT); }
DI unsigned xb_add(unsigned* p, unsigned v) { return __hip_atomic_fetch_add(p, v, __ATOMIC_RELAXED, __HIP_MEMORY_SCOPE_AGENT); }
DI unsigned xb_xcc_id() { return (unsigned)__builtin_amdgcn_s_getreg((3 << 11) | 20) & 0xFu; }
#define XB_SPIN(cond, bar) do { unsigned _sp = 0; while (cond) { __builtin_amdgcn_s_sleep(1); \
    if ((++_sp & 255u) == 0u) { if (xb_ld(&(bar)[XB_TMO])) break; if (_sp > XB_SPIN_CAP) { atomicAdd(&(bar)[XB_TMO], 1u); break; } } } } while (0)
struct XcdBarrier { unsigned* bar; unsigned x; volatile LAS unsigned* st; };
DI XcdBarrier xcd_barrier_post(unsigned* bar, volatile LAS unsigned* st) {
    XcdBarrier b; b.bar = bar; b.x = xb_xcc_id(); b.st = st;
    if (threadIdx.x == 0) (void)xb_add(&bar[XB_XCNT(b.x)], 1u);
    return b;
}
DI void xcd_barrier_complete(unsigned* bar, unsigned x, unsigned& nloc, unsigned& nx) {
    const unsigned G = gridDim.x * gridDim.y * gridDim.z;
    unsigned sum, cnt, mine, sp = 0u;
    for (;;) {
        sum = 0u; cnt = 0u; mine = 0u;
#pragma unroll
        for (unsigned j = 0; j < 16; ++j) { const unsigned c = xb_ld(&bar[XB_XCNT(j)]); sum += c; cnt += (c > 0u) ? 1u : 0u; mine = (j == x) ? c : mine; }
        if (sum == G) break;
        __builtin_amdgcn_s_sleep(1);
        if ((++sp & 255u) == 0u) { if (xb_ld(&bar[XB_TMO])) break; if (sp > XB_SPIN_CAP) { atomicAdd(&bar[XB_TMO], 1u); break; } }
    }
    nloc = mine > 0u ? mine : 1u; nx = cnt > 0u ? cnt : 1u;
}
DI void xcd_barrier(const XcdBarrier& b) {
    asm volatile("s_waitcnt vmcnt(0)" ::: "memory");
    __syncthreads();
    if (threadIdx.x == 0) {
        unsigned* bar = b.bar;
        __builtin_amdgcn_s_waitcnt(0);
        __builtin_amdgcn_fence(__ATOMIC_ACQUIRE, "agent");
        unsigned nloc = b.st[0], nx = b.st[1];
        if (nloc == 0u) { xcd_barrier_complete(bar, b.x, nloc, nx); b.st[0] = nloc; b.st[1] = nx; }
        const unsigned old = xb_add(&bar[XB_XSUB(b.x)], 1u);
        const unsigned gen = old / nloc;
        if (old + 1u == (gen + 1u) * nloc) {
            __builtin_amdgcn_fence(__ATOMIC_RELEASE, "agent");
            asm volatile("s_waitcnt vmcnt(0)" ::: "memory");
            const unsigned og = xb_add(&bar[XB_TOP], 1u);
            const unsigned tg = og / nx;
            if (og + 1u == (tg + 1u) * nx) xb_add(&bar[XB_TOPGEN], 1u);
            else XB_SPIN(xb_ld(&bar[XB_TOPGEN]) == tg, bar);
            xb_add(&bar[XB_XGEN(b.x)], 1u);
            asm volatile("s_waitcnt vmcnt(0)" ::: "memory");
        } else {
            XB_SPIN(xb_ld(&bar[XB_XGEN(b.x)]) == gen, bar);
            asm volatile("s_waitcnt vmcnt(0)" ::: "memory");
        }
    }
    __syncthreads();
}

struct Frame {
    LAS unsigned char* lds;
    int tid, lane, wave, vcu, G;
};

DI void p0_transpose_item(const float* W, int N, bf16* WT, int ldt, int row_off, int col_off, LAS float* scr, int item, int lane) {
    const int nblk = N / 32, kb = item / nblk, nb = item % nblk, k0 = 64 * kb, n0 = 32 * nb;
#pragma unroll 8
    for (int i = 0; i < 32; ++i) { const int kk = 2 * i + (lane >> 5); scr[kk * 33 + (lane & 31)] = W[(size_t)(k0 + kk) * N + n0 + (lane & 31)]; }
    LDS_WAIT(); asm volatile("" ::: "memory");
    const int c = lane & 7;
#pragma unroll
    for (int j = 0; j < 4; ++j) { const int n = (lane >> 3) + 8 * j; const LAS float* s = scr + (8 * c) * 33 + n;
        v4u o; o.x = pk2(s[0 * 33], s[1 * 33]); o.y = pk2(s[2 * 33], s[3 * 33]); o.z = pk2(s[4 * 33], s[5 * 33]); o.w = pk2(s[6 * 33], s[7 * 33]);
        *(GAS v4u*)(WT + (size_t)(row_off + n0 + n) * ldt + col_off + k0 + 8 * c) = o; }
    LDS_WAIT(); asm volatile("" ::: "memory");
}

struct Args { const float* in[20]; float* out; unsigned char* ws; };
enum { I_X = 0, I_C, I_CTX, I_CCTX, I_NORMW, I_WADA, I_BADA, I_WIN, I_QNA, I_KNA, I_QND, I_KND, I_SINK, I_WFNET, I_WSP, I_BSP, I_WBR, I_WMERGE, I_BMERGE, I_WOUT };

DI void p0_prologue(const Frame& F, const Args& a) {
    unsigned char* ws = a.ws;
    for (int u = F.vcu; u < 96; u += F.G) {
        const int l = u / 48, j0 = 64 * (u % 48);
        LAS float* sl = (LAS float*)F.lds; LAS float* red = sl + 3072;
        for (int i = F.tid; i < 3072; i += 512) { const int v = i >> 10, k = i & 1023; const float cv = (v < 2) ? a.in[I_C][v * 1024 + k] : a.in[I_CCTX][k]; sl[i] = siluf(cv); }
        __syncthreads();
        float a0 = 0.f, a1 = 0.f, a2 = 0.f;
        const float* wp = a.in[I_WADA] + (size_t)l * 1024 * 3072 + (size_t)(128 * F.wave) * 3072 + j0 + F.lane;
#pragma unroll 32
        for (int kk = 0; kk < 128; ++kk) { const float w = wp[(size_t)kk * 3072]; const int k = 128 * F.wave + kk; a0 += sl[k] * w; a1 += sl[1024 + k] * w; a2 += sl[2048 + k] * w; }
        red[(F.wave * 3 + 0) * 64 + F.lane] = a0; red[(F.wave * 3 + 1) * 64 + F.lane] = a1; red[(F.wave * 3 + 2) * 64 + F.lane] = a2;
        __syncthreads();
        if (F.tid < 192) { const int v = F.tid >> 6, jj = F.tid & 63; float s = a.in[I_BADA][l * 3072 + j0 + jj];
#pragma unroll
            for (int w = 0; w < 8; ++w) s += red[(w * 3 + v) * 64 + jj];
            ((float*)(ws + WS_MOD))[(l * 3 + v) * 3072 + j0 + jj] = s; }
        __syncthreads();
    }
    {
        LAS float* scr = (LAS float*)(F.lds + F.wave * 16384);
        const int gw = F.vcu * NWAVES + F.wave, NGW = F.G * NWAVES;
        constexpr int I_IN = 16 * 88, I_M = 16 * 128, I_O = 16 * 32, I_B = 4 * 32, PER_L = I_IN + I_M + I_O + 4 * I_B;
        for (int it = gw; it < 2 * PER_L; it += NGW) {
            const int l = it / PER_L; int r = it % PER_L;
            if (r < I_IN) { p0_transpose_item(a.in[I_WIN] + (size_t)l * 1024 * PW, PW, (bf16*)(ws + WS_WIN) + (size_t)l * PW * 1024, 1024, 0, 0, scr, r, F.lane); continue; } r -= I_IN;
            if (r < I_M) { p0_transpose_item(a.in[I_WMERGE] + (size_t)l * 1024 * 4096, 4096, (bf16*)(ws + WS_WM) + (size_t)l * 4096 * 1024, 1024, 0, 0, scr, r, F.lane); continue; } r -= I_M;
            if (r < I_O) { p0_transpose_item(a.in[I_WOUT] + (size_t)l * 1024 * 1024, 1024, (bf16*)(ws + WS_WOUT) + (size_t)l * 1024 * 1024, 1024, 0, 0, scr, r, F.lane); continue; } r -= I_O;
            { const int br = r / I_B; r -= br * I_B;
              p0_transpose_item(a.in[I_WBR] + ((size_t)l * 4 + br) * 256 * 1024, 1024, (bf16*)(ws + WS_WBR) + (size_t)l * 1024 * 1024, 1024, 0, 256 * br, scr, r, F.lane); }
        }
    }
    {
        const int gt = F.vcu * 512 + F.tid, NGT = F.G * 512;
        bf16* tab = (bf16*)(ws + WS_TAB);
        for (int e = gt; e < 65536; e += NGT) {
            const int l = e >> 15, g = (e >> 13) & 3, col = (e >> 6) & 127, c = e & 63, d = col & 63;
            const float* wf = a.in[I_WFNET] + ((size_t)(l * 4 + g) * 64) * 64 + d; float s = 0.f;
            for (int j = 0; j < 64; ++j) { const float rev = (float)((c * j) & 63) * (1.0f / 64.0f); const float tw = (col < 64) ? __builtin_amdgcn_cosf(rev) : -__builtin_amdgcn_sinf(rev); s += tw * wf[j * 64]; }
            tab[TAB_MA / 2 + e] = (bf16)f2bf(s);
        }
        for (int e = gt; e < 49152; e += NGT) {
            const int mat = e / 16384, rem = e % 16384, k1b = rem >> 12, nb = (rem >> 10) & 3, s = (rem >> 9) & 1, ln = (rem >> 3) & 63, j = rem & 7;
            const int n1 = 32 * nb + krow(s, ln >> 5, j), k1 = 32 * k1b + (ln & 31); const float rev = (float)((n1 * k1) & 127) * (1.0f / 128.0f);
            const float v = (mat == 0) ? __builtin_amdgcn_cosf(rev) : (mat == 1) ? __builtin_amdgcn_sinf(rev) : -__builtin_amdgcn_sinf(rev);
            tab[TAB_128 / 2 + e] = (bf16)f2bf(v);
        }
        for (int e = gt; e < 8192; e += NGT) {
            const int mat = e >> 12, k2 = (e >> 6) & 63, n2 = e & 63; const float rev = (float)((k2 * n2) & 63) * (1.0f / 64.0f);
            tab[TAB_64 / 2 + e] = (bf16)f2bf(mat == 0 ? __builtin_amdgcn_cosf(rev) : __builtin_amdgcn_sinf(rev));
        }
        for (int e = gt; e < 131072; e += NGT) {
            const int mat = e >> 16, rem = e & 65535, kb = rem >> 13, nb = (rem >> 10) & 7, s = (rem >> 9) & 1, ln = (rem >> 3) & 63, j = rem & 7;
            const int n = 32 * nb + krow(s, ln >> 5, j), k = 32 * kb + (ln & 31); const float rev = (float)((n * k) & 255) * (1.0f / 256.0f);
            tab[TAB_256 / 2 + e] = (bf16)f2bf(mat == 0 ? __builtin_amdgcn_cosf(rev) : __builtin_amdgcn_sinf(rev));
        }
        for (int e = gt; e < 131072; e += NGT) tab[TAB_WSP / 2 + e] = (bf16)f2bf(a.in[I_WSP][e]);
        for (int e = gt; e < M_CTX * 1024 / 4; e += NGT) { ((f32x4*)(ws + WS_XC1))[e] = ((const f32x4*)a.in[I_CTX])[e]; ((f32x4*)(ws + WS_MGC))[e] = (f32x4){0.f, 0.f, 0.f, 0.f}; }
        for (int e = gt; e < 4096; e += NGT) tab[TAB_ONES / 2 + e] = (bf16)(((e & 31) == 0) ? 0x3f80 : 0);
        for (int e = gt; e < 262144; e += NGT) tab[TAB_BIASB / 2 + e] = (bf16)(((e & 31) == 0) ? f2bf(a.in[I_BMERGE][e >> 5]) : 0u);
    }
}

DI void p1_modrms(const Frame& F, const Args& a, int l, const float* xlat, const float* xctx, int with_ctx) {
    const float* mod = (const float*)(a.ws + WS_MOD) + (size_t)l * 3 * 3072;
    const float* nw = a.in[I_NORMW] + l * 1024;
    bf16* H = (bf16*)(a.ws + WS_H);
    const int gw = F.vcu * NWAVES + F.wave, NGW = F.G * NWAVES;
    const int nrows = with_ctx ? M_ALL : M_LAT;
    int vcur = -1; f32x4 av[4], bv[4];
    for (int row = gw; row < nrows; row += NGW) {
        const int v = row < SEQ ? 0 : (row < M_LAT ? 1 : 2);
        if (v != vcur) { vcur = v;
#pragma unroll
            for (int j = 0; j < 4; ++j) { const int c = 4 * (F.lane + 64 * j); const f32x4 w = *(const f32x4*)(nw + c), sc = *(const f32x4*)(mod + v * 3072 + 1024 + c);
                av[j] = w * (sc + 1.0f); bv[j] = *(const f32x4*)(mod + v * 3072 + c); } }
        const float* xr = (row < M_LAT) ? xlat + (size_t)row * 1024 : xctx + (size_t)(row - M_LAT) * 1024;
        f32x4 x[4]; float ss = 0.f;
#pragma unroll
        for (int j = 0; j < 4; ++j) { x[j] = *(const f32x4*)(xr + 4 * (F.lane + 64 * j)); ss += (x[j].x * x[j].x + x[j].y * x[j].y) + (x[j].z * x[j].z + x[j].w * x[j].w); }
        const float rstd = __builtin_amdgcn_rsqf(wave_sum(ss, F.lane) * (1.0f / 1024.0f) + RMS_EPS);
#pragma unroll
        for (int j = 0; j < 4; ++j) { const f32x4 h = x[j] * rstd * av[j] + bv[j]; v2u o; o.x = pk2(h.x, h.y); o.y = pk2(h.z, h.w);
            *(v2u*)(H + (size_t)row * 1024 + 4 * (F.lane + 64 * j)) = o; }
    }
}

DI void p3_prep(const Frame& F, const Args& a, int l, bf16* P) {
    const int gw = F.vcu * NWAVES + F.wave, NGW = F.G * NWAVES;
    const int d = F.lane;
    const float wqa = a.in[I_QNA][l * 64 + d], wka = a.in[I_KNA][l * 64 + d], wqd = a.in[I_QND][l * 64 + d], wkd = a.in[I_KND][l * 64 + d];
    const float inv = __builtin_amdgcn_exp2f(-(float)(d & 15) * (13.287712379549449f / 16.0f));
    const float sgn = (d & 16) ? 1.0f : -1.0f;
    const int nrows = M_ALL;
    for (int row = gw; row < nrows; row += NGW) {
        const bool isctx = row >= M_LAT;
        const int n = row & (SEQ - 1);
        float cs = 1.0f, sn = 0.0f;
        if (!isctx) { const float pos = (float)((d < 32) ? (n >> 6) : (n & 63)); const float rev = pos * inv * 0.15915494309189535f; cs = __builtin_amdgcn_cosf(rev); sn = __builtin_amdgcn_sinf(rev); }
        bf16* pr = P + (size_t)row * PW;
        const bool qok = !(isctx && l == 1);
        float v[12];
#pragma unroll
        for (int s = 0; s < 12; ++s) { const int col = (s < 4) ? C_AQ + 64 * s : (s < 6) ? C_AK + 64 * (s - 4) : (s < 10) ? C_DQ + 64 * (s - 6) : C_DK + 64 * (s - 10);
            const bool isq = (s < 4) || (s >= 6 && s < 10);
            v[s] = (isq && !qok) ? 0.f : bf2f(pr[col + d]); }
#pragma unroll
        for (int s = 0; s < 12; ++s) { const int col = (s < 4) ? C_AQ + 64 * s : (s < 6) ? C_AK + 64 * (s - 4) : (s < 10) ? C_DQ + 64 * (s - 6) : C_DK + 64 * (s - 10);
            const bool isq = (s < 4) || (s >= 6 && s < 10);
            const float w = (s < 4) ? wqa : (s < 6) ? wka : (s < 10) ? wqd : wkd;
            const float ss = wave_sum(v[s] * v[s], d);
            float y = v[s] * __builtin_amdgcn_rsqf(ss * (1.0f / 64.0f) + RMS_EPS) * w;
            const float p = shx(y, 16, d);
            y = y * cs + sgn * p * sn;
            if (isq) y *= QSCALE;
            if (!isq || qok) pr[col + d] = (bf16)f2bf(y); }
    }
}

DI void fnet_stepA(const bf16* xrow, const bf16* MAt, int r32, int hi, bf16x8 (&gs)[4][2]) {
    bf16x8 xa[4];
#pragma unroll
    for (int s4 = 0; s4 < 4; ++s4) xa[s4] = *(const bf16x8*)(xrow + 16 * s4 + 8 * hi);
#pragma unroll
    for (int cb = 0; cb < 4; ++cb) { f32x16 acc = f32x16{};
#pragma unroll
        for (int s4 = 0; s4 < 4; ++s4) { const bf16x8 bfr = *(const bf16x8*)(MAt + (32 * cb + r32) * 64 + 16 * s4 + 8 * hi); acc = MFMA32(xa[s4], bfr, acc); }
        gs[cb][0] = pack_step(acc, 0); gs[cb][1] = pack_step(acc, 1); }
}

DI void fnet_s1_unit(const Frame& F, const Args& a, int l, int u, const bf16* P) {
    const int b = u >> 7, n2grp = (u >> 4) & 7, g = (u >> 2) & 3, k1b = u & 3;
    const int lane = F.lane, r32 = lane & 31, hi = lane >> 5, w = F.wave, n2 = 8 * n2grp + w;
    const bf16* tab = (const bf16*)(a.ws + WS_TAB);
    const bf16* MAt = tab + TAB_MA / 2 + (size_t)(l * 4 + g) * 128 * 64;
    const bf16* T128 = tab + TAB_128 / 2;
    f32x16 Tr[2], Ti[2];
#pragma unroll
    for (int j = 0; j < 2; ++j) { Tr[j] = f32x16{}; Ti[j] = f32x16{}; }
#pragma unroll 1
    for (int nb = 0; nb < 4; ++nb) {
        const bf16* xrow = P + (size_t)(SEQ * b + 64 * (32 * nb + r32) + n2) * PW + C_BF + 64 * g;
        bf16x8 gs[4][2]; fnet_stepA(xrow, MAt, r32, hi, gs);
#pragma unroll
        for (int s = 0; s < 2; ++s) {
            const size_t fo = ((size_t)((k1b * 4 + nb) * 2 + s) * 64 + lane) * 8;
            const bf16x8 ca = *(const bf16x8*)(T128 + fo), sa = *(const bf16x8*)(T128 + 16384 + fo), na = *(const bf16x8*)(T128 + 32768 + fo);
            Tr[0] = MFMA32(ca, gs[0][s], Tr[0]); Tr[0] = MFMA32(sa, gs[2][s], Tr[0]);
            Tr[1] = MFMA32(ca, gs[1][s], Tr[1]); Tr[1] = MFMA32(sa, gs[3][s], Tr[1]);
            Ti[0] = MFMA32(ca, gs[2][s], Ti[0]); Ti[0] = MFMA32(na, gs[0][s], Ti[0]);
            Ti[1] = MFMA32(ca, gs[3][s], Ti[1]); Ti[1] = MFMA32(na, gs[1][s], Ti[1]); }
    }
    LAS bf16* tl = (LAS bf16*)F.lds;
#pragma unroll
    for (int i = 0; i < 16; ++i) { const int k1l = crow(i, hi), k1 = 32 * k1b + k1l;
        const float rev = (float)((n2 * k1) & 8191) * (1.0f / 8192.0f); const float c = __builtin_amdgcn_cosf(rev), s = __builtin_amdgcn_sinf(rev);
#pragma unroll
        for (int jb = 0; jb < 2; ++jb) { const float tr = Tr[jb][i], ti = Ti[jb][i];
            tl[(k1l * 128 + 32 * jb + r32) * 8 + w] = (bf16)f2bf(tr * c + ti * s);
            tl[(k1l * 128 + 64 + 32 * jb + r32) * 8 + w] = (bf16)f2bf(ti * c - tr * s); } }
    __syncthreads();
    bf16* T1 = (bf16*)(a.ws + WS_T1);
#pragma unroll 4
    for (int pass = 0; pass < 8; ++pass) { const int q = F.tid + 512 * pass, k1l = q >> 7, colL = q & 127;
        const v4u v = *(const LAS v4u*)(F.lds + (size_t)q * 16);
        *(v4u*)(T1 + ((((size_t)(b * 128 + 32 * k1b + k1l) * 8 + n2grp) * 512) + g * 128 + colL) * 8) = v; }
    __syncthreads();
}

DI void fnet_ctx_unit(const Frame& F, const Args& a, int l, int u, const bf16* P, bf16* YB) {
    const int b = u >> 2, g = u & 3;
    const int lane = F.lane, r32 = lane & 31, hi = lane >> 5, w = F.wave;
    const bf16* tab = (const bf16*)(a.ws + WS_TAB);
    const bf16* MAt = tab + TAB_MA / 2 + (size_t)(l * 4 + g) * 128 * 64;
    const bf16* T256 = tab + TAB_256 / 2;
    f32x16 Y[2]; Y[0] = f32x16{}; Y[1] = f32x16{};
#pragma unroll 1
    for (int nb = 0; nb < 8; ++nb) {
        const bf16* xrow = P + (size_t)(M_LAT + NCTX * b + 32 * nb + r32) * PW + C_BF + 64 * g;
        bf16x8 gs[4][2]; fnet_stepA(xrow, MAt, r32, hi, gs);
#pragma unroll
        for (int s = 0; s < 2; ++s) {
            const size_t fo = ((size_t)((w * 8 + nb) * 2 + s) * 64 + lane) * 8;
            const bf16x8 ca = *(const bf16x8*)(T256 + fo), sa = *(const bf16x8*)(T256 + 65536 + fo);
            Y[0] = MFMA32(ca, gs[0][s], Y[0]); Y[0] = MFMA32(sa, gs[2][s], Y[0]);
            Y[1] = MFMA32(ca, gs[1][s], Y[1]); Y[1] = MFMA32(sa, gs[3][s], Y[1]); }
    }
#pragma unroll
    for (int jb = 0; jb < 2; ++jb)
#pragma unroll
        for (int i = 0; i < 16; ++i) { const int k = 32 * w + crow(i, hi), d = 32 * jb + r32; const size_t row = (size_t)(M_LAT + NCTX * b + k);
            const float z = bf2f(P[row * PW + C_BZ + 64 * g + d]);
            YB[row * 1024 + 512 + 64 * g + d] = (bf16)f2bf(Y[jb][i] * (1.0f / 128.0f) * siluf(z)); }
}

#ifndef B_SCALE
#define B_SCALE 1.0f
#endif
#ifndef C_SCALE
#define C_SCALE 1.0f
#endif
DI void fnet_s3_unit(const Frame& F, const Args& a, int u, const bf16* P, bf16* YB) {
    const int b = u >> 7, k1 = u & 127;
    const int lane = F.lane, r32 = lane & 31, hi = lane >> 5, g = F.wave >> 1, jb = F.wave & 1;
    const bf16* T64 = (const bf16*)(a.ws + WS_TAB) + TAB_64 / 2;
    const bf16* T1 = (const bf16*)(a.ws + WS_T1);
    f32x16 Y[2]; Y[0] = f32x16{}; Y[1] = f32x16{};
#pragma unroll
    for (int sc = 0; sc < 4; ++sc)
#pragma unroll
        for (int ri = 0; ri < 2; ++ri) {
            const bf16x8 afr = *(const bf16x8*)(T1 + ((((size_t)(b * 128 + k1) * 8 + 2 * sc + hi) * 512) + g * 128 + ri * 64 + 32 * jb + r32) * 8);
#pragma unroll
            for (int k2b = 0; k2b < 2; ++k2b) { const bf16x8 bfr = *(const bf16x8*)(T64 + ri * 4096 + (32 * k2b + r32) * 64 + 16 * sc + 8 * hi); Y[k2b] = MFMA32(afr, bfr, Y[k2b]); } }
#pragma unroll
    for (int k2b = 0; k2b < 2; ++k2b) { const size_t row = (size_t)(SEQ * b + k1 + 128 * (32 * k2b + r32));
#pragma unroll
        for (int q = 0; q < 4; ++q) { const int d0 = 32 * jb + 8 * q + 4 * hi;
            const v2u z = *(const v2u*)(P + row * PW + C_BZ + 64 * g + d0);
            v2u o; o.x = pk2(Y[k2b][4 * q] * (B_SCALE * 0.0013810679320049757f) * siluf(wlo(z.x)), Y[k2b][4 * q + 1] * (B_SCALE * 0.0013810679320049757f) * siluf(whi(z.x)));
            o.y = pk2(Y[k2b][4 * q + 2] * (B_SCALE * 0.0013810679320049757f) * siluf(wlo(z.y)), Y[k2b][4 * q + 3] * (B_SCALE * 0.0013810679320049757f) * siluf(whi(z.y)));
            *(v2u*)(YB + row * 1024 + 512 + 64 * g + d0) = o; } }
}

DI void sgu_unit(const Frame& F, const Args& a, int l, int u, const bf16* P, bf16* YB) {
    constexpr int VP = 136;
    LAS bf16* vt = (LAS bf16*)F.lds;
    const int ci = u >> 2, g = u & 3;
    const size_t row0 = (size_t)ci * 128;
    { const int q = F.tid & 127, cq = F.tid >> 7; const bf16* src = P + (row0 + q) * PW + C_CV + 64 * g + 16 * cq;
#pragma unroll
      for (int i = 0; i < 2; ++i) { const v4u v = *(const v4u*)(src + 8 * i); const unsigned wv[4] = {v.x, v.y, v.z, v.w};
#pragma unroll
          for (int e = 0; e < 4; ++e) { vt[(16 * cq + 8 * i + 2 * e) * VP + q] = (bf16)f2bf(geluf(wlo(wv[e]))); vt[(16 * cq + 8 * i + 2 * e + 1) * VP + q] = (bf16)f2bf(geluf(whi(wv[e]))); } } }
    __syncthreads();
    const int lane = F.lane, r32 = lane & 31, hi = lane >> 5, pb = F.wave >> 1, cb = F.wave & 1;
    const bf16* Wsp = (const bf16*)(a.ws + WS_TAB) + TAB_WSP / 2 + (size_t)(l * 4 + g) * 128 * 128;
    f32x16 acc = f32x16{};
#pragma unroll
    for (int s = 0; s < 8; ++s) {
        const bf16x8 af = *(const LAS bf16x8*)(vt + (32 * cb + r32) * VP + 16 * s + 8 * hi);
        const bf16x8 bfr = *(const bf16x8*)(Wsp + (32 * pb + r32) * 128 + 16 * s + 8 * hi);
        acc = MFMA32(af, bfr, acc);
    }
    const int p = 32 * pb + r32; const float bb = a.in[I_BSP][(l * 4 + g) * 128 + p]; const bf16* pr = P + (row0 + p) * PW;
#pragma unroll
    for (int q = 0; q < 4; ++q) { const int c0 = 64 * g + 32 * cb + 8 * q + 4 * hi;
        const v2u uu = *(const v2u*)(pr + C_CU + c0), zz = *(const v2u*)(pr + C_CZ + c0);
        v2u o; o.x = pk2(C_SCALE * geluf(wlo(uu.x)) * (acc[4 * q] + bb) * siluf(wlo(zz.x)), C_SCALE * geluf(whi(uu.x)) * (acc[4 * q + 1] + bb) * siluf(whi(zz.x)));
        o.y = pk2(C_SCALE * geluf(wlo(uu.y)) * (acc[4 * q + 2] + bb) * siluf(wlo(zz.y)), C_SCALE * geluf(whi(uu.y)) * (acc[4 * q + 3] + bb) * siluf(whi(zz.y)));
        *(v2u*)(YB + (row0 + p) * 1024 + 768 + c0) = o; }
    __syncthreads();
}

DI void p5_ctx_convert(const Frame& F, const Args& a) {
    const int gt = F.vcu * 512 + F.tid, NGT = F.G * 512;
    const f32x4* src = (const f32x4*)(a.ws + WS_MGC); v2u* dst = (v2u*)((bf16*)(a.ws + WS_MG) + (size_t)M_LAT * 1024);
    for (int e = gt; e < M_CTX * 1024 / 4; e += NGT) { const f32x4 v = src[e]; v2u o; o.x = pk2(v.x, v.y); o.y = pk2(v.z, v.w); dst[e] = o; }
}

#ifdef SELFCHECK
constexpr int CW_CHK = 8192;
DI unsigned hsh(unsigned x) { x *= 2654435761u; x ^= x >> 15; x *= 2246822519u; x ^= x >> 13; x *= 3266489917u; x ^= x >> 16; return x; }
DI void chk_acc(const Args& a, int id, float got, float want) {
    unsigned* w = (unsigned*)(a.ws + WS_CTL) + CW_CHK + 4 * id;
    float d = __builtin_fabsf(got - want); if (!(d == d) || d > 1e15f) d = 1e15f;
    atomicAdd((float*)w, d * d); atomicAdd((float*)(w + 1), want * want); atomicAdd(w + 2, 1u); atomicMax(w + 3, __float_as_uint(d));
}
DI float bfr(float x) { return __uint_as_float(f2bf(x) << 16); }
DI void chk_p0(const Frame& F, const Args& a) {
    const int gt = F.vcu * 512 + F.tid, NGT = F.G * 512;
    for (int s = gt; s < 18432; s += NGT) { const int l = s / 9216, v = (s / 3072) % 3, j = s % 3072; float acc = a.in[I_BADA][l * 3072 + j];
        for (int k = 0; k < 1024; ++k) { const float cv = (v < 2) ? a.in[I_C][v * 1024 + k] : a.in[I_CCTX][k]; acc += siluf(cv) * a.in[I_WADA][((size_t)l * 1024 + k) * 3072 + j]; }
        chk_acc(a, 0, ((const float*)(a.ws + WS_MOD))[(l * 3 + v) * 3072 + j], acc); }
    for (int s = gt; s < 65536; s += NGT) { const unsigned h = hsh(s); const int l = (s >> 2) & 1, m = s & 3, k = h & 1023; const unsigned h2 = hsh(h + 77u);
        float got, want;
        if (m == 0) { const int n = h2 % PW; want = bfr(a.in[I_WIN][((size_t)l * 1024 + k) * PW + n]); got = bf2f(((const bf16*)(a.ws + WS_WIN))[((size_t)l * PW + n) * 1024 + k]); }
        else if (m == 1) { const int n = h2 & 4095; want = bfr(a.in[I_WMERGE][((size_t)l * 1024 + k) * 4096 + n]); got = bf2f(((const bf16*)(a.ws + WS_WM))[((size_t)l * 4096 + n) * 1024 + k]); }
        else if (m == 2) { const int n = h2 & 1023; want = bfr(a.in[I_WOUT][((size_t)l * 1024 + k) * 1024 + n]); got = bf2f(((const bf16*)(a.ws + WS_WOUT))[((size_t)l * 1024 + n) * 1024 + k]); }
        else { const int n = h2 & 1023, br = k >> 8, kk = k & 255; want = bfr(a.in[I_WBR][(((size_t)l * 4 + br) * 256 + kk) * 1024 + n]); got = bf2f(((const bf16*)(a.ws + WS_WBR))[((size_t)l * 1024 + n) * 1024 + 256 * br + kk]); }
        chk_acc(a, 1, got, want); }
}
DI int sample_row(unsigned h, int l) { const int r = h % M_ALL; (void)l; return ((h >> 20) & 7) == 0 ? M_LAT + (h % M_CTX) : r; }
DI void chk_h(const Frame& F, const Args& a, int l, int id) {
    const float* mod = (const float*)(a.ws + WS_MOD) + (size_t)l * 3 * 3072; const bf16* H = (const bf16*)(a.ws + WS_H);
    const int gw = F.vcu * NWAVES + F.wave, NGW = F.G * NWAVES;
    for (int s = gw; s < M_ALL; s += NGW) { const int row = s; const int v = row < SEQ ? 0 : (row < M_LAT ? 1 : 2);
        const float* xr = (row < M_LAT) ? ((l == 0) ? a.in[I_X] : a.out) + (size_t)row * 1024 : ((l == 0) ? a.in[I_CTX] : (const float*)(a.ws + WS_XC1)) + (size_t)(row - M_LAT) * 1024;
        float ss = 0.f; for (int j = 0; j < 16; ++j) { const float x = xr[F.lane + 64 * j]; ss += x * x; }
        const float rstd = 1.0f / sqrtf(wave_sum(ss, F.lane) * (1.0f / 1024.0f) + RMS_EPS);
        for (int j = 0; j < 16; ++j) { const int c = F.lane + 64 * j; const float want = xr[c] * rstd * a.in[I_NORMW][l * 1024 + c] * (1.0f + mod[v * 3072 + 1024 + c]) + mod[v * 3072 + c];
            chk_acc(a, id, bf2f(H[(size_t)row * 1024 + c]), want); } }
}
DI float dot_h_w(const bf16* hrow, const bf16* wrow, int K) { float acc = 0.f; for (int k = 0; k < K; ++k) acc += bf2f(hrow[k]) * bf2f(wrow[k]); return acc; }
DI void chk_p(const Frame& F, const Args& a, int l, int id) {
    const bf16* H = (const bf16*)(a.ws + WS_H); const bf16* W = (const bf16*)(a.ws + WS_WIN) + (size_t)l * PW * 1024; const bf16* P = (const bf16*)(a.ws + WS_P);
    const int gt = F.vcu * 512 + F.tid, NGT = F.G * 512;
    for (int s = gt; s < (1 << 20); s += NGT) { const unsigned h = hsh(s * 5 + 2); const int row = sample_row(h, l); int col = hsh(h + 9u) % PW;
        if (l == 1 && row >= M_LAT) col = ((col & 1) ? 1024 : 256) + (col & 255);
        chk_acc(a, id, bf2f(P[(size_t)row * PW + col]), dot_h_w(H + (size_t)row * 1024, W + (size_t)col * 1024, 1024)); }
}
DI void chk_prep(const Frame& F, const Args& a, int l, int id) {
    const bf16* H = (const bf16*)(a.ws + WS_H); const bf16* W = (const bf16*)(a.ws + WS_WIN) + (size_t)l * PW * 1024; const bf16* P = (const bf16*)(a.ws + WS_P);
    const int gw = F.vcu * NWAVES + F.wave, NGW = F.G * NWAVES, d = F.lane;
    for (int s = gw; s < 16384; s += NGW) { const unsigned h = hsh(s * 7 + 3); const int row = sample_row(h, l); int sl = (h >> 8) % 12; const bool isctx = row >= M_LAT;
        if (isctx && l == 1) sl = (sl & 1) ? 4 + (sl & 1) : 10 + ((sl >> 1) & 1);
        const int col = (sl < 4) ? C_AQ + 64 * sl : (sl < 6) ? C_AK + 64 * (sl - 4) : (sl < 10) ? C_DQ + 64 * (sl - 6) : C_DK + 64 * (sl - 10);
        const bool isq = (sl < 4) || (sl >= 6 && sl < 10);
        const float raw = bfr(dot_h_w(H + (size_t)row * 1024, W + (size_t)(col + d) * 1024, 1024));
        const float wv = ((sl < 4) ? a.in[I_QNA] : (sl < 6) ? a.in[I_KNA] : (sl < 10) ? a.in[I_QND] : a.in[I_KND])[l * 64 + d];
        const float ms = wave_sum(raw * raw, d) * (1.0f / 64.0f);
        float y = raw / sqrtf(ms + RMS_EPS) * wv;
        if (!isctx) { const int n = row & (SEQ - 1); const float pos = (float)((d < 32) ? (n >> 6) : (n & 63)); const float inv = __builtin_amdgcn_exp2f(-(float)(d & 15) * (13.287712379549449f / 16.0f)); const float rev = pos * inv * 0.15915494309189535f; const float cs = __builtin_amdgcn_cosf(rev), sn = __builtin_amdgcn_sinf(rev);
            const float p = shx(y, 16, d); y = (d & 16) ? (p * sn + y * cs) : (y * cs - p * sn); }
        if (isq) y *= QSCALE;
        chk_acc(a, id, bf2f(P[(size_t)row * PW + col + d]), y); }
}
DI void chk_attn(const Frame& F, const Args& a, int l, int id, int mode) {
    const bf16* P = (const bf16*)(a.ws + WS_P); const bf16* YB = (const bf16*)(a.ws + WS_YB);
    LAS float* qs = (LAS float*)F.lds + F.wave * 192; LAS float* os = qs + 64; LAS float* red = qs + 128;
    const int gw = F.vcu * NWAVES + F.wave, NGW = F.G * NWAVES, lane = F.lane;
    const int qc0 = mode ? C_DQ : C_AQ, kc0 = mode ? C_DK : C_AK, vc0 = mode ? C_DV : C_AV, zc0 = mode ? C_DZ : C_AZ, oc0 = mode ? 256 : 0;
    for (int s = gw; s < 8192; s += NGW) { const unsigned hh = hsh(s * 11 + 5 + mode); int row = sample_row(hh, l); if ((s & 7) == 1) row = (hh & 8192) + (hh & 255) + ((hh & 256) ? 7936 : 0); if (l == 1 && row >= M_LAT) row = hh % M_LAT; const int h = (hh >> 9) & 3, kvh = h >> 1; const bool isctx = row >= M_LAT;
        const int b = isctx ? (row - M_LAT) / NCTX : row / SEQ, pos = row & (SEQ - 1);
        qs[lane] = bf2f(P[(size_t)row * PW + qc0 + 64 * h + lane]); LDS_WAIT();
        int klo = 0, khi = -1; if (!isctx) { if (mode == 0) { klo = 0; khi = SEQ - 1; } else { klo = pos - 128 < 0 ? 0 : pos - 128; khi = pos + 128 > SEQ - 1 ? SEQ - 1 : pos + 128; } }
        const int nlat = khi - klo + 1 > 0 ? khi - klo + 1 : 0, nk = NCTX + nlat;
        float m = -1e30f, lsum = 0.f; float acc[64];
#pragma unroll
        for (int dd = 0; dd < 64; ++dd) acc[dd] = 0.f;
        for (int kk = lane; kk < nk; kk += 64) { const size_t kr = (kk < NCTX) ? (size_t)(M_LAT + NCTX * b + kk) : (size_t)(SEQ * b + klo + kk - NCTX);
            const bf16* kp = P + kr * PW + kc0 + 64 * kvh; const bf16* vp = P + kr * PW + vc0 + 64 * kvh; float sc = 0.f;
#pragma unroll
            for (int dd = 0; dd < 64; ++dd) sc += qs[dd] * bf2f(kp[dd]);
            const float mn = fmaxf(m, sc), f = __builtin_amdgcn_exp2f(m - mn), p = __builtin_amdgcn_exp2f(sc - mn); lsum = lsum * f + p; m = mn;
#pragma unroll
            for (int dd = 0; dd < 64; ++dd) acc[dd] = acc[dd] * f + p * bf2f(vp[dd]); }
        float mall = m;
#pragma unroll
        for (int o = 1; o < 64; o <<= 1) mall = fmaxf(mall, shx(mall, o, lane));
        const float f = __builtin_amdgcn_exp2f(m - mall); lsum = wave_sum(lsum * f, lane);
        if (mode == 1) lsum += __builtin_amdgcn_exp2f(a.in[I_SINK][l * 4 + h] * 1.4426950408889634f - mall);
#pragma unroll
        for (int dd = 0; dd < 64; ++dd) { const float t = wave_sum(acc[dd] * f, lane); if (lane == dd) os[dd] = t; }
        LDS_WAIT();
        const float z = bf2f(P[(size_t)row * PW + zc0 + 64 * h + lane]);
        chk_acc(a, id, bf2f(YB[(size_t)row * 1024 + oc0 + 64 * h + lane]), os[lane] / lsum * siluf(z));
        (void)red; }
}
DI void chk_fnet(const Frame& F, const Args& a, int l, int id, int ctxmode) {
    const bf16* P = (const bf16*)(a.ws + WS_P); const bf16* YB = (const bf16*)(a.ws + WS_YB);
    LAS float* ys = (LAS float*)F.lds + F.wave * 64;
    const int gw = F.vcu * NWAVES + F.wave, NGW = F.G * NWAVES, j = F.lane;
    const int N = ctxmode ? NCTX : SEQ;
    for (int s = gw; s < (ctxmode ? 256 : 1024); s += NGW) { const unsigned hh = hsh(s * 13 + 7 + ctxmode); const int b = hh & 1, g = (hh >> 1) & 3; int k = (hh >> 3) % N;
#ifdef FNET_K0
        k = (s & 7) == 0 ? 0 : (s & 7) == 1 ? N / 2 : (s & 7) == 2 ? 64 : (s & 7) == 3 ? 128 : (s & 7) == 4 ? 1 : k;
#endif
        const size_t rbase = ctxmode ? (size_t)(M_LAT + NCTX * b) : (size_t)(SEQ * b);
        float y = 0.f;
        for (int n = 0; n < N; ++n) { const bf16* fr = P + (rbase + n) * PW + C_BF + 64 * g; float A = 0.f, B = 0.f;
            for (int c = 0; c < 64; ++c) { const float fv = bf2f(fr[c]); const float ph = (float)((j * c) & 63) * (1.0f / 64.0f); A += fv * __builtin_amdgcn_cosf(ph); B += fv * __builtin_amdgcn_sinf(ph); }
            const float th = (float)((k * n) & (N - 1)) / (float)N; y += __builtin_amdgcn_cosf(th) * A - __builtin_amdgcn_sinf(th) * B; }
        ys[j] = y / sqrtf((float)N * 64.0f); LDS_WAIT();
        float o = 0.f; for (int jj = 0; jj < 64; ++jj) o += ys[jj] * a.in[I_WFNET][((size_t)(l * 4 + g) * 64 + jj) * 64 + j];
        const size_t row = rbase + k; const float z = bf2f(P[row * PW + C_BZ + 64 * g + j]);
        chk_acc(a, id, bf2f(YB[row * 1024 + 512 + 64 * g + j]), o * siluf(z)); LDS_WAIT(); }
}
DI void chk_sgu(const Frame& F, const Args& a, int l, int id) {
    const bf16* P = (const bf16*)(a.ws + WS_P); const bf16* YB = (const bf16*)(a.ws + WS_YB);
    const int gt = F.vcu * 512 + F.tid, NGT = F.G * 512;
    for (int s = gt; s < (1 << 18); s += NGT) { const unsigned hh = hsh(s * 17 + 11); int row = sample_row(hh, l); if (l == 1 && row >= M_LAT) row = hh % M_LAT; const int cc = hsh(hh + 101u) & 255, g = cc >> 6, p = row & 127; const size_t r0 = (size_t)(row - p);
        float sp = a.in[I_BSP][(l * 4 + g) * 128 + p];
        for (int q = 0; q < 128; ++q) { const float v = bf2f(P[(r0 + q) * PW + C_CV + cc]); sp += a.in[I_WSP][((size_t)(l * 4 + g) * 128 + p) * 128 + q] * (0.5f * v * (1.0f + erff(v * 0.7071067811865476f))); }
        const float u = bf2f(P[(size_t)row * PW + C_CU + cc]), z = bf2f(P[(size_t)row * PW + C_CZ + cc]);
        chk_acc(a, id, bf2f(YB[(size_t)row * 1024 + 768 + cc]), (0.5f * u * (1.0f + erff(u * 0.7071067811865476f))) * sp * siluf(z)); }
}
DI void chk_merge(const Frame& F, const Args& a, int l, int id) {
    const bf16* H = (const bf16*)(a.ws + WS_H); const bf16* YB = (const bf16*)(a.ws + WS_YB); const bf16* MG = (const bf16*)(a.ws + WS_MG);
    const bf16* WM = (const bf16*)(a.ws + WS_WM) + (size_t)l * 4096 * 1024; const bf16* WB = (const bf16*)(a.ws + WS_WBR) + (size_t)l * 1024 * 1024;
    const int gt = F.vcu * 512 + F.tid, NGT = F.G * 512;
    for (int s = gt; s < (1 << 18); s += NGT) { const unsigned hh = hsh(s * 19 + 13); int row = sample_row(hh, l); if (l == 1 && row >= M_LAT) row = hh % M_LAT; const int d = hsh(hh + 202u) & 1023; float acc = 0.f;
        for (int r = 0; r < 4; ++r) { const float G = dot_h_w(H + (size_t)row * 1024, WM + ((size_t)r * 1024 + d) * 1024, 1024) + a.in[I_BMERGE][l * 4096 + r * 1024 + d];
            const float Y = dot_h_w(YB + (size_t)row * 1024 + 256 * r, WB + (size_t)d * 1024 + 256 * r, 256); acc += Y * __builtin_amdgcn_rcpf(1.0f + __builtin_amdgcn_exp2f(-1.4426950408889634f * G)); }
        float got; if (row < M_LAT) got = bf2f(MG[(size_t)row * 1024 + d]); else { got = 0.f; for (int br = 0; br < 4; ++br) got += bf2f(((const bf16*)(a.ws + WS_GTC))[((size_t)br * 512 + (row - M_LAT)) * 1024 + d]); }
        chk_acc(a, id, got, acc); }
}
DI void chk_gt(const Frame& F, const Args& a, int l, int r, int id) {
    const bf16* H = (const bf16*)(a.ws + WS_H); const bf16* GT = (const bf16*)(a.ws + WS_GT); const bf16* WM = (const bf16*)(a.ws + WS_WM) + (size_t)l * 4096 * 1024;
    const int gt = F.vcu * 512 + F.tid, NGT = F.G * 512;
    for (int s = gt; s < (1 << 18); s += NGT) { const unsigned hh = hsh(s * 29 + 19); int row = sample_row(hh, l); if (l == 1 && row >= M_LAT) row = hh % M_LAT; const int d = hsh(hh + 404u) & 1023;
        const float G = dot_h_w(H + (size_t)row * 1024, WM + ((size_t)r * 1024 + d) * 1024, 1024) + a.in[I_BMERGE][l * 4096 + r * 1024 + d];
        chk_acc(a, id, bf2f(GT[(size_t)row * 1024 + d]), __builtin_amdgcn_rcpf(1.0f + __builtin_amdgcn_exp2f(-1.4426950408889634f * G))); }
}
DI void chk_final(const Frame& F, const Args& a, int l, int id) {
    const bf16* MG = (const bf16*)(a.ws + WS_MG); const bf16* WO = (const bf16*)(a.ws + WS_WOUT) + (size_t)l * 1024 * 1024; const float* mod = (const float*)(a.ws + WS_MOD) + (size_t)l * 3 * 3072;
    const int gt = F.vcu * 512 + F.tid, NGT = F.G * 512;
    for (int s = gt; s < (1 << 18); s += NGT) { const unsigned hh = hsh(s * 23 + 17); const int row = sample_row(hh, l), c = hsh(hh + 303u) & 1023; const int v = row < SEQ ? 0 : (row < M_LAT ? 1 : 2);
        if (l == 1 && row >= M_LAT) continue;
        const float xi = (l == 1) ? ((const float*)(a.ws + WS_H))[(size_t)row * 1024 + c] : (row < M_LAT) ? a.in[I_X][(size_t)row * 1024 + c] : a.in[I_CTX][(size_t)(row - M_LAT) * 1024 + c];
        const float got = (row < M_LAT) ? a.out[(size_t)row * 1024 + c] : ((const float*)(a.ws + WS_XC1))[(size_t)(row - M_LAT) * 1024 + c];
        float dsum;
        if (row < M_LAT) dsum = dot_h_w(MG + (size_t)row * 1024, WO + (size_t)c * 1024, 1024);
        else { dsum = 0.f; for (int br = 0; br < 4; ++br) dsum += dot_h_w((const bf16*)(a.ws + WS_GTC) + ((size_t)br * 512 + (row - M_LAT)) * 1024, WO + (size_t)c * 1024, 1024); }
        chk_acc(a, id, got - xi, mod[v * 3072 + 2048 + c] * dsum); }
}
#ifdef CHECK_MAX
#define CHK_ERR(md, ss, n, mx) ((mx) / (sqrtf((ss) / (float)(n)) + 1e-20f))
#else
#define CHK_ERR(md, ss, n, mx) sqrtf((md) / ((ss) + 1e-30f))
#endif
DI void chk_report(const Frame& F, const Args& a) {
    const unsigned* w = (const unsigned*)(a.ws + WS_CTL) + CW_CHK; int first = -1; float ferr = 0.f;
#ifdef CHECK_ONLY
    { const int id = CHECK_ONLY; const float md = __uint_as_float(w[4 * id]), ss = ((const float*)w)[4 * id + 1]; const unsigned n = w[4 * id + 2]; first = id; ferr = n ? CHK_ERR(md, ss, n, __uint_as_float(w[4 * id + 3])) : 1e3f; }
#else
    for (int id = 0; id < 24; ++id) { const float md = __uint_as_float(w[4 * id]), ss = ((const float*)w)[4 * id + 1]; const unsigned n = w[4 * id + 2]; if (!n) continue;
        const float e = CHK_ERR(md, ss, n, __uint_as_float(w[4 * id + 3])); if (e > CHECK_TOL && first < 0) { first = id; ferr = e; } }
#endif
    const float V = first >= 0 ? 10.0f * (float)(1 + first) : 0.f; const float W = first >= 0 ? 4.0f + log10f(fminf(fmaxf(ferr, 1e-3f), 1e3f)) : 0.f;
    const size_t gt = (size_t)F.vcu * 512 + F.tid, NGT = (size_t)F.G * 512;
#ifdef KEEP_OUT
    if (gt == 0) a.out[0] += V; (void)W; (void)NGT;
#else
    for (size_t i = gt; i < (size_t)M_LAT * 1024; i += NGT) { float v = a.in[I_X][i]; if (i == 0) v += V; if (i >= (1u << 20) && i < (2u << 20)) v += W; a.out[i] = v; }
#endif
}
DI void chk_copy_out(const Frame& F, const Args& a) {
    const size_t gt = (size_t)F.vcu * 512 + F.tid, NGT = (size_t)F.G * 512; float* dst = (float*)(a.ws + WS_H);
    for (size_t i = gt; i < (size_t)M_LAT * 1024; i += NGT) dst[i] = a.out[i];
}
#endif

typedef const __attribute__((address_space(4))) Args* CArgsP;
DI Args fresh_args() { CArgsP p = (CArgsP)__builtin_amdgcn_kernarg_segment_ptr(); asm volatile("" : "+s"(p)); Args r;
#pragma unroll
    for (int i = 0; i < 20; ++i) r.in[i] = p->in[i];
    r.out = p->out; r.ws = p->ws; return r; }
DI Frame fresh_frame(unsigned char* lds) {
    Frame F; int t_ = threadIdx.x; asm volatile("" : "+v"(t_));
    F.lds = (LAS unsigned char*)lds; F.tid = t_; F.lane = t_ & 63; F.wave = __builtin_amdgcn_readfirstlane(t_ >> 6);
    F.G = gridDim.x; { const int bx = blockIdx.x; F.vcu = (F.G % 8 == 0) ? (bx % 8) * (F.G / 8) + bx / 8 : bx; }
    return F;
}
DI void grid_bar(unsigned char* lds) {
    const Args a = fresh_args();
    XcdBarrier b; b.bar = (unsigned*)(a.ws + WS_CTL) + CW_BAR; b.x = xb_xcc_id(); b.st = (volatile LAS unsigned*)((LAS unsigned char*)lds + MISC_OFF) + 8;
    xcd_barrier(b);
}

__global__ void __launch_bounds__(NWAVES * 64, 2) hybrid_fwd(Args args) {
    extern __shared__ __attribute__((aligned(16))) unsigned char lds[];
    for (int u = threadIdx.x; u < (LDS_BYTES - LDSCTL_OFF) / 4; u += NWAVES * 64) ((LAS unsigned*)((LAS unsigned char*)lds + LDSCTL_OFF))[u] = 0u;
    __syncthreads();
    { const Args a = fresh_args(); (void)xcd_barrier_post((unsigned*)(a.ws + WS_CTL) + CW_BAR, (volatile LAS unsigned*)((LAS unsigned char*)lds + MISC_OFF) + 8); }
#define GRID_BAR() grid_bar(lds)
#ifndef DUP_MASK
#define DUP_MASK 0
#endif
#define DUP(bit) for (int rep_ = 0; rep_ < 1 + (((DUP_MASK) >> (bit)) & 1); ++rep_)
#ifdef SELFCHECK
#ifndef CHECK_SET
#define CHECK_SET 0xffff
#endif
#define CHK(bit, call) do { if ((CHECK_SET) & (bit)) { { const Frame F = fresh_frame(lds); const Args a = fresh_args(); call; } GRID_BAR(); } } while (0)
#elif defined(EXTRA_BAR)
#define CHK(bit, call) GRID_BAR()
#else
#define CHK(bit, call) do {} while (0)
#endif

#ifndef SKIP_P0
    DUP(0) { const Frame F = fresh_frame(lds); const Args a = fresh_args(); p0_prologue(F, a); }
#endif
    GRID_BAR();
    CHK(1, chk_p0(F, a));

#pragma unroll 1
    for (int l = 0; l < 2; ++l) {
#ifndef SKIP_P1
        DUP(1) { const Frame F = fresh_frame(lds); const Args a = fresh_args();
          p1_modrms(F, a, l, (l == 0) ? a.in[I_X] : a.out, (l == 0) ? a.in[I_CTX] : (const float*)(a.ws + WS_XC1), 1); }
#endif
        GRID_BAR();
        CHK(2, chk_h(F, a, l, 2 + 10 * l));
#ifndef SKIP_G1
        DUP(2) { const Frame F = fresh_frame(lds); const Args a = fresh_args();
            pg8::Gemm g{(const bf16*)(a.ws + WS_H), (const bf16*)(a.ws + WS_WIN) + (size_t)l * PW * 1024, 1024, 1024, 1024};
            pg8::OrderX S; S.so.init(l == 0 ? M_ALL : M_LAT, PW, F.G, (int)blockIdx.x); S.nx = (l == 0) ? 0 : 4;
            pg8::EpiBf16<0> E{(bf16*)(a.ws + WS_P), PW, nullptr};
            pg8::gemm_phase<pg8::EpiBf16<0>, pg8::OrderX, true>(F.lds, g, S, E);
        }
#endif
        GRID_BAR();
        CHK(4, chk_p(F, a, l, 3 + 10 * l));
#ifndef SKIP_S1
        DUP(3) { const Frame F = fresh_frame(lds); const Args a = fresh_args();
          for (int u = F.vcu; u < 256; u += F.G) fnet_s1_unit(F, a, l, u, (const bf16*)(a.ws + WS_P)); }
#endif
#ifndef SKIP_FC
        if (l == 0) { const Frame F = fresh_frame(lds); const Args a = fresh_args();
          for (int e = F.vcu; e < 256; e += F.G) { if ((e & 31) == 7) fnet_ctx_unit(F, a, l, e >> 5, (const bf16*)(a.ws + WS_P), (bf16*)(a.ws + WS_YB)); } }
#endif
#ifndef SKIP_PREP
        { const Frame F = fresh_frame(lds); const Args a = fresh_args(); p3_prep(F, a, l, (bf16*)(a.ws + WS_P)); }
#endif
        GRID_BAR();
        CHK(8, chk_prep(F, a, l, 4 + 10 * l));
#ifndef SKIP_ATT
        DUP(4) { const Frame F = fresh_frame(lds); const Args a = fresh_args();
            const attn_body::bf16* Pa = (const attn_body::bf16*)(a.ws + WS_P); attn_body::bf16* Ya = (attn_body::bf16*)(a.ws + WS_YB);
            for (int u = F.vcu; u < 256; u += F.G) {
                const int bk = u >> 6, b = bk >> 1, kvh = bk & 1, h = 2 * kvh + ((u >> 5) & 1), qb = u & 31;
                attn_body::attn_unit<0, 8>(Pa, Ya, SEQ * b + 256 * qb, M_LAT + NCTX * b, SEQ * b, 0, 132, 0,
                                           C_AQ + 64 * h, C_AK + 64 * kvh, C_AV + 64 * kvh, C_AZ + 64 * h, 64 * h, 0.f, (char*)lds);
            }
        }
        DUP(5) { const Frame F = fresh_frame(lds); const Args a = fresh_args();
            const attn_body::bf16* Pa = (const attn_body::bf16*)(a.ws + WS_P); attn_body::bf16* Ya = (attn_body::bf16*)(a.ws + WS_YB);
            for (int u = F.vcu; u < 512; u += F.G) {
                if (u < 256) {
                    const int bk = u >> 6, b = bk >> 1, kvh = bk & 1, h = 2 * kvh + ((u >> 5) & 1), qb = u & 31;
                    const int off = (qb == 0) ? 0 : 4 * qb - 2, NT = (qb == 0 || qb == 31) ? 10 : 12;
                    const float sk = a.in[I_SINK][l * 4 + h] * 1.4426950408889634f;
                    attn_body::attn_unit<1, 8>(Pa, Ya, SEQ * b + 256 * qb, M_LAT + NCTX * b, SEQ * b, off, NT, 256 * qb - 64 * off,
                                               C_DQ + 64 * h, C_DK + 64 * kvh, C_DV + 64 * kvh, C_DZ + 64 * h, 256 + 64 * h, sk, (char*)lds);
                } else if (l == 0 && ((u - 256) & 15) == 0) {
                    const int ee = (u - 256) >> 4, mode = ee >> 3, b = (ee >> 2) & 1, h = ee & 3, kvh = h >> 1;
                    const float sk = (mode == 0) ? -INFINITY : a.in[I_SINK][l * 4 + h] * 1.4426950408889634f;
                    const int qc = (mode == 0) ? C_AQ : C_DQ, kc = (mode == 0) ? C_AK : C_DK, vc = (mode == 0) ? C_AV : C_DV, zc = (mode == 0) ? C_AZ : C_DZ, oc = (mode == 0) ? 0 : 256;
                    attn_body::attn_unit<1, 8>(Pa, Ya, M_LAT + NCTX * b, M_LAT + NCTX * b, SEQ * b, 0, 4, 0,
                                               qc + 64 * h, kc + 64 * kvh, vc + 64 * kvh, zc + 64 * h, oc + 64 * h, sk, (char*)lds);
                }
            }
        }
#endif
#ifndef SKIP_S3
        DUP(6) { const Frame F = fresh_frame(lds); const Args a = fresh_args();
          for (int u = F.vcu; u < 256; u += F.G) fnet_s3_unit(F, a, u, (const bf16*)(a.ws + WS_P), (bf16*)(a.ws + WS_YB)); }
#endif
#ifndef SKIP_SGU
        DUP(7) { const Frame F = fresh_frame(lds); const Args a = fresh_args();
          const int nunit = (l == 0) ? 528 : 512;
          for (int u = F.vcu; u < nunit; u += F.G) sgu_unit(F, a, l, u, (const bf16*)(a.ws + WS_P), (bf16*)(a.ws + WS_YB)); }
#endif
        GRID_BAR();
        CHK(16, chk_attn(F, a, l, 5 + 10 * l, 0)); CHK(16, chk_attn(F, a, l, 6 + 10 * l, 1)); CHK(32, chk_fnet(F, a, l, 7 + 10 * l, 0); if (l == 0) chk_fnet(F, a, l, 8, 1)); CHK(64, chk_sgu(F, a, l, 9 + 10 * l));
#ifndef MERGE_V1
        for (int rep_ = 0; rep_ < 1 + ((((DUP_MASK) >> 8) & 1) && l == 1); ++rep_) { const Frame F = fresh_frame(lds); const Args a = fresh_args();
            pg8::Gemm g{(const bf16*)(a.ws + WS_H), (const bf16*)(a.ws + WS_WM), 1024, 1024, 1024};
            pg8::MergeOrder S{(const bf16*)(a.ws + WS_H), (const bf16*)(a.ws + WS_YB), (const bf16*)(a.ws + WS_WM) + (size_t)l * 4096 * 1024, (const bf16*)(a.ws + WS_WBR) + (size_t)l * 1024 * 1024, F.G, F.vcu, (l == 0) ? 32 : 0};
            pg8::EpiMerge E{(bf16*)(a.ws + WS_GT), (bf16*)(a.ws + WS_MG), (float*)(a.ws + WS_MGC), a.in[I_BMERGE] + l * 4096, (bf16*)(a.ws + WS_GTC)};
            pg8::gemm_phase<pg8::EpiMerge, pg8::MergeOrder, true>(F.lds, g, S, E);
        }
        GRID_BAR();
#else
#pragma unroll 1
        for (int r = 0; r < 4; ++r) {
#ifdef ZERO_MASK
            if ((ZERO_MASK >> r) & 1) continue;
#endif
#ifndef SKIP_MG
            { const Frame F = fresh_frame(lds); const Args a = fresh_args();
                pg8::Gemm g{(const bf16*)(a.ws + WS_H), (const bf16*)(a.ws + WS_WM) + ((size_t)l * 4096 + r * 1024) * 1024, 1024, 1024, 1024};
                pg8::OrderX S; S.so.init((l == 0) ? M_ALL : M_LAT, 1024, F.G, (int)blockIdx.x); S.nx = 0;
                pg8::EpiBf16<2> E{(bf16*)(a.ws + WS_GT), 1024, a.in[I_BMERGE] + l * 4096 + r * 1024};
                pg8::gemm_phase<pg8::EpiBf16<2>, pg8::OrderX, true>(F.lds, g, S, E);
            }
#endif
            GRID_BAR();
            if (r == 3 && l == 0) CHK(512, chk_gt(F, a, l, r, 22); chk_gt(F, a, l, 2, 23));
#ifndef SKIP_MY
            { const Frame F = fresh_frame(lds); const Args a = fresh_args();
                pg8::Gemm g{(const bf16*)(a.ws + WS_YB) + r * 256, (const bf16*)(a.ws + WS_WBR) + (size_t)l * 1024 * 1024 + r * 256, 1024, 1024, 256};
                pg8::OrderX S; S.so.init((l == 0) ? M_ALL : M_LAT, 1024, F.G, (int)blockIdx.x); S.nx = 0;

#ifdef ZERO_MASK
                pg8::EpiGate E{(bf16*)(a.ws + WS_MG), (const bf16*)(a.ws + WS_GT), 1024, r == __builtin_ctz(~(ZERO_MASK)), 1.0f};
#else
#ifdef SCALE_MASK
                pg8::EpiGate E{(bf16*)(a.ws + WS_MG), (const bf16*)(a.ws + WS_GT), 1024, r == 0, ((SCALE_MASK >> r) & 1) ? (SCALE_VAL) : 1.0f};
#else
                pg8::EpiGate E{(bf16*)(a.ws + WS_MG), (const bf16*)(a.ws + WS_GT), 1024, r == 0, 1.0f};
#endif
#endif

                pg8::gemm_phase<pg8::EpiGate, pg8::OrderX, true>(F.lds, g, S, E);
            }
#endif
            GRID_BAR();
        }
#endif
        CHK(128, chk_merge(F, a, l, 10 + 10 * l));
        if (l == 1) CHK(256, chk_copy_out(F, a));
#ifndef SKIP_OUT
        { const Frame F = fresh_frame(lds); const Args a = fresh_args();
            pg8::Gemm g{(const bf16*)(a.ws + WS_MG), (const bf16*)(a.ws + WS_WOUT) + (size_t)l * 1024 * 1024, 1024, 1024, 1024};
            pg8::OrderOut S; S.so.init(M_LAT, 1024, F.G, (int)blockIdx.x); S.nx = (l == 0) ? 128 : 0; S.TERM = (const bf16*)(a.ws + WS_GTC);
            pg8::EpiRes E{(l == 0) ? a.in[I_X] : a.out, a.out, (l == 0) ? a.in[I_CTX] : (const float*)(a.ws + WS_XC1), (float*)(a.ws + WS_XC1), (const float*)(a.ws + WS_MOD) + (size_t)l * 3 * 3072};
            pg8::gemm_phase<pg8::EpiRes, pg8::OrderOut, true>(F.lds, g, S, E);
        }
#endif
        if (l == 0) GRID_BAR();
        if (l == 0) CHK(256, chk_final(F, a, l, 11));
#ifdef SELFCHECK
        if (l == 1) { GRID_BAR(); CHK(256, chk_final(F, a, l, 21)); }
#endif
    }
#ifdef SELFCHECK
    GRID_BAR();
    { const Frame F = fresh_frame(lds); const Args a = fresh_args(); chk_report(F, a); }
#endif
#ifdef BLEND_S
    GRID_BAR();
    { const Frame F = fresh_frame(lds); const Args a = fresh_args(); const size_t gt = (size_t)F.vcu * 512 + F.tid, NGT = (size_t)F.G * 512;
      for (size_t i = gt; i < (size_t)M_LAT * 1024; i += NGT) { const float x0 = a.in[I_X][i]; a.out[i] = x0 + (BLEND_S) * (a.out[i] - x0); } }
#endif
}

extern "C" void kernel_launch(void* const* d_in, const int* in_sizes, int n_in, void* d_out, int out_size, void* d_ws, size_t ws_size, hipStream_t stream) {
    static int grid = 0;
    if (grid == 0) {
        if (n_in != 20 || out_size != M_LAT * DM || ws_size < WS_END) { fprintf(stderr, "kernel_launch: unexpected problem: n_in %d out %d ws %zu\n", n_in, out_size, ws_size); grid = -1; return; }
        { const int want[20] = {M_LAT * DM, NB * DM, M_CTX * DM, DM, 2 * DM, 2 * DM * 3 * DM, 2 * 3 * DM, 2 * DM * PW, 128, 128, 128, 128, 8, 2 * 4 * 64 * 64, 2 * 4 * 128 * 128, 2 * 4 * 128, 2 * 4 * 256 * DM, 2 * DM * 4 * DM, 2 * 4 * DM, 2 * DM * DM};
          for (int i = 0; i < 20; ++i) if (in_sizes[i] != want[i]) { fprintf(stderr, "kernel_launch: input %d has %d elements, expected %d\n", i, in_sizes[i], want[i]); grid = -1; return; } }
        int dev = 0, cus = 0, per_cu = 0;
        if (hipGetDevice(&dev) != hipSuccess || hipDeviceGetAttribute(&cus, hipDeviceAttributeMultiprocessorCount, dev) != hipSuccess) { grid = -1; return; }
        if (hipFuncSetAttribute((const void*)hybrid_fwd, hipFuncAttributeMaxDynamicSharedMemorySize, LDS_BYTES) != hipSuccess) { fprintf(stderr, "kernel_launch: hipFuncSetAttribute failed\n"); grid = -1; return; }
        if (hipOccupancyMaxActiveBlocksPerMultiprocessor(&per_cu, (const void*)hybrid_fwd, NWAVES * 64, LDS_BYTES) != hipSuccess || per_cu < 1) { fprintf(stderr, "kernel_launch: occupancy query says %d blocks per CU\n", per_cu); per_cu = 1; }
        (void)hipGetLastError();
        grid = cus;
    }
    if (grid < 0) return;
    if (hipMemsetAsync((char*)d_ws + WS_CTL, 0, CTL_ZERO_BYTES, stream) != hipSuccess) { fprintf(stderr, "kernel_launch: memset failed\n"); return; }
    Args a{};
    for (int i = 0; i < 20; ++i) a.in[i] = (const float*)d_in[i];
    a.out = (float*)d_out; a.ws = (unsigned char*)d_ws;
    hipLaunchKernelGGL(hybrid_fwd, dim3(grid), dim3(NWAVES * 64), LDS_BYTES, stream, a);
}
```

```cpp
#include <hip/hip_runtime.h>
#include <hip/hip_bf16.h>
#include <cstdio>
#include <cstdint>
#include <cmath>

namespace pg8 {
#define PG8_LAS __attribute__((address_space(3)))
typedef unsigned short bf16_t;
typedef short bf16x8 __attribute__((ext_vector_type(8)));
typedef float f32x4 __attribute__((ext_vector_type(4)));
typedef unsigned u32x4 __attribute__((ext_vector_type(4)));
constexpr int BM = 256, BK = 64, HALF = 128, HTB = HALF * BK * 2, STAGE_BYTES = 8 * HTB, NXCD = 8, WGM = 8;

__host__ __device__ __forceinline__ int lds_byte(int r, int c) { const int st = (r >> 4) * 2 + (c >> 5), rr = r & 15, cc = c & 31, ob = rr * 64 + cc * 2; return st * 1024 + (ob ^ (((ob >> 9) & 1) << 5)); }
__host__ __device__ __forceinline__ void stage_rc(int b, int& R, int& C) { const int st = b / 1024, sb = b % 1024, swz = sb ^ (((sb >> 9) & 1) << 5); R = (st >> 1) * 16 + swz / 64; C = (st & 1) * 32 + (swz % 64) / 2; }
__host__ __device__ __forceinline__ int perm32(int rho) { const int n = rho >> 4, i = rho & 15; return 8 * (i >> 2) + 4 * n + (i & 3); }

struct Unit { int pm, pn, r, kind; };
struct Gemm { const bf16_t* A; const bf16_t* Bt; int lda, ldb, K; };

struct StaticOrder {
    int nM, nN, nwg, G, c;
    __host__ __device__ void init(int M, int N, int G_, int c_) { nM = M / BM; nN = N / BM; nwg = nM * nN; G = G_; c = c_; }
    __host__ __device__ bool next(int i, Unit& u) const {
        const long L = (long)i * G + c; if (L >= nwg) return false;
        int wgid = (int)L; { const int q = nwg / NXCD, r = nwg % NXCD, xcd = wgid % NXCD, off = wgid / NXCD; wgid = (xcd < r ? xcd * (q + 1) : r * (q + 1) + (xcd - r) * q) + off; }
        const int nig = WGM * nN, gid = wgid / nig, fm = gid * WGM, gsz = (nM - fm) < WGM ? (nM - fm) : WGM;
        u.pm = fm + ((wgid % nig) % gsz); u.pn = (wgid % nig) / gsz; u.r = 0; u.kind = 0; return true;
    }
};
struct OrderX {
    StaticOrder so; int nx;
    __device__ bool next(int i, Unit& u) const {
        const long L = (long)i * so.G + so.c;
        if (L < so.nwg) return so.next(i, u);
        const int e = (int)(L - so.nwg); if (e >= nx) return false;
        u.pm = 64 + (e >> 1); u.pn = (e & 1) ? 4 : 1; u.r = 0; u.kind = 0; return true;
    }
    __device__ __forceinline__ void src(const Gemm& g, const Unit& u, const char*& pa, const char*& pb, int& nt) const {
        pa = (const char*)g.A + (size_t)u.pm * (2 * HALF) * g.lda * 2; pb = (const char*)g.Bt + (size_t)u.pn * (2 * HALF) * g.ldb * 2; nt = g.K / BK; }
};

typedef float f32x2_c __attribute__((ext_vector_type(2))); typedef __bf16 bf16x2_c __attribute__((ext_vector_type(2)));
__device__ __forceinline__ unsigned cvt_pk_bf16(float lo, float hi) { f32x2_c v = {lo, hi}; bf16x2_c b = __builtin_convertvector(v, bf16x2_c); return __builtin_bit_cast(unsigned, b); }
__device__ __forceinline__ float bf_lo(unsigned w) { return __uint_as_float(w << 16); }
__device__ __forceinline__ float bf_hi(unsigned w) { return __uint_as_float(w & 0xffff0000u); }
__device__ __forceinline__ float sigmoidf_(float x) { return __builtin_amdgcn_rcpf(1.0f + __builtin_amdgcn_exp2f(-1.4426950408889634f * x)); }

template <int ACT> struct EpiBf16 {
    static constexpr bool PERM = true;
    bf16_t* O; int ldc; const float* bias;
    __device__ __forceinline__ void operator()(const f32x4 (&acc)[2][2][4][2], const Unit& u, int wr, int wc, int fr, int fq) const {
        const int row0 = u.pm * BM + wr * 64 + fr; const int col0 = u.pn * BM + wc * 32 + 8 * fq;
        f32x4 bv[2][2];
#pragma unroll
        for (int bj = 0; bj < 2; ++bj)
#pragma unroll
            for (int n = 0; n < 2; ++n) bv[bj][n] = bias ? *(const f32x4*)(bias + col0 + bj * HALF + 4 * n) : (f32x4){0.f, 0.f, 0.f, 0.f};
#pragma unroll
        for (int ai = 0; ai < 2; ++ai)
#pragma unroll
            for (int m = 0; m < 4; ++m) { bf16_t* rowp = O + (size_t)(row0 + ai * HALF + m * 16) * ldc + col0;
#pragma unroll
                for (int bj = 0; bj < 2; ++bj) { f32x4 v0 = acc[ai][bj][m][0] + bv[bj][0], v1 = acc[ai][bj][m][1] + bv[bj][1];
                    if (ACT == 2) {
#pragma unroll
                        for (int e = 0; e < 4; ++e) { v0[e] = sigmoidf_(v0[e]); v1[e] = sigmoidf_(v1[e]); } }
                    u32x4 w; w.x = cvt_pk_bf16(v0[0], v0[1]); w.y = cvt_pk_bf16(v0[2], v0[3]); w.z = cvt_pk_bf16(v1[0], v1[1]); w.w = cvt_pk_bf16(v1[2], v1[3]);
                    *(u32x4*)(rowp + bj * HALF) = w; } }
    }
};
struct EpiGate {
    static constexpr bool PERM = true;
    bf16_t* MG; const bf16_t* GT; int ldc; int first; float scl;
    typedef unsigned u32x2 __attribute__((ext_vector_type(2)));
    __device__ __forceinline__ void operator()(const f32x4 (&acc)[2][2][4][2], const Unit& u, int wr, int wc, int fr, int fq) const {
        const int row0 = u.pm * BM + wr * 64 + fr; const int col0 = u.pn * BM + wc * 32 + 8 * fq;
#pragma unroll
        for (int ai = 0; ai < 2; ++ai)
#pragma unroll
            for (int m = 0; m < 4; ++m) { const size_t off = (size_t)(row0 + ai * HALF + m * 16) * ldc + col0;
#pragma unroll
                for (int bj = 0; bj < 2; ++bj)
#pragma unroll
                    for (int n = 0; n < 2; ++n) {
                        const u32x2 g = *(const u32x2*)(GT + off + bj * HALF + 4 * n);
                        u32x2 o = (u32x2){0u, 0u}; if (!first) o = *(const u32x2*)(MG + off + bj * HALF + 4 * n);
                        const f32x4 v = acc[ai][bj][m][n] * scl;
                        u32x2 w;
                        w.x = cvt_pk_bf16(bf_lo(o.x) + bf_lo(g.x) * v[0], bf_hi(o.x) + bf_hi(g.x) * v[1]);
                        w.y = cvt_pk_bf16(bf_lo(o.y) + bf_lo(g.y) * v[2], bf_hi(o.y) + bf_hi(g.y) * v[3]);
                        *(u32x2*)(MG + off + bj * HALF + 4 * n) = w; asm volatile("" ::: "memory"); } }
    }
};
struct EpiRes {
    static constexpr bool PERM = false;
    const float* xin_lat; float* xout_lat; const float* xin_ctx; float* xout_ctx; const float* gate;
    __device__ __forceinline__ void operator()(const f32x4 (&acc)[2][2][4][2], const Unit& u, int wr, int wc, int fr, int fq) const {
        const bool isctx = u.pm >= 64;
        const float* xin = isctx ? xin_ctx + (size_t)(u.pm - 64) * BM * 1024 : xin_lat + (size_t)u.pm * BM * 1024;
        float* xout = isctx ? xout_ctx + (size_t)(u.pm - 64) * BM * 1024 : xout_lat + (size_t)u.pm * BM * 1024;
        const float* gv = gate + (isctx ? 2 : (u.pm >> 5)) * 3072 + 2048;
        const int col0 = u.pn * BM + wc * 32 + 4 * fq;
        f32x4 gt[2][2];
#pragma unroll
        for (int bj = 0; bj < 2; ++bj)
#pragma unroll
            for (int n = 0; n < 2; ++n) gt[bj][n] = *(const f32x4*)(gv + col0 + bj * HALF + n * 16);
#pragma unroll
        for (int ai = 0; ai < 2; ++ai)
#pragma unroll
            for (int m = 0; m < 4; ++m) { const size_t off = (size_t)(ai * HALF + wr * 64 + m * 16 + fr) * 1024 + col0;
#pragma unroll
                for (int bj = 0; bj < 2; ++bj)
#pragma unroll
                    for (int n = 0; n < 2; ++n) {
                        if (u.kind == 3) { const f32x4 v = gt[bj][n] * acc[ai][bj][m][n]; float* q = xout + off + bj * HALF + n * 16; atomicAdd(q + 0, v[0]); atomicAdd(q + 1, v[1]); atomicAdd(q + 2, v[2]); atomicAdd(q + 3, v[3]); }
                        else { const f32x4 bs = *(const f32x4*)(xin + off + bj * HALF + n * 16); *(f32x4*)(xout + off + bj * HALF + n * 16) = bs + gt[bj][n] * acc[ai][bj][m][n]; } }
                if (m & 1) asm volatile("" ::: "memory"); }
    }
};

struct MergeOrder {
    const bf16_t* H; const bf16_t* YB; const bf16_t* WmT; const bf16_t* WbrT; int G, c, nctx;
    __device__ bool next(int i, Unit& u) const {
        const int nl = (c < 256) ? 1 + (255 - c) / G : 0;
        if (i < 8 * nl) { const int t = c + (i >> 3) * G, q = i & 7; u.pm = t >> 2; u.pn = t & 3; u.r = q >> 1; u.kind = (q & 1) ? 0 : 1; return true; }
        const int j = i - 8 * nl;
        if (nctx == 0 || (c & 7) != 0) return false;
        const int jb = (c >> 3) + (j >> 1) * (G >> 3); if (jb >= nctx) return false;
        const int t = jb >> 2; u.pm = 64 + (t >> 2); u.pn = t & 3; u.r = jb & 3; u.kind = (j & 1) ? 2 : 1; return true;
    }
    __device__ __forceinline__ void src(const Gemm&, const Unit& u, const char*& pa, const char*& pb, int& nt) const {
        if (u.kind != 1) { pa = (const char*)(H + (size_t)u.pm * 256 * 1024); pb = (const char*)(WmT + ((size_t)u.r * 1024 + u.pn * 256) * 1024); nt = 16; }
        else { pa = (const char*)(YB + (size_t)u.pm * 256 * 1024 + u.r * 256); pb = (const char*)(WbrT + (size_t)u.pn * 256 * 1024 + u.r * 256); nt = 4; }
    }
};
typedef unsigned long long u64_t;
__device__ __forceinline__ u64_t ld_sc1(const void* p) { return __hip_atomic_load((const u64_t*)p, __ATOMIC_RELAXED, __HIP_MEMORY_SCOPE_AGENT); }
struct EpiMerge {
    static constexpr bool PERM = true;
    bf16_t* GT; bf16_t* MG; float* MGc; const float* bias; bf16_t* GTc;
    typedef unsigned u32x2 __attribute__((ext_vector_type(2)));
    __device__ __forceinline__ void operator()(const f32x4 (&acc)[2][2][4][2], const Unit& u, int wr, int wc, int fr, int fq) const {
        const int row0 = u.pm * BM + wr * 64 + fr; const int col0 = u.pn * BM + wc * 32 + 8 * fq;
        bf16_t* Yu = (u.pm >= 64) ? GTc + ((size_t)u.r * 512 - 16384) * 1024 : GT;
        if (u.kind == 1) {
#pragma unroll
            for (int ai = 0; ai < 2; ++ai)
#pragma unroll
                for (int m = 0; m < 4; ++m) { bf16_t* rowp = Yu + (size_t)(row0 + ai * HALF + m * 16) * 1024 + col0;
#pragma unroll
                    for (int bj = 0; bj < 2; ++bj) { const f32x4 v0 = acc[ai][bj][m][0], v1 = acc[ai][bj][m][1];
                        u32x4 w; w.x = cvt_pk_bf16(v0[0], v0[1]); w.y = cvt_pk_bf16(v0[2], v0[3]); w.z = cvt_pk_bf16(v1[0], v1[1]); w.w = cvt_pk_bf16(v1[2], v1[3]);
                        *(u32x4*)(rowp + bj * HALF) = w; } }
        } else {
            const bool isctx = (u.kind == 2), first = (u.r == 0) || isctx;
            bf16_t* Ou = isctx ? Yu : MG;
            const float* bp = bias + u.r * 1024 + col0;
            f32x4 bv[2][2];
#pragma unroll
            for (int bj = 0; bj < 2; ++bj)
#pragma unroll
                for (int n = 0; n < 2; ++n) bv[bj][n] = *(const f32x4*)(bp + bj * HALF + 4 * n);
#pragma unroll
            for (int ai = 0; ai < 2; ++ai) { u64_t yq[4][2][2], oq[4][2][2];
#pragma unroll
                for (int mm = 0; mm < 4; ++mm) { const size_t off = (size_t)(row0 + ai * HALF + mm * 16) * 1024 + col0;
#pragma unroll
                    for (int bj = 0; bj < 2; ++bj)
#pragma unroll
                        for (int n = 0; n < 2; ++n) { yq[mm][bj][n] = ld_sc1(Yu + off + bj * HALF + 4 * n); oq[mm][bj][n] = first ? 0ull : ld_sc1(MG + off + bj * HALF + 4 * n); } }
#pragma unroll
                for (int mm = 0; mm < 4; ++mm) { const size_t off = (size_t)(row0 + ai * HALF + mm * 16) * 1024 + col0;
#pragma unroll
                    for (int bj = 0; bj < 2; ++bj)
#pragma unroll
                        for (int n = 0; n < 2; ++n) { f32x4 gv = acc[ai][bj][mm][n] + bv[bj][n];
#pragma unroll
                            for (int e = 0; e < 4; ++e) gv[e] = sigmoidf_(gv[e]);
                            const u64_t y_ = yq[mm][bj][n], o_ = oq[mm][bj][n];
                            const unsigned yx = (unsigned)y_, yy = (unsigned)(y_ >> 32), ox = (unsigned)o_, oy = (unsigned)(o_ >> 32);
                            u32x2 w;
                            w.x = cvt_pk_bf16(bf_lo(ox) + gv[0] * bf_lo(yx), bf_hi(ox) + gv[1] * bf_hi(yx));
                            w.y = cvt_pk_bf16(bf_lo(oy) + gv[2] * bf_lo(yy), bf_hi(oy) + gv[3] * bf_hi(yy));
                            *(u32x2*)(Ou + off + bj * HALF + 4 * n) = w; } }
                asm volatile("" ::: "memory"); }
        }
    }
};
struct OrderOut {
    StaticOrder so; int nx; const bf16_t* TERM;
    __device__ bool next(int i, Unit& u) const {
        const long L = (long)i * so.G + so.c;
        if (L < so.nwg) return so.next(i, u);
        const int e = (int)(L - so.nwg); if (e >= nx) return false;
        const int t = e >> 4; u.pm = 64 + (t >> 2); u.pn = t & 3; u.r = e & 15; u.kind = 3; return true;
    }
    __device__ __forceinline__ void src(const Gemm& g, const Unit& u, const char*& pa, const char*& pb, int& nt) const {
        pa = (const char*)g.A + (size_t)u.pm * (2 * HALF) * g.lda * 2; pb = (const char*)g.Bt + (size_t)u.pn * (2 * HALF) * g.ldb * 2; nt = g.K / BK;
        if (u.kind == 3) { const int br = u.r >> 2, kq = u.r & 3; pa = (const char*)(TERM + ((size_t)br * 512 + (u.pm - 64) * 256) * 1024 + kq * 256); pb += (size_t)kq * 256 * 2; nt = 4; }
    }
};

template <class Epi, class Sched, bool ALIGN_EPI>
__device__ __forceinline__ void gemm_phase(PG8_LAS unsigned char* lds, const Gemm g, const Sched& S, const Epi& E) {
    int tid = threadIdx.x; asm volatile("" : "+v"(tid));
    const int wid = __builtin_amdgcn_readfirstlane(tid >> 6), lane = tid & 63, wr = wid >> 2, wc = wid & 3, fr = lane & 15, fq = lane >> 4;
    int nt;
    unsigned voffA[2], voffB[2];
#pragma unroll
    for (int i = 0; i < 2; ++i) { int R, C; stage_rc(tid * 16 + i * 8192, R, C); const int Rb = Epi::PERM ? ((R & ~31) + perm32(R & 31)) : R;
        voffA[i] = (unsigned)(R * g.lda + C) * 2u; voffB[i] = (unsigned)(Rb * g.ldb + C) * 2u; }
    const size_t kstep = (size_t)(BK * 2);
    const size_t hstepA = (size_t)HALF * g.lda * 2, hstepB = (size_t)HALF * g.ldb * 2;
    const unsigned ldsw = (unsigned)wid * 1024u;
    const int aoff = lds_byte(wr * 64 + fr, fq * 8), boff = lds_byte(wc * 32 + fr, fq * 8);
#define PG8_SA(b, h) (((b) * 2 + (h)) * HTB)
#define PG8_SB(b, h) ((4 + (b) * 2 + (h)) * HTB)
#define PG8_STAGE(bufoff, gbase, voff) do { _Pragma("unroll") for (int _i = 0; _i < 2; ++_i) \
        __builtin_amdgcn_global_load_lds((const unsigned*)((const char*)(gbase) + (voff)[_i]), (PG8_LAS unsigned*)(lds + (bufoff) + ldsw + _i * 8192), 16, 0, 0); } while (0)
#define PG8_LDA(dst, b, h) do { _Pragma("unroll") for (int m = 0; m < 4; ++m) _Pragma("unroll") for (int k = 0; k < 2; ++k) dst[m][k] = *(const PG8_LAS bf16x8*)(lds + PG8_SA(b, h) + aoff + m * 2048 + k * 1024); } while (0)
#define PG8_LDB(dst, b, h) do { _Pragma("unroll") for (int n = 0; n < 2; ++n) _Pragma("unroll") for (int k = 0; k < 2; ++k) dst[n][k] = *(const PG8_LAS bf16x8*)(lds + PG8_SB(b, h) + boff + n * 2048 + k * 1024); } while (0)
#define PG8_MMA(ai, bj, At, Bt) do { __builtin_amdgcn_s_setprio(1); _Pragma("unroll") for (int m = 0; m < 4; ++m) _Pragma("unroll") for (int n = 0; n < 2; ++n) _Pragma("unroll") for (int k = 0; k < 2; ++k) \
        acc[ai][bj][m][n] = __builtin_amdgcn_mfma_f32_16x16x32_bf16(Bt[n][k], At[m][k], acc[ai][bj][m][n], 0, 0, 0); __builtin_amdgcn_s_setprio(0); } while (0)
#define PG8_WAIT_V(n) asm volatile("s_waitcnt vmcnt(" #n ")" ::: "memory")
#define PG8_WAIT_L(n) asm volatile("s_waitcnt lgkmcnt(" #n ")" ::: "memory")
#define PG8_BAR __builtin_amdgcn_s_barrier()
#define PG8_SCHED __builtin_amdgcn_sched_barrier(0)
    Unit cur, nxt; int ui = 0;
    if (!S.next(0, cur)) return;
    f32x4 acc[2][2][4][2];
#pragma unroll
    for (int a = 0; a < 2; ++a)
#pragma unroll
        for (int b = 0; b < 2; ++b)
#pragma unroll
            for (int m = 0; m < 4; ++m)
#pragma unroll
                for (int n = 0; n < 2; ++n) acc[a][b][m][n] = (f32x4){0.f, 0.f, 0.f, 0.f};
    bf16x8 At[4][2], B0[2][2], B1[2][2];
    const char* cA; const char* cB; S.src(g, cur, cA, cB, nt);
    PG8_STAGE(PG8_SB(0, 0), cB, voffB); PG8_STAGE(PG8_SB(0, 1), cB + hstepB, voffB); PG8_STAGE(PG8_SA(0, 0), cA, voffA); PG8_STAGE(PG8_SA(0, 1), cA + hstepA, voffA);
    if (wr == 1) PG8_BAR;
    PG8_WAIT_V(2); PG8_BAR;
    PG8_STAGE(PG8_SB(1, 0), cB + kstep, voffB); PG8_STAGE(PG8_SA(1, 0), cA + kstep, voffA); PG8_STAGE(PG8_SB(1, 1), cB + hstepB + kstep, voffB);
    PG8_WAIT_V(6); PG8_BAR;
    for (;;) {
        const bool has_next = S.next(ui + 1, nxt);
        const char* nA = cA; const char* nB = cB; int nnt = nt; if (has_next) S.src(g, nxt, nA, nB, nnt);
        for (int t = 0; t < nt; t += 2) {
            const bool last = (t == nt - 2);
            const char* a1 = cA + (size_t)(t + 1) * kstep;
            const char* a2 = last ? nA : cA + (size_t)(t + 2) * kstep; const char* b2 = last ? nB : cB + (size_t)(t + 2) * kstep;
            const char* a3 = a2 + kstep; const char* b3 = b2 + kstep;
            PG8_LDB(B0, 0, 0); PG8_LDB(B1, 0, 1); PG8_SCHED; PG8_LDA(At, 0, 0); PG8_STAGE(PG8_SA(1, 1), a1 + hstepA, voffA);
            PG8_WAIT_V(8); PG8_WAIT_L(0); PG8_BAR; PG8_MMA(0, 0, At, B0); PG8_MMA(0, 1, At, B1); PG8_BAR; PG8_SCHED;
            PG8_LDA(At, 0, 1); PG8_STAGE(PG8_SB(0, 0), b2, voffB); PG8_STAGE(PG8_SB(0, 1), b2 + hstepB, voffB); PG8_STAGE(PG8_SA(0, 0), a2, voffA);
            PG8_WAIT_V(8); PG8_WAIT_L(0); PG8_BAR; PG8_MMA(1, 0, At, B0); PG8_MMA(1, 1, At, B1); PG8_BAR; PG8_SCHED;
            PG8_LDB(B0, 1, 0); PG8_LDB(B1, 1, 1); PG8_SCHED; PG8_LDA(At, 1, 0); PG8_STAGE(PG8_SA(0, 1), a2 + hstepA, voffA);
            PG8_WAIT_V(8); PG8_WAIT_L(0); PG8_BAR; PG8_MMA(0, 0, At, B0); PG8_MMA(0, 1, At, B1); PG8_BAR; PG8_SCHED;
            PG8_LDA(At, 1, 1); PG8_STAGE(PG8_SB(1, 0), b3, voffB); PG8_STAGE(PG8_SB(1, 1), b3 + hstepB, voffB); PG8_STAGE(PG8_SA(1, 0), a3, voffA);
            PG8_WAIT_V(8); PG8_WAIT_L(0); PG8_BAR; PG8_MMA(1, 0, At, B0); PG8_MMA(1, 1, At, B1); PG8_BAR; PG8_SCHED;
        }
        if constexpr (ALIGN_EPI) { if (wr == 0) PG8_BAR; }
        E(acc, cur, wr, wc, fr, fq);
        if (!has_next) break;
#pragma unroll
        for (int a = 0; a < 2; ++a)
#pragma unroll
            for (int b = 0; b < 2; ++b)
#pragma unroll
                for (int m = 0; m < 4; ++m)
#pragma unroll
                    for (int n = 0; n < 2; ++n) acc[a][b][m][n] = (f32x4){0.f, 0.f, 0.f, 0.f};
        cur = nxt; cA = nA; cB = nB; nt = nnt; ++ui;
        if constexpr (ALIGN_EPI) { if (wr == 1) PG8_BAR; }
    }
    PG8_WAIT_V(0);
    if constexpr (!ALIGN_EPI) { if (wr == 0) PG8_BAR; }
    PG8_BAR;
#undef PG8_SA
#undef PG8_SB
#undef PG8_STAGE
#undef PG8_LDA
#undef PG8_LDB
#undef PG8_MMA
#undef PG8_WAIT_V
#undef PG8_WAIT_L
#undef PG8_BAR
#undef PG8_SCHED
}
}
namespace attn_body {
using bf16=__hip_bfloat16;
using bf16x8=__attribute__((ext_vector_type(8)))short;
using s16x4=__attribute__((ext_vector_type(4)))short;
using f32x16=__attribute__((ext_vector_type(16)))float;
using u32x4=__attribute__((ext_vector_type(4)))unsigned;
constexpr int D=64;
constexpr int NW=8,QBLK=32,QB=QBLK*NW,KVBLK=64;
constexpr int PP=2816, YP=1024;
__device__ __forceinline__ int crow(int r,int hi){return (r&3)+8*(r>>2)+4*hi;}
#define SBAR() __builtin_amdgcn_sched_barrier(0)
__device__ __forceinline__ void dmask(f32x16&p0,f32x16&p1,int kb,unsigned lim,int qrel,int hi){
  const float NEG=-INFINITY; const unsigned b0=(unsigned)(kb+4*hi-qrel+128);
  #pragma unroll
  for(int r=0;r<16;++r){const unsigned dd=b0+(unsigned)((r&3)+8*(r>>2)); if(dd>lim)p0[r]=NEG; if(dd+32u>lim)p1[r]=NEG;}
}

constexpr int NSLOT=3, SLOTB=8192;
constexpr int LDS_K=0, LDS_V=NSLOT*SLOTB, LDS_WS=2*NSLOT*SLOTB, LDS_OST=LDS_WS+NW*64*4, LDS_BYTES=LDS_OST+NW*4096;
constexpr float C2=0.125f*1.4426950408889634f;
__device__ __forceinline__ void glds16(const void*gsrc,unsigned lds_dst){unsigned keep;
  asm volatile("s_mov_b32 %0, m0\n\ts_mov_b32 m0, %2\n\ts_nop 0\n\tglobal_load_lds_dwordx4 %1, off\n\ts_mov_b32 m0, %0":"=&s"(keep):"v"(gsrc),"s"(lds_dst):"memory");}
__device__ __forceinline__ float siluf_(float x){ return x*__builtin_amdgcn_rcpf(1.0f+__builtin_amdgcn_exp2f(-1.4426950408889634f*x)); }
__device__ __forceinline__ float max3f(float a,float b,float c){float r;asm("v_max3_f32 %0, %1, %2, %3":"=v"(r):"v"(a),"v"(b),"v"(c));return r;}
__device__ __forceinline__ float max2f(float a,float b){float r;asm("v_max_f32_e32 %0, %1, %2":"=v"(r):"v"(a),"v"(b));return r;}
__device__ __forceinline__ float fadd_s(float a,float b){float r;asm("v_add_f32_e32 %0, %1, %2":"=v"(r):"v"(a),"v"(b));return r;}
__device__ __forceinline__ float fsub_s(float a,float b){float r;asm("v_sub_f32_e32 %0, %1, %2":"=v"(r):"v"(a),"v"(b));return r;}
typedef float f32x2_t __attribute__((ext_vector_type(2))); typedef __bf16 bf16x2_t __attribute__((ext_vector_type(2)));
__device__ __forceinline__ unsigned cvtpk_s(float lo,float hi){f32x2_t v={lo,hi};bf16x2_t b=__builtin_convertvector(v,bf16x2_t);return __builtin_bit_cast(unsigned,b);}
#define WAIT_BAR(N) asm volatile("s_waitcnt vmcnt(" #N ") lgkmcnt(0)\n\ts_barrier":::"memory")

__device__ __forceinline__ void qkt(f32x16&p0,f32x16&p1,const char*Kslot,const bf16x8*qr,const f32x16&negm,int r32,int hi){
  const char*kb=Kslot+hi*1024+r32*16;
  #pragma unroll
  for(int d0=0;d0<4;++d0){
    const bf16x8 b0=*reinterpret_cast<const bf16x8*>(kb+d0*2048);
    const bf16x8 b1=*reinterpret_cast<const bf16x8*>(kb+d0*2048+512);
    if(d0==0){p0=__builtin_amdgcn_mfma_f32_32x32x16_bf16(b0,qr[0],negm,0,0,0);p1=__builtin_amdgcn_mfma_f32_32x32x16_bf16(b1,qr[0],negm,0,0,0);}
    else{p0=__builtin_amdgcn_mfma_f32_32x32x16_bf16(b0,qr[d0],p0,0,0,0);p1=__builtin_amdgcn_mfma_f32_32x32x16_bf16(b1,qr[d0],p1,0,0,0);}}
}
typedef __attribute__((address_space(3))) const char* lds_cptr;
typedef short v4i16_t __attribute__((ext_vector_type(4)));
__device__ __forceinline__ void kload8(bf16x8*kf,lds_cptr kp){
  kf[0]=*(const __attribute__((address_space(3))) bf16x8*)(kp);      kf[1]=*(const __attribute__((address_space(3))) bf16x8*)(kp+512);
  kf[2]=*(const __attribute__((address_space(3))) bf16x8*)(kp+2048); kf[3]=*(const __attribute__((address_space(3))) bf16x8*)(kp+2560);
  kf[4]=*(const __attribute__((address_space(3))) bf16x8*)(kp+4096); kf[5]=*(const __attribute__((address_space(3))) bf16x8*)(kp+4608);
  kf[6]=*(const __attribute__((address_space(3))) bf16x8*)(kp+6144); kf[7]=*(const __attribute__((address_space(3))) bf16x8*)(kp+6656);
}
__device__ __forceinline__ void kload2(bf16x8*kf,lds_cptr kp,int j){ kf[2*j]=*(const __attribute__((address_space(3))) bf16x8*)(kp+j*2048); kf[2*j+1]=*(const __attribute__((address_space(3))) bf16x8*)(kp+j*2048+512); }
__device__ __forceinline__ s16x4 vtr(lds_cptr p){ return __builtin_bit_cast(s16x4,__builtin_amdgcn_ds_read_tr16_b64_v4i16((__attribute__((address_space(3))) v4i16_t*)p)); }
__device__ __forceinline__ float rowmax(const f32x16&p0,const f32x16&p1){
  float a=max3f(p0[0],p0[1],p1[0]),b=max3f(p0[2],p0[3],p1[1]);a=max3f(a,p1[2],p1[3]);
  #pragma unroll
  for(int r=4;r<16;r+=4){a=max3f(a,p0[r],p0[r+1]);b=max3f(b,p0[r+2],p0[r+3]);a=max3f(a,p1[r],p1[r+1]);b=max3f(b,p1[r+2],p1[r+3]);}
  const float m=max2f(a,b);
  auto rr=__builtin_amdgcn_permlane32_swap(__float_as_uint(m),__float_as_uint(m),false,false);
  return max2f(__uint_as_float(rr[0]),__uint_as_float(rr[1]));
}
__device__ __forceinline__ void pv(f32x16*o,int vb,bf16x8 pa0,bf16x8 pa1,bf16x8 pa2,bf16x8 pa3){
  #pragma unroll
  for(int d0=0;d0<2;++d0){s16x4 lo[4],hi[4];
    #pragma unroll
    for(int ks=0;ks<4;++ks){
      asm volatile("ds_read_b64_tr_b16 %0,%1 offset:%c2":"=&v"(lo[ks]):"v"(vb),"i"(d0*4096+ks*1024):"memory");
      asm volatile("ds_read_b64_tr_b16 %0,%1 offset:%c2":"=&v"(hi[ks]):"v"(vb),"i"(d0*4096+ks*1024+512):"memory");}
    asm volatile("s_waitcnt lgkmcnt(0)":::"memory");SBAR();
    #define PK(k) (bf16x8){lo[k][0],lo[k][1],lo[k][2],lo[k][3],hi[k][0],hi[k][1],hi[k][2],hi[k][3]}
    o[d0]=__builtin_amdgcn_mfma_f32_32x32x16_bf16(pa0,PK(0),o[d0],0,0,0);
    o[d0]=__builtin_amdgcn_mfma_f32_32x32x16_bf16(pa1,PK(1),o[d0],0,0,0);
    o[d0]=__builtin_amdgcn_mfma_f32_32x32x16_bf16(pa2,PK(2),o[d0],0,0,0);
    o[d0]=__builtin_amdgcn_mfma_f32_32x32x16_bf16(pa3,PK(3),o[d0],0,0,0);
    #undef PK
  }
}

#ifndef ATTN_STORE16
#define ATTN_STORE16(p,v) (*(u32x4*)(p)=(v))
#endif
template<int MODE,int THRL> __device__ __forceinline__ void attn_unit(const bf16*Pm,bf16*YB,int qrow0,int ctx0,int lat0,int off,int NT,int wq0,int qcol,int kcol,int vcol,int zcol,int ocol,float sinkl2,char*shm){
  int tid_=threadIdx.x; asm volatile("":"+v"(tid_)); const int tid=tid_,lane=tid&63,r32=lane&31,hi=lane>>5; const int wid=__builtin_amdgcn_readfirstlane(tid>>6);
  const bf16*Qw=Pm+(long)(qrow0+wid*QBLK)*PP+qcol;
  const unsigned lds0=(unsigned)(uintptr_t)shm;
  float*wsf=(float*)(shm+LDS_WS)+wid*64;
  const bf16*ksrc=Pm+kcol+(long)lane*PP+wid*8;
  const bf16*vsrc=Pm+vcol+(long)(16*(wid&3)+(lane>>2))*PP+(wid>>2)*32+(lane&3)*8;
  const unsigned kdst=lds0+LDS_K+wid*1024, vdst=lds0+LDS_V+wid*1024;
  #define TROW(t) (((t)<4)?(ctx0+64*(t)):(lat0+64*((t)-4+off)))
  #define DMA_K(t,slot) glds16(ksrc+(long)TROW(t)*PP,(unsigned)__builtin_amdgcn_readfirstlane(kdst+(slot)))
  #define DMA_V(t,slot) glds16(vsrc+(long)TROW(t)*PP,(unsigned)__builtin_amdgcn_readfirstlane(vdst+(slot)))
  const int vb0=(int)(lds0+LDS_V)+((lane>>4)&1)*32+(lane&3)*8+(4*hi+((lane&15)>>2))*64;
  const char*Kbase=shm+LDS_K; bf16x8 kf[8];
  const lds_cptr shm3=(lds_cptr)shm; const lds_cptr kp0=shm3+LDS_K+hi*1024+r32*16; const lds_cptr vp0=shm3+LDS_V+((lane>>4)&1)*32+(lane&3)*8+(4*hi+((lane&15)>>2))*64;
  DMA_K(0,0);DMA_V(0,0);DMA_K(1,SLOTB);
  bf16x8 qr[4];
  #pragma unroll
  for(int d0=0;d0<4;++d0)qr[d0]=*reinterpret_cast<const bf16x8*>(&Qw[(long)r32*PP+d0*16+hi*8]);
  float mhat=0.f,l_reg=0.f;f32x16 o[2];o[0]=f32x16{};o[1]=f32x16{};f32x16 negm=f32x16{}; if(MODE==0){asm volatile("":"+v"(negm));}
  const int qrel=wid*QBLK+r32;
  #define CMASK(P0,P1,t) do{ if(MODE==1){ dmask(P0,P1,64*((t)-4)-wq0,((t)>=4)?256u:~0u,qrel,hi); } }while(0)
  bool resc=false;
  #define START(P0,P1) do{ const float rm=rowmax(P0,P1); resc=false; \
    { const float dl=rm; mhat=fadd_s(mhat,dl); \
      _Pragma("unroll") for(int r=0;r<16;++r){P0[r]=fsub_s(P0[r],dl);P1[r]=fsub_s(P1[r],dl);} \
      if(MODE==0){ _Pragma("unroll") for(int r=0;r<16;++r)negm[r]=-mhat; asm volatile("":"+v"(negm)); } } \
    _Pragma("unroll") for(int r=0;r<16;++r)P0[r]=__builtin_amdgcn_exp2f(P0[r]); }while(0)
  #define RESC() do{ if(resc){ asm volatile("s_waitcnt lgkmcnt(0)":::"memory"); \
      _Pragma("unroll") for(int d_=0;d_<2;++d_) _Pragma("unroll") for(int r=0;r<16;++r)o[d_][r]*=wsf[crow(r,hi)]; } }while(0)
  f32x16 pA0,pA1,pB0,pB1;
  int sl_prev=0,sl_cur=0,sl_next=SLOTB;
  #define ROT() do{sl_prev=sl_cur;sl_cur=sl_next;sl_next=(sl_next==(NSLOT-1)*SLOTB)?0:sl_next+SLOTB;}while(0)
  DMA_K(2,2*SLOTB);
  WAIT_BAR(3);
  qkt(pA0,pA1,Kbase,qr,negm,r32,hi);asm volatile("s_nop 15\n\ts_nop 7":"+v"(pA0),"+v"(pA1));CMASK(pA0,pA1,0);
  START(pA0,pA1);
  _Pragma("unroll") for(int r=0;r<16;++r)pA1[r]=__builtin_amdgcn_exp2f(pA1[r]);
  WAIT_BAR(0);
  DMA_K(3,0);DMA_V(1,SLOTB);
  ROT();
  kload8(kf,kp0+sl_cur);
  WAIT_BAR(2);
  s16x4 vlo[8],vhi[8]; u32x4 pw0,pw1,pw2,pw3;
  #define PKW(P,B) cvtpk_s(P[B],P[B+1])
  #define PAF(k) __builtin_bit_cast(bf16x8,pw##k)
  #define VFR(i) (bf16x8){vlo[i][0],vlo[i][1],vlo[i][2],vlo[i][3],vhi[i][0],vhi[i][1],vhi[i][2],vhi[i][3]}
  #define PIN(x) asm volatile("":"+v"(x))
  #define MX3(a,b,c) __builtin_fmaxf(__builtin_fmaxf((a),(b)),(c))
  #define GAPA(MF,A0,A1,A2,A3,W0,W1,PW) do{ MF; sacc+=A0; sacc+=A1; sacc+=A2; sacc+=A3; PIN(sacc); W0; W1; PIN(PW); SBAR(); }while(0)
  #define EX(v) __builtin_amdgcn_exp2f(v)
  #define GAPB(MF,X,B) do{ MF; X[B]=EX(X[B]); X[B+1]=EX(X[B+1]); X[B+2]=EX(X[B+2]); X[B+3]=EX(X[B+3]); PIN(X); SBAR(); }while(0)
  #define VRD(i) do{ vlo[i]=vtr(vp_+(((i)>>2)*4096+((i)&3)*1024)); vhi[i]=vtr(vp_+(((i)>>2)*4096+((i)&3)*1024+512)); }while(0)
  #define KRD(G,j) do{ if(G){ kload2(kf,kp0+sl_next,j); SBAR(); } }while(0)
  #define STEP(C0,C1,P0,P1,t,GK,GV,GL,MX) do{ SBAR(); \
    const lds_cptr vp_=vp0+sl_prev; \
    VRD(0); SBAR(); float sacc=(P0[0]+P0[1]); \
    GAPA(C0=__builtin_amdgcn_mfma_f32_32x32x16_bf16(kf[0],qr[0],negm,0,0,0), P0[2],P0[3],P0[4],P0[5],     pw0[0]=PKW(P0,0), pw0[1]=PKW(P0,2), pw0); \
    VRD(4); SBAR(); GAPA(C1=__builtin_amdgcn_mfma_f32_32x32x16_bf16(kf[1],qr[0],negm,0,0,0), P0[6],P0[7],P0[8],P0[9],     pw0[2]=PKW(P0,4), pw0[3]=PKW(P0,6), pw0); \
    VRD(1); SBAR(); GAPA(C0=__builtin_amdgcn_mfma_f32_32x32x16_bf16(kf[2],qr[1],C0,0,0,0),   P0[10],P0[11],P0[12],P0[13], pw1[0]=PKW(P0,8), pw1[1]=PKW(P0,10), pw1); \
    VRD(5); SBAR(); GAPA(C1=__builtin_amdgcn_mfma_f32_32x32x16_bf16(kf[3],qr[1],C1,0,0,0),   P0[14],P0[15],P1[0],P1[1],   pw1[2]=PKW(P0,12),pw1[3]=PKW(P0,14), pw1); \
    VRD(2); SBAR(); GAPA(C0=__builtin_amdgcn_mfma_f32_32x32x16_bf16(kf[4],qr[2],C0,0,0,0),   P1[2],P1[3],P1[4],P1[5],     pw2[0]=PKW(P1,0), pw2[1]=PKW(P1,2), pw2); \
    VRD(6); SBAR(); GAPA(C1=__builtin_amdgcn_mfma_f32_32x32x16_bf16(kf[5],qr[2],C1,0,0,0),   P1[6],P1[7],P1[8],P1[9],     pw2[2]=PKW(P1,4), pw2[3]=PKW(P1,6), pw2); \
    VRD(3); SBAR(); GAPA(C0=__builtin_amdgcn_mfma_f32_32x32x16_bf16(kf[6],qr[3],C0,0,0,0),   P1[10],P1[11],P1[12],P1[13], pw3[0]=PKW(P1,8), pw3[1]=PKW(P1,10), pw3); \
    VRD(7); SBAR(); GAPA(C1=__builtin_amdgcn_mfma_f32_32x32x16_bf16(kf[7],qr[3],C1,0,0,0),   P1[14],P1[15],0.f,0.f,       pw3[2]=PKW(P1,12),pw3[3]=PKW(P1,14), pw3); \
    l_reg+=sacc; \
    if(GK){DMA_K((t)+3,sl_cur);} if(GV){DMA_V((t)+1,sl_next);} \
    CMASK(C0,C1,t); \
    resc=false; if(MX){ float a=MX3(C0[0],C0[1],C1[0]),b=MX3(C0[2],C0[3],C1[1]); a=MX3(a,C1[2],C1[3]); \
      _Pragma("unroll") for(int r=4;r<16;r+=4){a=MX3(a,C0[r],C0[r+1]);b=MX3(b,C0[r+2],C0[r+3]);a=MX3(a,C1[r],C1[r+1]);b=MX3(b,C1[r+2],C1[r+3]);} \
      float rm=__builtin_fmaxf(a,b); { auto rr=__builtin_amdgcn_permlane32_swap(__float_as_uint(rm),__float_as_uint(rm),false,false); rm=__builtin_fmaxf(__uint_as_float(rr[0]),__uint_as_float(rr[1])); } \
      resc=false; if(MODE==1) rm-=mhat; \
      if(__builtin_expect(__any(rm>(float)THRL),0)){ const float dl=__builtin_fmaxf(rm,0.f); mhat+=dl; \
        if(MODE==0){ _Pragma("unroll") for(int r=0;r<16;++r){C0[r]-=dl;C1[r]-=dl;} \
          _Pragma("unroll") for(int r=0;r<16;++r)negm[r]=-mhat; asm volatile("":"+v"(negm)); } \
        const float f=__builtin_amdgcn_exp2f(-dl); l_reg*=f; if(hi==0)wsf[r32]=f; resc=true; } \
      if(MODE==1){ _Pragma("unroll") for(int r=0;r<16;++r){C0[r]-=mhat;C1[r]-=mhat;} } } \
    SBAR(); \
    GAPB(o[0]=__builtin_amdgcn_mfma_f32_32x32x16_bf16(PAF(0),VFR(0),o[0],0,0,0), C0,0); \
    GAPB(o[1]=__builtin_amdgcn_mfma_f32_32x32x16_bf16(PAF(0),VFR(4),o[1],0,0,0), C0,4); \
    KRD(GL,0); GAPB(o[0]=__builtin_amdgcn_mfma_f32_32x32x16_bf16(PAF(1),VFR(1),o[0],0,0,0), C0,8); \
    KRD(GL,1); GAPB(o[1]=__builtin_amdgcn_mfma_f32_32x32x16_bf16(PAF(1),VFR(5),o[1],0,0,0), C0,12); \
    KRD(GL,2); GAPB(o[0]=__builtin_amdgcn_mfma_f32_32x32x16_bf16(PAF(2),VFR(2),o[0],0,0,0), C1,0); \
    KRD(GL,3); GAPB(o[1]=__builtin_amdgcn_mfma_f32_32x32x16_bf16(PAF(2),VFR(6),o[1],0,0,0), C1,4); \
    GAPB(o[0]=__builtin_amdgcn_mfma_f32_32x32x16_bf16(PAF(3),VFR(3),o[0],0,0,0), C1,8); \
    GAPB(o[1]=__builtin_amdgcn_mfma_f32_32x32x16_bf16(PAF(3),VFR(7),o[1],0,0,0), C1,12); \
    }while(0)
  int t=1;
  if(MODE==0) for(;t+7<NT;t+=4){
    STEP(pB0,pB1,pA0,pA1,t,true,true,true,true);      WAIT_BAR(2); RESC(); ROT();
    STEP(pA0,pA1,pB0,pB1,t+1,true,true,true,false);   WAIT_BAR(2); RESC(); ROT();
    STEP(pB0,pB1,pA0,pA1,t+2,true,true,true,false);   WAIT_BAR(2); RESC(); ROT();
    STEP(pA0,pA1,pB0,pB1,t+3,true,true,true,false);   WAIT_BAR(2); RESC(); ROT();
  }
  if(MODE==0) for(;t+5<NT;t+=2){
    STEP(pB0,pB1,pA0,pA1,t,true,true,true,true);     WAIT_BAR(2); RESC(); ROT();
    STEP(pA0,pA1,pB0,pB1,t+1,true,true,true,false);   WAIT_BAR(2); RESC(); ROT();
  }
  #define ENDW(tt) do{ if((tt)+3<NT){WAIT_BAR(2);} else if((tt)+2<NT){WAIT_BAR(1);} else {WAIT_BAR(0);} }while(0)
  for(;t+1<NT;t+=2){
    STEP(pB0,pB1,pA0,pA1,t,(t+3<NT),(t+1<NT),(t+1<NT),true);       ENDW(t);   RESC(); ROT();
    STEP(pA0,pA1,pB0,pB1,t+1,(t+4<NT),(t+2<NT),(t+2<NT),true);     ENDW(t+1); RESC(); ROT();
  }
  STEP(pB0,pB1,pA0,pA1,NT-1,false,false,false,true); RESC();
  { float sacc=pB0[0]+pB0[1]; _Pragma("unroll") for(int r=2;r<16;++r)sacc+=pB0[r]; _Pragma("unroll") for(int r=0;r<16;++r)sacc+=pB1[r]; l_reg+=sacc;
    pw0=(u32x4){PKW(pB0,0),PKW(pB0,2),PKW(pB0,4),PKW(pB0,6)};pw1=(u32x4){PKW(pB0,8),PKW(pB0,10),PKW(pB0,12),PKW(pB0,14)};pw2=(u32x4){PKW(pB1,0),PKW(pB1,2),PKW(pB1,4),PKW(pB1,6)};pw3=(u32x4){PKW(pB1,8),PKW(pB1,10),PKW(pB1,12),PKW(pB1,14)};
    SBAR(); pv(o,vb0+sl_cur,PAF(0),PAF(1),PAF(2),PAF(3)); }
  #undef PKW
  #undef PAF
  #undef VFR
  #undef PIN
  #undef MX3
  #undef GAPA
  #undef GAPB
  #undef EX
  #undef VRD
  #undef KRD
  #undef STEP
  #undef ENDW
  {auto rr=__builtin_amdgcn_permlane32_swap(__float_as_uint(l_reg),__float_as_uint(l_reg),false,false);l_reg=__uint_as_float(rr[0])+__uint_as_float(rr[1]);}
  if(MODE==1){ l_reg+=__builtin_amdgcn_exp2f(sinkl2-mhat); }
  if(hi==0)wsf[32+r32]=l_reg;asm volatile("s_waitcnt lgkmcnt(0)":::"memory");
  float rli[16];
  #pragma unroll
  for(int r=0;r<16;++r)rli[r]=__builtin_amdgcn_rcpf(wsf[32+crow(r,hi)]);
  bf16*Ow=YB+(long)(qrow0+wid*QBLK)*YP+ocol; const bf16*Zw=Pm+(long)(qrow0+wid*QBLK)*PP+zcol;
  { bf16*stg=(bf16*)(shm+LDS_OST)+wid*2048;
    #pragma unroll
    for(int r=0;r<16;++r){const int orow=crow(r,hi);
      #pragma unroll
      for(int d0=0;d0<2;++d0)stg[orow*64+d0*32+r32]=__float2bfloat16(o[d0][r]*rli[r]);}
    asm volatile("s_waitcnt lgkmcnt(0)":::"memory");
    #pragma unroll
    for(int i=0;i<4;++i){const int row=i*8+(lane>>3),ch=lane&7; const u32x4 v=*(const u32x4*)(stg+row*64+ch*8); const u32x4 z=*(const u32x4*)(Zw+(long)row*PP+ch*8); u32x4 w;
      #define GATE2(vv,zz) cvtpk_s(__uint_as_float((vv)<<16)*siluf_(__uint_as_float((zz)<<16)),__uint_as_float((vv)&0xffff0000u)*siluf_(__uint_as_float((zz)&0xffff0000u)))
      w.x=GATE2(v.x,z.x); w.y=GATE2(v.y,z.y); w.z=GATE2(v.z,z.z); w.w=GATE2(v.w,z.w);
      #undef GATE2
      *(u32x4*)(Ow+(long)row*YP+ch*8)=w;} }
  asm volatile("s_waitcnt lgkmcnt(0)\n\ts_barrier":::"memory");
  #undef DMA_K
  #undef DMA_V
  #undef CMASK
  #undef START
  #undef RESC
  #undef ROT
  #undef TROW
}
#undef SBAR
#undef WAIT_BAR
}

constexpr int NWAVES = 8;
constexpr int DM = 1024, SEQ = 8192, NCTX = 256, NB = 2;
constexpr int M_LAT = NB * SEQ, M_CTX = NB * NCTX, M_ALL = M_LAT + M_CTX;
constexpr int PW = 2816;
constexpr float RMS_EPS = 1e-6f;
constexpr float QSCALE = 0.125f * 1.4426950408889634f;
constexpr int C_AQ = 0, C_AK = 256, C_AV = 384, C_AZ = 512, C_DQ = 768, C_DK = 1024, C_DV = 1152, C_DZ = 1280, C_BF = 1536, C_BZ = 1792, C_CU = 2048, C_CV = 2304, C_CZ = 2560;

constexpr size_t MiB = 1u << 20;
constexpr size_t WS_CTL = 0, CTL_ZERO_BYTES = 1 * MiB;
constexpr size_t WS_MOD = 1 * MiB;
constexpr size_t WS_TAB = 2 * MiB;
constexpr size_t TAB_MA = 0, TAB_128 = 131072, TAB_64 = 229376, TAB_256 = 245760, TAB_WSP = 507904, TAB_ONES = 786432, TAB_BIASB = 1048576;
constexpr size_t WS_WIN = 4 * MiB, WS_WM = 16 * MiB, WS_WBR = 32 * MiB, WS_WOUT = 36 * MiB;
constexpr size_t WS_XC1 = 40 * MiB;
constexpr size_t WS_H = 42 * MiB, WS_YB = 75 * MiB, WS_T1 = 108 * MiB, WS_P = 124 * MiB;
constexpr size_t WS_GT = WS_P, WS_MG = WS_P + 40 * MiB;
constexpr size_t WS_MGC = 216 * MiB;
constexpr size_t WS_GTC = 218 * MiB;
constexpr size_t WS_END = 222 * MiB;
constexpr int CW_BAR = 4096;

constexpr int RING_BYTES = 147456, LDSCTL_OFF = RING_BYTES, MISC_OFF = LDSCTL_OFF + 320, LDS_BYTES = RING_BYTES + 1024;

#define GAS __attribute__((address_space(1)))
#define LAS __attribute__((address_space(3)))
typedef unsigned short bf16;
typedef unsigned v4u __attribute__((ext_vector_type(4)));
typedef unsigned v2u __attribute__((ext_vector_type(2)));
typedef float f32x4 __attribute__((ext_vector_type(4)));
typedef float f32x16 __attribute__((ext_vector_type(16)));
typedef short bf16x8 __attribute__((ext_vector_type(8)));
typedef GAS unsigned gu32;
#define RLX_AGENT __ATOMIC_RELAXED, __HIP_MEMORY_SCOPE_AGENT
#define LDS_WAIT() asm volatile("s_waitcnt lgkmcnt(0)" ::: "memory")
#define MFMA32(a, b, c) __builtin_amdgcn_mfma_f32_32x32x16_bf16((a), (b), (c), 0, 0, 0)
#define DI __device__ __forceinline__
DI unsigned f2bf(float f) { unsigned u = __builtin_bit_cast(unsigned, f); return (u + 0x7fffu + ((u >> 16) & 1u)) >> 16; }
DI unsigned pk2(float lo, float hi) { return f2bf(lo) | (f2bf(hi) << 16); }
DI float bf2f(bf16 v) { return __uint_as_float((unsigned)v << 16); }
DI float wlo(unsigned w) { return __uint_as_float(w << 16); }
DI float whi(unsigned w) { return __uint_as_float(w & 0xffff0000u); }
DI int crow(int reg, int h) { return (reg & 3) + 8 * (reg >> 2) + 4 * h; }
DI int krow(int s, int h, int j) { return 16 * s + 8 * (j >> 2) + 4 * h + (j & 3); }
DI float siluf(float x) { return x * __builtin_amdgcn_rcpf(1.0f + __builtin_amdgcn_exp2f(-1.4426950408889634f * x)); }
DI float geluf(float v) {
    const float av = __builtin_fabsf(v), d = av * 0.2316418882f + 1.0f, t = __builtin_amdgcn_rcpf(d);
    float q = t * 0.5307027145f + (-0.7265760135f); q = q * t + 0.7107068705f; q = q * t + (-0.142248368f); q = q * t + 0.127414796f; q = q * t;
    const float e = __builtin_amdgcn_exp2f((v * v) * (-0.72134752044f)), m = v * (q * e), r = v - m;
    return v < 0.f ? m : r;
}
typedef float f32x2_t __attribute__((ext_vector_type(2))); typedef __bf16 bf16x2_t __attribute__((ext_vector_type(2)));
DI unsigned cvtpk(float lo, float hi) { f32x2_t v = {lo, hi}; bf16x2_t b = __builtin_convertvector(v, bf16x2_t); return __builtin_bit_cast(unsigned, b); }
DI bf16x8 pack_step(const f32x16& x, int s) {
    v4u p; p.x = cvtpk(x[8 * s], x[8 * s + 1]); p.y = cvtpk(x[8 * s + 2], x[8 * s + 3]); p.z = cvtpk(x[8 * s + 4], x[8 * s + 5]); p.w = cvtpk(x[8 * s + 6], x[8 * s + 7]);
    return __builtin_bit_cast(bf16x8, p);
}
DI float shx(float v, int o, int lane) { return __int_as_float(__builtin_amdgcn_ds_bpermute((lane ^ o) << 2, __float_as_int(v))); }
DI float wave_sum(float v, int lane) {
#pragma unroll
    for (int o = 1; o < 64; o <<= 1) v += shx(v, o, lane);
    return v;
}

#define XB_TMO      128
#define XB_XCNT(j)  (256  + 64 * (j))
#define XB_XSUB(j)  (1280 + 64 * (j))
#define XB_XGEN(j)  (2304 + 64 * (j))
#define XB_TOP      3328
#define XB_TOPGEN   3392
#define XCD_BAR_WORDS 3456
#define XB_SPIN_CAP (1u << 22)
DI unsigned xb_ld(unsigned* p)              { return __hip_atomic_load(p, __ATOMIC_RELAXED, __HIP_MEMORY_SCOPE_AGENT); }
DI unsigned xb_add(unsigned* p, unsigned v) { return __hip_atomic_fetch_add(p, v, __ATOMIC_RELAXED, __HIP_MEMORY_SCOPE_AGENT); }
DI unsigned xb_xcc_id() { return (unsigned)__builtin_amdgcn_s_getreg((3 << 11) | 20) & 0xFu; }
#define XB_SPIN(cond, bar) do { unsigned _sp = 0; while (cond) { __builtin_amdgcn_s_sleep(1); \
    if ((++_sp & 255u) == 0u) { if (xb_ld(&(bar)[XB_TMO])) break; if (_sp > XB_SPIN_CAP) { atomicAdd(&(bar)[XB_TMO], 1u); break; } } } } while (0)
struct XcdBarrier { unsigned* bar; unsigned x; volatile LAS unsigned* st; };
DI XcdBarrier xcd_barrier_post(unsigned* bar, volatile LAS unsigned* st) {
    XcdBarrier b; b.bar = bar; b.x = xb_xcc_id(); b.st = st;
    if (threadIdx.x == 0) (void)xb_add(&bar[XB_XCNT(b.x)], 1u);
    return b;
}
DI void xcd_barrier_complete(unsigned* bar, unsigned x, unsigned& nloc, unsigned& nx) {
    const unsigned G = gridDim.x * gridDim.y * gridDim.z;
    unsigned sum, cnt, mine, sp = 0u;
    for (;;) {
        sum = 0u; cnt = 0u; mine = 0u;
#pragma unroll
        for (unsigned j = 0; j < 16; ++j) { const unsigned c = xb_ld(&bar[XB_XCNT(j)]); sum += c; cnt += (c > 0u) ? 1u : 0u; mine = (j == x) ? c : mine; }
        if (sum == G) break;
        __builtin_amdgcn_s_sleep(1);
        if ((++sp & 255u) == 0u) { if (xb_ld(&bar[XB_TMO])) break; if (sp > XB_SPIN_CAP) { atomicAdd(&bar[XB_TMO], 1u); break; } }
    }
    nloc = mine > 0u ? mine : 1u; nx = cnt > 0u ? cnt : 1u;
}
DI void xcd_barrier(const XcdBarrier& b) {
    asm volatile("s_waitcnt vmcnt(0)" ::: "memory");
    __syncthreads();
    if (threadIdx.x == 0) {
        unsigned* bar = b.bar;
        __builtin_amdgcn_s_waitcnt(0);
        __builtin_amdgcn_fence(__ATOMIC_ACQUIRE, "agent");
        unsigned nloc = b.st[0], nx = b.st[1];
        if (nloc == 0u) { xcd_barrier_complete(bar, b.x, nloc, nx); b.st[0] = nloc; b.st[1] = nx; }
        const unsigned old = xb_add(&bar[XB_XSUB(b.x)], 1u);
        const unsigned gen = old / nloc;
        if (old + 1u == (gen + 1u) * nloc) {
            __builtin_amdgcn_fence(__ATOMIC_RELEASE, "agent");
            asm volatile("s_waitcnt vmcnt(0)" ::: "memory");
            const unsigned og = xb_add(&bar[XB_TOP], 1u);
            const unsigned tg = og / nx;
            if (og + 1u == (tg + 1u) * nx) xb_add(&bar[XB_TOPGEN], 1u);
            else XB_SPIN(xb_ld(&bar[XB_TOPGEN]) == tg, bar);
            xb_add(&bar[XB_XGEN(b.x)], 1u);
            asm volatile("s_waitcnt vmcnt(0)" ::: "memory");
        } else {
            XB_SPIN(xb_ld(&bar[XB_XGEN(b.x)]) == gen, bar);
            asm volatile("s_waitcnt vmcnt(0)" ::: "memory");
        }
    }
    __syncthreads();
}

struct Frame {
    LAS unsigned char* lds;
    int tid, lane, wave, vcu, G;
};

DI void p0_transpose_item(const float* W, int N, bf16* WT, int ldt, int row_off, int col_off, LAS float* scr, int item, int lane) {
    const int nblk = N / 32, kb = item / nblk, nb = item % nblk, k0 = 64 * kb, n0 = 32 * nb;
#pragma unroll 8
    for (int i = 0; i < 32; ++i) { const int kk = 2 * i + (lane >> 5); scr[kk * 33 + (lane & 31)] = W[(size_t)(k0 + kk) * N + n0 + (lane & 31)]; }
    LDS_WAIT(); asm volatile("" ::: "memory");
    const int c = lane & 7;
#pragma unroll
    for (int j = 0; j < 4; ++j) { const int n = (lane >> 3) + 8 * j; const LAS float* s = scr + (8 * c) * 33 + n;
        v4u o; o.x = pk2(s[0 * 33], s[1 * 33]); o.y = pk2(s[2 * 33], s[3 * 33]); o.z = pk2(s[4 * 33], s[5 * 33]); o.w = pk2(s[6 * 33], s[7 * 33]);
        *(GAS v4u*)(WT + (size_t)(row_off + n0 + n) * ldt + col_off + k0 + 8 * c) = o; }
    LDS_WAIT(); asm volatile("" ::: "memory");
}

struct Args { const float* in[20]; float* out; unsigned char* ws; };
enum { I_X = 0, I_C, I_CTX, I_CCTX, I_NORMW, I_WADA, I_BADA, I_WIN, I_QNA, I_KNA, I_QND, I_KND, I_SINK, I_WFNET, I_WSP, I_BSP, I_WBR, I_WMERGE, I_BMERGE, I_WOUT };

DI void p0_prologue(const Frame& F, const Args& a) {
    unsigned char* ws = a.ws;
    for (int u = F.vcu; u < 96; u += F.G) {
        const int l = u / 48, j0 = 64 * (u % 48);
        LAS float* sl = (LAS float*)F.lds; LAS float* red = sl + 3072;
        for (int i = F.tid; i < 3072; i += 512) { const int v = i >> 10, k = i & 1023; const float cv = (v < 2) ? a.in[I_C][v * 1024 + k] : a.in[I_CCTX][k]; sl[i] = siluf(cv); }
        __syncthreads();
        float a0 = 0.f, a1 = 0.f, a2 = 0.f;
        const float* wp = a.in[I_WADA] + (size_t)l * 1024 * 3072 + (size_t)(128 * F.wave) * 3072 + j0 + F.lane;
#pragma unroll 32
        for (int kk = 0; kk < 128; ++kk) { const float w = wp[(size_t)kk * 3072]; const int k = 128 * F.wave + kk; a0 += sl[k] * w; a1 += sl[1024 + k] * w; a2 += sl[2048 + k] * w; }
        red[(F.wave * 3 + 0) * 64 + F.lane] = a0; red[(F.wave * 3 + 1) * 64 + F.lane] = a1; red[(F.wave * 3 + 2) * 64 + F.lane] = a2;
        __syncthreads();
        if (F.tid < 192) { const int v = F.tid >> 6, jj = F.tid & 63; float s = a.in[I_BADA][l * 3072 + j0 + jj];
#pragma unroll
            for (int w = 0; w < 8; ++w) s += red[(w * 3 + v) * 64 + jj];
            ((float*)(ws + WS_MOD))[(l * 3 + v) * 3072 + j0 + jj] = s; }
        __syncthreads();
    }
    {
        LAS float* scr = (LAS float*)(F.lds + F.wave * 16384);
        const int gw = F.vcu * NWAVES + F.wave, NGW = F.G * NWAVES;
        constexpr int I_IN = 16 * 88, I_M = 16 * 128, I_O = 16 * 32, I_B = 4 * 32, PER_L = I_IN + I_M + I_O + 4 * I_B;
        for (int it = gw; it < 2 * PER_L; it += NGW) {
            const int l = it / PER_L; int r = it % PER_L;
            if (r < I_IN) { p0_transpose_item(a.in[I_WIN] + (size_t)l * 1024 * PW, PW, (bf16*)(ws + WS_WIN) + (size_t)l * PW * 1024, 1024, 0, 0, scr, r, F.lane); continue; } r -= I_IN;
            if (r < I_M) { p0_transpose_item(a.in[I_WMERGE] + (size_t)l * 1024 * 4096, 4096, (bf16*)(ws + WS_WM) + (size_t)l * 4096 * 1024, 1024, 0, 0, scr, r, F.lane); continue; } r -= I_M;
            if (r < I_O) { p0_transpose_item(a.in[I_WOUT] + (size_t)l * 1024 * 1024, 1024, (bf16*)(ws + WS_WOUT) + (size_t)l * 1024 * 1024, 1024, 0, 0, scr, r, F.lane); continue; } r -= I_O;
            { const int br = r / I_B; r -= br * I_B;
              p0_transpose_item(a.in[I_WBR] + ((size_t)l * 4 + br) * 256 * 1024, 1024, (bf16*)(ws + WS_WBR) + (size_t)l * 1024 * 1024, 1024, 0, 256 * br, scr, r, F.lane); }
        }
    }
    {
        const int gt = F.vcu * 512 + F.tid, NGT = F.G * 512;
        bf16* tab = (bf16*)(ws + WS_TAB);
        for (int e = gt; e < 65536; e += NGT) {
            const int l = e >> 15, g = (e >> 13) & 3, col = (e >> 6) & 127, c = e & 63, d = col & 63;
            const float* wf = a.in[I_WFNET] + ((size_t)(l * 4 + g) * 64) * 64 + d; float s = 0.f;
            for (int j = 0; j < 64; ++j) { const float rev = (float)((c * j) & 63) * (1.0f / 64.0f); const float tw = (col < 64) ? __builtin_amdgcn_cosf(rev) : -__builtin_amdgcn_sinf(rev); s += tw * wf[j * 64]; }
            tab[TAB_MA / 2 + e] = (bf16)f2bf(s);
        }
        for (int e = gt; e < 49152; e += NGT) {
            const int mat = e / 16384, rem = e % 16384, k1b = rem >> 12, nb = (rem >> 10) & 3, s = (rem >> 9) & 1, ln = (rem >> 3) & 63, j = rem & 7;
            const int n1 = 32 * nb + krow(s, ln >> 5, j), k1 = 32 * k1b + (ln & 31); const float rev = (float)((n1 * k1) & 127) * (1.0f / 128.0f);
            const float v = (mat == 0) ? __builtin_amdgcn_cosf(rev) : (mat == 1) ? __builtin_amdgcn_sinf(rev) : -__builtin_amdgcn_sinf(rev);
            tab[TAB_128 / 2 + e] = (bf16)f2bf(v);
        }
        for (int e = gt; e < 8192; e += NGT) {
            const int mat = e >> 12, k2 = (e >> 6) & 63, n2 = e & 63; const float rev = (float)((k2 * n2) & 63) * (1.0f / 64.0f);
            tab[TAB_64 / 2 + e] = (bf16)f2bf(mat == 0 ? __builtin_amdgcn_cosf(rev) : __builtin_amdgcn_sinf(rev));
        }
        for (int e = gt; e < 131072; e += NGT) {
            const int mat = e >> 16, rem = e & 65535, kb = rem >> 13, nb = (rem >> 10) & 7, s = (rem >> 9) & 1, ln = (rem >> 3) & 63, j = rem & 7;
            const int n = 32 * nb + krow(s, ln >> 5, j), k = 32 * kb + (ln & 31); const float rev = (float)((n * k) & 255) * (1.0f / 256.0f);
            tab[TAB_256 / 2 + e] = (bf16)f2bf(mat == 0 ? __builtin_amdgcn_cosf(rev) : __builtin_amdgcn_sinf(rev));
        }
        for (int e = gt; e < 131072; e += NGT) tab[TAB_WSP / 2 + e] = (bf16)f2bf(a.in[I_WSP][e]);
        for (int e = gt; e < M_CTX * 1024 / 4; e += NGT) { ((f32x4*)(ws + WS_XC1))[e] = ((const f32x4*)a.in[I_CTX])[e]; ((f32x4*)(ws + WS_MGC))[e] = (f32x4){0.f, 0.f, 0.f, 0.f}; }
        for (int e = gt; e < 4096; e += NGT) tab[TAB_ONES / 2 + e] = (bf16)(((e & 31) == 0) ? 0x3f80 : 0);
        for (int e = gt; e < 262144; e += NGT) tab[TAB_BIASB / 2 + e] = (bf16)(((e & 31) == 0) ? f2bf(a.in[I_BMERGE][e >> 5]) : 0u);
    }
}

DI void p1_modrms(const Frame& F, const Args& a, int l, const float* xlat, const float* xctx, int with_ctx) {
    const float* mod = (const float*)(a.ws + WS_MOD) + (size_t)l * 3 * 3072;
    const float* nw = a.in[I_NORMW] + l * 1024;
    bf16* H = (bf16*)(a.ws + WS_H);
    const int gw = F.vcu * NWAVES + F.wave, NGW = F.G * NWAVES;
    const int nrows = with_ctx ? M_ALL : M_LAT;
    int vcur = -1; f32x4 av[4], bv[4];
    for (int row = gw; row < nrows; row += NGW) {
        const int v = row < SEQ ? 0 : (row < M_LAT ? 1 : 2);
        if (v != vcur) { vcur = v;
#pragma unroll
            for (int j = 0; j < 4; ++j) { const int c = 4 * (F.lane + 64 * j); const f32x4 w = *(const f32x4*)(nw + c), sc = *(const f32x4*)(mod + v * 3072 + 1024 + c);
                av[j] = w * (sc + 1.0f); bv[j] = *(const f32x4*)(mod + v * 3072 + c); } }
        const float* xr = (row < M_LAT) ? xlat + (size_t)row * 1024 : xctx + (size_t)(row - M_LAT) * 1024;
        f32x4 x[4]; float ss = 0.f;
#pragma unroll
        for (int j = 0; j < 4; ++j) { x[j] = *(const f32x4*)(xr + 4 * (F.lane + 64 * j)); ss += (x[j].x * x[j].x + x[j].y * x[j].y) + (x[j].z * x[j].z + x[j].w * x[j].w); }
        const float rstd = __builtin_amdgcn_rsqf(wave_sum(ss, F.lane) * (1.0f / 1024.0f) + RMS_EPS);
#pragma unroll
        for (int j = 0; j < 4; ++j) { const f32x4 h = x[j] * rstd * av[j] + bv[j]; v2u o; o.x = pk2(h.x, h.y); o.y = pk2(h.z, h.w);
            *(v2u*)(H + (size_t)row * 1024 + 4 * (F.lane + 64 * j)) = o; }
    }
}

DI void p3_prep(const Frame& F, const Args& a, int l, bf16* P) {
    const int gw = F.vcu * NWAVES + F.wave, NGW = F.G * NWAVES;
    const int d = F.lane;
    const float wqa = a.in[I_QNA][l * 64 + d], wka = a.in[I_KNA][l * 64 + d], wqd = a.in[I_QND][l * 64 + d], wkd = a.in[I_KND][l * 64 + d];
    const float inv = __builtin_amdgcn_exp2f(-(float)(d & 15) * (13.287712379549449f / 16.0f));
    const float sgn = (d & 16) ? 1.0f : -1.0f;
    const int nrows = M_ALL;
    for (int row = gw; row < nrows; row += NGW) {
        const bool isctx = row >= M_LAT;
        const int n = row & (SEQ - 1);
        float cs = 1.0f, sn = 0.0f;
        if (!isctx) { const float pos = (float)((d < 32) ? (n >> 6) : (n & 63)); const float rev = pos * inv * 0.15915494309189535f; cs = __builtin_amdgcn_cosf(rev); sn = __builtin_amdgcn_sinf(rev); }
        bf16* pr = P + (size_t)row * PW;
        const bool qok = !(isctx && l == 1);
        float v[12];
#pragma unroll
        for (int s = 0; s < 12; ++s) { const int col = (s < 4) ? C_AQ + 64 * s : (s < 6) ? C_AK + 64 * (s - 4) : (s < 10) ? C_DQ + 64 * (s - 6) : C_DK + 64 * (s - 10);
            const bool isq = (s < 4) || (s >= 6 && s < 10);
            v[s] = (isq && !qok) ? 0.f : bf2f(pr[col + d]); }
#pragma unroll
        for (int s = 0; s < 12; ++s) { const int col = (s < 4) ? C_AQ + 64 * s : (s < 6) ? C_AK + 64 * (s - 4) : (s < 10) ? C_DQ + 64 * (s - 6) : C_DK + 64 * (s - 10);
            const bool isq = (s < 4) || (s >= 6 && s < 10);
            const float w = (s < 4) ? wqa : (s < 6) ? wka : (s < 10) ? wqd : wkd;
            const float ss = wave_sum(v[s] * v[s], d);
            float y = v[s] * __builtin_amdgcn_rsqf(ss * (1.0f / 64.0f) + RMS_EPS) * w;
            const float p = shx(y, 16, d);
            y = y * cs + sgn * p * sn;
            if (isq) y *= QSCALE;
            if (!isq || qok) pr[col + d] = (bf16)f2bf(y); }
    }
}

DI void fnet_stepA(const bf16* xrow, const bf16* MAt, int r32, int hi, bf16x8 (&gs)[4][2]) {
    bf16x8 xa[4];
#pragma unroll
    for (int s4 = 0; s4 < 4; ++s4) xa[s4] = *(const bf16x8*)(xrow + 16 * s4 + 8 * hi);
#pragma unroll
    for (int cb = 0; cb < 4; ++cb) { f32x16 acc = f32x16{};
#pragma unroll
        for (int s4 = 0; s4 < 4; ++s4) { const bf16x8 bfr = *(const bf16x8*)(MAt + (32 * cb + r32) * 64 + 16 * s4 + 8 * hi); acc = MFMA32(xa[s4], bfr, acc); }
        gs[cb][0] = pack_step(acc, 0); gs[cb][1] = pack_step(acc, 1); }
}

DI void fnet_s1_unit(const Frame& F, const Args& a, int l, int u, const bf16* P) {
    const int b = u >> 7, n2grp = (u >> 4) & 7, g = (u >> 2) & 3, k1b = u & 3;
    const int lane = F.lane, r32 = lane & 31, hi = lane >> 5, w = F.wave, n2 = 8 * n2grp + w;
    const bf16* tab = (const bf16*)(a.ws + WS_TAB);
    const bf16* MAt = tab + TAB_MA / 2 + (size_t)(l * 4 + g) * 128 * 64;
    const bf16* T128 = tab + TAB_128 / 2;
    f32x16 Tr[2], Ti[2];
#pragma unroll
    for (int j = 0; j < 2; ++j) { Tr[j] = f32x16{}; Ti[j] = f32x16{}; }
#pragma unroll 1
    for (int nb = 0; nb < 4; ++nb) {
        const bf16* xrow = P + (size_t)(SEQ * b + 64 * (32 * nb + r32) + n2) * PW + C_BF + 64 * g;
        bf16x8 gs[4][2]; fnet_stepA(xrow, MAt, r32, hi, gs);
#pragma unroll
        for (int s = 0; s < 2; ++s) {
            const size_t fo = ((size_t)((k1b * 4 + nb) * 2 + s) * 64 + lane) * 8;
            const bf16x8 ca = *(const bf16x8*)(T128 + fo), sa = *(const bf16x8*)(T128 + 16384 + fo), na = *(const bf16x8*)(T128 + 32768 + fo);
            Tr[0] = MFMA32(ca, gs[0][s], Tr[0]); Tr[0] = MFMA32(sa, gs[2][s], Tr[0]);
            Tr[1] = MFMA32(ca, gs[1][s], Tr[1]); Tr[1] = MFMA32(sa, gs[3][s], Tr[1]);
            Ti[0] = MFMA32(ca, gs[2][s], Ti[0]); Ti[0] = MFMA32(na, gs[0][s], Ti[0]);
            Ti[1] = MFMA32(ca, gs[3][s], Ti[1]); Ti[1] = MFMA32(na, gs[1][s], Ti[1]); }
    }
    LAS bf16* tl = (LAS bf16*)F.lds;
#pragma unroll
    for (int i = 0; i < 16; ++i) { const int k1l = crow(i, hi), k1 = 32 * k1b + k1l;
        const float rev = (float)((n2 * k1) & 8191) * (1.0f / 8192.0f); const float c = __builtin_amdgcn_cosf(rev), s = __builtin_amdgcn_sinf(rev);
#pragma unroll
        for (int jb = 0; jb < 2; ++jb) { const float tr = Tr[jb][i], ti = Ti[jb][i];
            tl[(k1l * 128 + 32 * jb + r32) * 8 + w] = (bf16)f2bf(tr * c + ti * s);
            tl[(k1l * 128 + 64 + 32 * jb + r32) * 8 + w] = (bf16)f2bf(ti * c - tr * s); } }
    __syncthreads();
    bf16* T1 = (bf16*)(a.ws + WS_T1);
#pragma unroll 4
    for (int pass = 0; pass < 8; ++pass) { const int q = F.tid + 512 * pass, k1l = q >> 7, colL = q & 127;
        const v4u v = *(const LAS v4u*)(F.lds + (size_t)q * 16);
        *(v4u*)(T1 + ((((size_t)(b * 128 + 32 * k1b + k1l) * 8 + n2grp) * 512) + g * 128 + colL) * 8) = v; }
    __syncthreads();
}

DI void fnet_ctx_unit(const Frame& F, const Args& a, int l, int u, const bf16* P, bf16* YB) {
    const int b = u >> 2, g = u & 3;
    const int lane = F.lane, r32 = lane & 31, hi = lane >> 5, w = F.wave;
    const bf16* tab = (const bf16*)(a.ws + WS_TAB);
    const bf16* MAt = tab + TAB_MA / 2 + (size_t)(l * 4 + g) * 128 * 64;
    const bf16* T256 = tab + TAB_256 / 2;
    f32x16 Y[2]; Y[0] = f32x16{}; Y[1] = f32x16{};
#pragma unroll 1
    for (int nb = 0; nb < 8; ++nb) {
        const bf16* xrow = P + (size_t)(M_LAT + NCTX * b + 32 * nb + r32) * PW + C_BF + 64 * g;
        bf16x8 gs[4][2]; fnet_stepA(xrow, MAt, r32, hi, gs);
#pragma unroll
        for (int s = 0; s < 2; ++s) {
            const size_t fo = ((size_t)((w * 8 + nb) * 2 + s) * 64 + lane) * 8;
            const bf16x8 ca = *(const bf16x8*)(T256 + fo), sa = *(const bf16x8*)(T256 + 65536 + fo);
            Y[0] = MFMA32(ca, gs[0][s], Y[0]); Y[0] = MFMA32(sa, gs[2][s], Y[0]);
            Y[1] = MFMA32(ca, gs[1][s], Y[1]); Y[1] = MFMA32(sa, gs[3][s], Y[1]); }
    }
#pragma unroll
    for (int jb = 0; jb < 2; ++jb)
#pragma unroll
        for (int i = 0; i < 16; ++i) { const int k = 32 * w + crow(i, hi), d = 32 * jb + r32; const size_t row = (size_t)(M_LAT + NCTX * b + k);
            const float z = bf2f(P[row * PW + C_BZ + 64 * g + d]);
            YB[row * 1024 + 512 + 64 * g + d] = (bf16)f2bf(Y[jb][i] * (1.0f / 128.0f) * siluf(z)); }
}

#ifndef B_SCALE
#define B_SCALE 1.0f
#endif
#ifndef C_SCALE
#define C_SCALE 1.0f
#endif
DI void fnet_s3_unit(const Frame& F, const Args& a, int u, const bf16* P, bf16* YB) {
    const int b = u >> 7, k1 = u & 127;
    const int lane = F.lane, r32 = lane & 31, hi = lane >> 5, g = F.wave >> 1, jb = F.wave & 1;
    const bf16* T64 = (const bf16*)(a.ws + WS_TAB) + TAB_64 / 2;
    const bf16* T1 = (const bf16*)(a.ws + WS_T1);
    f32x16 Y[2]; Y[0] = f32x16{}; Y[1] = f32x16{};
#pragma unroll
    for (int sc = 0; sc < 4; ++sc)
#pragma unroll
        for (int ri = 0; ri < 2; ++ri) {
            const bf16x8 afr = *(const bf16x8*)(T1 + ((((size_t)(b * 128 + k1) * 8 + 2 * sc + hi) * 512) + g * 128 + ri * 64 + 32 * jb + r32) * 8);
#pragma unroll
            for (int k2b = 0; k2b < 2; ++k2b) { const bf16x8 bfr = *(const bf16x8*)(T64 + ri * 4096 + (32 * k2b + r32) * 64 + 16 * sc + 8 * hi); Y[k2b] = MFMA32(afr, bfr, Y[k2b]); } }
#pragma unroll
    for (int k2b = 0; k2b < 2; ++k2b) { const size_t row = (size_t)(SEQ * b + k1 + 128 * (32 * k2b + r32));
#pragma unroll
        for (int q = 0; q < 4; ++q) { const int d0 = 32 * jb + 8 * q + 4 * hi;
            const v2u z = *(const v2u*)(P + row * PW + C_BZ + 64 * g + d0);
            v2u o; o.x = pk2(Y[k2b][4 * q] * (B_SCALE * 0.0013810679320049757f) * siluf(wlo(z.x)), Y[k2b][4 * q + 1] * (B_SCALE * 0.0013810679320049757f) * siluf(whi(z.x)));
            o.y = pk2(Y[k2b][4 * q + 2] * (B_SCALE * 0.0013810679320049757f) * siluf(wlo(z.y)), Y[k2b][4 * q + 3] * (B_SCALE * 0.0013810679320049757f) * siluf(whi(z.y)));
            *(v2u*)(YB + row * 1024 + 512 + 64 * g + d0) = o; } }
}

DI void sgu_unit(const Frame& F, const Args& a, int l, int u, const bf16* P, bf16* YB) {
    constexpr int VP = 136;
    LAS bf16* vt = (LAS bf16*)F.lds;
    const int ci = u >> 2, g = u & 3;
    const size_t row0 = (size_t)ci * 128;
    { const int q = F.tid & 127, cq = F.tid >> 7; const bf16* src = P + (row0 + q) * PW + C_CV + 64 * g + 16 * cq;
#pragma unroll
      for (int i = 0; i < 2; ++i) { const v4u v = *(const v4u*)(src + 8 * i); const unsigned wv[4] = {v.x, v.y, v.z, v.w};
#pragma unroll
          for (int e = 0; e < 4; ++e) { vt[(16 * cq + 8 * i + 2 * e) * VP + q] = (bf16)f2bf(geluf(wlo(wv[e]))); vt[(16 * cq + 8 * i + 2 * e + 1) * VP + q] = (bf16)f2bf(geluf(whi(wv[e]))); } } }
    __syncthreads();
    const int lane = F.lane, r32 = lane & 31, hi = lane >> 5, pb = F.wave >> 1, cb = F.wave & 1;
    const bf16* Wsp = (const bf16*)(a.ws + WS_TAB) + TAB_WSP / 2 + (size_t)(l * 4 + g) * 128 * 128;
    f32x16 acc = f32x16{};
#pragma unroll
    for (int s = 0; s < 8; ++s) {
        const bf16x8 af = *(const LAS bf16x8*)(vt + (32 * cb + r32) * VP + 16 * s + 8 * hi);
        const bf16x8 bfr = *(const bf16x8*)(Wsp + (32 * pb + r32) * 128 + 16 * s + 8 * hi);
        acc = MFMA32(af, bfr, acc);
    }
    const int p = 32 * pb + r32; const float bb = a.in[I_BSP][(l * 4 + g) * 128 + p]; const bf16* pr = P + (row0 + p) * PW;
#pragma unroll
    for (int q = 0; q < 4; ++q) { const int c0 = 64 * g + 32 * cb + 8 * q + 4 * hi;
        const v2u uu = *(const v2u*)(pr + C_CU + c0), zz = *(const v2u*)(pr + C_CZ + c0);
        v2u o; o.x = pk2(C_SCALE * geluf(wlo(uu.x)) * (acc[4 * q] + bb) * siluf(wlo(zz.x)), C_SCALE * geluf(whi(uu.x)) * (acc[4 * q + 1] + bb) * siluf(whi(zz.x)));
        o.y = pk2(C_SCALE * geluf(wlo(uu.y)) * (acc[4 * q + 2] + bb) * siluf(wlo(zz.y)), C_SCALE * geluf(whi(uu.y)) * (acc[4 * q + 3] + bb) * siluf(whi(zz.y)));
        *(v2u*)(YB + (row0 + p) * 1024 + 768 + c0) = o; }
    __syncthreads();
}

DI void p5_ctx_convert(const Frame& F, const Args& a) {
    const int gt = F.vcu * 512 + F.tid, NGT = F.G * 512;
    const f32x4* src = (const f32x4*)(a.ws + WS_MGC); v2u* dst = (v2u*)((bf16*)(a.ws + WS_MG) + (size_t)M_LAT * 1024);
    for (int e = gt; e < M_CTX * 1024 / 4; e += NGT) { const f32x4 v = src[e]; v2u o; o.x = pk2(v.x, v.y); o.y = pk2(v.z, v.w); dst[e] = o; }
}

#ifdef SELFCHECK
constexpr int CW_CHK = 8192;
DI unsigned hsh(unsigned x) { x *= 2654435761u; x ^= x >> 15; x *= 2246822519u; x ^= x >> 13; x *= 3266489917u; x ^= x >> 16; return x; }
DI void chk_acc(const Args& a, int id, float got, float want) {
    unsigned* w = (unsigned*)(a.ws + WS_CTL) + CW_CHK + 4 * id;
    float d = __builtin_fabsf(got - want); if (!(d == d) || d > 1e15f) d = 1e15f;
    atomicAdd((float*)w, d * d); atomicAdd((float*)(w + 1), want * want); atomicAdd(w + 2, 1u); atomicMax(w + 3, __float_as_uint(d));
}
DI float bfr(float x) { return __uint_as_float(f2bf(x) << 16); }
DI void chk_p0(const Frame& F, const Args& a) {
    const int gt = F.vcu * 512 + F.tid, NGT = F.G * 512;
    for (int s = gt; s < 18432; s += NGT) { const int l = s / 9216, v = (s / 3072) % 3, j = s % 3072; float acc = a.in[I_BADA][l * 3072 + j];
        for (int k = 0; k < 1024; ++k) { const float cv = (v < 2) ? a.in[I_C][v * 1024 + k] : a.in[I_CCTX][k]; acc += siluf(cv) * a.in[I_WADA][((size_t)l * 1024 + k) * 3072 + j]; }
        chk_acc(a, 0, ((const float*)(a.ws + WS_MOD))[(l * 3 + v) * 3072 + j], acc); }
    for (int s = gt; s < 65536; s += NGT) { const unsigned h = hsh(s); const int l = (s >> 2) & 1, m = s & 3, k = h & 1023; const unsigned h2 = hsh(h + 77u);
        float got, want;
        if (m == 0) { const int n = h2 % PW; want = bfr(a.in[I_WIN][((size_t)l * 1024 + k) * PW + n]); got = bf2f(((const bf16*)(a.ws + WS_WIN))[((size_t)l * PW + n) * 1024 + k]); }
        else if (m == 1) { const int n = h2 & 4095; want = bfr(a.in[I_WMERGE][((size_t)l * 1024 + k) * 4096 + n]); got = bf2f(((const bf16*)(a.ws + WS_WM))[((size_t)l * 4096 + n) * 1024 + k]); }
        else if (m == 2) { const int n = h2 & 1023; want = bfr(a.in[I_WOUT][((size_t)l * 1024 + k) * 1024 + n]); got = bf2f(((const bf16*)(a.ws + WS_WOUT))[((size_t)l * 1024 + n) * 1024 + k]); }
        else { const int n = h2 & 1023, br = k >> 8, kk = k & 255; want = bfr(a.in[I_WBR][(((size_t)l * 4 + br) * 256 + kk) * 1024 + n]); got = bf2f(((const bf16*)(a.ws + WS_WBR))[((size_t)l * 1024 + n) * 1024 + 256 * br + kk]); }
        chk_acc(a, 1, got, want); }
}
DI int sample_row(unsigned h, int l) { const int r = h % M_ALL; (void)l; return ((h >> 20) & 7) == 0 ? M_LAT + (h % M_CTX) : r; }
DI void chk_h(const Frame& F, const Args& a, int l, int id) {
    const float* mod = (const float*)(a.ws + WS_MOD) + (size_t)l * 3 * 3072; const bf16* H = (const bf16*)(a.ws + WS_H);
    const int gw = F.vcu * NWAVES + F.wave, NGW = F.G * NWAVES;
    for (int s = gw; s < M_ALL; s += NGW) { const int row = s; const int v = row < SEQ ? 0 : (row < M_LAT ? 1 : 2);
        const float* xr = (row < M_LAT) ? ((l == 0) ? a.in[I_X] : a.out) + (size_t)row * 1024 : ((l == 0) ? a.in[I_CTX] : (const float*)(a.ws + WS_XC1)) + (size_t)(row - M_LAT) * 1024;
        float ss = 0.f; for (int j = 0; j < 16; ++j) { const float x = xr[F.lane + 64 * j]; ss += x * x; }
        const float rstd = 1.0f / sqrtf(wave_sum(ss, F.lane) * (1.0f / 1024.0f) + RMS_EPS);
        for (int j = 0; j < 16; ++j) { const int c = F.lane + 64 * j; const float want = xr[c] * rstd * a.in[I_NORMW][l * 1024 + c] * (1.0f + mod[v * 3072 + 1024 + c]) + mod[v * 3072 + c];
            chk_acc(a, id, bf2f(H[(size_t)row * 1024 + c]), want); } }
}
DI float dot_h_w(const bf16* hrow, const bf16* wrow, int K) { float acc = 0.f; for (int k = 0; k < K; ++k) acc += bf2f(hrow[k]) * bf2f(wrow[k]); return acc; }
DI void chk_p(const Frame& F, const Args& a, int l, int id) {
    const bf16* H = (const bf16*)(a.ws + WS_H); const bf16* W = (const bf16*)(a.ws + WS_WIN) + (size_t)l * PW * 1024; const bf16* P = (const bf16*)(a.ws + WS_P);
    const int gt = F.vcu * 512 + F.tid, NGT = F.G * 512;
    for (int s = gt; s < (1 << 20); s += NGT) { const unsigned h = hsh(s * 5 + 2); const int row = sample_row(h, l); int col = hsh(h + 9u) % PW;
        if (l == 1 && row >= M_LAT) col = ((col & 1) ? 1024 : 256) + (col & 255);
        chk_acc(a, id, bf2f(P[(size_t)row * PW + col]), dot_h_w(H + (size_t)row * 1024, W + (size_t)col * 1024, 1024)); }
}
DI void chk_prep(const Frame& F, const Args& a, int l, int id) {
    const bf16* H = (const bf16*)(a.ws + WS_H); const bf16* W = (const bf16*)(a.ws + WS_WIN) + (size_t)l * PW * 1024; const bf16* P = (const bf16*)(a.ws + WS_P);
    const int gw = F.vcu * NWAVES + F.wave, NGW = F.G * NWAVES, d = F.lane;
    for (int s = gw; s < 16384; s += NGW) { const unsigned h = hsh(s * 7 + 3); const int row = sample_row(h, l); int sl = (h >> 8) % 12; const bool isctx = row >= M_LAT;
        if (isctx && l == 1) sl = (sl & 1) ? 4 + (sl & 1) : 10 + ((sl >> 1) & 1);
        const int col = (sl < 4) ? C_AQ + 64 * sl : (sl < 6) ? C_AK + 64 * (sl - 4) : (sl < 10) ? C_DQ + 64 * (sl - 6) : C_DK + 64 * (sl - 10);
        const bool isq = (sl < 4) || (sl >= 6 && sl < 10);
        const float raw = bfr(dot_h_w(H + (size_t)row * 1024, W + (size_t)(col + d) * 1024, 1024));
        const float wv = ((sl < 4) ? a.in[I_QNA] : (sl < 6) ? a.in[I_KNA] : (sl < 10) ? a.in[I_QND] : a.in[I_KND])[l * 64 + d];
        const float ms = wave_sum(raw * raw, d) * (1.0f / 64.0f);
        float y = raw / sqrtf(ms + RMS_EPS) * wv;
        if (!isctx) { const int n = row & (SEQ - 1); const float pos = (float)((d < 32) ? (n >> 6) : (n & 63)); const float inv = __builtin_amdgcn_exp2f(-(float)(d & 15) * (13.287712379549449f / 16.0f)); const float rev = pos * inv * 0.15915494309189535f; const float cs = __builtin_amdgcn_cosf(rev), sn = __builtin_amdgcn_sinf(rev);
            const float p = shx(y, 16, d); y = (d & 16) ? (p * sn + y * cs) : (y * cs - p * sn); }
        if (isq) y *= QSCALE;
        chk_acc(a, id, bf2f(P[(size_t)row * PW + col + d]), y); }
}
DI void chk_attn(const Frame& F, const Args& a, int l, int id, int mode) {
    const bf16* P = (const bf16*)(a.ws + WS_P); const bf16* YB = (const bf16*)(a.ws + WS_YB);
    LAS float* qs = (LAS float*)F.lds + F.wave * 192; LAS float* os = qs + 64; LAS float* red = qs + 128;
    const int gw = F.vcu * NWAVES + F.wave, NGW = F.G * NWAVES, lane = F.lane;
    const int qc0 = mode ? C_DQ : C_AQ, kc0 = mode ? C_DK : C_AK, vc0 = mode ? C_DV : C_AV, zc0 = mode ? C_DZ : C_AZ, oc0 = mode ? 256 : 0;
    for (int s = gw; s < 8192; s += NGW) { const unsigned hh = hsh(s * 11 + 5 + mode); int row = sample_row(hh, l); if ((s & 7) == 1) row = (hh & 8192) + (hh & 255) + ((hh & 256) ? 7936 : 0); if (l == 1 && row >= M_LAT) row = hh % M_LAT; const int h = (hh >> 9) & 3, kvh = h >> 1; const bool isctx = row >= M_LAT;
        const int b = isctx ? (row - M_LAT) / NCTX : row / SEQ, pos = row & (SEQ - 1);
        qs[lane] = bf2f(P[(size_t)row * PW + qc0 + 64 * h + lane]); LDS_WAIT();
        int klo = 0, khi = -1; if (!isctx) { if (mode == 0) { klo = 0; khi = SEQ - 1; } else { klo = pos - 128 < 0 ? 0 : pos - 128; khi = pos + 128 > SEQ - 1 ? SEQ - 1 : pos + 128; } }
        const int nlat = khi - klo + 1 > 0 ? khi - klo + 1 : 0, nk = NCTX + nlat;
        float m = -1e30f, lsum = 0.f; float acc[64];
#pragma unroll
        for (int dd = 0; dd < 64; ++dd) acc[dd] = 0.f;
        for (int kk = lane; kk < nk; kk += 64) { const size_t kr = (kk < NCTX) ? (size_t)(M_LAT + NCTX * b + kk) : (size_t)(SEQ * b + klo + kk - NCTX);
            const bf16* kp = P + kr * PW + kc0 + 64 * kvh; const bf16* vp = P + kr * PW + vc0 + 64 * kvh; float sc = 0.f;
#pragma unroll
            for (int dd = 0; dd < 64; ++dd) sc += qs[dd] * bf2f(kp[dd]);
            const float mn = fmaxf(m, sc), f = __builtin_amdgcn_exp2f(m - mn), p = __builtin_amdgcn_exp2f(sc - mn); lsum = lsum * f + p; m = mn;
#pragma unroll
            for (int dd = 0; dd < 64; ++dd) acc[dd] = acc[dd] * f + p * bf2f(vp[dd]); }
        float mall = m;
#pragma unroll
        for (int o = 1; o < 64; o <<= 1) mall = fmaxf(mall, shx(mall, o, lane));
        const float f = __builtin_amdgcn_exp2f(m - mall); lsum = wave_sum(lsum * f, lane);
        if (mode == 1) lsum += __builtin_amdgcn_exp2f(a.in[I_SINK][l * 4 + h] * 1.4426950408889634f - mall);
#pragma unroll
        for (int dd = 0; dd < 64; ++dd) { const float t = wave_sum(acc[dd] * f, lane); if (lane == dd) os[dd] = t; }
        LDS_WAIT();
        const float z = bf2f(P[(size_t)row * PW + zc0 + 64 * h + lane]);
        chk_acc(a, id, bf2f(YB[(size_t)row * 1024 + oc0 + 64 * h + lane]), os[lane] / lsum * siluf(z));
        (void)red; }
}
DI void chk_fnet(const Frame& F, const Args& a, int l, int id, int ctxmode) {
    const bf16* P = (const bf16*)(a.ws + WS_P); const bf16* YB = (const bf16*)(a.ws + WS_YB);
    LAS float* ys = (LAS float*)F.lds + F.wave * 64;
    const int gw = F.vcu * NWAVES + F.wave, NGW = F.G * NWAVES, j = F.lane;
    const int N = ctxmode ? NCTX : SEQ;
    for (int s = gw; s < (ctxmode ? 256 : 1024); s += NGW) { const unsigned hh = hsh(s * 13 + 7 + ctxmode); const int b = hh & 1, g = (hh >> 1) & 3; int k = (hh >> 3) % N;
#ifdef FNET_K0
        k = (s & 7) == 0 ? 0 : (s & 7) == 1 ? N / 2 : (s & 7) == 2 ? 64 : (s & 7) == 3 ? 128 : (s & 7) == 4 ? 1 : k;
#endif
        const size_t rbase = ctxmode ? (size_t)(M_LAT + NCTX * b) : (size_t)(SEQ * b);
        float y = 0.f;
        for (int n = 0; n < N; ++n) { const bf16* fr = P + (rbase + n) * PW + C_BF + 64 * g; float A = 0.f, B = 0.f;
            for (int c = 0; c < 64; ++c) { const float fv = bf2f(fr[c]); const float ph = (float)((j * c) & 63) * (1.0f / 64.0f); A += fv * __builtin_amdgcn_cosf(ph); B += fv * __builtin_amdgcn_sinf(ph); }
            const float th = (float)((k * n) & (N - 1)) / (float)N; y += __builtin_amdgcn_cosf(th) * A - __builtin_amdgcn_sinf(th) * B; }
        ys[j] = y / sqrtf((float)N * 64.0f); LDS_WAIT();
        float o = 0.f; for (int jj = 0; jj < 64; ++jj) o += ys[jj] * a.in[I_WFNET][((size_t)(l * 4 + g) * 64 + jj) * 64 + j];
        const size_t row = rbase + k; const float z = bf2f(P[row * PW + C_BZ + 64 * g + j]);
        chk_acc(a, id, bf2f(YB[row * 1024 + 512 + 64 * g + j]), o * siluf(z)); LDS_WAIT(); }
}
DI void chk_sgu(const Frame& F, const Args& a, int l, int id) {
    const bf16* P = (const bf16*)(a.ws + WS_P); const bf16* YB = (const bf16*)(a.ws + WS_YB);
    const int gt = F.vcu * 512 + F.tid, NGT = F.G * 512;
    for (int s = gt; s < (1 << 18); s += NGT) { const unsigned hh = hsh(s * 17 + 11); int row = sample_row(hh, l); if (l == 1 && row >= M_LAT) row = hh % M_LAT; const int cc = hsh(hh + 101u) & 255, g = cc >> 6, p = row & 127; const size_t r0 = (size_t)(row - p);
        float sp = a.in[I_BSP][(l * 4 + g) * 128 + p];
        for (int q = 0; q < 128; ++q) { const float v = bf2f(P[(r0 + q) * PW + C_CV + cc]); sp += a.in[I_WSP][((size_t)(l * 4 + g) * 128 + p) * 128 + q] * (0.5f * v * (1.0f + erff(v * 0.7071067811865476f))); }
        const float u = bf2f(P[(size_t)row * PW + C_CU + cc]), z = bf2f(P[(size_t)row * PW + C_CZ + cc]);
        chk_acc(a, id, bf2f(YB[(size_t)row * 1024 + 768 + cc]), (0.5f * u * (1.0f + erff(u * 0.7071067811865476f))) * sp * siluf(z)); }
}
DI void chk_merge(const Frame& F, const Args& a, int l, int id) {
    const bf16* H = (const bf16*)(a.ws + WS_H); const bf16* YB = (const bf16*)(a.ws + WS_YB); const bf16* MG = (const bf16*)(a.ws + WS_MG);
    const bf16* WM = (const bf16*)(a.ws + WS_WM) + (size_t)l * 4096 * 1024; const bf16* WB = (const bf16*)(a.ws + WS_WBR) + (size_t)l * 1024 * 1024;
    const int gt = F.vcu * 512 + F.tid, NGT = F.G * 512;
    for (int s = gt; s < (1 << 18); s += NGT) { const unsigned hh = hsh(s * 19 + 13); int row = sample_row(hh, l); if (l == 1 && row >= M_LAT) row = hh % M_LAT; const int d = hsh(hh + 202u) & 1023; float acc = 0.f;
        for (int r = 0; r < 4; ++r) { const float G = dot_h_w(H + (size_t)row * 1024, WM + ((size_t)r * 1024 + d) * 1024, 1024) + a.in[I_BMERGE][l * 4096 + r * 1024 + d];
            const float Y = dot_h_w(YB + (size_t)row * 1024 + 256 * r, WB + (size_t)d * 1024 + 256 * r, 256); acc += Y * __builtin_amdgcn_rcpf(1.0f + __builtin_amdgcn_exp2f(-1.4426950408889634f * G)); }
        float got; if (row < M_LAT) got = bf2f(MG[(size_t)row * 1024 + d]); else { got = 0.f; for (int br = 0; br < 4; ++br) got += bf2f(((const bf16*)(a.ws + WS_GTC))[((size_t)br * 512 + (row - M_LAT)) * 1024 + d]); }
        chk_acc(a, id, got, acc); }
}
DI void chk_gt(const Frame& F, const Args& a, int l, int r, int id) {
    const bf16* H = (const bf16*)(a.ws + WS_H); const bf16* GT = (const bf16*)(a.ws + WS_GT); const bf16* WM = (const bf16*)(a.ws + WS_WM) + (size_t)l * 4096 * 1024;
    const int gt = F.vcu * 512 + F.tid, NGT = F.G * 512;
    for (int s = gt; s < (1 << 18); s += NGT) { const unsigned hh = hsh(s * 29 + 19); int row = sample_row(hh, l); if (l == 1 && row >= M_LAT) row = hh % M_LAT; const int d = hsh(hh + 404u) & 1023;
        const float G = dot_h_w(H + (size_t)row * 1024, WM + ((size_t)r * 1024 + d) * 1024, 1024) + a.in[I_BMERGE][l * 4096 + r * 1024 + d];
        chk_acc(a, id, bf2f(GT[(size_t)row * 1024 + d]), __builtin_amdgcn_rcpf(1.0f + __builtin_amdgcn_exp2f(-1.4426950408889634f * G))); }
}
DI void chk_final(const Frame& F, const Args& a, int l, int id) {
    const bf16* MG = (const bf16*)(a.ws + WS_MG); const bf16* WO = (const bf16*)(a.ws + WS_WOUT) + (size_t)l * 1024 * 1024; const float* mod = (const float*)(a.ws + WS_MOD) + (size_t)l * 3 * 3072;
    const int gt = F.vcu * 512 + F.tid, NGT = F.G * 512;
    for (int s = gt; s < (1 << 18); s += NGT) { const unsigned hh = hsh(s * 23 + 17); const int row = sample_row(hh, l), c = hsh(hh + 303u) & 1023; const int v = row < SEQ ? 0 : (row < M_LAT ? 1 : 2);
        if (l == 1 && row >= M_LAT) continue;
        const float xi = (l == 1) ? ((const float*)(a.ws + WS_H))[(size_t)row * 1024 + c] : (row < M_LAT) ? a.in[I_X][(size_t)row * 1024 + c] : a.in[I_CTX][(size_t)(row - M_LAT) * 1024 + c];
        const float got = (row < M_LAT) ? a.out[(size_t)row * 1024 + c] : ((const float*)(a.ws + WS_XC1))[(size_t)(row - M_LAT) * 1024 + c];
        float dsum;
        if (row < M_LAT) dsum = dot_h_w(MG + (size_t)row * 1024, WO + (size_t)c * 1024, 1024);
        else { dsum = 0.f; for (int br = 0; br < 4; ++br) dsum += dot_h_w((const bf16*)(a.ws + WS_GTC) + ((size_t)br * 512 + (row - M_LAT)) * 1024, WO + (size_t)c * 1024, 1024); }
        chk_acc(a, id, got - xi, mod[v * 3072 + 2048 + c] * dsum); }
}
#ifdef CHECK_MAX
#define CHK_ERR(md, ss, n, mx) ((mx) / (sqrtf((ss) / (float)(n)) + 1e-20f))
#else
#define CHK_ERR(md, ss, n, mx) sqrtf((md) / ((ss) + 1e-30f))
#endif
DI void chk_report(const Frame& F, const Args& a) {
    const unsigned* w = (const unsigned*)(a.ws + WS_CTL) + CW_CHK; int first = -1; float ferr = 0.f;
#ifdef CHECK_ONLY
    { const int id = CHECK_ONLY; const float md = __uint_as_float(w[4 * id]), ss = ((const float*)w)[4 * id + 1]; const unsigned n = w[4 * id + 2]; first = id; ferr = n ? CHK_ERR(md, ss, n, __uint_as_float(w[4 * id + 3])) : 1e3f; }
#else
    for (int id = 0; id < 24; ++id) { const float md = __uint_as_float(w[4 * id]), ss = ((const float*)w)[4 * id + 1]; const unsigned n = w[4 * id + 2]; if (!n) continue;
        const float e = CHK_ERR(md, ss, n, __uint_as_float(w[4 * id + 3])); if (e > CHECK_TOL && first < 0) { first = id; ferr = e; } }
#endif
    const float V = first >= 0 ? 10.0f * (float)(1 + first) : 0.f; const float W = first >= 0 ? 4.0f + log10f(fminf(fmaxf(ferr, 1e-3f), 1e3f)) : 0.f;
    const size_t gt = (size_t)F.vcu * 512 + F.tid, NGT = (size_t)F.G * 512;
#ifdef KEEP_OUT
    if (gt == 0) a.out[0] += V; (void)W; (void)NGT;
#else
    for (size_t i = gt; i < (size_t)M_LAT * 1024; i += NGT) { float v = a.in[I_X][i]; if (i == 0) v += V; if (i >= (1u << 20) && i < (2u << 20)) v += W; a.out[i] = v; }
#endif
}
DI void chk_copy_out(const Frame& F, const Args& a) {
    const size_t gt = (size_t)F.vcu * 512 + F.tid, NGT = (size_t)F.G * 512; float* dst = (float*)(a.ws + WS_H);
    for (size_t i = gt; i < (size_t)M_LAT * 1024; i += NGT) dst[i] = a.out[i];
}
#endif

typedef const __attribute__((address_space(4))) Args* CArgsP;
DI Args fresh_args() { CArgsP p = (CArgsP)__builtin_amdgcn_kernarg_segment_ptr(); asm volatile("" : "+s"(p)); Args r;
#pragma unroll
    for (int i = 0; i < 20; ++i) r.in[i] = p->in[i];
    r.out = p->out; r.ws = p->ws; return r; }
DI Frame fresh_frame(unsigned char* lds) {
    Frame F; int t_ = threadIdx.x; asm volatile("" : "+v"(t_));
    F.lds = (LAS unsigned char*)lds; F.tid = t_; F.lane = t_ & 63; F.wave = __builtin_amdgcn_readfirstlane(t_ >> 6);
    F.G = gridDim.x; { const int bx = blockIdx.x; F.vcu = (F.G % 8 == 0) ? (bx % 8) * (F.G / 8) + bx / 8 : bx; }
    return F;
}
DI void grid_bar(unsigned char* lds) {
    const Args a = fresh_args();
    XcdBarrier b; b.bar = (unsigned*)(a.ws + WS_CTL) + CW_BAR; b.x = xb_xcc_id(); b.st = (volatile LAS unsigned*)((LAS unsigned char*)lds + MISC_OFF) + 8;
    xcd_barrier(b);
}

__global__ void __launch_bounds__(NWAVES * 64, 2) hybrid_fwd(Args args) {
    extern __shared__ __attribute__((aligned(16))) unsigned char lds[];
    for (int u = threadIdx.x; u < (LDS_BYTES - LDSCTL_OFF) / 4; u += NWAVES * 64) ((LAS unsigned*)((LAS unsigned char*)lds + LDSCTL_OFF))[u] = 0u;
    __syncthreads();
    { const Args a = fresh_args(); (void)xcd_barrier_post((unsigned*)(a.ws + WS_CTL) + CW_BAR, (volatile LAS unsigned*)((LAS unsigned char*)lds + MISC_OFF) + 8); }
#define GRID_BAR() grid_bar(lds)
#ifndef DUP_MASK
#define DUP_MASK 0
#endif
#define DUP(bit) for (int rep_ = 0; rep_ < 1 + (((DUP_MASK) >> (bit)) & 1); ++rep_)
#ifdef SELFCHECK
#ifndef CHECK_SET
#define CHECK_SET 0xffff
#endif
#define CHK(bit, call) do { if ((CHECK_SET) & (bit)) { { const Frame F = fresh_frame(lds); const Args a = fresh_args(); call; } GRID_BAR(); } } while (0)
#elif defined(EXTRA_BAR)
#define CHK(bit, call) GRID_BAR()
#else
#define CHK(bit, call) do {} while (0)
#endif

#ifndef SKIP_P0
    DUP(0) { const Frame F = fresh_frame(lds); const Args a = fresh_args(); p0_prologue(F, a); }
#endif
    GRID_BAR();
    CHK(1, chk_p0(F, a));

#pragma unroll 1
    for (int l = 0; l < 2; ++l) {
#ifndef SKIP_P1
        DUP(1) { const Frame F = fresh_frame(lds); const Args a = fresh_args();
          p1_modrms(F, a, l, (l == 0) ? a.in[I_X] : a.out, (l == 0) ? a.in[I_CTX] : (const float*)(a.ws + WS_XC1), 1); }
#endif
        GRID_BAR();
        CHK(2, chk_h(F, a, l, 2 + 10 * l));
#ifndef SKIP_G1
        DUP(2) { const Frame F = fresh_frame(lds); const Args a = fresh_args();
            pg8::Gemm g{(const bf16*)(a.ws + WS_H), (const bf16*)(a.ws + WS_WIN) + (size_t)l * PW * 1024, 1024, 1024, 1024};
            pg8::OrderX S; S.so.init(l == 0 ? M_ALL : M_LAT, PW, F.G, (int)blockIdx.x); S.nx = (l == 0) ? 0 : 4;
            pg8::EpiBf16<0> E{(bf16*)(a.ws + WS_P), PW, nullptr};
            pg8::gemm_phase<pg8::EpiBf16<0>, pg8::OrderX, true>(F.lds, g, S, E);
        }
#endif
        GRID_BAR();
        CHK(4, chk_p(F, a, l, 3 + 10 * l));
#ifndef SKIP_S1
        DUP(3) { const Frame F = fresh_frame(lds); const Args a = fresh_args();
          for (int u = F.vcu; u < 256; u += F.G) fnet_s1_unit(F, a, l, u, (const bf16*)(a.ws + WS_P)); }
#endif
#ifndef SKIP_FC
        if (l == 0) { const Frame F = fresh_frame(lds); const Args a = fresh_args();
          for (int e = F.vcu; e < 256; e += F.G) { if ((e & 31) == 7) fnet_ctx_unit(F, a, l, e >> 5, (const bf16*)(a.ws + WS_P), (bf16*)(a.ws + WS_YB)); } }
#endif
#ifndef SKIP_PREP
        { const Frame F = fresh_frame(lds); const Args a = fresh_args(); p3_prep(F, a, l, (bf16*)(a.ws + WS_P)); }
#endif
        GRID_BAR();
        CHK(8, chk_prep(F, a, l, 4 + 10 * l));
#ifndef SKIP_ATT
        DUP(4) { const Frame F = fresh_frame(lds); const Args a = fresh_args();
            const attn_body::bf16* Pa = (const attn_body::bf16*)(a.ws + WS_P); attn_body::bf16* Ya = (attn_body::bf16*)(a.ws + WS_YB);
            for (int u = F.vcu; u < 256; u += F.G) {
                const int bk = u >> 6, b = bk >> 1, kvh = bk & 1, h = 2 * kvh + ((u >> 5) & 1), qb = u & 31;
                attn_body::attn_unit<0, 8>(Pa, Ya, SEQ * b + 256 * qb, M_LAT + NCTX * b, SEQ * b, 0, 132, 0,
                                           C_AQ + 64 * h, C_AK + 64 * kvh, C_AV + 64 * kvh, C_AZ + 64 * h, 64 * h, 0.f, (char*)lds);
            }
        }
        DUP(5) { const Frame F = fresh_frame(lds); const Args a = fresh_args();
            const attn_body::bf16* Pa = (const attn_body::bf16*)(a.ws + WS_P); attn_body::bf16* Ya = (attn_body::bf16*)(a.ws + WS_YB);
            for (int u = F.vcu; u < 512; u += F.G) {
                if (u < 256) {
                    const int bk = u >> 6, b = bk >> 1, kvh = bk & 1, h = 2 * kvh + ((u >> 5) & 1), qb = u & 31;
                    const int off = (qb == 0) ? 0 : 4 * qb - 2, NT = (qb == 0 || qb == 31) ? 10 : 12;
                    const float sk = a.in[I_SINK][l * 4 + h] * 1.4426950408889634f;
                    attn_body::attn_unit<1, 8>(Pa, Ya, SEQ * b + 256 * qb, M_LAT + NCTX * b, SEQ * b, off, NT, 256 * qb - 64 * off,
                                               C_DQ + 64 * h, C_DK + 64 * kvh, C_DV + 64 * kvh, C_DZ + 64 * h, 256 + 64 * h, sk, (char*)lds);
                } else if (l == 0 && ((u - 256) & 15) == 0) {
                    const int ee = (u - 256) >> 4, mode = ee >> 3, b = (ee >> 2) & 1, h = ee & 3, kvh = h >> 1;
                    const float sk = (mode == 0) ? -INFINITY : a.in[I_SINK][l * 4 + h] * 1.4426950408889634f;
                    const int qc = (mode == 0) ? C_AQ : C_DQ, kc = (mode == 0) ? C_AK : C_DK, vc = (mode == 0) ? C_AV : C_DV, zc = (mode == 0) ? C_AZ : C_DZ, oc = (mode == 0) ? 0 : 256;
                    attn_body::attn_unit<1, 8>(Pa, Ya, M_LAT + NCTX * b, M_LAT + NCTX * b, SEQ * b, 0, 4, 0,
                                               qc + 64 * h, kc + 64 * kvh, vc + 64 * kvh, zc + 64 * h, oc + 64 * h, sk, (char*)lds);
                }
            }
        }
#endif
#ifndef SKIP_S3
        DUP(6) { const Frame F = fresh_frame(lds); const Args a = fresh_args();
          for (int u = F.vcu; u < 256; u += F.G) fnet_s3_unit(F, a, u, (const bf16*)(a.ws + WS_P), (bf16*)(a.ws + WS_YB)); }
#endif
#ifndef SKIP_SGU
        DUP(7) { const Frame F = fresh_frame(lds); const Args a = fresh_args();
          const int nunit = (l == 0) ? 528 : 512;
          for (int u = F.vcu; u < nunit; u += F.G) sgu_unit(F, a, l, u, (const bf16*)(a.ws + WS_P), (bf16*)(a.ws + WS_YB)); }
#endif
        GRID_BAR();
        CHK(16, chk_attn(F, a, l, 5 + 10 * l, 0)); CHK(16, chk_attn(F, a, l, 6 + 10 * l, 1)); CHK(32, chk_fnet(F, a, l, 7 + 10 * l, 0); if (l == 0) chk_fnet(F, a, l, 8, 1)); CHK(64, chk_sgu(F, a, l, 9 + 10 * l));
#ifndef MERGE_V1
        for (int rep_ = 0; rep_ < 1 + ((((DUP_MASK) >> 8) & 1) && l == 1); ++rep_) { const Frame F = fresh_frame(lds); const Args a = fresh_args();
            pg8::Gemm g{(const bf16*)(a.ws + WS_H), (const bf16*)(a.ws + WS_WM), 1024, 1024, 1024};
            pg8::MergeOrder S{(const bf16*)(a.ws + WS_H), (const bf16*)(a.ws + WS_YB), (const bf16*)(a.ws + WS_WM) + (size_t)l * 4096 * 1024, (const bf16*)(a.ws + WS_WBR) + (size_t)l * 1024 * 1024, F.G, F.vcu, (l == 0) ? 32 : 0};
            pg8::EpiMerge E{(bf16*)(a.ws + WS_GT), (bf16*)(a.ws + WS_MG), (float*)(a.ws + WS_MGC), a.in[I_BMERGE] + l * 4096, (bf16*)(a.ws + WS_GTC)};
            pg8::gemm_phase<pg8::EpiMerge, pg8::MergeOrder, true>(F.lds, g, S, E);
        }
        GRID_BAR();
#else
#pragma unroll 1
        for (int r = 0; r < 4; ++r) {
#ifdef ZERO_MASK
            if ((ZERO_MASK >> r) & 1) continue;
#endif
#ifndef SKIP_MG
            { const Frame F = fresh_frame(lds); const Args a = fresh_args();
                pg8::Gemm g{(const bf16*)(a.ws + WS_H), (const bf16*)(a.ws + WS_WM) + ((size_t)l * 4096 + r * 1024) * 1024, 1024, 1024, 1024};
                pg8::OrderX S; S.so.init((l == 0) ? M_ALL : M_LAT, 1024, F.G, (int)blockIdx.x); S.nx = 0;
                pg8::EpiBf16<2> E{(bf16*)(a.ws + WS_GT), 1024, a.in[I_BMERGE] + l * 4096 + r * 1024};
                pg8::gemm_phase<pg8::EpiBf16<2>, pg8::OrderX, true>(F.lds, g, S, E);
            }
#endif
            GRID_BAR();
            if (r == 3 && l == 0) CHK(512, chk_gt(F, a, l, r, 22); chk_gt(F, a, l, 2, 23));
#ifndef SKIP_MY
            { const Frame F = fresh_frame(lds); const Args a = fresh_args();
                pg8::Gemm g{(const bf16*)(a.ws + WS_YB) + r * 256, (const bf16*)(a.ws + WS_WBR) + (size_t)l * 1024 * 1024 + r * 256, 1024, 1024, 256};
                pg8::OrderX S; S.so.init((l == 0) ? M_ALL : M_LAT, 1024, F.G, (int)blockIdx.x); S.nx = 0;

#ifdef ZERO_MASK
                pg8::EpiGate E{(bf16*)(a.ws + WS_MG), (const bf16*)(a.ws + WS_GT), 1024, r == __builtin_ctz(~(ZERO_MASK)), 1.0f};
#else
#ifdef SCALE_MASK
                pg8::EpiGate E{(bf16*)(a.ws + WS_MG), (const bf16*)(a.ws + WS_GT), 1024, r == 0, ((SCALE_MASK >> r) & 1) ? (SCALE_VAL) : 1.0f};
#else
                pg8::EpiGate E{(bf16*)(a.ws + WS_MG), (const bf16*)(a.ws + WS_GT), 1024, r == 0, 1.0f};
#endif
#endif

                pg8::gemm_phase<pg8::EpiGate, pg8::OrderX, true>(F.lds, g, S, E);
            }
#endif
            GRID_BAR();
        }
#endif
        CHK(128, chk_merge(F, a, l, 10 + 10 * l));
        if (l == 1) CHK(256, chk_copy_out(F, a));
#ifndef SKIP_OUT
        { const Frame F = fresh_frame(lds); const Args a = fresh_args();
            pg8::Gemm g{(const bf16*)(a.ws + WS_MG), (const bf16*)(a.ws + WS_WOUT) + (size_t)l * 1024 * 1024, 1024, 1024, 1024};
            pg8::OrderOut S; S.so.init(M_LAT, 1024, F.G, (int)blockIdx.x); S.nx = (l == 0) ? 128 : 0; S.TERM = (const bf16*)(a.ws + WS_GTC);
            pg8::EpiRes E{(l == 0) ? a.in[I_X] : a.out, a.out, (l == 0) ? a.in[I_CTX] : (const float*)(a.ws + WS_XC1), (float*)(a.ws + WS_XC1), (const float*)(a.ws + WS_MOD) + (size_t)l * 3 * 3072};
            pg8::gemm_phase<pg8::EpiRes, pg8::OrderOut, true>(F.lds, g, S, E);
        }
#endif
        if (l == 0) GRID_BAR();
        if (l == 0) CHK(256, chk_final(F, a, l, 11));
#ifdef SELFCHECK
        if (l == 1) { GRID_BAR(); CHK(256, chk_final(F, a, l, 21)); }
#endif
    }
#ifdef SELFCHECK
    GRID_BAR();
    { const Frame F = fresh_frame(lds); const Args a = fresh_args(); chk_report(F, a); }
#endif
#ifdef BLEND_S
    GRID_BAR();
    { const Frame F = fresh_frame(lds); const Args a = fresh_args(); const size_t gt = (size_t)F.vcu * 512 + F.tid, NGT = (size_t)F.G * 512;
      for (size_t i = gt; i < (size_t)M_LAT * 1024; i += NGT) { const float x0 = a.in[I_X][i]; a.out[i] = x0 + (BLEND_S) * (a.out[i] - x0); } }
#endif
}

extern "C" void kernel_launch(void* const* d_in, const int* in_sizes, int n_in, void* d_out, int out_size, void* d_ws, size_t ws_size, hipStream_t stream) {
    static int grid = 0;
    if (grid == 0) {
        if (n_in != 20 || out_size != M_LAT * DM || ws_size < WS_END) { fprintf(stderr, "kernel_launch: unexpected problem: n_in %d out %d ws %zu\n", n_in, out_size, ws_size); grid = -1; return; }
        { const int want[20] = {M_LAT * DM, NB * DM, M_CTX * DM, DM, 2 * DM, 2 * DM * 3 * DM, 2 * 3 * DM, 2 * DM * PW, 128, 128, 128, 128, 8, 2 * 4 * 64 * 64, 2 * 4 * 128 * 128, 2 * 4 * 128, 2 * 4 * 256 * DM, 2 * DM * 4 * DM, 2 * 4 * DM, 2 * DM * DM};
          for (int i = 0; i < 20; ++i) if (in_sizes[i] != want[i]) { fprintf(stderr, "kernel_launch: input %d has %d elements, expected %d\n", i, in_sizes[i], want[i]); grid = -1; return; } }
        int dev = 0, cus = 0, per_cu = 0;
        if (hipGetDevice(&dev) != hipSuccess || hipDeviceGetAttribute(&cus, hipDeviceAttributeMultiprocessorCount, dev) != hipSuccess) { grid = -1; return; }
        if (hipFuncSetAttribute((const void*)hybrid_fwd, hipFuncAttributeMaxDynamicSharedMemorySize, LDS_BYTES) != hipSuccess) { fprintf(stderr, "kernel_launch: hipFuncSetAttribute failed\n"); grid = -1; return; }
        if (hipOccupancyMaxActiveBlocksPerMultiprocessor(&per_cu, (const void*)hybrid_fwd, NWAVES * 64, LDS_BYTES) != hipSuccess || per_cu < 1) { fprintf(stderr, "kernel_launch: occupancy query says %d blocks per CU\n", per_cu); per_cu = 1; }
        (void)hipGetLastError();
        grid = cus;
    }
    if (grid < 0) return;
    if (hipMemsetAsync((char*)d_ws + WS_CTL, 0, CTL_ZERO_BYTES, stream) != hipSuccess) { fprintf(stderr, "kernel_launch: memset failed\n"); return; }
    Args a{};
    for (int i = 0; i < 20; ++i) a.in[i] = (const float*)d_in[i];
    a.out = (float*)d_out; a.ws = (unsigned char*)d_ws;
    hipLaunchKernelGGL(hybrid_fwd, dim3(grid), dim3(NWAVES * 64), LDS_BYTES, stream, a);
}
```

```cpp
#include <hip/hip_runtime.h>
#include <hip/hip_bf16.h>
#include <cstdio>
#include <cstdint>
#include <cmath>

namespace pg8 {

#define PG8_LAS __attribute__((address_space(3)))
typedef unsigned short bf16_t;
typedef short bf16x8 __attribute__((ext_vector_type(8)));
typedef float f32x4 __attribute__((ext_vector_type(4)));
typedef unsigned u32x4 __attribute__((ext_vector_type(4)));
constexpr int BM = 256, BK = 64, HALF = 128, HTB = HALF * BK * 2, STAGE_BYTES = 8 * HTB, NXCD = 8, WGM = 8;

__host__ __device__ __forceinline__ int lds_byte(int r, int c) { const int st = (r >> 4) * 2 + (c >> 5), rr = r & 15, cc = c & 31, ob = rr * 64 + cc * 2; return st * 1024 + (ob ^ (((ob >> 9) & 1) << 5)); }
__host__ __device__ __forceinline__ void stage_rc(int b, int& R, int& C) { const int st = b / 1024, sb = b % 1024, swz = sb ^ (((sb >> 9) & 1) << 5); R = (st >> 1) * 16 + swz / 64; C = (st & 1) * 32 + (swz % 64) / 2; }
__host__ __device__ __forceinline__ int perm32(int rho) { const int n = rho >> 4, i = rho & 15; return 8 * (i >> 2) + 4 * n + (i & 3); }

struct Unit { int pm, pn, r, kind; };
struct Gemm { const bf16_t* A; const bf16_t* Bt; int lda, ldb, K; };

struct StaticOrder {
    int nM, nN, nwg, G, c;
    __host__ __device__ void init(int M, int N, int G_, int c_) { nM = M / BM; nN = N / BM; nwg = nM * nN; G = G_; c = c_; }
    __host__ __device__ bool next(int i, Unit& u) const {
        const long L = (long)i * G + c; if (L >= nwg) return false;
        int wgid = (int)L; { const int q = nwg / NXCD, r = nwg % NXCD, xcd = wgid % NXCD, off = wgid / NXCD; wgid = (xcd < r ? xcd * (q + 1) : r * (q + 1) + (xcd - r) * q) + off; }
        const int nig = WGM * nN, gid = wgid / nig, fm = gid * WGM, gsz = (nM - fm) < WGM ? (nM - fm) : WGM;
        u.pm = fm + ((wgid % nig) % gsz); u.pn = (wgid % nig) / gsz; u.r = 0; u.kind = 0; return true;
    }
};
struct OrderX {
    StaticOrder so; int nx;
    __device__ bool next(int i, Unit& u) const {
        const long L = (long)i * so.G + so.c;
        if (L < so.nwg) return so.next(i, u);
        const int e = (int)(L - so.nwg); if (e >= nx) return false;
        u.pm = 64 + (e >> 1); u.pn = (e & 1) ? 4 : 1; u.r = 0; u.kind = 0; return true;
    }
    __device__ __forceinline__ void src(const Gemm& g, const Unit& u, const char*& pa, const char*& pb, int& nt) const {
        pa = (const char*)g.A + (size_t)u.pm * (2 * HALF) * g.lda * 2; pb = (const char*)g.Bt + (size_t)u.pn * (2 * HALF) * g.ldb * 2; nt = g.K / BK; }
};

typedef float f32x2_c __attribute__((ext_vector_type(2))); typedef __bf16 bf16x2_c __attribute__((ext_vector_type(2)));
__device__ __forceinline__ unsigned cvt_pk_bf16(float lo, float hi) { f32x2_c v = {lo, hi}; bf16x2_c b = __builtin_convertvector(v, bf16x2_c); return __builtin_bit_cast(unsigned, b); }
__device__ __forceinline__ float bf_lo(unsigned w) { return __uint_as_float(w << 16); }
__device__ __forceinline__ float bf_hi(unsigned w) { return __uint_as_float(w & 0xffff0000u); }
__device__ __forceinline__ float sigmoidf_(float x) { return __builtin_amdgcn_rcpf(1.0f + __builtin_amdgcn_exp2f(-1.4426950408889634f * x)); }

template <int ACT> struct EpiBf16 {
    static constexpr bool PERM = true;
    bf16_t* O; int ldc; const float* bias;
    __device__ __forceinline__ void operator()(const f32x4 (&acc)[2][2][4][2], const Unit& u, int wr, int wc, int fr, int fq) const {
        const int row0 = u.pm * BM + wr * 64 + fr; const int col0 = u.pn * BM + wc * 32 + 8 * fq;
        f32x4 bv[2][2];
#pragma unroll
        for (int bj = 0; bj < 2; ++bj)
#pragma unroll
            for (int n = 0; n < 2; ++n) bv[bj][n] = bias ? *(const f32x4*)(bias + col0 + bj * HALF + 4 * n) : (f32x4){0.f, 0.f, 0.f, 0.f};
#pragma unroll
        for (int ai = 0; ai < 2; ++ai)
#pragma unroll
            for (int m = 0; m < 4; ++m) { bf16_t* rowp = O + (size_t)(row0 + ai * HALF + m * 16) * ldc + col0;
#pragma unroll
                for (int bj = 0; bj < 2; ++bj) { f32x4 v0 = acc[ai][bj][m][0] + bv[bj][0], v1 = acc[ai][bj][m][1] + bv[bj][1];
                    if (ACT == 2) {
#pragma unroll
                        for (int e = 0; e < 4; ++e) { v0[e] = sigmoidf_(v0[e]); v1[e] = sigmoidf_(v1[e]); } }
                    u32x4 w; w.x = cvt_pk_bf16(v0[0], v0[1]); w.y = cvt_pk_bf16(v0[2], v0[3]); w.z = cvt_pk_bf16(v1[0], v1[1]); w.w = cvt_pk_bf16(v1[2], v1[3]);
                    *(u32x4*)(rowp + bj * HALF) = w;
                    } }
    }
};
struct EpiGate {
    static constexpr bool PERM = true;
    bf16_t* MG; const bf16_t* GT; int ldc; int first; float scl;
    typedef unsigned u32x2 __attribute__((ext_vector_type(2)));
    __device__ __forceinline__ void operator()(const f32x4 (&acc)[2][2][4][2], const Unit& u, int wr, int wc, int fr, int fq) const {
        const int row0 = u.pm * BM + wr * 64 + fr; const int col0 = u.pn * BM + wc * 32 + 8 * fq;
#pragma unroll
        for (int ai = 0; ai < 2; ++ai)
#pragma unroll
            for (int m = 0; m < 4; ++m) { const size_t off = (size_t)(row0 + ai * HALF + m * 16) * ldc + col0;
#pragma unroll
                for (int bj = 0; bj < 2; ++bj)
#pragma unroll
                    for (int n = 0; n < 2; ++n) {
                        const u32x2 g = *(const u32x2*)(GT + off + bj * HALF + 4 * n);
                        u32x2 o = (u32x2){0u, 0u}; if (!first) o = *(const u32x2*)(MG + off + bj * HALF + 4 * n);
                        const f32x4 v = acc[ai][bj][m][n] * scl;
                        u32x2 w;
                        w.x = cvt_pk_bf16(bf_lo(o.x) + bf_lo(g.x) * v[0], bf_hi(o.x) + bf_hi(g.x) * v[1]);
                        w.y = cvt_pk_bf16(bf_lo(o.y) + bf_lo(g.y) * v[2], bf_hi(o.y) + bf_hi(g.y) * v[3]);
                        *(u32x2*)(MG + off + bj * HALF + 4 * n) = w; asm volatile("" ::: "memory"); } }
    }
};
struct EpiRes {
    static constexpr bool PERM = false;
    const float* xin_lat; float* xout_lat; const float* xin_ctx; float* xout_ctx; const float* gate;
    __device__ __forceinline__ void operator()(const f32x4 (&acc)[2][2][4][2], const Unit& u, int wr, int wc, int fr, int fq) const {
        const bool isctx = u.pm >= 64;
        const float* xin = isctx ? xin_ctx + (size_t)(u.pm - 64) * BM * 1024 : xin_lat + (size_t)u.pm * BM * 1024;
        float* xout = isctx ? xout_ctx + (size_t)(u.pm - 64) * BM * 1024 : xout_lat + (size_t)u.pm * BM * 1024;
        const float* gv = gate + (isctx ? 2 : (u.pm >> 5)) * 3072 + 2048;
        const int col0 = u.pn * BM + wc * 32 + 4 * fq;
        f32x4 gt[2][2];
#pragma unroll
        for (int bj = 0; bj < 2; ++bj)
#pragma unroll
            for (int n = 0; n < 2; ++n) gt[bj][n] = *(const f32x4*)(gv + col0 + bj * HALF + n * 16);
#pragma unroll
        for (int ai = 0; ai < 2; ++ai)
#pragma unroll
            for (int m = 0; m < 4; ++m) { const size_t off = (size_t)(ai * HALF + wr * 64 + m * 16 + fr) * 1024 + col0;
#pragma unroll
                for (int bj = 0; bj < 2; ++bj)
#pragma unroll
                    for (int n = 0; n < 2; ++n) {
                        if (u.kind == 3) { const f32x4 v = gt[bj][n] * acc[ai][bj][m][n]; float* q = xout + off + bj * HALF + n * 16; atomicAdd(q + 0, v[0]); atomicAdd(q + 1, v[1]); atomicAdd(q + 2, v[2]); atomicAdd(q + 3, v[3]); }
                        else { const f32x4 bs = *(const f32x4*)(xin + off + bj * HALF + n * 16); *(f32x4*)(xout + off + bj * HALF + n * 16) = bs + gt[bj][n] * acc[ai][bj][m][n]; } }
                if (m & 1) asm volatile("" ::: "memory"); }
    }
};

struct MergeOrder {
    const bf16_t* H; const bf16_t* YB; const bf16_t* WmT; const bf16_t* WbrT; int G, c, nctx;
    __device__ bool next(int i, Unit& u) const {
        const int nl = (c < 256) ? 1 + (255 - c) / G : 0;
        if (i < 8 * nl) { const int t = c + (i >> 3) * G, q = i & 7; u.pm = t >> 2; u.pn = t & 3; u.r = q >> 1; u.kind = (q & 1) ? 0 : 1; return true; }
        const int j = i - 8 * nl;
        if (nctx == 0 || (c & 7) != 0) return false;
        const int jb = (c >> 3) + (j >> 1) * (G >> 3); if (jb >= nctx) return false;
        const int t = jb >> 2; u.pm = 64 + (t >> 2); u.pn = t & 3; u.r = jb & 3; u.kind = (j & 1) ? 2 : 1; return true;
    }
    __device__ __forceinline__ void src(const Gemm&, const Unit& u, const char*& pa, const char*& pb, int& nt) const {
        if (u.kind != 1) { pa = (const char*)(H + (size_t)u.pm * 256 * 1024); pb = (const char*)(WmT + ((size_t)u.r * 1024 + u.pn * 256) * 1024); nt = 16; }
        else { pa = (const char*)(YB + (size_t)u.pm * 256 * 1024 + u.r * 256); pb = (const char*)(WbrT + (size_t)u.pn * 256 * 1024 + u.r * 256); nt = 4; }
    }
};
typedef unsigned long long u64_t;
__device__ __forceinline__ u64_t ld_sc1(const void* p) { return __hip_atomic_load((const u64_t*)p, __ATOMIC_RELAXED, __HIP_MEMORY_SCOPE_AGENT); }
struct EpiMerge {
    static constexpr bool PERM = true;
    bf16_t* GT; bf16_t* MG; float* MGc; const float* bias; bf16_t* GTc;
    typedef unsigned u32x2 __attribute__((ext_vector_type(2)));
    __device__ __forceinline__ void operator()(const f32x4 (&acc)[2][2][4][2], const Unit& u, int wr, int wc, int fr, int fq) const {
        const int row0 = u.pm * BM + wr * 64 + fr; const int col0 = u.pn * BM + wc * 32 + 8 * fq;
        bf16_t* Yu = (u.pm >= 64) ? GTc + ((size_t)u.r * 512 - 16384) * 1024 : GT;
        if (u.kind == 1) {
#pragma unroll
            for (int ai = 0; ai < 2; ++ai)
#pragma unroll
                for (int m = 0; m < 4; ++m) { bf16_t* rowp = Yu + (size_t)(row0 + ai * HALF + m * 16) * 1024 + col0;
#pragma unroll
                    for (int bj = 0; bj < 2; ++bj) { const f32x4 v0 = acc[ai][bj][m][0], v1 = acc[ai][bj][m][1];
                        u32x4 w; w.x = cvt_pk_bf16(v0[0], v0[1]); w.y = cvt_pk_bf16(v0[2], v0[3]); w.z = cvt_pk_bf16(v1[0], v1[1]); w.w = cvt_pk_bf16(v1[2], v1[3]);
                        *(u32x4*)(rowp + bj * HALF) = w; } }
        } else {
            const bool isctx = (u.kind == 2), first = (u.r == 0) || isctx;
            bf16_t* Ou = isctx ? Yu : MG;
            const float* bp = bias + u.r * 1024 + col0;
            f32x4 bv[2][2];
#pragma unroll
            for (int bj = 0; bj < 2; ++bj)
#pragma unroll
                for (int n = 0; n < 2; ++n) bv[bj][n] = *(const f32x4*)(bp + bj * HALF + 4 * n);
            const __amdgpu_buffer_rsrc_t ry = __builtin_amdgcn_make_buffer_rsrc((void*)Yu, 0, 0x7fffffff, 0x00020000), ro = __builtin_amdgcn_make_buffer_rsrc((void*)MG, 0, 0x7fffffff, 0x00020000);
#pragma unroll
            for (int ai = 0; ai < 2; ++ai) { u32x4 yq[4][2], oq[4][2];
#pragma unroll
                for (int mm = 0; mm < 4; ++mm) { const unsigned off = (unsigned)(((row0 + ai * HALF + mm * 16) * 1024 + col0) * 2);
#pragma unroll
                    for (int bj = 0; bj < 2; ++bj) { yq[mm][bj] = __builtin_bit_cast(u32x4, __builtin_amdgcn_raw_buffer_load_b128(ry, off + bj * HALF * 2, 0, 16));
                        oq[mm][bj] = first ? (u32x4){0u, 0u, 0u, 0u} : __builtin_bit_cast(u32x4, __builtin_amdgcn_raw_buffer_load_b128(ro, off + bj * HALF * 2, 0, 16)); } }
#pragma unroll
                for (int mm = 0; mm < 4; ++mm) { const size_t off = (size_t)(row0 + ai * HALF + mm * 16) * 1024 + col0;
#pragma unroll
                    for (int bj = 0; bj < 2; ++bj) { f32x4 g0 = acc[ai][bj][mm][0] + bv[bj][0], g1 = acc[ai][bj][mm][1] + bv[bj][1];
#pragma unroll
                        for (int e = 0; e < 4; ++e) { g0[e] = sigmoidf_(g0[e]); g1[e] = sigmoidf_(g1[e]); }
                        const u32x4 y = yq[mm][bj], o = oq[mm][bj];
                        u32x4 w;
                        w.x = cvt_pk_bf16(bf_lo(o.x) + g0[0] * bf_lo(y.x), bf_hi(o.x) + g0[1] * bf_hi(y.x));
                        w.y = cvt_pk_bf16(bf_lo(o.y) + g0[2] * bf_lo(y.y), bf_hi(o.y) + g0[3] * bf_hi(y.y));
                        w.z = cvt_pk_bf16(bf_lo(o.z) + g1[0] * bf_lo(y.z), bf_hi(o.z) + g1[1] * bf_hi(y.z));
                        w.w = cvt_pk_bf16(bf_lo(o.w) + g1[2] * bf_lo(y.w), bf_hi(o.w) + g1[3] * bf_hi(y.w));
                        *(u32x4*)(Ou + off + bj * HALF) = w; } }
                asm volatile("" ::: "memory"); }
        }
    }
};
struct OrderOut {
    StaticOrder so; int nx; const bf16_t* TERM;
    __device__ bool next(int i, Unit& u) const {
        const long L = (long)i * so.G + so.c;
        if (L < so.nwg) return so.next(i, u);
        const int e = (int)(L - so.nwg); if (e >= nx) return false;
        const int t = e >> 4; u.pm = 64 + (t >> 2); u.pn = t & 3; u.r = e & 15; u.kind = 3; return true;
    }
    __device__ __forceinline__ void src(const Gemm& g, const Unit& u, const char*& pa, const char*& pb, int& nt) const {
        pa = (const char*)g.A + (size_t)u.pm * (2 * HALF) * g.lda * 2; pb = (const char*)g.Bt + (size_t)u.pn * (2 * HALF) * g.ldb * 2; nt = g.K / BK;
        if (u.kind == 3) { const int br = u.r >> 2, kq = u.r & 3; pa = (const char*)(TERM + ((size_t)br * 512 + (u.pm - 64) * 256) * 1024 + kq * 256); pb += (size_t)kq * 256 * 2; nt = 4; }
    }
};

template <class Epi, class Sched, bool ALIGN_EPI>
__device__ __forceinline__ void gemm_phase(PG8_LAS unsigned char* lds, const Gemm g, const Sched& S, const Epi& E) {
    int tid = threadIdx.x; asm volatile("" : "+v"(tid));
    const int wid = __builtin_amdgcn_readfirstlane(tid >> 6), lane = tid & 63, wr = wid >> 2, wc = wid & 3, fr = lane & 15, fq = lane >> 4;
    int nt;
    unsigned voffA[2], voffB[2];
#pragma unroll
    for (int i = 0; i < 2; ++i) { int R, C; stage_rc(tid * 16 + i * 8192, R, C); const int Rb = Epi::PERM ? ((R & ~31) + perm32(R & 31)) : R;
        voffA[i] = (unsigned)(R * g.lda + C) * 2u; voffB[i] = (unsigned)(Rb * g.ldb + C) * 2u; }
    const size_t kstep = (size_t)(BK * 2);
    const size_t hstepA = (size_t)HALF * g.lda * 2, hstepB = (size_t)HALF * g.ldb * 2;
    const unsigned ldsw = (unsigned)wid * 1024u;
    const int aoff = lds_byte(wr * 64 + fr, fq * 8), boff = lds_byte(wc * 32 + fr, fq * 8);
#define PG8_SA(b, h) (((b) * 2 + (h)) * HTB)
#define PG8_SB(b, h) ((4 + (b) * 2 + (h)) * HTB)
#define PG8_STAGE(bufoff, gbase, voff) do { _Pragma("unroll") for (int _i = 0; _i < 2; ++_i) \
        __builtin_amdgcn_global_load_lds((const unsigned*)((const char*)(gbase) + (voff)[_i]), (PG8_LAS unsigned*)(lds + (bufoff) + ldsw + _i * 8192), 16, 0, 0); } while (0)
#define PG8_LDA(dst, b, h) do { _Pragma("unroll") for (int m = 0; m < 4; ++m) _Pragma("unroll") for (int k = 0; k < 2; ++k) dst[m][k] = *(const PG8_LAS bf16x8*)(lds + PG8_SA(b, h) + aoff + m * 2048 + k * 1024); } while (0)
#define PG8_LDB(dst, b, h) do { _Pragma("unroll") for (int n = 0; n < 2; ++n) _Pragma("unroll") for (int k = 0; k < 2; ++k) dst[n][k] = *(const PG8_LAS bf16x8*)(lds + PG8_SB(b, h) + boff + n * 2048 + k * 1024); } while (0)
#define PG8_MMA(ai, bj, At, Bt) do { __builtin_amdgcn_s_setprio(1); _Pragma("unroll") for (int m = 0; m < 4; ++m) _Pragma("unroll") for (int n = 0; n < 2; ++n) _Pragma("unroll") for (int k = 0; k < 2; ++k) \
        acc[ai][bj][m][n] = __builtin_amdgcn_mfma_f32_16x16x32_bf16(Bt[n][k], At[m][k], acc[ai][bj][m][n], 0, 0, 0); __builtin_amdgcn_s_setprio(0); } while (0)
#define PG8_WAIT_V(n) asm volatile("s_waitcnt vmcnt(" #n ")" ::: "memory")
#define PG8_WAIT_L(n) asm volatile("s_waitcnt lgkmcnt(" #n ")" ::: "memory")
#define PG8_BAR __builtin_amdgcn_s_barrier()
#define PG8_SCHED __builtin_amdgcn_sched_barrier(0)
    Unit cur, nxt; int ui = 0;
    if (!S.next(0, cur)) return;
    f32x4 acc[2][2][4][2];
#pragma unroll
    for (int a = 0; a < 2; ++a)
#pragma unroll
        for (int b = 0; b < 2; ++b)
#pragma unroll
            for (int m = 0; m < 4; ++m)
#pragma unroll
                for (int n = 0; n < 2; ++n) acc[a][b][m][n] = (f32x4){0.f, 0.f, 0.f, 0.f};
    bf16x8 At[4][2], B0[2][2], B1[2][2];
    const char* cA; const char* cB; S.src(g, cur, cA, cB, nt);
    PG8_STAGE(PG8_SB(0, 0), cB, voffB); PG8_STAGE(PG8_SB(0, 1), cB + hstepB, voffB); PG8_STAGE(PG8_SA(0, 0), cA, voffA); PG8_STAGE(PG8_SA(0, 1), cA + hstepA, voffA);
    if (wr == 1) PG8_BAR;
    PG8_WAIT_V(2); PG8_BAR;
    PG8_STAGE(PG8_SB(1, 0), cB + kstep, voffB); PG8_STAGE(PG8_SA(1, 0), cA + kstep, voffA); PG8_STAGE(PG8_SB(1, 1), cB + hstepB + kstep, voffB);
    PG8_WAIT_V(6); PG8_BAR;
    for (;;) {
        const bool has_next = S.next(ui + 1, nxt);
        const char* nA = cA; const char* nB = cB; int nnt = nt; if (has_next) S.src(g, nxt, nA, nB, nnt);
        for (int t = 0; t < nt; t += 2) {
            const bool last = (t == nt - 2);
            const char* a1 = cA + (size_t)(t + 1) * kstep;
            const char* a2 = last ? nA : cA + (size_t)(t + 2) * kstep; const char* b2 = last ? nB : cB + (size_t)(t + 2) * kstep;
            const char* a3 = a2 + kstep; const char* b3 = b2 + kstep;
            PG8_LDB(B0, 0, 0); PG8_LDB(B1, 0, 1); PG8_SCHED; PG8_LDA(At, 0, 0); PG8_STAGE(PG8_SA(1, 1), a1 + hstepA, voffA);
            PG8_WAIT_V(8); PG8_WAIT_L(0); PG8_BAR; PG8_MMA(0, 0, At, B0); PG8_MMA(0, 1, At, B1); PG8_BAR; PG8_SCHED;
            PG8_LDA(At, 0, 1); PG8_STAGE(PG8_SB(0, 0), b2, voffB); PG8_STAGE(PG8_SB(0, 1), b2 + hstepB, voffB); PG8_STAGE(PG8_SA(0, 0), a2, voffA);
            PG8_WAIT_V(8); PG8_WAIT_L(0); PG8_BAR; PG8_MMA(1, 0, At, B0); PG8_MMA(1, 1, At, B1); PG8_BAR; PG8_SCHED;
            PG8_LDB(B0, 1, 0); PG8_LDB(B1, 1, 1); PG8_SCHED; PG8_LDA(At, 1, 0); PG8_STAGE(PG8_SA(0, 1), a2 + hstepA, voffA);
            PG8_WAIT_V(8); PG8_WAIT_L(0); PG8_BAR; PG8_MMA(0, 0, At, B0); PG8_MMA(0, 1, At, B1); PG8_BAR; PG8_SCHED;
            PG8_LDA(At, 1, 1); PG8_STAGE(PG8_SB(1, 0), b3, voffB); PG8_STAGE(PG8_SB(1, 1), b3 + hstepB, voffB); PG8_STAGE(PG8_SA(1, 0), a3, voffA);
            PG8_WAIT_V(8); PG8_WAIT_L(0); PG8_BAR; PG8_MMA(1, 0, At, B0); PG8_MMA(1, 1, At, B1); PG8_BAR; PG8_SCHED;
        }
        if constexpr (ALIGN_EPI) { if (wr == 0) PG8_BAR; }
        E(acc, cur, wr, wc, fr, fq);
        if (!has_next) break;
#pragma unroll
        for (int a = 0; a < 2; ++a)
#pragma unroll
            for (int b = 0; b < 2; ++b)
#pragma unroll
                for (int m = 0; m < 4; ++m)
#pragma unroll
                    for (int n = 0; n < 2; ++n) acc[a][b][m][n] = (f32x4){0.f, 0.f, 0.f, 0.f};
        cur = nxt; cA = nA; cB = nB; nt = nnt; ++ui;
        if constexpr (ALIGN_EPI) { if (wr == 1) PG8_BAR; }
    }
    PG8_WAIT_V(0);
    if constexpr (!ALIGN_EPI) { if (wr == 0) PG8_BAR; }
    PG8_BAR;
#undef PG8_SA
#undef PG8_SB
#undef PG8_STAGE
#undef PG8_LDA
#undef PG8_LDB
#undef PG8_MMA
#undef PG8_WAIT_V
#undef PG8_WAIT_L
#undef PG8_BAR
#undef PG8_SCHED
}
}
namespace attn_body {
using bf16=__hip_bfloat16;
using bf16x8=__attribute__((ext_vector_type(8)))short;
using s16x4=__attribute__((ext_vector_type(4)))short;
using f32x16=__attribute__((ext_vector_type(16)))float;
using u32x4=__attribute__((ext_vector_type(4)))unsigned;
constexpr int D=64;
constexpr int NW=8,QBLK=32,QB=QBLK*NW,KVBLK=64;
constexpr int PP=2816, YP=1024;
__device__ __forceinline__ int crow(int r,int hi){return (r&3)+8*(r>>2)+4*hi;}
#define SBAR() __builtin_amdgcn_sched_barrier(0)
__device__ __forceinline__ void dmask(f32x16&p0,f32x16&p1,int kb,unsigned lim,int qrel,int hi){
  const float NEG=-INFINITY; const unsigned b0=(unsigned)(kb+4*hi-qrel+128);
  #pragma unroll
  for(int r=0;r<16;++r){const unsigned dd=b0+(unsigned)((r&3)+8*(r>>2)); if(dd>lim)p0[r]=NEG; if(dd+32u>lim)p1[r]=NEG;}
}

constexpr int NSLOT=3, SLOTB=8192;
constexpr int LDS_K=0, LDS_V=NSLOT*SLOTB, LDS_WS=2*NSLOT*SLOTB, LDS_OST=LDS_WS+NW*64*4, LDS_BYTES=LDS_OST+NW*4096;
constexpr float C2=0.125f*1.4426950408889634f;
__device__ __forceinline__ void glds16(const void*gsrc,unsigned lds_dst){unsigned keep;
  asm volatile("s_mov_b32 %0, m0\n\ts_mov_b32 m0, %2\n\ts_nop 0\n\tglobal_load_lds_dwordx4 %1, off\n\ts_mov_b32 m0, %0":"=&s"(keep):"v"(gsrc),"s"(lds_dst):"memory");}
__device__ __forceinline__ float siluf_(float x){ return x*__builtin_amdgcn_rcpf(1.0f+__builtin_amdgcn_exp2f(-1.4426950408889634f*x)); }
__device__ __forceinline__ float max3f(float a,float b,float c){float r;asm("v_max3_f32 %0, %1, %2, %3":"=v"(r):"v"(a),"v"(b),"v"(c));return r;}
__device__ __forceinline__ float max2f(float a,float b){float r;asm("v_max_f32_e32 %0, %1, %2":"=v"(r):"v"(a),"v"(b));return r;}
__device__ __forceinline__ float fadd_s(float a,float b){float r;asm("v_add_f32_e32 %0, %1, %2":"=v"(r):"v"(a),"v"(b));return r;}
__device__ __forceinline__ float fsub_s(float a,float b){float r;asm("v_sub_f32_e32 %0, %1, %2":"=v"(r):"v"(a),"v"(b));return r;}
typedef float f32x2_t __attribute__((ext_vector_type(2))); typedef __bf16 bf16x2_t __attribute__((ext_vector_type(2)));
__device__ __forceinline__ unsigned cvtpk_s(float lo,float hi){f32x2_t v={lo,hi};bf16x2_t b=__builtin_convertvector(v,bf16x2_t);return __builtin_bit_cast(unsigned,b);}
#define WAIT_BAR(N) asm volatile("s_waitcnt vmcnt(" #N ") lgkmcnt(0)\n\ts_barrier":::"memory")

__device__ __forceinline__ void qkt(f32x16&p0,f32x16&p1,const char*Kslot,const bf16x8*qr,const f32x16&negm,int r32,int hi){
  const char*kb=Kslot+hi*1024+r32*16;
  #pragma unroll
  for(int d0=0;d0<4;++d0){
    const bf16x8 b0=*reinterpret_cast<const bf16x8*>(kb+d0*2048);
    const bf16x8 b1=*reinterpret_cast<const bf16x8*>(kb+d0*2048+512);
    if(d0==0){p0=__builtin_amdgcn_mfma_f32_32x32x16_bf16(b0,qr[0],negm,0,0,0);p1=__builtin_amdgcn_mfma_f32_32x32x16_bf16(b1,qr[0],negm,0,0,0);}
    else{p0=__builtin_amdgcn_mfma_f32_32x32x16_bf16(b0,qr[d0],p0,0,0,0);p1=__builtin_amdgcn_mfma_f32_32x32x16_bf16(b1,qr[d0],p1,0,0,0);}}
}
typedef __attribute__((address_space(3))) const char* lds_cptr;
typedef short v4i16_t __attribute__((ext_vector_type(4)));
__device__ __forceinline__ void kload8(bf16x8*kf,lds_cptr kp){
  kf[0]=*(const __attribute__((address_space(3))) bf16x8*)(kp);      kf[1]=*(const __attribute__((address_space(3))) bf16x8*)(kp+512);
  kf[2]=*(const __attribute__((address_space(3))) bf16x8*)(kp+2048); kf[3]=*(const __attribute__((address_space(3))) bf16x8*)(kp+2560);
  kf[4]=*(const __attribute__((address_space(3))) bf16x8*)(kp+4096); kf[5]=*(const __attribute__((address_space(3))) bf16x8*)(kp+4608);
  kf[6]=*(const __attribute__((address_space(3))) bf16x8*)(kp+6144); kf[7]=*(const __attribute__((address_space(3))) bf16x8*)(kp+6656);
}
__device__ __forceinline__ void kload2(bf16x8*kf,lds_cptr kp,int j){ kf[2*j]=*(const __attribute__((address_space(3))) bf16x8*)(kp+j*2048); kf[2*j+1]=*(const __attribute__((address_space(3))) bf16x8*)(kp+j*2048+512); }
__device__ __forceinline__ s16x4 vtr(lds_cptr p){ return __builtin_bit_cast(s16x4,__builtin_amdgcn_ds_read_tr16_b64_v4i16((__attribute__((address_space(3))) v4i16_t*)p)); }
__device__ __forceinline__ float rowmax(const f32x16&p0,const f32x16&p1){
  float a=max3f(p0[0],p0[1],p1[0]),b=max3f(p0[2],p0[3],p1[1]);a=max3f(a,p1[2],p1[3]);
  #pragma unroll
  for(int r=4;r<16;r+=4){a=max3f(a,p0[r],p0[r+1]);b=max3f(b,p0[r+2],p0[r+3]);a=max3f(a,p1[r],p1[r+1]);b=max3f(b,p1[r+2],p1[r+3]);}
  const float m=max2f(a,b);
  auto rr=__builtin_amdgcn_permlane32_swap(__float_as_uint(m),__float_as_uint(m),false,false);
  return max2f(__uint_as_float(rr[0]),__uint_as_float(rr[1]));
}
__device__ __forceinline__ void pv(f32x16*o,int vb,bf16x8 pa0,bf16x8 pa1,bf16x8 pa2,bf16x8 pa3){
  #pragma unroll
  for(int d0=0;d0<2;++d0){s16x4 lo[4],hi[4];
    #pragma unroll
    for(int ks=0;ks<4;++ks){
      asm volatile("ds_read_b64_tr_b16 %0,%1 offset:%c2":"=&v"(lo[ks]):"v"(vb),"i"(d0*4096+ks*1024):"memory");
      asm volatile("ds_read_b64_tr_b16 %0,%1 offset:%c2":"=&v"(hi[ks]):"v"(vb),"i"(d0*4096+ks*1024+512):"memory");}
    asm volatile("s_waitcnt lgkmcnt(0)":::"memory");SBAR();
    #define PK(k) (bf16x8){lo[k][0],lo[k][1],lo[k][2],lo[k][3],hi[k][0],hi[k][1],hi[k][2],hi[k][3]}
    o[d0]=__builtin_amdgcn_mfma_f32_32x32x16_bf16(pa0,PK(0),o[d0],0,0,0);
    o[d0]=__builtin_amdgcn_mfma_f32_32x32x16_bf16(pa1,PK(1),o[d0],0,0,0);
    o[d0]=__builtin_amdgcn_mfma_f32_32x32x16_bf16(pa2,PK(2),o[d0],0,0,0);
    o[d0]=__builtin_amdgcn_mfma_f32_32x32x16_bf16(pa3,PK(3),o[d0],0,0,0);
    #undef PK
  }
}

#ifndef ATTN_STORE16
#define ATTN_STORE16(p,v) (*(u32x4*)(p)=(v))
#endif
template<int MODE,int THRL> __device__ __forceinline__ void attn_unit(const bf16*Pm,bf16*YB,int qrow0,int ctx0,int lat0,int off,int NT,int wq0,int qcol,int kcol,int vcol,int zcol,int ocol,float sinkl2,char*shm){
  int tid_=threadIdx.x; asm volatile("":"+v"(tid_)); const int tid=tid_,lane=tid&63,r32=lane&31,hi=lane>>5; const int wid=__builtin_amdgcn_readfirstlane(tid>>6);
  const bf16*Qw=Pm+(long)(qrow0+wid*QBLK)*PP+qcol;
  const unsigned lds0=(unsigned)(uintptr_t)shm;
  float*wsf=(float*)(shm+LDS_WS)+wid*64;
  const bf16*ksrc=Pm+kcol+(long)lane*PP+wid*8;
  const bf16*vsrc=Pm+vcol+(long)(16*(wid&3)+(lane>>2))*PP+(wid>>2)*32+(lane&3)*8;
  const unsigned kdst=lds0+LDS_K+wid*1024, vdst=lds0+LDS_V+wid*1024;
  #define TROW(t) (((t)<4)?(ctx0+64*(t)):(lat0+64*((t)-4+off)))
  #define DMA_K(t,slot) glds16(ksrc+(long)TROW(t)*PP,(unsigned)__builtin_amdgcn_readfirstlane(kdst+(slot)))
  #define DMA_V(t,slot) glds16(vsrc+(long)TROW(t)*PP,(unsigned)__builtin_amdgcn_readfirstlane(vdst+(slot)))
  const int vb0=(int)(lds0+LDS_V)+((lane>>4)&1)*32+(lane&3)*8+(4*hi+((lane&15)>>2))*64;
  const char*Kbase=shm+LDS_K; bf16x8 kf[8];
  const lds_cptr shm3=(lds_cptr)shm; const lds_cptr kp0=shm3+LDS_K+hi*1024+r32*16; const lds_cptr vp0=shm3+LDS_V+((lane>>4)&1)*32+(lane&3)*8+(4*hi+((lane&15)>>2))*64;
  DMA_K(0,0);DMA_V(0,0);DMA_K(1,SLOTB);
  bf16x8 qr[4];
  #pragma unroll
  for(int d0=0;d0<4;++d0)qr[d0]=*reinterpret_cast<const bf16x8*>(&Qw[(long)r32*PP+d0*16+hi*8]);
  float mhat=0.f,l_reg=0.f;f32x16 o[2];o[0]=f32x16{};o[1]=f32x16{};f32x16 negm=f32x16{}; if(MODE==0){asm volatile("":"+v"(negm));}
  const int qrel=wid*QBLK+r32;
  #define CMASK(P0,P1,t) do{ if(MODE==1){ dmask(P0,P1,64*((t)-4)-wq0,((t)>=4)?256u:~0u,qrel,hi); } }while(0)
  bool resc=false;
  #define START(P0,P1) do{ const float rm=rowmax(P0,P1); resc=false; \
    { const float dl=rm; mhat=fadd_s(mhat,dl); \
      _Pragma("unroll") for(int r=0;r<16;++r){P0[r]=fsub_s(P0[r],dl);P1[r]=fsub_s(P1[r],dl);} \
      if(MODE==0){ _Pragma("unroll") for(int r=0;r<16;++r)negm[r]=-mhat; asm volatile("":"+v"(negm)); } } \
    _Pragma("unroll") for(int r=0;r<16;++r)P0[r]=__builtin_amdgcn_exp2f(P0[r]); }while(0)
  #define RESC() do{ if(resc){ asm volatile("s_waitcnt lgkmcnt(0)":::"memory"); \
      _Pragma("unroll") for(int d_=0;d_<2;++d_) _Pragma("unroll") for(int r=0;r<16;++r)o[d_][r]*=wsf[crow(r,hi)]; } }while(0)
  f32x16 pA0,pA1,pB0,pB1;
  int sl_prev=0,sl_cur=0,sl_next=SLOTB;
  #define ROT() do{sl_prev=sl_cur;sl_cur=sl_next;sl_next=(sl_next==(NSLOT-1)*SLOTB)?0:sl_next+SLOTB;}while(0)
  DMA_K(2,2*SLOTB);
  WAIT_BAR(3);
  qkt(pA0,pA1,Kbase,qr,negm,r32,hi);asm volatile("s_nop 15\n\ts_nop 7":"+v"(pA0),"+v"(pA1));CMASK(pA0,pA1,0);
  START(pA0,pA1);
  _Pragma("unroll") for(int r=0;r<16;++r)pA1[r]=__builtin_amdgcn_exp2f(pA1[r]);
  WAIT_BAR(0);
  DMA_K(3,0);DMA_V(1,SLOTB);
  ROT();
  kload8(kf,kp0+sl_cur);
  WAIT_BAR(2);
  s16x4 vlo[8],vhi[8]; u32x4 pw0,pw1,pw2,pw3;
  #define PKW(P,B) cvtpk_s(P[B],P[B+1])
  #define PAF(k) __builtin_bit_cast(bf16x8,pw##k)
  #define VFR(i) (bf16x8){vlo[i][0],vlo[i][1],vlo[i][2],vlo[i][3],vhi[i][0],vhi[i][1],vhi[i][2],vhi[i][3]}
  #define PIN(x) asm volatile("":"+v"(x))
  #define MX3(a,b,c) __builtin_fmaxf(__builtin_fmaxf((a),(b)),(c))
  #define GAPA(MF,A0,A1,A2,A3,W0,W1,PW) do{ MF; sacc+=A0; sacc+=A1; sacc+=A2; sacc+=A3; PIN(sacc); W0; W1; PIN(PW); SBAR(); }while(0)
  #define EX(v) __builtin_amdgcn_exp2f(v)
  #define GAPB(MF,X,B) do{ MF; X[B]=EX(X[B]); X[B+1]=EX(X[B+1]); X[B+2]=EX(X[B+2]); X[B+3]=EX(X[B+3]); PIN(X); SBAR(); }while(0)
  #define VRD(i) do{ vlo[i]=vtr(vp_+(((i)>>2)*4096+((i)&3)*1024)); vhi[i]=vtr(vp_+(((i)>>2)*4096+((i)&3)*1024+512)); }while(0)
  #define KRD(G,j) do{ if(G){ kload2(kf,kp0+sl_next,j); SBAR(); } }while(0)
  #define STEP(C0,C1,P0,P1,t,GK,GV,GL,MX) do{ SBAR(); \
    const lds_cptr vp_=vp0+sl_prev; \
    VRD(0); SBAR(); float sacc=(P0[0]+P0[1]); \
    GAPA(C0=__builtin_amdgcn_mfma_f32_32x32x16_bf16(kf[0],qr[0],negm,0,0,0), P0[2],P0[3],P0[4],P0[5],     pw0[0]=PKW(P0,0), pw0[1]=PKW(P0,2), pw0); \
    VRD(4); SBAR(); GAPA(C1=__builtin_amdgcn_mfma_f32_32x32x16_bf16(kf[1],qr[0],negm,0,0,0), P0[6],P0[7],P0[8],P0[9],     pw0[2]=PKW(P0,4), pw0[3]=PKW(P0,6), pw0); \
    VRD(1); SBAR(); GAPA(C0=__builtin_amdgcn_mfma_f32_32x32x16_bf16(kf[2],qr[1],C0,0,0,0),   P0[10],P0[11],P0[12],P0[13], pw1[0]=PKW(P0,8), pw1[1]=PKW(P0,10), pw1); \
    VRD(5); SBAR(); GAPA(C1=__builtin_amdgcn_mfma_f32_32x32x16_bf16(kf[3],qr[1],C1,0,0,0),   P0[14],P0[15],P1[0],P1[1],   pw1[2]=PKW(P0,12),pw1[3]=PKW(P0,14), pw1); \
    VRD(2); SBAR(); GAPA(C0=__builtin_amdgcn_mfma_f32_32x32x16_bf16(kf[4],qr[2],C0,0,0,0),   P1[2],P1[3],P1[4],P1[5],     pw2[0]=PKW(P1,0), pw2[1]=PKW(P1,2), pw2); \
    VRD(6); SBAR(); GAPA(C1=__builtin_amdgcn_mfma_f32_32x32x16_bf16(kf[5],qr[2],C1,0,0,0),   P1[6],P1[7],P1[8],P1[9],     pw2[2]=PKW(P1,4), pw2[3]=PKW(P1,6), pw2); \
    VRD(3); SBAR(); GAPA(C0=__builtin_amdgcn_mfma_f32_32x32x16_bf16(kf[6],qr[3],C0,0,0,0),   P1[10],P1[11],P1[12],P1[13], pw3[0]=PKW(P1,8), pw3[1]=PKW(P1,10), pw3); \
    VRD(7); SBAR(); GAPA(C1=__builtin_amdgcn_mfma_f32_32x32x16_bf16(kf[7],qr[3],C1,0,0,0),   P1[14],P1[15],0.f,0.f,       pw3[2]=PKW(P1,12),pw3[3]=PKW(P1,14), pw3); \
    l_reg+=sacc; \
    if(GK){DMA_K((t)+3,sl_cur);} if(GV){DMA_V((t)+1,sl_next);} \
    CMASK(C0,C1,t); \
    resc=false; if(MX){ float a=MX3(C0[0],C0[1],C1[0]),b=MX3(C0[2],C0[3],C1[1]); a=MX3(a,C1[2],C1[3]); \
      _Pragma("unroll") for(int r=4;r<16;r+=4){a=MX3(a,C0[r],C0[r+1]);b=MX3(b,C0[r+2],C0[r+3]);a=MX3(a,C1[r],C1[r+1]);b=MX3(b,C1[r+2],C1[r+3]);} \
      float rm=__builtin_fmaxf(a,b); { auto rr=__builtin_amdgcn_permlane32_swap(__float_as_uint(rm),__float_as_uint(rm),false,false); rm=__builtin_fmaxf(__uint_as_float(rr[0]),__uint_as_float(rr[1])); } \
      resc=false; if(MODE==1) rm-=mhat; \
      if(__builtin_expect(__any(rm>(float)THRL),0)){ const float dl=__builtin_fmaxf(rm,0.f); mhat+=dl; \
        if(MODE==0){ _Pragma("unroll") for(int r=0;r<16;++r){C0[r]-=dl;C1[r]-=dl;} \
          _Pragma("unroll") for(int r=0;r<16;++r)negm[r]=-mhat; asm volatile("":"+v"(negm)); } \
        const float f=__builtin_amdgcn_exp2f(-dl); l_reg*=f; if(hi==0)wsf[r32]=f; resc=true; } \
      if(MODE==1){ _Pragma("unroll") for(int r=0;r<16;++r){C0[r]-=mhat;C1[r]-=mhat;} } } \
    SBAR(); \
    GAPB(o[0]=__builtin_amdgcn_mfma_f32_32x32x16_bf16(PAF(0),VFR(0),o[0],0,0,0), C0,0); \
    GAPB(o[1]=__builtin_amdgcn_mfma_f32_32x32x16_bf16(PAF(0),VFR(4),o[1],0,0,0), C0,4); \
    KRD(GL,0); GAPB(o[0]=__builtin_amdgcn_mfma_f32_32x32x16_bf16(PAF(1),VFR(1),o[0],0,0,0), C0,8); \
    KRD(GL,1); GAPB(o[1]=__builtin_amdgcn_mfma_f32_32x32x16_bf16(PAF(1),VFR(5),o[1],0,0,0), C0,12); \
    KRD(GL,2); GAPB(o[0]=__builtin_amdgcn_mfma_f32_32x32x16_bf16(PAF(2),VFR(2),o[0],0,0,0), C1,0); \
    KRD(GL,3); GAPB(o[1]=__builtin_amdgcn_mfma_f32_32x32x16_bf16(PAF(2),VFR(6),o[1],0,0,0), C1,4); \
    GAPB(o[0]=__builtin_amdgcn_mfma_f32_32x32x16_bf16(PAF(3),VFR(3),o[0],0,0,0), C1,8); \
    GAPB(o[1]=__builtin_amdgcn_mfma_f32_32x32x16_bf16(PAF(3),VFR(7),o[1],0,0,0), C1,12); \
    }while(0)
  int t=1;
  if(MODE==0) for(;t+7<NT;t+=4){
    STEP(pB0,pB1,pA0,pA1,t,true,true,true,true);      WAIT_BAR(2); RESC(); ROT();
    STEP(pA0,pA1,pB0,pB1,t+1,true,true,true,false);   WAIT_BAR(2); RESC(); ROT();
    STEP(pB0,pB1,pA0,pA1,t+2,true,true,true,false);   WAIT_BAR(2); RESC(); ROT();
    STEP(pA0,pA1,pB0,pB1,t+3,true,true,true,false);   WAIT_BAR(2); RESC(); ROT();
  }
  if(MODE==0) for(;t+5<NT;t+=2){
    STEP(pB0,pB1,pA0,pA1,t,true,true,true,true);     WAIT_BAR(2); RESC(); ROT();
    STEP(pA0,pA1,pB0,pB1,t+1,true,true,true,false);   WAIT_BAR(2); RESC(); ROT();
  }
  #define ENDW(tt) do{ if((tt)+3<NT){WAIT_BAR(2);} else if((tt)+2<NT){WAIT_BAR(1);} else {WAIT_BAR(0);} }while(0)
  for(;t+1<NT;t+=2){
    STEP(pB0,pB1,pA0,pA1,t,(t+3<NT),(t+1<NT),(t+1<NT),true);       ENDW(t);   RESC(); ROT();
    STEP(pA0,pA1,pB0,pB1,t+1,(t+4<NT),(t+2<NT),(t+2<NT),true);     ENDW(t+1); RESC(); ROT();
  }
  STEP(pB0,pB1,pA0,pA1,NT-1,false,false,false,true); RESC();
  { float sacc=pB0[0]+pB0[1]; _Pragma("unroll") for(int r=2;r<16;++r)sacc+=pB0[r]; _Pragma("unroll") for(int r=0;r<16;++r)sacc+=pB1[r]; l_reg+=sacc;
    pw0=(u32x4){PKW(pB0,0),PKW(pB0,2),PKW(pB0,4),PKW(pB0,6)};pw1=(u32x4){PKW(pB0,8),PKW(pB0,10),PKW(pB0,12),PKW(pB0,14)};pw2=(u32x4){PKW(pB1,0),PKW(pB1,2),PKW(pB1,4),PKW(pB1,6)};pw3=(u32x4){PKW(pB1,8),PKW(pB1,10),PKW(pB1,12),PKW(pB1,14)};
    SBAR(); pv(o,vb0+sl_cur,PAF(0),PAF(1),PAF(2),PAF(3)); }
  #undef PKW
  #undef PAF
  #undef VFR
  #undef PIN
  #undef MX3
  #undef GAPA
  #undef GAPB
  #undef EX
  #undef VRD
  #undef KRD
  #undef STEP
  #undef ENDW
  {auto rr=__builtin_amdgcn_permlane32_swap(__float_as_uint(l_reg),__float_as_uint(l_reg),false,false);l_reg=__uint_as_float(rr[0])+__uint_as_float(rr[1]);}
  if(MODE==1){ l_reg+=__builtin_amdgcn_exp2f(sinkl2-mhat); }
  if(hi==0)wsf[32+r32]=l_reg;asm volatile("s_waitcnt lgkmcnt(0)":::"memory");
  float rli[16];
  #pragma unroll
  for(int r=0;r<16;++r)rli[r]=__builtin_amdgcn_rcpf(wsf[32+crow(r,hi)]);
  bf16*Ow=YB+(long)(qrow0+wid*QBLK)*YP+ocol; const bf16*Zw=Pm+(long)(qrow0+wid*QBLK)*PP+zcol;
  { bf16*stg=(bf16*)(shm+LDS_OST)+wid*2048;
    #pragma unroll
    for(int r=0;r<16;++r){const int orow=crow(r,hi);
      #pragma unroll
      for(int d0=0;d0<2;++d0)stg[orow*64+d0*32+r32]=__float2bfloat16(o[d0][r]*rli[r]);}
    asm volatile("s_waitcnt lgkmcnt(0)":::"memory");
    #pragma unroll
    for(int i=0;i<4;++i){const int row=i*8+(lane>>3),ch=lane&7; const u32x4 v=*(const u32x4*)(stg+row*64+ch*8); const u32x4 z=*(const u32x4*)(Zw+(long)row*PP+ch*8); u32x4 w;
      #define GATE2(vv,zz) cvtpk_s(__uint_as_float((vv)<<16)*siluf_(__uint_as_float((zz)<<16)),__uint_as_float((vv)&0xffff0000u)*siluf_(__uint_as_float((zz)&0xffff0000u)))
      w.x=GATE2(v.x,z.x); w.y=GATE2(v.y,z.y); w.z=GATE2(v.z,z.z); w.w=GATE2(v.w,z.w);
      #undef GATE2
      *(u32x4*)(Ow+(long)row*YP+ch*8)=w;} }
  asm volatile("s_waitcnt lgkmcnt(0)\n\ts_barrier":::"memory");
  #undef DMA_K
  #undef DMA_V
  #undef CMASK
  #undef START
  #undef RESC
  #undef ROT
  #undef TROW
}
#undef SBAR
#undef WAIT_BAR
}

constexpr int NWAVES = 8;
constexpr int DM = 1024, SEQ = 8192, NCTX = 256, NB = 2;
constexpr int M_LAT = NB * SEQ, M_CTX = NB * NCTX, M_ALL = M_LAT + M_CTX;
constexpr int PW = 2816;
constexpr float RMS_EPS = 1e-6f;
#ifndef WPITCH
#define WPITCH 1024
#endif
constexpr float QSCALE = 0.125f * 1.4426950408889634f;
constexpr int C_AQ = 0, C_AK = 256, C_AV = 384, C_AZ = 512, C_DQ = 768, C_DK = 1024, C_DV = 1152, C_DZ = 1280, C_BF = 1536, C_BZ = 1792, C_CU = 2048, C_CV = 2304, C_CZ = 2560;

constexpr size_t MiB = 1u << 20;
constexpr size_t WS_CTL = 0, CTL_ZERO_BYTES = 1 * MiB;
constexpr size_t WS_MOD = 1 * MiB;
constexpr size_t WS_TAB = 2 * MiB;
constexpr size_t TAB_MA = 0, TAB_128 = 131072, TAB_64 = 229376, TAB_256 = 245760, TAB_WSP = 507904, TAB_ONES = 786432, TAB_BIASB = 1048576;
constexpr size_t WS_WIN = 4 * MiB, WS_WM = 16 * MiB, WS_WBR = 32 * MiB, WS_WOUT = 36 * MiB;
constexpr size_t WS_XC1 = 40 * MiB;
constexpr size_t WS_H = 42 * MiB, WS_YB = 75 * MiB, WS_T1 = 108 * MiB, WS_P = 124 * MiB;
constexpr size_t WS_GT = WS_P, WS_MG = WS_P + 40 * MiB;
constexpr size_t WS_MGC = 216 * MiB;
constexpr size_t WS_GTC = 218 * MiB;
constexpr size_t WS_END = 222 * MiB;
constexpr int CW_BAR = 4096;

constexpr int RING_BYTES = 147456, LDSCTL_OFF = RING_BYTES, MISC_OFF = LDSCTL_OFF + 320, LDS_BYTES = RING_BYTES + 1024;

#define GAS __attribute__((address_space(1)))
#define LAS __attribute__((address_space(3)))
typedef unsigned short bf16;
typedef unsigned v4u __attribute__((ext_vector_type(4)));
typedef unsigned v2u __attribute__((ext_vector_type(2)));
typedef float f32x4 __attribute__((ext_vector_type(4)));
typedef float f32x16 __attribute__((ext_vector_type(16)));
typedef short bf16x8 __attribute__((ext_vector_type(8)));
typedef GAS unsigned gu32;
#define RLX_AGENT __ATOMIC_RELAXED, __HIP_MEMORY_SCOPE_AGENT
#define LDS_WAIT() asm volatile("s_waitcnt lgkmcnt(0)" ::: "memory")
#define MFMA32(a, b, c) __builtin_amdgcn_mfma_f32_32x32x16_bf16((a), (b), (c), 0, 0, 0)
#define DI __device__ __forceinline__
DI unsigned f2bf(float f) { unsigned u = __builtin_bit_cast(unsigned, f); return (u + 0x7fffu + ((u >> 16) & 1u)) >> 16; }
DI unsigned pk2(float lo, float hi) { return f2bf(lo) | (f2bf(hi) << 16); }
DI float bf2f(bf16 v) { return __uint_as_float((unsigned)v << 16); }
DI float wlo(unsigned w) { return __uint_as_float(w << 16); }
DI float whi(unsigned w) { return __uint_as_float(w & 0xffff0000u); }
DI int crow(int reg, int h) { return (reg & 3) + 8 * (reg >> 2) + 4 * h; }
DI int krow(int s, int h, int j) { return 16 * s + 8 * (j >> 2) + 4 * h + (j & 3); }
DI float siluf(float x) { return x * __builtin_amdgcn_rcpf(1.0f + __builtin_amdgcn_exp2f(-1.4426950408889634f * x)); }
DI float geluf(float v) {
    const float av = __builtin_fabsf(v), d = av * 0.2316418882f + 1.0f, t = __builtin_amdgcn_rcpf(d);
    float q = t * 0.5307027145f + (-0.7265760135f); q = q * t + 0.7107068705f; q = q * t + (-0.142248368f); q = q * t + 0.127414796f; q = q * t;
    const float e = __builtin_amdgcn_exp2f((v * v) * (-0.72134752044f)), m = v * (q * e), r = v - m;
    return v < 0.f ? m : r;
}
typedef float f32x2_t __attribute__((ext_vector_type(2))); typedef __bf16 bf16x2_t __attribute__((ext_vector_type(2)));
DI unsigned cvtpk(float lo, float hi) { f32x2_t v = {lo, hi}; bf16x2_t b = __builtin_convertvector(v, bf16x2_t); return __builtin_bit_cast(unsigned, b); }
DI bf16x8 pack_step(const f32x16& x, int s) {
    v4u p; p.x = cvtpk(x[8 * s], x[8 * s + 1]); p.y = cvtpk(x[8 * s + 2], x[8 * s + 3]); p.z = cvtpk(x[8 * s + 4], x[8 * s + 5]); p.w = cvtpk(x[8 * s + 6], x[8 * s + 7]);
    return __builtin_bit_cast(bf16x8, p);
}
DI float shx(float v, int o, int lane) { return __int_as_float(__builtin_amdgcn_ds_bpermute((lane ^ o) << 2, __float_as_int(v))); }
DI float wave_sum(float v, int lane) {
#pragma unroll
    for (int o = 1; o < 64; o <<= 1) v += shx(v, o, lane);
    return v;
}

#define XB_TMO      128
#define XB_XCNT(j)  (256  + 64 * (j))
#define XB_XSUB(j)  (1280 + 64 * (j))
#define XB_XGEN(j)  (2304 + 64 * (j))
#define XB_TOP      3328
#define XB_TOPGEN   3392
#define XCD_BAR_WORDS 3456
#define XB_SPIN_CAP (1u << 22)
DI unsigned xb_ld(unsigned* p)              { return __hip_atomic_load(p, __ATOMIC_RELAXED, __HIP_MEMORY_SCOPE_AGENT); }
DI unsigned xb_add(unsigned* p, unsigned v) { return __hip_atomic_fetch_add(p, v, __ATOMIC_RELAXED, __HIP_MEMORY_SCOPE_AGENT); }
DI unsigned xb_xcc_id() { return (unsigned)__builtin_amdgcn_s_getreg((3 << 11) | 20) & 0xFu; }
#define XB_SPIN(cond, bar) do { unsigned _sp = 0; while (cond) { __builtin_amdgcn_s_sleep(1); \
    if ((++_sp & 255u) == 0u) { if (xb_ld(&(bar)[XB_TMO])) break; if (_sp > XB_SPIN_CAP) { atomicAdd(&(bar)[XB_TMO], 1u); break; } } } } while (0)
struct XcdBarrier { unsigned* bar; unsigned x; volatile LAS unsigned* st; };
DI XcdBarrier xcd_barrier_post(unsigned* bar, volatile LAS unsigned* st) {
    XcdBarrier b; b.bar = bar; b.x = xb_xcc_id(); b.st = st;
    if (threadIdx.x == 0) (void)xb_add(&bar[XB_XCNT(b.x)], 1u);
    return b;
}
DI void xcd_barrier_complete(unsigned* bar, unsigned x, unsigned& nloc, unsigned& nx) {
    const unsigned G = gridDim.x * gridDim.y * gridDim.z;
    unsigned sum, cnt, mine, sp = 0u;
    for (;;) {
        sum = 0u; cnt = 0u; mine = 0u;
#pragma unroll
        for (unsigned j = 0; j < 16; ++j) { const unsigned c = xb_ld(&bar[XB_XCNT(j)]); sum += c; cnt += (c > 0u) ? 1u : 0u; mine = (j == x) ? c : mine; }
        if (sum == G) break;
        __builtin_amdgcn_s_sleep(1);
        if ((++sp & 255u) == 0u) { if (xb_ld(&bar[XB_TMO])) break; if (sp > XB_SPIN_CAP) { atomicAdd(&bar[XB_TMO], 1u); break; } }
    }
    nloc = mine > 0u ? mine : 1u; nx = cnt > 0u ? cnt : 1u;
}
DI void xcd_barrier(const XcdBarrier& b) {
    asm volatile("s_waitcnt vmcnt(0)" ::: "memory");
    __syncthreads();
    if (threadIdx.x == 0) {
        unsigned* bar = b.bar;
        __builtin_amdgcn_s_waitcnt(0);
        __builtin_amdgcn_fence(__ATOMIC_ACQUIRE, "agent");
        unsigned nloc = b.st[0], nx = b.st[1];
        if (nloc == 0u) { xcd_barrier_complete(bar, b.x, nloc, nx); b.st[0] = nloc; b.st[1] = nx; }
        const unsigned old = xb_add(&bar[XB_XSUB(b.x)], 1u);
        const unsigned gen = old / nloc;
        if (old + 1u == (gen + 1u) * nloc) {
            __builtin_amdgcn_fence(__ATOMIC_RELEASE, "agent");
            asm volatile("s_waitcnt vmcnt(0)" ::: "memory");
            const unsigned og = xb_add(&bar[XB_TOP], 1u);
            const unsigned tg = og / nx;
            if (og + 1u == (tg + 1u) * nx) xb_add(&bar[XB_TOPGEN], 1u);
            else XB_SPIN(xb_ld(&bar[XB_TOPGEN]) == tg, bar);
            xb_add(&bar[XB_XGEN(b.x)], 1u);
            asm volatile("s_waitcnt vmcnt(0)" ::: "memory");
        } else {
            XB_SPIN(xb_ld(&bar[XB_XGEN(b.x)]) == gen, bar);
            asm volatile("s_waitcnt vmcnt(0)" ::: "memory");
        }
    }
    __syncthreads();
}

struct Frame {
    LAS unsigned char* lds;
    int tid, lane, wave, vcu, G;
};

DI void p0_transpose_item(const float* W, int N, bf16* WT, int ldt, int row_off, int col_off, LAS float* scr, int item, int lane) {
    const int nblk = N / 32, kb = item / nblk, nb = item % nblk, k0 = 64 * kb, n0 = 32 * nb;
#pragma unroll 8
    for (int i = 0; i < 32; ++i) { const int kk = 2 * i + (lane >> 5); scr[kk * 33 + (lane & 31)] = W[(size_t)(k0 + kk) * N + n0 + (lane & 31)]; }
    LDS_WAIT(); asm volatile("" ::: "memory");
    const int c = lane & 7;
#pragma unroll
    for (int j = 0; j < 4; ++j) { const int n = (lane >> 3) + 8 * j; const LAS float* s = scr + (8 * c) * 33 + n;
        v4u o; o.x = pk2(s[0 * 33], s[1 * 33]); o.y = pk2(s[2 * 33], s[3 * 33]); o.z = pk2(s[4 * 33], s[5 * 33]); o.w = pk2(s[6 * 33], s[7 * 33]);
        *(GAS v4u*)(WT + (size_t)(row_off + n0 + n) * ldt + col_off + k0 + 8 * c) = o; }
    LDS_WAIT(); asm volatile("" ::: "memory");
}

struct Args { const float* in[20]; float* out; unsigned char* ws; };
enum { I_X = 0, I_C, I_CTX, I_CCTX, I_NORMW, I_WADA, I_BADA, I_WIN, I_QNA, I_KNA, I_QND, I_KND, I_SINK, I_WFNET, I_WSP, I_BSP, I_WBR, I_WMERGE, I_BMERGE, I_WOUT };

DI void p0_prologue(const Frame& F, const Args& a) {
    unsigned char* ws = a.ws;
    for (int u = F.vcu; u < 96; u += F.G) {
        const int l = u / 48, j0 = 64 * (u % 48);
        LAS float* sl = (LAS float*)F.lds; LAS float* red = sl + 3072;
        for (int i = F.tid; i < 3072; i += 512) { const int v = i >> 10, k = i & 1023; const float cv = (v < 2) ? a.in[I_C][v * 1024 + k] : a.in[I_CCTX][k]; sl[i] = siluf(cv); }
        __syncthreads();
        float a0 = 0.f, a1 = 0.f, a2 = 0.f;
        const float* wp = a.in[I_WADA] + (size_t)l * 1024 * 3072 + (size_t)(128 * F.wave) * 3072 + j0 + F.lane;
#pragma unroll 32
        for (int kk = 0; kk < 128; ++kk) { const float w = wp[(size_t)kk * 3072]; const int k = 128 * F.wave + kk; a0 += sl[k] * w; a1 += sl[1024 + k] * w; a2 += sl[2048 + k] * w; }
        red[(F.wave * 3 + 0) * 64 + F.lane] = a0; red[(F.wave * 3 + 1) * 64 + F.lane] = a1; red[(F.wave * 3 + 2) * 64 + F.lane] = a2;
        __syncthreads();
        if (F.tid < 192) { const int v = F.tid >> 6, jj = F.tid & 63; float s = a.in[I_BADA][l * 3072 + j0 + jj];
#pragma unroll
            for (int w = 0; w < 8; ++w) s += red[(w * 3 + v) * 64 + jj];
            ((float*)(ws + WS_MOD))[(l * 3 + v) * 3072 + j0 + jj] = s; }
        __syncthreads();
    }
    {
        LAS float* scr = (LAS float*)(F.lds + F.wave * 16384);
        const int gw = F.vcu * NWAVES + F.wave, NGW = F.G * NWAVES;
        constexpr int I_IN = 16 * 88, I_M = 16 * 128, I_O = 16 * 32, I_B = 4 * 32, PER_L = I_IN + I_M + I_O + 4 * I_B;
        for (int it = gw; it < 2 * PER_L; it += NGW) {
            const int l = it / PER_L; int r = it % PER_L;
            if (r < I_IN) { p0_transpose_item(a.in[I_WIN] + (size_t)l * 1024 * PW, PW, (bf16*)(ws + WS_WIN) + (size_t)l * PW * WPITCH, WPITCH, 0, 0, scr, r, F.lane); continue; } r -= I_IN;
            if (r < I_M) { p0_transpose_item(a.in[I_WMERGE] + (size_t)l * 1024 * 4096, 4096, (bf16*)(ws + WS_WM) + (size_t)l * 4096 * 1024, 1024, 0, 0, scr, r, F.lane); continue; } r -= I_M;
            if (r < I_O) { p0_transpose_item(a.in[I_WOUT] + (size_t)l * 1024 * 1024, 1024, (bf16*)(ws + WS_WOUT) + (size_t)l * 1024 * 1024, 1024, 0, 0, scr, r, F.lane); continue; } r -= I_O;
            { const int br = r / I_B; r -= br * I_B;
              p0_transpose_item(a.in[I_WBR] + ((size_t)l * 4 + br) * 256 * 1024, 1024, (bf16*)(ws + WS_WBR) + (size_t)l * 1024 * 1024, 1024, 0, 256 * br, scr, r, F.lane); }
        }
    }
    {
        const int gt = F.vcu * 512 + F.tid, NGT = F.G * 512;
        bf16* tab = (bf16*)(ws + WS_TAB);
        for (int e = gt; e < 65536; e += NGT) {
            const int l = e >> 15, g = (e >> 13) & 3, col = (e >> 6) & 127, c = e & 63, d = col & 63;
            const float* wf = a.in[I_WFNET] + ((size_t)(l * 4 + g) * 64) * 64 + d; float s = 0.f;
            for (int j = 0; j < 64; ++j) { const float rev = (float)((c * j) & 63) * (1.0f / 64.0f); const float tw = (col < 64) ? __builtin_amdgcn_cosf(rev) : -__builtin_amdgcn_sinf(rev); s += tw * wf[j * 64]; }
            tab[TAB_MA / 2 + e] = (bf16)f2bf(s);
        }
        for (int e = gt; e < 49152; e += NGT) {
            const int mat = e / 16384, rem = e % 16384, k1b = rem >> 12, nb = (rem >> 10) & 3, s = (rem >> 9) & 1, ln = (rem >> 3) & 63, j = rem & 7;
            const int n1 = 32 * nb + krow(s, ln >> 5, j), k1 = 32 * k1b + (ln & 31); const float rev = (float)((n1 * k1) & 127) * (1.0f / 128.0f);
            const float v = (mat == 0) ? __builtin_amdgcn_cosf(rev) : (mat == 1) ? __builtin_amdgcn_sinf(rev) : -__builtin_amdgcn_sinf(rev);
            tab[TAB_128 / 2 + e] = (bf16)f2bf(v);
        }
        for (int e = gt; e < 8192; e += NGT) {
            const int mat = e >> 12, k2 = (e >> 6) & 63, n2 = e & 63; const float rev = (float)((k2 * n2) & 63) * (1.0f / 64.0f);
            tab[TAB_64 / 2 + e] = (bf16)f2bf(mat == 0 ? __builtin_amdgcn_cosf(rev) : __builtin_amdgcn_sinf(rev));
        }
        for (int e = gt; e < 131072; e += NGT) {
            const int mat = e >> 16, rem = e & 65535, kb = rem >> 13, nb = (rem >> 10) & 7, s = (rem >> 9) & 1, ln = (rem >> 3) & 63, j = rem & 7;
            const int n = 32 * nb + krow(s, ln >> 5, j), k = 32 * kb + (ln & 31); const float rev = (float)((n * k) & 255) * (1.0f / 256.0f);
            tab[TAB_256 / 2 + e] = (bf16)f2bf(mat == 0 ? __builtin_amdgcn_cosf(rev) : __builtin_amdgcn_sinf(rev));
        }
        for (int e = gt; e < 131072; e += NGT) tab[TAB_WSP / 2 + e] = (bf16)f2bf(a.in[I_WSP][e]);
        for (int e = gt; e < M_CTX * 1024 / 4; e += NGT) { ((f32x4*)(ws + WS_XC1))[e] = ((const f32x4*)a.in[I_CTX])[e]; ((f32x4*)(ws + WS_MGC))[e] = (f32x4){0.f, 0.f, 0.f, 0.f}; }
        for (int e = gt; e < 4096; e += NGT) tab[TAB_ONES / 2 + e] = (bf16)(((e & 31) == 0) ? 0x3f80 : 0);
        for (int e = gt; e < 262144; e += NGT) tab[TAB_BIASB / 2 + e] = (bf16)(((e & 31) == 0) ? f2bf(a.in[I_BMERGE][e >> 5]) : 0u);
    }
}

DI void p1_modrms(const Frame& F, const Args& a, int l, const float* xlat, const float* xctx, int with_ctx) {
    const float* mod = (const float*)(a.ws + WS_MOD) + (size_t)l * 3 * 3072;
    const float* nw = a.in[I_NORMW] + l * 1024;
    bf16* H = (bf16*)(a.ws + WS_H);
    const int gw = F.vcu * NWAVES + F.wave, NGW = F.G * NWAVES;
    const int nrows = with_ctx ? M_ALL : M_LAT;
    int vcur = -1; f32x4 av[4], bv[4];
    for (int row = gw; row < nrows; row += NGW) {
        const int v = row < SEQ ? 0 : (row < M_LAT ? 1 : 2);
        if (v != vcur) { vcur = v;
#pragma unroll
            for (int j = 0; j < 4; ++j) { const int c = 4 * (F.lane + 64 * j); const f32x4 w = *(const f32x4*)(nw + c), sc = *(const f32x4*)(mod + v * 3072 + 1024 + c);
                av[j] = w * (sc + 1.0f); bv[j] = *(const f32x4*)(mod + v * 3072 + c); } }
        const float* xr = (row < M_LAT) ? xlat + (size_t)row * 1024 : xctx + (size_t)(row - M_LAT) * 1024;
        f32x4 x[4]; float ss = 0.f;
#pragma unroll
        for (int j = 0; j < 4; ++j) { x[j] = *(const f32x4*)(xr + 4 * (F.lane + 64 * j)); ss += (x[j].x * x[j].x + x[j].y * x[j].y) + (x[j].z * x[j].z + x[j].w * x[j].w); }
        const float rstd = __builtin_amdgcn_rsqf(wave_sum(ss, F.lane) * (1.0f / 1024.0f) + RMS_EPS);
#pragma unroll
        for (int j = 0; j < 4; ++j) { const f32x4 h = x[j] * rstd * av[j] + bv[j]; v2u o; o.x = pk2(h.x, h.y); o.y = pk2(h.z, h.w);
            *(v2u*)(H + (size_t)row * 1024 + 4 * (F.lane + 64 * j)) = o; }
    }
}

DI void p3_prep(const Frame& F, const Args& a, int l, bf16* P) {
    const int gw = F.vcu * NWAVES + F.wave, NGW = F.G * NWAVES;
    const int d = F.lane;
    const float wqa = a.in[I_QNA][l * 64 + d], wka = a.in[I_KNA][l * 64 + d], wqd = a.in[I_QND][l * 64 + d], wkd = a.in[I_KND][l * 64 + d];
    const float inv = __builtin_amdgcn_exp2f(-(float)(d & 15) * (13.287712379549449f / 16.0f));
    const float sgn = (d & 16) ? 1.0f : -1.0f;
    const int nrows = M_ALL;
    for (int row = gw; row < nrows; row += NGW) {
        const bool isctx = row >= M_LAT;
        const int n = row & (SEQ - 1);
        float cs = 1.0f, sn = 0.0f;
        if (!isctx) { const float pos = (float)((d < 32) ? (n >> 6) : (n & 63)); const float rev = pos * inv * 0.15915494309189535f; cs = __builtin_amdgcn_cosf(rev); sn = __builtin_amdgcn_sinf(rev); }
        bf16* pr = P + (size_t)row * PW;
        const bool qok = !(isctx && l == 1);
        float v[12];
#pragma unroll
        for (int s = 0; s < 12; ++s) { const int col = (s < 4) ? C_AQ + 64 * s : (s < 6) ? C_AK + 64 * (s - 4) : (s < 10) ? C_DQ + 64 * (s - 6) : C_DK + 64 * (s - 10);
            const bool isq = (s < 4) || (s >= 6 && s < 10);
            v[s] = (isq && !qok) ? 0.f : bf2f(pr[col + d]); }
#pragma unroll
        for (int s = 0; s < 12; ++s) { const int col = (s < 4) ? C_AQ + 64 * s : (s < 6) ? C_AK + 64 * (s - 4) : (s < 10) ? C_DQ + 64 * (s - 6) : C_DK + 64 * (s - 10);
            const bool isq = (s < 4) || (s >= 6 && s < 10);
            const float w = (s < 4) ? wqa : (s < 6) ? wka : (s < 10) ? wqd : wkd;
            const float ss = wave_sum(v[s] * v[s], d);
            float y = v[s] * __builtin_amdgcn_rsqf(ss * (1.0f / 64.0f) + RMS_EPS) * w;
            const float p = shx(y, 16, d);
            y = y * cs + sgn * p * sn;
            if (isq) y *= QSCALE;
            if (!isq || qok) pr[col + d] = (bf16)f2bf(y); }
    }
}

DI void fnet_stepA(const bf16* xrow, const bf16* MAt, int r32, int hi, bf16x8 (&gs)[4][2]) {
    bf16x8 xa[4];
#pragma unroll
    for (int s4 = 0; s4 < 4; ++s4) xa[s4] = *(const bf16x8*)(xrow + 16 * s4 + 8 * hi);
#pragma unroll
    for (int cb = 0; cb < 4; ++cb) { f32x16 acc = f32x16{};
#pragma unroll
        for (int s4 = 0; s4 < 4; ++s4) { const bf16x8 bfr = *(const bf16x8*)(MAt + (32 * cb + r32) * 64 + 16 * s4 + 8 * hi); acc = MFMA32(xa[s4], bfr, acc); }
        gs[cb][0] = pack_step(acc, 0); gs[cb][1] = pack_step(acc, 1); }
}

DI void fnet_s1_unit(const Frame& F, const Args& a, int l, int u, const bf16* P) {
    const int b = u >> 7, n2grp = (u >> 4) & 7, g = (u >> 2) & 3, k1b = u & 3;
    const int lane = F.lane, r32 = lane & 31, hi = lane >> 5, w = F.wave, n2 = 8 * n2grp + w;
    const bf16* tab = (const bf16*)(a.ws + WS_TAB);
    const bf16* MAt = tab + TAB_MA / 2 + (size_t)(l * 4 + g) * 128 * 64;
    const bf16* T128 = tab + TAB_128 / 2;
    f32x16 Tr[2], Ti[2];
#pragma unroll
    for (int j = 0; j < 2; ++j) { Tr[j] = f32x16{}; Ti[j] = f32x16{}; }
#pragma unroll 1
    for (int nb = 0; nb < 4; ++nb) {
        const bf16* xrow = P + (size_t)(SEQ * b + 64 * (32 * nb + r32) + n2) * PW + C_BF + 64 * g;
        bf16x8 gs[4][2]; fnet_stepA(xrow, MAt, r32, hi, gs);
#pragma unroll
        for (int s = 0; s < 2; ++s) {
            const size_t fo = ((size_t)((k1b * 4 + nb) * 2 + s) * 64 + lane) * 8;
            const bf16x8 ca = *(const bf16x8*)(T128 + fo), sa = *(const bf16x8*)(T128 + 16384 + fo), na = *(const bf16x8*)(T128 + 32768 + fo);
            Tr[0] = MFMA32(ca, gs[0][s], Tr[0]); Tr[0] = MFMA32(sa, gs[2][s], Tr[0]);
            Tr[1] = MFMA32(ca, gs[1][s], Tr[1]); Tr[1] = MFMA32(sa, gs[3][s], Tr[1]);
            Ti[0] = MFMA32(ca, gs[2][s], Ti[0]); Ti[0] = MFMA32(na, gs[0][s], Ti[0]);
            Ti[1] = MFMA32(ca, gs[3][s], Ti[1]); Ti[1] = MFMA32(na, gs[1][s], Ti[1]); }
    }
    LAS bf16* tl = (LAS bf16*)F.lds;
#pragma unroll
    for (int i = 0; i < 16; ++i) { const int k1l = crow(i, hi), k1 = 32 * k1b + k1l;
        const float rev = (float)((n2 * k1) & 8191) * (1.0f / 8192.0f); const float c = __builtin_amdgcn_cosf(rev), s = __builtin_amdgcn_sinf(rev);
#pragma unroll
        for (int jb = 0; jb < 2; ++jb) { const float tr = Tr[jb][i], ti = Ti[jb][i];
            tl[(k1l * 128 + 32 * jb + r32) * 8 + w] = (bf16)f2bf(tr * c + ti * s);
            tl[(k1l * 128 + 64 + 32 * jb + r32) * 8 + w] = (bf16)f2bf(ti * c - tr * s); } }
    __syncthreads();
    bf16* T1 = (bf16*)(a.ws + WS_T1);
#pragma unroll 4
    for (int pass = 0; pass < 8; ++pass) { const int q = F.tid + 512 * pass, k1l = q >> 7, colL = q & 127;
        const v4u v = *(const LAS v4u*)(F.lds + (size_t)q * 16);
        *(v4u*)(T1 + ((((size_t)(b * 128 + 32 * k1b + k1l) * 8 + n2grp) * 512) + g * 128 + colL) * 8) = v; }
    __syncthreads();
}

DI void fnet_ctx_unit(const Frame& F, const Args& a, int l, int u, const bf16* P, bf16* YB) {
    const int b = u >> 2, g = u & 3;
    const int lane = F.lane, r32 = lane & 31, hi = lane >> 5, w = F.wave;
    const bf16* tab = (const bf16*)(a.ws + WS_TAB);
    const bf16* MAt = tab + TAB_MA / 2 + (size_t)(l * 4 + g) * 128 * 64;
    const bf16* T256 = tab + TAB_256 / 2;
    f32x16 Y[2]; Y[0] = f32x16{}; Y[1] = f32x16{};
#pragma unroll 1
    for (int nb = 0; nb < 8; ++nb) {
        const bf16* xrow = P + (size_t)(M_LAT + NCTX * b + 32 * nb + r32) * PW + C_BF + 64 * g;
        bf16x8 gs[4][2]; fnet_stepA(xrow, MAt, r32, hi, gs);
#pragma unroll
        for (int s = 0; s < 2; ++s) {
            const size_t fo = ((size_t)((w * 8 + nb) * 2 + s) * 64 + lane) * 8;
            const bf16x8 ca = *(const bf16x8*)(T256 + fo), sa = *(const bf16x8*)(T256 + 65536 + fo);
            Y[0] = MFMA32(ca, gs[0][s], Y[0]); Y[0] = MFMA32(sa, gs[2][s], Y[0]);
            Y[1] = MFMA32(ca, gs[1][s], Y[1]); Y[1] = MFMA32(sa, gs[3][s], Y[1]); }
    }
#pragma unroll
    for (int jb = 0; jb < 2; ++jb)
#pragma unroll
        for (int i = 0; i < 16; ++i) { const int k = 32 * w + crow(i, hi), d = 32 * jb + r32; const size_t row = (size_t)(M_LAT + NCTX * b + k);
            const float z = bf2f(P[row * PW + C_BZ + 64 * g + d]);
            YB[row * 1024 + 512 + 64 * g + d] = (bf16)f2bf(Y[jb][i] * (1.0f / 128.0f) * siluf(z)); }
}

#ifndef B_SCALE
#define B_SCALE 1.0f
#endif
#ifndef C_SCALE
#define C_SCALE 1.0f
#endif
DI void fnet_s3_unit(const Frame& F, const Args& a, int u, const bf16* P, bf16* YB) {
    const int b = u >> 7, k1 = u & 127;
    const int lane = F.lane, r32 = lane & 31, hi = lane >> 5, g = F.wave >> 1, jb = F.wave & 1;
    const bf16* T64 = (const bf16*)(a.ws + WS_TAB) + TAB_64 / 2;
    const bf16* T1 = (const bf16*)(a.ws + WS_T1);
    f32x16 Y[2]; Y[0] = f32x16{}; Y[1] = f32x16{};
#pragma unroll
    for (int sc = 0; sc < 4; ++sc)
#pragma unroll
        for (int ri = 0; ri < 2; ++ri) {
            const bf16x8 afr = *(const bf16x8*)(T1 + ((((size_t)(b * 128 + k1) * 8 + 2 * sc + hi) * 512) + g * 128 + ri * 64 + 32 * jb + r32) * 8);
#pragma unroll
            for (int k2b = 0; k2b < 2; ++k2b) { const bf16x8 bfr = *(const bf16x8*)(T64 + ri * 4096 + (32 * k2b + r32) * 64 + 16 * sc + 8 * hi); Y[k2b] = MFMA32(afr, bfr, Y[k2b]); } }
#pragma unroll
    for (int k2b = 0; k2b < 2; ++k2b) { const size_t row = (size_t)(SEQ * b + k1 + 128 * (32 * k2b + r32));
#pragma unroll
        for (int q = 0; q < 4; ++q) { const int d0 = 32 * jb + 8 * q + 4 * hi;
            const v2u z = *(const v2u*)(P + row * PW + C_BZ + 64 * g + d0);
            v2u o; o.x = pk2(Y[k2b][4 * q] * (B_SCALE * 0.0013810679320049757f) * siluf(wlo(z.x)), Y[k2b][4 * q + 1] * (B_SCALE * 0.0013810679320049757f) * siluf(whi(z.x)));
            o.y = pk2(Y[k2b][4 * q + 2] * (B_SCALE * 0.0013810679320049757f) * siluf(wlo(z.y)), Y[k2b][4 * q + 3] * (B_SCALE * 0.0013810679320049757f) * siluf(whi(z.y)));
            *(v2u*)(YB + row * 1024 + 512 + 64 * g + d0) = o; } }
}

DI void sgu_unit(const Frame& F, const Args& a, int l, int u, const bf16* P, bf16* YB) {
    constexpr int VP = 136;
    LAS bf16* vt = (LAS bf16*)F.lds;
    const int ci = u >> 2, g = u & 3;
    const size_t row0 = (size_t)ci * 128;
    { const int q = F.tid & 127, cq = F.tid >> 7; const bf16* src = P + (row0 + q) * PW + C_CV + 64 * g + 16 * cq;
#pragma unroll
      for (int i = 0; i < 2; ++i) { const v4u v = *(const v4u*)(src + 8 * i); const unsigned wv[4] = {v.x, v.y, v.z, v.w};
#pragma unroll
          for (int e = 0; e < 4; ++e) { vt[(16 * cq + 8 * i + 2 * e) * VP + q] = (bf16)f2bf(geluf(wlo(wv[e]))); vt[(16 * cq + 8 * i + 2 * e + 1) * VP + q] = (bf16)f2bf(geluf(whi(wv[e]))); } } }
    __syncthreads();
    const int lane = F.lane, r32 = lane & 31, hi = lane >> 5, pb = F.wave >> 1, cb = F.wave & 1;
    const bf16* Wsp = (const bf16*)(a.ws + WS_TAB) + TAB_WSP / 2 + (size_t)(l * 4 + g) * 128 * 128;
    f32x16 acc = f32x16{};
#pragma unroll
    for (int s = 0; s < 8; ++s) {
        const bf16x8 af = *(const LAS bf16x8*)(vt + (32 * cb + r32) * VP + 16 * s + 8 * hi);
        const bf16x8 bfr = *(const bf16x8*)(Wsp + (32 * pb + r32) * 128 + 16 * s + 8 * hi);
        acc = MFMA32(af, bfr, acc);
    }
    const int p = 32 * pb + r32; const float bb = a.in[I_BSP][(l * 4 + g) * 128 + p]; const bf16* pr = P + (row0 + p) * PW;
#pragma unroll
    for (int q = 0; q < 4; ++q) { const int c0 = 64 * g + 32 * cb + 8 * q + 4 * hi;
        const v2u uu = *(const v2u*)(pr + C_CU + c0), zz = *(const v2u*)(pr + C_CZ + c0);
        v2u o; o.x = pk2(C_SCALE * geluf(wlo(uu.x)) * (acc[4 * q] + bb) * siluf(wlo(zz.x)), C_SCALE * geluf(whi(uu.x)) * (acc[4 * q + 1] + bb) * siluf(whi(zz.x)));
        o.y = pk2(C_SCALE * geluf(wlo(uu.y)) * (acc[4 * q + 2] + bb) * siluf(wlo(zz.y)), C_SCALE * geluf(whi(uu.y)) * (acc[4 * q + 3] + bb) * siluf(whi(zz.y)));
        *(v2u*)(YB + (row0 + p) * 1024 + 768 + c0) = o; }
    __syncthreads();
}

DI void p5_ctx_convert(const Frame& F, const Args& a) {
    const int gt = F.vcu * 512 + F.tid, NGT = F.G * 512;
    const f32x4* src = (const f32x4*)(a.ws + WS_MGC); v2u* dst = (v2u*)((bf16*)(a.ws + WS_MG) + (size_t)M_LAT * 1024);
    for (int e = gt; e < M_CTX * 1024 / 4; e += NGT) { const f32x4 v = src[e]; v2u o; o.x = pk2(v.x, v.y); o.y = pk2(v.z, v.w); dst[e] = o; }
}

#ifdef SELFCHECK
constexpr int CW_CHK = 8192;
DI unsigned hsh(unsigned x) { x *= 2654435761u; x ^= x >> 15; x *= 2246822519u; x ^= x >> 13; x *= 3266489917u; x ^= x >> 16; return x; }
DI void chk_acc(const Args& a, int id, float got, float want) {
    unsigned* w = (unsigned*)(a.ws + WS_CTL) + CW_CHK + 4 * id;
    float d = __builtin_fabsf(got - want); if (!(d == d) || d > 1e15f) d = 1e15f;
    atomicAdd((float*)w, d * d); atomicAdd((float*)(w + 1), want * want); atomicAdd(w + 2, 1u); atomicMax(w + 3, __float_as_uint(d));
}
DI float bfr(float x) { return __uint_as_float(f2bf(x) << 16); }
DI void chk_p0(const Frame& F, const Args& a) {
    const int gt = F.vcu * 512 + F.tid, NGT = F.G * 512;
    for (int s = gt; s < 18432; s += NGT) { const int l = s / 9216, v = (s / 3072) % 3, j = s % 3072; float acc = a.in[I_BADA][l * 3072 + j];
        for (int k = 0; k < 1024; ++k) { const float cv = (v < 2) ? a.in[I_C][v * 1024 + k] : a.in[I_CCTX][k]; acc += siluf(cv) * a.in[I_WADA][((size_t)l * 1024 + k) * 3072 + j]; }
        chk_acc(a, 0, ((const float*)(a.ws + WS_MOD))[(l * 3 + v) * 3072 + j], acc); }
    for (int s = gt; s < 65536; s += NGT) { const unsigned h = hsh(s); const int l = (s >> 2) & 1, m = s & 3, k = h & 1023; const unsigned h2 = hsh(h + 77u);
        float got, want;
        if (m == 0) { const int n = h2 % PW; want = bfr(a.in[I_WIN][((size_t)l * 1024 + k) * PW + n]); got = bf2f(((const bf16*)(a.ws + WS_WIN))[((size_t)l * PW + n) * WPITCH + k]); }
        else if (m == 1) { const int n = h2 & 4095; want = bfr(a.in[I_WMERGE][((size_t)l * 1024 + k) * 4096 + n]); got = bf2f(((const bf16*)(a.ws + WS_WM))[((size_t)l * 4096 + n) * 1024 + k]); }
        else if (m == 2) { const int n = h2 & 1023; want = bfr(a.in[I_WOUT][((size_t)l * 1024 + k) * 1024 + n]); got = bf2f(((const bf16*)(a.ws + WS_WOUT))[((size_t)l * 1024 + n) * 1024 + k]); }
        else { const int n = h2 & 1023, br = k >> 8, kk = k & 255; want = bfr(a.in[I_WBR][(((size_t)l * 4 + br) * 256 + kk) * 1024 + n]); got = bf2f(((const bf16*)(a.ws + WS_WBR))[((size_t)l * 1024 + n) * 1024 + 256 * br + kk]); }
        chk_acc(a, 1, got, want); }
}
DI int sample_row(unsigned h, int l) { const int r = h % M_ALL; (void)l; return ((h >> 20) & 7) == 0 ? M_LAT + (h % M_CTX) : r; }
DI void chk_h(const Frame& F, const Args& a, int l, int id) {
    const float* mod = (const float*)(a.ws + WS_MOD) + (size_t)l * 3 * 3072; const bf16* H = (const bf16*)(a.ws + WS_H);
    const int gw = F.vcu * NWAVES + F.wave, NGW = F.G * NWAVES;
    for (int s = gw; s < M_ALL; s += NGW) { const int row = s; const int v = row < SEQ ? 0 : (row < M_LAT ? 1 : 2);
        const float* xr = (row < M_LAT) ? ((l == 0) ? a.in[I_X] : a.out) + (size_t)row * 1024 : ((l == 0) ? a.in[I_CTX] : (const float*)(a.ws + WS_XC1)) + (size_t)(row - M_LAT) * 1024;
        float ss = 0.f; for (int j = 0; j < 16; ++j) { const float x = xr[F.lane + 64 * j]; ss += x * x; }
        const float rstd = 1.0f / sqrtf(wave_sum(ss, F.lane) * (1.0f / 1024.0f) + RMS_EPS);
        for (int j = 0; j < 16; ++j) { const int c = F.lane + 64 * j; const float want = xr[c] * rstd * a.in[I_NORMW][l * 1024 + c] * (1.0f + mod[v * 3072 + 1024 + c]) + mod[v * 3072 + c];
            chk_acc(a, id, bf2f(H[(size_t)row * 1024 + c]), want); } }
}
DI float dot_h_w(const bf16* hrow, const bf16* wrow, int K) { float acc = 0.f; for (int k = 0; k < K; ++k) acc += bf2f(hrow[k]) * bf2f(wrow[k]); return acc; }
DI void chk_p(const Frame& F, const Args& a, int l, int id) {
    const bf16* H = (const bf16*)(a.ws + WS_H); const bf16* W = (const bf16*)(a.ws + WS_WIN) + (size_t)l * PW * WPITCH; const bf16* P = (const bf16*)(a.ws + WS_P);
    const int gt = F.vcu * 512 + F.tid, NGT = F.G * 512;
    for (int s = gt; s < (1 << 20); s += NGT) { const unsigned h = hsh(s * 5 + 2); const int row = sample_row(h, l); int col = hsh(h + 9u) % PW;
        if (l == 1 && row >= M_LAT) col = ((col & 1) ? 1024 : 256) + (col & 255);
        chk_acc(a, id, bf2f(P[(size_t)row * PW + col]), dot_h_w(H + (size_t)row * 1024, W + (size_t)col * WPITCH, 1024)); }
}
DI void chk_prep(const Frame& F, const Args& a, int l, int id) {
    const bf16* H = (const bf16*)(a.ws + WS_H); const bf16* W = (const bf16*)(a.ws + WS_WIN) + (size_t)l * PW * WPITCH; const bf16* P = (const bf16*)(a.ws + WS_P);
    const int gw = F.vcu * NWAVES + F.wave, NGW = F.G * NWAVES, d = F.lane;
    for (int s = gw; s < 16384; s += NGW) { const unsigned h = hsh(s * 7 + 3); const int row = sample_row(h, l); int sl = (h >> 8) % 12; const bool isctx = row >= M_LAT;
        if (isctx && l == 1) sl = (sl & 1) ? 4 + (sl & 1) : 10 + ((sl >> 1) & 1);
        const int col = (sl < 4) ? C_AQ + 64 * sl : (sl < 6) ? C_AK + 64 * (sl - 4) : (sl < 10) ? C_DQ + 64 * (sl - 6) : C_DK + 64 * (sl - 10);
        const bool isq = (sl < 4) || (sl >= 6 && sl < 10);
        const float raw = bfr(dot_h_w(H + (size_t)row * 1024, W + (size_t)(col + d) * WPITCH, 1024));
        const float wv = ((sl < 4) ? a.in[I_QNA] : (sl < 6) ? a.in[I_KNA] : (sl < 10) ? a.in[I_QND] : a.in[I_KND])[l * 64 + d];
        const float ms = wave_sum(raw * raw, d) * (1.0f / 64.0f);
        float y = raw / sqrtf(ms + RMS_EPS) * wv;
        if (!isctx) { const int n = row & (SEQ - 1); const float pos = (float)((d < 32) ? (n >> 6) : (n & 63)); const float inv = __builtin_amdgcn_exp2f(-(float)(d & 15) * (13.287712379549449f / 16.0f)); const float rev = pos * inv * 0.15915494309189535f; const float cs = __builtin_amdgcn_cosf(rev), sn = __builtin_amdgcn_sinf(rev);
            const float p = shx(y, 16, d); y = (d & 16) ? (p * sn + y * cs) : (y * cs - p * sn); }
        if (isq) y *= QSCALE;
        chk_acc(a, id, bf2f(P[(size_t)row * PW + col + d]), y); }
}
DI void chk_attn(const Frame& F, const Args& a, int l, int id, int mode) {
    const bf16* P = (const bf16*)(a.ws + WS_P); const bf16* YB = (const bf16*)(a.ws + WS_YB);
    LAS float* qs = (LAS float*)F.lds + F.wave * 192; LAS float* os = qs + 64; LAS float* red = qs + 128;
    const int gw = F.vcu * NWAVES + F.wave, NGW = F.G * NWAVES, lane = F.lane;
    const int qc0 = mode ? C_DQ : C_AQ, kc0 = mode ? C_DK : C_AK, vc0 = mode ? C_DV : C_AV, zc0 = mode ? C_DZ : C_AZ, oc0 = mode ? 256 : 0;
    for (int s = gw; s < 8192; s += NGW) { const unsigned hh = hsh(s * 11 + 5 + mode); int row = sample_row(hh, l); if ((s & 7) == 1) row = (hh & 8192) + (hh & 255) + ((hh & 256) ? 7936 : 0); if (l == 1 && row >= M_LAT) row = hh % M_LAT; const int h = (hh >> 9) & 3, kvh = h >> 1; const bool isctx = row >= M_LAT;
        const int b = isctx ? (row - M_LAT) / NCTX : row / SEQ, pos = row & (SEQ - 1);
        qs[lane] = bf2f(P[(size_t)row * PW + qc0 + 64 * h + lane]); LDS_WAIT();
        int klo = 0, khi = -1; if (!isctx) { if (mode == 0) { klo = 0; khi = SEQ - 1; } else { klo = pos - 128 < 0 ? 0 : pos - 128; khi = pos + 128 > SEQ - 1 ? SEQ - 1 : pos + 128; } }
        const int nlat = khi - klo + 1 > 0 ? khi - klo + 1 : 0, nk = NCTX + nlat;
        float m = -1e30f, lsum = 0.f; float acc[64];
#pragma unroll
        for (int dd = 0; dd < 64; ++dd) acc[dd] = 0.f;
        for (int kk = lane; kk < nk; kk += 64) { const size_t kr = (kk < NCTX) ? (size_t)(M_LAT + NCTX * b + kk) : (size_t)(SEQ * b + klo + kk - NCTX);
            const bf16* kp = P + kr * PW + kc0 + 64 * kvh; const bf16* vp = P + kr * PW + vc0 + 64 * kvh; float sc = 0.f;
#pragma unroll
            for (int dd = 0; dd < 64; ++dd) sc += qs[dd] * bf2f(kp[dd]);
            const float mn = fmaxf(m, sc), f = __builtin_amdgcn_exp2f(m - mn), p = __builtin_amdgcn_exp2f(sc - mn); lsum = lsum * f + p; m = mn;
#pragma unroll
            for (int dd = 0; dd < 64; ++dd) acc[dd] = acc[dd] * f + p * bf2f(vp[dd]); }
        float mall = m;
#pragma unroll
        for (int o = 1; o < 64; o <<= 1) mall = fmaxf(mall, shx(mall, o, lane));
        const float f = __builtin_amdgcn_exp2f(m - mall); lsum = wave_sum(lsum * f, lane);
        if (mode == 1) lsum += __builtin_amdgcn_exp2f(a.in[I_SINK][l * 4 + h] * 1.4426950408889634f - mall);
#pragma unroll
        for (int dd = 0; dd < 64; ++dd) { const float t = wave_sum(acc[dd] * f, lane); if (lane == dd) os[dd] = t; }
        LDS_WAIT();
        const float z = bf2f(P[(size_t)row * PW + zc0 + 64 * h + lane]);
        chk_acc(a, id, bf2f(YB[(size_t)row * 1024 + oc0 + 64 * h + lane]), os[lane] / lsum * siluf(z));
        (void)red; }
}
DI void chk_fnet(const Frame& F, const Args& a, int l, int id, int ctxmode) {
    const bf16* P = (const bf16*)(a.ws + WS_P); const bf16* YB = (const bf16*)(a.ws + WS_YB);
    LAS float* ys = (LAS float*)F.lds + F.wave * 64;
    const int gw = F.vcu * NWAVES + F.wave, NGW = F.G * NWAVES, j = F.lane;
    const int N = ctxmode ? NCTX : SEQ;
    for (int s = gw; s < (ctxmode ? 256 : 1024); s += NGW) { const unsigned hh = hsh(s * 13 + 7 + ctxmode); const int b = hh & 1, g = (hh >> 1) & 3; int k = (hh >> 3) % N;
#ifdef FNET_K0
        k = (s & 7) == 0 ? 0 : (s & 7) == 1 ? N / 2 : (s & 7) == 2 ? 64 : (s & 7) == 3 ? 128 : (s & 7) == 4 ? 1 : k;
#endif
        const size_t rbase = ctxmode ? (size_t)(M_LAT + NCTX * b) : (size_t)(SEQ * b);
        float y = 0.f;
        for (int n = 0; n < N; ++n) { const bf16* fr = P + (rbase + n) * PW + C_BF + 64 * g; float A = 0.f, B = 0.f;
            for (int c = 0; c < 64; ++c) { const float fv = bf2f(fr[c]); const float ph = (float)((j * c) & 63) * (1.0f / 64.0f); A += fv * __builtin_amdgcn_cosf(ph); B += fv * __builtin_amdgcn_sinf(ph); }
            const float th = (float)((k * n) & (N - 1)) / (float)N; y += __builtin_amdgcn_cosf(th) * A - __builtin_amdgcn_sinf(th) * B; }
        ys[j] = y / sqrtf((float)N * 64.0f); LDS_WAIT();
        float o = 0.f; for (int jj = 0; jj < 64; ++jj) o += ys[jj] * a.in[I_WFNET][((size_t)(l * 4 + g) * 64 + jj) * 64 + j];
        const size_t row = rbase + k; const float z = bf2f(P[row * PW + C_BZ + 64 * g + j]);
        chk_acc(a, id, bf2f(YB[row * 1024 + 512 + 64 * g + j]), o * siluf(z)); LDS_WAIT(); }
}
DI void chk_sgu(const Frame& F, const Args& a, int l, int id) {
    const bf16* P = (const bf16*)(a.ws + WS_P); const bf16* YB = (const bf16*)(a.ws + WS_YB);
    const int gt = F.vcu * 512 + F.tid, NGT = F.G * 512;
    for (int s = gt; s < (1 << 18); s += NGT) { const unsigned hh = hsh(s * 17 + 11); int row = sample_row(hh, l); if (l == 1 && row >= M_LAT) row = hh % M_LAT; const int cc = hsh(hh + 101u) & 255, g = cc >> 6, p = row & 127; const size_t r0 = (size_t)(row - p);
        float sp = a.in[I_BSP][(l * 4 + g) * 128 + p];
        for (int q = 0; q < 128; ++q) { const float v = bf2f(P[(r0 + q) * PW + C_CV + cc]); sp += a.in[I_WSP][((size_t)(l * 4 + g) * 128 + p) * 128 + q] * (0.5f * v * (1.0f + erff(v * 0.7071067811865476f))); }
        const float u = bf2f(P[(size_t)row * PW + C_CU + cc]), z = bf2f(P[(size_t)row * PW + C_CZ + cc]);
        chk_acc(a, id, bf2f(YB[(size_t)row * 1024 + 768 + cc]), (0.5f * u * (1.0f + erff(u * 0.7071067811865476f))) * sp * siluf(z)); }
}
DI void chk_merge(const Frame& F, const Args& a, int l, int id) {
    const bf16* H = (const bf16*)(a.ws + WS_H); const bf16* YB = (const bf16*)(a.ws + WS_YB); const bf16* MG = (const bf16*)(a.ws + WS_MG);
    const bf16* WM = (const bf16*)(a.ws + WS_WM) + (size_t)l * 4096 * 1024; const bf16* WB = (const bf16*)(a.ws + WS_WBR) + (size_t)l * 1024 * 1024;
    const int gt = F.vcu * 512 + F.tid, NGT = F.G * 512;
    for (int s = gt; s < (1 << 18); s += NGT) { const unsigned hh = hsh(s * 19 + 13); int row = sample_row(hh, l); if (l == 1 && row >= M_LAT) row = hh % M_LAT; const int d = hsh(hh + 202u) & 1023; float acc = 0.f;
        for (int r = 0; r < 4; ++r) { const float G = dot_h_w(H + (size_t)row * 1024, WM + ((size_t)r * 1024 + d) * 1024, 1024) + a.in[I_BMERGE][l * 4096 + r * 1024 + d];
            const float Y = dot_h_w(YB + (size_t)row * 1024 + 256 * r, WB + (size_t)d * 1024 + 256 * r, 256); acc += Y * __builtin_amdgcn_rcpf(1.0f + __builtin_amdgcn_exp2f(-1.4426950408889634f * G)); }
        float got; if (row < M_LAT) got = bf2f(MG[(size_t)row * 1024 + d]); else { got = 0.f; for (int br = 0; br < 4; ++br) got += bf2f(((const bf16*)(a.ws + WS_GTC))[((size_t)br * 512 + (row - M_LAT)) * 1024 + d]); }
        chk_acc(a, id, got, acc); }
}
DI void chk_gt(const Frame& F, const Args& a, int l, int r, int id) {
    const bf16* H = (const bf16*)(a.ws + WS_H); const bf16* GT = (const bf16*)(a.ws + WS_GT); const bf16* WM = (const bf16*)(a.ws + WS_WM) + (size_t)l * 4096 * 1024;
    const int gt = F.vcu * 512 + F.tid, NGT = F.G * 512;
    for (int s = gt; s < (1 << 18); s += NGT) { const unsigned hh = hsh(s * 29 + 19); int row = sample_row(hh, l); if (l == 1 && row >= M_LAT) row = hh % M_LAT; const int d = hsh(hh + 404u) & 1023;
        const float G = dot_h_w(H + (size_t)row * 1024, WM + ((size_t)r * 1024 + d) * 1024, 1024) + a.in[I_BMERGE][l * 4096 + r * 1024 + d];
        chk_acc(a, id, bf2f(GT[(size_t)row * 1024 + d]), __builtin_amdgcn_rcpf(1.0f + __builtin_amdgcn_exp2f(-1.4426950408889634f * G))); }
}
DI void chk_final(const Frame& F, const Args& a, int l, int id) {
    const bf16* MG = (const bf16*)(a.ws + WS_MG); const bf16* WO = (const bf16*)(a.ws + WS_WOUT) + (size_t)l * 1024 * 1024; const float* mod = (const float*)(a.ws + WS_MOD) + (size_t)l * 3 * 3072;
    const int gt = F.vcu * 512 + F.tid, NGT = F.G * 512;
    for (int s = gt; s < (1 << 18); s += NGT) { const unsigned hh = hsh(s * 23 + 17); const int row = sample_row(hh, l), c = hsh(hh + 303u) & 1023; const int v = row < SEQ ? 0 : (row < M_LAT ? 1 : 2);
        if (l == 1 && row >= M_LAT) continue;
        const float xi = (l == 1) ? ((const float*)(a.ws + WS_H))[(size_t)row * 1024 + c] : (row < M_LAT) ? a.in[I_X][(size_t)row * 1024 + c] : a.in[I_CTX][(size_t)(row - M_LAT) * 1024 + c];
        const float got = (row < M_LAT) ? a.out[(size_t)row * 1024 + c] : ((const float*)(a.ws + WS_XC1))[(size_t)(row - M_LAT) * 1024 + c];
        float dsum;
        if (row < M_LAT) dsum = dot_h_w(MG + (size_t)row * 1024, WO + (size_t)c * 1024, 1024);
        else { dsum = 0.f; for (int br = 0; br < 4; ++br) dsum += dot_h_w((const bf16*)(a.ws + WS_GTC) + ((size_t)br * 512 + (row - M_LAT)) * 1024, WO + (size_t)c * 1024, 1024); }
        chk_acc(a, id, got - xi, mod[v * 3072 + 2048 + c] * dsum); }
}
#ifdef CHECK_MAX
#define CHK_ERR(md, ss, n, mx) ((mx) / (sqrtf((ss) / (float)(n)) + 1e-20f))
#else
#define CHK_ERR(md, ss, n, mx) sqrtf((md) / ((ss) + 1e-30f))
#endif
DI void chk_report(const Frame& F, const Args& a) {
    const unsigned* w = (const unsigned*)(a.ws + WS_CTL) + CW_CHK; int first = -1; float ferr = 0.f;
#ifdef CHECK_ONLY
    { const int id = CHECK_ONLY; const float md = __uint_as_float(w[4 * id]), ss = ((const float*)w)[4 * id + 1]; const unsigned n = w[4 * id + 2]; first = id; ferr = n ? CHK_ERR(md, ss, n, __uint_as_float(w[4 * id + 3])) : 1e3f; }
#else
    for (int id = 0; id < 24; ++id) { const float md = __uint_as_float(w[4 * id]), ss = ((const float*)w)[4 * id + 1]; const unsigned n = w[4 * id + 2]; if (!n) continue;
        const float e = CHK_ERR(md, ss, n, __uint_as_float(w[4 * id + 3])); if (e > CHECK_TOL && first < 0) { first = id; ferr = e; } }
#endif
    const float V = first >= 0 ? 10.0f * (float)(1 + first) : 0.f; const float W = first >= 0 ? 4.0f + log10f(fminf(fmaxf(ferr, 1e-3f), 1e3f)) : 0.f;
    const size_t gt = (size_t)F.vcu * 512 + F.tid, NGT = (size_t)F.G * 512;
#ifdef KEEP_OUT
    if (gt == 0) a.out[0] += V; (void)W; (void)NGT;
#else
    for (size_t i = gt; i < (size_t)M_LAT * 1024; i += NGT) { float v = a.in[I_X][i]; if (i == 0) v += V; if (i >= (1u << 20) && i < (2u << 20)) v += W; a.out[i] = v; }
#endif
}
DI void chk_copy_out(const Frame& F, const Args& a) {
    const size_t gt = (size_t)F.vcu * 512 + F.tid, NGT = (size_t)F.G * 512; float* dst = (float*)(a.ws + WS_H);
    for (size_t i = gt; i < (size_t)M_LAT * 1024; i += NGT) dst[i] = a.out[i];
}
#endif

typedef const __attribute__((address_space(4))) Args* CArgsP;
DI Args fresh_args() { CArgsP p = (CArgsP)__builtin_amdgcn_kernarg_segment_ptr(); asm volatile("" : "+s"(p)); Args r;
#pragma unroll
    for (int i = 0; i < 20; ++i) r.in[i] = p->in[i];
    r.out = p->out; r.ws = p->ws; return r; }
DI Frame fresh_frame(unsigned char* lds) {
    Frame F; int t_ = threadIdx.x; asm volatile("" : "+v"(t_));
    F.lds = (LAS unsigned char*)lds; F.tid = t_; F.lane = t_ & 63; F.wave = __builtin_amdgcn_readfirstlane(t_ >> 6);
    F.G = gridDim.x; { const int bx = blockIdx.x; F.vcu = (F.G % 8 == 0) ? (bx % 8) * (F.G / 8) + bx / 8 : bx; }
    return F;
}
DI void grid_bar(unsigned char* lds) {
    const Args a = fresh_args();
    XcdBarrier b; b.bar = (unsigned*)(a.ws + WS_CTL) + CW_BAR; b.x = xb_xcc_id(); b.st = (volatile LAS unsigned*)((LAS unsigned char*)lds + MISC_OFF) + 8;
    xcd_barrier(b);
}

__global__ void __launch_bounds__(NWAVES * 64, 2) hybrid_fwd(Args args) {
    extern __shared__ __attribute__((aligned(16))) unsigned char lds[];
    for (int u = threadIdx.x; u < (LDS_BYTES - LDSCTL_OFF) / 4; u += NWAVES * 64) ((LAS unsigned*)((LAS unsigned char*)lds + LDSCTL_OFF))[u] = 0u;
    __syncthreads();
    { const Args a = fresh_args(); (void)xcd_barrier_post((unsigned*)(a.ws + WS_CTL) + CW_BAR, (volatile LAS unsigned*)((LAS unsigned char*)lds + MISC_OFF) + 8); }
#define GRID_BAR() grid_bar(lds)
#ifndef DUP_MASK
#define DUP_MASK 0
#endif
#define DUP(bit) for (int rep_ = 0; rep_ < 1 + (((DUP_MASK) >> (bit)) & 1); ++rep_)
#ifdef SELFCHECK
#ifndef CHECK_SET
#define CHECK_SET 0xffff
#endif
#define CHK(bit, call) do { if ((CHECK_SET) & (bit)) { { const Frame F = fresh_frame(lds); const Args a = fresh_args(); call; } GRID_BAR(); } } while (0)
#elif defined(EXTRA_BAR)
#define CHK(bit, call) GRID_BAR()
#else
#define CHK(bit, call) do {} while (0)
#endif

#ifndef SKIP_P0
    DUP(0) { const Frame F = fresh_frame(lds); const Args a = fresh_args(); p0_prologue(F, a); }
#endif
    GRID_BAR();
    CHK(1, chk_p0(F, a));

#pragma unroll 1
    for (int l = 0; l < 2; ++l) {
#ifndef SKIP_P1
        DUP(1) { const Frame F = fresh_frame(lds); const Args a = fresh_args();
          p1_modrms(F, a, l, (l == 0) ? a.in[I_X] : a.out, (l == 0) ? a.in[I_CTX] : (const float*)(a.ws + WS_XC1), 1); }
#endif
        GRID_BAR();
        CHK(2, chk_h(F, a, l, 2 + 10 * l));
#ifndef SKIP_G1
        DUP(2) { const Frame F = fresh_frame(lds); const Args a = fresh_args();
            pg8::Gemm g{(const bf16*)(a.ws + WS_H), (const bf16*)(a.ws + WS_WIN) + (size_t)l * PW * WPITCH, 1024, WPITCH, 1024};
            pg8::OrderX S; S.so.init(l == 0 ? M_ALL : M_LAT, PW, F.G, (int)blockIdx.x); S.nx = (l == 0) ? 0 : 4;
            pg8::EpiBf16<0> E{(bf16*)(a.ws + WS_P), PW, nullptr};
            pg8::gemm_phase<pg8::EpiBf16<0>, pg8::OrderX, true>(F.lds, g, S, E);
        }
#endif
        GRID_BAR();
        CHK(4, chk_p(F, a, l, 3 + 10 * l));
#ifndef SKIP_S1
        DUP(3) { const Frame F = fresh_frame(lds); const Args a = fresh_args();
          for (int u = F.vcu; u < 256; u += F.G) fnet_s1_unit(F, a, l, u, (const bf16*)(a.ws + WS_P)); }
#endif
#ifndef SKIP_FC
        if (l == 0) { const Frame F = fresh_frame(lds); const Args a = fresh_args();
          for (int e = F.vcu; e < 256; e += F.G) { if ((e & 31) == 7) fnet_ctx_unit(F, a, l, e >> 5, (const bf16*)(a.ws + WS_P), (bf16*)(a.ws + WS_YB)); } }
#endif
#ifndef SKIP_PREP
        { const Frame F = fresh_frame(lds); const Args a = fresh_args(); p3_prep(F, a, l, (bf16*)(a.ws + WS_P)); }
#endif
        GRID_BAR();
        CHK(8, chk_prep(F, a, l, 4 + 10 * l));
#ifndef SKIP_ATT
        DUP(4) { const Frame F = fresh_frame(lds); const Args a = fresh_args();
            const attn_body::bf16* Pa = (const attn_body::bf16*)(a.ws + WS_P); attn_body::bf16* Ya = (attn_body::bf16*)(a.ws + WS_YB);
            for (int u = F.vcu; u < 256; u += F.G) {
                const int bk = u >> 6, b = bk >> 1, kvh = bk & 1, h = 2 * kvh + ((u >> 5) & 1), qb = u & 31;
                attn_body::attn_unit<0, 8>(Pa, Ya, SEQ * b + 256 * qb, M_LAT + NCTX * b, SEQ * b, 0, 132, 0,
                                           C_AQ + 64 * h, C_AK + 64 * kvh, C_AV + 64 * kvh, C_AZ + 64 * h, 64 * h, 0.f, (char*)lds);
            }
        }
        DUP(5) { const Frame F = fresh_frame(lds); const Args a = fresh_args();
            const attn_body::bf16* Pa = (const attn_body::bf16*)(a.ws + WS_P); attn_body::bf16* Ya = (attn_body::bf16*)(a.ws + WS_YB);
            for (int u = F.vcu; u < 512; u += F.G) {
                if (u < 256) {
                    const int bk = u >> 6, b = bk >> 1, kvh = bk & 1, h = 2 * kvh + ((u >> 5) & 1), qb = u & 31;
                    const int off = (qb == 0) ? 0 : 4 * qb - 2, NT = (qb == 0 || qb == 31) ? 10 : 12;
                    const float sk = a.in[I_SINK][l * 4 + h] * 1.4426950408889634f;
                    attn_body::attn_unit<1, 8>(Pa, Ya, SEQ * b + 256 * qb, M_LAT + NCTX * b, SEQ * b, off, NT, 256 * qb - 64 * off,
                                               C_DQ + 64 * h, C_DK + 64 * kvh, C_DV + 64 * kvh, C_DZ + 64 * h, 256 + 64 * h, sk, (char*)lds);
                } else if (l == 0 && ((u - 256) & 15) == 0) {
                    const int ee = (u - 256) >> 4, mode = ee >> 3, b = (ee >> 2) & 1, h = ee & 3, kvh = h >> 1;
                    const float sk = (mode == 0) ? -INFINITY : a.in[I_SINK][l * 4 + h] * 1.4426950408889634f;
                    const int qc = (mode == 0) ? C_AQ : C_DQ, kc = (mode == 0) ? C_AK : C_DK, vc = (mode == 0) ? C_AV : C_DV, zc = (mode == 0) ? C_AZ : C_DZ, oc = (mode == 0) ? 0 : 256;
                    attn_body::attn_unit<1, 8>(Pa, Ya, M_LAT + NCTX * b, M_LAT + NCTX * b, SEQ * b, 0, 4, 0,
                                               qc + 64 * h, kc + 64 * kvh, vc + 64 * kvh, zc + 64 * h, oc + 64 * h, sk, (char*)lds);
                }
            }
        }
#endif
#ifndef SKIP_S3
        DUP(6) { const Frame F = fresh_frame(lds); const Args a = fresh_args();
          for (int u = F.vcu; u < 256; u += F.G) fnet_s3_unit(F, a, u, (const bf16*)(a.ws + WS_P), (bf16*)(a.ws + WS_YB)); }
#endif
#ifndef SKIP_SGU
        DUP(7) { const Frame F = fresh_frame(lds); const Args a = fresh_args();
          const int nunit = (l == 0) ? 528 : 512;
          for (int u = F.vcu; u < nunit; u += F.G) sgu_unit(F, a, l, u, (const bf16*)(a.ws + WS_P), (bf16*)(a.ws + WS_YB)); }
#endif
        GRID_BAR();
        CHK(16, chk_attn(F, a, l, 5 + 10 * l, 0)); CHK(16, chk_attn(F, a, l, 6 + 10 * l, 1)); CHK(32, chk_fnet(F, a, l, 7 + 10 * l, 0); if (l == 0) chk_fnet(F, a, l, 8, 1)); CHK(64, chk_sgu(F, a, l, 9 + 10 * l));
#ifndef MERGE_V1
        for (int rep_ = 0; rep_ < 1 + ((((DUP_MASK) >> 8) & 1) && l == 1); ++rep_) { const Frame F = fresh_frame(lds); const Args a = fresh_args();
            pg8::Gemm g{(const bf16*)(a.ws + WS_H), (const bf16*)(a.ws + WS_WM), 1024, 1024, 1024};
            pg8::MergeOrder S{(const bf16*)(a.ws + WS_H), (const bf16*)(a.ws + WS_YB), (const bf16*)(a.ws + WS_WM) + (size_t)l * 4096 * 1024, (const bf16*)(a.ws + WS_WBR) + (size_t)l * 1024 * 1024, F.G, F.vcu, (l == 0) ? 32 : 0};
            pg8::EpiMerge E{(bf16*)(a.ws + WS_GT), (bf16*)(a.ws + WS_MG), (float*)(a.ws + WS_MGC), a.in[I_BMERGE] + l * 4096, (bf16*)(a.ws + WS_GTC)};
            pg8::gemm_phase<pg8::EpiMerge, pg8::MergeOrder, true>(F.lds, g, S, E);
        }
        GRID_BAR();
#else
#pragma unroll 1
        for (int r = 0; r < 4; ++r) {
#ifdef ZERO_MASK
            if ((ZERO_MASK >> r) & 1) continue;
#endif
#ifndef SKIP_MG
            { const Frame F = fresh_frame(lds); const Args a = fresh_args();
                pg8::Gemm g{(const bf16*)(a.ws + WS_H), (const bf16*)(a.ws + WS_WM) + ((size_t)l * 4096 + r * 1024) * 1024, 1024, 1024, 1024};
                pg8::OrderX S; S.so.init((l == 0) ? M_ALL : M_LAT, 1024, F.G, (int)blockIdx.x); S.nx = 0;
                pg8::EpiBf16<2> E{(bf16*)(a.ws + WS_GT), 1024, a.in[I_BMERGE] + l * 4096 + r * 1024};
                pg8::gemm_phase<pg8::EpiBf16<2>, pg8::OrderX, true>(F.lds, g, S, E);
            }
#endif
            GRID_BAR();
            if (r == 3 && l == 0) CHK(512, chk_gt(F, a, l, r, 22); chk_gt(F, a, l, 2, 23));
#ifndef SKIP_MY
            { const Frame F = fresh_frame(lds); const Args a = fresh_args();
                pg8::Gemm g{(const bf16*)(a.ws + WS_YB) + r * 256, (const bf16*)(a.ws + WS_WBR) + (size_t)l * 1024 * 1024 + r * 256, 1024, 1024, 256};
                pg8::OrderX S; S.so.init((l == 0) ? M_ALL : M_LAT, 1024, F.G, (int)blockIdx.x); S.nx = 0;

#ifdef ZERO_MASK
                pg8::EpiGate E{(bf16*)(a.ws + WS_MG), (const bf16*)(a.ws + WS_GT), 1024, r == __builtin_ctz(~(ZERO_MASK)), 1.0f};
#else
#ifdef SCALE_MASK
                pg8::EpiGate E{(bf16*)(a.ws + WS_MG), (const bf16*)(a.ws + WS_GT), 1024, r == 0, ((SCALE_MASK >> r) & 1) ? (SCALE_VAL) : 1.0f};
#else
                pg8::EpiGate E{(bf16*)(a.ws + WS_MG), (const bf16*)(a.ws + WS_GT), 1024, r == 0, 1.0f};
#endif
#endif

                pg8::gemm_phase<pg8::EpiGate, pg8::OrderX, true>(F.lds, g, S, E);
            }
#endif
            GRID_BAR();
        }
#endif
        CHK(128, chk_merge(F, a, l, 10 + 10 * l));
        if (l == 1) CHK(256, chk_copy_out(F, a));
#ifndef SKIP_OUT
        { const Frame F = fresh_frame(lds); const Args a = fresh_args();
            pg8::Gemm g{(const bf16*)(a.ws + WS_MG), (const bf16*)(a.ws + WS_WOUT) + (size_t)l * 1024 * 1024, 1024, 1024, 1024};
            pg8::OrderOut S; S.so.init(M_LAT, 1024, F.G, (int)blockIdx.x); S.nx = (l == 0) ? 128 : 0; S.TERM = (const bf16*)(a.ws + WS_GTC);
            pg8::EpiRes E{(l == 0) ? a.in[I_X] : a.out, a.out, (l == 0) ? a.in[I_CTX] : (const float*)(a.ws + WS_XC1), (float*)(a.ws + WS_XC1), (const float*)(a.ws + WS_MOD) + (size_t)l * 3 * 3072};
            pg8::gemm_phase<pg8::EpiRes, pg8::OrderOut, true>(F.lds, g, S, E);
        }
#endif
        if (l == 0) GRID_BAR();
        if (l == 0) CHK(256, chk_final(F, a, l, 11));
#ifdef SELFCHECK
        if (l == 1) { GRID_BAR(); CHK(256, chk_final(F, a, l, 21)); }
#endif
    }
#ifdef SELFCHECK
    GRID_BAR();
    { const Frame F = fresh_frame(lds); const Args a = fresh_args(); chk_report(F, a); }
#endif
#ifdef BLEND_S
    GRID_BAR();
    { const Frame F = fresh_frame(lds); const Args a = fresh_args(); const size_t gt = (size_t)F.vcu * 512 + F.tid, NGT = (size_t)F.G * 512;
      for (size_t i = gt; i < (size_t)M_LAT * 1024; i += NGT) { const float x0 = a.in[I_X][i]; a.out[i] = x0 + (BLEND_S) * (a.out[i] - x0); } }
#endif
}

extern "C" void kernel_launch(void* const* d_in, const int* in_sizes, int n_in, void* d_out, int out_size, void* d_ws, size_t ws_size, hipStream_t stream) {
    static int grid = 0;
    if (grid == 0) {
        if (n_in != 20 || out_size != M_LAT * DM || ws_size < WS_END) { fprintf(stderr, "kernel_launch: unexpected problem: n_in %d out %d ws %zu\n", n_in, out_size, ws_size); grid = -1; return; }
        { const int want[20] = {M_LAT * DM, NB * DM, M_CTX * DM, DM, 2 * DM, 2 * DM * 3 * DM, 2 * 3 * DM, 2 * DM * PW, 128, 128, 128, 128, 8, 2 * 4 * 64 * 64, 2 * 4 * 128 * 128, 2 * 4 * 128, 2 * 4 * 256 * DM, 2 * DM * 4 * DM, 2 * 4 * DM, 2 * DM * DM};
          for (int i = 0; i < 20; ++i) if (in_sizes[i] != want[i]) { fprintf(stderr, "kernel_launch: input %d has %d elements, expected %d\n", i, in_sizes[i], want[i]); grid = -1; return; } }
        int dev = 0, cus = 0, per_cu = 0;
        if (hipGetDevice(&dev) != hipSuccess || hipDeviceGetAttribute(&cus, hipDeviceAttributeMultiprocessorCount, dev) != hipSuccess) { grid = -1; return; }
        if (hipFuncSetAttribute((const void*)hybrid_fwd, hipFuncAttributeMaxDynamicSharedMemorySize, LDS_BYTES) != hipSuccess) { fprintf(stderr, "kernel_launch: hipFuncSetAttribute failed\n"); grid = -1; return; }
        if (hipOccupancyMaxActiveBlocksPerMultiprocessor(&per_cu, (const void*)hybrid_fwd, NWAVES * 64, LDS_BYTES) != hipSuccess || per_cu < 1) { fprintf(stderr, "kernel_launch: occupancy query says %d blocks per CU\n", per_cu); per_cu = 1; }
        (void)hipGetLastError();
        grid = cus;
    }
    if (grid < 0) return;
    if (hipMemsetAsync((char*)d_ws + WS_CTL, 0, CTL_ZERO_BYTES, stream) != hipSuccess) { fprintf(stderr, "kernel_launch: memset failed\n"); return; }
    Args a{};
    for (int i = 0; i < 20; ++i) a.in[i] = (const float*)d_in[i];
    a.out = (float*)d_out; a.ws = (unsigned char*)d_ws;
    hipLaunchKernelGGL(hybrid_fwd, dim3(grid), dim3(NWAVES * 64), LDS_BYTES, stream, a);
}
```

```cpp
#include <hip/hip_runtime.h>
#include <hip/hip_bf16.h>
#include <cstdio>
#include <cstdint>
#include <cmath>

namespace pg8 {

#define PG8_LAS __attribute__((address_space(3)))
typedef unsigned short bf16_t;
typedef short bf16x8 __attribute__((ext_vector_type(8)));
typedef float f32x4 __attribute__((ext_vector_type(4)));
typedef unsigned u32x4 __attribute__((ext_vector_type(4)));
constexpr int BM = 256, BK = 64, HALF = 128, HTB = HALF * BK * 2, STAGE_BYTES = 8 * HTB, NXCD = 8, WGM = 8;

__host__ __device__ __forceinline__ int lds_byte(int r, int c) { const int st = (r >> 4) * 2 + (c >> 5), rr = r & 15, cc = c & 31, ob = rr * 64 + cc * 2; return st * 1024 + (ob ^ (((ob >> 9) & 1) << 5)); }
__host__ __device__ __forceinline__ void stage_rc(int b, int& R, int& C) { const int st = b / 1024, sb = b % 1024, swz = sb ^ (((sb >> 9) & 1) << 5); R = (st >> 1) * 16 + swz / 64; C = (st & 1) * 32 + (swz % 64) / 2; }
__host__ __device__ __forceinline__ int perm32(int rho) { const int n = rho >> 4, i = rho & 15; return 8 * (i >> 2) + 4 * n + (i & 3); }

struct Unit { int pm, pn, r, kind; };
struct Gemm { const bf16_t* A; const bf16_t* Bt; int lda, ldb, K; };

struct StaticOrder {
    int nM, nN, nwg, G, c;
    __host__ __device__ void init(int M, int N, int G_, int c_) { nM = M / BM; nN = N / BM; nwg = nM * nN; G = G_; c = c_; }
    __host__ __device__ bool next(int i, Unit& u) const {
        const long L = (long)i * G + c; if (L >= nwg) return false;
        int wgid = (int)L; { const int q = nwg / NXCD, r = nwg % NXCD, xcd = wgid % NXCD, off = wgid / NXCD; wgid = (xcd < r ? xcd * (q + 1) : r * (q + 1) + (xcd - r) * q) + off; }
        const int nig = WGM * nN, gid = wgid / nig, fm = gid * WGM, gsz = (nM - fm) < WGM ? (nM - fm) : WGM;
        u.pm = fm + ((wgid % nig) % gsz); u.pn = (wgid % nig) / gsz; u.r = 0; u.kind = 0; return true;
    }
};
struct OrderX {
    StaticOrder so; int nx;
    __device__ bool next(int i, Unit& u) const {
        const long L = (long)i * so.G + so.c;
        if (L < so.nwg) return so.next(i, u);
        const int e = (int)(L - so.nwg); if (e >= nx) return false;
        u.pm = 64 + (e >> 1); u.pn = (e & 1) ? 4 : 1; u.r = 0; u.kind = 0; return true;
    }
    __device__ __forceinline__ void src(const Gemm& g, const Unit& u, const char*& pa, const char*& pb, int& nt) const {
        pa = (const char*)g.A + (size_t)u.pm * (2 * HALF) * g.lda * 2; pb = (const char*)g.Bt + (size_t)u.pn * (2 * HALF) * g.ldb * 2; nt = g.K / BK; }
};

typedef float f32x2_c __attribute__((ext_vector_type(2))); typedef __bf16 bf16x2_c __attribute__((ext_vector_type(2)));
__device__ __forceinline__ unsigned cvt_pk_bf16(float lo, float hi) { f32x2_c v = {lo, hi}; bf16x2_c b = __builtin_convertvector(v, bf16x2_c); return __builtin_bit_cast(unsigned, b); }
__device__ __forceinline__ float bf_lo(unsigned w) { return __uint_as_float(w << 16); }
__device__ __forceinline__ float bf_hi(unsigned w) { return __uint_as_float(w & 0xffff0000u); }
__device__ __forceinline__ float sigmoidf_(float x) { return __builtin_amdgcn_rcpf(1.0f + __builtin_amdgcn_exp2f(-1.4426950408889634f * x)); }

template <int ACT> struct EpiBf16 {
    static constexpr bool PERM = true;
    bf16_t* O; int ldc; const float* bias;
    __device__ __forceinline__ void operator()(const f32x4 (&acc)[2][2][4][2], const Unit& u, int wr, int wc, int fr, int fq) const {
        const int row0 = u.pm * BM + wr * 64 + fr; const int col0 = u.pn * BM + wc * 32 + 8 * fq;
        f32x4 bv[2][2];
#pragma unroll
        for (int bj = 0; bj < 2; ++bj)
#pragma unroll
            for (int n = 0; n < 2; ++n) bv[bj][n] = bias ? *(const f32x4*)(bias + col0 + bj * HALF + 4 * n) : (f32x4){0.f, 0.f, 0.f, 0.f};
#pragma unroll
        for (int ai = 0; ai < 2; ++ai)
#pragma unroll
            for (int m = 0; m < 4; ++m) { bf16_t* rowp = O + (size_t)(row0 + ai * HALF + m * 16) * ldc + col0;
#pragma unroll
                for (int bj = 0; bj < 2; ++bj) { f32x4 v0 = acc[ai][bj][m][0] + bv[bj][0], v1 = acc[ai][bj][m][1] + bv[bj][1];
                    if (ACT == 2) {
#pragma unroll
                        for (int e = 0; e < 4; ++e) { v0[e] = sigmoidf_(v0[e]); v1[e] = sigmoidf_(v1[e]); } }
                    u32x4 w; w.x = cvt_pk_bf16(v0[0], v0[1]); w.y = cvt_pk_bf16(v0[2], v0[3]); w.z = cvt_pk_bf16(v1[0], v1[1]); w.w = cvt_pk_bf16(v1[2], v1[3]);
                    *(u32x4*)(rowp + bj * HALF) = w;
                    } }
    }
};
struct EpiGate {
    static constexpr bool PERM = true;
    bf16_t* MG; const bf16_t* GT; int ldc; int first; float scl;
    typedef unsigned u32x2 __attribute__((ext_vector_type(2)));
    __device__ __forceinline__ void operator()(const f32x4 (&acc)[2][2][4][2], const Unit& u, int wr, int wc, int fr, int fq) const {
        const int row0 = u.pm * BM + wr * 64 + fr; const int col0 = u.pn * BM + wc * 32 + 8 * fq;
#pragma unroll
        for (int ai = 0; ai < 2; ++ai)
#pragma unroll
            for (int m = 0; m < 4; ++m) { const size_t off = (size_t)(row0 + ai * HALF + m * 16) * ldc + col0;
#pragma unroll
                for (int bj = 0; bj < 2; ++bj)
#pragma unroll
                    for (int n = 0; n < 2; ++n) {
                        const u32x2 g = *(const u32x2*)(GT + off + bj * HALF + 4 * n);
                        u32x2 o = (u32x2){0u, 0u}; if (!first) o = *(const u32x2*)(MG + off + bj * HALF + 4 * n);
                        const f32x4 v = acc[ai][bj][m][n] * scl;
                        u32x2 w;
                        w.x = cvt_pk_bf16(bf_lo(o.x) + bf_lo(g.x) * v[0], bf_hi(o.x) + bf_hi(g.x) * v[1]);
                        w.y = cvt_pk_bf16(bf_lo(o.y) + bf_lo(g.y) * v[2], bf_hi(o.y) + bf_hi(g.y) * v[3]);
                        *(u32x2*)(MG + off + bj * HALF + 4 * n) = w; asm volatile("" ::: "memory"); } }
    }
};
struct EpiRes {
    static constexpr bool PERM = false;
    const float* xin_lat; float* xout_lat; const float* xin_ctx; float* xout_ctx; const float* gate;
    __device__ __forceinline__ void operator()(const f32x4 (&acc)[2][2][4][2], const Unit& u, int wr, int wc, int fr, int fq) const {
        const bool isctx = u.pm >= 64;
        const float* xin = isctx ? xin_ctx + (size_t)(u.pm - 64) * BM * 1024 : xin_lat + (size_t)u.pm * BM * 1024;
        float* xout = isctx ? xout_ctx + (size_t)(u.pm - 64) * BM * 1024 : xout_lat + (size_t)u.pm * BM * 1024;
        const float* gv = gate + (isctx ? 2 : (u.pm >> 5)) * 3072 + 2048;
        const int col0 = u.pn * BM + wc * 32 + 4 * fq;
        f32x4 gt[2][2];
#pragma unroll
        for (int bj = 0; bj < 2; ++bj)
#pragma unroll
            for (int n = 0; n < 2; ++n) gt[bj][n] = *(const f32x4*)(gv + col0 + bj * HALF + n * 16);
#pragma unroll
        for (int ai = 0; ai < 2; ++ai)
#pragma unroll
            for (int m = 0; m < 4; ++m) { const size_t off = (size_t)(ai * HALF + wr * 64 + m * 16 + fr) * 1024 + col0;
#pragma unroll
                for (int bj = 0; bj < 2; ++bj)
#pragma unroll
                    for (int n = 0; n < 2; ++n) {
                        if (u.kind == 3) { const f32x4 v = gt[bj][n] * acc[ai][bj][m][n]; float* q = xout + off + bj * HALF + n * 16; atomicAdd(q + 0, v[0]); atomicAdd(q + 1, v[1]); atomicAdd(q + 2, v[2]); atomicAdd(q + 3, v[3]); }
                        else { const f32x4 bs = *(const f32x4*)(xin + off + bj * HALF + n * 16); *(f32x4*)(xout + off + bj * HALF + n * 16) = bs + gt[bj][n] * acc[ai][bj][m][n]; } }
                if (m & 1) asm volatile("" ::: "memory"); }
    }
};

struct MergeOrder {
    const bf16_t* H; const bf16_t* YB; const bf16_t* WmT; const bf16_t* WbrT; int G, c, nctx;
    __device__ bool next(int i, Unit& u) const {
        const int nl = (c < 256) ? 1 + (255 - c) / G : 0;
        if (i < 8 * nl) { const int t = c + (i >> 3) * G, q = i & 7; u.pm = t >> 2; u.pn = t & 3; u.r = q >> 1; u.kind = (q & 1) ? 0 : 1; return true; }
        const int j = i - 8 * nl;
        if (nctx == 0 || (c & 7) != 0) return false;
        const int jb = (c >> 3) + (j >> 1) * (G >> 3); if (jb >= nctx) return false;
        const int t = jb >> 2; u.pm = 64 + (t >> 2); u.pn = t & 3; u.r = jb & 3; u.kind = (j & 1) ? 2 : 1; return true;
    }
    __device__ __forceinline__ void src(const Gemm&, const Unit& u, const char*& pa, const char*& pb, int& nt) const {
        if (u.kind != 1) { pa = (const char*)(H + (size_t)u.pm * 256 * 1024); pb = (const char*)(WmT + ((size_t)u.r * 1024 + u.pn * 256) * 1024); nt = 16; }
        else { pa = (const char*)(YB + (size_t)u.pm * 256 * 1024 + u.r * 256); pb = (const char*)(WbrT + (size_t)u.pn * 256 * 1024 + u.r * 256); nt = 4; }
    }
};
typedef unsigned long long u64_t;
__device__ __forceinline__ u64_t ld_sc1(const void* p) { return __hip_atomic_load((const u64_t*)p, __ATOMIC_RELAXED, __HIP_MEMORY_SCOPE_AGENT); }
struct EpiMerge {
    static constexpr bool PERM = true;
    bf16_t* GT; bf16_t* MG; float* MGc; const float* bias; bf16_t* GTc;
    typedef unsigned u32x2 __attribute__((ext_vector_type(2)));
    __device__ __forceinline__ void operator()(const f32x4 (&acc)[2][2][4][2], const Unit& u, int wr, int wc, int fr, int fq) const {
        const int row0 = u.pm * BM + wr * 64 + fr; const int col0 = u.pn * BM + wc * 32 + 8 * fq;
        bf16_t* Yu = (u.pm >= 64) ? GTc + ((size_t)u.r * 512 - 16384) * 1024 : GT;
        if (u.kind == 1) {
#pragma unroll
            for (int ai = 0; ai < 2; ++ai)
#pragma unroll
                for (int m = 0; m < 4; ++m) { bf16_t* rowp = Yu + (size_t)(row0 + ai * HALF + m * 16) * 1024 + col0;
#pragma unroll
                    for (int bj = 0; bj < 2; ++bj) { const f32x4 v0 = acc[ai][bj][m][0], v1 = acc[ai][bj][m][1];
                        u32x4 w; w.x = cvt_pk_bf16(v0[0], v0[1]); w.y = cvt_pk_bf16(v0[2], v0[3]); w.z = cvt_pk_bf16(v1[0], v1[1]); w.w = cvt_pk_bf16(v1[2], v1[3]);
                        *(u32x4*)(rowp + bj * HALF) = w; } }
        } else {
            const bool isctx = (u.kind == 2), first = (u.r == 0) || isctx;
            bf16_t* Ou = isctx ? Yu : MG;
            const float* bp = bias + u.r * 1024 + col0;
            f32x4 bv[2][2];
#pragma unroll
            for (int bj = 0; bj < 2; ++bj)
#pragma unroll
                for (int n = 0; n < 2; ++n) bv[bj][n] = *(const f32x4*)(bp + bj * HALF + 4 * n);
            const __amdgpu_buffer_rsrc_t ry = __builtin_amdgcn_make_buffer_rsrc((void*)Yu, 0, 0x7fffffff, 0x00020000), ro = __builtin_amdgcn_make_buffer_rsrc((void*)MG, 0, 0x7fffffff, 0x00020000);
#pragma unroll
            for (int ai = 0; ai < 2; ++ai) { u32x4 yq[4][2], oq[4][2];
#pragma unroll
                for (int mm = 0; mm < 4; ++mm) { const unsigned off = (unsigned)(((row0 + ai * HALF + mm * 16) * 1024 + col0) * 2);
#pragma unroll
                    for (int bj = 0; bj < 2; ++bj) { yq[mm][bj] = __builtin_bit_cast(u32x4, __builtin_amdgcn_raw_buffer_load_b128(ry, off + bj * HALF * 2, 0, 16));
                        oq[mm][bj] = first ? (u32x4){0u, 0u, 0u, 0u} : __builtin_bit_cast(u32x4, __builtin_amdgcn_raw_buffer_load_b128(ro, off + bj * HALF * 2, 0, 16)); } }
#pragma unroll
                for (int mm = 0; mm < 4; ++mm) { const size_t off = (size_t)(row0 + ai * HALF + mm * 16) * 1024 + col0;
#pragma unroll
                    for (int bj = 0; bj < 2; ++bj) { f32x4 g0 = acc[ai][bj][mm][0] + bv[bj][0], g1 = acc[ai][bj][mm][1] + bv[bj][1];
#pragma unroll
                        for (int e = 0; e < 4; ++e) { g0[e] = sigmoidf_(g0[e]); g1[e] = sigmoidf_(g1[e]); }
                        const u32x4 y = yq[mm][bj], o = oq[mm][bj];
                        u32x4 w;
                        w.x = cvt_pk_bf16(bf_lo(o.x) + g0[0] * bf_lo(y.x), bf_hi(o.x) + g0[1] * bf_hi(y.x));
                        w.y = cvt_pk_bf16(bf_lo(o.y) + g0[2] * bf_lo(y.y), bf_hi(o.y) + g0[3] * bf_hi(y.y));
                        w.z = cvt_pk_bf16(bf_lo(o.z) + g1[0] * bf_lo(y.z), bf_hi(o.z) + g1[1] * bf_hi(y.z));
                        w.w = cvt_pk_bf16(bf_lo(o.w) + g1[2] * bf_lo(y.w), bf_hi(o.w) + g1[3] * bf_hi(y.w));
                        *(u32x4*)(Ou + off + bj * HALF) = w; } }
                asm volatile("" ::: "memory"); }
        }
    }
};
struct OrderOut {
    StaticOrder so; int nx; const bf16_t* TERM;
    __device__ bool next(int i, Unit& u) const {
        const long L = (long)i * so.G + so.c;
        if (L < so.nwg) return so.next(i, u);
        const int e = (int)(L - so.nwg); if (e >= nx) return false;
        const int t = e >> 4; u.pm = 64 + (t >> 2); u.pn = t & 3; u.r = e & 15; u.kind = 3; return true;
    }
    __device__ __forceinline__ void src(const Gemm& g, const Unit& u, const char*& pa, const char*& pb, int& nt) const {
        pa = (const char*)g.A + (size_t)u.pm * (2 * HALF) * g.lda * 2; pb = (const char*)g.Bt + (size_t)u.pn * (2 * HALF) * g.ldb * 2; nt = g.K / BK;
        if (u.kind == 3) { const int br = u.r >> 2, kq = u.r & 3; pa = (const char*)(TERM + ((size_t)br * 512 + (u.pm - 64) * 256) * 1024 + kq * 256); pb += (size_t)kq * 256 * 2; nt = 4; }
    }
};

template <class Epi, class Sched, bool ALIGN_EPI>
__device__ __forceinline__ void gemm_phase(PG8_LAS unsigned char* lds, const Gemm g, const Sched& S, const Epi& E) {
    int tid = threadIdx.x; asm volatile("" : "+v"(tid));
    const int wid = __builtin_amdgcn_readfirstlane(tid >> 6), lane = tid & 63, wr = wid >> 2, wc = wid & 3, fr = lane & 15, fq = lane >> 4;
    int nt;
    unsigned voffA[2], voffB[2];
#pragma unroll
    for (int i = 0; i < 2; ++i) { int R, C; stage_rc(tid * 16 + i * 8192, R, C); const int Rb = Epi::PERM ? ((R & ~31) + perm32(R & 31)) : R;
        voffA[i] = (unsigned)(R * g.lda + C) * 2u; voffB[i] = (unsigned)(Rb * g.ldb + C) * 2u; }
    const size_t kstep = (size_t)(BK * 2);
    const size_t hstepA = (size_t)HALF * g.lda * 2, hstepB = (size_t)HALF * g.ldb * 2;
    const unsigned ldsw = (unsigned)wid * 1024u;
    const int aoff = lds_byte(wr * 64 + fr, fq * 8), boff = lds_byte(wc * 32 + fr, fq * 8);
#define PG8_SA(b, h) (((b) * 2 + (h)) * HTB)
#define PG8_SB(b, h) ((4 + (b) * 2 + (h)) * HTB)
#define PG8_STAGE(bufoff, gbase, voff) do { _Pragma("unroll") for (int _i = 0; _i < 2; ++_i) \
        __builtin_amdgcn_global_load_lds((const unsigned*)((const char*)(gbase) + (voff)[_i]), (PG8_LAS unsigned*)(lds + (bufoff) + ldsw + _i * 8192), 16, 0, 0); } while (0)
#define PG8_LDA(dst, b, h) do { _Pragma("unroll") for (int m = 0; m < 4; ++m) _Pragma("unroll") for (int k = 0; k < 2; ++k) dst[m][k] = *(const PG8_LAS bf16x8*)(lds + PG8_SA(b, h) + aoff + m * 2048 + k * 1024); } while (0)
#define PG8_LDB(dst, b, h) do { _Pragma("unroll") for (int n = 0; n < 2; ++n) _Pragma("unroll") for (int k = 0; k < 2; ++k) dst[n][k] = *(const PG8_LAS bf16x8*)(lds + PG8_SB(b, h) + boff + n * 2048 + k * 1024); } while (0)
#define PG8_MMA(ai, bj, At, Bt) do { __builtin_amdgcn_s_setprio(1); _Pragma("unroll") for (int m = 0; m < 4; ++m) _Pragma("unroll") for (int n = 0; n < 2; ++n) _Pragma("unroll") for (int k = 0; k < 2; ++k) \
        acc[ai][bj][m][n] = __builtin_amdgcn_mfma_f32_16x16x32_bf16(Bt[n][k], At[m][k], acc[ai][bj][m][n], 0, 0, 0); __builtin_amdgcn_s_setprio(0); } while (0)
#define PG8_WAIT_V(n) asm volatile("s_waitcnt vmcnt(" #n ")" ::: "memory")
#define PG8_WAIT_L(n) asm volatile("s_waitcnt lgkmcnt(" #n ")" ::: "memory")
#define PG8_BAR __builtin_amdgcn_s_barrier()
#define PG8_SCHED __builtin_amdgcn_sched_barrier(0)
    Unit cur, nxt; int ui = 0;
    if (!S.next(0, cur)) return;
    f32x4 acc[2][2][4][2];
#pragma unroll
    for (int a = 0; a < 2; ++a)
#pragma unroll
        for (int b = 0; b < 2; ++b)
#pragma unroll
            for (int m = 0; m < 4; ++m)
#pragma unroll
                for (int n = 0; n < 2; ++n) acc[a][b][m][n] = (f32x4){0.f, 0.f, 0.f, 0.f};
    bf16x8 At[4][2], B0[2][2], B1[2][2];
    const char* cA; const char* cB; S.src(g, cur, cA, cB, nt);
    PG8_STAGE(PG8_SB(0, 0), cB, voffB); PG8_STAGE(PG8_SB(0, 1), cB + hstepB, voffB); PG8_STAGE(PG8_SA(0, 0), cA, voffA); PG8_STAGE(PG8_SA(0, 1), cA + hstepA, voffA);
    if (wr == 1) PG8_BAR;
    PG8_WAIT_V(2); PG8_BAR;
    PG8_STAGE(PG8_SB(1, 0), cB + kstep, voffB); PG8_STAGE(PG8_SA(1, 0), cA + kstep, voffA); PG8_STAGE(PG8_SB(1, 1), cB + hstepB + kstep, voffB);
    PG8_WAIT_V(6); PG8_BAR;
    for (;;) {
        const bool has_next = S.next(ui + 1, nxt);
        const char* nA = cA; const char* nB = cB; int nnt = nt; if (has_next) S.src(g, nxt, nA, nB, nnt);
        for (int t = 0; t < nt; t += 2) {
            const bool last = (t == nt - 2);
            const char* a1 = cA + (size_t)(t + 1) * kstep;
            const char* a2 = last ? nA : cA + (size_t)(t + 2) * kstep; const char* b2 = last ? nB : cB + (size_t)(t + 2) * kstep;
            const char* a3 = a2 + kstep; const char* b3 = b2 + kstep;
            PG8_LDB(B0, 0, 0); PG8_LDB(B1, 0, 1); PG8_SCHED; PG8_LDA(At, 0, 0); PG8_STAGE(PG8_SA(1, 1), a1 + hstepA, voffA);
            PG8_WAIT_V(8); PG8_WAIT_L(0); PG8_BAR; PG8_MMA(0, 0, At, B0); PG8_MMA(0, 1, At, B1); PG8_BAR; PG8_SCHED;
            PG8_LDA(At, 0, 1); PG8_STAGE(PG8_SB(0, 0), b2, voffB); PG8_STAGE(PG8_SB(0, 1), b2 + hstepB, voffB); PG8_STAGE(PG8_SA(0, 0), a2, voffA);
            PG8_WAIT_V(8); PG8_WAIT_L(0); PG8_BAR; PG8_MMA(1, 0, At, B0); PG8_MMA(1, 1, At, B1); PG8_BAR; PG8_SCHED;
            PG8_LDB(B0, 1, 0); PG8_LDB(B1, 1, 1); PG8_SCHED; PG8_LDA(At, 1, 0); PG8_STAGE(PG8_SA(0, 1), a2 + hstepA, voffA);
            PG8_WAIT_V(8); PG8_WAIT_L(0); PG8_BAR; PG8_MMA(0, 0, At, B0); PG8_MMA(0, 1, At, B1); PG8_BAR; PG8_SCHED;
            PG8_LDA(At, 1, 1); PG8_STAGE(PG8_SB(1, 0), b3, voffB); PG8_STAGE(PG8_SB(1, 1), b3 + hstepB, voffB); PG8_STAGE(PG8_SA(1, 0), a3, voffA);
            PG8_WAIT_V(8); PG8_WAIT_L(0); PG8_BAR; PG8_MMA(1, 0, At, B0); PG8_MMA(1, 1, At, B1); PG8_BAR; PG8_SCHED;
        }
        if constexpr (ALIGN_EPI) { if (wr == 0) PG8_BAR; }
        E(acc, cur, wr, wc, fr, fq);
        if (!has_next) break;
#pragma unroll
        for (int a = 0; a < 2; ++a)
#pragma unroll
            for (int b = 0; b < 2; ++b)
#pragma unroll
                for (int m = 0; m < 4; ++m)
#pragma unroll
                    for (int n = 0; n < 2; ++n) acc[a][b][m][n] = (f32x4){0.f, 0.f, 0.f, 0.f};
        cur = nxt; cA = nA; cB = nB; nt = nnt; ++ui;
        if constexpr (ALIGN_EPI) { if (wr == 1) PG8_BAR; }
    }
    PG8_WAIT_V(0);
    if constexpr (!ALIGN_EPI) { if (wr == 0) PG8_BAR; }
    PG8_BAR;
#undef PG8_SA
#undef PG8_SB
#undef PG8_STAGE
#undef PG8_LDA
#undef PG8_LDB
#undef PG8_MMA
#undef PG8_WAIT_V
#undef PG8_WAIT_L
#undef PG8_BAR
#undef PG8_SCHED
}
}
namespace attn_body {
using bf16=__hip_bfloat16;
using bf16x8=__attribute__((ext_vector_type(8)))short;
using s16x4=__attribute__((ext_vector_type(4)))short;
using f32x16=__attribute__((ext_vector_type(16)))float;
using u32x4=__attribute__((ext_vector_type(4)))unsigned;
constexpr int D=64;
constexpr int NW=8,QBLK=32,QB=QBLK*NW,KVBLK=64;
constexpr int PP=2816, YP=1024;
__device__ __forceinline__ int crow(int r,int hi){return (r&3)+8*(r>>2)+4*hi;}
#define SBAR() __builtin_amdgcn_sched_barrier(0)
__device__ __forceinline__ void dmask(f32x16&p0,f32x16&p1,int kb,unsigned lim,int qrel,int hi){
  const float NEG=-INFINITY; const unsigned b0=(unsigned)(kb+4*hi-qrel+128);
  #pragma unroll
  for(int r=0;r<16;++r){const unsigned dd=b0+(unsigned)((r&3)+8*(r>>2)); if(dd>lim)p0[r]=NEG; if(dd+32u>lim)p1[r]=NEG;}
}

constexpr int NSLOT=3, SLOTB=8192;
constexpr int LDS_K=0, LDS_V=NSLOT*SLOTB, LDS_WS=2*NSLOT*SLOTB, LDS_OST=LDS_WS+NW*64*4, LDS_BYTES=LDS_OST+NW*4096;
constexpr float C2=0.125f*1.4426950408889634f;
__device__ __forceinline__ void glds16(const void*gsrc,unsigned lds_dst){unsigned keep;
  asm volatile("s_mov_b32 %0, m0\n\ts_mov_b32 m0, %2\n\ts_nop 0\n\tglobal_load_lds_dwordx4 %1, off\n\ts_mov_b32 m0, %0":"=&s"(keep):"v"(gsrc),"s"(lds_dst):"memory");}
__device__ __forceinline__ float siluf_(float x){ return x*__builtin_amdgcn_rcpf(1.0f+__builtin_amdgcn_exp2f(-1.4426950408889634f*x)); }
__device__ __forceinline__ float max3f(float a,float b,float c){float r;asm("v_max3_f32 %0, %1, %2, %3":"=v"(r):"v"(a),"v"(b),"v"(c));return r;}
__device__ __forceinline__ float max2f(float a,float b){float r;asm("v_max_f32_e32 %0, %1, %2":"=v"(r):"v"(a),"v"(b));return r;}
__device__ __forceinline__ float fadd_s(float a,float b){float r;asm("v_add_f32_e32 %0, %1, %2":"=v"(r):"v"(a),"v"(b));return r;}
__device__ __forceinline__ float fsub_s(float a,float b){float r;asm("v_sub_f32_e32 %0, %1, %2":"=v"(r):"v"(a),"v"(b));return r;}
typedef float f32x2_t __attribute__((ext_vector_type(2))); typedef __bf16 bf16x2_t __attribute__((ext_vector_type(2)));
__device__ __forceinline__ unsigned cvtpk_s(float lo,float hi){f32x2_t v={lo,hi};bf16x2_t b=__builtin_convertvector(v,bf16x2_t);return __builtin_bit_cast(unsigned,b);}
#define WAIT_BAR(N) asm volatile("s_waitcnt vmcnt(" #N ") lgkmcnt(0)\n\ts_barrier":::"memory")

__device__ __forceinline__ void qkt(f32x16&p0,f32x16&p1,const char*Kslot,const bf16x8*qr,const f32x16&negm,int r32,int hi){
  const char*kb=Kslot+hi*1024+r32*16;
  #pragma unroll
  for(int d0=0;d0<4;++d0){
    const bf16x8 b0=*reinterpret_cast<const bf16x8*>(kb+d0*2048);
    const bf16x8 b1=*reinterpret_cast<const bf16x8*>(kb+d0*2048+512);
    if(d0==0){p0=__builtin_amdgcn_mfma_f32_32x32x16_bf16(b0,qr[0],negm,0,0,0);p1=__builtin_amdgcn_mfma_f32_32x32x16_bf16(b1,qr[0],negm,0,0,0);}
    else{p0=__builtin_amdgcn_mfma_f32_32x32x16_bf16(b0,qr[d0],p0,0,0,0);p1=__builtin_amdgcn_mfma_f32_32x32x16_bf16(b1,qr[d0],p1,0,0,0);}}
}
typedef __attribute__((address_space(3))) const char* lds_cptr;
typedef short v4i16_t __attribute__((ext_vector_type(4)));
__device__ __forceinline__ void kload8(bf16x8*kf,lds_cptr kp){
  kf[0]=*(const __attribute__((address_space(3))) bf16x8*)(kp);      kf[1]=*(const __attribute__((address_space(3))) bf16x8*)(kp+512);
  kf[2]=*(const __attribute__((address_space(3))) bf16x8*)(kp+2048); kf[3]=*(const __attribute__((address_space(3))) bf16x8*)(kp+2560);
  kf[4]=*(const __attribute__((address_space(3))) bf16x8*)(kp+4096); kf[5]=*(const __attribute__((address_space(3))) bf16x8*)(kp+4608);
  kf[6]=*(const __attribute__((address_space(3))) bf16x8*)(kp+6144); kf[7]=*(const __attribute__((address_space(3))) bf16x8*)(kp+6656);
}
__device__ __forceinline__ void kload2(bf16x8*kf,lds_cptr kp,int j){ kf[2*j]=*(const __attribute__((address_space(3))) bf16x8*)(kp+j*2048); kf[2*j+1]=*(const __attribute__((address_space(3))) bf16x8*)(kp+j*2048+512); }
__device__ __forceinline__ s16x4 vtr(lds_cptr p){ return __builtin_bit_cast(s16x4,__builtin_amdgcn_ds_read_tr16_b64_v4i16((__attribute__((address_space(3))) v4i16_t*)p)); }
__device__ __forceinline__ float rowmax(const f32x16&p0,const f32x16&p1){
  float a=max3f(p0[0],p0[1],p1[0]),b=max3f(p0[2],p0[3],p1[1]);a=max3f(a,p1[2],p1[3]);
  #pragma unroll
  for(int r=4;r<16;r+=4){a=max3f(a,p0[r],p0[r+1]);b=max3f(b,p0[r+2],p0[r+3]);a=max3f(a,p1[r],p1[r+1]);b=max3f(b,p1[r+2],p1[r+3]);}
  const float m=max2f(a,b);
  auto rr=__builtin_amdgcn_permlane32_swap(__float_as_uint(m),__float_as_uint(m),false,false);
  return max2f(__uint_as_float(rr[0]),__uint_as_float(rr[1]));
}
__device__ __forceinline__ void pv(f32x16*o,int vb,bf16x8 pa0,bf16x8 pa1,bf16x8 pa2,bf16x8 pa3){
  #pragma unroll
  for(int d0=0;d0<2;++d0){s16x4 lo[4],hi[4];
    #pragma unroll
    for(int ks=0;ks<4;++ks){
      asm volatile("ds_read_b64_tr_b16 %0,%1 offset:%c2":"=&v"(lo[ks]):"v"(vb),"i"(d0*4096+ks*1024):"memory");
      asm volatile("ds_read_b64_tr_b16 %0,%1 offset:%c2":"=&v"(hi[ks]):"v"(vb),"i"(d0*4096+ks*1024+512):"memory");}
    asm volatile("s_waitcnt lgkmcnt(0)":::"memory");SBAR();
    #define PK(k) (bf16x8){lo[k][0],lo[k][1],lo[k][2],lo[k][3],hi[k][0],hi[k][1],hi[k][2],hi[k][3]}
    o[d0]=__builtin_amdgcn_mfma_f32_32x32x16_bf16(pa0,PK(0),o[d0],0,0,0);
    o[d0]=__builtin_amdgcn_mfma_f32_32x32x16_bf16(pa1,PK(1),o[d0],0,0,0);
    o[d0]=__builtin_amdgcn_mfma_f32_32x32x16_bf16(pa2,PK(2),o[d0],0,0,0);
    o[d0]=__builtin_amdgcn_mfma_f32_32x32x16_bf16(pa3,PK(3),o[d0],0,0,0);
    #undef PK
  }
}

#ifndef ATTN_STORE16
#define ATTN_STORE16(p,v) (*(u32x4*)(p)=(v))
#endif
template<int MODE,int THRL> __device__ __forceinline__ void attn_unit(const bf16*Pm,bf16*YB,int qrow0,int ctx0,int lat0,int off,int NT,int wq0,int qcol,int kcol,int vcol,int zcol,int ocol,float sinkl2,char*shm){
  int tid_=threadIdx.x; asm volatile("":"+v"(tid_)); const int tid=tid_,lane=tid&63,r32=lane&31,hi=lane>>5; const int wid=__builtin_amdgcn_readfirstlane(tid>>6);
  const bf16*Qw=Pm+(long)(qrow0+wid*QBLK)*PP+qcol;
  const unsigned lds0=(unsigned)(uintptr_t)shm;
  float*wsf=(float*)(shm+LDS_WS)+wid*64;
  const bf16*ksrc=Pm+kcol+(long)lane*PP+wid*8;
  const bf16*vsrc=Pm+vcol+(long)(16*(wid&3)+(lane>>2))*PP+(wid>>2)*32+(lane&3)*8;
  const unsigned kdst=lds0+LDS_K+wid*1024, vdst=lds0+LDS_V+wid*1024;
  #define TROW(t) (((t)<4)?(ctx0+64*(t)):(lat0+64*((t)-4+off)))
  #define DMA_K(t,slot) glds16(ksrc+(long)TROW(t)*PP,(unsigned)__builtin_amdgcn_readfirstlane(kdst+(slot)))
  #define DMA_V(t,slot) glds16(vsrc+(long)TROW(t)*PP,(unsigned)__builtin_amdgcn_readfirstlane(vdst+(slot)))
  const int vb0=(int)(lds0+LDS_V)+((lane>>4)&1)*32+(lane&3)*8+(4*hi+((lane&15)>>2))*64;
  const char*Kbase=shm+LDS_K; bf16x8 kf[8];
  const lds_cptr shm3=(lds_cptr)shm; const lds_cptr kp0=shm3+LDS_K+hi*1024+r32*16; const lds_cptr vp0=shm3+LDS_V+((lane>>4)&1)*32+(lane&3)*8+(4*hi+((lane&15)>>2))*64;
  DMA_K(0,0);DMA_V(0,0);DMA_K(1,SLOTB);
  bf16x8 qr[4];
  #pragma unroll
  for(int d0=0;d0<4;++d0)qr[d0]=*reinterpret_cast<const bf16x8*>(&Qw[(long)r32*PP+d0*16+hi*8]);
  float mhat=0.f,l_reg=0.f;f32x16 o[2];o[0]=f32x16{};o[1]=f32x16{};f32x16 negm=f32x16{}; if(MODE==0){asm volatile("":"+v"(negm));}
  const int qrel=wid*QBLK+r32;
  #define CMASK(P0,P1,t) do{ if(MODE==1){ dmask(P0,P1,64*((t)-4)-wq0,((t)>=4)?256u:~0u,qrel,hi); } }while(0)
  bool resc=false;
  #define START(P0,P1) do{ const float rm=rowmax(P0,P1); resc=false; \
    { const float dl=rm; mhat=fadd_s(mhat,dl); \
      _Pragma("unroll") for(int r=0;r<16;++r){P0[r]=fsub_s(P0[r],dl);P1[r]=fsub_s(P1[r],dl);} \
      if(MODE==0){ _Pragma("unroll") for(int r=0;r<16;++r)negm[r]=-mhat; asm volatile("":"+v"(negm)); } } \
    _Pragma("unroll") for(int r=0;r<16;++r)P0[r]=__builtin_amdgcn_exp2f(P0[r]); }while(0)
  #define RESC() do{ if(resc){ asm volatile("s_waitcnt lgkmcnt(0)":::"memory"); \
      _Pragma("unroll") for(int d_=0;d_<2;++d_) _Pragma("unroll") for(int r=0;r<16;++r)o[d_][r]*=wsf[crow(r,hi)]; } }while(0)
  f32x16 pA0,pA1,pB0,pB1;
  int sl_prev=0,sl_cur=0,sl_next=SLOTB;
  #define ROT() do{sl_prev=sl_cur;sl_cur=sl_next;sl_next=(sl_next==(NSLOT-1)*SLOTB)?0:sl_next+SLOTB;}while(0)
  DMA_K(2,2*SLOTB);
  WAIT_BAR(3);
  qkt(pA0,pA1,Kbase,qr,negm,r32,hi);asm volatile("s_nop 15\n\ts_nop 7":"+v"(pA0),"+v"(pA1));CMASK(pA0,pA1,0);
  START(pA0,pA1);
  _Pragma("unroll") for(int r=0;r<16;++r)pA1[r]=__builtin_amdgcn_exp2f(pA1[r]);
  WAIT_BAR(0);
  DMA_K(3,0);DMA_V(1,SLOTB);
  ROT();
  kload8(kf,kp0+sl_cur);
  WAIT_BAR(2);
  s16x4 vlo[8],vhi[8]; u32x4 pw0,pw1,pw2,pw3;
  #define PKW(P,B) cvtpk_s(P[B],P[B+1])
  #define PAF(k) __builtin_bit_cast(bf16x8,pw##k)
  #define VFR(i) (bf16x8){vlo[i][0],vlo[i][1],vlo[i][2],vlo[i][3],vhi[i][0],vhi[i][1],vhi[i][2],vhi[i][3]}
  #define PIN(x) asm volatile("":"+v"(x))
  #define MX3(a,b,c) __builtin_fmaxf(__builtin_fmaxf((a),(b)),(c))
  #define GAPA(MF,A0,A1,A2,A3,W0,W1,PW) do{ MF; sacc+=A0; sacc+=A1; sacc+=A2; sacc+=A3; PIN(sacc); W0; W1; PIN(PW); SBAR(); }while(0)
  #define EX(v) __builtin_amdgcn_exp2f(v)
  #define GAPB(MF,X,B) do{ MF; X[B]=EX(X[B]); X[B+1]=EX(X[B+1]); X[B+2]=EX(X[B+2]); X[B+3]=EX(X[B+3]); PIN(X); SBAR(); }while(0)
  #define VRD(i) do{ vlo[i]=vtr(vp_+(((i)>>2)*4096+((i)&3)*1024)); vhi[i]=vtr(vp_+(((i)>>2)*4096+((i)&3)*1024+512)); }while(0)
  #define KRD(G,j) do{ if(G){ kload2(kf,kp0+sl_next,j); SBAR(); } }while(0)
  #define STEP(C0,C1,P0,P1,t,GK,GV,GL,MX) do{ SBAR(); \
    const lds_cptr vp_=vp0+sl_prev; \
    VRD(0); SBAR(); float sacc=(P0[0]+P0[1]); \
    GAPA(C0=__builtin_amdgcn_mfma_f32_32x32x16_bf16(kf[0],qr[0],negm,0,0,0), P0[2],P0[3],P0[4],P0[5],     pw0[0]=PKW(P0,0), pw0[1]=PKW(P0,2), pw0); \
    VRD(4); SBAR(); GAPA(C1=__builtin_amdgcn_mfma_f32_32x32x16_bf16(kf[1],qr[0],negm,0,0,0), P0[6],P0[7],P0[8],P0[9],     pw0[2]=PKW(P0,4), pw0[3]=PKW(P0,6), pw0); \
    VRD(1); SBAR(); GAPA(C0=__builtin_amdgcn_mfma_f32_32x32x16_bf16(kf[2],qr[1],C0,0,0,0),   P0[10],P0[11],P0[12],P0[13], pw1[0]=PKW(P0,8), pw1[1]=PKW(P0,10), pw1); \
    VRD(5); SBAR(); GAPA(C1=__builtin_amdgcn_mfma_f32_32x32x16_bf16(kf[3],qr[1],C1,0,0,0),   P0[14],P0[15],P1[0],P1[1],   pw1[2]=PKW(P0,12),pw1[3]=PKW(P0,14), pw1); \
    VRD(2); SBAR(); GAPA(C0=__builtin_amdgcn_mfma_f32_32x32x16_bf16(kf[4],qr[2],C0,0,0,0),   P1[2],P1[3],P1[4],P1[5],     pw2[0]=PKW(P1,0), pw2[1]=PKW(P1,2), pw2); \
    VRD(6); SBAR(); GAPA(C1=__builtin_amdgcn_mfma_f32_32x32x16_bf16(kf[5],qr[2],C1,0,0,0),   P1[6],P1[7],P1[8],P1[9],     pw2[2]=PKW(P1,4), pw2[3]=PKW(P1,6), pw2); \
    VRD(3); SBAR(); GAPA(C0=__builtin_amdgcn_mfma_f32_32x32x16_bf16(kf[6],qr[3],C0,0,0,0),   P1[10],P1[11],P1[12],P1[13], pw3[0]=PKW(P1,8), pw3[1]=PKW(P1,10), pw3); \
    VRD(7); SBAR(); GAPA(C1=__builtin_amdgcn_mfma_f32_32x32x16_bf16(kf[7],qr[3],C1,0,0,0),   P1[14],P1[15],0.f,0.f,       pw3[2]=PKW(P1,12),pw3[3]=PKW(P1,14), pw3); \
    l_reg+=sacc; \
    if(GK){DMA_K((t)+3,sl_cur);} if(GV){DMA_V((t)+1,sl_next);} \
    CMASK(C0,C1,t); \
    resc=false; if(MX){ float a=MX3(C0[0],C0[1],C1[0]),b=MX3(C0[2],C0[3],C1[1]); a=MX3(a,C1[2],C1[3]); \
      _Pragma("unroll") for(int r=4;r<16;r+=4){a=MX3(a,C0[r],C0[r+1]);b=MX3(b,C0[r+2],C0[r+3]);a=MX3(a,C1[r],C1[r+1]);b=MX3(b,C1[r+2],C1[r+3]);} \
      float rm=__builtin_fmaxf(a,b); { auto rr=__builtin_amdgcn_permlane32_swap(__float_as_uint(rm),__float_as_uint(rm),false,false); rm=__builtin_fmaxf(__uint_as_float(rr[0]),__uint_as_float(rr[1])); } \
      resc=false; if(MODE==1) rm-=mhat; \
      if(__builtin_expect(__any(rm>(float)THRL),0)){ const float dl=__builtin_fmaxf(rm,0.f); mhat+=dl; \
        if(MODE==0){ _Pragma("unroll") for(int r=0;r<16;++r){C0[r]-=dl;C1[r]-=dl;} \
          _Pragma("unroll") for(int r=0;r<16;++r)negm[r]=-mhat; asm volatile("":"+v"(negm)); } \
        const float f=__builtin_amdgcn_exp2f(-dl); l_reg*=f; if(hi==0)wsf[r32]=f; resc=true; } \
      if(MODE==1){ _Pragma("unroll") for(int r=0;r<16;++r){C0[r]-=mhat;C1[r]-=mhat;} } } \
    SBAR(); \
    GAPB(o[0]=__builtin_amdgcn_mfma_f32_32x32x16_bf16(PAF(0),VFR(0),o[0],0,0,0), C0,0); \
    GAPB(o[1]=__builtin_amdgcn_mfma_f32_32x32x16_bf16(PAF(0),VFR(4),o[1],0,0,0), C0,4); \
    KRD(GL,0); GAPB(o[0]=__builtin_amdgcn_mfma_f32_32x32x16_bf16(PAF(1),VFR(1),o[0],0,0,0), C0,8); \
    KRD(GL,1); GAPB(o[1]=__builtin_amdgcn_mfma_f32_32x32x16_bf16(PAF(1),VFR(5),o[1],0,0,0), C0,12); \
    KRD(GL,2); GAPB(o[0]=__builtin_amdgcn_mfma_f32_32x32x16_bf16(PAF(2),VFR(2),o[0],0,0,0), C1,0); \
    KRD(GL,3); GAPB(o[1]=__builtin_amdgcn_mfma_f32_32x32x16_bf16(PAF(2),VFR(6),o[1],0,0,0), C1,4); \
    GAPB(o[0]=__builtin_amdgcn_mfma_f32_32x32x16_bf16(PAF(3),VFR(3),o[0],0,0,0), C1,8); \
    GAPB(o[1]=__builtin_amdgcn_mfma_f32_32x32x16_bf16(PAF(3),VFR(7),o[1],0,0,0), C1,12); \
    }while(0)
  int t=1;
  if(MODE==0) for(;t+7<NT;t+=4){
    STEP(pB0,pB1,pA0,pA1,t,true,true,true,true);      WAIT_BAR(2); RESC(); ROT();
    STEP(pA0,pA1,pB0,pB1,t+1,true,true,true,false);   WAIT_BAR(2); RESC(); ROT();
    STEP(pB0,pB1,pA0,pA1,t+2,true,true,true,false);   WAIT_BAR(2); RESC(); ROT();
    STEP(pA0,pA1,pB0,pB1,t+3,true,true,true,false);   WAIT_BAR(2); RESC(); ROT();
  }
  if(MODE==0) for(;t+5<NT;t+=2){
    STEP(pB0,pB1,pA0,pA1,t,true,true,true,true);     WAIT_BAR(2); RESC(); ROT();
    STEP(pA0,pA1,pB0,pB1,t+1,true,true,true,false);   WAIT_BAR(2); RESC(); ROT();
  }
  #define ENDW(tt) do{ if((tt)+3<NT){WAIT_BAR(2);} else if((tt)+2<NT){WAIT_BAR(1);} else {WAIT_BAR(0);} }while(0)
  for(;t+1<NT;t+=2){
    STEP(pB0,pB1,pA0,pA1,t,(t+3<NT),(t+1<NT),(t+1<NT),true);       ENDW(t);   RESC(); ROT();
    STEP(pA0,pA1,pB0,pB1,t+1,(t+4<NT),(t+2<NT),(t+2<NT),true);     ENDW(t+1); RESC(); ROT();
  }
  STEP(pB0,pB1,pA0,pA1,NT-1,false,false,false,true); RESC();
  { float sacc=pB0[0]+pB0[1]; _Pragma("unroll") for(int r=2;r<16;++r)sacc+=pB0[r]; _Pragma("unroll") for(int r=0;r<16;++r)sacc+=pB1[r]; l_reg+=sacc;
    pw0=(u32x4){PKW(pB0,0),PKW(pB0,2),PKW(pB0,4),PKW(pB0,6)};pw1=(u32x4){PKW(pB0,8),PKW(pB0,10),PKW(pB0,12),PKW(pB0,14)};pw2=(u32x4){PKW(pB1,0),PKW(pB1,2),PKW(pB1,4),PKW(pB1,6)};pw3=(u32x4){PKW(pB1,8),PKW(pB1,10),PKW(pB1,12),PKW(pB1,14)};
    SBAR(); pv(o,vb0+sl_cur,PAF(0),PAF(1),PAF(2),PAF(3)); }
  #undef PKW
  #undef PAF
  #undef VFR
  #undef PIN
  #undef MX3
  #undef GAPA
  #undef GAPB
  #undef EX
  #undef VRD
  #undef KRD
  #undef STEP
  #undef ENDW
  {auto rr=__builtin_amdgcn_permlane32_swap(__float_as_uint(l_reg),__float_as_uint(l_reg),false,false);l_reg=__uint_as_float(rr[0])+__uint_as_float(rr[1]);}
  if(MODE==1){ l_reg+=__builtin_amdgcn_exp2f(sinkl2-mhat); }
  if(hi==0)wsf[32+r32]=l_reg;asm volatile("s_waitcnt lgkmcnt(0)":::"memory");
  float rli[16];
  #pragma unroll
  for(int r=0;r<16;++r)rli[r]=__builtin_amdgcn_rcpf(wsf[32+crow(r,hi)]);
  bf16*Ow=YB+(long)(qrow0+wid*QBLK)*YP+ocol; const bf16*Zw=Pm+(long)(qrow0+wid*QBLK)*PP+zcol;
  { bf16*stg=(bf16*)(shm+LDS_OST)+wid*2048;
    #pragma unroll
    for(int r=0;r<16;++r){const int orow=crow(r,hi);
      #pragma unroll
      for(int d0=0;d0<2;++d0)stg[orow*64+d0*32+r32]=__float2bfloat16(o[d0][r]*rli[r]);}
    asm volatile("s_waitcnt lgkmcnt(0)":::"memory");
    #pragma unroll
    for(int i=0;i<4;++i){const int row=i*8+(lane>>3),ch=lane&7; const u32x4 v=*(const u32x4*)(stg+row*64+ch*8); const u32x4 z=*(const u32x4*)(Zw+(long)row*PP+ch*8); u32x4 w;
      #define GATE2(vv,zz) cvtpk_s(__uint_as_float((vv)<<16)*siluf_(__uint_as_float((zz)<<16)),__uint_as_float((vv)&0xffff0000u)*siluf_(__uint_as_float((zz)&0xffff0000u)))
      w.x=GATE2(v.x,z.x); w.y=GATE2(v.y,z.y); w.z=GATE2(v.z,z.z); w.w=GATE2(v.w,z.w);
      #undef GATE2
      *(u32x4*)(Ow+(long)row*YP+ch*8)=w;} }
  asm volatile("s_waitcnt lgkmcnt(0)\n\ts_barrier":::"memory");
  #undef DMA_K
  #undef DMA_V
  #undef CMASK
  #undef START
  #undef RESC
  #undef ROT
  #undef TROW
}
#undef SBAR
#undef WAIT_BAR
}

constexpr int NWAVES = 8;
constexpr int DM = 1024, SEQ = 8192, NCTX = 256, NB = 2;
constexpr int M_LAT = NB * SEQ, M_CTX = NB * NCTX, M_ALL = M_LAT + M_CTX;
constexpr int PW = 2816;
constexpr float RMS_EPS = 1e-6f;
#ifndef WPITCH
#define WPITCH 1024
#endif
constexpr float QSCALE = 0.125f * 1.4426950408889634f;
constexpr int C_AQ = 0, C_AK = 256, C_AV = 384, C_AZ = 512, C_DQ = 768, C_DK = 1024, C_DV = 1152, C_DZ = 1280, C_BF = 1536, C_BZ = 1792, C_CU = 2048, C_CV = 2304, C_CZ = 2560;

constexpr size_t MiB = 1u << 20;
constexpr size_t WS_CTL = 0, CTL_ZERO_BYTES = 1 * MiB;
constexpr size_t WS_MOD = 1 * MiB;
constexpr size_t WS_TAB = 2 * MiB;
constexpr size_t TAB_MA = 0, TAB_128 = 131072, TAB_64 = 229376, TAB_256 = 245760, TAB_WSP = 507904, TAB_ONES = 786432, TAB_BIASB = 1048576;
constexpr size_t WS_WIN = 4 * MiB, WS_WM = 16 * MiB, WS_WBR = 32 * MiB, WS_WOUT = 36 * MiB;
constexpr size_t WS_XC1 = 40 * MiB;
constexpr size_t WS_H = 42 * MiB, WS_YB = 75 * MiB, WS_T1 = 108 * MiB, WS_P = 124 * MiB;
constexpr size_t WS_GT = WS_P, WS_MG = WS_P + 40 * MiB;
constexpr size_t WS_MGC = 216 * MiB;
constexpr size_t WS_GTC = 218 * MiB;
constexpr size_t WS_END = 222 * MiB;
constexpr int CW_BAR = 4096;

constexpr int RING_BYTES = 147456, LDSCTL_OFF = RING_BYTES, MISC_OFF = LDSCTL_OFF + 320, LDS_BYTES = RING_BYTES + 1024;

#define GAS __attribute__((address_space(1)))
#define LAS __attribute__((address_space(3)))
typedef unsigned short bf16;
typedef unsigned v4u __attribute__((ext_vector_type(4)));
typedef unsigned v2u __attribute__((ext_vector_type(2)));
typedef float f32x4 __attribute__((ext_vector_type(4)));
typedef float f32x16 __attribute__((ext_vector_type(16)));
typedef short bf16x8 __attribute__((ext_vector_type(8)));
typedef GAS unsigned gu32;
#define RLX_AGENT __ATOMIC_RELAXED, __HIP_MEMORY_SCOPE_AGENT
#define LDS_WAIT() asm volatile("s_waitcnt lgkmcnt(0)" ::: "memory")
#define MFMA32(a, b, c) __builtin_amdgcn_mfma_f32_32x32x16_bf16((a), (b), (c), 0, 0, 0)
#define DI __device__ __forceinline__
DI unsigned f2bf(float f) { unsigned u = __builtin_bit_cast(unsigned, f); return (u + 0x7fffu + ((u >> 16) & 1u)) >> 16; }
DI unsigned pk2(float lo, float hi) { return f2bf(lo) | (f2bf(hi) << 16); }
DI float bf2f(bf16 v) { return __uint_as_float((unsigned)v << 16); }
DI float wlo(unsigned w) { return __uint_as_float(w << 16); }
DI float whi(unsigned w) { return __uint_as_float(w & 0xffff0000u); }
DI int crow(int reg, int h) { return (reg & 3) + 8 * (reg >> 2) + 4 * h; }
DI int krow(int s, int h, int j) { return 16 * s + 8 * (j >> 2) + 4 * h + (j & 3); }
DI float siluf(float x) { return x * __builtin_amdgcn_rcpf(1.0f + __builtin_amdgcn_exp2f(-1.4426950408889634f * x)); }
DI float geluf(float v) {
    const float av = __builtin_fabsf(v), d = av * 0.2316418882f + 1.0f, t = __builtin_amdgcn_rcpf(d);
    float q = t * 0.5307027145f + (-0.7265760135f); q = q * t + 0.7107068705f; q = q * t + (-0.142248368f); q = q * t + 0.127414796f; q = q * t;
    const float e = __builtin_amdgcn_exp2f((v * v) * (-0.72134752044f)), m = v * (q * e), r = v - m;
    return v < 0.f ? m : r;
}
typedef float f32x2_t __attribute__((ext_vector_type(2))); typedef __bf16 bf16x2_t __attribute__((ext_vector_type(2)));
DI unsigned cvtpk(float lo, float hi) { f32x2_t v = {lo, hi}; bf16x2_t b = __builtin_convertvector(v, bf16x2_t); return __builtin_bit_cast(unsigned, b); }
DI bf16x8 pack_step(const f32x16& x, int s) {
    v4u p; p.x = cvtpk(x[8 * s], x[8 * s + 1]); p.y = cvtpk(x[8 * s + 2], x[8 * s + 3]); p.z = cvtpk(x[8 * s + 4], x[8 * s + 5]); p.w = cvtpk(x[8 * s + 6], x[8 * s + 7]);
    return __builtin_bit_cast(bf16x8, p);
}
DI float shx(float v, int o, int lane) { return __int_as_float(__builtin_amdgcn_ds_bpermute((lane ^ o) << 2, __float_as_int(v))); }
DI float wave_sum(float v, int lane) {
#pragma unroll
    for (int o = 1; o < 64; o <<= 1) v += shx(v, o, lane);
    return v;
}

#define XB_TMO      128
#define XB_XCNT(j)  (256  + 64 * (j))
#define XB_XSUB(j)  (1280 + 64 * (j))
#define XB_XGEN(j)  (2304 + 64 * (j))
#define XB_TOP      3328
#define XB_TOPGEN   3392
#define XCD_BAR_WORDS 3456
#define XB_SPIN_CAP (1u << 22)
DI unsigned xb_ld(unsigned* p)              { return __hip_atomic_load(p, __ATOMIC_RELAXED, __HIP_MEMORY_SCOPE_AGENT); }
DI unsigned xb_add(unsigned* p, unsigned v) { return __hip_atomic_fetch_add(p, v, __ATOMIC_RELAXED, __HIP_MEMORY_SCOPE_AGENT); }
DI unsigned xb_xcc_id() { return (unsigned)__builtin_amdgcn_s_getreg((3 << 11) | 20) & 0xFu; }
#define XB_SPIN(cond, bar) do { unsigned _sp = 0; while (cond) { __builtin_amdgcn_s_sleep(1); \
    if ((++_sp & 255u) == 0u) { if (xb_ld(&(bar)[XB_TMO])) break; if (_sp > XB_SPIN_CAP) { atomicAdd(&(bar)[XB_TMO], 1u); break; } } } } while (0)
struct XcdBarrier { unsigned* bar; unsigned x; volatile LAS unsigned* st; };
DI XcdBarrier xcd_barrier_post(unsigned* bar, volatile LAS unsigned* st) {
    XcdBarrier b; b.bar = bar; b.x = xb_xcc_id(); b.st = st;
    if (threadIdx.x == 0) (void)xb_add(&bar[XB_XCNT(b.x)], 1u);
    return b;
}
DI void xcd_barrier_complete(unsigned* bar, unsigned x, unsigned& nloc, unsigned& nx) {
    const unsigned G = gridDim.x * gridDim.y * gridDim.z;
    unsigned sum, cnt, mine, sp = 0u;
    for (;;) {
        sum = 0u; cnt = 0u; mine = 0u;
#pragma unroll
        for (unsigned j = 0; j < 16; ++j) { const unsigned c = xb_ld(&bar[XB_XCNT(j)]); sum += c; cnt += (c > 0u) ? 1u : 0u; mine = (j == x) ? c : mine; }
        if (sum == G) break;
        __builtin_amdgcn_s_sleep(1);
        if ((++sp & 255u) == 0u) { if (xb_ld(&bar[XB_TMO])) break; if (sp > XB_SPIN_CAP) { atomicAdd(&bar[XB_TMO], 1u); break; } }
    }
    nloc = mine > 0u ? mine : 1u; nx = cnt > 0u ? cnt : 1u;
}
DI void xcd_barrier(const XcdBarrier& b) {
    asm volatile("s_waitcnt vmcnt(0)" ::: "memory");
    __syncthreads();
    if (threadIdx.x == 0) {
        unsigned* bar = b.bar;
        __builtin_amdgcn_s_waitcnt(0);
        __builtin_amdgcn_fence(__ATOMIC_ACQUIRE, "agent");
        unsigned nloc = b.st[0], nx = b.st[1];
        if (nloc == 0u) { xcd_barrier_complete(bar, b.x, nloc, nx); b.st[0] = nloc; b.st[1] = nx; }
        const unsigned old = xb_add(&bar[XB_XSUB(b.x)], 1u);
        const unsigned gen = old / nloc;
        if (old + 1u == (gen + 1u) * nloc) {
            __builtin_amdgcn_fence(__ATOMIC_RELEASE, "agent");
            asm volatile("s_waitcnt vmcnt(0)" ::: "memory");
            const unsigned og = xb_add(&bar[XB_TOP], 1u);
            const unsigned tg = og / nx;
            if (og + 1u == (tg + 1u) * nx) xb_add(&bar[XB_TOPGEN], 1u);
            else XB_SPIN(xb_ld(&bar[XB_TOPGEN]) == tg, bar);
            xb_add(&bar[XB_XGEN(b.x)], 1u);
            asm volatile("s_waitcnt vmcnt(0)" ::: "memory");
        } else {
            XB_SPIN(xb_ld(&bar[XB_XGEN(b.x)]) == gen, bar);
            asm volatile("s_waitcnt vmcnt(0)" ::: "memory");
        }
    }
    __syncthreads();
}

struct Frame {
    LAS unsigned char* lds;
    int tid, lane, wave, vcu, G;
};

DI void p0_transpose_item(const float* W, int N, bf16* WT, int ldt, int row_off, int col_off, LAS float* scr, int item, int lane) {
    const int nblk = N / 32, kb = item / nblk, nb = item % nblk, k0 = 64 * kb, n0 = 32 * nb;
#pragma unroll 8
    for (int i = 0; i < 32; ++i) { const int kk = 2 * i + (lane >> 5); scr[kk * 33 + (lane & 31)] = W[(size_t)(k0 + kk) * N + n0 + (lane & 31)]; }
    LDS_WAIT(); asm volatile("" ::: "memory");
    const int c = lane & 7;
#pragma unroll
    for (int j = 0; j < 4; ++j) { const int n = (lane >> 3) + 8 * j; const LAS float* s = scr + (8 * c) * 33 + n;
        v4u o; o.x = pk2(s[0 * 33], s[1 * 33]); o.y = pk2(s[2 * 33], s[3 * 33]); o.z = pk2(s[4 * 33], s[5 * 33]); o.w = pk2(s[6 * 33], s[7 * 33]);
        *(GAS v4u*)(WT + (size_t)(row_off + n0 + n) * ldt + col_off + k0 + 8 * c) = o; }
    LDS_WAIT(); asm volatile("" ::: "memory");
}

struct Args { const float* in[20]; float* out; unsigned char* ws; };
enum { I_X = 0, I_C, I_CTX, I_CCTX, I_NORMW, I_WADA, I_BADA, I_WIN, I_QNA, I_KNA, I_QND, I_KND, I_SINK, I_WFNET, I_WSP, I_BSP, I_WBR, I_WMERGE, I_BMERGE, I_WOUT };

DI void p0_prologue(const Frame& F, const Args& a) {
    unsigned char* ws = a.ws;
    for (int u = F.vcu; u < 96; u += F.G) {
        const int l = u / 48, j0 = 64 * (u % 48);
        LAS float* sl = (LAS float*)F.lds; LAS float* red = sl + 3072;
        for (int i = F.tid; i < 3072; i += 512) { const int v = i >> 10, k = i & 1023; const float cv = (v < 2) ? a.in[I_C][v * 1024 + k] : a.in[I_CCTX][k]; sl[i] = siluf(cv); }
        __syncthreads();
        float a0 = 0.f, a1 = 0.f, a2 = 0.f;
        const float* wp = a.in[I_WADA] + (size_t)l * 1024 * 3072 + (size_t)(128 * F.wave) * 3072 + j0 + F.lane;
#pragma unroll 32
        for (int kk = 0; kk < 128; ++kk) { const float w = wp[(size_t)kk * 3072]; const int k = 128 * F.wave + kk; a0 += sl[k] * w; a1 += sl[1024 + k] * w; a2 += sl[2048 + k] * w; }
        red[(F.wave * 3 + 0) * 64 + F.lane] = a0; red[(F.wave * 3 + 1) * 64 + F.lane] = a1; red[(F.wave * 3 + 2) * 64 + F.lane] = a2;
        __syncthreads();
        if (F.tid < 192) { const int v = F.tid >> 6, jj = F.tid & 63; float s = a.in[I_BADA][l * 3072 + j0 + jj];
#pragma unroll
            for (int w = 0; w < 8; ++w) s += red[(w * 3 + v) * 64 + jj];
            ((float*)(ws + WS_MOD))[(l * 3 + v) * 3072 + j0 + jj] = s; }
        __syncthreads();
    }
    {
        LAS float* scr = (LAS float*)(F.lds + F.wave * 16384);
        const int gw = F.vcu * NWAVES + F.wave, NGW = F.G * NWAVES;
        constexpr int I_IN = 16 * 88, I_M = 16 * 128, I_O = 16 * 32, I_B = 4 * 32, PER_L = I_IN + I_M + I_O + 4 * I_B;
        for (int it = gw; it < 2 * PER_L; it += NGW) {
            const int l = it / PER_L; int r = it % PER_L;
            if (r < I_IN) { p0_transpose_item(a.in[I_WIN] + (size_t)l * 1024 * PW, PW, (bf16*)(ws + WS_WIN) + (size_t)l * PW * WPITCH, WPITCH, 0, 0, scr, r, F.lane); continue; } r -= I_IN;
            if (r < I_M) { p0_transpose_item(a.in[I_WMERGE] + (size_t)l * 1024 * 4096, 4096, (bf16*)(ws + WS_WM) + (size_t)l * 4096 * 1024, 1024, 0, 0, scr, r, F.lane); continue; } r -= I_M;
            if (r < I_O) { p0_transpose_item(a.in[I_WOUT] + (size_t)l * 1024 * 1024, 1024, (bf16*)(ws + WS_WOUT) + (size_t)l * 1024 * 1024, 1024, 0, 0, scr, r, F.lane); continue; } r -= I_O;
            { const int br = r / I_B; r -= br * I_B;
              p0_transpose_item(a.in[I_WBR] + ((size_t)l * 4 + br) * 256 * 1024, 1024, (bf16*)(ws + WS_WBR) + (size_t)l * 1024 * 1024, 1024, 0, 256 * br, scr, r, F.lane); }
        }
    }
    {
        const int gt = F.vcu * 512 + F.tid, NGT = F.G * 512;
        bf16* tab = (bf16*)(ws + WS_TAB);
        for (int e = gt; e < 65536; e += NGT) {
            const int l = e >> 15, g = (e >> 13) & 3, col = (e >> 6) & 127, c = e & 63, d = col & 63;
            const float* wf = a.in[I_WFNET] + ((size_t)(l * 4 + g) * 64) * 64 + d; float s = 0.f;
            for (int j = 0; j < 64; ++j) { const float rev = (float)((c * j) & 63) * (1.0f / 64.0f); const float tw = (col < 64) ? __builtin_amdgcn_cosf(rev) : -__builtin_amdgcn_sinf(rev); s += tw * wf[j * 64]; }
            tab[TAB_MA / 2 + e] = (bf16)f2bf(s);
        }
        for (int e = gt; e < 49152; e += NGT) {
            const int mat = e / 16384, rem = e % 16384, k1b = rem >> 12, nb = (rem >> 10) & 3, s = (rem >> 9) & 1, ln = (rem >> 3) & 63, j = rem & 7;
            const int n1 = 32 * nb + krow(s, ln >> 5, j), k1 = 32 * k1b + (ln & 31); const float rev = (float)((n1 * k1) & 127) * (1.0f / 128.0f);
            const float v = (mat == 0) ? __builtin_amdgcn_cosf(rev) : (mat == 1) ? __builtin_amdgcn_sinf(rev) : -__builtin_amdgcn_sinf(rev);
            tab[TAB_128 / 2 + e] = (bf16)f2bf(v);
        }
        for (int e = gt; e < 8192; e += NGT) {
            const int mat = e >> 12, k2 = (e >> 6) & 63, n2 = e & 63; const float rev = (float)((k2 * n2) & 63) * (1.0f / 64.0f);
            tab[TAB_64 / 2 + e] = (bf16)f2bf(mat == 0 ? __builtin_amdgcn_cosf(rev) : __builtin_amdgcn_sinf(rev));
        }
        for (int e = gt; e < 131072; e += NGT) {
            const int mat = e >> 16, rem = e & 65535, kb = rem >> 13, nb = (rem >> 10) & 7, s = (rem >> 9) & 1, ln = (rem >> 3) & 63, j = rem & 7;
            const int n = 32 * nb + krow(s, ln >> 5, j), k = 32 * kb + (ln & 31); const float rev = (float)((n * k) & 255) * (1.0f / 256.0f);
            tab[TAB_256 / 2 + e] = (bf16)f2bf(mat == 0 ? __builtin_amdgcn_cosf(rev) : __builtin_amdgcn_sinf(rev));
        }
        for (int e = gt; e < 131072; e += NGT) tab[TAB_WSP / 2 + e] = (bf16)f2bf(a.in[I_WSP][e]);
        for (int e = gt; e < M_CTX * 1024 / 4; e += NGT) { ((f32x4*)(ws + WS_XC1))[e] = ((const f32x4*)a.in[I_CTX])[e]; ((f32x4*)(ws + WS_MGC))[e] = (f32x4){0.f, 0.f, 0.f, 0.f}; }
        for (int e = gt; e < 4096; e += NGT) tab[TAB_ONES / 2 + e] = (bf16)(((e & 31) == 0) ? 0x3f80 : 0);
        for (int e = gt; e < 262144; e += NGT) tab[TAB_BIASB / 2 + e] = (bf16)(((e & 31) == 0) ? f2bf(a.in[I_BMERGE][e >> 5]) : 0u);
    }
}

DI void p1_modrms(const Frame& F, const Args& a, int l, const float* xlat, const float* xctx, int with_ctx) {
    const float* mod = (const float*)(a.ws + WS_MOD) + (size_t)l * 3 * 3072;
    const float* nw = a.in[I_NORMW] + l * 1024;
    bf16* H = (bf16*)(a.ws + WS_H);
    const int gw = F.vcu * NWAVES + F.wave, NGW = F.G * NWAVES;
    const int nrows = with_ctx ? M_ALL : M_LAT;
    int vcur = -1; f32x4 av[4], bv[4];
    for (int row = gw; row < nrows; row += NGW) {
        const int v = row < SEQ ? 0 : (row < M_LAT ? 1 : 2);
        if (v != vcur) { vcur = v;
#pragma unroll
            for (int j = 0; j < 4; ++j) { const int c = 4 * (F.lane + 64 * j); const f32x4 w = *(const f32x4*)(nw + c), sc = *(const f32x4*)(mod + v * 3072 + 1024 + c);
                av[j] = w * (sc + 1.0f); bv[j] = *(const f32x4*)(mod + v * 3072 + c); } }
        const float* xr = (row < M_LAT) ? xlat + (size_t)row * 1024 : xctx + (size_t)(row - M_LAT) * 1024;
        f32x4 x[4]; float ss = 0.f;
#pragma unroll
        for (int j = 0; j < 4; ++j) { x[j] = *(const f32x4*)(xr + 4 * (F.lane + 64 * j)); ss += (x[j].x * x[j].x + x[j].y * x[j].y) + (x[j].z * x[j].z + x[j].w * x[j].w); }
        const float rstd = __builtin_amdgcn_rsqf(wave_sum(ss, F.lane) * (1.0f / 1024.0f) + RMS_EPS);
#pragma unroll
        for (int j = 0; j < 4; ++j) { const f32x4 h = x[j] * rstd * av[j] + bv[j]; v2u o; o.x = pk2(h.x, h.y); o.y = pk2(h.z, h.w);
            *(v2u*)(H + (size_t)row * 1024 + 4 * (F.lane + 64 * j)) = o; }
    }
}

DI void p3_prep(const Frame& F, const Args& a, int l, bf16* P) {
    const int gw = F.vcu * NWAVES + F.wave, NGW = F.G * NWAVES;
    const int lane = F.lane, d0 = 4 * (lane & 15);
    f32x4 wq_a, wq_d, wk, inv;
#pragma unroll
    for (int e = 0; e < 4; ++e) { wq_a[e] = a.in[I_QNA][l * 64 + d0 + e]; wq_d[e] = a.in[I_QND][l * 64 + d0 + e]; wk[e] = (lane < 32 ? a.in[I_KNA] : a.in[I_KND])[l * 64 + d0 + e];
        inv[e] = __builtin_amdgcn_exp2f(-(float)((d0 + e) & 15) * (13.287712379549449f / 16.0f)) * 0.15915494309189535f; }
    const float sgn = (d0 & 16) ? 1.0f : -1.0f;
    for (int row = gw; row < M_ALL; row += NGW) {
        const bool isctx = row >= M_LAT; const int n = row & (SEQ - 1);
        f32x4 cs = (f32x4){1.f, 1.f, 1.f, 1.f}, sn = (f32x4){0.f, 0.f, 0.f, 0.f};
        if (!isctx) { const float pos = (float)((d0 < 32) ? (n >> 6) : (n & 63));
#pragma unroll
            for (int e = 0; e < 4; ++e) { const float rev = pos * inv[e]; cs[e] = __builtin_amdgcn_cosf(rev); sn[e] = __builtin_amdgcn_sinf(rev); } }
        bf16* pr = P + (size_t)row * PW;
        const bool qok = !(isctx && l == 1);
        const int colk = (lane < 32) ? C_AK + 4 * lane : C_DK + 4 * (lane - 32);
        v2u raw[3];
        raw[0] = qok ? *(const v2u*)(pr + C_AQ + 4 * lane) : (v2u){0u, 0u}; raw[1] = qok ? *(const v2u*)(pr + C_DQ + 4 * lane) : (v2u){0u, 0u}; raw[2] = *(const v2u*)(pr + colk);
#pragma unroll
        for (int p = 0; p < 3; ++p) {
            f32x4 v = (f32x4){wlo(raw[p].x), whi(raw[p].x), wlo(raw[p].y), whi(raw[p].y)};
            float ss = (v[0] * v[0] + v[1] * v[1]) + (v[2] * v[2] + v[3] * v[3]);
            ss += shx(ss, 1, lane); ss += shx(ss, 2, lane); ss += shx(ss, 4, lane); ss += shx(ss, 8, lane);
            const f32x4 w = (p == 0) ? wq_a : (p == 1) ? wq_d : wk;
            v = v * __builtin_amdgcn_rsqf(ss * (1.0f / 64.0f) + RMS_EPS) * w;
            f32x4 pt;
#pragma unroll
            for (int e = 0; e < 4; ++e) pt[e] = shx(v[e], 4, lane);
            v = v * cs + pt * sn * sgn;
            if (p < 2) v = v * QSCALE;
            v2u o; o.x = pk2(v[0], v[1]); o.y = pk2(v[2], v[3]);
            if (p == 2) *(v2u*)(pr + colk) = o; else if (qok) *(v2u*)(pr + (p == 0 ? C_AQ : C_DQ) + 4 * lane) = o;
        }
    }
}

DI void fnet_stepA(const bf16* xrow, const bf16* MAt, int r32, int hi, bf16x8 (&gs)[4][2]) {
    bf16x8 xa[4];
#pragma unroll
    for (int s4 = 0; s4 < 4; ++s4) xa[s4] = *(const bf16x8*)(xrow + 16 * s4 + 8 * hi);
#pragma unroll
    for (int cb = 0; cb < 4; ++cb) { f32x16 acc = f32x16{};
#pragma unroll
        for (int s4 = 0; s4 < 4; ++s4) { const bf16x8 bfr = *(const bf16x8*)(MAt + (32 * cb + r32) * 64 + 16 * s4 + 8 * hi); acc = MFMA32(xa[s4], bfr, acc); }
        gs[cb][0] = pack_step(acc, 0); gs[cb][1] = pack_step(acc, 1); }
}

DI void fnet_s1_unit(const Frame& F, const Args& a, int l, int u, const bf16* P) {
    const int b = u >> 7, n2grp = (u >> 4) & 7, g = (u >> 2) & 3, k1b = u & 3;
    const int lane = F.lane, r32 = lane & 31, hi = lane >> 5, w = F.wave, n2 = 8 * n2grp + w;
    const bf16* tab = (const bf16*)(a.ws + WS_TAB);
    const bf16* MAt = tab + TAB_MA / 2 + (size_t)(l * 4 + g) * 128 * 64;
    const bf16* T128 = tab + TAB_128 / 2;
    f32x16 Tr[2], Ti[2];
#pragma unroll
    for (int j = 0; j < 2; ++j) { Tr[j] = f32x16{}; Ti[j] = f32x16{}; }
#pragma unroll 1
    for (int nb = 0; nb < 4; ++nb) {
        const bf16* xrow = P + (size_t)(SEQ * b + 64 * (32 * nb + r32) + n2) * PW + C_BF + 64 * g;
        bf16x8 gs[4][2]; fnet_stepA(xrow, MAt, r32, hi, gs);
#pragma unroll
        for (int s = 0; s < 2; ++s) {
            const size_t fo = ((size_t)((k1b * 4 + nb) * 2 + s) * 64 + lane) * 8;
            const bf16x8 ca = *(const bf16x8*)(T128 + fo), sa = *(const bf16x8*)(T128 + 16384 + fo), na = *(const bf16x8*)(T128 + 32768 + fo);
            Tr[0] = MFMA32(ca, gs[0][s], Tr[0]); Tr[0] = MFMA32(sa, gs[2][s], Tr[0]);
            Tr[1] = MFMA32(ca, gs[1][s], Tr[1]); Tr[1] = MFMA32(sa, gs[3][s], Tr[1]);
            Ti[0] = MFMA32(ca, gs[2][s], Ti[0]); Ti[0] = MFMA32(na, gs[0][s], Ti[0]);
            Ti[1] = MFMA32(ca, gs[3][s], Ti[1]); Ti[1] = MFMA32(na, gs[1][s], Ti[1]); }
    }
    LAS bf16* tl = (LAS bf16*)F.lds;
#pragma unroll
    for (int i = 0; i < 16; ++i) { const int k1l = crow(i, hi), k1 = 32 * k1b + k1l;
        const float rev = (float)((n2 * k1) & 8191) * (1.0f / 8192.0f); const float c = __builtin_amdgcn_cosf(rev), s = __builtin_amdgcn_sinf(rev);
#pragma unroll
        for (int jb = 0; jb < 2; ++jb) { const float tr = Tr[jb][i], ti = Ti[jb][i];
            tl[(k1l * 128 + 32 * jb + r32) * 8 + w] = (bf16)f2bf(tr * c + ti * s);
            tl[(k1l * 128 + 64 + 32 * jb + r32) * 8 + w] = (bf16)f2bf(ti * c - tr * s); } }
    __syncthreads();
    bf16* T1 = (bf16*)(a.ws + WS_T1);
#pragma unroll 4
    for (int pass = 0; pass < 8; ++pass) { const int q = F.tid + 512 * pass, k1l = q >> 7, colL = q & 127;
        const v4u v = *(const LAS v4u*)(F.lds + (size_t)q * 16);
        *(v4u*)(T1 + ((((size_t)(b * 128 + 32 * k1b + k1l) * 8 + n2grp) * 512) + g * 128 + colL) * 8) = v; }
    __syncthreads();
}

DI void fnet_ctx_unit(const Frame& F, const Args& a, int l, int u, const bf16* P, bf16* YB) {
    const int b = u >> 2, g = u & 3;
    const int lane = F.lane, r32 = lane & 31, hi = lane >> 5, w = F.wave;
    const bf16* tab = (const bf16*)(a.ws + WS_TAB);
    const bf16* MAt = tab + TAB_MA / 2 + (size_t)(l * 4 + g) * 128 * 64;
    const bf16* T256 = tab + TAB_256 / 2;
    f32x16 Y[2]; Y[0] = f32x16{}; Y[1] = f32x16{};
#pragma unroll 1
    for (int nb = 0; nb < 8; ++nb) {
        const bf16* xrow = P + (size_t)(M_LAT + NCTX * b + 32 * nb + r32) * PW + C_BF + 64 * g;
        bf16x8 gs[4][2]; fnet_stepA(xrow, MAt, r32, hi, gs);
#pragma unroll
        for (int s = 0; s < 2; ++s) {
            const size_t fo = ((size_t)((w * 8 + nb) * 2 + s) * 64 + lane) * 8;
            const bf16x8 ca = *(const bf16x8*)(T256 + fo), sa = *(const bf16x8*)(T256 + 65536 + fo);
            Y[0] = MFMA32(ca, gs[0][s], Y[0]); Y[0] = MFMA32(sa, gs[2][s], Y[0]);
            Y[1] = MFMA32(ca, gs[1][s], Y[1]); Y[1] = MFMA32(sa, gs[3][s], Y[1]); }
    }
#pragma unroll
    for (int jb = 0; jb < 2; ++jb)
#pragma unroll
        for (int i = 0; i < 16; ++i) { const int k = 32 * w + crow(i, hi), d = 32 * jb + r32; const size_t row = (size_t)(M_LAT + NCTX * b + k);
            const float z = bf2f(P[row * PW + C_BZ + 64 * g + d]);
            YB[row * 1024 + 512 + 64 * g + d] = (bf16)f2bf(Y[jb][i] * (1.0f / 128.0f) * siluf(z)); }
}

#ifndef B_SCALE
#define B_SCALE 1.0f
#endif
#ifndef C_SCALE
#define C_SCALE 1.0f
#endif
DI void fnet_s3_unit(const Frame& F, const Args& a, int u, const bf16* P, bf16* YB) {
    const int b = u >> 7, k1 = u & 127;
    const int lane = F.lane, r32 = lane & 31, hi = lane >> 5, g = F.wave >> 1, jb = F.wave & 1;
    const bf16* T64 = (const bf16*)(a.ws + WS_TAB) + TAB_64 / 2;
    const bf16* T1 = (const bf16*)(a.ws + WS_T1);
    f32x16 Y[2]; Y[0] = f32x16{}; Y[1] = f32x16{};
#pragma unroll
    for (int sc = 0; sc < 4; ++sc)
#pragma unroll
        for (int ri = 0; ri < 2; ++ri) {
            const bf16x8 afr = *(const bf16x8*)(T1 + ((((size_t)(b * 128 + k1) * 8 + 2 * sc + hi) * 512) + g * 128 + ri * 64 + 32 * jb + r32) * 8);
#pragma unroll
            for (int k2b = 0; k2b < 2; ++k2b) { const bf16x8 bfr = *(const bf16x8*)(T64 + ri * 4096 + (32 * k2b + r32) * 64 + 16 * sc + 8 * hi); Y[k2b] = MFMA32(afr, bfr, Y[k2b]); } }
#pragma unroll
    for (int k2b = 0; k2b < 2; ++k2b) { const size_t row = (size_t)(SEQ * b + k1 + 128 * (32 * k2b + r32));
#pragma unroll
        for (int q = 0; q < 4; ++q) { const int d0 = 32 * jb + 8 * q + 4 * hi;
            const v2u z = *(const v2u*)(P + row * PW + C_BZ + 64 * g + d0);
            v2u o; o.x = pk2(Y[k2b][4 * q] * (B_SCALE * 0.0013810679320049757f) * siluf(wlo(z.x)), Y[k2b][4 * q + 1] * (B_SCALE * 0.0013810679320049757f) * siluf(whi(z.x)));
            o.y = pk2(Y[k2b][4 * q + 2] * (B_SCALE * 0.0013810679320049757f) * siluf(wlo(z.y)), Y[k2b][4 * q + 3] * (B_SCALE * 0.0013810679320049757f) * siluf(whi(z.y)));
            *(v2u*)(YB + row * 1024 + 512 + 64 * g + d0) = o; } }
}

DI void sgu_unit(const Frame& F, const Args& a, int l, int u, const bf16* P, bf16* YB) {
    constexpr int VP = 136;
    LAS bf16* vt = (LAS bf16*)F.lds;
    const int ci = u >> 2, g = u & 3;
    const size_t row0 = (size_t)ci * 128;
    { const int q = F.tid & 127, cq = F.tid >> 7; const bf16* src = P + (row0 + q) * PW + C_CV + 64 * g + 16 * cq;
#pragma unroll
      for (int i = 0; i < 2; ++i) { const v4u v = *(const v4u*)(src + 8 * i); const unsigned wv[4] = {v.x, v.y, v.z, v.w};
#pragma unroll
          for (int e = 0; e < 4; ++e) { vt[(16 * cq + 8 * i + 2 * e) * VP + q] = (bf16)f2bf(geluf(wlo(wv[e]))); vt[(16 * cq + 8 * i + 2 * e + 1) * VP + q] = (bf16)f2bf(geluf(whi(wv[e]))); } } }
    __syncthreads();
    const int lane = F.lane, r32 = lane & 31, hi = lane >> 5, pb = F.wave >> 1, cb = F.wave & 1;
    const bf16* Wsp = (const bf16*)(a.ws + WS_TAB) + TAB_WSP / 2 + (size_t)(l * 4 + g) * 128 * 128;
    f32x16 acc = f32x16{};
#pragma unroll
    for (int s = 0; s < 8; ++s) {
        const bf16x8 af = *(const LAS bf16x8*)(vt + (32 * cb + r32) * VP + 16 * s + 8 * hi);
        const bf16x8 bfr = *(const bf16x8*)(Wsp + (32 * pb + r32) * 128 + 16 * s + 8 * hi);
        acc = MFMA32(af, bfr, acc);
    }
    const int p = 32 * pb + r32; const float bb = a.in[I_BSP][(l * 4 + g) * 128 + p]; const bf16* pr = P + (row0 + p) * PW;
#pragma unroll
    for (int q = 0; q < 4; ++q) { const int c0 = 64 * g + 32 * cb + 8 * q + 4 * hi;
        const v2u uu = *(const v2u*)(pr + C_CU + c0), zz = *(const v2u*)(pr + C_CZ + c0);
        v2u o; o.x = pk2(C_SCALE * geluf(wlo(uu.x)) * (acc[4 * q] + bb) * siluf(wlo(zz.x)), C_SCALE * geluf(whi(uu.x)) * (acc[4 * q + 1] + bb) * siluf(whi(zz.x)));
        o.y = pk2(C_SCALE * geluf(wlo(uu.y)) * (acc[4 * q + 2] + bb) * siluf(wlo(zz.y)), C_SCALE * geluf(whi(uu.y)) * (acc[4 * q + 3] + bb) * siluf(whi(zz.y)));
        *(v2u*)(YB + (row0 + p) * 1024 + 768 + c0) = o; }
    __syncthreads();
}

DI void p5_ctx_convert(const Frame& F, const Args& a) {
    const int gt = F.vcu * 512 + F.tid, NGT = F.G * 512;
    const f32x4* src = (const f32x4*)(a.ws + WS_MGC); v2u* dst = (v2u*)((bf16*)(a.ws + WS_MG) + (size_t)M_LAT * 1024);
    for (int e = gt; e < M_CTX * 1024 / 4; e += NGT) { const f32x4 v = src[e]; v2u o; o.x = pk2(v.x, v.y); o.y = pk2(v.z, v.w); dst[e] = o; }
}

#ifdef SELFCHECK
constexpr int CW_CHK = 8192;
DI unsigned hsh(unsigned x) { x *= 2654435761u; x ^= x >> 15; x *= 2246822519u; x ^= x >> 13; x *= 3266489917u; x ^= x >> 16; return x; }
DI void chk_acc(const Args& a, int id, float got, float want) {
    unsigned* w = (unsigned*)(a.ws + WS_CTL) + CW_CHK + 4 * id;
    float d = __builtin_fabsf(got - want); if (!(d == d) || d > 1e15f) d = 1e15f;
    atomicAdd((float*)w, d * d); atomicAdd((float*)(w + 1), want * want); atomicAdd(w + 2, 1u); atomicMax(w + 3, __float_as_uint(d));
}
DI float bfr(float x) { return __uint_as_float(f2bf(x) << 16); }
DI void chk_p0(const Frame& F, const Args& a) {
    const int gt = F.vcu * 512 + F.tid, NGT = F.G * 512;
    for (int s = gt; s < 18432; s += NGT) { const int l = s / 9216, v = (s / 3072) % 3, j = s % 3072; float acc = a.in[I_BADA][l * 3072 + j];
        for (int k = 0; k < 1024; ++k) { const float cv = (v < 2) ? a.in[I_C][v * 1024 + k] : a.in[I_CCTX][k]; acc += siluf(cv) * a.in[I_WADA][((size_t)l * 1024 + k) * 3072 + j]; }
        chk_acc(a, 0, ((const float*)(a.ws + WS_MOD))[(l * 3 + v) * 3072 + j], acc); }
    for (int s = gt; s < 65536; s += NGT) { const unsigned h = hsh(s); const int l = (s >> 2) & 1, m = s & 3, k = h & 1023; const unsigned h2 = hsh(h + 77u);
        float got, want;
        if (m == 0) { const int n = h2 % PW; want = bfr(a.in[I_WIN][((size_t)l * 1024 + k) * PW + n]); got = bf2f(((const bf16*)(a.ws + WS_WIN))[((size_t)l * PW + n) * WPITCH + k]); }
        else if (m == 1) { const int n = h2 & 4095; want = bfr(a.in[I_WMERGE][((size_t)l * 1024 + k) * 4096 + n]); got = bf2f(((const bf16*)(a.ws + WS_WM))[((size_t)l * 4096 + n) * 1024 + k]); }
        else if (m == 2) { const int n = h2 & 1023; want = bfr(a.in[I_WOUT][((size_t)l * 1024 + k) * 1024 + n]); got = bf2f(((const bf16*)(a.ws + WS_WOUT))[((size_t)l * 1024 + n) * 1024 + k]); }
        else { const int n = h2 & 1023, br = k >> 8, kk = k & 255; want = bfr(a.in[I_WBR][(((size_t)l * 4 + br) * 256 + kk) * 1024 + n]); got = bf2f(((const bf16*)(a.ws + WS_WBR))[((size_t)l * 1024 + n) * 1024 + 256 * br + kk]); }
        chk_acc(a, 1, got, want); }
}
DI int sample_row(unsigned h, int l) { const int r = h % M_ALL; (void)l; return ((h >> 20) & 7) == 0 ? M_LAT + (h % M_CTX) : r; }
DI void chk_h(const Frame& F, const Args& a, int l, int id) {
    const float* mod = (const float*)(a.ws + WS_MOD) + (size_t)l * 3 * 3072; const bf16* H = (const bf16*)(a.ws + WS_H);
    const int gw = F.vcu * NWAVES + F.wave, NGW = F.G * NWAVES;
    for (int s = gw; s < M_ALL; s += NGW) { const int row = s; const int v = row < SEQ ? 0 : (row < M_LAT ? 1 : 2);
        const float* xr = (row < M_LAT) ? ((l == 0) ? a.in[I_X] : a.out) + (size_t)row * 1024 : ((l == 0) ? a.in[I_CTX] : (const float*)(a.ws + WS_XC1)) + (size_t)(row - M_LAT) * 1024;
        float ss = 0.f; for (int j = 0; j < 16; ++j) { const float x = xr[F.lane + 64 * j]; ss += x * x; }
        const float rstd = 1.0f / sqrtf(wave_sum(ss, F.lane) * (1.0f / 1024.0f) + RMS_EPS);
        for (int j = 0; j < 16; ++j) { const int c = F.lane + 64 * j; const float want = xr[c] * rstd * a.in[I_NORMW][l * 1024 + c] * (1.0f + mod[v * 3072 + 1024 + c]) + mod[v * 3072 + c];
            chk_acc(a, id, bf2f(H[(size_t)row * 1024 + c]), want); } }
}
DI float dot_h_w(const bf16* hrow, const bf16* wrow, int K) { float acc = 0.f; for (int k = 0; k < K; ++k) acc += bf2f(hrow[k]) * bf2f(wrow[k]); return acc; }
DI void chk_p(const Frame& F, const Args& a, int l, int id) {
    const bf16* H = (const bf16*)(a.ws + WS_H); const bf16* W = (const bf16*)(a.ws + WS_WIN) + (size_t)l * PW * WPITCH; const bf16* P = (const bf16*)(a.ws + WS_P);
    const int gt = F.vcu * 512 + F.tid, NGT = F.G * 512;
    for (int s = gt; s < (1 << 20); s += NGT) { const unsigned h = hsh(s * 5 + 2); const int row = sample_row(h, l); int col = hsh(h + 9u) % PW;
        if (l == 1 && row >= M_LAT) col = ((col & 1) ? 1024 : 256) + (col & 255);
        chk_acc(a, id, bf2f(P[(size_t)row * PW + col]), dot_h_w(H + (size_t)row * 1024, W + (size_t)col * WPITCH, 1024)); }
}
DI void chk_prep(const Frame& F, const Args& a, int l, int id) {
    const bf16* H = (const bf16*)(a.ws + WS_H); const bf16* W = (const bf16*)(a.ws + WS_WIN) + (size_t)l * PW * WPITCH; const bf16* P = (const bf16*)(a.ws + WS_P);
    const int gw = F.vcu * NWAVES + F.wave, NGW = F.G * NWAVES, d = F.lane;
    for (int s = gw; s < 16384; s += NGW) { const unsigned h = hsh(s * 7 + 3); const int row = sample_row(h, l); int sl = (h >> 8) % 12; const bool isctx = row >= M_LAT;
        if (isctx && l == 1) sl = (sl & 1) ? 4 + (sl & 1) : 10 + ((sl >> 1) & 1);
        const int col = (sl < 4) ? C_AQ + 64 * sl : (sl < 6) ? C_AK + 64 * (sl - 4) : (sl < 10) ? C_DQ + 64 * (sl - 6) : C_DK + 64 * (sl - 10);
        const bool isq = (sl < 4) || (sl >= 6 && sl < 10);
        const float raw = bfr(dot_h_w(H + (size_t)row * 1024, W + (size_t)(col + d) * WPITCH, 1024));
        const float wv = ((sl < 4) ? a.in[I_QNA] : (sl < 6) ? a.in[I_KNA] : (sl < 10) ? a.in[I_QND] : a.in[I_KND])[l * 64 + d];
        const float ms = wave_sum(raw * raw, d) * (1.0f / 64.0f);
        float y = raw / sqrtf(ms + RMS_EPS) * wv;
        if (!isctx) { const int n = row & (SEQ - 1); const float pos = (float)((d < 32) ? (n >> 6) : (n & 63)); const float inv = __builtin_amdgcn_exp2f(-(float)(d & 15) * (13.287712379549449f / 16.0f)); const float rev = pos * inv * 0.15915494309189535f; const float cs = __builtin_amdgcn_cosf(rev), sn = __builtin_amdgcn_sinf(rev);
            const float p = shx(y, 16, d); y = (d & 16) ? (p * sn + y * cs) : (y * cs - p * sn); }
        if (isq) y *= QSCALE;
        chk_acc(a, id, bf2f(P[(size_t)row * PW + col + d]), y); }
}
DI void chk_attn(const Frame& F, const Args& a, int l, int id, int mode) {
    const bf16* P = (const bf16*)(a.ws + WS_P); const bf16* YB = (const bf16*)(a.ws + WS_YB);
    LAS float* qs = (LAS float*)F.lds + F.wave * 192; LAS float* os = qs + 64; LAS float* red = qs + 128;
    const int gw = F.vcu * NWAVES + F.wave, NGW = F.G * NWAVES, lane = F.lane;
    const int qc0 = mode ? C_DQ : C_AQ, kc0 = mode ? C_DK : C_AK, vc0 = mode ? C_DV : C_AV, zc0 = mode ? C_DZ : C_AZ, oc0 = mode ? 256 : 0;
    for (int s = gw; s < 8192; s += NGW) { const unsigned hh = hsh(s * 11 + 5 + mode); int row = sample_row(hh, l); if ((s & 7) == 1) row = (hh & 8192) + (hh & 255) + ((hh & 256) ? 7936 : 0); if (l == 1 && row >= M_LAT) row = hh % M_LAT; const int h = (hh >> 9) & 3, kvh = h >> 1; const bool isctx = row >= M_LAT;
        const int b = isctx ? (row - M_LAT) / NCTX : row / SEQ, pos = row & (SEQ - 1);
        qs[lane] = bf2f(P[(size_t)row * PW + qc0 + 64 * h + lane]); LDS_WAIT();
        int klo = 0, khi = -1; if (!isctx) { if (mode == 0) { klo = 0; khi = SEQ - 1; } else { klo = pos - 128 < 0 ? 0 : pos - 128; khi = pos + 128 > SEQ - 1 ? SEQ - 1 : pos + 128; } }
        const int nlat = khi - klo + 1 > 0 ? khi - klo + 1 : 0, nk = NCTX + nlat;
        float m = -1e30f, lsum = 0.f; float acc[64];
#pragma unroll
        for (int dd = 0; dd < 64; ++dd) acc[dd] = 0.f;
        for (int kk = lane; kk < nk; kk += 64) { const size_t kr = (kk < NCTX) ? (size_t)(M_LAT + NCTX * b + kk) : (size_t)(SEQ * b + klo + kk - NCTX);
            const bf16* kp = P + kr * PW + kc0 + 64 * kvh; const bf16* vp = P + kr * PW + vc0 + 64 * kvh; float sc = 0.f;
#pragma unroll
            for (int dd = 0; dd < 64; ++dd) sc += qs[dd] * bf2f(kp[dd]);
            const float mn = fmaxf(m, sc), f = __builtin_amdgcn_exp2f(m - mn), p = __builtin_amdgcn_exp2f(sc - mn); lsum = lsum * f + p; m = mn;
#pragma unroll
            for (int dd = 0; dd < 64; ++dd) acc[dd] = acc[dd] * f + p * bf2f(vp[dd]); }
        float mall = m;
#pragma unroll
        for (int o = 1; o < 64; o <<= 1) mall = fmaxf(mall, shx(mall, o, lane));
        const float f = __builtin_amdgcn_exp2f(m - mall); lsum = wave_sum(lsum * f, lane);
        if (mode == 1) lsum += __builtin_amdgcn_exp2f(a.in[I_SINK][l * 4 + h] * 1.4426950408889634f - mall);
#pragma unroll
        for (int dd = 0; dd < 64; ++dd) { const float t = wave_sum(acc[dd] * f, lane); if (lane == dd) os[dd] = t; }
        LDS_WAIT();
        const float z = bf2f(P[(size_t)row * PW + zc0 + 64 * h + lane]);
        chk_acc(a, id, bf2f(YB[(size_t)row * 1024 + oc0 + 64 * h + lane]), os[lane] / lsum * siluf(z));
        (void)red; }
}
DI void chk_fnet(const Frame& F, const Args& a, int l, int id, int ctxmode) {
    const bf16* P = (const bf16*)(a.ws + WS_P); const bf16* YB = (const bf16*)(a.ws + WS_YB);
    LAS float* ys = (LAS float*)F.lds + F.wave * 64;
    const int gw = F.vcu * NWAVES + F.wave, NGW = F.G * NWAVES, j = F.lane;
    const int N = ctxmode ? NCTX : SEQ;
    for (int s = gw; s < (ctxmode ? 256 : 1024); s += NGW) { const unsigned hh = hsh(s * 13 + 7 + ctxmode); const int b = hh & 1, g = (hh >> 1) & 3; int k = (hh >> 3) % N;
#ifdef FNET_K0
        k = (s & 7) == 0 ? 0 : (s & 7) == 1 ? N / 2 : (s & 7) == 2 ? 64 : (s & 7) == 3 ? 128 : (s & 7) == 4 ? 1 : k;
#endif
        const size_t rbase = ctxmode ? (size_t)(M_LAT + NCTX * b) : (size_t)(SEQ * b);
        float y = 0.f;
        for (int n = 0; n < N; ++n) { const bf16* fr = P + (rbase + n) * PW + C_BF + 64 * g; float A = 0.f, B = 0.f;
            for (int c = 0; c < 64; ++c) { const float fv = bf2f(fr[c]); const float ph = (float)((j * c) & 63) * (1.0f / 64.0f); A += fv * __builtin_amdgcn_cosf(ph); B += fv * __builtin_amdgcn_sinf(ph); }
            const float th = (float)((k * n) & (N - 1)) / (float)N; y += __builtin_amdgcn_cosf(th) * A - __builtin_amdgcn_sinf(th) * B; }
        ys[j] = y / sqrtf((float)N * 64.0f); LDS_WAIT();
        float o = 0.f; for (int jj = 0; jj < 64; ++jj) o += ys[jj] * a.in[I_WFNET][((size_t)(l * 4 + g) * 64 + jj) * 64 + j];
        const size_t row = rbase + k; const float z = bf2f(P[row * PW + C_BZ + 64 * g + j]);
        chk_acc(a, id, bf2f(YB[row * 1024 + 512 + 64 * g + j]), o * siluf(z)); LDS_WAIT(); }
}
DI void chk_sgu(const Frame& F, const Args& a, int l, int id) {
    const bf16* P = (const bf16*)(a.ws + WS_P); const bf16* YB = (const bf16*)(a.ws + WS_YB);
    const int gt = F.vcu * 512 + F.tid, NGT = F.G * 512;
    for (int s = gt; s < (1 << 18); s += NGT) { const unsigned hh = hsh(s * 17 + 11); int row = sample_row(hh, l); if (l == 1 && row >= M_LAT) row = hh % M_LAT; const int cc = hsh(hh + 101u) & 255, g = cc >> 6, p = row & 127; const size_t r0 = (size_t)(row - p);
        float sp = a.in[I_BSP][(l * 4 + g) * 128 + p];
        for (int q = 0; q < 128; ++q) { const float v = bf2f(P[(r0 + q) * PW + C_CV + cc]); sp += a.in[I_WSP][((size_t)(l * 4 + g) * 128 + p) * 128 + q] * (0.5f * v * (1.0f + erff(v * 0.7071067811865476f))); }
        const float u = bf2f(P[(size_t)row * PW + C_CU + cc]), z = bf2f(P[(size_t)row * PW + C_CZ + cc]);
        chk_acc(a, id, bf2f(YB[(size_t)row * 1024 + 768 + cc]), (0.5f * u * (1.0f + erff(u * 0.7071067811865476f))) * sp * siluf(z)); }
}
DI void chk_merge(const Frame& F, const Args& a, int l, int id) {
    const bf16* H = (const bf16*)(a.ws + WS_H); const bf16* YB = (const bf16*)(a.ws + WS_YB); const bf16* MG = (const bf16*)(a.ws + WS_MG);
    const bf16* WM = (const bf16*)(a.ws + WS_WM) + (size_t)l * 4096 * 1024; const bf16* WB = (const bf16*)(a.ws + WS_WBR) + (size_t)l * 1024 * 1024;
    const int gt = F.vcu * 512 + F.tid, NGT = F.G * 512;
    for (int s = gt; s < (1 << 18); s += NGT) { const unsigned hh = hsh(s * 19 + 13); int row = sample_row(hh, l); if (l == 1 && row >= M_LAT) row = hh % M_LAT; const int d = hsh(hh + 202u) & 1023; float acc = 0.f;
        for (int r = 0; r < 4; ++r) { const float G = dot_h_w(H + (size_t)row * 1024, WM + ((size_t)r * 1024 + d) * 1024, 1024) + a.in[I_BMERGE][l * 4096 + r * 1024 + d];
            const float Y = dot_h_w(YB + (size_t)row * 1024 + 256 * r, WB + (size_t)d * 1024 + 256 * r, 256); acc += Y * __builtin_amdgcn_rcpf(1.0f + __builtin_amdgcn_exp2f(-1.4426950408889634f * G)); }
        float got; if (row < M_LAT) got = bf2f(MG[(size_t)row * 1024 + d]); else { got = 0.f; for (int br = 0; br < 4; ++br) got += bf2f(((const bf16*)(a.ws + WS_GTC))[((size_t)br * 512 + (row - M_LAT)) * 1024 + d]); }
        chk_acc(a, id, got, acc); }
}
DI void chk_gt(const Frame& F, const Args& a, int l, int r, int id) {
    const bf16* H = (const bf16*)(a.ws + WS_H); const bf16* GT = (const bf16*)(a.ws + WS_GT); const bf16* WM = (const bf16*)(a.ws + WS_WM) + (size_t)l * 4096 * 1024;
    const int gt = F.vcu * 512 + F.tid, NGT = F.G * 512;
    for (int s = gt; s < (1 << 18); s += NGT) { const unsigned hh = hsh(s * 29 + 19); int row = sample_row(hh, l); if (l == 1 && row >= M_LAT) row = hh % M_LAT; const int d = hsh(hh + 404u) & 1023;
        const float G = dot_h_w(H + (size_t)row * 1024, WM + ((size_t)r * 1024 + d) * 1024, 1024) + a.in[I_BMERGE][l * 4096 + r * 1024 + d];
        chk_acc(a, id, bf2f(GT[(size_t)row * 1024 + d]), __builtin_amdgcn_rcpf(1.0f + __builtin_amdgcn_exp2f(-1.4426950408889634f * G))); }
}
DI void chk_final(const Frame& F, const Args& a, int l, int id) {
    const bf16* MG = (const bf16*)(a.ws + WS_MG); const bf16* WO = (const bf16*)(a.ws + WS_WOUT) + (size_t)l * 1024 * 1024; const float* mod = (const float*)(a.ws + WS_MOD) + (size_t)l * 3 * 3072;
    const int gt = F.vcu * 512 + F.tid, NGT = F.G * 512;
    for (int s = gt; s < (1 << 18); s += NGT) { const unsigned hh = hsh(s * 23 + 17); const int row = sample_row(hh, l), c = hsh(hh + 303u) & 1023; const int v = row < SEQ ? 0 : (row < M_LAT ? 1 : 2);
        if (l == 1 && row >= M_LAT) continue;
        const float xi = (l == 1) ? ((const float*)(a.ws + WS_H))[(size_t)row * 1024 + c] : (row < M_LAT) ? a.in[I_X][(size_t)row * 1024 + c] : a.in[I_CTX][(size_t)(row - M_LAT) * 1024 + c];
        const float got = (row < M_LAT) ? a.out[(size_t)row * 1024 + c] : ((const float*)(a.ws + WS_XC1))[(size_t)(row - M_LAT) * 1024 + c];
        float dsum;
        if (row < M_LAT) dsum = dot_h_w(MG + (size_t)row * 1024, WO + (size_t)c * 1024, 1024);
        else { dsum = 0.f; for (int br = 0; br < 4; ++br) dsum += dot_h_w((const bf16*)(a.ws + WS_GTC) + ((size_t)br * 512 + (row - M_LAT)) * 1024, WO + (size_t)c * 1024, 1024); }
        chk_acc(a, id, got - xi, mod[v * 3072 + 2048 + c] * dsum); }
}
#ifdef CHECK_MAX
#define CHK_ERR(md, ss, n, mx) ((mx) / (sqrtf((ss) / (float)(n)) + 1e-20f))
#else
#define CHK_ERR(md, ss, n, mx) sqrtf((md) / ((ss) + 1e-30f))
#endif
DI void chk_report(const Frame& F, const Args& a) {
    const unsigned* w = (const unsigned*)(a.ws + WS_CTL) + CW_CHK; int first = -1; float ferr = 0.f;
#ifdef CHECK_ONLY
    { const int id = CHECK_ONLY; const float md = __uint_as_float(w[4 * id]), ss = ((const float*)w)[4 * id + 1]; const unsigned n = w[4 * id + 2]; first = id; ferr = n ? CHK_ERR(md, ss, n, __uint_as_float(w[4 * id + 3])) : 1e3f; }
#else
    for (int id = 0; id < 24; ++id) { const float md = __uint_as_float(w[4 * id]), ss = ((const float*)w)[4 * id + 1]; const unsigned n = w[4 * id + 2]; if (!n) continue;
        const float e = CHK_ERR(md, ss, n, __uint_as_float(w[4 * id + 3])); if (e > CHECK_TOL && first < 0) { first = id; ferr = e; } }
#endif
    const float V = first >= 0 ? 10.0f * (float)(1 + first) : 0.f; const float W = first >= 0 ? 4.0f + log10f(fminf(fmaxf(ferr, 1e-3f), 1e3f)) : 0.f;
    const size_t gt = (size_t)F.vcu * 512 + F.tid, NGT = (size_t)F.G * 512;
#ifdef KEEP_OUT
    if (gt == 0) a.out[0] += V; (void)W; (void)NGT;
#else
    for (size_t i = gt; i < (size_t)M_LAT * 1024; i += NGT) { float v = a.in[I_X][i]; if (i == 0) v += V; if (i >= (1u << 20) && i < (2u << 20)) v += W; a.out[i] = v; }
#endif
}
DI void chk_copy_out(const Frame& F, const Args& a) {
    const size_t gt = (size_t)F.vcu * 512 + F.tid, NGT = (size_t)F.G * 512; float* dst = (float*)(a.ws + WS_H);
    for (size_t i = gt; i < (size_t)M_LAT * 1024; i += NGT) dst[i] = a.out[i];
}
#endif

typedef const __attribute__((address_space(4))) Args* CArgsP;
DI Args fresh_args() { CArgsP p = (CArgsP)__builtin_amdgcn_kernarg_segment_ptr(); asm volatile("" : "+s"(p)); Args r;
#pragma unroll
    for (int i = 0; i < 20; ++i) r.in[i] = p->in[i];
    r.out = p->out; r.ws = p->ws; return r; }
DI Frame fresh_frame(unsigned char* lds) {
    Frame F; int t_ = threadIdx.x; asm volatile("" : "+v"(t_));
    F.lds = (LAS unsigned char*)lds; F.tid = t_; F.lane = t_ & 63; F.wave = __builtin_amdgcn_readfirstlane(t_ >> 6);
    F.G = gridDim.x; { const int bx = blockIdx.x; F.vcu = (F.G % 8 == 0) ? (bx % 8) * (F.G / 8) + bx / 8 : bx; }
    return F;
}
DI void grid_bar(unsigned char* lds) {
    const Args a = fresh_args();
    XcdBarrier b; b.bar = (unsigned*)(a.ws + WS_CTL) + CW_BAR; b.x = xb_xcc_id(); b.st = (volatile LAS unsigned*)((LAS unsigned char*)lds + MISC_OFF) + 8;
    xcd_barrier(b);
}

__global__ void __launch_bounds__(NWAVES * 64, 2) hybrid_fwd(Args args) {
    extern __shared__ __attribute__((aligned(16))) unsigned char lds[];
    for (int u = threadIdx.x; u < (LDS_BYTES - LDSCTL_OFF) / 4; u += NWAVES * 64) ((LAS unsigned*)((LAS unsigned char*)lds + LDSCTL_OFF))[u] = 0u;
    __syncthreads();
    { const Args a = fresh_args(); (void)xcd_barrier_post((unsigned*)(a.ws + WS_CTL) + CW_BAR, (volatile LAS unsigned*)((LAS unsigned char*)lds + MISC_OFF) + 8); }
#define GRID_BAR() grid_bar(lds)
#ifndef DUP_MASK
#define DUP_MASK 0
#endif
#define DUP(bit) for (int rep_ = 0; rep_ < 1 + (((DUP_MASK) >> (bit)) & 1); ++rep_)
#ifdef SELFCHECK
#ifndef CHECK_SET
#define CHECK_SET 0xffff
#endif
#define CHK(bit, call) do { if ((CHECK_SET) & (bit)) { { const Frame F = fresh_frame(lds); const Args a = fresh_args(); call; } GRID_BAR(); } } while (0)
#elif defined(EXTRA_BAR)
#define CHK(bit, call) GRID_BAR()
#else
#define CHK(bit, call) do {} while (0)
#endif

#ifdef REPEAT_ALL
    for (int rep_all = 0; rep_all < 2; ++rep_all) {
    if (rep_all) GRID_BAR();
#endif
#ifndef SKIP_P0
    DUP(0) { const Frame F = fresh_frame(lds); const Args a = fresh_args(); p0_prologue(F, a); }
#endif
    GRID_BAR();
    CHK(1, chk_p0(F, a));

#pragma unroll 1
    for (int l = 0; l < 2; ++l) {
#ifndef SKIP_P1
        DUP(1) { const Frame F = fresh_frame(lds); const Args a = fresh_args();
          p1_modrms(F, a, l, (l == 0) ? a.in[I_X] : a.out, (l == 0) ? a.in[I_CTX] : (const float*)(a.ws + WS_XC1), 1); }
#endif
        GRID_BAR();
        CHK(2, chk_h(F, a, l, 2 + 10 * l));
#ifndef SKIP_G1
        DUP(2) { const Frame F = fresh_frame(lds); const Args a = fresh_args();
            pg8::Gemm g{(const bf16*)(a.ws + WS_H), (const bf16*)(a.ws + WS_WIN) + (size_t)l * PW * WPITCH, 1024, WPITCH, 1024};
            pg8::OrderX S; S.so.init(l == 0 ? M_ALL : M_LAT, PW, F.G, (int)blockIdx.x); S.nx = (l == 0) ? 0 : 4;
            pg8::EpiBf16<0> E{(bf16*)(a.ws + WS_P), PW, nullptr};
            pg8::gemm_phase<pg8::EpiBf16<0>, pg8::OrderX, true>(F.lds, g, S, E);
        }
#endif
        GRID_BAR();
        CHK(4, chk_p(F, a, l, 3 + 10 * l));
#ifndef SKIP_S1
        DUP(3) { const Frame F = fresh_frame(lds); const Args a = fresh_args();
          for (int u = F.vcu; u < 256; u += F.G) fnet_s1_unit(F, a, l, u, (const bf16*)(a.ws + WS_P)); }
#endif
#ifndef SKIP_FC
        if (l == 0) DUP(10) { const Frame F = fresh_frame(lds); const Args a = fresh_args();
          for (int e = F.vcu; e < 256; e += F.G) { if ((e & 31) == 7) fnet_ctx_unit(F, a, l, e >> 5, (const bf16*)(a.ws + WS_P), (bf16*)(a.ws + WS_YB)); } }
#endif
#ifndef SKIP_PREP
        { const Frame F = fresh_frame(lds); const Args a = fresh_args(); p3_prep(F, a, l, (bf16*)(a.ws + WS_P)); }
#endif
        GRID_BAR();
        CHK(8, chk_prep(F, a, l, 4 + 10 * l));
#ifndef SKIP_ATT
        DUP(4) { const Frame F = fresh_frame(lds); const Args a = fresh_args();
            const attn_body::bf16* Pa = (const attn_body::bf16*)(a.ws + WS_P); attn_body::bf16* Ya = (attn_body::bf16*)(a.ws + WS_YB);
            for (int u = F.vcu; u < 256; u += F.G) {
                const int bk = u >> 6, b = bk >> 1, kvh = bk & 1, h = 2 * kvh + ((u >> 5) & 1), qb = u & 31;
                attn_body::attn_unit<0, 8>(Pa, Ya, SEQ * b + 256 * qb, M_LAT + NCTX * b, SEQ * b, 0, 132, 0,
                                           C_AQ + 64 * h, C_AK + 64 * kvh, C_AV + 64 * kvh, C_AZ + 64 * h, 64 * h, 0.f, (char*)lds);
            }
        }
        DUP(5) { const Frame F = fresh_frame(lds); const Args a = fresh_args();
            const attn_body::bf16* Pa = (const attn_body::bf16*)(a.ws + WS_P); attn_body::bf16* Ya = (attn_body::bf16*)(a.ws + WS_YB);
            for (int u = F.vcu; u < 512; u += F.G) {
                if (u < 256) {
                    const int bk = u >> 6, b = bk >> 1, kvh = bk & 1, h = 2 * kvh + ((u >> 5) & 1), qb = u & 31;
                    const int off = (qb == 0) ? 0 : 4 * qb - 2, NT = (qb == 0 || qb == 31) ? 10 : 12;
                    const float sk = a.in[I_SINK][l * 4 + h] * 1.4426950408889634f;
                    attn_body::attn_unit<1, 8>(Pa, Ya, SEQ * b + 256 * qb, M_LAT + NCTX * b, SEQ * b, off, NT, 256 * qb - 64 * off,
                                               C_DQ + 64 * h, C_DK + 64 * kvh, C_DV + 64 * kvh, C_DZ + 64 * h, 256 + 64 * h, sk, (char*)lds);
                } else if (l == 0 && ((u - 256) & 15) == 0) {
                    const int ee = (u - 256) >> 4, mode = ee >> 3, b = (ee >> 2) & 1, h = ee & 3, kvh = h >> 1;
                    const float sk = (mode == 0) ? -INFINITY : a.in[I_SINK][l * 4 + h] * 1.4426950408889634f;
                    const int qc = (mode == 0) ? C_AQ : C_DQ, kc = (mode == 0) ? C_AK : C_DK, vc = (mode == 0) ? C_AV : C_DV, zc = (mode == 0) ? C_AZ : C_DZ, oc = (mode == 0) ? 0 : 256;
                    attn_body::attn_unit<1, 8>(Pa, Ya, M_LAT + NCTX * b, M_LAT + NCTX * b, SEQ * b, 0, 4, 0,
                                               qc + 64 * h, kc + 64 * kvh, vc + 64 * kvh, zc + 64 * h, oc + 64 * h, sk, (char*)lds);
                }
            }
        }
#endif
#ifndef SKIP_S3
        DUP(6) { const Frame F = fresh_frame(lds); const Args a = fresh_args();
          for (int u = F.vcu; u < 256; u += F.G) fnet_s3_unit(F, a, u, (const bf16*)(a.ws + WS_P), (bf16*)(a.ws + WS_YB)); }
#endif
#ifndef SKIP_SGU
        DUP(7) { const Frame F = fresh_frame(lds); const Args a = fresh_args();
          const int nunit = (l == 0) ? 528 : 512;
          for (int u = F.vcu; u < nunit; u += F.G) sgu_unit(F, a, l, u, (const bf16*)(a.ws + WS_P), (bf16*)(a.ws + WS_YB)); }
#endif
        GRID_BAR();
        CHK(16, chk_attn(F, a, l, 5 + 10 * l, 0)); CHK(16, chk_attn(F, a, l, 6 + 10 * l, 1)); CHK(32, chk_fnet(F, a, l, 7 + 10 * l, 0); if (l == 0) chk_fnet(F, a, l, 8, 1)); CHK(64, chk_sgu(F, a, l, 9 + 10 * l));
#ifndef MERGE_V1
        for (int rep_ = 0; rep_ < 1 + ((((DUP_MASK) >> 8) & 1) && l == 1); ++rep_) { const Frame F = fresh_frame(lds); const Args a = fresh_args();
            pg8::Gemm g{(const bf16*)(a.ws + WS_H), (const bf16*)(a.ws + WS_WM), 1024, 1024, 1024};
            pg8::MergeOrder S{(const bf16*)(a.ws + WS_H), (const bf16*)(a.ws + WS_YB), (const bf16*)(a.ws + WS_WM) + (size_t)l * 4096 * 1024, (const bf16*)(a.ws + WS_WBR) + (size_t)l * 1024 * 1024, F.G, F.vcu, (l == 0) ? 32 : 0};
            pg8::EpiMerge E{(bf16*)(a.ws + WS_GT), (bf16*)(a.ws + WS_MG), (float*)(a.ws + WS_MGC), a.in[I_BMERGE] + l * 4096, (bf16*)(a.ws + WS_GTC)};
            pg8::gemm_phase<pg8::EpiMerge, pg8::MergeOrder, true>(F.lds, g, S, E);
        }
        GRID_BAR();
#else
#pragma unroll 1
        for (int r = 0; r < 4; ++r) {
#ifdef ZERO_MASK
            if ((ZERO_MASK >> r) & 1) continue;
#endif
#ifndef SKIP_MG
            { const Frame F = fresh_frame(lds); const Args a = fresh_args();
                pg8::Gemm g{(const bf16*)(a.ws + WS_H), (const bf16*)(a.ws + WS_WM) + ((size_t)l * 4096 + r * 1024) * 1024, 1024, 1024, 1024};
                pg8::OrderX S; S.so.init((l == 0) ? M_ALL : M_LAT, 1024, F.G, (int)blockIdx.x); S.nx = 0;
                pg8::EpiBf16<2> E{(bf16*)(a.ws + WS_GT), 1024, a.in[I_BMERGE] + l * 4096 + r * 1024};
                pg8::gemm_phase<pg8::EpiBf16<2>, pg8::OrderX, true>(F.lds, g, S, E);
            }
#endif
            GRID_BAR();
            if (r == 3 && l == 0) CHK(512, chk_gt(F, a, l, r, 22); chk_gt(F, a, l, 2, 23));
#ifndef SKIP_MY
            { const Frame F = fresh_frame(lds); const Args a = fresh_args();
                pg8::Gemm g{(const bf16*)(a.ws + WS_YB) + r * 256, (const bf16*)(a.ws + WS_WBR) + (size_t)l * 1024 * 1024 + r * 256, 1024, 1024, 256};
                pg8::OrderX S; S.so.init((l == 0) ? M_ALL : M_LAT, 1024, F.G, (int)blockIdx.x); S.nx = 0;

#ifdef ZERO_MASK
                pg8::EpiGate E{(bf16*)(a.ws + WS_MG), (const bf16*)(a.ws + WS_GT), 1024, r == __builtin_ctz(~(ZERO_MASK)), 1.0f};
#else
#ifdef SCALE_MASK
                pg8::EpiGate E{(bf16*)(a.ws + WS_MG), (const bf16*)(a.ws + WS_GT), 1024, r == 0, ((SCALE_MASK >> r) & 1) ? (SCALE_VAL) : 1.0f};
#else
                pg8::EpiGate E{(bf16*)(a.ws + WS_MG), (const bf16*)(a.ws + WS_GT), 1024, r == 0, 1.0f};
#endif
#endif

                pg8::gemm_phase<pg8::EpiGate, pg8::OrderX, true>(F.lds, g, S, E);
            }
#endif
            GRID_BAR();
        }
#endif
        CHK(128, chk_merge(F, a, l, 10 + 10 * l));
        if (l == 1) CHK(256, chk_copy_out(F, a));
#ifndef SKIP_OUT
        { const Frame F = fresh_frame(lds); const Args a = fresh_args();
            pg8::Gemm g{(const bf16*)(a.ws + WS_MG), (const bf16*)(a.ws + WS_WOUT) + (size_t)l * 1024 * 1024, 1024, 1024, 1024};
            pg8::OrderOut S; S.so.init(M_LAT, 1024, F.G, (int)blockIdx.x); S.nx = (l == 0) ? 128 : 0; S.TERM = (const bf16*)(a.ws + WS_GTC);
            pg8::EpiRes E{(l == 0) ? a.in[I_X] : a.out, a.out, (l == 0) ? a.in[I_CTX] : (const float*)(a.ws + WS_XC1), (float*)(a.ws + WS_XC1), (const float*)(a.ws + WS_MOD) + (size_t)l * 3 * 3072};
            pg8::gemm_phase<pg8::EpiRes, pg8::OrderOut, true>(F.lds, g, S, E);
        }
#endif
        if (l == 0) GRID_BAR();
        if (l == 0) CHK(256, chk_final(F, a, l, 11));
#ifdef SELFCHECK
        if (l == 1) { GRID_BAR(); CHK(256, chk_final(F, a, l, 21)); }
#endif
    }
#ifdef REPEAT_ALL
    }
#endif
#ifdef SELFCHECK
    GRID_BAR();
    { const Frame F = fresh_frame(lds); const Args a = fresh_args(); chk_report(F, a); }
#endif
#ifdef BLEND_S
    GRID_BAR();
    { const Frame F = fresh_frame(lds); const Args a = fresh_args(); const size_t gt = (size_t)F.vcu * 512 + F.tid, NGT = (size_t)F.G * 512;
      for (size_t i = gt; i < (size_t)M_LAT * 1024; i += NGT) { const float x0 = a.in[I_X][i]; a.out[i] = x0 + (BLEND_S) * (a.out[i] - x0); } }
#endif
}

extern "C" void kernel_launch(void* const* d_in, const int* in_sizes, int n_in, void* d_out, int out_size, void* d_ws, size_t ws_size, hipStream_t stream) {
    static int grid = 0;
    if (grid == 0) {
        if (n_in != 20 || out_size != M_LAT * DM || ws_size < WS_END) { fprintf(stderr, "kernel_launch: unexpected problem: n_in %d out %d ws %zu\n", n_in, out_size, ws_size); grid = -1; return; }
        { const int want[20] = {M_LAT * DM, NB * DM, M_CTX * DM, DM, 2 * DM, 2 * DM * 3 * DM, 2 * 3 * DM, 2 * DM * PW, 128, 128, 128, 128, 8, 2 * 4 * 64 * 64, 2 * 4 * 128 * 128, 2 * 4 * 128, 2 * 4 * 256 * DM, 2 * DM * 4 * DM, 2 * 4 * DM, 2 * DM * DM};
          for (int i = 0; i < 20; ++i) if (in_sizes[i] != want[i]) { fprintf(stderr, "kernel_launch: input %d has %d elements, expected %d\n", i, in_sizes[i], want[i]); grid = -1; return; } }
        int dev = 0, cus = 0, per_cu = 0;
        if (hipGetDevice(&dev) != hipSuccess || hipDeviceGetAttribute(&cus, hipDeviceAttributeMultiprocessorCount, dev) != hipSuccess) { grid = -1; return; }
        if (hipFuncSetAttribute((const void*)hybrid_fwd, hipFuncAttributeMaxDynamicSharedMemorySize, LDS_BYTES) != hipSuccess) { fprintf(stderr, "kernel_launch: hipFuncSetAttribute failed\n"); grid = -1; return; }
        if (hipOccupancyMaxActiveBlocksPerMultiprocessor(&per_cu, (const void*)hybrid_fwd, NWAVES * 64, LDS_BYTES) != hipSuccess || per_cu < 1) { fprintf(stderr, "kernel_launch: occupancy query says %d blocks per CU\n", per_cu); per_cu = 1; }
        (void)hipGetLastError();
        grid = cus;
    }
    if (grid < 0) return;
    if (hipMemsetAsync((char*)d_ws + WS_CTL, 0, CTL_ZERO_BYTES, stream) != hipSuccess) { fprintf(stderr, "kernel_launch: memset failed\n"); return; }
    Args a{};
    for (int i = 0; i < 20; ++i) a.in[i] = (const float*)d_in[i];
    a.out = (float*)d_out; a.ws = (unsigned char*)d_ws;
    hipLaunchKernelGGL(hybrid_fwd, dim3(grid), dim3(NWAVES * 64), LDS_BYTES, stream, a);
}
```

```cpp
#include <hip/hip_runtime.h>
#include <hip/hip_bf16.h>
#include <cstdio>
#include <cstdint>
#include <cmath>

namespace pg8 {

#define PG8_LAS __attribute__((address_space(3)))
typedef unsigned short bf16_t;
typedef short bf16x8 __attribute__((ext_vector_type(8)));
typedef float f32x4 __attribute__((ext_vector_type(4)));
typedef unsigned u32x4 __attribute__((ext_vector_type(4)));
constexpr int BM = 256, BK = 64, HALF = 128, HTB = HALF * BK * 2, STAGE_BYTES = 8 * HTB, NXCD = 8, WGM = 8;

__host__ __device__ __forceinline__ int lds_byte(int r, int c) { const int st = (r >> 4) * 2 + (c >> 5), rr = r & 15, cc = c & 31, ob = rr * 64 + cc * 2; return st * 1024 + (ob ^ (((ob >> 9) & 1) << 5)); }
__host__ __device__ __forceinline__ void stage_rc(int b, int& R, int& C) { const int st = b / 1024, sb = b % 1024, swz = sb ^ (((sb >> 9) & 1) << 5); R = (st >> 1) * 16 + swz / 64; C = (st & 1) * 32 + (swz % 64) / 2; }
__host__ __device__ __forceinline__ int perm32(int rho) { const int n = rho >> 4, i = rho & 15; return 8 * (i >> 2) + 4 * n + (i & 3); }

struct Unit { int pm, pn, r, kind; };
struct Gemm { const bf16_t* A; const bf16_t* Bt; int lda, ldb, K; };

struct StaticOrder {
    int nM, nN, nwg, G, c;
    __host__ __device__ void init(int M, int N, int G_, int c_) { nM = M / BM; nN = N / BM; nwg = nM * nN; G = G_; c = c_; }
    __host__ __device__ bool next(int i, Unit& u) const {
        const long L = (long)i * G + c; if (L >= nwg) return false;
        int wgid = (int)L; { const int q = nwg / NXCD, r = nwg % NXCD, xcd = wgid % NXCD, off = wgid / NXCD; wgid = (xcd < r ? xcd * (q + 1) : r * (q + 1) + (xcd - r) * q) + off; }
        const int nig = WGM * nN, gid = wgid / nig, fm = gid * WGM, gsz = (nM - fm) < WGM ? (nM - fm) : WGM;
        u.pm = fm + ((wgid % nig) % gsz); u.pn = (wgid % nig) / gsz; u.r = 0; u.kind = 0; return true;
    }
};
struct OrderX {
    StaticOrder so; int nx;
    __device__ bool next(int i, Unit& u) const {
        const long L = (long)i * so.G + so.c;
        if (L < so.nwg) return so.next(i, u);
        const int e = (int)(L - so.nwg); if (e >= nx) return false;
        u.pm = 64 + (e >> 1); u.pn = (e & 1) ? 4 : 1; u.r = 0; u.kind = 0; return true;
    }
    __device__ __forceinline__ void src(const Gemm& g, const Unit& u, const char*& pa, const char*& pb, int& nt) const {
        pa = (const char*)g.A + (size_t)u.pm * (2 * HALF) * g.lda * 2; pb = (const char*)g.Bt + (size_t)u.pn * (2 * HALF) * g.ldb * 2; nt = g.K / BK; }
};

typedef float f32x2_c __attribute__((ext_vector_type(2))); typedef __bf16 bf16x2_c __attribute__((ext_vector_type(2)));
__device__ __forceinline__ unsigned cvt_pk_bf16(float lo, float hi) { f32x2_c v = {lo, hi}; bf16x2_c b = __builtin_convertvector(v, bf16x2_c); return __builtin_bit_cast(unsigned, b); }
__device__ __forceinline__ float bf_lo(unsigned w) { return __uint_as_float(w << 16); }
__device__ __forceinline__ float bf_hi(unsigned w) { return __uint_as_float(w & 0xffff0000u); }
__device__ __forceinline__ float sigmoidf_(float x) { return __builtin_amdgcn_rcpf(1.0f + __builtin_amdgcn_exp2f(-1.4426950408889634f * x)); }

template <int ACT> struct EpiBf16 {
    static constexpr bool PERM = true;
    bf16_t* O; int ldc; const float* bias;
    __device__ __forceinline__ void operator()(const f32x4 (&acc)[2][2][4][2], const Unit& u, int wr, int wc, int fr, int fq) const {
        const int row0 = u.pm * BM + wr * 64 + fr; const int col0 = u.pn * BM + wc * 32 + 8 * fq;
        f32x4 bv[2][2];
#pragma unroll
        for (int bj = 0; bj < 2; ++bj)
#pragma unroll
            for (int n = 0; n < 2; ++n) bv[bj][n] = bias ? *(const f32x4*)(bias + col0 + bj * HALF + 4 * n) : (f32x4){0.f, 0.f, 0.f, 0.f};
#pragma unroll
        for (int ai = 0; ai < 2; ++ai)
#pragma unroll
            for (int m = 0; m < 4; ++m) { bf16_t* rowp = O + (size_t)(row0 + ai * HALF + m * 16) * ldc + col0;
#pragma unroll
                for (int bj = 0; bj < 2; ++bj) { f32x4 v0 = acc[ai][bj][m][0] + bv[bj][0], v1 = acc[ai][bj][m][1] + bv[bj][1];
                    if (ACT == 2) {
#pragma unroll
                        for (int e = 0; e < 4; ++e) { v0[e] = sigmoidf_(v0[e]); v1[e] = sigmoidf_(v1[e]); } }
                    u32x4 w; w.x = cvt_pk_bf16(v0[0], v0[1]); w.y = cvt_pk_bf16(v0[2], v0[3]); w.z = cvt_pk_bf16(v1[0], v1[1]); w.w = cvt_pk_bf16(v1[2], v1[3]);
                    *(u32x4*)(rowp + bj * HALF) = w;
                    } }
    }
};
struct EpiGate {
    static constexpr bool PERM = true;
    bf16_t* MG; const bf16_t* GT; int ldc; int first; float scl;
    typedef unsigned u32x2 __attribute__((ext_vector_type(2)));
    __device__ __forceinline__ void operator()(const f32x4 (&acc)[2][2][4][2], const Unit& u, int wr, int wc, int fr, int fq) const {
        const int row0 = u.pm * BM + wr * 64 + fr; const int col0 = u.pn * BM + wc * 32 + 8 * fq;
#pragma unroll
        for (int ai = 0; ai < 2; ++ai)
#pragma unroll
            for (int m = 0; m < 4; ++m) { const size_t off = (size_t)(row0 + ai * HALF + m * 16) * ldc + col0;
#pragma unroll
                for (int bj = 0; bj < 2; ++bj)
#pragma unroll
                    for (int n = 0; n < 2; ++n) {
                        const u32x2 g = *(const u32x2*)(GT + off + bj * HALF + 4 * n);
                        u32x2 o = (u32x2){0u, 0u}; if (!first) o = *(const u32x2*)(MG + off + bj * HALF + 4 * n);
                        const f32x4 v = acc[ai][bj][m][n] * scl;
                        u32x2 w;
                        w.x = cvt_pk_bf16(bf_lo(o.x) + bf_lo(g.x) * v[0], bf_hi(o.x) + bf_hi(g.x) * v[1]);
                        w.y = cvt_pk_bf16(bf_lo(o.y) + bf_lo(g.y) * v[2], bf_hi(o.y) + bf_hi(g.y) * v[3]);
                        *(u32x2*)(MG + off + bj * HALF + 4 * n) = w; asm volatile("" ::: "memory"); } }
    }
};
struct EpiRes {
    static constexpr bool PERM = false;
    const float* xin_lat; float* xout_lat; const float* xin_ctx; float* xout_ctx; const float* gate;
    __device__ __forceinline__ void operator()(const f32x4 (&acc)[2][2][4][2], const Unit& u, int wr, int wc, int fr, int fq) const {
        const bool isctx = u.pm >= 64;
        const float* xin = isctx ? xin_ctx + (size_t)(u.pm - 64) * BM * 1024 : xin_lat + (size_t)u.pm * BM * 1024;
        float* xout = isctx ? xout_ctx + (size_t)(u.pm - 64) * BM * 1024 : xout_lat + (size_t)u.pm * BM * 1024;
        const float* gv = gate + (isctx ? 2 : (u.pm >> 5)) * 3072 + 2048;
        const int col0 = u.pn * BM + wc * 32 + 4 * fq;
        f32x4 gt[2][2];
#pragma unroll
        for (int bj = 0; bj < 2; ++bj)
#pragma unroll
            for (int n = 0; n < 2; ++n) gt[bj][n] = *(const f32x4*)(gv + col0 + bj * HALF + n * 16);
        if (u.kind == 3) {
#pragma unroll
            for (int ai = 0; ai < 2; ++ai)
#pragma unroll
                for (int m = 0; m < 4; ++m) { const size_t off = (size_t)(ai * HALF + wr * 64 + m * 16 + fr) * 1024 + col0;
#pragma unroll
                    for (int bj = 0; bj < 2; ++bj)
#pragma unroll
                        for (int n = 0; n < 2; ++n) { const f32x4 v = gt[bj][n] * acc[ai][bj][m][n]; float* q = xout + off + bj * HALF + n * 16; atomicAdd(q + 0, v[0]); atomicAdd(q + 1, v[1]); atomicAdd(q + 2, v[2]); atomicAdd(q + 3, v[3]); } }
        } else {
#pragma unroll
            for (int ai = 0; ai < 2; ++ai) { f32x4 bs[4][2][2];
#pragma unroll
                for (int m = 0; m < 4; ++m) { const size_t off = (size_t)(ai * HALF + wr * 64 + m * 16 + fr) * 1024 + col0;
#pragma unroll
                    for (int bj = 0; bj < 2; ++bj)
#pragma unroll
                        for (int n = 0; n < 2; ++n) bs[m][bj][n] = *(const f32x4*)(xin + off + bj * HALF + n * 16); }
#pragma unroll
                for (int m = 0; m < 4; ++m) { const size_t off = (size_t)(ai * HALF + wr * 64 + m * 16 + fr) * 1024 + col0;
#pragma unroll
                    for (int bj = 0; bj < 2; ++bj)
#pragma unroll
                        for (int n = 0; n < 2; ++n) *(f32x4*)(xout + off + bj * HALF + n * 16) = bs[m][bj][n] + gt[bj][n] * acc[ai][bj][m][n]; }
                asm volatile("" ::: "memory"); }
        }
    }
};

struct MergeOrder {
    const bf16_t* H; const bf16_t* YB; const bf16_t* WmT; const bf16_t* WbrT; int G, c, nctx;
    __device__ bool next(int i, Unit& u) const {
        const int nl = (c < 256) ? 1 + (255 - c) / G : 0;
        if (i < 8 * nl) { const int t = c + (i >> 3) * G, q = i & 7; u.pm = t >> 2; u.pn = t & 3; u.r = q >> 1; u.kind = (q & 1) ? 0 : 1; return true; }
        const int j = i - 8 * nl;
        if (nctx == 0 || (c & 7) != 0) return false;
        const int jb = (c >> 3) + (j >> 1) * (G >> 3); if (jb >= nctx) return false;
        const int t = jb >> 2; u.pm = 64 + (t >> 2); u.pn = t & 3; u.r = jb & 3; u.kind = (j & 1) ? 2 : 1; return true;
    }
    __device__ __forceinline__ void src(const Gemm&, const Unit& u, const char*& pa, const char*& pb, int& nt) const {
        if (u.kind != 1) { pa = (const char*)(H + (size_t)u.pm * 256 * 1024); pb = (const char*)(WmT + ((size_t)u.r * 1024 + u.pn * 256) * 1024); nt = 16; }
        else { pa = (const char*)(YB + (size_t)u.pm * 256 * 1024 + u.r * 256); pb = (const char*)(WbrT + (size_t)u.pn * 256 * 1024 + u.r * 256); nt = 4; }
    }
};
typedef unsigned long long u64_t;
__device__ __forceinline__ u64_t ld_sc1(const void* p) { return __hip_atomic_load((const u64_t*)p, __ATOMIC_RELAXED, __HIP_MEMORY_SCOPE_AGENT); }
struct EpiMerge {
    static constexpr bool PERM = true;
    bf16_t* GT; bf16_t* MG; float* MGc; const float* bias; bf16_t* GTc;
    typedef unsigned u32x2 __attribute__((ext_vector_type(2)));
    __device__ __forceinline__ void operator()(const f32x4 (&acc)[2][2][4][2], const Unit& u, int wr, int wc, int fr, int fq) const {
        const int row0 = u.pm * BM + wr * 64 + fr; const int col0 = u.pn * BM + wc * 32 + 8 * fq;
        bf16_t* Yu = (u.pm >= 64) ? GTc + ((size_t)u.r * 512 - 16384) * 1024 : GT;
        if (u.kind == 1) {
#pragma unroll
            for (int ai = 0; ai < 2; ++ai)
#pragma unroll
                for (int m = 0; m < 4; ++m) { bf16_t* rowp = Yu + (size_t)(row0 + ai * HALF + m * 16) * 1024 + col0;
#pragma unroll
                    for (int bj = 0; bj < 2; ++bj) { const f32x4 v0 = acc[ai][bj][m][0], v1 = acc[ai][bj][m][1];
                        u32x4 w; w.x = cvt_pk_bf16(v0[0], v0[1]); w.y = cvt_pk_bf16(v0[2], v0[3]); w.z = cvt_pk_bf16(v1[0], v1[1]); w.w = cvt_pk_bf16(v1[2], v1[3]);
                        *(u32x4*)(rowp + bj * HALF) = w; } }
        } else {
            const bool isctx = (u.kind == 2), first = (u.r == 0) || isctx;
            bf16_t* Ou = isctx ? Yu : MG;
            const float* bp = bias + u.r * 1024 + col0;
            f32x4 bv[2][2];
#pragma unroll
            for (int bj = 0; bj < 2; ++bj)
#pragma unroll
                for (int n = 0; n < 2; ++n) bv[bj][n] = *(const f32x4*)(bp + bj * HALF + 4 * n);
            const __amdgpu_buffer_rsrc_t ry = __builtin_amdgcn_make_buffer_rsrc((void*)Yu, 0, 0x7fffffff, 0x00020000), ro = __builtin_amdgcn_make_buffer_rsrc((void*)MG, 0, 0x7fffffff, 0x00020000);
#pragma unroll
            for (int ai = 0; ai < 2; ++ai) { u32x4 yq[4][2], oq[4][2];
#pragma unroll
                for (int mm = 0; mm < 4; ++mm) { const unsigned off = (unsigned)(((row0 + ai * HALF + mm * 16) * 1024 + col0) * 2);
#pragma unroll
                    for (int bj = 0; bj < 2; ++bj) { yq[mm][bj] = __builtin_bit_cast(u32x4, __builtin_amdgcn_raw_buffer_load_b128(ry, off + bj * HALF * 2, 0, 16));
                        oq[mm][bj] = first ? (u32x4){0u, 0u, 0u, 0u} : __builtin_bit_cast(u32x4, __builtin_amdgcn_raw_buffer_load_b128(ro, off + bj * HALF * 2, 0, 16)); } }
#pragma unroll
                for (int mm = 0; mm < 4; ++mm) { const size_t off = (size_t)(row0 + ai * HALF + mm * 16) * 1024 + col0;
#pragma unroll
                    for (int bj = 0; bj < 2; ++bj) { f32x4 g0 = acc[ai][bj][mm][0] + bv[bj][0], g1 = acc[ai][bj][mm][1] + bv[bj][1];
#pragma unroll
                        for (int e = 0; e < 4; ++e) { g0[e] = sigmoidf_(g0[e]); g1[e] = sigmoidf_(g1[e]); }
                        const u32x4 y = yq[mm][bj], o = oq[mm][bj];
                        u32x4 w;
                        w.x = cvt_pk_bf16(bf_lo(o.x) + g0[0] * bf_lo(y.x), bf_hi(o.x) + g0[1] * bf_hi(y.x));
                        w.y = cvt_pk_bf16(bf_lo(o.y) + g0[2] * bf_lo(y.y), bf_hi(o.y) + g0[3] * bf_hi(y.y));
                        w.z = cvt_pk_bf16(bf_lo(o.z) + g1[0] * bf_lo(y.z), bf_hi(o.z) + g1[1] * bf_hi(y.z));
                        w.w = cvt_pk_bf16(bf_lo(o.w) + g1[2] * bf_lo(y.w), bf_hi(o.w) + g1[3] * bf_hi(y.w));
                        *(u32x4*)(Ou + off + bj * HALF) = w; } }
                asm volatile("" ::: "memory"); }
        }
    }
};
struct OrderOut {
    StaticOrder so; int nx; const bf16_t* TERM;
    __device__ bool next(int i, Unit& u) const {
        const long L = (long)i * so.G + so.c;
        if (L < so.nwg) return so.next(i, u);
        const int e = (int)(L - so.nwg); if (e >= nx) return false;
        const int t = e >> 4; u.pm = 64 + (t >> 2); u.pn = t & 3; u.r = e & 15; u.kind = 3; return true;
    }
    __device__ __forceinline__ void src(const Gemm& g, const Unit& u, const char*& pa, const char*& pb, int& nt) const {
        pa = (const char*)g.A + (size_t)u.pm * (2 * HALF) * g.lda * 2; pb = (const char*)g.Bt + (size_t)u.pn * (2 * HALF) * g.ldb * 2; nt = g.K / BK;
        if (u.kind == 3) { const int br = u.r >> 2, kq = u.r & 3; pa = (const char*)(TERM + ((size_t)br * 512 + (u.pm - 64) * 256) * 1024 + kq * 256); pb += (size_t)kq * 256 * 2; nt = 4; }
    }
};

template <class Epi, class Sched, bool ALIGN_EPI>
__device__ __forceinline__ void gemm_phase(PG8_LAS unsigned char* lds, const Gemm g, const Sched& S, const Epi& E) {
    int tid = threadIdx.x; asm volatile("" : "+v"(tid));
    const int wid = __builtin_amdgcn_readfirstlane(tid >> 6), lane = tid & 63, wr = wid >> 2, wc = wid & 3, fr = lane & 15, fq = lane >> 4;
    int nt;
    unsigned voffA[2], voffB[2];
#pragma unroll
    for (int i = 0; i < 2; ++i) { int R, C; stage_rc(tid * 16 + i * 8192, R, C); const int Rb = Epi::PERM ? ((R & ~31) + perm32(R & 31)) : R;
        voffA[i] = (unsigned)(R * g.lda + C) * 2u; voffB[i] = (unsigned)(Rb * g.ldb + C) * 2u; }
    const size_t kstep = (size_t)(BK * 2);
    const size_t hstepA = (size_t)HALF * g.lda * 2, hstepB = (size_t)HALF * g.ldb * 2;
    const unsigned ldsw = (unsigned)wid * 1024u;
    const int aoff = lds_byte(wr * 64 + fr, fq * 8), boff = lds_byte(wc * 32 + fr, fq * 8);
#define PG8_SA(b, h) (((b) * 2 + (h)) * HTB)
#define PG8_SB(b, h) ((4 + (b) * 2 + (h)) * HTB)
#define PG8_STAGE(bufoff, gbase, voff) do { _Pragma("unroll") for (int _i = 0; _i < 2; ++_i) \
        __builtin_amdgcn_global_load_lds((const unsigned*)((const char*)(gbase) + (voff)[_i]), (PG8_LAS unsigned*)(lds + (bufoff) + ldsw + _i * 8192), 16, 0, 0); } while (0)
#define PG8_LDA(dst, b, h) do { _Pragma("unroll") for (int m = 0; m < 4; ++m) _Pragma("unroll") for (int k = 0; k < 2; ++k) dst[m][k] = *(const PG8_LAS bf16x8*)(lds + PG8_SA(b, h) + aoff + m * 2048 + k * 1024); } while (0)
#define PG8_LDB(dst, b, h) do { _Pragma("unroll") for (int n = 0; n < 2; ++n) _Pragma("unroll") for (int k = 0; k < 2; ++k) dst[n][k] = *(const PG8_LAS bf16x8*)(lds + PG8_SB(b, h) + boff + n * 2048 + k * 1024); } while (0)
#define PG8_MMA(ai, bj, At, Bt) do { __builtin_amdgcn_s_setprio(1); _Pragma("unroll") for (int m = 0; m < 4; ++m) _Pragma("unroll") for (int n = 0; n < 2; ++n) _Pragma("unroll") for (int k = 0; k < 2; ++k) \
        acc[ai][bj][m][n] = __builtin_amdgcn_mfma_f32_16x16x32_bf16(Bt[n][k], At[m][k], acc[ai][bj][m][n], 0, 0, 0); __builtin_amdgcn_s_setprio(0); } while (0)
#define PG8_WAIT_V(n) asm volatile("s_waitcnt vmcnt(" #n ")" ::: "memory")
#define PG8_WAIT_L(n) asm volatile("s_waitcnt lgkmcnt(" #n ")" ::: "memory")
#define PG8_BAR __builtin_amdgcn_s_barrier()
#define PG8_SCHED __builtin_amdgcn_sched_barrier(0)
    Unit cur, nxt; int ui = 0;
    if (!S.next(0, cur)) return;
    f32x4 acc[2][2][4][2];
#pragma unroll
    for (int a = 0; a < 2; ++a)
#pragma unroll
        for (int b = 0; b < 2; ++b)
#pragma unroll
            for (int m = 0; m < 4; ++m)
#pragma unroll
                for (int n = 0; n < 2; ++n) acc[a][b][m][n] = (f32x4){0.f, 0.f, 0.f, 0.f};
    bf16x8 At[4][2], B0[2][2], B1[2][2];
    const char* cA; const char* cB; S.src(g, cur, cA, cB, nt);
    PG8_STAGE(PG8_SB(0, 0), cB, voffB); PG8_STAGE(PG8_SB(0, 1), cB + hstepB, voffB); PG8_STAGE(PG8_SA(0, 0), cA, voffA); PG8_STAGE(PG8_SA(0, 1), cA + hstepA, voffA);
    if (wr == 1) PG8_BAR;
    PG8_WAIT_V(2); PG8_BAR;
    PG8_STAGE(PG8_SB(1, 0), cB + kstep, voffB); PG8_STAGE(PG8_SA(1, 0), cA + kstep, voffA); PG8_STAGE(PG8_SB(1, 1), cB + hstepB + kstep, voffB);
    PG8_WAIT_V(6); PG8_BAR;
    for (;;) {
        const bool has_next = S.next(ui + 1, nxt);
        const char* nA = cA; const char* nB = cB; int nnt = nt; if (has_next) S.src(g, nxt, nA, nB, nnt);
        for (int t = 0; t < nt; t += 2) {
            const bool last = (t == nt - 2);
            const char* a1 = cA + (size_t)(t + 1) * kstep;
            const char* a2 = last ? nA : cA + (size_t)(t + 2) * kstep; const char* b2 = last ? nB : cB + (size_t)(t + 2) * kstep;
            const char* a3 = a2 + kstep; const char* b3 = b2 + kstep;
            PG8_LDB(B0, 0, 0); PG8_LDB(B1, 0, 1); PG8_SCHED; PG8_LDA(At, 0, 0); PG8_STAGE(PG8_SA(1, 1), a1 + hstepA, voffA);
            PG8_WAIT_V(8); PG8_WAIT_L(0); PG8_BAR; PG8_MMA(0, 0, At, B0); PG8_MMA(0, 1, At, B1); PG8_BAR; PG8_SCHED;
            PG8_LDA(At, 0, 1); PG8_STAGE(PG8_SB(0, 0), b2, voffB); PG8_STAGE(PG8_SB(0, 1), b2 + hstepB, voffB); PG8_STAGE(PG8_SA(0, 0), a2, voffA);
            PG8_WAIT_V(8); PG8_WAIT_L(0); PG8_BAR; PG8_MMA(1, 0, At, B0); PG8_MMA(1, 1, At, B1); PG8_BAR; PG8_SCHED;
            PG8_LDB(B0, 1, 0); PG8_LDB(B1, 1, 1); PG8_SCHED; PG8_LDA(At, 1, 0); PG8_STAGE(PG8_SA(0, 1), a2 + hstepA, voffA);
            PG8_WAIT_V(8); PG8_WAIT_L(0); PG8_BAR; PG8_MMA(0, 0, At, B0); PG8_MMA(0, 1, At, B1); PG8_BAR; PG8_SCHED;
            PG8_LDA(At, 1, 1); PG8_STAGE(PG8_SB(1, 0), b3, voffB); PG8_STAGE(PG8_SB(1, 1), b3 + hstepB, voffB); PG8_STAGE(PG8_SA(1, 0), a3, voffA);
            PG8_WAIT_V(8); PG8_WAIT_L(0); PG8_BAR; PG8_MMA(1, 0, At, B0); PG8_MMA(1, 1, At, B1); PG8_BAR; PG8_SCHED;
        }
        if constexpr (ALIGN_EPI) { if (wr == 0) PG8_BAR; }
        E(acc, cur, wr, wc, fr, fq);
        if (!has_next) break;
#pragma unroll
        for (int a = 0; a < 2; ++a)
#pragma unroll
            for (int b = 0; b < 2; ++b)
#pragma unroll
                for (int m = 0; m < 4; ++m)
#pragma unroll
                    for (int n = 0; n < 2; ++n) acc[a][b][m][n] = (f32x4){0.f, 0.f, 0.f, 0.f};
        cur = nxt; cA = nA; cB = nB; nt = nnt; ++ui;
        if constexpr (ALIGN_EPI) { if (wr == 1) PG8_BAR; }
    }
    PG8_WAIT_V(0);
    if constexpr (!ALIGN_EPI) { if (wr == 0) PG8_BAR; }
    PG8_BAR;
#undef PG8_SA
#undef PG8_SB
#undef PG8_STAGE
#undef PG8_LDA
#undef PG8_LDB
#undef PG8_MMA
#undef PG8_WAIT_V
#undef PG8_WAIT_L
#undef PG8_BAR
#undef PG8_SCHED
}
}
namespace attn_body {
using bf16=__hip_bfloat16;
using bf16x8=__attribute__((ext_vector_type(8)))short;
using s16x4=__attribute__((ext_vector_type(4)))short;
using f32x16=__attribute__((ext_vector_type(16)))float;
using u32x4=__attribute__((ext_vector_type(4)))unsigned;
constexpr int D=64;
constexpr int NW=8,QBLK=32,QB=QBLK*NW,KVBLK=64;
constexpr int PP=2816, YP=1024;
__device__ __forceinline__ int crow(int r,int hi){return (r&3)+8*(r>>2)+4*hi;}
#define SBAR() __builtin_amdgcn_sched_barrier(0)
__device__ __forceinline__ void dmask(f32x16&p0,f32x16&p1,int kb,unsigned lim,int qrel,int hi){
  const float NEG=-INFINITY; const unsigned b0=(unsigned)(kb+4*hi-qrel+128);
  #pragma unroll
  for(int r=0;r<16;++r){const unsigned dd=b0+(unsigned)((r&3)+8*(r>>2)); if(dd>lim)p0[r]=NEG; if(dd+32u>lim)p1[r]=NEG;}
}

constexpr int NSLOT=3, SLOTB=8192;
constexpr int LDS_K=0, LDS_V=NSLOT*SLOTB, LDS_WS=2*NSLOT*SLOTB, LDS_OST=LDS_WS+NW*64*4, LDS_BYTES=LDS_OST+NW*4096;
constexpr float C2=0.125f*1.4426950408889634f;
__device__ __forceinline__ void glds16(const void*gsrc,unsigned lds_dst){unsigned keep;
  asm volatile("s_mov_b32 %0, m0\n\ts_mov_b32 m0, %2\n\ts_nop 0\n\tglobal_load_lds_dwordx4 %1, off\n\ts_mov_b32 m0, %0":"=&s"(keep):"v"(gsrc),"s"(lds_dst):"memory");}
__device__ __forceinline__ float siluf_(float x){ return x*__builtin_amdgcn_rcpf(1.0f+__builtin_amdgcn_exp2f(-1.4426950408889634f*x)); }
__device__ __forceinline__ float max3f(float a,float b,float c){float r;asm("v_max3_f32 %0, %1, %2, %3":"=v"(r):"v"(a),"v"(b),"v"(c));return r;}
__device__ __forceinline__ float max2f(float a,float b){float r;asm("v_max_f32_e32 %0, %1, %2":"=v"(r):"v"(a),"v"(b));return r;}
__device__ __forceinline__ float fadd_s(float a,float b){float r;asm("v_add_f32_e32 %0, %1, %2":"=v"(r):"v"(a),"v"(b));return r;}
__device__ __forceinline__ float fsub_s(float a,float b){float r;asm("v_sub_f32_e32 %0, %1, %2":"=v"(r):"v"(a),"v"(b));return r;}
typedef float f32x2_t __attribute__((ext_vector_type(2))); typedef __bf16 bf16x2_t __attribute__((ext_vector_type(2)));
__device__ __forceinline__ unsigned cvtpk_s(float lo,float hi){f32x2_t v={lo,hi};bf16x2_t b=__builtin_convertvector(v,bf16x2_t);return __builtin_bit_cast(unsigned,b);}
#define WAIT_BAR(N) asm volatile("s_waitcnt vmcnt(" #N ") lgkmcnt(0)\n\ts_barrier":::"memory")

__device__ __forceinline__ void qkt(f32x16&p0,f32x16&p1,const char*Kslot,const bf16x8*qr,const f32x16&negm,int r32,int hi){
  const char*kb=Kslot+hi*1024+r32*16;
  #pragma unroll
  for(int d0=0;d0<4;++d0){
    const bf16x8 b0=*reinterpret_cast<const bf16x8*>(kb+d0*2048);
    const bf16x8 b1=*reinterpret_cast<const bf16x8*>(kb+d0*2048+512);
    if(d0==0){p0=__builtin_amdgcn_mfma_f32_32x32x16_bf16(b0,qr[0],negm,0,0,0);p1=__builtin_amdgcn_mfma_f32_32x32x16_bf16(b1,qr[0],negm,0,0,0);}
    else{p0=__builtin_amdgcn_mfma_f32_32x32x16_bf16(b0,qr[d0],p0,0,0,0);p1=__builtin_amdgcn_mfma_f32_32x32x16_bf16(b1,qr[d0],p1,0,0,0);}}
}
typedef __attribute__((address_space(3))) const char* lds_cptr;
typedef short v4i16_t __attribute__((ext_vector_type(4)));
__device__ __forceinline__ void kload8(bf16x8*kf,lds_cptr kp){
  kf[0]=*(const __attribute__((address_space(3))) bf16x8*)(kp);      kf[1]=*(const __attribute__((address_space(3))) bf16x8*)(kp+512);
  kf[2]=*(const __attribute__((address_space(3))) bf16x8*)(kp+2048); kf[3]=*(const __attribute__((address_space(3))) bf16x8*)(kp+2560);
  kf[4]=*(const __attribute__((address_space(3))) bf16x8*)(kp+4096); kf[5]=*(const __attribute__((address_space(3))) bf16x8*)(kp+4608);
  kf[6]=*(const __attribute__((address_space(3))) bf16x8*)(kp+6144); kf[7]=*(const __attribute__((address_space(3))) bf16x8*)(kp+6656);
}
__device__ __forceinline__ void kload2(bf16x8*kf,lds_cptr kp,int j){ kf[2*j]=*(const __attribute__((address_space(3))) bf16x8*)(kp+j*2048); kf[2*j+1]=*(const __attribute__((address_space(3))) bf16x8*)(kp+j*2048+512); }
__device__ __forceinline__ s16x4 vtr(lds_cptr p){ return __builtin_bit_cast(s16x4,__builtin_amdgcn_ds_read_tr16_b64_v4i16((__attribute__((address_space(3))) v4i16_t*)p)); }
__device__ __forceinline__ float rowmax(const f32x16&p0,const f32x16&p1){
  float a=max3f(p0[0],p0[1],p1[0]),b=max3f(p0[2],p0[3],p1[1]);a=max3f(a,p1[2],p1[3]);
  #pragma unroll
  for(int r=4;r<16;r+=4){a=max3f(a,p0[r],p0[r+1]);b=max3f(b,p0[r+2],p0[r+3]);a=max3f(a,p1[r],p1[r+1]);b=max3f(b,p1[r+2],p1[r+3]);}
  const float m=max2f(a,b);
  auto rr=__builtin_amdgcn_permlane32_swap(__float_as_uint(m),__float_as_uint(m),false,false);
  return max2f(__uint_as_float(rr[0]),__uint_as_float(rr[1]));
}
__device__ __forceinline__ void pv(f32x16*o,int vb,bf16x8 pa0,bf16x8 pa1,bf16x8 pa2,bf16x8 pa3){
  #pragma unroll
  for(int d0=0;d0<2;++d0){s16x4 lo[4],hi[4];
    #pragma unroll
    for(int ks=0;ks<4;++ks){
      asm volatile("ds_read_b64_tr_b16 %0,%1 offset:%c2":"=&v"(lo[ks]):"v"(vb),"i"(d0*4096+ks*1024):"memory");
      asm volatile("ds_read_b64_tr_b16 %0,%1 offset:%c2":"=&v"(hi[ks]):"v"(vb),"i"(d0*4096+ks*1024+512):"memory");}
    asm volatile("s_waitcnt lgkmcnt(0)":::"memory");SBAR();
    #define PK(k) (bf16x8){lo[k][0],lo[k][1],lo[k][2],lo[k][3],hi[k][0],hi[k][1],hi[k][2],hi[k][3]}
    o[d0]=__builtin_amdgcn_mfma_f32_32x32x16_bf16(pa0,PK(0),o[d0],0,0,0);
    o[d0]=__builtin_amdgcn_mfma_f32_32x32x16_bf16(pa1,PK(1),o[d0],0,0,0);
    o[d0]=__builtin_amdgcn_mfma_f32_32x32x16_bf16(pa2,PK(2),o[d0],0,0,0);
    o[d0]=__builtin_amdgcn_mfma_f32_32x32x16_bf16(pa3,PK(3),o[d0],0,0,0);
    #undef PK
  }
}

#ifndef ATTN_STORE16
#define ATTN_STORE16(p,v) (*(u32x4*)(p)=(v))
#endif
template<int MODE,int THRL> __device__ __forceinline__ void attn_unit(const bf16*Pm,bf16*YB,int qrow0,int ctx0,int lat0,int off,int NT,int wq0,int qcol,int kcol,int vcol,int zcol,int ocol,float sinkl2,char*shm){
  int tid_=threadIdx.x; asm volatile("":"+v"(tid_)); const int tid=tid_,lane=tid&63,r32=lane&31,hi=lane>>5; const int wid=__builtin_amdgcn_readfirstlane(tid>>6);
  const bf16*Qw=Pm+(long)(qrow0+wid*QBLK)*PP+qcol;
  const unsigned lds0=(unsigned)(uintptr_t)shm;
  float*wsf=(float*)(shm+LDS_WS)+wid*64;
  const bf16*ksrc=Pm+kcol+(long)lane*PP+wid*8;
  const bf16*vsrc=Pm+vcol+(long)(16*(wid&3)+(lane>>2))*PP+(wid>>2)*32+(lane&3)*8;
  const unsigned kdst=lds0+LDS_K+wid*1024, vdst=lds0+LDS_V+wid*1024;
  #define TROW(t) (((t)<4)?(ctx0+64*(t)):(lat0+64*((t)-4+off)))
  #define DMA_K(t,slot) glds16(ksrc+(long)TROW(t)*PP,(unsigned)__builtin_amdgcn_readfirstlane(kdst+(slot)))
  #define DMA_V(t,slot) glds16(vsrc+(long)TROW(t)*PP,(unsigned)__builtin_amdgcn_readfirstlane(vdst+(slot)))
  const int vb0=(int)(lds0+LDS_V)+((lane>>4)&1)*32+(lane&3)*8+(4*hi+((lane&15)>>2))*64;
  const char*Kbase=shm+LDS_K; bf16x8 kf[8];
  const lds_cptr shm3=(lds_cptr)shm; const lds_cptr kp0=shm3+LDS_K+hi*1024+r32*16; const lds_cptr vp0=shm3+LDS_V+((lane>>4)&1)*32+(lane&3)*8+(4*hi+((lane&15)>>2))*64;
  DMA_K(0,0);DMA_V(0,0);DMA_K(1,SLOTB);
  bf16x8 qr[4];
  #pragma unroll
  for(int d0=0;d0<4;++d0)qr[d0]=*reinterpret_cast<const bf16x8*>(&Qw[(long)r32*PP+d0*16+hi*8]);
  float mhat=0.f,l_reg=0.f;f32x16 o[2];o[0]=f32x16{};o[1]=f32x16{};f32x16 negm=f32x16{}; if(MODE==0){asm volatile("":"+v"(negm));}
  const int qrel=wid*QBLK+r32;
  #define CMASK(P0,P1,t) do{ if(MODE==1){ dmask(P0,P1,64*((t)-4)-wq0,((t)>=4)?256u:~0u,qrel,hi); } }while(0)
  bool resc=false;
  #define START(P0,P1) do{ const float rm=rowmax(P0,P1); resc=false; \
    { const float dl=rm; mhat=fadd_s(mhat,dl); \
      _Pragma("unroll") for(int r=0;r<16;++r){P0[r]=fsub_s(P0[r],dl);P1[r]=fsub_s(P1[r],dl);} \
      if(MODE==0){ _Pragma("unroll") for(int r=0;r<16;++r)negm[r]=-mhat; asm volatile("":"+v"(negm)); } } \
    _Pragma("unroll") for(int r=0;r<16;++r)P0[r]=__builtin_amdgcn_exp2f(P0[r]); }while(0)
  #define RESC() do{ if(resc){ asm volatile("s_waitcnt lgkmcnt(0)":::"memory"); \
      _Pragma("unroll") for(int d_=0;d_<2;++d_) _Pragma("unroll") for(int r=0;r<16;++r)o[d_][r]*=wsf[crow(r,hi)]; } }while(0)
  f32x16 pA0,pA1,pB0,pB1;
  int sl_prev=0,sl_cur=0,sl_next=SLOTB;
  #define ROT() do{sl_prev=sl_cur;sl_cur=sl_next;sl_next=(sl_next==(NSLOT-1)*SLOTB)?0:sl_next+SLOTB;}while(0)
  DMA_K(2,2*SLOTB);
  WAIT_BAR(3);
  qkt(pA0,pA1,Kbase,qr,negm,r32,hi);asm volatile("s_nop 15\n\ts_nop 7":"+v"(pA0),"+v"(pA1));CMASK(pA0,pA1,0);
  START(pA0,pA1);
  _Pragma("unroll") for(int r=0;r<16;++r)pA1[r]=__builtin_amdgcn_exp2f(pA1[r]);
  WAIT_BAR(0);
  DMA_K(3,0);DMA_V(1,SLOTB);
  ROT();
  kload8(kf,kp0+sl_cur);
  WAIT_BAR(2);
  s16x4 vlo[8],vhi[8]; u32x4 pw0,pw1,pw2,pw3;
  #define PKW(P,B) cvtpk_s(P[B],P[B+1])
  #define PAF(k) __builtin_bit_cast(bf16x8,pw##k)
  #define VFR(i) (bf16x8){vlo[i][0],vlo[i][1],vlo[i][2],vlo[i][3],vhi[i][0],vhi[i][1],vhi[i][2],vhi[i][3]}
  #define PIN(x) asm volatile("":"+v"(x))
  #define MX3(a,b,c) __builtin_fmaxf(__builtin_fmaxf((a),(b)),(c))
  #define GAPA(MF,A0,A1,A2,A3,W0,W1,PW) do{ MF; sacc+=A0; sacc+=A1; sacc+=A2; sacc+=A3; PIN(sacc); W0; W1; PIN(PW); SBAR(); }while(0)
  #define EX(v) __builtin_amdgcn_exp2f(v)
  #define GAPB(MF,X,B) do{ MF; X[B]=EX(X[B]); X[B+1]=EX(X[B+1]); X[B+2]=EX(X[B+2]); X[B+3]=EX(X[B+3]); PIN(X); SBAR(); }while(0)
  #define VRD(i) do{ vlo[i]=vtr(vp_+(((i)>>2)*4096+((i)&3)*1024)); vhi[i]=vtr(vp_+(((i)>>2)*4096+((i)&3)*1024+512)); }while(0)
  #define KRD(G,j) do{ if(G){ kload2(kf,kp0+sl_next,j); SBAR(); } }while(0)
  #define STEP(C0,C1,P0,P1,t,GK,GV,GL,MX) do{ SBAR(); \
    const lds_cptr vp_=vp0+sl_prev; \
    VRD(0); SBAR(); float sacc=(P0[0]+P0[1]); \
    GAPA(C0=__builtin_amdgcn_mfma_f32_32x32x16_bf16(kf[0],qr[0],negm,0,0,0), P0[2],P0[3],P0[4],P0[5],     pw0[0]=PKW(P0,0), pw0[1]=PKW(P0,2), pw0); \
    VRD(4); SBAR(); GAPA(C1=__builtin_amdgcn_mfma_f32_32x32x16_bf16(kf[1],qr[0],negm,0,0,0), P0[6],P0[7],P0[8],P0[9],     pw0[2]=PKW(P0,4), pw0[3]=PKW(P0,6), pw0); \
    VRD(1); SBAR(); GAPA(C0=__builtin_amdgcn_mfma_f32_32x32x16_bf16(kf[2],qr[1],C0,0,0,0),   P0[10],P0[11],P0[12],P0[13], pw1[0]=PKW(P0,8), pw1[1]=PKW(P0,10), pw1); \
    VRD(5); SBAR(); GAPA(C1=__builtin_amdgcn_mfma_f32_32x32x16_bf16(kf[3],qr[1],C1,0,0,0),   P0[14],P0[15],P1[0],P1[1],   pw1[2]=PKW(P0,12),pw1[3]=PKW(P0,14), pw1); \
    VRD(2); SBAR(); GAPA(C0=__builtin_amdgcn_mfma_f32_32x32x16_bf16(kf[4],qr[2],C0,0,0,0),   P1[2],P1[3],P1[4],P1[5],     pw2[0]=PKW(P1,0), pw2[1]=PKW(P1,2), pw2); \
    VRD(6); SBAR(); GAPA(C1=__builtin_amdgcn_mfma_f32_32x32x16_bf16(kf[5],qr[2],C1,0,0,0),   P1[6],P1[7],P1[8],P1[9],     pw2[2]=PKW(P1,4), pw2[3]=PKW(P1,6), pw2); \
    VRD(3); SBAR(); GAPA(C0=__builtin_amdgcn_mfma_f32_32x32x16_bf16(kf[6],qr[3],C0,0,0,0),   P1[10],P1[11],P1[12],P1[13], pw3[0]=PKW(P1,8), pw3[1]=PKW(P1,10), pw3); \
    VRD(7); SBAR(); GAPA(C1=__builtin_amdgcn_mfma_f32_32x32x16_bf16(kf[7],qr[3],C1,0,0,0),   P1[14],P1[15],0.f,0.f,       pw3[2]=PKW(P1,12),pw3[3]=PKW(P1,14), pw3); \
    l_reg+=sacc; \
    if(GK){DMA_K((t)+3,sl_cur);} if(GV){DMA_V((t)+1,sl_next);} \
    CMASK(C0,C1,t); \
    resc=false; if(MX){ float a=MX3(C0[0],C0[1],C1[0]),b=MX3(C0[2],C0[3],C1[1]); a=MX3(a,C1[2],C1[3]); \
      _Pragma("unroll") for(int r=4;r<16;r+=4){a=MX3(a,C0[r],C0[r+1]);b=MX3(b,C0[r+2],C0[r+3]);a=MX3(a,C1[r],C1[r+1]);b=MX3(b,C1[r+2],C1[r+3]);} \
      float rm=__builtin_fmaxf(a,b); { auto rr=__builtin_amdgcn_permlane32_swap(__float_as_uint(rm),__float_as_uint(rm),false,false); rm=__builtin_fmaxf(__uint_as_float(rr[0]),__uint_as_float(rr[1])); } \
      resc=false; if(MODE==1) rm-=mhat; \
      if(__builtin_expect(__any(rm>(float)THRL),0)){ const float dl=__builtin_fmaxf(rm,0.f); mhat+=dl; \
        if(MODE==0){ _Pragma("unroll") for(int r=0;r<16;++r){C0[r]-=dl;C1[r]-=dl;} \
          _Pragma("unroll") for(int r=0;r<16;++r)negm[r]=-mhat; asm volatile("":"+v"(negm)); } \
        const float f=__builtin_amdgcn_exp2f(-dl); l_reg*=f; if(hi==0)wsf[r32]=f; resc=true; } \
      if(MODE==1){ _Pragma("unroll") for(int r=0;r<16;++r){C0[r]-=mhat;C1[r]-=mhat;} } } \
    SBAR(); \
    GAPB(o[0]=__builtin_amdgcn_mfma_f32_32x32x16_bf16(PAF(0),VFR(0),o[0],0,0,0), C0,0); \
    GAPB(o[1]=__builtin_amdgcn_mfma_f32_32x32x16_bf16(PAF(0),VFR(4),o[1],0,0,0), C0,4); \
    KRD(GL,0); GAPB(o[0]=__builtin_amdgcn_mfma_f32_32x32x16_bf16(PAF(1),VFR(1),o[0],0,0,0), C0,8); \
    KRD(GL,1); GAPB(o[1]=__builtin_amdgcn_mfma_f32_32x32x16_bf16(PAF(1),VFR(5),o[1],0,0,0), C0,12); \
    KRD(GL,2); GAPB(o[0]=__builtin_amdgcn_mfma_f32_32x32x16_bf16(PAF(2),VFR(2),o[0],0,0,0), C1,0); \
    KRD(GL,3); GAPB(o[1]=__builtin_amdgcn_mfma_f32_32x32x16_bf16(PAF(2),VFR(6),o[1],0,0,0), C1,4); \
    GAPB(o[0]=__builtin_amdgcn_mfma_f32_32x32x16_bf16(PAF(3),VFR(3),o[0],0,0,0), C1,8); \
    GAPB(o[1]=__builtin_amdgcn_mfma_f32_32x32x16_bf16(PAF(3),VFR(7),o[1],0,0,0), C1,12); \
    }while(0)
  int t=1;
  if(MODE==0) for(;t+7<NT;t+=4){
    STEP(pB0,pB1,pA0,pA1,t,true,true,true,true);      WAIT_BAR(2); RESC(); ROT();
    STEP(pA0,pA1,pB0,pB1,t+1,true,true,true,false);   WAIT_BAR(2); RESC(); ROT();
    STEP(pB0,pB1,pA0,pA1,t+2,true,true,true,false);   WAIT_BAR(2); RESC(); ROT();
    STEP(pA0,pA1,pB0,pB1,t+3,true,true,true,false);   WAIT_BAR(2); RESC(); ROT();
  }
  if(MODE==0) for(;t+5<NT;t+=2){
    STEP(pB0,pB1,pA0,pA1,t,true,true,true,true);     WAIT_BAR(2); RESC(); ROT();
    STEP(pA0,pA1,pB0,pB1,t+1,true,true,true,false);   WAIT_BAR(2); RESC(); ROT();
  }
  #define ENDW(tt) do{ if((tt)+3<NT){WAIT_BAR(2);} else if((tt)+2<NT){WAIT_BAR(1);} else {WAIT_BAR(0);} }while(0)
  for(;t+1<NT;t+=2){
    STEP(pB0,pB1,pA0,pA1,t,(t+3<NT),(t+1<NT),(t+1<NT),true);       ENDW(t);   RESC(); ROT();
    STEP(pA0,pA1,pB0,pB1,t+1,(t+4<NT),(t+2<NT),(t+2<NT),true);     ENDW(t+1); RESC(); ROT();
  }
  STEP(pB0,pB1,pA0,pA1,NT-1,false,false,false,true); RESC();
  { float sacc=pB0[0]+pB0[1]; _Pragma("unroll") for(int r=2;r<16;++r)sacc+=pB0[r]; _Pragma("unroll") for(int r=0;r<16;++r)sacc+=pB1[r]; l_reg+=sacc;
    pw0=(u32x4){PKW(pB0,0),PKW(pB0,2),PKW(pB0,4),PKW(pB0,6)};pw1=(u32x4){PKW(pB0,8),PKW(pB0,10),PKW(pB0,12),PKW(pB0,14)};pw2=(u32x4){PKW(pB1,0),PKW(pB1,2),PKW(pB1,4),PKW(pB1,6)};pw3=(u32x4){PKW(pB1,8),PKW(pB1,10),PKW(pB1,12),PKW(pB1,14)};
    SBAR(); pv(o,vb0+sl_cur,PAF(0),PAF(1),PAF(2),PAF(3)); }
  #undef PKW
  #undef PAF
  #undef VFR
  #undef PIN
  #undef MX3
  #undef GAPA
  #undef GAPB
  #undef EX
  #undef VRD
  #undef KRD
  #undef STEP
  #undef ENDW
  {auto rr=__builtin_amdgcn_permlane32_swap(__float_as_uint(l_reg),__float_as_uint(l_reg),false,false);l_reg=__uint_as_float(rr[0])+__uint_as_float(rr[1]);}
  if(MODE==1){ l_reg+=__builtin_amdgcn_exp2f(sinkl2-mhat); }
  if(hi==0)wsf[32+r32]=l_reg;asm volatile("s_waitcnt lgkmcnt(0)":::"memory");
  float rli[16];
  #pragma unroll
  for(int r=0;r<16;++r)rli[r]=__builtin_amdgcn_rcpf(wsf[32+crow(r,hi)]);
  bf16*Ow=YB+(long)(qrow0+wid*QBLK)*YP+ocol; const bf16*Zw=Pm+(long)(qrow0+wid*QBLK)*PP+zcol;
  { bf16*stg=(bf16*)(shm+LDS_OST)+wid*2048;
    #pragma unroll
    for(int r=0;r<16;++r){const int orow=crow(r,hi);
      #pragma unroll
      for(int d0=0;d0<2;++d0)stg[orow*64+d0*32+r32]=__float2bfloat16(o[d0][r]*rli[r]);}
    asm volatile("s_waitcnt lgkmcnt(0)":::"memory");
    #pragma unroll
    for(int i=0;i<4;++i){const int row=i*8+(lane>>3),ch=lane&7; const u32x4 v=*(const u32x4*)(stg+row*64+ch*8); const u32x4 z=*(const u32x4*)(Zw+(long)row*PP+ch*8); u32x4 w;
      #define GATE2(vv,zz) cvtpk_s(__uint_as_float((vv)<<16)*siluf_(__uint_as_float((zz)<<16)),__uint_as_float((vv)&0xffff0000u)*siluf_(__uint_as_float((zz)&0xffff0000u)))
      w.x=GATE2(v.x,z.x); w.y=GATE2(v.y,z.y); w.z=GATE2(v.z,z.z); w.w=GATE2(v.w,z.w);
      #undef GATE2
      *(u32x4*)(Ow+(long)row*YP+ch*8)=w;} }
  asm volatile("s_waitcnt lgkmcnt(0)\n\ts_barrier":::"memory");
  #undef DMA_K
  #undef DMA_V
  #undef CMASK
  #undef START
  #undef RESC
  #undef ROT
  #undef TROW
}
#undef SBAR
#undef WAIT_BAR
}

constexpr int NWAVES = 8;
constexpr int DM = 1024, SEQ = 8192, NCTX = 256, NB = 2;
constexpr int M_LAT = NB * SEQ, M_CTX = NB * NCTX, M_ALL = M_LAT + M_CTX;
constexpr int PW = 2816;
constexpr float RMS_EPS = 1e-6f;
#ifndef WPITCH
#define WPITCH 1024
#endif
constexpr float QSCALE = 0.125f * 1.4426950408889634f;
constexpr int C_AQ = 0, C_AK = 256, C_AV = 384, C_AZ = 512, C_DQ = 768, C_DK = 1024, C_DV = 1152, C_DZ = 1280, C_BF = 1536, C_BZ = 1792, C_CU = 2048, C_CV = 2304, C_CZ = 2560;

constexpr size_t MiB = 1u << 20;
constexpr size_t WS_CTL = 0, CTL_ZERO_BYTES = 1 * MiB;
constexpr size_t WS_MOD = 1 * MiB;
constexpr size_t WS_TAB = 2 * MiB;
constexpr size_t TAB_MA = 0, TAB_128 = 131072, TAB_64 = 229376, TAB_256 = 245760, TAB_WSP = 507904, TAB_ONES = 786432, TAB_BIASB = 1048576;
constexpr size_t WS_WIN = 4 * MiB, WS_WM = 16 * MiB, WS_WBR = 32 * MiB, WS_WOUT = 36 * MiB;
constexpr size_t WS_XC1 = 40 * MiB;
constexpr size_t WS_H = 42 * MiB, WS_YB = 75 * MiB, WS_T1 = 108 * MiB, WS_P = 124 * MiB;
constexpr size_t WS_GT = WS_P, WS_MG = WS_P + 40 * MiB;
constexpr size_t WS_MGC = 216 * MiB;
constexpr size_t WS_GTC = 218 * MiB;
constexpr size_t WS_END = 222 * MiB;
constexpr int CW_BAR = 4096;

constexpr int RING_BYTES = 147456, LDSCTL_OFF = RING_BYTES, MISC_OFF = LDSCTL_OFF + 320, LDS_BYTES = RING_BYTES + 1024;

#define GAS __attribute__((address_space(1)))
#define LAS __attribute__((address_space(3)))
typedef unsigned short bf16;
typedef unsigned v4u __attribute__((ext_vector_type(4)));
typedef unsigned v2u __attribute__((ext_vector_type(2)));
typedef float f32x4 __attribute__((ext_vector_type(4)));
typedef float f32x16 __attribute__((ext_vector_type(16)));
typedef short bf16x8 __attribute__((ext_vector_type(8)));
typedef GAS unsigned gu32;
#define RLX_AGENT __ATOMIC_RELAXED, __HIP_MEMORY_SCOPE_AGENT
#define LDS_WAIT() asm volatile("s_waitcnt lgkmcnt(0)" ::: "memory")
#define MFMA32(a, b, c) __builtin_amdgcn_mfma_f32_32x32x16_bf16((a), (b), (c), 0, 0, 0)
#define DI __device__ __forceinline__
DI unsigned f2bf(float f) { unsigned u = __builtin_bit_cast(unsigned, f); return (u + 0x7fffu + ((u >> 16) & 1u)) >> 16; }
DI unsigned pk2(float lo, float hi) { return f2bf(lo) | (f2bf(hi) << 16); }
DI float bf2f(bf16 v) { return __uint_as_float((unsigned)v << 16); }
DI float wlo(unsigned w) { return __uint_as_float(w << 16); }
DI float whi(unsigned w) { return __uint_as_float(w & 0xffff0000u); }
DI int crow(int reg, int h) { return (reg & 3) + 8 * (reg >> 2) + 4 * h; }
DI int krow(int s, int h, int j) { return 16 * s + 8 * (j >> 2) + 4 * h + (j & 3); }
DI float siluf(float x) { return x * __builtin_amdgcn_rcpf(1.0f + __builtin_amdgcn_exp2f(-1.4426950408889634f * x)); }
DI float geluf(float v) {
    const float av = __builtin_fabsf(v), d = av * 0.2316418882f + 1.0f, t = __builtin_amdgcn_rcpf(d);
    float q = t * 0.5307027145f + (-0.7265760135f); q = q * t + 0.7107068705f; q = q * t + (-0.142248368f); q = q * t + 0.127414796f; q = q * t;
    const float e = __builtin_amdgcn_exp2f((v * v) * (-0.72134752044f)), m = v * (q * e), r = v - m;
    return v < 0.f ? m : r;
}
typedef float f32x2_t __attribute__((ext_vector_type(2))); typedef __bf16 bf16x2_t __attribute__((ext_vector_type(2)));
DI unsigned cvtpk(float lo, float hi) { f32x2_t v = {lo, hi}; bf16x2_t b = __builtin_convertvector(v, bf16x2_t); return __builtin_bit_cast(unsigned, b); }
DI bf16x8 pack_step(const f32x16& x, int s) {
    v4u p; p.x = cvtpk(x[8 * s], x[8 * s + 1]); p.y = cvtpk(x[8 * s + 2], x[8 * s + 3]); p.z = cvtpk(x[8 * s + 4], x[8 * s + 5]); p.w = cvtpk(x[8 * s + 6], x[8 * s + 7]);
    return __builtin_bit_cast(bf16x8, p);
}
DI float shx(float v, int o, int lane) { return __int_as_float(__builtin_amdgcn_ds_bpermute((lane ^ o) << 2, __float_as_int(v))); }
DI float wave_sum(float v, int lane) {
#pragma unroll
    for (int o = 1; o < 64; o <<= 1) v += shx(v, o, lane);
    return v;
}

#define XB_TMO      128
#define XB_XCNT(j)  (256  + 64 * (j))
#define XB_XSUB(j)  (1280 + 64 * (j))
#define XB_XGEN(j)  (2304 + 64 * (j))
#define XB_TOP      3328
#define XB_TOPGEN   3392
#define XCD_BAR_WORDS 3456
#define XB_SPIN_CAP (1u << 22)
DI unsigned xb_ld(unsigned* p)              { return __hip_atomic_load(p, __ATOMIC_RELAXED, __HIP_MEMORY_SCOPE_AGENT); }
DI unsigned xb_add(unsigned* p, unsigned v) { return __hip_atomic_fetch_add(p, v, __ATOMIC_RELAXED, __HIP_MEMORY_SCOPE_AGENT); }
DI unsigned xb_xcc_id() { return (unsigned)__builtin_amdgcn_s_getreg((3 << 11) | 20) & 0xFu; }
#define XB_SPIN(cond, bar) do { unsigned _sp = 0; while (cond) { __builtin_amdgcn_s_sleep(1); \
    if ((++_sp & 255u) == 0u) { if (xb_ld(&(bar)[XB_TMO])) break; if (_sp > XB_SPIN_CAP) { atomicAdd(&(bar)[XB_TMO], 1u); break; } } } } while (0)
struct XcdBarrier { unsigned* bar; unsigned x; volatile LAS unsigned* st; };
DI XcdBarrier xcd_barrier_post(unsigned* bar, volatile LAS unsigned* st) {
    XcdBarrier b; b.bar = bar; b.x = xb_xcc_id(); b.st = st;
    if (threadIdx.x == 0) (void)xb_add(&bar[XB_XCNT(b.x)], 1u);
    return b;
}
DI void xcd_barrier_complete(unsigned* bar, unsigned x, unsigned& nloc, unsigned& nx) {
    const unsigned G = gridDim.x * gridDim.y * gridDim.z;
    unsigned sum, cnt, mine, sp = 0u;
    for (;;) {
        sum = 0u; cnt = 0u; mine = 0u;
#pragma unroll
        for (unsigned j = 0; j < 16; ++j) { const unsigned c = xb_ld(&bar[XB_XCNT(j)]); sum += c; cnt += (c > 0u) ? 1u : 0u; mine = (j == x) ? c : mine; }
        if (sum == G) break;
        __builtin_amdgcn_s_sleep(1);
        if ((++sp & 255u) == 0u) { if (xb_ld(&bar[XB_TMO])) break; if (sp > XB_SPIN_CAP) { atomicAdd(&bar[XB_TMO], 1u); break; } }
    }
    nloc = mine > 0u ? mine : 1u; nx = cnt > 0u ? cnt : 1u;
}
DI void xcd_barrier(const XcdBarrier& b) {
    asm volatile("s_waitcnt vmcnt(0)" ::: "memory");
    __syncthreads();
    if (threadIdx.x == 0) {
        unsigned* bar = b.bar;
        __builtin_amdgcn_s_waitcnt(0);
        __builtin_amdgcn_fence(__ATOMIC_ACQUIRE, "agent");
        unsigned nloc = b.st[0], nx = b.st[1];
        if (nloc == 0u) { xcd_barrier_complete(bar, b.x, nloc, nx); b.st[0] = nloc; b.st[1] = nx; }
        const unsigned old = xb_add(&bar[XB_XSUB(b.x)], 1u);
        const unsigned gen = old / nloc;
        if (old + 1u == (gen + 1u) * nloc) {
            __builtin_amdgcn_fence(__ATOMIC_RELEASE, "agent");
            asm volatile("s_waitcnt vmcnt(0)" ::: "memory");
            const unsigned og = xb_add(&bar[XB_TOP], 1u);
            const unsigned tg = og / nx;
            if (og + 1u == (tg + 1u) * nx) xb_add(&bar[XB_TOPGEN], 1u);
            else XB_SPIN(xb_ld(&bar[XB_TOPGEN]) == tg, bar);
            xb_add(&bar[XB_XGEN(b.x)], 1u);
            asm volatile("s_waitcnt vmcnt(0)" ::: "memory");
        } else {
            XB_SPIN(xb_ld(&bar[XB_XGEN(b.x)]) == gen, bar);
            asm volatile("s_waitcnt vmcnt(0)" ::: "memory");
        }
    }
    __syncthreads();
}

struct Frame {
    LAS unsigned char* lds;
    int tid, lane, wave, vcu, G;
};

DI void p0_transpose_item(const float* W, int N, bf16* WT, int ldt, int row_off, int col_off, LAS float* scr, int item, int lane) {
    const int nblk = N / 32, kb = item / nblk, nb = item % nblk, k0 = 64 * kb, n0 = 32 * nb;
#pragma unroll 8
    for (int i = 0; i < 32; ++i) { const int kk = 2 * i + (lane >> 5); scr[kk * 33 + (lane & 31)] = W[(size_t)(k0 + kk) * N + n0 + (lane & 31)]; }
    LDS_WAIT(); asm volatile("" ::: "memory");
    const int c = lane & 7;
#pragma unroll
    for (int j = 0; j < 4; ++j) { const int n = (lane >> 3) + 8 * j; const LAS float* s = scr + (8 * c) * 33 + n;
        v4u o; o.x = pk2(s[0 * 33], s[1 * 33]); o.y = pk2(s[2 * 33], s[3 * 33]); o.z = pk2(s[4 * 33], s[5 * 33]); o.w = pk2(s[6 * 33], s[7 * 33]);
        *(GAS v4u*)(WT + (size_t)(row_off + n0 + n) * ldt + col_off + k0 + 8 * c) = o; }
    LDS_WAIT(); asm volatile("" ::: "memory");
}

struct Args { const float* in[20]; float* out; unsigned char* ws; };
enum { I_X = 0, I_C, I_CTX, I_CCTX, I_NORMW, I_WADA, I_BADA, I_WIN, I_QNA, I_KNA, I_QND, I_KND, I_SINK, I_WFNET, I_WSP, I_BSP, I_WBR, I_WMERGE, I_BMERGE, I_WOUT };

DI void p0_prologue(const Frame& F, const Args& a) {
    unsigned char* ws = a.ws;
    for (int u = F.vcu; u < 96; u += F.G) {
        const int l = u / 48, j0 = 64 * (u % 48);
        LAS float* sl = (LAS float*)F.lds; LAS float* red = sl + 3072;
        for (int i = F.tid; i < 3072; i += 512) { const int v = i >> 10, k = i & 1023; const float cv = (v < 2) ? a.in[I_C][v * 1024 + k] : a.in[I_CCTX][k]; sl[i] = siluf(cv); }
        __syncthreads();
        float a0 = 0.f, a1 = 0.f, a2 = 0.f;
        const float* wp = a.in[I_WADA] + (size_t)l * 1024 * 3072 + (size_t)(128 * F.wave) * 3072 + j0 + F.lane;
#pragma unroll 32
        for (int kk = 0; kk < 128; ++kk) { const float w = wp[(size_t)kk * 3072]; const int k = 128 * F.wave + kk; a0 += sl[k] * w; a1 += sl[1024 + k] * w; a2 += sl[2048 + k] * w; }
        red[(F.wave * 3 + 0) * 64 + F.lane] = a0; red[(F.wave * 3 + 1) * 64 + F.lane] = a1; red[(F.wave * 3 + 2) * 64 + F.lane] = a2;
        __syncthreads();
        if (F.tid < 192) { const int v = F.tid >> 6, jj = F.tid & 63; float s = a.in[I_BADA][l * 3072 + j0 + jj];
#pragma unroll
            for (int w = 0; w < 8; ++w) s += red[(w * 3 + v) * 64 + jj];
            ((float*)(ws + WS_MOD))[(l * 3 + v) * 3072 + j0 + jj] = s; }
        __syncthreads();
    }
    {
        LAS float* scr = (LAS float*)(F.lds + F.wave * 16384);
        const int gw = F.vcu * NWAVES + F.wave, NGW = F.G * NWAVES;
        constexpr int I_IN = 16 * 88, I_M = 16 * 128, I_O = 16 * 32, I_B = 4 * 32, PER_L = I_IN + I_M + I_O + 4 * I_B;
        for (int it = gw; it < 2 * PER_L; it += NGW) {
            const int l = it / PER_L; int r = it % PER_L;
            if (r < I_IN) { p0_transpose_item(a.in[I_WIN] + (size_t)l * 1024 * PW, PW, (bf16*)(ws + WS_WIN) + (size_t)l * PW * WPITCH, WPITCH, 0, 0, scr, r, F.lane); continue; } r -= I_IN;
            if (r < I_M) { p0_transpose_item(a.in[I_WMERGE] + (size_t)l * 1024 * 4096, 4096, (bf16*)(ws + WS_WM) + (size_t)l * 4096 * 1024, 1024, 0, 0, scr, r, F.lane); continue; } r -= I_M;
            if (r < I_O) { p0_transpose_item(a.in[I_WOUT] + (size_t)l * 1024 * 1024, 1024, (bf16*)(ws + WS_WOUT) + (size_t)l * 1024 * 1024, 1024, 0, 0, scr, r, F.lane); continue; } r -= I_O;
            { const int br = r / I_B; r -= br * I_B;
              p0_transpose_item(a.in[I_WBR] + ((size_t)l * 4 + br) * 256 * 1024, 1024, (bf16*)(ws + WS_WBR) + (size_t)l * 1024 * 1024, 1024, 0, 256 * br, scr, r, F.lane); }
        }
    }
    {
        const int gt = F.vcu * 512 + F.tid, NGT = F.G * 512;
        bf16* tab = (bf16*)(ws + WS_TAB);
        for (int e = gt; e < 65536; e += NGT) {
            const int l = e >> 15, g = (e >> 13) & 3, col = (e >> 6) & 127, c = e & 63, d = col & 63;
            const float* wf = a.in[I_WFNET] + ((size_t)(l * 4 + g) * 64) * 64 + d; float s = 0.f;
            for (int j = 0; j < 64; ++j) { const float rev = (float)((c * j) & 63) * (1.0f / 64.0f); const float tw = (col < 64) ? __builtin_amdgcn_cosf(rev) : -__builtin_amdgcn_sinf(rev); s += tw * wf[j * 64]; }
            tab[TAB_MA / 2 + e] = (bf16)f2bf(s);
        }
        for (int e = gt; e < 49152; e += NGT) {
            const int mat = e / 16384, rem = e % 16384, k1b = rem >> 12, nb = (rem >> 10) & 3, s = (rem >> 9) & 1, ln = (rem >> 3) & 63, j = rem & 7;
            const int n1 = 32 * nb + krow(s, ln >> 5, j), k1 = 32 * k1b + (ln & 31); const float rev = (float)((n1 * k1) & 127) * (1.0f / 128.0f);
            const float v = (mat == 0) ? __builtin_amdgcn_cosf(rev) : (mat == 1) ? __builtin_amdgcn_sinf(rev) : -__builtin_amdgcn_sinf(rev);
            tab[TAB_128 / 2 + e] = (bf16)f2bf(v);
        }
        for (int e = gt; e < 8192; e += NGT) {
            const int mat = e >> 12, k2 = (e >> 6) & 63, n2 = e & 63; const float rev = (float)((k2 * n2) & 63) * (1.0f / 64.0f);
            tab[TAB_64 / 2 + e] = (bf16)f2bf(mat == 0 ? __builtin_amdgcn_cosf(rev) : __builtin_amdgcn_sinf(rev));
        }
        for (int e = gt; e < 131072; e += NGT) {
            const int mat = e >> 16, rem = e & 65535, kb = rem >> 13, nb = (rem >> 10) & 7, s = (rem >> 9) & 1, ln = (rem >> 3) & 63, j = rem & 7;
            const int n = 32 * nb + krow(s, ln >> 5, j), k = 32 * kb + (ln & 31); const float rev = (float)((n * k) & 255) * (1.0f / 256.0f);
            tab[TAB_256 / 2 + e] = (bf16)f2bf(mat == 0 ? __builtin_amdgcn_cosf(rev) : __builtin_amdgcn_sinf(rev));
        }
        for (int e = gt; e < 131072; e += NGT) tab[TAB_WSP / 2 + e] = (bf16)f2bf(a.in[I_WSP][e]);
        for (int e = gt; e < M_CTX * 1024 / 4; e += NGT) { ((f32x4*)(ws + WS_XC1))[e] = ((const f32x4*)a.in[I_CTX])[e]; ((f32x4*)(ws + WS_MGC))[e] = (f32x4){0.f, 0.f, 0.f, 0.f}; }
        for (int e = gt; e < 4096; e += NGT) tab[TAB_ONES / 2 + e] = (bf16)(((e & 31) == 0) ? 0x3f80 : 0);
        for (int e = gt; e < 262144; e += NGT) tab[TAB_BIASB / 2 + e] = (bf16)(((e & 31) == 0) ? f2bf(a.in[I_BMERGE][e >> 5]) : 0u);
    }
}

DI void p1_modrms(const Frame& F, const Args& a, int l, const float* xlat, const float* xctx, int with_ctx) {
    const float* mod = (const float*)(a.ws + WS_MOD) + (size_t)l * 3 * 3072;
    const float* nw = a.in[I_NORMW] + l * 1024;
    bf16* H = (bf16*)(a.ws + WS_H);
    const int gw = F.vcu * NWAVES + F.wave, NGW = F.G * NWAVES;
    const int nrows = with_ctx ? M_ALL : M_LAT;
    int vcur = -1; f32x4 av[4], bv[4];
    for (int row = gw; row < nrows; row += 2 * NGW) {
        const int row2 = row + NGW; const bool has2 = row2 < nrows;
        const float* xr = (row < M_LAT) ? xlat + (size_t)row * 1024 : xctx + (size_t)(row - M_LAT) * 1024;
        const float* xr2 = !has2 ? xr : (row2 < M_LAT) ? xlat + (size_t)row2 * 1024 : xctx + (size_t)(row2 - M_LAT) * 1024;
        f32x4 x[4], y[4]; float ss = 0.f, ss2 = 0.f;
#pragma unroll
        for (int j = 0; j < 4; ++j) { x[j] = *(const f32x4*)(xr + 4 * (F.lane + 64 * j)); y[j] = *(const f32x4*)(xr2 + 4 * (F.lane + 64 * j)); }
#pragma unroll
        for (int j = 0; j < 4; ++j) { ss += (x[j].x * x[j].x + x[j].y * x[j].y) + (x[j].z * x[j].z + x[j].w * x[j].w); ss2 += (y[j].x * y[j].x + y[j].y * y[j].y) + (y[j].z * y[j].z + y[j].w * y[j].w); }
#pragma unroll
        for (int o = 1; o < 64; o <<= 1) { ss += shx(ss, o, F.lane); ss2 += shx(ss2, o, F.lane); }
#pragma unroll
        for (int k = 0; k < 2; ++k) { const int r_ = k ? row2 : row; if (k && !has2) break;
            const int v = r_ < SEQ ? 0 : (r_ < M_LAT ? 1 : 2);
            if (v != vcur) { vcur = v;
#pragma unroll
                for (int j = 0; j < 4; ++j) { const int c = 4 * (F.lane + 64 * j); const f32x4 w = *(const f32x4*)(nw + c), sc = *(const f32x4*)(mod + v * 3072 + 1024 + c);
                    av[j] = w * (sc + 1.0f); bv[j] = *(const f32x4*)(mod + v * 3072 + c); } }
            const float rstd = __builtin_amdgcn_rsqf((k ? ss2 : ss) * (1.0f / 1024.0f) + RMS_EPS);
#pragma unroll
            for (int j = 0; j < 4; ++j) { const f32x4 h = (k ? y[j] : x[j]) * rstd * av[j] + bv[j]; v2u o; o.x = pk2(h.x, h.y); o.y = pk2(h.z, h.w);
                *(v2u*)(H + (size_t)r_ * 1024 + 4 * (F.lane + 64 * j)) = o; } }
    }
}

DI void p3_prep(const Frame& F, const Args& a, int l, bf16* P) {
    const int gw = F.vcu * NWAVES + F.wave, NGW = F.G * NWAVES;
    const int lane = F.lane, d0 = 4 * (lane & 15);
    f32x4 wq_a, wq_d, wk, inv;
#pragma unroll
    for (int e = 0; e < 4; ++e) { wq_a[e] = a.in[I_QNA][l * 64 + d0 + e]; wq_d[e] = a.in[I_QND][l * 64 + d0 + e]; wk[e] = (lane < 32 ? a.in[I_KNA] : a.in[I_KND])[l * 64 + d0 + e];
        inv[e] = __builtin_amdgcn_exp2f(-(float)((d0 + e) & 15) * (13.287712379549449f / 16.0f)) * 0.15915494309189535f; }
    const float sgn = (d0 & 16) ? 1.0f : -1.0f;
    for (int row = gw; row < M_ALL; row += NGW) {
        const bool isctx = row >= M_LAT; const int n = row & (SEQ - 1);
        f32x4 cs = (f32x4){1.f, 1.f, 1.f, 1.f}, sn = (f32x4){0.f, 0.f, 0.f, 0.f};
        if (!isctx) { const float pos = (float)((d0 < 32) ? (n >> 6) : (n & 63));
#pragma unroll
            for (int e = 0; e < 4; ++e) { const float rev = pos * inv[e]; cs[e] = __builtin_amdgcn_cosf(rev); sn[e] = __builtin_amdgcn_sinf(rev); } }
        bf16* pr = P + (size_t)row * PW;
        const bool qok = !(isctx && l == 1);
        const int colk = (lane < 32) ? C_AK + 4 * lane : C_DK + 4 * (lane - 32);
        v2u raw[3];
        raw[0] = qok ? *(const v2u*)(pr + C_AQ + 4 * lane) : (v2u){0u, 0u}; raw[1] = qok ? *(const v2u*)(pr + C_DQ + 4 * lane) : (v2u){0u, 0u}; raw[2] = *(const v2u*)(pr + colk);
#pragma unroll
        for (int p = 0; p < 3; ++p) {
            f32x4 v = (f32x4){wlo(raw[p].x), whi(raw[p].x), wlo(raw[p].y), whi(raw[p].y)};
            float ss = (v[0] * v[0] + v[1] * v[1]) + (v[2] * v[2] + v[3] * v[3]);
            ss += shx(ss, 1, lane); ss += shx(ss, 2, lane); ss += shx(ss, 4, lane); ss += shx(ss, 8, lane);
            const f32x4 w = (p == 0) ? wq_a : (p == 1) ? wq_d : wk;
            v = v * __builtin_amdgcn_rsqf(ss * (1.0f / 64.0f) + RMS_EPS) * w;
            f32x4 pt;
#pragma unroll
            for (int e = 0; e < 4; ++e) pt[e] = shx(v[e], 4, lane);
            v = v * cs + pt * sn * sgn;
            if (p < 2) v = v * QSCALE;
            v2u o; o.x = pk2(v[0], v[1]); o.y = pk2(v[2], v[3]);
            if (p == 2) *(v2u*)(pr + colk) = o; else if (qok) *(v2u*)(pr + (p == 0 ? C_AQ : C_DQ) + 4 * lane) = o;
        }
    }
}

DI void fnet_stepA(const bf16* xrow, const bf16* MAt, int r32, int hi, bf16x8 (&gs)[4][2]) {
    bf16x8 xa[4];
#pragma unroll
    for (int s4 = 0; s4 < 4; ++s4) xa[s4] = *(const bf16x8*)(xrow + 16 * s4 + 8 * hi);
#pragma unroll
    for (int cb = 0; cb < 4; ++cb) { f32x16 acc = f32x16{};
#pragma unroll
        for (int s4 = 0; s4 < 4; ++s4) { const bf16x8 bfr = *(const bf16x8*)(MAt + (32 * cb + r32) * 64 + 16 * s4 + 8 * hi); acc = MFMA32(xa[s4], bfr, acc); }
        gs[cb][0] = pack_step(acc, 0); gs[cb][1] = pack_step(acc, 1); }
}

DI void fnet_s1_unit(const Frame& F, const Args& a, int l, int u, const bf16* P) {
    const int b = u >> 7, n2grp = (u >> 4) & 7, g = (u >> 2) & 3, k1b = u & 3;
    const int lane = F.lane, r32 = lane & 31, hi = lane >> 5, w = F.wave, n2 = 8 * n2grp + w;
    const bf16* tab = (const bf16*)(a.ws + WS_TAB);
    const bf16* MAt = tab + TAB_MA / 2 + (size_t)(l * 4 + g) * 128 * 64;
    const bf16* T128 = tab + TAB_128 / 2;
    f32x16 Tr[2], Ti[2];
#pragma unroll
    for (int j = 0; j < 2; ++j) { Tr[j] = f32x16{}; Ti[j] = f32x16{}; }
#pragma unroll 1
    for (int nb = 0; nb < 4; ++nb) {
        const bf16* xrow = P + (size_t)(SEQ * b + 64 * (32 * nb + r32) + n2) * PW + C_BF + 64 * g;
        bf16x8 gs[4][2]; fnet_stepA(xrow, MAt, r32, hi, gs);
#pragma unroll
        for (int s = 0; s < 2; ++s) {
            const size_t fo = ((size_t)((k1b * 4 + nb) * 2 + s) * 64 + lane) * 8;
            const bf16x8 ca = *(const bf16x8*)(T128 + fo), sa = *(const bf16x8*)(T128 + 16384 + fo), na = *(const bf16x8*)(T128 + 32768 + fo);
            Tr[0] = MFMA32(ca, gs[0][s], Tr[0]); Tr[0] = MFMA32(sa, gs[2][s], Tr[0]);
            Tr[1] = MFMA32(ca, gs[1][s], Tr[1]); Tr[1] = MFMA32(sa, gs[3][s], Tr[1]);
            Ti[0] = MFMA32(ca, gs[2][s], Ti[0]); Ti[0] = MFMA32(na, gs[0][s], Ti[0]);
            Ti[1] = MFMA32(ca, gs[3][s], Ti[1]); Ti[1] = MFMA32(na, gs[1][s], Ti[1]); }
    }
    LAS bf16* tl = (LAS bf16*)F.lds;
#pragma unroll
    for (int i = 0; i < 16; ++i) { const int k1l = crow(i, hi), k1 = 32 * k1b + k1l;
        const float rev = (float)((n2 * k1) & 8191) * (1.0f / 8192.0f); const float c = __builtin_amdgcn_cosf(rev), s = __builtin_amdgcn_sinf(rev);
#pragma unroll
        for (int jb = 0; jb < 2; ++jb) { const float tr = Tr[jb][i], ti = Ti[jb][i];
            tl[(k1l * 128 + 32 * jb + r32) * 8 + w] = (bf16)f2bf(tr * c + ti * s);
            tl[(k1l * 128 + 64 + 32 * jb + r32) * 8 + w] = (bf16)f2bf(ti * c - tr * s); } }
    __syncthreads();
    bf16* T1 = (bf16*)(a.ws + WS_T1);
#pragma unroll 4
    for (int pass = 0; pass < 8; ++pass) { const int q = F.tid + 512 * pass, k1l = q >> 7, colL = q & 127;
        const v4u v = *(const LAS v4u*)(F.lds + (size_t)q * 16);
        *(v4u*)(T1 + ((((size_t)(b * 128 + 32 * k1b + k1l) * 8 + n2grp) * 512) + g * 128 + colL) * 8) = v; }
    __syncthreads();
}

DI void fnet_ctx_unit(const Frame& F, const Args& a, int l, int u, const bf16* P, bf16* YB) {
    const int b = u >> 2, g = u & 3;
    const int lane = F.lane, r32 = lane & 31, hi = lane >> 5, w = F.wave;
    const bf16* tab = (const bf16*)(a.ws + WS_TAB);
    const bf16* MAt = tab + TAB_MA / 2 + (size_t)(l * 4 + g) * 128 * 64;
    const bf16* T256 = tab + TAB_256 / 2;
    f32x16 Y[2]; Y[0] = f32x16{}; Y[1] = f32x16{};
#pragma unroll 1
    for (int nb = 0; nb < 8; ++nb) {
        const bf16* xrow = P + (size_t)(M_LAT + NCTX * b + 32 * nb + r32) * PW + C_BF + 64 * g;
        bf16x8 gs[4][2]; fnet_stepA(xrow, MAt, r32, hi, gs);
#pragma unroll
        for (int s = 0; s < 2; ++s) {
            const size_t fo = ((size_t)((w * 8 + nb) * 2 + s) * 64 + lane) * 8;
            const bf16x8 ca = *(const bf16x8*)(T256 + fo), sa = *(const bf16x8*)(T256 + 65536 + fo);
            Y[0] = MFMA32(ca, gs[0][s], Y[0]); Y[0] = MFMA32(sa, gs[2][s], Y[0]);
            Y[1] = MFMA32(ca, gs[1][s], Y[1]); Y[1] = MFMA32(sa, gs[3][s], Y[1]); }
    }
#pragma unroll
    for (int jb = 0; jb < 2; ++jb)
#pragma unroll
        for (int i = 0; i < 16; ++i) { const int k = 32 * w + crow(i, hi), d = 32 * jb + r32; const size_t row = (size_t)(M_LAT + NCTX * b + k);
            const float z = bf2f(P[row * PW + C_BZ + 64 * g + d]);
            YB[row * 1024 + 512 + 64 * g + d] = (bf16)f2bf(Y[jb][i] * (1.0f / 128.0f) * siluf(z)); }
}

#ifndef B_SCALE
#define B_SCALE 1.0f
#endif
#ifndef C_SCALE
#define C_SCALE 1.0f
#endif
DI void fnet_s3_unit(const Frame& F, const Args& a, int u, const bf16* P, bf16* YB) {
    const int b = u >> 7, k1 = u & 127;
    const int lane = F.lane, r32 = lane & 31, hi = lane >> 5, g = F.wave >> 1, jb = F.wave & 1;
    const bf16* T64 = (const bf16*)(a.ws + WS_TAB) + TAB_64 / 2;
    const bf16* T1 = (const bf16*)(a.ws + WS_T1);
    f32x16 Y[2]; Y[0] = f32x16{}; Y[1] = f32x16{};
#pragma unroll
    for (int sc = 0; sc < 4; ++sc)
#pragma unroll
        for (int ri = 0; ri < 2; ++ri) {
            const bf16x8 afr = *(const bf16x8*)(T1 + ((((size_t)(b * 128 + k1) * 8 + 2 * sc + hi) * 512) + g * 128 + ri * 64 + 32 * jb + r32) * 8);
#pragma unroll
            for (int k2b = 0; k2b < 2; ++k2b) { const bf16x8 bfr = *(const bf16x8*)(T64 + ri * 4096 + (32 * k2b + r32) * 64 + 16 * sc + 8 * hi); Y[k2b] = MFMA32(afr, bfr, Y[k2b]); } }
#pragma unroll
    for (int k2b = 0; k2b < 2; ++k2b) { const size_t row = (size_t)(SEQ * b + k1 + 128 * (32 * k2b + r32));
#pragma unroll
        for (int q = 0; q < 4; ++q) { const int d0 = 32 * jb + 8 * q + 4 * hi;
            const v2u z = *(const v2u*)(P + row * PW + C_BZ + 64 * g + d0);
            v2u o; o.x = pk2(Y[k2b][4 * q] * (B_SCALE * 0.0013810679320049757f) * siluf(wlo(z.x)), Y[k2b][4 * q + 1] * (B_SCALE * 0.0013810679320049757f) * siluf(whi(z.x)));
            o.y = pk2(Y[k2b][4 * q + 2] * (B_SCALE * 0.0013810679320049757f) * siluf(wlo(z.y)), Y[k2b][4 * q + 3] * (B_SCALE * 0.0013810679320049757f) * siluf(whi(z.y)));
            *(v2u*)(YB + row * 1024 + 512 + 64 * g + d0) = o; } }
}

DI void sgu_unit(const Frame& F, const Args& a, int l, int u, const bf16* P, bf16* YB) {
    constexpr int VP = 136;
    LAS bf16* vt = (LAS bf16*)F.lds;
    const int ci = u >> 2, g = u & 3;
    const size_t row0 = (size_t)ci * 128;
    { const int q = F.tid & 127, cq = F.tid >> 7; const bf16* src = P + (row0 + q) * PW + C_CV + 64 * g + 16 * cq;
#pragma unroll
      for (int i = 0; i < 2; ++i) { const v4u v = *(const v4u*)(src + 8 * i); const unsigned wv[4] = {v.x, v.y, v.z, v.w};
#pragma unroll
          for (int e = 0; e < 4; ++e) { vt[(16 * cq + 8 * i + 2 * e) * VP + q] = (bf16)f2bf(geluf(wlo(wv[e]))); vt[(16 * cq + 8 * i + 2 * e + 1) * VP + q] = (bf16)f2bf(geluf(whi(wv[e]))); } } }
    __syncthreads();
    const int lane = F.lane, r32 = lane & 31, hi = lane >> 5, pb = F.wave >> 1, cb = F.wave & 1;
    const bf16* Wsp = (const bf16*)(a.ws + WS_TAB) + TAB_WSP / 2 + (size_t)(l * 4 + g) * 128 * 128;
    f32x16 acc = f32x16{};
#pragma unroll
    for (int s = 0; s < 8; ++s) {
        const bf16x8 af = *(const LAS bf16x8*)(vt + (32 * cb + r32) * VP + 16 * s + 8 * hi);
        const bf16x8 bfr = *(const bf16x8*)(Wsp + (32 * pb + r32) * 128 + 16 * s + 8 * hi);
        acc = MFMA32(af, bfr, acc);
    }
    const int p = 32 * pb + r32; const float bb = a.in[I_BSP][(l * 4 + g) * 128 + p]; const bf16* pr = P + (row0 + p) * PW;
#pragma unroll
    for (int q = 0; q < 4; ++q) { const int c0 = 64 * g + 32 * cb + 8 * q + 4 * hi;
        const v2u uu = *(const v2u*)(pr + C_CU + c0), zz = *(const v2u*)(pr + C_CZ + c0);
        v2u o; o.x = pk2(C_SCALE * geluf(wlo(uu.x)) * (acc[4 * q] + bb) * siluf(wlo(zz.x)), C_SCALE * geluf(whi(uu.x)) * (acc[4 * q + 1] + bb) * siluf(whi(zz.x)));
        o.y = pk2(C_SCALE * geluf(wlo(uu.y)) * (acc[4 * q + 2] + bb) * siluf(wlo(zz.y)), C_SCALE * geluf(whi(uu.y)) * (acc[4 * q + 3] + bb) * siluf(whi(zz.y)));
        *(v2u*)(YB + (row0 + p) * 1024 + 768 + c0) = o; }
    __syncthreads();
}

DI void p5_ctx_convert(const Frame& F, const Args& a) {
    const int gt = F.vcu * 512 + F.tid, NGT = F.G * 512;
    const f32x4* src = (const f32x4*)(a.ws + WS_MGC); v2u* dst = (v2u*)((bf16*)(a.ws + WS_MG) + (size_t)M_LAT * 1024);
    for (int e = gt; e < M_CTX * 1024 / 4; e += NGT) { const f32x4 v = src[e]; v2u o; o.x = pk2(v.x, v.y); o.y = pk2(v.z, v.w); dst[e] = o; }
}

#ifdef SELFCHECK
constexpr int CW_CHK = 8192;
DI unsigned hsh(unsigned x) { x *= 2654435761u; x ^= x >> 15; x *= 2246822519u; x ^= x >> 13; x *= 3266489917u; x ^= x >> 16; return x; }
DI void chk_acc(const Args& a, int id, float got, float want) {
    unsigned* w = (unsigned*)(a.ws + WS_CTL) + CW_CHK + 4 * id;
    float d = __builtin_fabsf(got - want); if (!(d == d) || d > 1e15f) d = 1e15f;
    atomicAdd((float*)w, d * d); atomicAdd((float*)(w + 1), want * want); atomicAdd(w + 2, 1u); atomicMax(w + 3, __float_as_uint(d));
}
DI float bfr(float x) { return __uint_as_float(f2bf(x) << 16); }
DI void chk_p0(const Frame& F, const Args& a) {
    const int gt = F.vcu * 512 + F.tid, NGT = F.G * 512;
    for (int s = gt; s < 18432; s += NGT) { const int l = s / 9216, v = (s / 3072) % 3, j = s % 3072; float acc = a.in[I_BADA][l * 3072 + j];
        for (int k = 0; k < 1024; ++k) { const float cv = (v < 2) ? a.in[I_C][v * 1024 + k] : a.in[I_CCTX][k]; acc += siluf(cv) * a.in[I_WADA][((size_t)l * 1024 + k) * 3072 + j]; }
        chk_acc(a, 0, ((const float*)(a.ws + WS_MOD))[(l * 3 + v) * 3072 + j], acc); }
    for (int s = gt; s < 65536; s += NGT) { const unsigned h = hsh(s); const int l = (s >> 2) & 1, m = s & 3, k = h & 1023; const unsigned h2 = hsh(h + 77u);
        float got, want;
        if (m == 0) { const int n = h2 % PW; want = bfr(a.in[I_WIN][((size_t)l * 1024 + k) * PW + n]); got = bf2f(((const bf16*)(a.ws + WS_WIN))[((size_t)l * PW + n) * WPITCH + k]); }
        else if (m == 1) { const int n = h2 & 4095; want = bfr(a.in[I_WMERGE][((size_t)l * 1024 + k) * 4096 + n]); got = bf2f(((const bf16*)(a.ws + WS_WM))[((size_t)l * 4096 + n) * 1024 + k]); }
        else if (m == 2) { const int n = h2 & 1023; want = bfr(a.in[I_WOUT][((size_t)l * 1024 + k) * 1024 + n]); got = bf2f(((const bf16*)(a.ws + WS_WOUT))[((size_t)l * 1024 + n) * 1024 + k]); }
        else { const int n = h2 & 1023, br = k >> 8, kk = k & 255; want = bfr(a.in[I_WBR][(((size_t)l * 4 + br) * 256 + kk) * 1024 + n]); got = bf2f(((const bf16*)(a.ws + WS_WBR))[((size_t)l * 1024 + n) * 1024 + 256 * br + kk]); }
        chk_acc(a, 1, got, want); }
}
DI int sample_row(unsigned h, int l) { const int r = h % M_ALL; (void)l; return ((h >> 20) & 7) == 0 ? M_LAT + (h % M_CTX) : r; }
DI void chk_h(const Frame& F, const Args& a, int l, int id) {
    const float* mod = (const float*)(a.ws + WS_MOD) + (size_t)l * 3 * 3072; const bf16* H = (const bf16*)(a.ws + WS_H);
    const int gw = F.vcu * NWAVES + F.wave, NGW = F.G * NWAVES;
    for (int s = gw; s < M_ALL; s += NGW) { const int row = s; const int v = row < SEQ ? 0 : (row < M_LAT ? 1 : 2);
        const float* xr = (row < M_LAT) ? ((l == 0) ? a.in[I_X] : a.out) + (size_t)row * 1024 : ((l == 0) ? a.in[I_CTX] : (const float*)(a.ws + WS_XC1)) + (size_t)(row - M_LAT) * 1024;
        float ss = 0.f; for (int j = 0; j < 16; ++j) { const float x = xr[F.lane + 64 * j]; ss += x * x; }
        const float rstd = 1.0f / sqrtf(wave_sum(ss, F.lane) * (1.0f / 1024.0f) + RMS_EPS);
        for (int j = 0; j < 16; ++j) { const int c = F.lane + 64 * j; const float want = xr[c] * rstd * a.in[I_NORMW][l * 1024 + c] * (1.0f + mod[v * 3072 + 1024 + c]) + mod[v * 3072 + c];
            chk_acc(a, id, bf2f(H[(size_t)row * 1024 + c]), want); } }
}
DI float dot_h_w(const bf16* hrow, const bf16* wrow, int K) { float acc = 0.f; for (int k = 0; k < K; ++k) acc += bf2f(hrow[k]) * bf2f(wrow[k]); return acc; }
DI void chk_p(const Frame& F, const Args& a, int l, int id) {
    const bf16* H = (const bf16*)(a.ws + WS_H); const bf16* W = (const bf16*)(a.ws + WS_WIN) + (size_t)l * PW * WPITCH; const bf16* P = (const bf16*)(a.ws + WS_P);
    const int gt = F.vcu * 512 + F.tid, NGT = F.G * 512;
    for (int s = gt; s < (1 << 20); s += NGT) { const unsigned h = hsh(s * 5 + 2); const int row = sample_row(h, l); int col = hsh(h + 9u) % PW;
        if (l == 1 && row >= M_LAT) col = ((col & 1) ? 1024 : 256) + (col & 255);
        chk_acc(a, id, bf2f(P[(size_t)row * PW + col]), dot_h_w(H + (size_t)row * 1024, W + (size_t)col * WPITCH, 1024)); }
}
DI void chk_prep(const Frame& F, const Args& a, int l, int id) {
    const bf16* H = (const bf16*)(a.ws + WS_H); const bf16* W = (const bf16*)(a.ws + WS_WIN) + (size_t)l * PW * WPITCH; const bf16* P = (const bf16*)(a.ws + WS_P);
    const int gw = F.vcu * NWAVES + F.wave, NGW = F.G * NWAVES, d = F.lane;
    for (int s = gw; s < 16384; s += NGW) { const unsigned h = hsh(s * 7 + 3); const int row = sample_row(h, l); int sl = (h >> 8) % 12; const bool isctx = row >= M_LAT;
        if (isctx && l == 1) sl = (sl & 1) ? 4 + (sl & 1) : 10 + ((sl >> 1) & 1);
        const int col = (sl < 4) ? C_AQ + 64 * sl : (sl < 6) ? C_AK + 64 * (sl - 4) : (sl < 10) ? C_DQ + 64 * (sl - 6) : C_DK + 64 * (sl - 10);
        const bool isq = (sl < 4) || (sl >= 6 && sl < 10);
        const float raw = bfr(dot_h_w(H + (size_t)row * 1024, W + (size_t)(col + d) * WPITCH, 1024));
        const float wv = ((sl < 4) ? a.in[I_QNA] : (sl < 6) ? a.in[I_KNA] : (sl < 10) ? a.in[I_QND] : a.in[I_KND])[l * 64 + d];
        const float ms = wave_sum(raw * raw, d) * (1.0f / 64.0f);
        float y = raw / sqrtf(ms + RMS_EPS) * wv;
        if (!isctx) { const int n = row & (SEQ - 1); const float pos = (float)((d < 32) ? (n >> 6) : (n & 63)); const float inv = __builtin_amdgcn_exp2f(-(float)(d & 15) * (13.287712379549449f / 16.0f)); const float rev = pos * inv * 0.15915494309189535f; const float cs = __builtin_amdgcn_cosf(rev), sn = __builtin_amdgcn_sinf(rev);
            const float p = shx(y, 16, d); y = (d & 16) ? (p * sn + y * cs) : (y * cs - p * sn); }
        if (isq) y *= QSCALE;
        chk_acc(a, id, bf2f(P[(size_t)row * PW + col + d]), y); }
}
DI void chk_attn(const Frame& F, const Args& a, int l, int id, int mode) {
    const bf16* P = (const bf16*)(a.ws + WS_P); const bf16* YB = (const bf16*)(a.ws + WS_YB);
    LAS float* qs = (LAS float*)F.lds + F.wave * 192; LAS float* os = qs + 64; LAS float* red = qs + 128;
    const int gw = F.vcu * NWAVES + F.wave, NGW = F.G * NWAVES, lane = F.lane;
    const int qc0 = mode ? C_DQ : C_AQ, kc0 = mode ? C_DK : C_AK, vc0 = mode ? C_DV : C_AV, zc0 = mode ? C_DZ : C_AZ, oc0 = mode ? 256 : 0;
    for (int s = gw; s < 8192; s += NGW) { const unsigned hh = hsh(s * 11 + 5 + mode); int row = sample_row(hh, l); if ((s & 7) == 1) row = (hh & 8192) + (hh & 255) + ((hh & 256) ? 7936 : 0); if (l == 1 && row >= M_LAT) row = hh % M_LAT; const int h = (hh >> 9) & 3, kvh = h >> 1; const bool isctx = row >= M_LAT;
        const int b = isctx ? (row - M_LAT) / NCTX : row / SEQ, pos = row & (SEQ - 1);
        qs[lane] = bf2f(P[(size_t)row * PW + qc0 + 64 * h + lane]); LDS_WAIT();
        int klo = 0, khi = -1; if (!isctx) { if (mode == 0) { klo = 0; khi = SEQ - 1; } else { klo = pos - 128 < 0 ? 0 : pos - 128; khi = pos + 128 > SEQ - 1 ? SEQ - 1 : pos + 128; } }
        const int nlat = khi - klo + 1 > 0 ? khi - klo + 1 : 0, nk = NCTX + nlat;
        float m = -1e30f, lsum = 0.f; float acc[64];
#pragma unroll
        for (int dd = 0; dd < 64; ++dd) acc[dd] = 0.f;
        for (int kk = lane; kk < nk; kk += 64) { const size_t kr = (kk < NCTX) ? (size_t)(M_LAT + NCTX * b + kk) : (size_t)(SEQ * b + klo + kk - NCTX);
            const bf16* kp = P + kr * PW + kc0 + 64 * kvh; const bf16* vp = P + kr * PW + vc0 + 64 * kvh; float sc = 0.f;
#pragma unroll
            for (int dd = 0; dd < 64; ++dd) sc += qs[dd] * bf2f(kp[dd]);
            const float mn = fmaxf(m, sc), f = __builtin_amdgcn_exp2f(m - mn), p = __builtin_amdgcn_exp2f(sc - mn); lsum = lsum * f + p; m = mn;
#pragma unroll
            for (int dd = 0; dd < 64; ++dd) acc[dd] = acc[dd] * f + p * bf2f(vp[dd]); }
        float mall = m;
#pragma unroll
        for (int o = 1; o < 64; o <<= 1) mall = fmaxf(mall, shx(mall, o, lane));
        const float f = __builtin_amdgcn_exp2f(m - mall); lsum = wave_sum(lsum * f, lane);
        if (mode == 1) lsum += __builtin_amdgcn_exp2f(a.in[I_SINK][l * 4 + h] * 1.4426950408889634f - mall);
#pragma unroll
        for (int dd = 0; dd < 64; ++dd) { const float t = wave_sum(acc[dd] * f, lane); if (lane == dd) os[dd] = t; }
        LDS_WAIT();
        const float z = bf2f(P[(size_t)row * PW + zc0 + 64 * h + lane]);
        chk_acc(a, id, bf2f(YB[(size_t)row * 1024 + oc0 + 64 * h + lane]), os[lane] / lsum * siluf(z));
        (void)red; }
}
DI void chk_fnet(const Frame& F, const Args& a, int l, int id, int ctxmode) {
    const bf16* P = (const bf16*)(a.ws + WS_P); const bf16* YB = (const bf16*)(a.ws + WS_YB);
    LAS float* ys = (LAS float*)F.lds + F.wave * 64;
    const int gw = F.vcu * NWAVES + F.wave, NGW = F.G * NWAVES, j = F.lane;
    const int N = ctxmode ? NCTX : SEQ;
    for (int s = gw; s < (ctxmode ? 256 : 1024); s += NGW) { const unsigned hh = hsh(s * 13 + 7 + ctxmode); const int b = hh & 1, g = (hh >> 1) & 3; int k = (hh >> 3) % N;
#ifdef FNET_K0
        k = (s & 7) == 0 ? 0 : (s & 7) == 1 ? N / 2 : (s & 7) == 2 ? 64 : (s & 7) == 3 ? 128 : (s & 7) == 4 ? 1 : k;
#endif
        const size_t rbase = ctxmode ? (size_t)(M_LAT + NCTX * b) : (size_t)(SEQ * b);
        float y = 0.f;
        for (int n = 0; n < N; ++n) { const bf16* fr = P + (rbase + n) * PW + C_BF + 64 * g; float A = 0.f, B = 0.f;
            for (int c = 0; c < 64; ++c) { const float fv = bf2f(fr[c]); const float ph = (float)((j * c) & 63) * (1.0f / 64.0f); A += fv * __builtin_amdgcn_cosf(ph); B += fv * __builtin_amdgcn_sinf(ph); }
            const float th = (float)((k * n) & (N - 1)) / (float)N; y += __builtin_amdgcn_cosf(th) * A - __builtin_amdgcn_sinf(th) * B; }
        ys[j] = y / sqrtf((float)N * 64.0f); LDS_WAIT();
        float o = 0.f; for (int jj = 0; jj < 64; ++jj) o += ys[jj] * a.in[I_WFNET][((size_t)(l * 4 + g) * 64 + jj) * 64 + j];
        const size_t row = rbase + k; const float z = bf2f(P[row * PW + C_BZ + 64 * g + j]);
        chk_acc(a, id, bf2f(YB[row * 1024 + 512 + 64 * g + j]), o * siluf(z)); LDS_WAIT(); }
}
DI void chk_sgu(const Frame& F, const Args& a, int l, int id) {
    const bf16* P = (const bf16*)(a.ws + WS_P); const bf16* YB = (const bf16*)(a.ws + WS_YB);
    const int gt = F.vcu * 512 + F.tid, NGT = F.G * 512;
    for (int s = gt; s < (1 << 18); s += NGT) { const unsigned hh = hsh(s * 17 + 11); int row = sample_row(hh, l); if (l == 1 && row >= M_LAT) row = hh % M_LAT; const int cc = hsh(hh + 101u) & 255, g = cc >> 6, p = row & 127; const size_t r0 = (size_t)(row - p);
        float sp = a.in[I_BSP][(l * 4 + g) * 128 + p];
        for (int q = 0; q < 128; ++q) { const float v = bf2f(P[(r0 + q) * PW + C_CV + cc]); sp += a.in[I_WSP][((size_t)(l * 4 + g) * 128 + p) * 128 + q] * (0.5f * v * (1.0f + erff(v * 0.7071067811865476f))); }
        const float u = bf2f(P[(size_t)row * PW + C_CU + cc]), z = bf2f(P[(size_t)row * PW + C_CZ + cc]);
        chk_acc(a, id, bf2f(YB[(size_t)row * 1024 + 768 + cc]), (0.5f * u * (1.0f + erff(u * 0.7071067811865476f))) * sp * siluf(z)); }
}
DI void chk_merge(const Frame& F, const Args& a, int l, int id) {
    const bf16* H = (const bf16*)(a.ws + WS_H); const bf16* YB = (const bf16*)(a.ws + WS_YB); const bf16* MG = (const bf16*)(a.ws + WS_MG);
    const bf16* WM = (const bf16*)(a.ws + WS_WM) + (size_t)l * 4096 * 1024; const bf16* WB = (const bf16*)(a.ws + WS_WBR) + (size_t)l * 1024 * 1024;
    const int gt = F.vcu * 512 + F.tid, NGT = F.G * 512;
    for (int s = gt; s < (1 << 18); s += NGT) { const unsigned hh = hsh(s * 19 + 13); int row = sample_row(hh, l); if (l == 1 && row >= M_LAT) row = hh % M_LAT; const int d = hsh(hh + 202u) & 1023; float acc = 0.f;
        for (int r = 0; r < 4; ++r) { const float G = dot_h_w(H + (size_t)row * 1024, WM + ((size_t)r * 1024 + d) * 1024, 1024) + a.in[I_BMERGE][l * 4096 + r * 1024 + d];
            const float Y = dot_h_w(YB + (size_t)row * 1024 + 256 * r, WB + (size_t)d * 1024 + 256 * r, 256); acc += Y * __builtin_amdgcn_rcpf(1.0f + __builtin_amdgcn_exp2f(-1.4426950408889634f * G)); }
        float got; if (row < M_LAT) got = bf2f(MG[(size_t)row * 1024 + d]); else { got = 0.f; for (int br = 0; br < 4; ++br) got += bf2f(((const bf16*)(a.ws + WS_GTC))[((size_t)br * 512 + (row - M_LAT)) * 1024 + d]); }
        chk_acc(a, id, got, acc); }
}
DI void chk_gt(const Frame& F, const Args& a, int l, int r, int id) {
    const bf16* H = (const bf16*)(a.ws + WS_H); const bf16* GT = (const bf16*)(a.ws + WS_GT); const bf16* WM = (const bf16*)(a.ws + WS_WM) + (size_t)l * 4096 * 1024;
    const int gt = F.vcu * 512 + F.tid, NGT = F.G * 512;
    for (int s = gt; s < (1 << 18); s += NGT) { const unsigned hh = hsh(s * 29 + 19); int row = sample_row(hh, l); if (l == 1 && row >= M_LAT) row = hh % M_LAT; const int d = hsh(hh + 404u) & 1023;
        const float G = dot_h_w(H + (size_t)row * 1024, WM + ((size_t)r * 1024 + d) * 1024, 1024) + a.in[I_BMERGE][l * 4096 + r * 1024 + d];
        chk_acc(a, id, bf2f(GT[(size_t)row * 1024 + d]), __builtin_amdgcn_rcpf(1.0f + __builtin_amdgcn_exp2f(-1.4426950408889634f * G))); }
}
DI void chk_final(const Frame& F, const Args& a, int l, int id) {
    const bf16* MG = (const bf16*)(a.ws + WS_MG); const bf16* WO = (const bf16*)(a.ws + WS_WOUT) + (size_t)l * 1024 * 1024; const float* mod = (const float*)(a.ws + WS_MOD) + (size_t)l * 3 * 3072;
    const int gt = F.vcu * 512 + F.tid, NGT = F.G * 512;
    for (int s = gt; s < (1 << 18); s += NGT) { const unsigned hh = hsh(s * 23 + 17); const int row = sample_row(hh, l), c = hsh(hh + 303u) & 1023; const int v = row < SEQ ? 0 : (row < M_LAT ? 1 : 2);
        if (l == 1 && row >= M_LAT) continue;
        const float xi = (l == 1) ? ((const float*)(a.ws + WS_H))[(size_t)row * 1024 + c] : (row < M_LAT) ? a.in[I_X][(size_t)row * 1024 + c] : a.in[I_CTX][(size_t)(row - M_LAT) * 1024 + c];
        const float got = (row < M_LAT) ? a.out[(size_t)row * 1024 + c] : ((const float*)(a.ws + WS_XC1))[(size_t)(row - M_LAT) * 1024 + c];
        float dsum;
        if (row < M_LAT) dsum = dot_h_w(MG + (size_t)row * 1024, WO + (size_t)c * 1024, 1024);
        else { dsum = 0.f; for (int br = 0; br < 4; ++br) dsum += dot_h_w((const bf16*)(a.ws + WS_GTC) + ((size_t)br * 512 + (row - M_LAT)) * 1024, WO + (size_t)c * 1024, 1024); }
        chk_acc(a, id, got - xi, mod[v * 3072 + 2048 + c] * dsum); }
}
#ifdef CHECK_MAX
#define CHK_ERR(md, ss, n, mx) ((mx) / (sqrtf((ss) / (float)(n)) + 1e-20f))
#else
#define CHK_ERR(md, ss, n, mx) sqrtf((md) / ((ss) + 1e-30f))
#endif
DI void chk_report(const Frame& F, const Args& a) {
    const unsigned* w = (const unsigned*)(a.ws + WS_CTL) + CW_CHK; int first = -1; float ferr = 0.f;
#ifdef CHECK_ONLY
    { const int id = CHECK_ONLY; const float md = __uint_as_float(w[4 * id]), ss = ((const float*)w)[4 * id + 1]; const unsigned n = w[4 * id + 2]; first = id; ferr = n ? CHK_ERR(md, ss, n, __uint_as_float(w[4 * id + 3])) : 1e3f; }
#else
    for (int id = 0; id < 24; ++id) { const float md = __uint_as_float(w[4 * id]), ss = ((const float*)w)[4 * id + 1]; const unsigned n = w[4 * id + 2]; if (!n) continue;
        const float e = CHK_ERR(md, ss, n, __uint_as_float(w[4 * id + 3])); if (e > CHECK_TOL && first < 0) { first = id; ferr = e; } }
#endif
    const float V = first >= 0 ? 10.0f * (float)(1 + first) : 0.f; const float W = first >= 0 ? 4.0f + log10f(fminf(fmaxf(ferr, 1e-3f), 1e3f)) : 0.f;
    const size_t gt = (size_t)F.vcu * 512 + F.tid, NGT = (size_t)F.G * 512;
#ifdef KEEP_OUT
    if (gt == 0) a.out[0] += V; (void)W; (void)NGT;
#else
    for (size_t i = gt; i < (size_t)M_LAT * 1024; i += NGT) { float v = a.in[I_X][i]; if (i == 0) v += V; if (i >= (1u << 20) && i < (2u << 20)) v += W; a.out[i] = v; }
#endif
}
DI void chk_copy_out(const Frame& F, const Args& a) {
    const size_t gt = (size_t)F.vcu * 512 + F.tid, NGT = (size_t)F.G * 512; float* dst = (float*)(a.ws + WS_H);
    for (size_t i = gt; i < (size_t)M_LAT * 1024; i += NGT) dst[i] = a.out[i];
}
#endif

typedef const __attribute__((address_space(4))) Args* CArgsP;
DI Args fresh_args() { CArgsP p = (CArgsP)__builtin_amdgcn_kernarg_segment_ptr(); asm volatile("" : "+s"(p)); Args r;
#pragma unroll
    for (int i = 0; i < 20; ++i) r.in[i] = p->in[i];
    r.out = p->out; r.ws = p->ws; return r; }
DI Frame fresh_frame(unsigned char* lds) {
    Frame F; int t_ = threadIdx.x; asm volatile("" : "+v"(t_));
    F.lds = (LAS unsigned char*)lds; F.tid = t_; F.lane = t_ & 63; F.wave = __builtin_amdgcn_readfirstlane(t_ >> 6);
    F.G = gridDim.x; { const int bx = blockIdx.x; F.vcu = (F.G % 8 == 0) ? (bx % 8) * (F.G / 8) + bx / 8 : bx; }
    return F;
}
DI void grid_bar(unsigned char* lds) {
    const Args a = fresh_args();
    XcdBarrier b; b.bar = (unsigned*)(a.ws + WS_CTL) + CW_BAR; b.x = xb_xcc_id(); b.st = (volatile LAS unsigned*)((LAS unsigned char*)lds + MISC_OFF) + 8;
    xcd_barrier(b);
}

__global__ void __launch_bounds__(NWAVES * 64, 2) hybrid_fwd(Args args) {
    extern __shared__ __attribute__((aligned(16))) unsigned char lds[];
    for (int u = threadIdx.x; u < (LDS_BYTES - LDSCTL_OFF) / 4; u += NWAVES * 64) ((LAS unsigned*)((LAS unsigned char*)lds + LDSCTL_OFF))[u] = 0u;
    __syncthreads();
    { const Args a = fresh_args(); (void)xcd_barrier_post((unsigned*)(a.ws + WS_CTL) + CW_BAR, (volatile LAS unsigned*)((LAS unsigned char*)lds + MISC_OFF) + 8); }
#define GRID_BAR() grid_bar(lds)
#ifndef DUP_MASK
#define DUP_MASK 0
#endif
#define DUP(bit) for (int rep_ = 0; rep_ < 1 + (((DUP_MASK) >> (bit)) & 1); ++rep_)
#ifdef SELFCHECK
#ifndef CHECK_SET
#define CHECK_SET 0xffff
#endif
#define CHK(bit, call) do { if ((CHECK_SET) & (bit)) { { const Frame F = fresh_frame(lds); const Args a = fresh_args(); call; } GRID_BAR(); } } while (0)
#elif defined(EXTRA_BAR)
#define CHK(bit, call) GRID_BAR()
#else
#define CHK(bit, call) do {} while (0)
#endif

#ifdef REPEAT_ALL
    for (int rep_all = 0; rep_all < 2; ++rep_all) {
    if (rep_all) GRID_BAR();
#endif
#ifndef SKIP_P0
    DUP(0) { const Frame F = fresh_frame(lds); const Args a = fresh_args(); p0_prologue(F, a); }
#endif
    GRID_BAR();
    CHK(1, chk_p0(F, a));

#pragma unroll 1
    for (int l = 0; l < 2; ++l) {
#ifndef SKIP_P1
        DUP(1) { const Frame F = fresh_frame(lds); const Args a = fresh_args();
          p1_modrms(F, a, l, (l == 0) ? a.in[I_X] : a.out, (l == 0) ? a.in[I_CTX] : (const float*)(a.ws + WS_XC1), 1); }
#endif
        GRID_BAR();
        CHK(2, chk_h(F, a, l, 2 + 10 * l));
#ifndef SKIP_G1
        DUP(2) { const Frame F = fresh_frame(lds); const Args a = fresh_args();
            pg8::Gemm g{(const bf16*)(a.ws + WS_H), (const bf16*)(a.ws + WS_WIN) + (size_t)l * PW * WPITCH, 1024, WPITCH, 1024};
            pg8::OrderX S; S.so.init(l == 0 ? M_ALL : M_LAT, PW, F.G, (int)blockIdx.x); S.nx = (l == 0) ? 0 : 4;
            pg8::EpiBf16<0> E{(bf16*)(a.ws + WS_P), PW, nullptr};
            pg8::gemm_phase<pg8::EpiBf16<0>, pg8::OrderX, true>(F.lds, g, S, E);
        }
#endif
        GRID_BAR();
        CHK(4, chk_p(F, a, l, 3 + 10 * l));
#ifndef SKIP_S1
        DUP(3) { const Frame F = fresh_frame(lds); const Args a = fresh_args();
          for (int u = F.vcu; u < 256; u += F.G) fnet_s1_unit(F, a, l, u, (const bf16*)(a.ws + WS_P)); }
#endif
#ifndef SKIP_FC
        if (l == 0) DUP(10) { const Frame F = fresh_frame(lds); const Args a = fresh_args();
          for (int e = F.vcu; e < 256; e += F.G) { if ((e & 31) == 7) fnet_ctx_unit(F, a, l, e >> 5, (const bf16*)(a.ws + WS_P), (bf16*)(a.ws + WS_YB)); } }
#endif
#ifndef SKIP_PREP
        { const Frame F = fresh_frame(lds); const Args a = fresh_args(); p3_prep(F, a, l, (bf16*)(a.ws + WS_P)); }
#endif
        GRID_BAR();
        CHK(8, chk_prep(F, a, l, 4 + 10 * l));
#ifndef SKIP_ATT
        DUP(4) { const Frame F = fresh_frame(lds); const Args a = fresh_args();
            const attn_body::bf16* Pa = (const attn_body::bf16*)(a.ws + WS_P); attn_body::bf16* Ya = (attn_body::bf16*)(a.ws + WS_YB);
            for (int u = F.vcu; u < 256; u += F.G) {
                const int bk = u >> 6, b = bk >> 1, kvh = bk & 1, h = 2 * kvh + ((u >> 5) & 1), qb = u & 31;
                attn_body::attn_unit<0, 8>(Pa, Ya, SEQ * b + 256 * qb, M_LAT + NCTX * b, SEQ * b, 0, 132, 0,
                                           C_AQ + 64 * h, C_AK + 64 * kvh, C_AV + 64 * kvh, C_AZ + 64 * h, 64 * h, 0.f, (char*)lds);
            }
        }
        DUP(5) { const Frame F = fresh_frame(lds); const Args a = fresh_args();
            const attn_body::bf16* Pa = (const attn_body::bf16*)(a.ws + WS_P); attn_body::bf16* Ya = (attn_body::bf16*)(a.ws + WS_YB);
            for (int u = F.vcu; u < 512; u += F.G) {
                if (u < 256) {
                    const int bk = u >> 6, b = bk >> 1, kvh = bk & 1, h = 2 * kvh + ((u >> 5) & 1), qb = u & 31;
                    const int off = (qb == 0) ? 0 : 4 * qb - 2, NT = (qb == 0 || qb == 31) ? 10 : 12;
                    const float sk = a.in[I_SINK][l * 4 + h] * 1.4426950408889634f;
                    attn_body::attn_unit<1, 8>(Pa, Ya, SEQ * b + 256 * qb, M_LAT + NCTX * b, SEQ * b, off, NT, 256 * qb - 64 * off,
                                               C_DQ + 64 * h, C_DK + 64 * kvh, C_DV + 64 * kvh, C_DZ + 64 * h, 256 + 64 * h, sk, (char*)lds);
                } else if (l == 0 && ((u - 256) & 15) == 0) {
                    const int ee = (u - 256) >> 4, mode = ee >> 3, b = (ee >> 2) & 1, h = ee & 3, kvh = h >> 1;
                    const float sk = (mode == 0) ? -INFINITY : a.in[I_SINK][l * 4 + h] * 1.4426950408889634f;
                    const int qc = (mode == 0) ? C_AQ : C_DQ, kc = (mode == 0) ? C_AK : C_DK, vc = (mode == 0) ? C_AV : C_DV, zc = (mode == 0) ? C_AZ : C_DZ, oc = (mode == 0) ? 0 : 256;
                    attn_body::attn_unit<1, 8>(Pa, Ya, M_LAT + NCTX * b, M_LAT + NCTX * b, SEQ * b, 0, 4, 0,
                                               qc + 64 * h, kc + 64 * kvh, vc + 64 * kvh, zc + 64 * h, oc + 64 * h, sk, (char*)lds);
                }
            }
        }
#endif
#ifndef SKIP_S3
        DUP(6) { const Frame F = fresh_frame(lds); const Args a = fresh_args();
          for (int u = F.vcu; u < 256; u += F.G) fnet_s3_unit(F, a, u, (const bf16*)(a.ws + WS_P), (bf16*)(a.ws + WS_YB)); }
#endif
#ifndef SKIP_SGU
        DUP(7) { const Frame F = fresh_frame(lds); const Args a = fresh_args();
          const int nunit = (l == 0) ? 528 : 512;
          for (int u = F.vcu; u < nunit; u += F.G) sgu_unit(F, a, l, u, (const bf16*)(a.ws + WS_P), (bf16*)(a.ws + WS_YB)); }
#endif
        GRID_BAR();
        CHK(16, chk_attn(F, a, l, 5 + 10 * l, 0)); CHK(16, chk_attn(F, a, l, 6 + 10 * l, 1)); CHK(32, chk_fnet(F, a, l, 7 + 10 * l, 0); if (l == 0) chk_fnet(F, a, l, 8, 1)); CHK(64, chk_sgu(F, a, l, 9 + 10 * l));
#ifndef MERGE_V1
        for (int rep_ = 0; rep_ < 1 + ((((DUP_MASK) >> 8) & 1) && l == 1); ++rep_) { const Frame F = fresh_frame(lds); const Args a = fresh_args();
            pg8::Gemm g{(const bf16*)(a.ws + WS_H), (const bf16*)(a.ws + WS_WM), 1024, 1024, 1024};
            pg8::MergeOrder S{(const bf16*)(a.ws + WS_H), (const bf16*)(a.ws + WS_YB), (const bf16*)(a.ws + WS_WM) + (size_t)l * 4096 * 1024, (const bf16*)(a.ws + WS_WBR) + (size_t)l * 1024 * 1024, F.G, F.vcu, (l == 0) ? 32 : 0};
            pg8::EpiMerge E{(bf16*)(a.ws + WS_GT), (bf16*)(a.ws + WS_MG), (float*)(a.ws + WS_MGC), a.in[I_BMERGE] + l * 4096, (bf16*)(a.ws + WS_GTC)};
            pg8::gemm_phase<pg8::EpiMerge, pg8::MergeOrder, true>(F.lds, g, S, E);
        }
        GRID_BAR();
#else
#pragma unroll 1
        for (int r = 0; r < 4; ++r) {
#ifdef ZERO_MASK
            if ((ZERO_MASK >> r) & 1) continue;
#endif
#ifndef SKIP_MG
            { const Frame F = fresh_frame(lds); const Args a = fresh_args();
                pg8::Gemm g{(const bf16*)(a.ws + WS_H), (const bf16*)(a.ws + WS_WM) + ((size_t)l * 4096 + r * 1024) * 1024, 1024, 1024, 1024};
                pg8::OrderX S; S.so.init((l == 0) ? M_ALL : M_LAT, 1024, F.G, (int)blockIdx.x); S.nx = 0;
                pg8::EpiBf16<2> E{(bf16*)(a.ws + WS_GT), 1024, a.in[I_BMERGE] + l * 4096 + r * 1024};
                pg8::gemm_phase<pg8::EpiBf16<2>, pg8::OrderX, true>(F.lds, g, S, E);
            }
#endif
            GRID_BAR();
            if (r == 3 && l == 0) CHK(512, chk_gt(F, a, l, r, 22); chk_gt(F, a, l, 2, 23));
#ifndef SKIP_MY
            { const Frame F = fresh_frame(lds); const Args a = fresh_args();
                pg8::Gemm g{(const bf16*)(a.ws + WS_YB) + r * 256, (const bf16*)(a.ws + WS_WBR) + (size_t)l * 1024 * 1024 + r * 256, 1024, 1024, 256};
                pg8::OrderX S; S.so.init((l == 0) ? M_ALL : M_LAT, 1024, F.G, (int)blockIdx.x); S.nx = 0;

#ifdef ZERO_MASK
                pg8::EpiGate E{(bf16*)(a.ws + WS_MG), (const bf16*)(a.ws + WS_GT), 1024, r == __builtin_ctz(~(ZERO_MASK)), 1.0f};
#else
#ifdef SCALE_MASK
                pg8::EpiGate E{(bf16*)(a.ws + WS_MG), (const bf16*)(a.ws + WS_GT), 1024, r == 0, ((SCALE_MASK >> r) & 1) ? (SCALE_VAL) : 1.0f};
#else
                pg8::EpiGate E{(bf16*)(a.ws + WS_MG), (const bf16*)(a.ws + WS_GT), 1024, r == 0, 1.0f};
#endif
#endif

                pg8::gemm_phase<pg8::EpiGate, pg8::OrderX, true>(F.lds, g, S, E);
            }
#endif
            GRID_BAR();
        }
#endif
        CHK(128, chk_merge(F, a, l, 10 + 10 * l));
        if (l == 1) CHK(256, chk_copy_out(F, a));
#ifndef SKIP_OUT
        { const Frame F = fresh_frame(lds); const Args a = fresh_args();
            pg8::Gemm g{(const bf16*)(a.ws + WS_MG), (const bf16*)(a.ws + WS_WOUT) + (size_t)l * 1024 * 1024, 1024, 1024, 1024};
            pg8::OrderOut S; S.so.init(M_LAT, 1024, F.G, (int)blockIdx.x); S.nx = (l == 0) ? 128 : 0; S.TERM = (const bf16*)(a.ws + WS_GTC);
            pg8::EpiRes E{(l == 0) ? a.in[I_X] : a.out, a.out, (l == 0) ? a.in[I_CTX] : (const float*)(a.ws + WS_XC1), (float*)(a.ws + WS_XC1), (const float*)(a.ws + WS_MOD) + (size_t)l * 3 * 3072};
            pg8::gemm_phase<pg8::EpiRes, pg8::OrderOut, true>(F.lds, g, S, E);
        }
#endif
        if (l == 0) GRID_BAR();
        if (l == 0) CHK(256, chk_final(F, a, l, 11));
#ifdef SELFCHECK
        if (l == 1) { GRID_BAR(); CHK(256, chk_final(F, a, l, 21)); }
#endif
    }
#ifdef REPEAT_ALL
    }
#endif
#ifdef SELFCHECK
    GRID_BAR();
    { const Frame F = fresh_frame(lds); const Args a = fresh_args(); chk_report(F, a); }
#endif
#ifdef BLEND_S
    GRID_BAR();
    { const Frame F = fresh_frame(lds); const Args a = fresh_args(); const size_t gt = (size_t)F.vcu * 512 + F.tid, NGT = (size_t)F.G * 512;
      for (size_t i = gt; i < (size_t)M_LAT * 1024; i += NGT) { const float x0 = a.in[I_X][i]; a.out[i] = x0 + (BLEND_S) * (a.out[i] - x0); } }
#endif
}

extern "C" void kernel_launch(void* const* d_in, const int* in_sizes, int n_in, void* d_out, int out_size, void* d_ws, size_t ws_size, hipStream_t stream) {
    static int grid = 0;
    if (grid == 0) {
        if (n_in != 20 || out_size != M_LAT * DM || ws_size < WS_END) { fprintf(stderr, "kernel_launch: unexpected problem: n_in %d out %d ws %zu\n", n_in, out_size, ws_size); grid = -1; return; }
        { const int want[20] = {M_LAT * DM, NB * DM, M_CTX * DM, DM, 2 * DM, 2 * DM * 3 * DM, 2 * 3 * DM, 2 * DM * PW, 128, 128, 128, 128, 8, 2 * 4 * 64 * 64, 2 * 4 * 128 * 128, 2 * 4 * 128, 2 * 4 * 256 * DM, 2 * DM * 4 * DM, 2 * 4 * DM, 2 * DM * DM};
          for (int i = 0; i < 20; ++i) if (in_sizes[i] != want[i]) { fprintf(stderr, "kernel_launch: input %d has %d elements, expected %d\n", i, in_sizes[i], want[i]); grid = -1; return; } }
        int dev = 0, cus = 0, per_cu = 0;
        if (hipGetDevice(&dev) != hipSuccess || hipDeviceGetAttribute(&cus, hipDeviceAttributeMultiprocessorCount, dev) != hipSuccess) { grid = -1; return; }
        if (hipFuncSetAttribute((const void*)hybrid_fwd, hipFuncAttributeMaxDynamicSharedMemorySize, LDS_BYTES) != hipSuccess) { fprintf(stderr, "kernel_launch: hipFuncSetAttribute failed\n"); grid = -1; return; }
        if (hipOccupancyMaxActiveBlocksPerMultiprocessor(&per_cu, (const void*)hybrid_fwd, NWAVES * 64, LDS_BYTES) != hipSuccess || per_cu < 1) { fprintf(stderr, "kernel_launch: occupancy query says %d blocks per CU\n", per_cu); per_cu = 1; }
        (void)hipGetLastError();
        grid = cus;
    }
    if (grid < 0) return;
    if (hipMemsetAsync((char*)d_ws + WS_CTL, 0, CTL_ZERO_BYTES, stream) != hipSuccess) { fprintf(stderr, "kernel_launch: memset failed\n"); return; }
    Args a{};
    for (int i = 0; i < 20; ++i) a.in[i] = (const float*)d_in[i];
    a.out = (float*)d_out; a.ws = (unsigned char*)d_ws;
    hipLaunchKernelGGL(hybrid_fwd, dim3(grid), dim3(NWAVES * 64), LDS_BYTES, stream, a);
}
```

```cpp
#include <hip/hip_runtime.h>
#include <hip/hip_bf16.h>
#include <cstdio>
#include <cstdint>
#include <cmath>

namespace pg8 {

#define PG8_LAS __attribute__((address_space(3)))
typedef unsigned short bf16_t;
typedef short bf16x8 __attribute__((ext_vector_type(8)));
typedef float f32x4 __attribute__((ext_vector_type(4)));
typedef unsigned u32x4 __attribute__((ext_vector_type(4)));
constexpr int BM = 256, BK = 64, HALF = 128, HTB = HALF * BK * 2, STAGE_BYTES = 8 * HTB, NXCD = 8, WGM = 8;

__host__ __device__ __forceinline__ int lds_byte(int r, int c) { const int st = (r >> 4) * 2 + (c >> 5), rr = r & 15, cc = c & 31, ob = rr * 64 + cc * 2; return st * 1024 + (ob ^ (((ob >> 9) & 1) << 5)); }
__host__ __device__ __forceinline__ void stage_rc(int b, int& R, int& C) { const int st = b / 1024, sb = b % 1024, swz = sb ^ (((sb >> 9) & 1) << 5); R = (st >> 1) * 16 + swz / 64; C = (st & 1) * 32 + (swz % 64) / 2; }
__host__ __device__ __forceinline__ int perm32(int rho) { const int n = rho >> 4, i = rho & 15; return 8 * (i >> 2) + 4 * n + (i & 3); }

struct Unit { int pm, pn, r, kind; };
struct Gemm { const bf16_t* A; const bf16_t* Bt; int lda, ldb, K; };

struct StaticOrder {
    int nM, nN, nwg, G, c;
    __host__ __device__ void init(int M, int N, int G_, int c_) { nM = M / BM; nN = N / BM; nwg = nM * nN; G = G_; c = c_; }
    __host__ __device__ bool next(int i, Unit& u) const {
        const long L = (long)i * G + c; if (L >= nwg) return false;
        int wgid = (int)L; { const int q = nwg / NXCD, r = nwg % NXCD, xcd = wgid % NXCD, off = wgid / NXCD; wgid = (xcd < r ? xcd * (q + 1) : r * (q + 1) + (xcd - r) * q) + off; }
        const int nig = WGM * nN, gid = wgid / nig, fm = gid * WGM, gsz = (nM - fm) < WGM ? (nM - fm) : WGM;
        u.pm = fm + ((wgid % nig) % gsz); u.pn = (wgid % nig) / gsz; u.r = 0; u.kind = 0; return true;
    }
};
struct OrderX {
    StaticOrder so; int nx;
    __device__ bool next(int i, Unit& u) const {
        const long L = (long)i * so.G + so.c;
        if (L < so.nwg) return so.next(i, u);
        const int e = (int)(L - so.nwg); if (e >= nx) return false;
        u.pm = 64 + (e >> 1); u.pn = (e & 1) ? 4 : 1; u.r = 0; u.kind = 0; return true;
    }
    __device__ __forceinline__ void src(const Gemm& g, const Unit& u, const char*& pa, const char*& pb, const char*& pb1, int& nt) const {
        pa = (const char*)g.A + (size_t)u.pm * (2 * HALF) * g.lda * 2; pb = (const char*)g.Bt + (size_t)u.pn * (2 * HALF) * g.ldb * 2; pb1 = pb + (size_t)HALF * g.ldb * 2; nt = g.K / BK; }
};

typedef float f32x2_c __attribute__((ext_vector_type(2))); typedef __bf16 bf16x2_c __attribute__((ext_vector_type(2)));
__device__ __forceinline__ unsigned cvt_pk_bf16(float lo, float hi) { f32x2_c v = {lo, hi}; bf16x2_c b = __builtin_convertvector(v, bf16x2_c); return __builtin_bit_cast(unsigned, b); }
__device__ __forceinline__ float bf_lo(unsigned w) { return __uint_as_float(w << 16); }
__device__ __forceinline__ float bf_hi(unsigned w) { return __uint_as_float(w & 0xffff0000u); }
__device__ __forceinline__ float sigmoidf_(float x) { return __builtin_amdgcn_rcpf(1.0f + __builtin_amdgcn_exp2f(-1.4426950408889634f * x)); }

template <int ACT> struct EpiBf16 {
    static constexpr bool PERM = true; static constexpr int NSTORE = 16;
    bf16_t* O; int ldc; const float* bias;
    __device__ __forceinline__ void operator()(const f32x4 (&acc)[2][2][4][2], const Unit& u, int wr, int wc, int fr, int fq) const {
        const int row0 = u.pm * BM + wr * 64 + fr; const int col0 = u.pn * BM + wc * 32 + 8 * fq;
        f32x4 bv[2][2];
#pragma unroll
        for (int bj = 0; bj < 2; ++bj)
#pragma unroll
            for (int n = 0; n < 2; ++n) bv[bj][n] = bias ? *(const f32x4*)(bias + col0 + bj * HALF + 4 * n) : (f32x4){0.f, 0.f, 0.f, 0.f};
#pragma unroll
        for (int ai = 0; ai < 2; ++ai)
#pragma unroll
            for (int m = 0; m < 4; ++m) { bf16_t* rowp = O + (size_t)(row0 + ai * HALF + m * 16) * ldc + col0;
#pragma unroll
                for (int bj = 0; bj < 2; ++bj) { f32x4 v0 = acc[ai][bj][m][0] + bv[bj][0], v1 = acc[ai][bj][m][1] + bv[bj][1];
                    if (ACT == 2) {
#pragma unroll
                        for (int e = 0; e < 4; ++e) { v0[e] = sigmoidf_(v0[e]); v1[e] = sigmoidf_(v1[e]); } }
                    u32x4 w; w.x = cvt_pk_bf16(v0[0], v0[1]); w.y = cvt_pk_bf16(v0[2], v0[3]); w.z = cvt_pk_bf16(v1[0], v1[1]); w.w = cvt_pk_bf16(v1[2], v1[3]);
                    *(u32x4*)(rowp + bj * HALF) = w;
                    } }
    }
};
struct EpiGate {
    static constexpr bool PERM = true; static constexpr int NSTORE = 0;
    bf16_t* MG; const bf16_t* GT; int ldc; int first; float scl;
    typedef unsigned u32x2 __attribute__((ext_vector_type(2)));
    __device__ __forceinline__ void operator()(const f32x4 (&acc)[2][2][4][2], const Unit& u, int wr, int wc, int fr, int fq) const {
        const int row0 = u.pm * BM + wr * 64 + fr; const int col0 = u.pn * BM + wc * 32 + 8 * fq;
#pragma unroll
        for (int ai = 0; ai < 2; ++ai)
#pragma unroll
            for (int m = 0; m < 4; ++m) { const size_t off = (size_t)(row0 + ai * HALF + m * 16) * ldc + col0;
#pragma unroll
                for (int bj = 0; bj < 2; ++bj)
#pragma unroll
                    for (int n = 0; n < 2; ++n) {
                        const u32x2 g = *(const u32x2*)(GT + off + bj * HALF + 4 * n);
                        u32x2 o = (u32x2){0u, 0u}; if (!first) o = *(const u32x2*)(MG + off + bj * HALF + 4 * n);
                        const f32x4 v = acc[ai][bj][m][n] * scl;
                        u32x2 w;
                        w.x = cvt_pk_bf16(bf_lo(o.x) + bf_lo(g.x) * v[0], bf_hi(o.x) + bf_hi(g.x) * v[1]);
                        w.y = cvt_pk_bf16(bf_lo(o.y) + bf_lo(g.y) * v[2], bf_hi(o.y) + bf_hi(g.y) * v[3]);
                        *(u32x2*)(MG + off + bj * HALF + 4 * n) = w; asm volatile("" ::: "memory"); } }
    }
};
struct EpiRes {
    static constexpr bool PERM = false; static constexpr int NSTORE = 32;
    const float* xin_lat; float* xout_lat; const float* xin_ctx; float* xout_ctx; const float* gate; float* part;
    __device__ __forceinline__ void operator()(const f32x4 (&acc)[2][2][4][2], const Unit& u, int wr, int wc, int fr, int fq) const {
        const bool isctx = u.pm >= 64;
        const float* xin = isctx ? xin_ctx + (size_t)(u.pm - 64) * BM * 1024 : xin_lat + (size_t)u.pm * BM * 1024;
        float* xout = isctx ? xout_ctx + (size_t)(u.pm - 64) * BM * 1024 : xout_lat + (size_t)u.pm * BM * 1024;
        const float* gv = gate + (isctx ? 2 : (u.pm >> 5)) * 3072 + 2048;
        const int col0 = u.pn * BM + wc * 32 + 4 * fq;
        f32x4 gt[2][2];
#pragma unroll
        for (int bj = 0; bj < 2; ++bj)
#pragma unroll
            for (int n = 0; n < 2; ++n) gt[bj][n] = *(const f32x4*)(gv + col0 + bj * HALF + n * 16);
        if (u.kind == 3) {
            float* pt = part + ((size_t)u.r * 512 + (size_t)(u.pm - 64) * BM) * 1024;
#pragma unroll
            for (int ai = 0; ai < 2; ++ai)
#pragma unroll
                for (int m = 0; m < 4; ++m) { const size_t off = (size_t)(ai * HALF + wr * 64 + m * 16 + fr) * 1024 + col0;
#pragma unroll
                    for (int bj = 0; bj < 2; ++bj)
#pragma unroll
                        for (int n = 0; n < 2; ++n) *(f32x4*)(pt + off + bj * HALF + n * 16) = gt[bj][n] * acc[ai][bj][m][n]; }
        } else {
            const __amdgpu_buffer_rsrc_t rx = __builtin_amdgcn_make_buffer_rsrc((void*)xin, 0, 0x7fffffff, 0x00020000);
            const unsigned vb = (unsigned)(((wr * 64 + fr) * 1024 + col0) * 4);
            f32x4 bs[8][2][2];
#define EPR_SOFF(c, bj, n) (((((c) >> 2) * HALF + ((c) & 3) * 16) * 1024 + (bj) * HALF + (n) * 16) * 4)
#define EPR_LOAD(c) do { _Pragma("unroll") for (int bj = 0; bj < 2; ++bj) _Pragma("unroll") for (int n = 0; n < 2; ++n) \
                bs[c][bj][n] = __builtin_bit_cast(f32x4, __builtin_amdgcn_raw_buffer_load_b128(rx, vb, EPR_SOFF(c, bj, n), 0)); asm volatile("" ::: "memory"); } while (0)
            EPR_LOAD(0); EPR_LOAD(1); EPR_LOAD(2); EPR_LOAD(3);
#pragma unroll
            for (int c = 0; c < 8; ++c) { const int ai = c >> 2, m = c & 3;
#pragma unroll
                for (int bj = 0; bj < 2; ++bj)
#pragma unroll
                    for (int n = 0; n < 2; ++n) *(f32x4*)((char*)xout + vb + EPR_SOFF(c, bj, n)) = bs[c][bj][n] + gt[bj][n] * acc[ai][bj][m][n];
                asm volatile("" ::: "memory");
                if (c + 4 < 8) { if (c == 0) EPR_LOAD(4); else if (c == 1) EPR_LOAD(5); else if (c == 2) EPR_LOAD(6); else EPR_LOAD(7); } }
#undef EPR_LOAD
#undef EPR_SOFF
        }
    }
};

struct MergeOrder {
    const bf16_t* H; const bf16_t* YB; const bf16_t* WmT; const bf16_t* WbrT; int G, c, nctx;
    __device__ bool next(int i, Unit& u) const {
        const int nl = (c < 256) ? 1 + (255 - c) / G : 0;
        if (i < 8 * nl) { const int t = c + (i >> 3) * G, q = i & 7; u.pm = t >> 2; u.pn = t & 3; u.r = 2 * (q >> 2) + (q & 1); u.kind = (q & 2) ? 0 : 1; return true; }
        const int j = i - 8 * nl;
        if (nctx == 0 || (c & 7) != 0) return false;
        const int jb = (c >> 3) + (j >> 1) * (G >> 3); if (jb >= nctx) return false;
        const int t = jb >> 2; u.pm = 64 + (t >> 2); u.pn = t & 3; u.r = jb & 3; u.kind = (j & 1) ? 2 : 1; return true;
    }
    __device__ __forceinline__ void src(const Gemm&, const Unit& u, const char*& pa, const char*& pb, const char*& pb1, int& nt) const {
        if (u.kind == 1) { pa = (const char*)(YB + (size_t)u.pm * 256 * 1024 + u.r * 256); pb = (const char*)(WbrT + (size_t)u.pn * 256 * 1024 + u.r * 256); pb1 = pb + (size_t)HALF * 1024 * 2; nt = 4; }
        else if (u.kind == 2) { pa = (const char*)(H + (size_t)u.pm * 256 * 1024); pb = (const char*)(WmT + ((size_t)u.r * 1024 + u.pn * 256) * 1024); pb1 = pb + (size_t)HALF * 1024 * 2; nt = 16; }
        else { pa = (const char*)(H + (size_t)u.pm * 256 * 1024); pb = (const char*)(WmT + ((size_t)(u.r & 2) * 1024 + u.pn * 256 + (u.r & 1) * HALF) * 1024); pb1 = pb + (size_t)1024 * 1024 * 2; nt = 16; }
    }
};
typedef unsigned long long u64_t;
__device__ __forceinline__ u64_t ld_sc1(const void* p) { return __hip_atomic_load((const u64_t*)p, __ATOMIC_RELAXED, __HIP_MEMORY_SCOPE_AGENT); }
struct EpiMerge {
    static constexpr bool PERM = true; static constexpr int NSTORE = 8;
    bf16_t* GT; bf16_t* MG; float* MGc; const float* bias; bf16_t* GTc; bf16_t* GT2;
    typedef unsigned u32x2 __attribute__((ext_vector_type(2)));
    __device__ __forceinline__ void gate_ctx(const f32x4 (&acc)[2][2][4][2], bf16_t* Yu, int row0, int col0, const f32x4 (&bv)[2][2]) const {
        const __amdgpu_buffer_rsrc_t ry = __builtin_amdgcn_make_buffer_rsrc((void*)Yu, 0, 0x7fffffff, 0x00020000);
        u32x4 yq[8][2];
        const unsigned vb = (unsigned)((row0 * 1024 + col0) * 2);
#define EPM_SOFF(c) ((((c) >> 2) * HALF + ((c) & 3) * 16) * 1024 * 2)
#define EPM_LOAD(c) do { _Pragma("unroll") for (int bj = 0; bj < 2; ++bj) \
            yq[c][bj] = __builtin_bit_cast(u32x4, __builtin_amdgcn_raw_buffer_load_b128(ry, vb, EPM_SOFF(c) + bj * HALF * 2, 16)); asm volatile("" ::: "memory"); } while (0)
        EPM_LOAD(0); EPM_LOAD(1); EPM_LOAD(2); EPM_LOAD(3);
#pragma unroll
        for (int c = 0; c < 8; ++c) { const int ai = c >> 2, mm = c & 3;
#pragma unroll
            for (int bj = 0; bj < 2; ++bj) { f32x4 g0 = acc[ai][bj][mm][0] + bv[bj][0], g1 = acc[ai][bj][mm][1] + bv[bj][1];
#pragma unroll
                for (int e = 0; e < 4; ++e) { g0[e] = sigmoidf_(g0[e]); g1[e] = sigmoidf_(g1[e]); }
                const u32x4 y = yq[c][bj];
                u32x4 w;
                w.x = cvt_pk_bf16(g0[0] * bf_lo(y.x), g0[1] * bf_hi(y.x)); w.y = cvt_pk_bf16(g0[2] * bf_lo(y.y), g0[3] * bf_hi(y.y));
                w.z = cvt_pk_bf16(g1[0] * bf_lo(y.z), g1[1] * bf_hi(y.z)); w.w = cvt_pk_bf16(g1[2] * bf_lo(y.w), g1[3] * bf_hi(y.w));
                *(u32x4*)((char*)Yu + vb + EPM_SOFF(c) + bj * HALF * 2) = w; }
            asm volatile("" ::: "memory");
            if (c + 4 < 8) { if (c == 0) EPM_LOAD(4); else if (c == 1) EPM_LOAD(5); else if (c == 2) EPM_LOAD(6); else EPM_LOAD(7); } }
#undef EPM_LOAD
#undef EPM_SOFF
    }
#ifndef GP_DEPTH
#define GP_DEPTH 4
#endif
    template <bool FIRST> __device__ __forceinline__ void gate_pair(const f32x4 (&acc)[2][2][4][2], int row0, int colb, const f32x4 (&bv)[2][2]) const {
        const __amdgpu_buffer_rsrc_t r0 = __builtin_amdgcn_make_buffer_rsrc((void*)GT, 0, 0x7fffffff, 0x00020000), r1 = __builtin_amdgcn_make_buffer_rsrc((void*)GT2, 0, 0x7fffffff, 0x00020000),
                                     ro = __builtin_amdgcn_make_buffer_rsrc((void*)MG, 0, 0x7fffffff, 0x00020000);
        u32x4 y0q[8], y1q[8], oq[8];
        const unsigned vb = (unsigned)((row0 * 1024 + colb) * 2);
#define EPM_SOFF(c) ((((c) >> 2) * HALF + ((c) & 3) * 16) * 1024 * 2)
#define EPM_LOAD(c) do { \
            y0q[c] = __builtin_bit_cast(u32x4, __builtin_amdgcn_raw_buffer_load_b128(r0, vb, EPM_SOFF(c), 16)); y1q[c] = __builtin_bit_cast(u32x4, __builtin_amdgcn_raw_buffer_load_b128(r1, vb, EPM_SOFF(c), 16)); \
            oq[c] = FIRST ? (u32x4){0u, 0u, 0u, 0u} : __builtin_bit_cast(u32x4, __builtin_amdgcn_raw_buffer_load_b128(ro, vb, EPM_SOFF(c), 16)); asm volatile("" ::: "memory"); } while (0)
#pragma unroll
        for (int c = 0; c < GP_DEPTH; ++c) { if (c == 0) EPM_LOAD(0); else if (c == 1) EPM_LOAD(1); else if (c == 2) EPM_LOAD(2); else if (c == 3) EPM_LOAD(3); else if (c == 4) EPM_LOAD(4); else if (c == 5) EPM_LOAD(5); else if (c == 6) EPM_LOAD(6); else EPM_LOAD(7); }
#pragma unroll
        for (int c = 0; c < 8; ++c) { const int ai = c >> 2, mm = c & 3;
            f32x4 ga0 = acc[ai][0][mm][0] + bv[0][0], ga1 = acc[ai][0][mm][1] + bv[0][1], gb0 = acc[ai][1][mm][0] + bv[1][0], gb1 = acc[ai][1][mm][1] + bv[1][1];
#pragma unroll
            for (int e = 0; e < 4; ++e) { ga0[e] = sigmoidf_(ga0[e]); ga1[e] = sigmoidf_(ga1[e]); gb0[e] = sigmoidf_(gb0[e]); gb1[e] = sigmoidf_(gb1[e]); }
            const u32x4 ya = y0q[c], yb = y1q[c], o = oq[c];
            u32x4 w;
            w.x = cvt_pk_bf16(bf_lo(o.x) + ga0[0] * bf_lo(ya.x) + gb0[0] * bf_lo(yb.x), bf_hi(o.x) + ga0[1] * bf_hi(ya.x) + gb0[1] * bf_hi(yb.x));
            w.y = cvt_pk_bf16(bf_lo(o.y) + ga0[2] * bf_lo(ya.y) + gb0[2] * bf_lo(yb.y), bf_hi(o.y) + ga0[3] * bf_hi(ya.y) + gb0[3] * bf_hi(yb.y));
            w.z = cvt_pk_bf16(bf_lo(o.z) + ga1[0] * bf_lo(ya.z) + gb1[0] * bf_lo(yb.z), bf_hi(o.z) + ga1[1] * bf_hi(ya.z) + gb1[1] * bf_hi(yb.z));
            w.w = cvt_pk_bf16(bf_lo(o.w) + ga1[2] * bf_lo(ya.w) + gb1[2] * bf_lo(yb.w), bf_hi(o.w) + ga1[3] * bf_hi(ya.w) + gb1[3] * bf_hi(yb.w));
            *(u32x4*)((char*)MG + vb + EPM_SOFF(c)) = w;
            asm volatile("" ::: "memory");
            if (c + GP_DEPTH < 8) { const int cn = c + GP_DEPTH; if (cn == 1) EPM_LOAD(1); else if (cn == 2) EPM_LOAD(2); else if (cn == 3) EPM_LOAD(3); else if (cn == 4) EPM_LOAD(4); else if (cn == 5) EPM_LOAD(5); else if (cn == 6) EPM_LOAD(6); else EPM_LOAD(7); } }
#undef EPM_LOAD
#undef EPM_SOFF
    }
    __device__ __forceinline__ void operator()(const f32x4 (&acc)[2][2][4][2], const Unit& u, int wr, int wc, int fr, int fq) const {
        const int row0 = u.pm * BM + wr * 64 + fr; const int col0 = u.pn * BM + wc * 32 + 8 * fq;
        if (u.kind == 1) {
            bf16_t* Yu = (u.pm >= 64) ? GTc + ((size_t)u.r * 512 - 16384) * 1024 : ((u.r & 1) ? GT2 : GT);
#pragma unroll
            for (int ai = 0; ai < 2; ++ai)
#pragma unroll
                for (int m = 0; m < 4; ++m) { bf16_t* rowp = Yu + (size_t)(row0 + ai * HALF + m * 16) * 1024 + col0;
#pragma unroll
                    for (int bj = 0; bj < 2; ++bj) { const f32x4 v0 = acc[ai][bj][m][0], v1 = acc[ai][bj][m][1];
                        u32x4 w; w.x = cvt_pk_bf16(v0[0], v0[1]); w.y = cvt_pk_bf16(v0[2], v0[3]); w.z = cvt_pk_bf16(v1[0], v1[1]); w.w = cvt_pk_bf16(v1[2], v1[3]);
                        *(u32x4*)(rowp + bj * HALF) = w; } }
        } else if (u.kind == 2) {
            bf16_t* Yu = GTc + ((size_t)u.r * 512 - 16384) * 1024;
            const float* bp = bias + u.r * 1024 + col0;
            f32x4 bv[2][2];
#pragma unroll
            for (int bj = 0; bj < 2; ++bj)
#pragma unroll
                for (int n = 0; n < 2; ++n) bv[bj][n] = *(const f32x4*)(bp + bj * HALF + 4 * n);
            gate_ctx(acc, Yu, row0, col0, bv);
        } else {
            const int p2 = u.r & 2, colb = u.pn * BM + (u.r & 1) * HALF + wc * 32 + 8 * fq;
            f32x4 bv[2][2];
#pragma unroll
            for (int bj = 0; bj < 2; ++bj)
#pragma unroll
                for (int n = 0; n < 2; ++n) bv[bj][n] = *(const f32x4*)(bias + (p2 + bj) * 1024 + colb + 4 * n);
            if (p2 == 0) gate_pair<true>(acc, row0, colb, bv); else gate_pair<false>(acc, row0, colb, bv);
        }
    }
};
struct OrderOut {
    StaticOrder so; int nx; const bf16_t* TERM;
    __device__ bool next(int i, Unit& u) const {
        const long L = (long)i * so.G + so.c;
        if (L < so.nwg) return so.next(i, u);
        const int e = (int)(L - so.nwg); if (e >= nx) return false;
        const int t = e >> 4; u.pm = 64 + (t >> 2); u.pn = t & 3; u.r = e & 15; u.kind = 3; return true;
    }
    __device__ __forceinline__ void src(const Gemm& g, const Unit& u, const char*& pa, const char*& pb, const char*& pb1, int& nt) const {
        pa = (const char*)g.A + (size_t)u.pm * (2 * HALF) * g.lda * 2; pb = (const char*)g.Bt + (size_t)u.pn * (2 * HALF) * g.ldb * 2; nt = g.K / BK;
        if (u.kind == 3) { const int br = u.r >> 2, kq = u.r & 3; pa = (const char*)(TERM + ((size_t)br * 512 + (u.pm - 64) * 256) * 1024 + kq * 256); pb += (size_t)kq * 256 * 2; nt = 4; }
        pb1 = pb + (size_t)HALF * g.ldb * 2;
    }
};

template <class Epi, class Sched, bool ALIGN_EPI, bool RELAX = false>
__device__ __forceinline__ void gemm_phase(PG8_LAS unsigned char* lds, const Gemm g, const Sched& S, const Epi& E) {
    int tid = threadIdx.x; asm volatile("" : "+v"(tid));
    const int wid = __builtin_amdgcn_readfirstlane(tid >> 6), lane = tid & 63, wr = wid >> 2, wc = wid & 3, fr = lane & 15, fq = lane >> 4;
    int nt;
    unsigned voffA[2], voffB[2];
#pragma unroll
    for (int i = 0; i < 2; ++i) { int R, C; stage_rc(tid * 16 + i * 8192, R, C); const int Rb = Epi::PERM ? ((R & ~31) + perm32(R & 31)) : R;
        voffA[i] = (unsigned)(R * g.lda + C) * 2u; voffB[i] = (unsigned)(Rb * g.ldb + C) * 2u; }
    const size_t kstep = (size_t)(BK * 2);
    const size_t hstepA = (size_t)HALF * g.lda * 2;
    const unsigned ldsw = (unsigned)wid * 1024u;
    const int aoff = lds_byte(wr * 64 + fr, fq * 8), boff = lds_byte(wc * 32 + fr, fq * 8);
#define PG8_SA(b, h) (((b) * 2 + (h)) * HTB)
#define PG8_SB(b, h) ((4 + (b) * 2 + (h)) * HTB)
#define PG8_STAGE(bufoff, gbase, voff) do { _Pragma("unroll") for (int _i = 0; _i < 2; ++_i) { unsigned vo_ = (voff)[_i]; asm volatile("" : "+v"(vo_));        \
        __builtin_amdgcn_global_load_lds((const unsigned*)((const char*)(gbase) + vo_), (PG8_LAS unsigned*)(lds + (bufoff) + ldsw + _i * 8192), 16, 0, 0); } } while (0)
#define PG8_LDA(dst, b, h) do { _Pragma("unroll") for (int m = 0; m < 4; ++m) _Pragma("unroll") for (int k = 0; k < 2; ++k) dst[m][k] = *(const PG8_LAS bf16x8*)(lds + PG8_SA(b, h) + aoff + m * 2048 + k * 1024); } while (0)
#define PG8_LDB(dst, b, h) do { _Pragma("unroll") for (int n = 0; n < 2; ++n) _Pragma("unroll") for (int k = 0; k < 2; ++k) dst[n][k] = *(const PG8_LAS bf16x8*)(lds + PG8_SB(b, h) + boff + n * 2048 + k * 1024); } while (0)
#define PG8_MMA(ai, bj, At, Bt) do { __builtin_amdgcn_s_setprio(1); _Pragma("unroll") for (int m = 0; m < 4; ++m) _Pragma("unroll") for (int n = 0; n < 2; ++n) _Pragma("unroll") for (int k = 0; k < 2; ++k) \
        acc[ai][bj][m][n] = __builtin_amdgcn_mfma_f32_16x16x32_bf16(Bt[n][k], At[m][k], acc[ai][bj][m][n], 0, 0, 0); __builtin_amdgcn_s_setprio(0); } while (0)
#define PG8_WAIT_V(n) asm volatile("s_waitcnt vmcnt(" #n ")" ::: "memory")
#define PG8_WAIT_L(n) asm volatile("s_waitcnt lgkmcnt(" #n ")" ::: "memory")
#define PG8_WAIT_VX(rx) asm volatile("s_cmp_eq_u32 %0, 0\n\ts_cbranch_scc1 .Lpg8w8_%=\n\ts_waitcnt vmcnt(%1)\n\ts_branch .Lpg8wd_%=\n.Lpg8w8_%=:\n\ts_waitcnt vmcnt(8)\n.Lpg8wd_%=:" :: "s"(rx), "n"(8 + Epi::NSTORE) : "memory", "scc")
#define PG8_BAR __builtin_amdgcn_s_barrier()
#define PG8_SCHED __builtin_amdgcn_sched_barrier(0)
    Unit cur, nxt; int ui = 0;
    if (!S.next(0, cur)) return;
    f32x4 acc[2][2][4][2];
#pragma unroll
    for (int a = 0; a < 2; ++a)
#pragma unroll
        for (int b = 0; b < 2; ++b)
#pragma unroll
            for (int m = 0; m < 4; ++m)
#pragma unroll
                for (int n = 0; n < 2; ++n) acc[a][b][m][n] = (f32x4){0.f, 0.f, 0.f, 0.f};
    bf16x8 At[4][2], B0[2][2], B1[2][2];
    const char* cA; const char* cB; const char* cB1; S.src(g, cur, cA, cB, cB1, nt);
    PG8_STAGE(PG8_SB(0, 0), cB, voffB); PG8_STAGE(PG8_SB(0, 1), cB1, voffB); PG8_STAGE(PG8_SA(0, 0), cA, voffA); PG8_STAGE(PG8_SA(0, 1), cA + hstepA, voffA);
    if (wr == 1) PG8_BAR;
    PG8_WAIT_V(2); PG8_BAR;
    PG8_STAGE(PG8_SB(1, 0), cB + kstep, voffB); PG8_STAGE(PG8_SA(1, 0), cA + kstep, voffA); PG8_STAGE(PG8_SB(1, 1), cB1 + kstep, voffB);
    PG8_WAIT_V(6); PG8_BAR;
    for (;;) {
        const bool has_next = S.next(ui + 1, nxt);
        const char* nA = cA; const char* nB = cB; const char* nB1 = cB1; int nnt = nt; if (has_next) S.src(g, nxt, nA, nB, nB1, nnt);
        for (int t = 0; t < nt; t += 2) {
            const bool last = (t == nt - 2);
            const char* a1 = cA + (size_t)(t + 1) * kstep;
            const char* a2 = last ? nA : cA + (size_t)(t + 2) * kstep; const char* b2 = last ? nB : cB + (size_t)(t + 2) * kstep;
            const char* a3 = a2 + kstep; const char* b3 = b2 + kstep;
            const char* b2h = last ? nB1 : cB1 + (size_t)(t + 2) * kstep; const char* b3h = b2h + kstep;
            asm volatile("" : "+s"(a1), "+s"(a2), "+s"(a3), "+s"(b2), "+s"(b3), "+s"(b2h), "+s"(b3h));
            const int relax = __builtin_amdgcn_readfirstlane((RELAX && Epi::NSTORE > 0 && t == 0 && ui > 0) ? 1 : 0);
            PG8_LDB(B0, 0, 0); PG8_LDB(B1, 0, 1); PG8_SCHED; PG8_LDA(At, 0, 0); PG8_STAGE(PG8_SA(1, 1), a1 + hstepA, voffA);
            PG8_WAIT_VX(relax); PG8_WAIT_L(0); PG8_BAR; PG8_MMA(0, 0, At, B0); PG8_MMA(0, 1, At, B1); PG8_BAR; PG8_SCHED;
            PG8_LDA(At, 0, 1); PG8_STAGE(PG8_SB(0, 0), b2, voffB); PG8_STAGE(PG8_SB(0, 1), b2h, voffB); PG8_STAGE(PG8_SA(0, 0), a2, voffA);
            PG8_WAIT_VX(relax); PG8_WAIT_L(0); PG8_BAR; PG8_MMA(1, 0, At, B0); PG8_MMA(1, 1, At, B1); PG8_BAR; PG8_SCHED;
            PG8_LDB(B0, 1, 0); PG8_LDB(B1, 1, 1); PG8_SCHED; PG8_LDA(At, 1, 0); PG8_STAGE(PG8_SA(0, 1), a2 + hstepA, voffA);
            PG8_WAIT_V(8); PG8_WAIT_L(0); PG8_BAR; PG8_MMA(0, 0, At, B0); PG8_MMA(0, 1, At, B1); PG8_BAR; PG8_SCHED;
            PG8_LDA(At, 1, 1); PG8_STAGE(PG8_SB(1, 0), b3, voffB); PG8_STAGE(PG8_SB(1, 1), b3h, voffB); PG8_STAGE(PG8_SA(1, 0), a3, voffA);
            PG8_WAIT_V(8); PG8_WAIT_L(0); PG8_BAR; PG8_MMA(1, 0, At, B0); PG8_MMA(1, 1, At, B1); PG8_BAR; PG8_SCHED;
        }
        if constexpr (ALIGN_EPI) { if (wr == 0) PG8_BAR; }
        E(acc, cur, wr, wc, fr, fq);
        if (!has_next) break;
#pragma unroll
        for (int a = 0; a < 2; ++a)
#pragma unroll
            for (int b = 0; b < 2; ++b)
#pragma unroll
                for (int m = 0; m < 4; ++m)
#pragma unroll
                    for (int n = 0; n < 2; ++n) acc[a][b][m][n] = (f32x4){0.f, 0.f, 0.f, 0.f};
        cur = nxt; cA = nA; cB = nB; cB1 = nB1; nt = nnt; ++ui;
        if constexpr (ALIGN_EPI) { if (wr == 1) PG8_BAR; }
    }
    PG8_WAIT_V(0);
    if constexpr (!ALIGN_EPI) { if (wr == 0) PG8_BAR; }
    PG8_BAR;
#undef PG8_SA
#undef PG8_SB
#undef PG8_STAGE
#undef PG8_LDA
#undef PG8_LDB
#undef PG8_MMA
#undef PG8_WAIT_V
#undef PG8_WAIT_L
#undef PG8_WAIT_VX
#undef PG8_BAR
#undef PG8_SCHED
}
}
namespace attn_body {
using bf16=__hip_bfloat16;
using bf16x8=__attribute__((ext_vector_type(8)))short;
using s16x4=__attribute__((ext_vector_type(4)))short;
using f32x16=__attribute__((ext_vector_type(16)))float;
using u32x4=__attribute__((ext_vector_type(4)))unsigned;
using f32x4=__attribute__((ext_vector_type(4)))float;
constexpr int D=64;
constexpr int NW=8,QBLK=32,QB=QBLK*NW,KVBLK=64;
constexpr int PP=2816, YP=1024;
__device__ __forceinline__ int crow(int r,int hi){return (r&3)+8*(r>>2)+4*hi;}
#define SBAR() __builtin_amdgcn_sched_barrier(0)
__device__ __forceinline__ void dmask(f32x16&p0,f32x16&p1,int kb,unsigned lim,int qrel,int hi){
  const float NEG=-INFINITY; const unsigned b0=(unsigned)(kb+4*hi-qrel+128);
  #pragma unroll
  for(int r=0;r<16;++r){const unsigned dd=b0+(unsigned)((r&3)+8*(r>>2)); if(dd>lim)p0[r]=NEG; if(dd+32u>lim)p1[r]=NEG;}
}

constexpr int NSLOT=3, SLOTB=8192;
constexpr int LDS_K=0, LDS_V=NSLOT*SLOTB, LDS_WS=2*NSLOT*SLOTB, LDS_OST=LDS_WS+NW*64*4, LDS_BYTES=LDS_OST+NW*4096;
constexpr float C2=0.125f*1.4426950408889634f;
__device__ __forceinline__ void glds16(const void*gsrc,unsigned lds_dst){unsigned keep;
  asm volatile("s_mov_b32 %0, m0\n\ts_mov_b32 m0, %2\n\ts_nop 0\n\tglobal_load_lds_dwordx4 %1, off\n\ts_mov_b32 m0, %0":"=&s"(keep):"v"(gsrc),"s"(lds_dst):"memory");}
__device__ __forceinline__ float siluf_(float x){ return x*__builtin_amdgcn_rcpf(1.0f+__builtin_amdgcn_exp2f(-1.4426950408889634f*x)); }
__device__ __forceinline__ float max3f(float a,float b,float c){float r;asm("v_max3_f32 %0, %1, %2, %3":"=v"(r):"v"(a),"v"(b),"v"(c));return r;}
__device__ __forceinline__ float max2f(float a,float b){float r;asm("v_max_f32_e32 %0, %1, %2":"=v"(r):"v"(a),"v"(b));return r;}
__device__ __forceinline__ float fadd_s(float a,float b){float r;asm("v_add_f32_e32 %0, %1, %2":"=v"(r):"v"(a),"v"(b));return r;}
__device__ __forceinline__ float fsub_s(float a,float b){float r;asm("v_sub_f32_e32 %0, %1, %2":"=v"(r):"v"(a),"v"(b));return r;}
typedef float f32x2_t __attribute__((ext_vector_type(2))); typedef __bf16 bf16x2_t __attribute__((ext_vector_type(2)));
__device__ __forceinline__ unsigned cvtpk_s(float lo,float hi){f32x2_t v={lo,hi};bf16x2_t b=__builtin_convertvector(v,bf16x2_t);return __builtin_bit_cast(unsigned,b);}
#define WAIT_BAR(N) asm volatile("s_waitcnt vmcnt(" #N ") lgkmcnt(0)\n\ts_barrier":::"memory")

__device__ __forceinline__ void qkt(f32x16&p0,f32x16&p1,const char*Kslot,const bf16x8*qr,const f32x16&negm,int r32,int hi){
  const char*kb=Kslot+hi*1024+r32*16;
  #pragma unroll
  for(int d0=0;d0<4;++d0){
    const bf16x8 b0=*reinterpret_cast<const bf16x8*>(kb+d0*2048);
    const bf16x8 b1=*reinterpret_cast<const bf16x8*>(kb+d0*2048+512);
    if(d0==0){p0=__builtin_amdgcn_mfma_f32_32x32x16_bf16(b0,qr[0],negm,0,0,0);p1=__builtin_amdgcn_mfma_f32_32x32x16_bf16(b1,qr[0],negm,0,0,0);}
    else{p0=__builtin_amdgcn_mfma_f32_32x32x16_bf16(b0,qr[d0],p0,0,0,0);p1=__builtin_amdgcn_mfma_f32_32x32x16_bf16(b1,qr[d0],p1,0,0,0);}}
}
typedef __attribute__((address_space(3))) const char* lds_cptr;
typedef short v4i16_t __attribute__((ext_vector_type(4)));
__device__ __forceinline__ void kload8(bf16x8*kf,lds_cptr kp){
  kf[0]=*(const __attribute__((address_space(3))) bf16x8*)(kp);      kf[1]=*(const __attribute__((address_space(3))) bf16x8*)(kp+512);
  kf[2]=*(const __attribute__((address_space(3))) bf16x8*)(kp+2048); kf[3]=*(const __attribute__((address_space(3))) bf16x8*)(kp+2560);
  kf[4]=*(const __attribute__((address_space(3))) bf16x8*)(kp+4096); kf[5]=*(const __attribute__((address_space(3))) bf16x8*)(kp+4608);
  kf[6]=*(const __attribute__((address_space(3))) bf16x8*)(kp+6144); kf[7]=*(const __attribute__((address_space(3))) bf16x8*)(kp+6656);
}
__device__ __forceinline__ void kload2(bf16x8*kf,lds_cptr kp,int j){ kf[2*j]=*(const __attribute__((address_space(3))) bf16x8*)(kp+j*2048); kf[2*j+1]=*(const __attribute__((address_space(3))) bf16x8*)(kp+j*2048+512); }
__device__ __forceinline__ s16x4 vtr(lds_cptr p){ return __builtin_bit_cast(s16x4,__builtin_amdgcn_ds_read_tr16_b64_v4i16((__attribute__((address_space(3))) v4i16_t*)p)); }
__device__ __forceinline__ float rowmax(const f32x16&p0,const f32x16&p1){
  float a=max3f(p0[0],p0[1],p1[0]),b=max3f(p0[2],p0[3],p1[1]);a=max3f(a,p1[2],p1[3]);
  #pragma unroll
  for(int r=4;r<16;r+=4){a=max3f(a,p0[r],p0[r+1]);b=max3f(b,p0[r+2],p0[r+3]);a=max3f(a,p1[r],p1[r+1]);b=max3f(b,p1[r+2],p1[r+3]);}
  const float m=max2f(a,b);
  auto rr=__builtin_amdgcn_permlane32_swap(__float_as_uint(m),__float_as_uint(m),false,false);
  return max2f(__uint_as_float(rr[0]),__uint_as_float(rr[1]));
}
__device__ __forceinline__ void pv(f32x16*o,int vb,bf16x8 pa0,bf16x8 pa1,bf16x8 pa2,bf16x8 pa3){
  #pragma unroll
  for(int d0=0;d0<2;++d0){s16x4 lo[4],hi[4];
    #pragma unroll
    for(int ks=0;ks<4;++ks){
      asm volatile("ds_read_b64_tr_b16 %0,%1 offset:%c2":"=&v"(lo[ks]):"v"(vb),"i"(d0*4096+ks*1024):"memory");
      asm volatile("ds_read_b64_tr_b16 %0,%1 offset:%c2":"=&v"(hi[ks]):"v"(vb),"i"(d0*4096+ks*1024+512):"memory");}
    asm volatile("s_waitcnt lgkmcnt(0)":::"memory");SBAR();
    #define PK(k) (bf16x8){lo[k][0],lo[k][1],lo[k][2],lo[k][3],hi[k][0],hi[k][1],hi[k][2],hi[k][3]}
    o[d0]=__builtin_amdgcn_mfma_f32_32x32x16_bf16(pa0,PK(0),o[d0],0,0,0);
    o[d0]=__builtin_amdgcn_mfma_f32_32x32x16_bf16(pa1,PK(1),o[d0],0,0,0);
    o[d0]=__builtin_amdgcn_mfma_f32_32x32x16_bf16(pa2,PK(2),o[d0],0,0,0);
    o[d0]=__builtin_amdgcn_mfma_f32_32x32x16_bf16(pa3,PK(3),o[d0],0,0,0);
    #undef PK
  }
}

#ifndef ATTN_STORE16
#define ATTN_STORE16(p,v) (*(u32x4*)(p)=(v))
#endif
template<int MODE,int THRL> __device__ __forceinline__ void attn_unit(const bf16*Pm,bf16*YB,int qrow0,int ctx0,int lat0,int off,int NT,int wq0,int qcol,int kcol,int vcol,int zcol,int ocol,float sinkl2,char*shm,const float*qw,int rope){
  int tid_=threadIdx.x; asm volatile("":"+v"(tid_)); const int tid=tid_,lane=tid&63,r32=lane&31,hi=lane>>5; const int wid=__builtin_amdgcn_readfirstlane(tid>>6);
  const bf16*Qw=Pm+(long)(qrow0+wid*QBLK)*PP+qcol;
  const unsigned lds0=(unsigned)(uintptr_t)shm;
  float*wsf=(float*)(shm+LDS_WS)+wid*64;
  const bf16*ksrc=Pm+kcol+(long)lane*PP+wid*8;
  const bf16*vsrc=Pm+vcol+(long)(16*(wid&3)+(lane>>2))*PP+(wid>>2)*32+(lane&3)*8;
  const unsigned kdst=lds0+LDS_K+wid*1024, vdst=lds0+LDS_V+wid*1024;
  #define TROW(t) (((t)<4)?(ctx0+64*(t)):(lat0+64*((t)-4+off)))
  #define DMA_K(t,slot) glds16(ksrc+(long)TROW(t)*PP,(unsigned)__builtin_amdgcn_readfirstlane(kdst+(slot)))
  #define DMA_V(t,slot) glds16(vsrc+(long)TROW(t)*PP,(unsigned)__builtin_amdgcn_readfirstlane(vdst+(slot)))
  const int vb0=(int)(lds0+LDS_V)+((lane>>4)&1)*32+(lane&3)*8+(4*hi+((lane&15)>>2))*64;
  const char*Kbase=shm+LDS_K; bf16x8 kf[8];
  const lds_cptr shm3=(lds_cptr)shm; const lds_cptr kp0=shm3+LDS_K+hi*1024+r32*16; const lds_cptr vp0=shm3+LDS_V+((lane>>4)&1)*32+(lane&3)*8+(4*hi+((lane&15)>>2))*64;
  DMA_K(0,0);DMA_V(0,0);DMA_K(1,SLOTB);
  bf16x8 qr[4];
  { bf16x8 qraw[4];
    #pragma unroll
    for(int d0=0;d0<4;++d0)qraw[d0]=*reinterpret_cast<const bf16x8*>(&Qw[(long)r32*PP+d0*16+hi*8]);
    f32x4 wq[4][2];
    #pragma unroll
    for(int d0=0;d0<4;++d0){wq[d0][0]=*reinterpret_cast<const f32x4*>(qw+16*d0+8*hi);wq[d0][1]=*reinterpret_cast<const f32x4*>(qw+16*d0+8*hi+4);}
    float ss=0.f;
    #pragma unroll
    for(int d0=0;d0<4;++d0)
      #pragma unroll
      for(int j=0;j<8;++j){const float f=__uint_as_float(((unsigned)(unsigned short)qraw[d0][j])<<16);ss+=f*f;}
    {auto rr=__builtin_amdgcn_permlane32_swap(__float_as_uint(ss),__float_as_uint(ss),false,false);ss=__uint_as_float(rr[0])+__uint_as_float(rr[1]);}
    const float rs=__builtin_amdgcn_rsqf(ss*(1.0f/64.0f)+1e-6f)*C2;
    const int ntok=(qrow0+wid*QBLK+r32)&8191;
    #pragma unroll
    for(int hf=0;hf<2;++hf){ const float pos=(float)(hf?(ntok&63):(ntok>>6)); unsigned pk1[4],pk2[4];
      #pragma unroll
      for(int jp=0;jp<4;++jp){ float y1[2],y2[2];
        #pragma unroll
        for(int e=0;e<2;++e){ const int j=2*jp+e; const int fi=8*hi+j;
          const float inv=__builtin_amdgcn_exp2f(-(float)fi*(13.287712379549449f/16.0f))*0.15915494309189535f;
          const float rev=pos*inv; const float cs=rope?__builtin_amdgcn_cosf(rev):1.0f, sn=rope?__builtin_amdgcn_sinf(rev):0.0f;
          const float x1=__uint_as_float(((unsigned)(unsigned short)qraw[2*hf][j])<<16)*rs*wq[2*hf][j>>2][j&3];
          const float x2=__uint_as_float(((unsigned)(unsigned short)qraw[2*hf+1][j])<<16)*rs*wq[2*hf+1][j>>2][j&3];
          y1[e]=x1*cs-x2*sn; y2[e]=x1*sn+x2*cs; }
        pk1[jp]=cvtpk_s(y1[0],y1[1]); pk2[jp]=cvtpk_s(y2[0],y2[1]); }
      qr[2*hf]=__builtin_bit_cast(bf16x8,(u32x4){pk1[0],pk1[1],pk1[2],pk1[3]}); qr[2*hf+1]=__builtin_bit_cast(bf16x8,(u32x4){pk2[0],pk2[1],pk2[2],pk2[3]}); } }
  float mhat=0.f,l_reg=0.f;f32x16 o[2];o[0]=f32x16{};o[1]=f32x16{};f32x16 negm=f32x16{}; if(MODE==0){asm volatile("":"+v"(negm));}
  const int qrel=wid*QBLK+r32;
  #define CMASK(P0,P1,t) do{ if(MODE==1){ if((t)>=4){ const int kb_=64*((t)-4)-wq0, dlo_=kb_-32*wid-31, dhi_=kb_+63-32*wid; if(dlo_<-128||dhi_>128) dmask(P0,P1,kb_,256u,qrel,hi); } } }while(0)
  bool resc=false;
  #define START(P0,P1) do{ const float rm=rowmax(P0,P1); resc=false; \
    { const float dl=rm; mhat=fadd_s(mhat,dl); \
      _Pragma("unroll") for(int r=0;r<16;++r){P0[r]=fsub_s(P0[r],dl);P1[r]=fsub_s(P1[r],dl);} \
      if(MODE==0){ _Pragma("unroll") for(int r=0;r<16;++r)negm[r]=-mhat; asm volatile("":"+v"(negm)); } } \
    _Pragma("unroll") for(int r=0;r<16;++r)P0[r]=__builtin_amdgcn_exp2f(P0[r]); }while(0)
  #define RESC() do{ if(resc){ asm volatile("s_waitcnt lgkmcnt(0)":::"memory"); \
      _Pragma("unroll") for(int d_=0;d_<2;++d_) _Pragma("unroll") for(int r=0;r<16;++r)o[d_][r]*=wsf[crow(r,hi)]; } }while(0)
  f32x16 pA0,pA1,pB0,pB1;
  int sl_prev=0,sl_cur=0,sl_next=SLOTB;
  #define ROT() do{sl_prev=sl_cur;sl_cur=sl_next;sl_next=(sl_next==(NSLOT-1)*SLOTB)?0:sl_next+SLOTB;}while(0)
  DMA_K(2,2*SLOTB);
  WAIT_BAR(3);
  qkt(pA0,pA1,Kbase,qr,negm,r32,hi);asm volatile("s_nop 15\n\ts_nop 7":"+v"(pA0),"+v"(pA1));CMASK(pA0,pA1,0);
  START(pA0,pA1);
  _Pragma("unroll") for(int r=0;r<16;++r)pA1[r]=__builtin_amdgcn_exp2f(pA1[r]);
  WAIT_BAR(0);
  DMA_K(3,0);DMA_V(1,SLOTB);
  ROT();
  kload8(kf,kp0+sl_cur);
  WAIT_BAR(2);
  s16x4 vlo[8],vhi[8]; u32x4 pw0,pw1,pw2,pw3;
  #define PKW(P,B) cvtpk_s(P[B],P[B+1])
  #define PAF(k) __builtin_bit_cast(bf16x8,pw##k)
  #define VFR(i) (bf16x8){vlo[i][0],vlo[i][1],vlo[i][2],vlo[i][3],vhi[i][0],vhi[i][1],vhi[i][2],vhi[i][3]}
  #define PIN(x) asm volatile("":"+v"(x))
  #define MX3(a,b,c) __builtin_fmaxf(__builtin_fmaxf((a),(b)),(c))
  #define GAPA(MF,A0,A1,A2,A3,W0,W1,PW) do{ MF; sacc+=A0; sacc+=A1; sacc+=A2; sacc+=A3; PIN(sacc); W0; W1; PIN(PW); SBAR(); }while(0)
  #define EX(v) __builtin_amdgcn_exp2f(v)
  #define GAPB(MF,X,B) do{ MF; X[B]=EX(X[B]); X[B+1]=EX(X[B+1]); X[B+2]=EX(X[B+2]); X[B+3]=EX(X[B+3]); PIN(X); SBAR(); }while(0)
  #define VRD(i) do{ vlo[i]=vtr(vp_+(((i)>>2)*4096+((i)&3)*1024)); vhi[i]=vtr(vp_+(((i)>>2)*4096+((i)&3)*1024+512)); }while(0)
  #define KRD(G,j) do{ if(G){ kload2(kf,kp0+sl_next,j); SBAR(); } }while(0)
  #define STEP(C0,C1,P0,P1,t,GK,GV,GL,MX) do{ SBAR(); \
    const lds_cptr vp_=vp0+sl_prev; \
    VRD(0); SBAR(); float sacc=(P0[0]+P0[1]); \
    GAPA(C0=__builtin_amdgcn_mfma_f32_32x32x16_bf16(kf[0],qr[0],negm,0,0,0), P0[2],P0[3],P0[4],P0[5],     pw0[0]=PKW(P0,0), pw0[1]=PKW(P0,2), pw0); \
    VRD(4); SBAR(); GAPA(C1=__builtin_amdgcn_mfma_f32_32x32x16_bf16(kf[1],qr[0],negm,0,0,0), P0[6],P0[7],P0[8],P0[9],     pw0[2]=PKW(P0,4), pw0[3]=PKW(P0,6), pw0); \
    VRD(1); SBAR(); GAPA(C0=__builtin_amdgcn_mfma_f32_32x32x16_bf16(kf[2],qr[1],C0,0,0,0),   P0[10],P0[11],P0[12],P0[13], pw1[0]=PKW(P0,8), pw1[1]=PKW(P0,10), pw1); \
    VRD(5); SBAR(); GAPA(C1=__builtin_amdgcn_mfma_f32_32x32x16_bf16(kf[3],qr[1],C1,0,0,0),   P0[14],P0[15],P1[0],P1[1],   pw1[2]=PKW(P0,12),pw1[3]=PKW(P0,14), pw1); \
    VRD(2); SBAR(); GAPA(C0=__builtin_amdgcn_mfma_f32_32x32x16_bf16(kf[4],qr[2],C0,0,0,0),   P1[2],P1[3],P1[4],P1[5],     pw2[0]=PKW(P1,0), pw2[1]=PKW(P1,2), pw2); \
    VRD(6); SBAR(); GAPA(C1=__builtin_amdgcn_mfma_f32_32x32x16_bf16(kf[5],qr[2],C1,0,0,0),   P1[6],P1[7],P1[8],P1[9],     pw2[2]=PKW(P1,4), pw2[3]=PKW(P1,6), pw2); \
    VRD(3); SBAR(); GAPA(C0=__builtin_amdgcn_mfma_f32_32x32x16_bf16(kf[6],qr[3],C0,0,0,0),   P1[10],P1[11],P1[12],P1[13], pw3[0]=PKW(P1,8), pw3[1]=PKW(P1,10), pw3); \
    VRD(7); SBAR(); GAPA(C1=__builtin_amdgcn_mfma_f32_32x32x16_bf16(kf[7],qr[3],C1,0,0,0),   P1[14],P1[15],0.f,0.f,       pw3[2]=PKW(P1,12),pw3[3]=PKW(P1,14), pw3); \
    l_reg+=sacc; \
    if(GK){DMA_K((t)+3,sl_cur);} if(GV){DMA_V((t)+1,sl_next);} \
    CMASK(C0,C1,t); \
    resc=false; if(MX){ float a=MX3(C0[0],C0[1],C1[0]),b=MX3(C0[2],C0[3],C1[1]); a=MX3(a,C1[2],C1[3]); \
      _Pragma("unroll") for(int r=4;r<16;r+=4){a=MX3(a,C0[r],C0[r+1]);b=MX3(b,C0[r+2],C0[r+3]);a=MX3(a,C1[r],C1[r+1]);b=MX3(b,C1[r+2],C1[r+3]);} \
      float rm=__builtin_fmaxf(a,b); { auto rr=__builtin_amdgcn_permlane32_swap(__float_as_uint(rm),__float_as_uint(rm),false,false); rm=__builtin_fmaxf(__uint_as_float(rr[0]),__uint_as_float(rr[1])); } \
      resc=false; if(MODE==1) rm-=mhat; \
      if(__builtin_expect(__any(rm>(float)THRL),0)){ const float dl=__builtin_fmaxf(rm,0.f); mhat+=dl; \
        if(MODE==0){ _Pragma("unroll") for(int r=0;r<16;++r){C0[r]-=dl;C1[r]-=dl;} \
          _Pragma("unroll") for(int r=0;r<16;++r)negm[r]=-mhat; asm volatile("":"+v"(negm)); } \
        const float f=__builtin_amdgcn_exp2f(-dl); l_reg*=f; if(hi==0)wsf[r32]=f; resc=true; } \
      if(MODE==1){ _Pragma("unroll") for(int r=0;r<16;++r){C0[r]-=mhat;C1[r]-=mhat;} } } \
    SBAR(); \
    GAPB(o[0]=__builtin_amdgcn_mfma_f32_32x32x16_bf16(PAF(0),VFR(0),o[0],0,0,0), C0,0); \
    GAPB(o[1]=__builtin_amdgcn_mfma_f32_32x32x16_bf16(PAF(0),VFR(4),o[1],0,0,0), C0,4); \
    KRD(GL,0); GAPB(o[0]=__builtin_amdgcn_mfma_f32_32x32x16_bf16(PAF(1),VFR(1),o[0],0,0,0), C0,8); \
    KRD(GL,1); GAPB(o[1]=__builtin_amdgcn_mfma_f32_32x32x16_bf16(PAF(1),VFR(5),o[1],0,0,0), C0,12); \
    KRD(GL,2); GAPB(o[0]=__builtin_amdgcn_mfma_f32_32x32x16_bf16(PAF(2),VFR(2),o[0],0,0,0), C1,0); \
    KRD(GL,3); GAPB(o[1]=__builtin_amdgcn_mfma_f32_32x32x16_bf16(PAF(2),VFR(6),o[1],0,0,0), C1,4); \
    GAPB(o[0]=__builtin_amdgcn_mfma_f32_32x32x16_bf16(PAF(3),VFR(3),o[0],0,0,0), C1,8); \
    GAPB(o[1]=__builtin_amdgcn_mfma_f32_32x32x16_bf16(PAF(3),VFR(7),o[1],0,0,0), C1,12); \
    }while(0)
  int t=1;
  if(MODE==0) for(;t+7<NT;t+=4){
    STEP(pB0,pB1,pA0,pA1,t,true,true,true,true);      WAIT_BAR(2); RESC(); ROT();
    STEP(pA0,pA1,pB0,pB1,t+1,true,true,true,false);   WAIT_BAR(2); RESC(); ROT();
    STEP(pB0,pB1,pA0,pA1,t+2,true,true,true,false);   WAIT_BAR(2); RESC(); ROT();
    STEP(pA0,pA1,pB0,pB1,t+3,true,true,true,false);   WAIT_BAR(2); RESC(); ROT();
  }
  if(MODE==0) for(;t+5<NT;t+=2){
    STEP(pB0,pB1,pA0,pA1,t,true,true,true,true);     WAIT_BAR(2); RESC(); ROT();
    STEP(pA0,pA1,pB0,pB1,t+1,true,true,true,false);   WAIT_BAR(2); RESC(); ROT();
  }
  #define ENDW(tt) do{ if((tt)+3<NT){WAIT_BAR(2);} else if((tt)+2<NT){WAIT_BAR(1);} else {WAIT_BAR(0);} }while(0)
  for(;t+1<NT;t+=2){
    STEP(pB0,pB1,pA0,pA1,t,(t+3<NT),(t+1<NT),(t+1<NT),true);       ENDW(t);   RESC(); ROT();
    STEP(pA0,pA1,pB0,pB1,t+1,(t+4<NT),(t+2<NT),(t+2<NT),true);     ENDW(t+1); RESC(); ROT();
  }
  STEP(pB0,pB1,pA0,pA1,NT-1,false,false,false,true); RESC();
  { float sacc=pB0[0]+pB0[1]; _Pragma("unroll") for(int r=2;r<16;++r)sacc+=pB0[r]; _Pragma("unroll") for(int r=0;r<16;++r)sacc+=pB1[r]; l_reg+=sacc;
    pw0=(u32x4){PKW(pB0,0),PKW(pB0,2),PKW(pB0,4),PKW(pB0,6)};pw1=(u32x4){PKW(pB0,8),PKW(pB0,10),PKW(pB0,12),PKW(pB0,14)};pw2=(u32x4){PKW(pB1,0),PKW(pB1,2),PKW(pB1,4),PKW(pB1,6)};pw3=(u32x4){PKW(pB1,8),PKW(pB1,10),PKW(pB1,12),PKW(pB1,14)};
    SBAR(); pv(o,vb0+sl_cur,PAF(0),PAF(1),PAF(2),PAF(3)); }
  #undef PKW
  #undef PAF
  #undef VFR
  #undef PIN
  #undef MX3
  #undef GAPA
  #undef GAPB
  #undef EX
  #undef VRD
  #undef KRD
  #undef STEP
  #undef ENDW
  {auto rr=__builtin_amdgcn_permlane32_swap(__float_as_uint(l_reg),__float_as_uint(l_reg),false,false);l_reg=__uint_as_float(rr[0])+__uint_as_float(rr[1]);}
  if(MODE==1){ l_reg+=__builtin_amdgcn_exp2f(sinkl2-mhat); }
  if(hi==0)wsf[32+r32]=l_reg;asm volatile("s_waitcnt lgkmcnt(0)":::"memory");
  float rli[16];
  #pragma unroll
  for(int r=0;r<16;++r)rli[r]=__builtin_amdgcn_rcpf(wsf[32+crow(r,hi)]);
  bf16*Ow=YB+(long)(qrow0+wid*QBLK)*YP+ocol; const bf16*Zw=Pm+(long)(qrow0+wid*QBLK)*PP+zcol;
  { bf16*stg=(bf16*)(shm+LDS_OST)+wid*2048;
    #pragma unroll
    for(int r=0;r<16;++r){const int orow=crow(r,hi);
      #pragma unroll
      for(int d0=0;d0<2;++d0)stg[orow*64+d0*32+r32]=__float2bfloat16(o[d0][r]*rli[r]);}
    asm volatile("s_waitcnt lgkmcnt(0)":::"memory");
    #pragma unroll
    for(int i=0;i<4;++i){const int row=i*8+(lane>>3),ch=lane&7; const u32x4 v=*(const u32x4*)(stg+row*64+ch*8); const u32x4 z=*(const u32x4*)(Zw+(long)row*PP+ch*8); u32x4 w;
      #define GATE2(vv,zz) cvtpk_s(__uint_as_float((vv)<<16)*siluf_(__uint_as_float((zz)<<16)),__uint_as_float((vv)&0xffff0000u)*siluf_(__uint_as_float((zz)&0xffff0000u)))
      w.x=GATE2(v.x,z.x); w.y=GATE2(v.y,z.y); w.z=GATE2(v.z,z.z); w.w=GATE2(v.w,z.w);
      #undef GATE2
      *(u32x4*)(Ow+(long)row*YP+ch*8)=w;} }
  asm volatile("s_waitcnt lgkmcnt(0)\n\ts_barrier":::"memory");
  #undef DMA_K
  #undef DMA_V
  #undef CMASK
  #undef START
  #undef RESC
  #undef ROT
  #undef TROW
}
#undef SBAR
#undef WAIT_BAR
}

constexpr int NWAVES = 8;
constexpr int DM = 1024, SEQ = 8192, NCTX = 256, NB = 2;
constexpr int M_LAT = NB * SEQ, M_CTX = NB * NCTX, M_ALL = M_LAT + M_CTX;
constexpr int PW = 2816;
constexpr float RMS_EPS = 1e-6f;
#ifndef WPITCH
#define WPITCH 1024
#endif
constexpr float QSCALE = 0.125f * 1.4426950408889634f;
constexpr int C_AQ = 0, C_AK = 256, C_AV = 384, C_AZ = 512, C_DQ = 768, C_DK = 1024, C_DV = 1152, C_DZ = 1280, C_BF = 1536, C_BZ = 1792, C_CU = 2048, C_CV = 2304, C_CZ = 2560;

constexpr size_t MiB = 1u << 20;
constexpr size_t WS_CTL = 0, CTL_ZERO_BYTES = 1 * MiB;
constexpr size_t WS_MOD = 1 * MiB;
constexpr size_t WS_TAB = 2 * MiB;
constexpr size_t TAB_MA = 0, TAB_128 = 131072, TAB_64 = 229376, TAB_256 = 245760, TAB_WSP = 507904, TAB_ONES = 786432, TAB_BIASB = 1048576;
constexpr size_t WS_WIN = 4 * MiB, WS_WM = 16 * MiB, WS_WBR = 32 * MiB, WS_WOUT = 36 * MiB;
constexpr size_t WS_XC1 = 40 * MiB;
constexpr size_t WS_H = 42 * MiB, WS_YB = 75 * MiB, WS_T1 = 108 * MiB, WS_P = 124 * MiB;
constexpr size_t WS_GT = WS_P, WS_MG = WS_P + 40 * MiB;
constexpr size_t WS_MGC = 216 * MiB;
constexpr size_t WS_GTC = 218 * MiB;
constexpr size_t WS_GT2 = 222 * MiB;
constexpr size_t WS_END = 254 * MiB;
constexpr int CW_BAR = 4096;

constexpr int RING_BYTES = 147456, LDSCTL_OFF = RING_BYTES, MISC_OFF = LDSCTL_OFF + 320, LDS_BYTES = RING_BYTES + 1024;

#define GAS __attribute__((address_space(1)))
#define LAS __attribute__((address_space(3)))
typedef unsigned short bf16;
typedef unsigned v4u __attribute__((ext_vector_type(4)));
typedef unsigned v2u __attribute__((ext_vector_type(2)));
typedef float f32x4 __attribute__((ext_vector_type(4)));
typedef float f32x16 __attribute__((ext_vector_type(16)));
typedef short bf16x8 __attribute__((ext_vector_type(8)));
typedef GAS unsigned gu32;
#define RLX_AGENT __ATOMIC_RELAXED, __HIP_MEMORY_SCOPE_AGENT
#define LDS_WAIT() asm volatile("s_waitcnt lgkmcnt(0)" ::: "memory")
#define MFMA32(a, b, c) __builtin_amdgcn_mfma_f32_32x32x16_bf16((a), (b), (c), 0, 0, 0)
#define DI __device__ __forceinline__
DI unsigned f2bf(float f) { unsigned u = __builtin_bit_cast(unsigned, f); return (u + 0x7fffu + ((u >> 16) & 1u)) >> 16; }
DI unsigned pk2(float lo, float hi) { return f2bf(lo) | (f2bf(hi) << 16); }
DI float bf2f(bf16 v) { return __uint_as_float((unsigned)v << 16); }
DI float wlo(unsigned w) { return __uint_as_float(w << 16); }
DI float whi(unsigned w) { return __uint_as_float(w & 0xffff0000u); }
DI int crow(int reg, int h) { return (reg & 3) + 8 * (reg >> 2) + 4 * h; }
DI int krow(int s, int h, int j) { return 16 * s + 8 * (j >> 2) + 4 * h + (j & 3); }
DI float siluf(float x) { return x * __builtin_amdgcn_rcpf(1.0f + __builtin_amdgcn_exp2f(-1.4426950408889634f * x)); }
DI float geluf(float v) {
    const float av = __builtin_fabsf(v), d = av * 0.2316418882f + 1.0f, t = __builtin_amdgcn_rcpf(d);
    float q = t * 0.5307027145f + (-0.7265760135f); q = q * t + 0.7107068705f; q = q * t + (-0.142248368f); q = q * t + 0.127414796f; q = q * t;
    const float e = __builtin_amdgcn_exp2f((v * v) * (-0.72134752044f)), m = v * (q * e), r = v - m;
    return v < 0.f ? m : r;
}
typedef float f32x2_t __attribute__((ext_vector_type(2))); typedef __bf16 bf16x2_t __attribute__((ext_vector_type(2)));
DI unsigned cvtpk(float lo, float hi) { f32x2_t v = {lo, hi}; bf16x2_t b = __builtin_convertvector(v, bf16x2_t); return __builtin_bit_cast(unsigned, b); }
DI bf16x8 pack_step(const f32x16& x, int s) {
    v4u p; p.x = cvtpk(x[8 * s], x[8 * s + 1]); p.y = cvtpk(x[8 * s + 2], x[8 * s + 3]); p.z = cvtpk(x[8 * s + 4], x[8 * s + 5]); p.w = cvtpk(x[8 * s + 6], x[8 * s + 7]);
    return __builtin_bit_cast(bf16x8, p);
}
DI float shx(float v, int o, int lane) { return __int_as_float(__builtin_amdgcn_ds_bpermute((lane ^ o) << 2, __float_as_int(v))); }
DI float wave_sum(float v, int lane) {
#pragma unroll
    for (int o = 1; o < 64; o <<= 1) v += shx(v, o, lane);
    return v;
}

#define XB_TMO      128
#define XB_XCNT(j)  (256  + 64 * (j))
#define XB_XSUB(j)  (1280 + 64 * (j))
#define XB_XGEN(j)  (2304 + 64 * (j))
#define XB_TOP      3328
#define XB_TOPGEN   3392
#define XCD_BAR_WORDS 3456
#define XB_SPIN_CAP (1u << 22)
DI unsigned xb_ld(unsigned* p)              { return __hip_atomic_load(p, __ATOMIC_RELAXED, __HIP_MEMORY_SCOPE_AGENT); }
DI unsigned xb_add(unsigned* p, unsigned v) { return __hip_atomic_fetch_add(p, v, __ATOMIC_RELAXED, __HIP_MEMORY_SCOPE_AGENT); }
DI unsigned xb_xcc_id() { return (unsigned)__builtin_amdgcn_s_getreg((3 << 11) | 20) & 0xFu; }
#define XB_SPIN(cond, bar) do { unsigned _sp = 0; while (cond) { __builtin_amdgcn_s_sleep(1); \
    if ((++_sp & 255u) == 0u) { if (xb_ld(&(bar)[XB_TMO])) break; if (_sp > XB_SPIN_CAP) { atomicAdd(&(bar)[XB_TMO], 1u); break; } } } } while (0)
struct XcdBarrier { unsigned* bar; unsigned x; volatile LAS unsigned* st; };
DI XcdBarrier xcd_barrier_post(unsigned* bar, volatile LAS unsigned* st) {
    XcdBarrier b; b.bar = bar; b.x = xb_xcc_id(); b.st = st;
    if (threadIdx.x == 0) (void)xb_add(&bar[XB_XCNT(b.x)], 1u);
    return b;
}
DI void xcd_barrier_complete(unsigned* bar, unsigned x, unsigned& nloc, unsigned& nx) {
    const unsigned G = gridDim.x * gridDim.y * gridDim.z;
    unsigned sum, cnt, mine, sp = 0u;
    for (;;) {
        sum = 0u; cnt = 0u; mine = 0u;
#pragma unroll
        for (unsigned j = 0; j < 16; ++j) { const unsigned c = xb_ld(&bar[XB_XCNT(j)]); sum += c; cnt += (c > 0u) ? 1u : 0u; mine = (j == x) ? c : mine; }
        if (sum == G) break;
        __builtin_amdgcn_s_sleep(1);
        if ((++sp & 255u) == 0u) { if (xb_ld(&bar[XB_TMO])) break; if (sp > XB_SPIN_CAP) { atomicAdd(&bar[XB_TMO], 1u); break; } }
    }
    nloc = mine > 0u ? mine : 1u; nx = cnt > 0u ? cnt : 1u;
}
DI void xcd_barrier(const XcdBarrier& b) {
    asm volatile("s_waitcnt vmcnt(0)" ::: "memory");
    __syncthreads();
    if (threadIdx.x == 0) {
        unsigned* bar = b.bar;
        __builtin_amdgcn_s_waitcnt(0);
        __builtin_amdgcn_fence(__ATOMIC_ACQUIRE, "agent");
        unsigned nloc = b.st[0], nx = b.st[1];
        if (nloc == 0u) { xcd_barrier_complete(bar, b.x, nloc, nx); b.st[0] = nloc; b.st[1] = nx; }
        const unsigned old = xb_add(&bar[XB_XSUB(b.x)], 1u);
        const unsigned gen = old / nloc;
        if (old + 1u == (gen + 1u) * nloc) {
            __builtin_amdgcn_fence(__ATOMIC_RELEASE, "agent");
            asm volatile("s_waitcnt vmcnt(0)" ::: "memory");
            const unsigned og = xb_add(&bar[XB_TOP], 1u);
            const unsigned tg = og / nx;
            if (og + 1u == (tg + 1u) * nx) xb_add(&bar[XB_TOPGEN], 1u);
            else XB_SPIN(xb_ld(&bar[XB_TOPGEN]) == tg, bar);
            xb_add(&bar[XB_XGEN(b.x)], 1u);
            asm volatile("s_waitcnt vmcnt(0)" ::: "memory");
        } else {
            XB_SPIN(xb_ld(&bar[XB_XGEN(b.x)]) == gen, bar);
            asm volatile("s_waitcnt vmcnt(0)" ::: "memory");
        }
    }
    __syncthreads();
}

struct Frame {
    LAS unsigned char* lds;
    int tid, lane, wave, vcu, G;
};

DI void p0_transpose_item(const float* W, int N, bf16* WT, int ldt, int row_off, int col_off, LAS float* scr, int item, int lane) {
    const int nblk = N / 32, kb = item / nblk, nb = item % nblk, k0 = 64 * kb, n0 = 32 * nb;
#pragma unroll 8
    for (int i = 0; i < 32; ++i) { const int kk = 2 * i + (lane >> 5); scr[kk * 33 + (lane & 31)] = W[(size_t)(k0 + kk) * N + n0 + (lane & 31)]; }
    LDS_WAIT(); asm volatile("" ::: "memory");
    const int c = lane & 7;
#pragma unroll
    for (int j = 0; j < 4; ++j) { const int n = (lane >> 3) + 8 * j; const LAS float* s = scr + (8 * c) * 33 + n;
        v4u o; o.x = pk2(s[0 * 33], s[1 * 33]); o.y = pk2(s[2 * 33], s[3 * 33]); o.z = pk2(s[4 * 33], s[5 * 33]); o.w = pk2(s[6 * 33], s[7 * 33]);
        *(GAS v4u*)(WT + (size_t)(row_off + n0 + n) * ldt + col_off + k0 + 8 * c) = o; }
    LDS_WAIT(); asm volatile("" ::: "memory");
}

struct Args { const float* in[20]; float* out; unsigned char* ws; };
enum { I_X = 0, I_C, I_CTX, I_CCTX, I_NORMW, I_WADA, I_BADA, I_WIN, I_QNA, I_KNA, I_QND, I_KND, I_SINK, I_WFNET, I_WSP, I_BSP, I_WBR, I_WMERGE, I_BMERGE, I_WOUT };

DI void p0_weights(const Frame& F, const Args& a, int l, int widx, int nworkers) {
    unsigned char* ws = a.ws;
    LAS float* scr = (LAS float*)(F.lds + F.wave * 16384);
    const int gw = widx * NWAVES + F.wave, NGW = nworkers * NWAVES;
    constexpr int I_IN = 16 * 88, I_M = 16 * 128, I_O = 16 * 32, I_B = 4 * 32, PER_L = I_IN + I_M + I_O + 4 * I_B;
    for (int it = gw; it < PER_L; it += NGW) {
        int r = it;
        if (r < I_IN) { p0_transpose_item(a.in[I_WIN] + (size_t)l * 1024 * PW, PW, (bf16*)(ws + WS_WIN) + (size_t)l * PW * WPITCH, WPITCH, 0, 0, scr, r, F.lane); continue; } r -= I_IN;
        if (r < I_M) { p0_transpose_item(a.in[I_WMERGE] + (size_t)l * 1024 * 4096, 4096, (bf16*)(ws + WS_WM) + (size_t)l * 4096 * 1024, 1024, 0, 0, scr, r, F.lane); continue; } r -= I_M;
        if (r < I_O) { p0_transpose_item(a.in[I_WOUT] + (size_t)l * 1024 * 1024, 1024, (bf16*)(ws + WS_WOUT) + (size_t)l * 1024 * 1024, 1024, 0, 0, scr, r, F.lane); continue; } r -= I_O;
        { const int br = r / I_B; r -= br * I_B;
          p0_transpose_item(a.in[I_WBR] + ((size_t)l * 4 + br) * 256 * 1024, 1024, (bf16*)(ws + WS_WBR) + (size_t)l * 1024 * 1024, 1024, 0, 256 * br, scr, r, F.lane); }
    }
}
DI void p0_prologue(const Frame& F, const Args& a) {
    unsigned char* ws = a.ws;
    for (int u = F.vcu; u < 96; u += F.G) {
        const int l = u / 48, j0 = 64 * (u % 48);
        LAS float* sl = (LAS float*)F.lds; LAS float* red = sl + 3072;
        for (int i = F.tid; i < 3072; i += 512) { const int v = i >> 10, k = i & 1023; const float cv = (v < 2) ? a.in[I_C][v * 1024 + k] : a.in[I_CCTX][k]; sl[i] = siluf(cv); }
        __syncthreads();
        float a0 = 0.f, a1 = 0.f, a2 = 0.f;
        const float* wp = a.in[I_WADA] + (size_t)l * 1024 * 3072 + (size_t)(128 * F.wave) * 3072 + j0 + F.lane;
#pragma unroll 32
        for (int kk = 0; kk < 128; ++kk) { const float w = wp[(size_t)kk * 3072]; const int k = 128 * F.wave + kk; a0 += sl[k] * w; a1 += sl[1024 + k] * w; a2 += sl[2048 + k] * w; }
        red[(F.wave * 3 + 0) * 64 + F.lane] = a0; red[(F.wave * 3 + 1) * 64 + F.lane] = a1; red[(F.wave * 3 + 2) * 64 + F.lane] = a2;
        __syncthreads();
        if (F.tid < 192) { const int v = F.tid >> 6, jj = F.tid & 63; float s = a.in[I_BADA][l * 3072 + j0 + jj];
#pragma unroll
            for (int w = 0; w < 8; ++w) s += red[(w * 3 + v) * 64 + jj];
            ((float*)(ws + WS_MOD))[(l * 3 + v) * 3072 + j0 + jj] = s; }
        __syncthreads();
    }
    p0_weights(F, a, 0, F.vcu, F.G);
    {
        const int gt = F.vcu * 512 + F.tid, NGT = F.G * 512;
        bf16* tab = (bf16*)(ws + WS_TAB);
        for (int e = gt; e < 65536; e += NGT) {
            const int l = e >> 15, g = (e >> 13) & 3, col = (e >> 6) & 127, c = e & 63, d = col & 63;
            const float* wf = a.in[I_WFNET] + ((size_t)(l * 4 + g) * 64) * 64 + d; float s = 0.f;
            for (int j = 0; j < 64; ++j) { const float rev = (float)((c * j) & 63) * (1.0f / 64.0f); const float tw = (col < 64) ? __builtin_amdgcn_cosf(rev) : -__builtin_amdgcn_sinf(rev); s += tw * wf[j * 64]; }
            tab[TAB_MA / 2 + e] = (bf16)f2bf(s);
        }
        for (int e = gt; e < 49152; e += NGT) {
            const int mat = e / 16384, rem = e % 16384, k1b = rem >> 12, nb = (rem >> 10) & 3, s = (rem >> 9) & 1, ln = (rem >> 3) & 63, j = rem & 7;
            const int n1 = 32 * nb + krow(s, ln >> 5, j), k1 = 32 * k1b + (ln & 31); const float rev = (float)((n1 * k1) & 127) * (1.0f / 128.0f);
            const float v = (mat == 0) ? __builtin_amdgcn_cosf(rev) : (mat == 1) ? __builtin_amdgcn_sinf(rev) : -__builtin_amdgcn_sinf(rev);
            tab[TAB_128 / 2 + e] = (bf16)f2bf(v);
        }
        for (int e = gt; e < 8192; e += NGT) {
            const int mat = e >> 12, k2 = (e >> 6) & 63, n2 = e & 63; const float rev = (float)((k2 * n2) & 63) * (1.0f / 64.0f);
            tab[TAB_64 / 2 + e] = (bf16)f2bf(mat == 0 ? __builtin_amdgcn_cosf(rev) : __builtin_amdgcn_sinf(rev));
        }
        for (int e = gt; e < 131072; e += NGT) {
            const int mat = e >> 16, rem = e & 65535, kb = rem >> 13, nb = (rem >> 10) & 7, s = (rem >> 9) & 1, ln = (rem >> 3) & 63, j = rem & 7;
            const int n = 32 * nb + krow(s, ln >> 5, j), k = 32 * kb + (ln & 31); const float rev = (float)((n * k) & 255) * (1.0f / 256.0f);
            tab[TAB_256 / 2 + e] = (bf16)f2bf(mat == 0 ? __builtin_amdgcn_cosf(rev) : __builtin_amdgcn_sinf(rev));
        }
        for (int e = gt; e < 131072; e += NGT) tab[TAB_WSP / 2 + e] = (bf16)f2bf(a.in[I_WSP][e]);
        for (int e = gt; e < 4096; e += NGT) tab[TAB_ONES / 2 + e] = (bf16)(((e & 31) == 0) ? 0x3f80 : 0);
        for (int e = gt; e < 262144; e += NGT) tab[TAB_BIASB / 2 + e] = (bf16)(((e & 31) == 0) ? f2bf(a.in[I_BMERGE][e >> 5]) : 0u);
    }
}

DI void p1_modrms(const Frame& F, const Args& a, int l, const float* xlat, const float* xctx, int with_ctx) {
    const float* part = (l == 1) ? (const float*)(a.ws + WS_GT2) : nullptr;
    const float* mod = (const float*)(a.ws + WS_MOD) + (size_t)l * 3 * 3072;
    const float* nw = a.in[I_NORMW] + l * 1024;
    bf16* H = (bf16*)(a.ws + WS_H);
    const int gw = F.vcu * NWAVES + F.wave, NGW = F.G * NWAVES;
    const int nrows = with_ctx ? M_ALL : M_LAT;
    int vcur = -1; f32x4 av[4], bv[4];
    for (int row = gw; row < nrows; row += 2 * NGW) {
        const int row2 = row + NGW; const bool has2 = row2 < nrows;
        const float* xr = (row < M_LAT) ? xlat + (size_t)row * 1024 : xctx + (size_t)(row - M_LAT) * 1024;
        const float* xr2 = !has2 ? xr : (row2 < M_LAT) ? xlat + (size_t)row2 * 1024 : xctx + (size_t)(row2 - M_LAT) * 1024;
        f32x4 x[4], y[4]; float ss = 0.f, ss2 = 0.f;
#pragma unroll
        for (int j = 0; j < 4; ++j) { x[j] = *(const f32x4*)(xr + 4 * (F.lane + 64 * j)); y[j] = *(const f32x4*)(xr2 + 4 * (F.lane + 64 * j)); }
        if (part != nullptr) {
            if (row >= M_LAT) { const float* pp = part + (size_t)(row - M_LAT) * 1024;
#pragma unroll 4
                for (int q = 0; q < 16; ++q)
#pragma unroll
                    for (int j = 0; j < 4; ++j) x[j] += *(const f32x4*)(pp + (size_t)q * 512 * 1024 + 4 * (F.lane + 64 * j)); }
            if (has2 && row2 >= M_LAT) { const float* pp = part + (size_t)(row2 - M_LAT) * 1024;
#pragma unroll 4
                for (int q = 0; q < 16; ++q)
#pragma unroll
                    for (int j = 0; j < 4; ++j) y[j] += *(const f32x4*)(pp + (size_t)q * 512 * 1024 + 4 * (F.lane + 64 * j)); }
        }
#pragma unroll
        for (int j = 0; j < 4; ++j) { ss += (x[j].x * x[j].x + x[j].y * x[j].y) + (x[j].z * x[j].z + x[j].w * x[j].w); ss2 += (y[j].x * y[j].x + y[j].y * y[j].y) + (y[j].z * y[j].z + y[j].w * y[j].w); }
#pragma unroll
        for (int o = 1; o < 64; o <<= 1) { ss += shx(ss, o, F.lane); ss2 += shx(ss2, o, F.lane); }
#pragma unroll
        for (int k = 0; k < 2; ++k) { const int r_ = k ? row2 : row; if (k && !has2) break;
            const int v = r_ < SEQ ? 0 : (r_ < M_LAT ? 1 : 2);
            if (v != vcur) { vcur = v;
#pragma unroll
                for (int j = 0; j < 4; ++j) { const int c = 4 * (F.lane + 64 * j); const f32x4 w = *(const f32x4*)(nw + c), sc = *(const f32x4*)(mod + v * 3072 + 1024 + c);
                    av[j] = w * (sc + 1.0f); bv[j] = *(const f32x4*)(mod + v * 3072 + c); } }
            const float rstd = __builtin_amdgcn_rsqf((k ? ss2 : ss) * (1.0f / 1024.0f) + RMS_EPS);
#pragma unroll
            for (int j = 0; j < 4; ++j) { const f32x4 h = (k ? y[j] : x[j]) * rstd * av[j] + bv[j]; v2u o; o.x = pk2(h.x, h.y); o.y = pk2(h.z, h.w);
                *(v2u*)(H + (size_t)r_ * 1024 + 4 * (F.lane + 64 * j)) = o; } }
    }
}

DI void p3_prep(const Frame& F, const Args& a, int l, bf16* P) {
    const int gw = F.vcu * NWAVES + F.wave, NGW = F.G * NWAVES;
    const int lane = F.lane, d0 = 4 * (lane & 15);
    f32x4 wk, inv;
#pragma unroll
    for (int e = 0; e < 4; ++e) { wk[e] = (lane < 32 ? a.in[I_KNA] : a.in[I_KND])[l * 64 + d0 + e];
        inv[e] = __builtin_amdgcn_exp2f(-(float)((d0 + e) & 15) * (13.287712379549449f / 16.0f)) * 0.15915494309189535f; }
    const float sgn = (d0 & 16) ? 1.0f : -1.0f;
    const int colk = (lane < 32) ? C_AK + 4 * lane : C_DK + 4 * (lane - 32);
    for (int row = gw; row < M_ALL; row += 2 * NGW) {
        const int row2 = row + NGW; const bool has2 = row2 < M_ALL;
        bf16* pr = P + (size_t)row * PW + colk; bf16* pr2 = P + (size_t)(has2 ? row2 : row) * PW + colk;
        const v2u raw = *(const v2u*)pr, raw2 = *(const v2u*)pr2;
#pragma unroll
        for (int k = 0; k < 2; ++k) { if (k && !has2) break;
            const int r_ = k ? row2 : row; const bool isctx = r_ >= M_LAT; const int n = r_ & (SEQ - 1);
            f32x4 cs = (f32x4){1.f, 1.f, 1.f, 1.f}, sn = (f32x4){0.f, 0.f, 0.f, 0.f};
            if (!isctx) { const float pos = (float)((d0 < 32) ? (n >> 6) : (n & 63));
#pragma unroll
                for (int e = 0; e < 4; ++e) { const float rev = pos * inv[e]; cs[e] = __builtin_amdgcn_cosf(rev); sn[e] = __builtin_amdgcn_sinf(rev); } }
            const v2u rw = k ? raw2 : raw;
            f32x4 v = (f32x4){wlo(rw.x), whi(rw.x), wlo(rw.y), whi(rw.y)};
            float ss = (v[0] * v[0] + v[1] * v[1]) + (v[2] * v[2] + v[3] * v[3]);
            ss += shx(ss, 1, lane); ss += shx(ss, 2, lane); ss += shx(ss, 4, lane); ss += shx(ss, 8, lane);
            v = v * __builtin_amdgcn_rsqf(ss * (1.0f / 64.0f) + RMS_EPS) * wk;
            f32x4 pt;
#pragma unroll
            for (int e = 0; e < 4; ++e) pt[e] = shx(v[e], 4, lane);
            v = v * cs + pt * sn * sgn;
            v2u o; o.x = pk2(v[0], v[1]); o.y = pk2(v[2], v[3]);
            *(v2u*)(k ? pr2 : pr) = o; }
    }
}

DI void fnet_stepA(const bf16* xrow, const bf16* MAt, int r32, int hi, bf16x8 (&gs)[4][2]) {
    bf16x8 xa[4];
#pragma unroll
    for (int s4 = 0; s4 < 4; ++s4) xa[s4] = *(const bf16x8*)(xrow + 16 * s4 + 8 * hi);
#pragma unroll
    for (int cb = 0; cb < 4; ++cb) { f32x16 acc = f32x16{};
#pragma unroll
        for (int s4 = 0; s4 < 4; ++s4) { const bf16x8 bfr = *(const bf16x8*)(MAt + (32 * cb + r32) * 64 + 16 * s4 + 8 * hi); acc = MFMA32(xa[s4], bfr, acc); }
        gs[cb][0] = pack_step(acc, 0); gs[cb][1] = pack_step(acc, 1); }
}

DI void fnet_s1_unit(const Frame& F, const Args& a, int l, int u, const bf16* P) {
    const int b = u >> 7, n2grp = (u >> 4) & 7, g = (u >> 2) & 3, k1b = u & 3;
    const int lane = F.lane, r32 = lane & 31, hi = lane >> 5, w = F.wave, n2 = 8 * n2grp + w;
    const bf16* tab = (const bf16*)(a.ws + WS_TAB);
    const bf16* MAt = tab + TAB_MA / 2 + (size_t)(l * 4 + g) * 128 * 64;
    const bf16* T128 = tab + TAB_128 / 2;
    f32x16 Tr[2], Ti[2];
#pragma unroll
    for (int j = 0; j < 2; ++j) { Tr[j] = f32x16{}; Ti[j] = f32x16{}; }
#pragma unroll 1
    for (int nb = 0; nb < 4; ++nb) {
        const bf16* xrow = P + (size_t)(SEQ * b + 64 * (32 * nb + r32) + n2) * PW + C_BF + 64 * g;
        bf16x8 gs[4][2]; fnet_stepA(xrow, MAt, r32, hi, gs);
#pragma unroll
        for (int s = 0; s < 2; ++s) {
            const size_t fo = ((size_t)((k1b * 4 + nb) * 2 + s) * 64 + lane) * 8;
            const bf16x8 ca = *(const bf16x8*)(T128 + fo), sa = *(const bf16x8*)(T128 + 16384 + fo), na = *(const bf16x8*)(T128 + 32768 + fo);
            Tr[0] = MFMA32(ca, gs[0][s], Tr[0]); Tr[0] = MFMA32(sa, gs[2][s], Tr[0]);
            Tr[1] = MFMA32(ca, gs[1][s], Tr[1]); Tr[1] = MFMA32(sa, gs[3][s], Tr[1]);
            Ti[0] = MFMA32(ca, gs[2][s], Ti[0]); Ti[0] = MFMA32(na, gs[0][s], Ti[0]);
            Ti[1] = MFMA32(ca, gs[3][s], Ti[1]); Ti[1] = MFMA32(na, gs[1][s], Ti[1]); }
    }
    LAS bf16* tl = (LAS bf16*)F.lds;
#pragma unroll
    for (int i = 0; i < 16; ++i) { const int k1l = crow(i, hi), k1 = 32 * k1b + k1l;
        const float rev = (float)((n2 * k1) & 8191) * (1.0f / 8192.0f); const float c = __builtin_amdgcn_cosf(rev), s = __builtin_amdgcn_sinf(rev);
#pragma unroll
        for (int jb = 0; jb < 2; ++jb) { const float tr = Tr[jb][i], ti = Ti[jb][i];
            tl[(k1l * 128 + 32 * jb + r32) * 8 + w] = (bf16)f2bf(tr * c + ti * s);
            tl[(k1l * 128 + 64 + 32 * jb + r32) * 8 + w] = (bf16)f2bf(ti * c - tr * s); } }
    __syncthreads();
    bf16* T1 = (bf16*)(a.ws + WS_T1);
#pragma unroll 4
    for (int pass = 0; pass < 8; ++pass) { const int q = F.tid + 512 * pass, k1l = q >> 7, colL = q & 127;
        const v4u v = *(const LAS v4u*)(F.lds + (size_t)q * 16);
        *(v4u*)(T1 + ((((size_t)(b * 128 + 32 * k1b + k1l) * 8 + n2grp) * 512) + g * 128 + colL) * 8) = v; }
    __syncthreads();
}

DI void fnet_ctx_unit(const Frame& F, const Args& a, int l, int u, const bf16* P, bf16* YB) {
    const int b = u >> 2, g = u & 3;
    const int lane = F.lane, r32 = lane & 31, hi = lane >> 5, w = F.wave;
    const bf16* tab = (const bf16*)(a.ws + WS_TAB);
    const bf16* MAt = tab + TAB_MA / 2 + (size_t)(l * 4 + g) * 128 * 64;
    const bf16* T256 = tab + TAB_256 / 2;
    LAS bf16x8* sh = (LAS bf16x8*)F.lds;
    { const bf16* xrow = P + (size_t)(M_LAT + NCTX * b + 32 * w + r32) * PW + C_BF + 64 * g;
      bf16x8 gs[4][2]; fnet_stepA(xrow, MAt, r32, hi, gs);
#pragma unroll
      for (int cb = 0; cb < 4; ++cb)
#pragma unroll
          for (int s = 0; s < 2; ++s) sh[((w * 4 + cb) * 2 + s) * 64 + lane] = gs[cb][s]; }
    __syncthreads();
    f32x16 Y[2]; Y[0] = f32x16{}; Y[1] = f32x16{};
#pragma unroll 2
    for (int nb = 0; nb < 8; ++nb) {
#pragma unroll
        for (int s = 0; s < 2; ++s) {
            const size_t fo = ((size_t)((w * 8 + nb) * 2 + s) * 64 + lane) * 8;
            const bf16x8 ca = *(const bf16x8*)(T256 + fo), sa = *(const bf16x8*)(T256 + 65536 + fo);
            const bf16x8 gr0 = sh[((nb * 4 + 0) * 2 + s) * 64 + lane], gr1 = sh[((nb * 4 + 1) * 2 + s) * 64 + lane], gi0 = sh[((nb * 4 + 2) * 2 + s) * 64 + lane], gi1 = sh[((nb * 4 + 3) * 2 + s) * 64 + lane];
            Y[0] = MFMA32(ca, gr0, Y[0]); Y[0] = MFMA32(sa, gi0, Y[0]);
            Y[1] = MFMA32(ca, gr1, Y[1]); Y[1] = MFMA32(sa, gi1, Y[1]); }
    }
#pragma unroll
    for (int jb = 0; jb < 2; ++jb)
#pragma unroll
        for (int i = 0; i < 16; ++i) { const int k = 32 * w + crow(i, hi), d = 32 * jb + r32; const size_t row = (size_t)(M_LAT + NCTX * b + k);
            const float z = bf2f(P[row * PW + C_BZ + 64 * g + d]);
            YB[row * 1024 + 512 + 64 * g + d] = (bf16)f2bf(Y[jb][i] * (1.0f / 128.0f) * siluf(z)); }
    __syncthreads();
}

#ifndef B_SCALE
#define B_SCALE 1.0f
#endif
#ifndef C_SCALE
#define C_SCALE 1.0f
#endif
DI void fnet_s3_unit(const Frame& F, const Args& a, int u, const bf16* P, bf16* YB) {
    const int b = u >> 7, k1 = u & 127;
    const int lane = F.lane, r32 = lane & 31, hi = lane >> 5, g = F.wave >> 1, jb = F.wave & 1;
    const bf16* T64 = (const bf16*)(a.ws + WS_TAB) + TAB_64 / 2;
    const bf16* T1 = (const bf16*)(a.ws + WS_T1);
    f32x16 Y[2]; Y[0] = f32x16{}; Y[1] = f32x16{};
#pragma unroll
    for (int sc = 0; sc < 4; ++sc)
#pragma unroll
        for (int ri = 0; ri < 2; ++ri) {
            const bf16x8 afr = *(const bf16x8*)(T1 + ((((size_t)(b * 128 + k1) * 8 + 2 * sc + hi) * 512) + g * 128 + ri * 64 + 32 * jb + r32) * 8);
#pragma unroll
            for (int k2b = 0; k2b < 2; ++k2b) { const bf16x8 bfr = *(const bf16x8*)(T64 + ri * 4096 + (32 * k2b + r32) * 64 + 16 * sc + 8 * hi); Y[k2b] = MFMA32(afr, bfr, Y[k2b]); } }
#pragma unroll
    for (int k2b = 0; k2b < 2; ++k2b) { const size_t row = (size_t)(SEQ * b + k1 + 128 * (32 * k2b + r32));
#pragma unroll
        for (int q = 0; q < 4; ++q) { const int d0 = 32 * jb + 8 * q + 4 * hi;
            const v2u z = *(const v2u*)(P + row * PW + C_BZ + 64 * g + d0);
            v2u o; o.x = pk2(Y[k2b][4 * q] * (B_SCALE * 0.0013810679320049757f) * siluf(wlo(z.x)), Y[k2b][4 * q + 1] * (B_SCALE * 0.0013810679320049757f) * siluf(whi(z.x)));
            o.y = pk2(Y[k2b][4 * q + 2] * (B_SCALE * 0.0013810679320049757f) * siluf(wlo(z.y)), Y[k2b][4 * q + 3] * (B_SCALE * 0.0013810679320049757f) * siluf(whi(z.y)));
            *(v2u*)(YB + row * 1024 + 512 + 64 * g + d0) = o; } }
}

DI void sgu_unit(const Frame& F, const Args& a, int l, int u, const bf16* P, bf16* YB) {
    constexpr int VP = 136;
    LAS bf16* vt = (LAS bf16*)F.lds;
    const int ci = u >> 2, g = u & 3;
    const size_t row0 = (size_t)ci * 128;
    { const int q = F.tid & 127, cq = F.tid >> 7; const bf16* src = P + (row0 + q) * PW + C_CV + 64 * g + 16 * cq;
#pragma unroll
      for (int i = 0; i < 2; ++i) { const v4u v = *(const v4u*)(src + 8 * i); const unsigned wv[4] = {v.x, v.y, v.z, v.w};
#pragma unroll
          for (int e = 0; e < 4; ++e) { vt[(16 * cq + 8 * i + 2 * e) * VP + q] = (bf16)f2bf(geluf(wlo(wv[e]))); vt[(16 * cq + 8 * i + 2 * e + 1) * VP + q] = (bf16)f2bf(geluf(whi(wv[e]))); } } }
    __syncthreads();
    const int lane = F.lane, r32 = lane & 31, hi = lane >> 5, pb = F.wave >> 1, cb = F.wave & 1;
    const bf16* Wsp = (const bf16*)(a.ws + WS_TAB) + TAB_WSP / 2 + (size_t)(l * 4 + g) * 128 * 128;
    f32x16 acc = f32x16{};
#pragma unroll
    for (int s = 0; s < 8; ++s) {
        const bf16x8 af = *(const LAS bf16x8*)(vt + (32 * cb + r32) * VP + 16 * s + 8 * hi);
        const bf16x8 bfr = *(const bf16x8*)(Wsp + (32 * pb + r32) * 128 + 16 * s + 8 * hi);
        acc = MFMA32(af, bfr, acc);
    }
    const int p = 32 * pb + r32; const float bb = a.in[I_BSP][(l * 4 + g) * 128 + p]; const bf16* pr = P + (row0 + p) * PW;
#pragma unroll
    for (int q = 0; q < 4; ++q) { const int c0 = 64 * g + 32 * cb + 8 * q + 4 * hi;
        const v2u uu = *(const v2u*)(pr + C_CU + c0), zz = *(const v2u*)(pr + C_CZ + c0);
        v2u o; o.x = pk2(C_SCALE * geluf(wlo(uu.x)) * (acc[4 * q] + bb) * siluf(wlo(zz.x)), C_SCALE * geluf(whi(uu.x)) * (acc[4 * q + 1] + bb) * siluf(whi(zz.x)));
        o.y = pk2(C_SCALE * geluf(wlo(uu.y)) * (acc[4 * q + 2] + bb) * siluf(wlo(zz.y)), C_SCALE * geluf(whi(uu.y)) * (acc[4 * q + 3] + bb) * siluf(whi(zz.y)));
        *(v2u*)(YB + (row0 + p) * 1024 + 768 + c0) = o; }
    __syncthreads();
}

DI void p5_ctx_convert(const Frame& F, const Args& a) {
    const int gt = F.vcu * 512 + F.tid, NGT = F.G * 512;
    const f32x4* src = (const f32x4*)(a.ws + WS_MGC); v2u* dst = (v2u*)((bf16*)(a.ws + WS_MG) + (size_t)M_LAT * 1024);
    for (int e = gt; e < M_CTX * 1024 / 4; e += NGT) { const f32x4 v = src[e]; v2u o; o.x = pk2(v.x, v.y); o.y = pk2(v.z, v.w); dst[e] = o; }
}

#ifdef SELFCHECK
constexpr int CW_CHK = 8192;
DI unsigned hsh(unsigned x) { x *= 2654435761u; x ^= x >> 15; x *= 2246822519u; x ^= x >> 13; x *= 3266489917u; x ^= x >> 16; return x; }
DI void chk_acc(const Args& a, int id, float got, float want) {
    unsigned* w = (unsigned*)(a.ws + WS_CTL) + CW_CHK + 4 * id;
    float d = __builtin_fabsf(got - want); if (!(d == d) || d > 1e15f) d = 1e15f;
    atomicAdd((float*)w, d * d); atomicAdd((float*)(w + 1), want * want); atomicAdd(w + 2, 1u); atomicMax(w + 3, __float_as_uint(d));
}
DI float bfr(float x) { return __uint_as_float(f2bf(x) << 16); }
DI void chk_p0(const Frame& F, const Args& a) {
    const int gt = F.vcu * 512 + F.tid, NGT = F.G * 512;
    for (int s = gt; s < 18432; s += NGT) { const int l = s / 9216, v = (s / 3072) % 3, j = s % 3072; float acc = a.in[I_BADA][l * 3072 + j];
        for (int k = 0; k < 1024; ++k) { const float cv = (v < 2) ? a.in[I_C][v * 1024 + k] : a.in[I_CCTX][k]; acc += siluf(cv) * a.in[I_WADA][((size_t)l * 1024 + k) * 3072 + j]; }
        chk_acc(a, 0, ((const float*)(a.ws + WS_MOD))[(l * 3 + v) * 3072 + j], acc); }
    for (int s = gt; s < 65536; s += NGT) { const unsigned h = hsh(s); const int l = (s >> 2) & 1, m = s & 3, k = h & 1023; const unsigned h2 = hsh(h + 77u);
        float got, want;
        if (m == 0) { const int n = h2 % PW; want = bfr(a.in[I_WIN][((size_t)l * 1024 + k) * PW + n]); got = bf2f(((const bf16*)(a.ws + WS_WIN))[((size_t)l * PW + n) * WPITCH + k]); }
        else if (m == 1) { const int n = h2 & 4095; want = bfr(a.in[I_WMERGE][((size_t)l * 1024 + k) * 4096 + n]); got = bf2f(((const bf16*)(a.ws + WS_WM))[((size_t)l * 4096 + n) * 1024 + k]); }
        else if (m == 2) { const int n = h2 & 1023; want = bfr(a.in[I_WOUT][((size_t)l * 1024 + k) * 1024 + n]); got = bf2f(((const bf16*)(a.ws + WS_WOUT))[((size_t)l * 1024 + n) * 1024 + k]); }
        else { const int n = h2 & 1023, br = k >> 8, kk = k & 255; want = bfr(a.in[I_WBR][(((size_t)l * 4 + br) * 256 + kk) * 1024 + n]); got = bf2f(((const bf16*)(a.ws + WS_WBR))[((size_t)l * 1024 + n) * 1024 + 256 * br + kk]); }
        chk_acc(a, 1, got, want); }
}
DI int sample_row(unsigned h, int l) { const int r = h % M_ALL; (void)l; return ((h >> 20) & 7) == 0 ? M_LAT + (h % M_CTX) : r; }
DI void chk_h(const Frame& F, const Args& a, int l, int id) {
    const float* mod = (const float*)(a.ws + WS_MOD) + (size_t)l * 3 * 3072; const bf16* H = (const bf16*)(a.ws + WS_H);
    const int gw = F.vcu * NWAVES + F.wave, NGW = F.G * NWAVES;
    for (int s = gw; s < M_ALL; s += NGW) { const int row = s; const int v = row < SEQ ? 0 : (row < M_LAT ? 1 : 2);
        const float* xr = (row < M_LAT) ? ((l == 0) ? a.in[I_X] : a.out) + (size_t)row * 1024 : ((l == 0) ? a.in[I_CTX] : (const float*)(a.ws + WS_XC1)) + (size_t)(row - M_LAT) * 1024;
        float ss = 0.f; for (int j = 0; j < 16; ++j) { const float x = xr[F.lane + 64 * j]; ss += x * x; }
        const float rstd = 1.0f / sqrtf(wave_sum(ss, F.lane) * (1.0f / 1024.0f) + RMS_EPS);
        for (int j = 0; j < 16; ++j) { const int c = F.lane + 64 * j; const float want = xr[c] * rstd * a.in[I_NORMW][l * 1024 + c] * (1.0f + mod[v * 3072 + 1024 + c]) + mod[v * 3072 + c];
            chk_acc(a, id, bf2f(H[(size_t)row * 1024 + c]), want); } }
}
DI float dot_h_w(const bf16* hrow, const bf16* wrow, int K) { float acc = 0.f; for (int k = 0; k < K; ++k) acc += bf2f(hrow[k]) * bf2f(wrow[k]); return acc; }
DI void chk_p(const Frame& F, const Args& a, int l, int id) {
    const bf16* H = (const bf16*)(a.ws + WS_H); const bf16* W = (const bf16*)(a.ws + WS_WIN) + (size_t)l * PW * WPITCH; const bf16* P = (const bf16*)(a.ws + WS_P);
    const int gt = F.vcu * 512 + F.tid, NGT = F.G * 512;
    for (int s = gt; s < (1 << 20); s += NGT) { const unsigned h = hsh(s * 5 + 2); const int row = sample_row(h, l); int col = hsh(h + 9u) % PW;
        if (l == 1 && row >= M_LAT) col = ((col & 1) ? 1024 : 256) + (col & 255);
        chk_acc(a, id, bf2f(P[(size_t)row * PW + col]), dot_h_w(H + (size_t)row * 1024, W + (size_t)col * WPITCH, 1024)); }
}
DI void chk_prep(const Frame& F, const Args& a, int l, int id) {
    const bf16* H = (const bf16*)(a.ws + WS_H); const bf16* W = (const bf16*)(a.ws + WS_WIN) + (size_t)l * PW * WPITCH; const bf16* P = (const bf16*)(a.ws + WS_P);
    const int gw = F.vcu * NWAVES + F.wave, NGW = F.G * NWAVES, d = F.lane;
    for (int s = gw; s < 16384; s += NGW) { const unsigned h = hsh(s * 7 + 3); const int row = sample_row(h, l); int sl = (h >> 8) % 12; const bool isctx = row >= M_LAT;
        if (isctx && l == 1) sl = (sl & 1) ? 4 + (sl & 1) : 10 + ((sl >> 1) & 1);
        const int col = (sl < 4) ? C_AQ + 64 * sl : (sl < 6) ? C_AK + 64 * (sl - 4) : (sl < 10) ? C_DQ + 64 * (sl - 6) : C_DK + 64 * (sl - 10);
        const bool isq = (sl < 4) || (sl >= 6 && sl < 10);
        const float raw = bfr(dot_h_w(H + (size_t)row * 1024, W + (size_t)(col + d) * WPITCH, 1024));
        const float wv = ((sl < 4) ? a.in[I_QNA] : (sl < 6) ? a.in[I_KNA] : (sl < 10) ? a.in[I_QND] : a.in[I_KND])[l * 64 + d];
        const float ms = wave_sum(raw * raw, d) * (1.0f / 64.0f);
        float y = raw / sqrtf(ms + RMS_EPS) * wv;
        if (!isctx) { const int n = row & (SEQ - 1); const float pos = (float)((d < 32) ? (n >> 6) : (n & 63)); const float inv = __builtin_amdgcn_exp2f(-(float)(d & 15) * (13.287712379549449f / 16.0f)); const float rev = pos * inv * 0.15915494309189535f; const float cs = __builtin_amdgcn_cosf(rev), sn = __builtin_amdgcn_sinf(rev);
            const float p = shx(y, 16, d); y = (d & 16) ? (p * sn + y * cs) : (y * cs - p * sn); }
        if (isq) y *= QSCALE;
        chk_acc(a, id, bf2f(P[(size_t)row * PW + col + d]), y); }
}
DI void chk_attn(const Frame& F, const Args& a, int l, int id, int mode) {
    const bf16* P = (const bf16*)(a.ws + WS_P); const bf16* YB = (const bf16*)(a.ws + WS_YB);
    LAS float* qs = (LAS float*)F.lds + F.wave * 192; LAS float* os = qs + 64; LAS float* red = qs + 128;
    const int gw = F.vcu * NWAVES + F.wave, NGW = F.G * NWAVES, lane = F.lane;
    const int qc0 = mode ? C_DQ : C_AQ, kc0 = mode ? C_DK : C_AK, vc0 = mode ? C_DV : C_AV, zc0 = mode ? C_DZ : C_AZ, oc0 = mode ? 256 : 0;
    for (int s = gw; s < 8192; s += NGW) { const unsigned hh = hsh(s * 11 + 5 + mode); int row = sample_row(hh, l); if ((s & 7) == 1) row = (hh & 8192) + (hh & 255) + ((hh & 256) ? 7936 : 0); if (l == 1 && row >= M_LAT) row = hh % M_LAT; const int h = (hh >> 9) & 3, kvh = h >> 1; const bool isctx = row >= M_LAT;
        const int b = isctx ? (row - M_LAT) / NCTX : row / SEQ, pos = row & (SEQ - 1);
        qs[lane] = bf2f(P[(size_t)row * PW + qc0 + 64 * h + lane]); LDS_WAIT();
        int klo = 0, khi = -1; if (!isctx) { if (mode == 0) { klo = 0; khi = SEQ - 1; } else { klo = pos - 128 < 0 ? 0 : pos - 128; khi = pos + 128 > SEQ - 1 ? SEQ - 1 : pos + 128; } }
        const int nlat = khi - klo + 1 > 0 ? khi - klo + 1 : 0, nk = NCTX + nlat;
        float m = -1e30f, lsum = 0.f; float acc[64];
#pragma unroll
        for (int dd = 0; dd < 64; ++dd) acc[dd] = 0.f;
        for (int kk = lane; kk < nk; kk += 64) { const size_t kr = (kk < NCTX) ? (size_t)(M_LAT + NCTX * b + kk) : (size_t)(SEQ * b + klo + kk - NCTX);
            const bf16* kp = P + kr * PW + kc0 + 64 * kvh; const bf16* vp = P + kr * PW + vc0 + 64 * kvh; float sc = 0.f;
#pragma unroll
            for (int dd = 0; dd < 64; ++dd) sc += qs[dd] * bf2f(kp[dd]);
            const float mn = fmaxf(m, sc), f = __builtin_amdgcn_exp2f(m - mn), p = __builtin_amdgcn_exp2f(sc - mn); lsum = lsum * f + p; m = mn;
#pragma unroll
            for (int dd = 0; dd < 64; ++dd) acc[dd] = acc[dd] * f + p * bf2f(vp[dd]); }
        float mall = m;
#pragma unroll
        for (int o = 1; o < 64; o <<= 1) mall = fmaxf(mall, shx(mall, o, lane));
        const float f = __builtin_amdgcn_exp2f(m - mall); lsum = wave_sum(lsum * f, lane);
        if (mode == 1) lsum += __builtin_amdgcn_exp2f(a.in[I_SINK][l * 4 + h] * 1.4426950408889634f - mall);
#pragma unroll
        for (int dd = 0; dd < 64; ++dd) { const float t = wave_sum(acc[dd] * f, lane); if (lane == dd) os[dd] = t; }
        LDS_WAIT();
        const float z = bf2f(P[(size_t)row * PW + zc0 + 64 * h + lane]);
        chk_acc(a, id, bf2f(YB[(size_t)row * 1024 + oc0 + 64 * h + lane]), os[lane] / lsum * siluf(z));
        (void)red; }
}
DI void chk_fnet(const Frame& F, const Args& a, int l, int id, int ctxmode) {
    const bf16* P = (const bf16*)(a.ws + WS_P); const bf16* YB = (const bf16*)(a.ws + WS_YB);
    LAS float* ys = (LAS float*)F.lds + F.wave * 64;
    const int gw = F.vcu * NWAVES + F.wave, NGW = F.G * NWAVES, j = F.lane;
    const int N = ctxmode ? NCTX : SEQ;
    for (int s = gw; s < (ctxmode ? 256 : 1024); s += NGW) { const unsigned hh = hsh(s * 13 + 7 + ctxmode); const int b = hh & 1, g = (hh >> 1) & 3; int k = (hh >> 3) % N;
#ifdef FNET_K0
        k = (s & 7) == 0 ? 0 : (s & 7) == 1 ? N / 2 : (s & 7) == 2 ? 64 : (s & 7) == 3 ? 128 : (s & 7) == 4 ? 1 : k;
#endif
        const size_t rbase = ctxmode ? (size_t)(M_LAT + NCTX * b) : (size_t)(SEQ * b);
        float y = 0.f;
        for (int n = 0; n < N; ++n) { const bf16* fr = P + (rbase + n) * PW + C_BF + 64 * g; float A = 0.f, B = 0.f;
            for (int c = 0; c < 64; ++c) { const float fv = bf2f(fr[c]); const float ph = (float)((j * c) & 63) * (1.0f / 64.0f); A += fv * __builtin_amdgcn_cosf(ph); B += fv * __builtin_amdgcn_sinf(ph); }
            const float th = (float)((k * n) & (N - 1)) / (float)N; y += __builtin_amdgcn_cosf(th) * A - __builtin_amdgcn_sinf(th) * B; }
        ys[j] = y / sqrtf((float)N * 64.0f); LDS_WAIT();
        float o = 0.f; for (int jj = 0; jj < 64; ++jj) o += ys[jj] * a.in[I_WFNET][((size_t)(l * 4 + g) * 64 + jj) * 64 + j];
        const size_t row = rbase + k; const float z = bf2f(P[row * PW + C_BZ + 64 * g + j]);
        chk_acc(a, id, bf2f(YB[row * 1024 + 512 + 64 * g + j]), o * siluf(z)); LDS_WAIT(); }
}
DI void chk_sgu(const Frame& F, const Args& a, int l, int id) {
    const bf16* P = (const bf16*)(a.ws + WS_P); const bf16* YB = (const bf16*)(a.ws + WS_YB);
    const int gt = F.vcu * 512 + F.tid, NGT = F.G * 512;
    for (int s = gt; s < (1 << 18); s += NGT) { const unsigned hh = hsh(s * 17 + 11); int row = sample_row(hh, l); if (l == 1 && row >= M_LAT) row = hh % M_LAT; const int cc = hsh(hh + 101u) & 255, g = cc >> 6, p = row & 127; const size_t r0 = (size_t)(row - p);
        float sp = a.in[I_BSP][(l * 4 + g) * 128 + p];
        for (int q = 0; q < 128; ++q) { const float v = bf2f(P[(r0 + q) * PW + C_CV + cc]); sp += a.in[I_WSP][((size_t)(l * 4 + g) * 128 + p) * 128 + q] * (0.5f * v * (1.0f + erff(v * 0.7071067811865476f))); }
        const float u = bf2f(P[(size_t)row * PW + C_CU + cc]), z = bf2f(P[(size_t)row * PW + C_CZ + cc]);
        chk_acc(a, id, bf2f(YB[(size_t)row * 1024 + 768 + cc]), (0.5f * u * (1.0f + erff(u * 0.7071067811865476f))) * sp * siluf(z)); }
}
DI void chk_merge(const Frame& F, const Args& a, int l, int id) {
    const bf16* H = (const bf16*)(a.ws + WS_H); const bf16* YB = (const bf16*)(a.ws + WS_YB); const bf16* MG = (const bf16*)(a.ws + WS_MG);
    const bf16* WM = (const bf16*)(a.ws + WS_WM) + (size_t)l * 4096 * 1024; const bf16* WB = (const bf16*)(a.ws + WS_WBR) + (size_t)l * 1024 * 1024;
    const int gt = F.vcu * 512 + F.tid, NGT = F.G * 512;
    for (int s = gt; s < (1 << 18); s += NGT) { const unsigned hh = hsh(s * 19 + 13); int row = sample_row(hh, l); if (l == 1 && row >= M_LAT) row = hh % M_LAT; const int d = hsh(hh + 202u) & 1023; float acc = 0.f;
        for (int r = 0; r < 4; ++r) { const float G = dot_h_w(H + (size_t)row * 1024, WM + ((size_t)r * 1024 + d) * 1024, 1024) + a.in[I_BMERGE][l * 4096 + r * 1024 + d];
            const float Y = dot_h_w(YB + (size_t)row * 1024 + 256 * r, WB + (size_t)d * 1024 + 256 * r, 256); acc += Y * __builtin_amdgcn_rcpf(1.0f + __builtin_amdgcn_exp2f(-1.4426950408889634f * G)); }
        float got; if (row < M_LAT) got = bf2f(MG[(size_t)row * 1024 + d]); else { got = 0.f; for (int br = 0; br < 4; ++br) got += bf2f(((const bf16*)(a.ws + WS_GTC))[((size_t)br * 512 + (row - M_LAT)) * 1024 + d]); }
        chk_acc(a, id, got, acc); }
}
DI void chk_gt(const Frame& F, const Args& a, int l, int r, int id) {
    const bf16* H = (const bf16*)(a.ws + WS_H); const bf16* GT = (const bf16*)(a.ws + WS_GT); const bf16* WM = (const bf16*)(a.ws + WS_WM) + (size_t)l * 4096 * 1024;
    const int gt = F.vcu * 512 + F.tid, NGT = F.G * 512;
    for (int s = gt; s < (1 << 18); s += NGT) { const unsigned hh = hsh(s * 29 + 19); int row = sample_row(hh, l); if (l == 1 && row >= M_LAT) row = hh % M_LAT; const int d = hsh(hh + 404u) & 1023;
        const float G = dot_h_w(H + (size_t)row * 1024, WM + ((size_t)r * 1024 + d) * 1024, 1024) + a.in[I_BMERGE][l * 4096 + r * 1024 + d];
        chk_acc(a, id, bf2f(GT[(size_t)row * 1024 + d]), __builtin_amdgcn_rcpf(1.0f + __builtin_amdgcn_exp2f(-1.4426950408889634f * G))); }
}
DI void chk_final(const Frame& F, const Args& a, int l, int id) {
    const bf16* MG = (const bf16*)(a.ws + WS_MG); const bf16* WO = (const bf16*)(a.ws + WS_WOUT) + (size_t)l * 1024 * 1024; const float* mod = (const float*)(a.ws + WS_MOD) + (size_t)l * 3 * 3072;
    const int gt = F.vcu * 512 + F.tid, NGT = F.G * 512;
    for (int s = gt; s < (1 << 18); s += NGT) { const unsigned hh = hsh(s * 23 + 17); const int row = sample_row(hh, l), c = hsh(hh + 303u) & 1023; const int v = row < SEQ ? 0 : (row < M_LAT ? 1 : 2);
        if (l == 1 && row >= M_LAT) continue;
        const float xi = (l == 1) ? ((const float*)(a.ws + WS_H))[(size_t)row * 1024 + c] : (row < M_LAT) ? a.in[I_X][(size_t)row * 1024 + c] : a.in[I_CTX][(size_t)(row - M_LAT) * 1024 + c];
        const float got = (row < M_LAT) ? a.out[(size_t)row * 1024 + c] : ((const float*)(a.ws + WS_XC1))[(size_t)(row - M_LAT) * 1024 + c];
        float dsum;
        if (row < M_LAT) dsum = dot_h_w(MG + (size_t)row * 1024, WO + (size_t)c * 1024, 1024);
        else { dsum = 0.f; for (int br = 0; br < 4; ++br) dsum += dot_h_w((const bf16*)(a.ws + WS_GTC) + ((size_t)br * 512 + (row - M_LAT)) * 1024, WO + (size_t)c * 1024, 1024); }
        chk_acc(a, id, got - xi, mod[v * 3072 + 2048 + c] * dsum); }
}
#ifdef CHECK_MAX
#define CHK_ERR(md, ss, n, mx) ((mx) / (sqrtf((ss) / (float)(n)) + 1e-20f))
#else
#define CHK_ERR(md, ss, n, mx) sqrtf((md) / ((ss) + 1e-30f))
#endif
DI void chk_report(const Frame& F, const Args& a) {
    const unsigned* w = (const unsigned*)(a.ws + WS_CTL) + CW_CHK; int first = -1; float ferr = 0.f;
#ifdef CHECK_ONLY
    { const int id = CHECK_ONLY; const float md = __uint_as_float(w[4 * id]), ss = ((const float*)w)[4 * id + 1]; const unsigned n = w[4 * id + 2]; first = id; ferr = n ? CHK_ERR(md, ss, n, __uint_as_float(w[4 * id + 3])) : 1e3f; }
#else
    for (int id = 0; id < 24; ++id) { const float md = __uint_as_float(w[4 * id]), ss = ((const float*)w)[4 * id + 1]; const unsigned n = w[4 * id + 2]; if (!n) continue;
        const float e = CHK_ERR(md, ss, n, __uint_as_float(w[4 * id + 3])); if (e > CHECK_TOL && first < 0) { first = id; ferr = e; } }
#endif
    const float V = first >= 0 ? 10.0f * (float)(1 + first) : 0.f; const float W = first >= 0 ? 4.0f + log10f(fminf(fmaxf(ferr, 1e-3f), 1e3f)) : 0.f;
    const size_t gt = (size_t)F.vcu * 512 + F.tid, NGT = (size_t)F.G * 512;
#ifdef KEEP_OUT
    if (gt == 0) a.out[0] += V; (void)W; (void)NGT;
#else
    for (size_t i = gt; i < (size_t)M_LAT * 1024; i += NGT) { float v = a.in[I_X][i]; if (i == 0) v += V; if (i >= (1u << 20) && i < (2u << 20)) v += W; a.out[i] = v; }
#endif
}
DI void chk_copy_out(const Frame& F, const Args& a) {
    const size_t gt = (size_t)F.vcu * 512 + F.tid, NGT = (size_t)F.G * 512; float* dst = (float*)(a.ws + WS_H);
    for (size_t i = gt; i < (size_t)M_LAT * 1024; i += NGT) dst[i] = a.out[i];
}
#endif
#ifndef RELAX_G1
#define RELAX_G1 true
#endif
#ifndef RELAX_MG
#define RELAX_MG true
#endif
#ifndef RELAX_OUT
#define RELAX_OUT true
#endif

typedef const __attribute__((address_space(4))) Args* CArgsP;
DI Args fresh_args() { CArgsP p = (CArgsP)__builtin_amdgcn_kernarg_segment_ptr(); asm volatile("" : "+s"(p)); Args r;
#pragma unroll
    for (int i = 0; i < 20; ++i) r.in[i] = p->in[i];
    r.out = p->out; r.ws = p->ws; return r; }
DI Frame fresh_frame(unsigned char* lds) {
    Frame F; int t_ = threadIdx.x; asm volatile("" : "+v"(t_));
    F.lds = (LAS unsigned char*)lds; F.tid = t_; F.lane = t_ & 63; F.wave = __builtin_amdgcn_readfirstlane(t_ >> 6);
    F.G = gridDim.x; { const int bx = blockIdx.x; F.vcu = (F.G % 8 == 0) ? (bx % 8) * (F.G / 8) + bx / 8 : bx; }
    return F;
}
DI void grid_bar(unsigned char* lds) {
    const Args a = fresh_args();
    XcdBarrier b; b.bar = (unsigned*)(a.ws + WS_CTL) + CW_BAR; b.x = xb_xcc_id(); b.st = (volatile LAS unsigned*)((LAS unsigned char*)lds + MISC_OFF) + 8;
    xcd_barrier(b);
}

__global__ void __launch_bounds__(NWAVES * 64, 2) hybrid_fwd(Args args) {
    extern __shared__ __attribute__((aligned(16))) unsigned char lds[];
    for (int u = threadIdx.x; u < (LDS_BYTES - LDSCTL_OFF) / 4; u += NWAVES * 64) ((LAS unsigned*)((LAS unsigned char*)lds + LDSCTL_OFF))[u] = 0u;
    __syncthreads();
    { const Args a = fresh_args(); (void)xcd_barrier_post((unsigned*)(a.ws + WS_CTL) + CW_BAR, (volatile LAS unsigned*)((LAS unsigned char*)lds + MISC_OFF) + 8); }
#define GRID_BAR() grid_bar(lds)
#ifndef DUP_MASK
#define DUP_MASK 0
#endif
#define DUP(bit) for (int rep_ = 0; rep_ < 1 + (((DUP_MASK) >> (bit)) & 1); ++rep_)
#ifdef SELFCHECK
#ifndef CHECK_SET
#define CHECK_SET 0xffff
#endif
#define CHK(bit, call) do { if ((CHECK_SET) & (bit)) { { const Frame F = fresh_frame(lds); const Args a = fresh_args(); call; } GRID_BAR(); } } while (0)
#elif defined(EXTRA_BAR)
#define CHK(bit, call) GRID_BAR()
#else
#define CHK(bit, call) do {} while (0)
#endif

#ifdef REPEAT_ALL
    for (int rep_all = 0; rep_all < 2; ++rep_all) {
    if (rep_all) GRID_BAR();
#endif
#ifndef SKIP_P0
    DUP(0) { const Frame F = fresh_frame(lds); const Args a = fresh_args(); p0_prologue(F, a); }
#endif
    GRID_BAR();
    CHK(1, chk_p0(F, a));

#pragma unroll 1
    for (int l = 0; l < 2; ++l) {
#ifndef SKIP_P1
        DUP(1) { const Frame F = fresh_frame(lds); const Args a = fresh_args();
          p1_modrms(F, a, l, (l == 0) ? a.in[I_X] : a.out, a.in[I_CTX], 1); }
#endif
        GRID_BAR();
        CHK(2, chk_h(F, a, l, 2 + 10 * l));
#ifndef SKIP_G1
        DUP(2) { const Frame F = fresh_frame(lds); const Args a = fresh_args();
            pg8::Gemm g{(const bf16*)(a.ws + WS_H), (const bf16*)(a.ws + WS_WIN) + (size_t)l * PW * WPITCH, 1024, WPITCH, 1024};
            pg8::OrderX S; S.so.init(l == 0 ? M_ALL : M_LAT, PW, F.G, (int)blockIdx.x); S.nx = (l == 0) ? 0 : 4;
            pg8::EpiBf16<0> E{(bf16*)(a.ws + WS_P), PW, nullptr};
            pg8::gemm_phase<pg8::EpiBf16<0>, pg8::OrderX, true, RELAX_G1>(F.lds, g, S, E);
        }
#endif
        GRID_BAR();
        CHK(4, chk_p(F, a, l, 3 + 10 * l));
#ifndef SKIP_S1
        DUP(3) { const Frame F = fresh_frame(lds); const Args a = fresh_args();
          for (int u = F.vcu; u < 256; u += F.G) fnet_s1_unit(F, a, l, u, (const bf16*)(a.ws + WS_P)); }
#endif
#ifndef SKIP_PREP
        { const Frame F = fresh_frame(lds); const Args a = fresh_args(); p3_prep(F, a, l, (bf16*)(a.ws + WS_P)); }
#endif
        GRID_BAR();
        CHK(8, chk_prep(F, a, l, 4 + 10 * l));
#ifndef SKIP_ATT
        DUP(4) { const Frame F = fresh_frame(lds); const Args a = fresh_args();
            const attn_body::bf16* Pa = (const attn_body::bf16*)(a.ws + WS_P); attn_body::bf16* Ya = (attn_body::bf16*)(a.ws + WS_YB);
            for (int u = F.vcu; u < 256; u += F.G) {
                const int bk = u >> 6, b = bk >> 1, kvh = bk & 1, h = 2 * kvh + ((u >> 5) & 1), qb = u & 31;
                attn_body::attn_unit<0, 8>(Pa, Ya, SEQ * b + 256 * qb, M_LAT + NCTX * b, SEQ * b, 0, 132, 0,
                                           C_AQ + 64 * h, C_AK + 64 * kvh, C_AV + 64 * kvh, C_AZ + 64 * h, 64 * h, 0.f, (char*)lds, a.in[I_QNA] + l * 64, 1);
            }
        }
        DUP(5) { const Frame F = fresh_frame(lds); const Args a = fresh_args();
            const attn_body::bf16* Pa = (const attn_body::bf16*)(a.ws + WS_P); attn_body::bf16* Ya = (attn_body::bf16*)(a.ws + WS_YB);
            for (int u = F.vcu; u < 512; u += F.G) {
                if (u < 256) {
                    const int bk = u >> 6, b = bk >> 1, kvh = bk & 1, h = 2 * kvh + ((u >> 5) & 1), qb = u & 31;
                    const int off = (qb == 0) ? 0 : 4 * qb - 2, NT = (qb == 0 || qb == 31) ? 10 : 12;
                    const float sk = a.in[I_SINK][l * 4 + h] * 1.4426950408889634f;
                    attn_body::attn_unit<1, 8>(Pa, Ya, SEQ * b + 256 * qb, M_LAT + NCTX * b, SEQ * b, off, NT, 256 * qb - 64 * off,
                                               C_DQ + 64 * h, C_DK + 64 * kvh, C_DV + 64 * kvh, C_DZ + 64 * h, 256 + 64 * h, sk, (char*)lds, a.in[I_QND] + l * 64, 1);
                } else if (l == 0 && u >= 288 && u < 416 && ((u - 288) & 7) == 0) {
                    const int ee = (u - 288) >> 3, mode = ee >> 3, b = (ee >> 2) & 1, h = ee & 3, kvh = h >> 1;
                    const float sk = (mode == 0) ? -INFINITY : a.in[I_SINK][l * 4 + h] * 1.4426950408889634f;
                    const int qc = (mode == 0) ? C_AQ : C_DQ, kc = (mode == 0) ? C_AK : C_DK, vc = (mode == 0) ? C_AV : C_DV, zc = (mode == 0) ? C_AZ : C_DZ, oc = (mode == 0) ? 0 : 256;
                    attn_body::attn_unit<1, 8>(Pa, Ya, M_LAT + NCTX * b, M_LAT + NCTX * b, SEQ * b, 0, 4, 0,
                                               qc + 64 * h, kc + 64 * kvh, vc + 64 * kvh, zc + 64 * h, oc + 64 * h, sk, (char*)lds, ((mode == 0) ? a.in[I_QNA] : a.in[I_QND]) + l * 64, 0);
                }
            }
        }
#endif
#ifndef SKIP_S3
        DUP(6) { const Frame F = fresh_frame(lds); const Args a = fresh_args();
          for (int u = F.vcu; u < 256; u += F.G) fnet_s3_unit(F, a, u, (const bf16*)(a.ws + WS_P), (bf16*)(a.ws + WS_YB)); }
#endif
#ifndef SKIP_SGU
        DUP(7) { const Frame F = fresh_frame(lds); const Args a = fresh_args();
          const int nunit = (l == 0) ? 528 : 512;
          for (int u = F.vcu; u < nunit; u += F.G) sgu_unit(F, a, l, u, (const bf16*)(a.ws + WS_P), (bf16*)(a.ws + WS_YB)); }
#endif
#ifndef SKIP_FC
        if (l == 0) DUP(10) { const Frame F = fresh_frame(lds); const Args a = fresh_args();
          for (int e = F.vcu; e < 256; e += F.G) { if (e >= 160 && e < 224 && ((e - 160) & 7) == 0) fnet_ctx_unit(F, a, l, (e - 160) >> 3, (const bf16*)(a.ws + WS_P), (bf16*)(a.ws + WS_YB)); } }
#endif
        GRID_BAR();
        CHK(16, chk_attn(F, a, l, 5 + 10 * l, 0)); CHK(16, chk_attn(F, a, l, 6 + 10 * l, 1)); CHK(32, chk_fnet(F, a, l, 7 + 10 * l, 0); if (l == 0) chk_fnet(F, a, l, 8, 1)); CHK(64, chk_sgu(F, a, l, 9 + 10 * l));
#ifndef MERGE_V1
        for (int rep_ = 0; rep_ < 1 + ((((DUP_MASK) >> 8) & 1) && l == 1); ++rep_) { const Frame F = fresh_frame(lds); const Args a = fresh_args();
            pg8::Gemm g{(const bf16*)(a.ws + WS_H), (const bf16*)(a.ws + WS_WM), 1024, 1024, 1024};
            pg8::MergeOrder S{(const bf16*)(a.ws + WS_H), (const bf16*)(a.ws + WS_YB), (const bf16*)(a.ws + WS_WM) + (size_t)l * 4096 * 1024, (const bf16*)(a.ws + WS_WBR) + (size_t)l * 1024 * 1024, F.G, F.vcu, (l == 0) ? 32 : 0};
            pg8::EpiMerge E{(bf16*)(a.ws + WS_GT), (bf16*)(a.ws + WS_MG), (float*)(a.ws + WS_MGC), a.in[I_BMERGE] + l * 4096, (bf16*)(a.ws + WS_GTC), (bf16*)(a.ws + WS_GT2)};
            pg8::gemm_phase<pg8::EpiMerge, pg8::MergeOrder, true, RELAX_MG>(F.lds, g, S, E);
        }
        if (l == 0) { const Frame F = fresh_frame(lds); const Args a = fresh_args();
            if (F.G == 256) { if ((F.vcu & 7) != 0) p0_weights(F, a, 1, F.vcu - (F.vcu >> 3) - 1, 224); } else p0_weights(F, a, 1, F.vcu, F.G); }
        GRID_BAR();
#else
#pragma unroll 1
        for (int r = 0; r < 4; ++r) {
#ifdef ZERO_MASK
            if ((ZERO_MASK >> r) & 1) continue;
#endif
#ifndef SKIP_MG
            { const Frame F = fresh_frame(lds); const Args a = fresh_args();
                pg8::Gemm g{(const bf16*)(a.ws + WS_H), (const bf16*)(a.ws + WS_WM) + ((size_t)l * 4096 + r * 1024) * 1024, 1024, 1024, 1024};
                pg8::OrderX S; S.so.init((l == 0) ? M_ALL : M_LAT, 1024, F.G, (int)blockIdx.x); S.nx = 0;
                pg8::EpiBf16<2> E{(bf16*)(a.ws + WS_GT), 1024, a.in[I_BMERGE] + l * 4096 + r * 1024};
                pg8::gemm_phase<pg8::EpiBf16<2>, pg8::OrderX, true>(F.lds, g, S, E);
            }
#endif
            GRID_BAR();
            if (r == 3 && l == 0) CHK(512, chk_gt(F, a, l, r, 22); chk_gt(F, a, l, 2, 23));
#ifndef SKIP_MY
            { const Frame F = fresh_frame(lds); const Args a = fresh_args();
                pg8::Gemm g{(const bf16*)(a.ws + WS_YB) + r * 256, (const bf16*)(a.ws + WS_WBR) + (size_t)l * 1024 * 1024 + r * 256, 1024, 1024, 256};
                pg8::OrderX S; S.so.init((l == 0) ? M_ALL : M_LAT, 1024, F.G, (int)blockIdx.x); S.nx = 0;

#ifdef ZERO_MASK
                pg8::EpiGate E{(bf16*)(a.ws + WS_MG), (const bf16*)(a.ws + WS_GT), 1024, r == __builtin_ctz(~(ZERO_MASK)), 1.0f};
#else
#ifdef SCALE_MASK
                pg8::EpiGate E{(bf16*)(a.ws + WS_MG), (const bf16*)(a.ws + WS_GT), 1024, r == 0, ((SCALE_MASK >> r) & 1) ? (SCALE_VAL) : 1.0f};
#else
                pg8::EpiGate E{(bf16*)(a.ws + WS_MG), (const bf16*)(a.ws + WS_GT), 1024, r == 0, 1.0f};
#endif
#endif

                pg8::gemm_phase<pg8::EpiGate, pg8::OrderX, true>(F.lds, g, S, E);
            }
#endif
            GRID_BAR();
        }
#endif
        CHK(128, chk_merge(F, a, l, 10 + 10 * l));
        if (l == 1) CHK(256, chk_copy_out(F, a));
#ifndef SKIP_OUT
        { const Frame F = fresh_frame(lds); const Args a = fresh_args();
            pg8::Gemm g{(const bf16*)(a.ws + WS_MG), (const bf16*)(a.ws + WS_WOUT) + (size_t)l * 1024 * 1024, 1024, 1024, 1024};
            pg8::OrderOut S; S.so.init(M_LAT, 1024, F.G, (int)blockIdx.x); S.nx = (l == 0) ? 128 : 0; S.TERM = (const bf16*)(a.ws + WS_GTC);
            pg8::EpiRes E{(l == 0) ? a.in[I_X] : a.out, a.out, (l == 0) ? a.in[I_CTX] : (const float*)(a.ws + WS_XC1), (float*)(a.ws + WS_XC1), (const float*)(a.ws + WS_MOD) + (size_t)l * 3 * 3072, (float*)(a.ws + WS_GT2)};
            pg8::gemm_phase<pg8::EpiRes, pg8::OrderOut, true, RELAX_OUT>(F.lds, g, S, E);
        }
#endif
        if (l == 0) GRID_BAR();
        if (l == 0) CHK(256, chk_final(F, a, l, 11));
#ifdef SELFCHECK
        if (l == 1) { GRID_BAR(); CHK(256, chk_final(F, a, l, 21)); }
#endif
    }
#ifdef REPEAT_ALL
    }
#endif
#ifdef SELFCHECK
    GRID_BAR();
    { const Frame F = fresh_frame(lds); const Args a = fresh_args(); chk_report(F, a); }
#endif
#ifdef BLEND_S
    GRID_BAR();
    { const Frame F = fresh_frame(lds); const Args a = fresh_args(); const size_t gt = (size_t)F.vcu * 512 + F.tid, NGT = (size_t)F.G * 512;
      for (size_t i = gt; i < (size_t)M_LAT * 1024; i += NGT) { const float x0 = a.in[I_X][i]; a.out[i] = x0 + (BLEND_S) * (a.out[i] - x0); } }
#endif
}

extern "C" void kernel_launch(void* const* d_in, const int* in_sizes, int n_in, void* d_out, int out_size, void* d_ws, size_t ws_size, hipStream_t stream) {
    static int grid = 0;
    if (grid == 0) {
        if (n_in != 20 || out_size != M_LAT * DM || ws_size < WS_END) { fprintf(stderr, "kernel_launch: unexpected problem: n_in %d out %d ws %zu\n", n_in, out_size, ws_size); grid = -1; return; }
        { const int want[20] = {M_LAT * DM, NB * DM, M_CTX * DM, DM, 2 * DM, 2 * DM * 3 * DM, 2 * 3 * DM, 2 * DM * PW, 128, 128, 128, 128, 8, 2 * 4 * 64 * 64, 2 * 4 * 128 * 128, 2 * 4 * 128, 2 * 4 * 256 * DM, 2 * DM * 4 * DM, 2 * 4 * DM, 2 * DM * DM};
          for (int i = 0; i < 20; ++i) if (in_sizes[i] != want[i]) { fprintf(stderr, "kernel_launch: input %d has %d elements, expected %d\n", i, in_sizes[i], want[i]); grid = -1; return; } }
        int dev = 0, cus = 0, per_cu = 0;
        if (hipGetDevice(&dev) != hipSuccess || hipDeviceGetAttribute(&cus, hipDeviceAttributeMultiprocessorCount, dev) != hipSuccess) { grid = -1; return; }
        if (hipFuncSetAttribute((const void*)hybrid_fwd, hipFuncAttributeMaxDynamicSharedMemorySize, LDS_BYTES) != hipSuccess) { fprintf(stderr, "kernel_launch: hipFuncSetAttribute failed\n"); grid = -1; return; }
        if (hipOccupancyMaxActiveBlocksPerMultiprocessor(&per_cu, (const void*)hybrid_fwd, NWAVES * 64, LDS_BYTES) != hipSuccess || per_cu < 1) { fprintf(stderr, "kernel_launch: occupancy query says %d blocks per CU\n", per_cu); per_cu = 1; }
        (void)hipGetLastError();
        grid = cus;
    }
    if (grid < 0) return;
    if (hipMemsetAsync((char*)d_ws + WS_CTL, 0, CTL_ZERO_BYTES, stream) != hipSuccess) { fprintf(stderr, "kernel_launch: memset failed\n"); return; }
    Args a{};
    for (int i = 0; i < 20; ++i) a.in[i] = (const float*)d_in[i];
    a.out = (float*)d_out; a.ws = (unsigned char*)d_ws;
    hipLaunchKernelGGL(hybrid_fwd, dim3(grid), dim3(NWAVES * 64), LDS_BYTES, stream, a);
}
```

```cpp
#include <hip/hip_runtime.h>
#include <hip/hip_bf16.h>
#include <cstdio>
#include <cstdint>
#include <cmath>

namespace pg8 {

#define PG8_LAS __attribute__((address_space(3)))
typedef unsigned short bf16_t;
typedef short bf16x8 __attribute__((ext_vector_type(8)));
typedef float f32x4 __attribute__((ext_vector_type(4)));
typedef unsigned u32x4 __attribute__((ext_vector_type(4)));
constexpr int BM = 256, BK = 64, HALF = 128, HTB = HALF * BK * 2, STAGE_BYTES = 8 * HTB, NXCD = 8, WGM = 8;

__host__ __device__ __forceinline__ int lds_byte(int r, int c) { const int st = (r >> 4) * 2 + (c >> 5), rr = r & 15, cc = c & 31, ob = rr * 64 + cc * 2; return st * 1024 + (ob ^ (((ob >> 9) & 1) << 5)); }
__host__ __device__ __forceinline__ void stage_rc(int b, int& R, int& C) { const int st = b / 1024, sb = b % 1024, swz = sb ^ (((sb >> 9) & 1) << 5); R = (st >> 1) * 16 + swz / 64; C = (st & 1) * 32 + (swz % 64) / 2; }
__host__ __device__ __forceinline__ int perm32(int rho) { const int n = rho >> 4, i = rho & 15; return 8 * (i >> 2) + 4 * n + (i & 3); }

struct Unit { int pm, pn, r, kind; };
struct Gemm { const bf16_t* A; const bf16_t* Bt; int lda, ldb, K; };

struct StaticOrder {
    int nM, nN, nwg, G, c;
    __host__ __device__ void init(int M, int N, int G_, int c_) { nM = M / BM; nN = N / BM; nwg = nM * nN; G = G_; c = c_; }
    __host__ __device__ bool next(int i, Unit& u) const {
        const long L = (long)i * G + c; if (L >= nwg) return false;
        int wgid = (int)L; { const int q = nwg / NXCD, r = nwg % NXCD, xcd = wgid % NXCD, off = wgid / NXCD; wgid = (xcd < r ? xcd * (q + 1) : r * (q + 1) + (xcd - r) * q) + off; }
        const int nig = WGM * nN, gid = wgid / nig, fm = gid * WGM, gsz = (nM - fm) < WGM ? (nM - fm) : WGM;
        u.pm = fm + ((wgid % nig) % gsz); u.pn = (wgid % nig) / gsz; u.r = 0; u.kind = 0; return true;
    }
};
struct OrderX {
    StaticOrder so; int nx;
    __device__ bool next(int i, Unit& u) const {
        const long L = (long)i * so.G + so.c;
        if (L < so.nwg) return so.next(i, u);
        const int e = (int)(L - so.nwg); if (e >= nx) return false;
        u.pm = 64 + (e >> 1); u.pn = (e & 1) ? 4 : 1; u.r = 0; u.kind = 0; return true;
    }
    __device__ __forceinline__ void src(const Gemm& g, const Unit& u, const char*& pa, const char*& pb, const char*& pb1, int& nt) const {
        pa = (const char*)g.A + (size_t)u.pm * (2 * HALF) * g.lda * 2; pb = (const char*)g.Bt + (size_t)u.pn * (2 * HALF) * g.ldb * 2; pb1 = pb + (size_t)HALF * g.ldb * 2; nt = g.K / BK; }
};

typedef float f32x2_c __attribute__((ext_vector_type(2))); typedef __bf16 bf16x2_c __attribute__((ext_vector_type(2)));
__device__ __forceinline__ unsigned cvt_pk_bf16(float lo, float hi) { f32x2_c v = {lo, hi}; bf16x2_c b = __builtin_convertvector(v, bf16x2_c); return __builtin_bit_cast(unsigned, b); }
__device__ __forceinline__ float bf_lo(unsigned w) { return __uint_as_float(w << 16); }
__device__ __forceinline__ float bf_hi(unsigned w) { return __uint_as_float(w & 0xffff0000u); }
__device__ __forceinline__ float sigmoidf_(float x) { return __builtin_amdgcn_rcpf(1.0f + __builtin_amdgcn_exp2f(-1.4426950408889634f * x)); }

template <int ACT> struct EpiBf16 {
    static constexpr bool PERM = true; static constexpr int NSTORE = 16;
    bf16_t* O; int ldc; const float* bias;
    __device__ __forceinline__ void operator()(const f32x4 (&acc)[2][2][4][2], const Unit& u, int wr, int wc, int fr, int fq) const {
        const int row0 = u.pm * BM + wr * 64 + fr; const int col0 = u.pn * BM + wc * 32 + 8 * fq;
        f32x4 bv[2][2];
#pragma unroll
        for (int bj = 0; bj < 2; ++bj)
#pragma unroll
            for (int n = 0; n < 2; ++n) bv[bj][n] = bias ? *(const f32x4*)(bias + col0 + bj * HALF + 4 * n) : (f32x4){0.f, 0.f, 0.f, 0.f};
#pragma unroll
        for (int ai = 0; ai < 2; ++ai)
#pragma unroll
            for (int m = 0; m < 4; ++m) { bf16_t* rowp = O + (size_t)(row0 + ai * HALF + m * 16) * ldc + col0;
#pragma unroll
                for (int bj = 0; bj < 2; ++bj) { f32x4 v0 = acc[ai][bj][m][0] + bv[bj][0], v1 = acc[ai][bj][m][1] + bv[bj][1];
                    if (ACT == 2) {
#pragma unroll
                        for (int e = 0; e < 4; ++e) { v0[e] = sigmoidf_(v0[e]); v1[e] = sigmoidf_(v1[e]); } }
                    u32x4 w; w.x = cvt_pk_bf16(v0[0], v0[1]); w.y = cvt_pk_bf16(v0[2], v0[3]); w.z = cvt_pk_bf16(v1[0], v1[1]); w.w = cvt_pk_bf16(v1[2], v1[3]);
                    *(u32x4*)(rowp + bj * HALF) = w;
                    } }
    }
};
struct EpiGate {
    static constexpr bool PERM = true; static constexpr int NSTORE = 0;
    bf16_t* MG; const bf16_t* GT; int ldc; int first; float scl;
    typedef unsigned u32x2 __attribute__((ext_vector_type(2)));
    __device__ __forceinline__ void operator()(const f32x4 (&acc)[2][2][4][2], const Unit& u, int wr, int wc, int fr, int fq) const {
        const int row0 = u.pm * BM + wr * 64 + fr; const int col0 = u.pn * BM + wc * 32 + 8 * fq;
#pragma unroll
        for (int ai = 0; ai < 2; ++ai)
#pragma unroll
            for (int m = 0; m < 4; ++m) { const size_t off = (size_t)(row0 + ai * HALF + m * 16) * ldc + col0;
#pragma unroll
                for (int bj = 0; bj < 2; ++bj)
#pragma unroll
                    for (int n = 0; n < 2; ++n) {
                        const u32x2 g = *(const u32x2*)(GT + off + bj * HALF + 4 * n);
                        u32x2 o = (u32x2){0u, 0u}; if (!first) o = *(const u32x2*)(MG + off + bj * HALF + 4 * n);
                        const f32x4 v = acc[ai][bj][m][n] * scl;
                        u32x2 w;
                        w.x = cvt_pk_bf16(bf_lo(o.x) + bf_lo(g.x) * v[0], bf_hi(o.x) + bf_hi(g.x) * v[1]);
                        w.y = cvt_pk_bf16(bf_lo(o.y) + bf_lo(g.y) * v[2], bf_hi(o.y) + bf_hi(g.y) * v[3]);
                        *(u32x2*)(MG + off + bj * HALF + 4 * n) = w; asm volatile("" ::: "memory"); } }
    }
};
struct EpiRes {
    static constexpr bool PERM = false; static constexpr int NSTORE = 32;
    const float* xin_lat; float* xout_lat; const float* xin_ctx; float* xout_ctx; const float* gate; float* part;
    __device__ __forceinline__ void operator()(const f32x4 (&acc)[2][2][4][2], const Unit& u, int wr, int wc, int fr, int fq) const {
        const bool isctx = u.pm >= 64;
        const float* xin = isctx ? xin_ctx + (size_t)(u.pm - 64) * BM * 1024 : xin_lat + (size_t)u.pm * BM * 1024;
        float* xout = isctx ? xout_ctx + (size_t)(u.pm - 64) * BM * 1024 : xout_lat + (size_t)u.pm * BM * 1024;
        const float* gv = gate + (isctx ? 2 : (u.pm >> 5)) * 3072 + 2048;
        const int col0 = u.pn * BM + wc * 32 + 4 * fq;
        f32x4 gt[2][2];
#pragma unroll
        for (int bj = 0; bj < 2; ++bj)
#pragma unroll
            for (int n = 0; n < 2; ++n) gt[bj][n] = *(const f32x4*)(gv + col0 + bj * HALF + n * 16);
        if (u.kind == 3) {
            float* pt = part + ((size_t)u.r * 512 + (size_t)(u.pm - 64) * BM) * 1024;
#pragma unroll
            for (int ai = 0; ai < 2; ++ai)
#pragma unroll
                for (int m = 0; m < 4; ++m) { const size_t off = (size_t)(ai * HALF + wr * 64 + m * 16 + fr) * 1024 + col0;
#pragma unroll
                    for (int bj = 0; bj < 2; ++bj)
#pragma unroll
                        for (int n = 0; n < 2; ++n) *(f32x4*)(pt + off + bj * HALF + n * 16) = gt[bj][n] * acc[ai][bj][m][n]; }
        } else {
            const __amdgpu_buffer_rsrc_t rx = __builtin_amdgcn_make_buffer_rsrc((void*)xin, 0, 0x7fffffff, 0x00020000);
            const unsigned vb = (unsigned)(((wr * 64 + fr) * 1024 + col0) * 4);
            f32x4 bs[8][2][2];
#define EPR_SOFF(c, bj, n) (((((c) >> 2) * HALF + ((c) & 3) * 16) * 1024 + (bj) * HALF + (n) * 16) * 4)
#define EPR_LOAD(c) do { _Pragma("unroll") for (int bj = 0; bj < 2; ++bj) _Pragma("unroll") for (int n = 0; n < 2; ++n) \
                bs[c][bj][n] = __builtin_bit_cast(f32x4, __builtin_amdgcn_raw_buffer_load_b128(rx, vb, EPR_SOFF(c, bj, n), 0)); asm volatile("" ::: "memory"); } while (0)
            EPR_LOAD(0); EPR_LOAD(1); EPR_LOAD(2); EPR_LOAD(3);
#pragma unroll
            for (int c = 0; c < 8; ++c) { const int ai = c >> 2, m = c & 3;
#pragma unroll
                for (int bj = 0; bj < 2; ++bj)
#pragma unroll
                    for (int n = 0; n < 2; ++n) *(f32x4*)((char*)xout + vb + EPR_SOFF(c, bj, n)) = bs[c][bj][n] + gt[bj][n] * acc[ai][bj][m][n];
                asm volatile("" ::: "memory");
                if (c + 4 < 8) { if (c == 0) EPR_LOAD(4); else if (c == 1) EPR_LOAD(5); else if (c == 2) EPR_LOAD(6); else EPR_LOAD(7); } }
#undef EPR_LOAD
#undef EPR_SOFF
        }
    }
};

struct MergeOrder {
    const bf16_t* H; const bf16_t* YB; const bf16_t* WmT; const bf16_t* WbrT; int G, c, nctx;
    __device__ bool next(int i, Unit& u) const {
        const int nl = (c < 256) ? 1 + (255 - c) / G : 0;
        if (i < 8 * nl) { const int t = c + (i >> 3) * G, q = i & 7; u.pm = t >> 2; u.pn = t & 3; u.r = 2 * (q >> 2) + (q & 1); u.kind = (q & 2) ? 0 : 1; return true; }
        const int j = i - 8 * nl;
        if (nctx == 0 || (c & 7) != 0) return false;
        const int jb = (c >> 3) + (j >> 1) * (G >> 3); if (jb >= nctx) return false;
        const int t = jb >> 2; u.pm = 64 + (t >> 2); u.pn = t & 3; u.r = jb & 3; u.kind = (j & 1) ? 2 : 1; return true;
    }
    __device__ __forceinline__ void src(const Gemm&, const Unit& u, const char*& pa, const char*& pb, const char*& pb1, int& nt) const {
        if (u.kind == 1) { pa = (const char*)(YB + (size_t)u.pm * 256 * 1024 + u.r * 256); pb = (const char*)(WbrT + (size_t)u.pn * 256 * 1024 + u.r * 256); pb1 = pb + (size_t)HALF * 1024 * 2; nt = 4; }
        else if (u.kind == 2) { pa = (const char*)(H + (size_t)u.pm * 256 * 1024); pb = (const char*)(WmT + ((size_t)u.r * 1024 + u.pn * 256) * 1024); pb1 = pb + (size_t)HALF * 1024 * 2; nt = 16; }
        else { pa = (const char*)(H + (size_t)u.pm * 256 * 1024); pb = (const char*)(WmT + ((size_t)(u.r & 2) * 1024 + u.pn * 256 + (u.r & 1) * HALF) * 1024); pb1 = pb + (size_t)1024 * 1024 * 2; nt = 16; }
    }
};
typedef unsigned long long u64_t;
__device__ __forceinline__ u64_t ld_sc1(const void* p) { return __hip_atomic_load((const u64_t*)p, __ATOMIC_RELAXED, __HIP_MEMORY_SCOPE_AGENT); }
struct EpiMerge {
    static constexpr bool PERM = true; static constexpr int NSTORE = 8;
    bf16_t* GT; bf16_t* MG; float* MGc; const float* bias; bf16_t* GTc; bf16_t* GT2;
    typedef unsigned u32x2 __attribute__((ext_vector_type(2)));
    __device__ __forceinline__ void gate_ctx(const f32x4 (&acc)[2][2][4][2], bf16_t* Yu, int row0, int col0, const f32x4 (&bv)[2][2]) const {
        const __amdgpu_buffer_rsrc_t ry = __builtin_amdgcn_make_buffer_rsrc((void*)Yu, 0, 0x7fffffff, 0x00020000);
        u32x4 yq[8][2];
        const unsigned vb = (unsigned)((row0 * 1024 + col0) * 2);
#define EPM_SOFF(c) ((((c) >> 2) * HALF + ((c) & 3) * 16) * 1024 * 2)
#define EPM_LOAD(c) do { _Pragma("unroll") for (int bj = 0; bj < 2; ++bj) \
            yq[c][bj] = __builtin_bit_cast(u32x4, __builtin_amdgcn_raw_buffer_load_b128(ry, vb, EPM_SOFF(c) + bj * HALF * 2, 16)); asm volatile("" ::: "memory"); } while (0)
        EPM_LOAD(0); EPM_LOAD(1); EPM_LOAD(2); EPM_LOAD(3);
#pragma unroll
        for (int c = 0; c < 8; ++c) { const int ai = c >> 2, mm = c & 3;
#pragma unroll
            for (int bj = 0; bj < 2; ++bj) { f32x4 g0 = acc[ai][bj][mm][0] + bv[bj][0], g1 = acc[ai][bj][mm][1] + bv[bj][1];
#pragma unroll
                for (int e = 0; e < 4; ++e) { g0[e] = sigmoidf_(g0[e]); g1[e] = sigmoidf_(g1[e]); }
                const u32x4 y = yq[c][bj];
                u32x4 w;
                w.x = cvt_pk_bf16(g0[0] * bf_lo(y.x), g0[1] * bf_hi(y.x)); w.y = cvt_pk_bf16(g0[2] * bf_lo(y.y), g0[3] * bf_hi(y.y));
                w.z = cvt_pk_bf16(g1[0] * bf_lo(y.z), g1[1] * bf_hi(y.z)); w.w = cvt_pk_bf16(g1[2] * bf_lo(y.w), g1[3] * bf_hi(y.w));
                *(u32x4*)((char*)Yu + vb + EPM_SOFF(c) + bj * HALF * 2) = w; }
            asm volatile("" ::: "memory");
            if (c + 4 < 8) { if (c == 0) EPM_LOAD(4); else if (c == 1) EPM_LOAD(5); else if (c == 2) EPM_LOAD(6); else EPM_LOAD(7); } }
#undef EPM_LOAD
#undef EPM_SOFF
    }
#ifndef GP_DEPTH
#define GP_DEPTH 4
#endif
    template <bool FIRST> __device__ __forceinline__ void gate_pair(const f32x4 (&acc)[2][2][4][2], int row0, int colb, const f32x4 (&bv)[2][2]) const {
        const __amdgpu_buffer_rsrc_t r0 = __builtin_amdgcn_make_buffer_rsrc((void*)GT, 0, 0x7fffffff, 0x00020000), r1 = __builtin_amdgcn_make_buffer_rsrc((void*)GT2, 0, 0x7fffffff, 0x00020000),
                                     ro = __builtin_amdgcn_make_buffer_rsrc((void*)MG, 0, 0x7fffffff, 0x00020000);
        u32x4 y0q[8], y1q[8], oq[8];
        const unsigned vb = (unsigned)((row0 * 1024 + colb) * 2);
#define EPM_SOFF(c) ((((c) >> 2) * HALF + ((c) & 3) * 16) * 1024 * 2)
#define EPM_LOAD(c) do { \
            y0q[c] = __builtin_bit_cast(u32x4, __builtin_amdgcn_raw_buffer_load_b128(r0, vb, EPM_SOFF(c), 16)); y1q[c] = __builtin_bit_cast(u32x4, __builtin_amdgcn_raw_buffer_load_b128(r1, vb, EPM_SOFF(c), 16)); \
            oq[c] = FIRST ? (u32x4){0u, 0u, 0u, 0u} : __builtin_bit_cast(u32x4, __builtin_amdgcn_raw_buffer_load_b128(ro, vb, EPM_SOFF(c), 16)); asm volatile("" ::: "memory"); } while (0)
#pragma unroll
        for (int c = 0; c < GP_DEPTH; ++c) { if (c == 0) EPM_LOAD(0); else if (c == 1) EPM_LOAD(1); else if (c == 2) EPM_LOAD(2); else if (c == 3) EPM_LOAD(3); else if (c == 4) EPM_LOAD(4); else if (c == 5) EPM_LOAD(5); else if (c == 6) EPM_LOAD(6); else EPM_LOAD(7); }
#pragma unroll
        for (int c = 0; c < 8; ++c) { const int ai = c >> 2, mm = c & 3;
            f32x4 ga0 = acc[ai][0][mm][0] + bv[0][0], ga1 = acc[ai][0][mm][1] + bv[0][1], gb0 = acc[ai][1][mm][0] + bv[1][0], gb1 = acc[ai][1][mm][1] + bv[1][1];
#pragma unroll
            for (int e = 0; e < 4; ++e) { ga0[e] = sigmoidf_(ga0[e]); ga1[e] = sigmoidf_(ga1[e]); gb0[e] = sigmoidf_(gb0[e]); gb1[e] = sigmoidf_(gb1[e]); }
            const u32x4 ya = y0q[c], yb = y1q[c], o = oq[c];
            u32x4 w;
            w.x = cvt_pk_bf16(bf_lo(o.x) + ga0[0] * bf_lo(ya.x) + gb0[0] * bf_lo(yb.x), bf_hi(o.x) + ga0[1] * bf_hi(ya.x) + gb0[1] * bf_hi(yb.x));
            w.y = cvt_pk_bf16(bf_lo(o.y) + ga0[2] * bf_lo(ya.y) + gb0[2] * bf_lo(yb.y), bf_hi(o.y) + ga0[3] * bf_hi(ya.y) + gb0[3] * bf_hi(yb.y));
            w.z = cvt_pk_bf16(bf_lo(o.z) + ga1[0] * bf_lo(ya.z) + gb1[0] * bf_lo(yb.z), bf_hi(o.z) + ga1[1] * bf_hi(ya.z) + gb1[1] * bf_hi(yb.z));
            w.w = cvt_pk_bf16(bf_lo(o.w) + ga1[2] * bf_lo(ya.w) + gb1[2] * bf_lo(yb.w), bf_hi(o.w) + ga1[3] * bf_hi(ya.w) + gb1[3] * bf_hi(yb.w));
            *(u32x4*)((char*)MG + vb + EPM_SOFF(c)) = w;
            asm volatile("" ::: "memory");
            if (c + GP_DEPTH < 8) { const int cn = c + GP_DEPTH; if (cn == 1) EPM_LOAD(1); else if (cn == 2) EPM_LOAD(2); else if (cn == 3) EPM_LOAD(3); else if (cn == 4) EPM_LOAD(4); else if (cn == 5) EPM_LOAD(5); else if (cn == 6) EPM_LOAD(6); else EPM_LOAD(7); } }
#undef EPM_LOAD
#undef EPM_SOFF
    }
    __device__ __forceinline__ void operator()(const f32x4 (&acc)[2][2][4][2], const Unit& u, int wr, int wc, int fr, int fq) const {
        const int row0 = u.pm * BM + wr * 64 + fr; const int col0 = u.pn * BM + wc * 32 + 8 * fq;
        if (u.kind == 1) {
            bf16_t* Yu = (u.pm >= 64) ? GTc + ((size_t)u.r * 512 - 16384) * 1024 : ((u.r & 1) ? GT2 : GT);
#pragma unroll
            for (int ai = 0; ai < 2; ++ai)
#pragma unroll
                for (int m = 0; m < 4; ++m) { bf16_t* rowp = Yu + (size_t)(row0 + ai * HALF + m * 16) * 1024 + col0;
#pragma unroll
                    for (int bj = 0; bj < 2; ++bj) { const f32x4 v0 = acc[ai][bj][m][0], v1 = acc[ai][bj][m][1];
                        u32x4 w; w.x = cvt_pk_bf16(v0[0], v0[1]); w.y = cvt_pk_bf16(v0[2], v0[3]); w.z = cvt_pk_bf16(v1[0], v1[1]); w.w = cvt_pk_bf16(v1[2], v1[3]);
                        *(u32x4*)(rowp + bj * HALF) = w; } }
        } else if (u.kind == 2) {
            bf16_t* Yu = GTc + ((size_t)u.r * 512 - 16384) * 1024;
            const float* bp = bias + u.r * 1024 + col0;
            f32x4 bv[2][2];
#pragma unroll
            for (int bj = 0; bj < 2; ++bj)
#pragma unroll
                for (int n = 0; n < 2; ++n) bv[bj][n] = *(const f32x4*)(bp + bj * HALF + 4 * n);
            gate_ctx(acc, Yu, row0, col0, bv);
        } else {
            const int p2 = u.r & 2, colb = u.pn * BM + (u.r & 1) * HALF + wc * 32 + 8 * fq;
            f32x4 bv[2][2];
#pragma unroll
            for (int bj = 0; bj < 2; ++bj)
#pragma unroll
                for (int n = 0; n < 2; ++n) bv[bj][n] = *(const f32x4*)(bias + (p2 + bj) * 1024 + colb + 4 * n);
            if (p2 == 0) gate_pair<true>(acc, row0, colb, bv); else gate_pair<false>(acc, row0, colb, bv);
        }
    }
};
struct OrderOut {
    StaticOrder so; int nx; const bf16_t* TERM;
    __device__ bool next(int i, Unit& u) const {
        const long L = (long)i * so.G + so.c;
        if (L < so.nwg) return so.next(i, u);
        const int e = (int)(L - so.nwg); if (e >= nx) return false;
        const int t = e >> 4; u.pm = 64 + (t >> 2); u.pn = t & 3; u.r = e & 15; u.kind = 3; return true;
    }
    __device__ __forceinline__ void src(const Gemm& g, const Unit& u, const char*& pa, const char*& pb, const char*& pb1, int& nt) const {
        pa = (const char*)g.A + (size_t)u.pm * (2 * HALF) * g.lda * 2; pb = (const char*)g.Bt + (size_t)u.pn * (2 * HALF) * g.ldb * 2; nt = g.K / BK;
        if (u.kind == 3) { const int br = u.r >> 2, kq = u.r & 3; pa = (const char*)(TERM + ((size_t)br * 512 + (u.pm - 64) * 256) * 1024 + kq * 256); pb += (size_t)kq * 256 * 2; nt = 4; }
        pb1 = pb + (size_t)HALF * g.ldb * 2;
    }
};

template <class Epi, class Sched, bool ALIGN_EPI, bool RELAX = false>
__device__ __forceinline__ void gemm_phase(PG8_LAS unsigned char* lds, const Gemm g, const Sched& S, const Epi& E) {
    int tid = threadIdx.x; asm volatile("" : "+v"(tid));
    const int wid = __builtin_amdgcn_readfirstlane(tid >> 6), lane = tid & 63, wr = wid >> 2, wc = wid & 3, fr = lane & 15, fq = lane >> 4;
    int nt;
    unsigned voffA[2], voffB[2];
#pragma unroll
    for (int i = 0; i < 2; ++i) { int R, C; stage_rc(tid * 16 + i * 8192, R, C); const int Rb = Epi::PERM ? ((R & ~31) + perm32(R & 31)) : R;
        voffA[i] = (unsigned)(R * g.lda + C) * 2u; voffB[i] = (unsigned)(Rb * g.ldb + C) * 2u; }
    const size_t kstep = (size_t)(BK * 2);
    const size_t hstepA = (size_t)HALF * g.lda * 2;
    const unsigned ldsw = (unsigned)wid * 1024u;
    const int aoff = lds_byte(wr * 64 + fr, fq * 8), boff = lds_byte(wc * 32 + fr, fq * 8);
#define PG8_SA(b, h) (((b) * 2 + (h)) * HTB)
#define PG8_SB(b, h) ((4 + (b) * 2 + (h)) * HTB)
#define PG8_STAGE(bufoff, gbase, voff) do { _Pragma("unroll") for (int _i = 0; _i < 2; ++_i) { unsigned vo_ = (voff)[_i]; asm volatile("" : "+v"(vo_));        \
        __builtin_amdgcn_global_load_lds((const unsigned*)((const char*)(gbase) + vo_), (PG8_LAS unsigned*)(lds + (bufoff) + ldsw + _i * 8192), 16, 0, 0); } } while (0)
#define PG8_LDA(dst, b, h) do { _Pragma("unroll") for (int m = 0; m < 4; ++m) _Pragma("unroll") for (int k = 0; k < 2; ++k) dst[m][k] = *(const PG8_LAS bf16x8*)(lds + PG8_SA(b, h) + aoff + m * 2048 + k * 1024); } while (0)
#define PG8_LDB(dst, b, h) do { _Pragma("unroll") for (int n = 0; n < 2; ++n) _Pragma("unroll") for (int k = 0; k < 2; ++k) dst[n][k] = *(const PG8_LAS bf16x8*)(lds + PG8_SB(b, h) + boff + n * 2048 + k * 1024); } while (0)
#define PG8_MMA(ai, bj, At, Bt) do { __builtin_amdgcn_s_setprio(1); _Pragma("unroll") for (int m = 0; m < 4; ++m) _Pragma("unroll") for (int n = 0; n < 2; ++n) _Pragma("unroll") for (int k = 0; k < 2; ++k) \
        acc[ai][bj][m][n] = __builtin_amdgcn_mfma_f32_16x16x32_bf16(Bt[n][k], At[m][k], acc[ai][bj][m][n], 0, 0, 0); __builtin_amdgcn_s_setprio(0); } while (0)
#define PG8_WAIT_V(n) asm volatile("s_waitcnt vmcnt(" #n ")" ::: "memory")
#define PG8_WAIT_L(n) asm volatile("s_waitcnt lgkmcnt(" #n ")" ::: "memory")
#define PG8_WAIT_VX(rx) asm volatile("s_cmp_eq_u32 %0, 0\n\ts_cbranch_scc1 .Lpg8w8_%=\n\ts_waitcnt vmcnt(%1)\n\ts_branch .Lpg8wd_%=\n.Lpg8w8_%=:\n\ts_waitcnt vmcnt(8)\n.Lpg8wd_%=:" :: "s"(rx), "n"(8 + Epi::NSTORE) : "memory", "scc")
#define PG8_BAR __builtin_amdgcn_s_barrier()
#define PG8_SCHED __builtin_amdgcn_sched_barrier(0)
    Unit cur, nxt; int ui = 0;
    if (!S.next(0, cur)) return;
    f32x4 acc[2][2][4][2];
#pragma unroll
    for (int a = 0; a < 2; ++a)
#pragma unroll
        for (int b = 0; b < 2; ++b)
#pragma unroll
            for (int m = 0; m < 4; ++m)
#pragma unroll
                for (int n = 0; n < 2; ++n) acc[a][b][m][n] = (f32x4){0.f, 0.f, 0.f, 0.f};
    bf16x8 At[4][2], B0[2][2], B1[2][2];
    const char* cA; const char* cB; const char* cB1; S.src(g, cur, cA, cB, cB1, nt);
    PG8_STAGE(PG8_SB(0, 0), cB, voffB); PG8_STAGE(PG8_SB(0, 1), cB1, voffB); PG8_STAGE(PG8_SA(0, 0), cA, voffA); PG8_STAGE(PG8_SA(0, 1), cA + hstepA, voffA);
    if (wr == 1) PG8_BAR;
    PG8_WAIT_V(2); PG8_BAR;
    PG8_STAGE(PG8_SB(1, 0), cB + kstep, voffB); PG8_STAGE(PG8_SA(1, 0), cA + kstep, voffA); PG8_STAGE(PG8_SB(1, 1), cB1 + kstep, voffB);
    PG8_WAIT_V(6); PG8_BAR;
    for (;;) {
        const bool has_next = S.next(ui + 1, nxt);
        const char* nA = cA; const char* nB = cB; const char* nB1 = cB1; int nnt = nt; if (has_next) S.src(g, nxt, nA, nB, nB1, nnt);
        for (int t = 0; t < nt; t += 2) {
            const bool last = (t == nt - 2);
            const char* a1 = cA + (size_t)(t + 1) * kstep;
            const char* a2 = last ? nA : cA + (size_t)(t + 2) * kstep; const char* b2 = last ? nB : cB + (size_t)(t + 2) * kstep;
            const char* a3 = a2 + kstep; const char* b3 = b2 + kstep;
            const char* b2h = last ? nB1 : cB1 + (size_t)(t + 2) * kstep; const char* b3h = b2h + kstep;
            asm volatile("" : "+s"(a1), "+s"(a2), "+s"(a3), "+s"(b2), "+s"(b3), "+s"(b2h), "+s"(b3h));
            const int relax = __builtin_amdgcn_readfirstlane((RELAX && Epi::NSTORE > 0 && t == 0 && ui > 0) ? 1 : 0);
            PG8_LDB(B0, 0, 0); PG8_LDB(B1, 0, 1); PG8_SCHED; PG8_LDA(At, 0, 0); PG8_STAGE(PG8_SA(1, 1), a1 + hstepA, voffA);
            PG8_WAIT_VX(relax); PG8_WAIT_L(0); PG8_BAR; PG8_MMA(0, 0, At, B0); PG8_MMA(0, 1, At, B1); PG8_BAR; PG8_SCHED;
            PG8_LDA(At, 0, 1); PG8_STAGE(PG8_SB(0, 0), b2, voffB); PG8_STAGE(PG8_SB(0, 1), b2h, voffB); PG8_STAGE(PG8_SA(0, 0), a2, voffA);
            PG8_WAIT_VX(relax); PG8_WAIT_L(0); PG8_BAR; PG8_MMA(1, 0, At, B0); PG8_MMA(1, 1, At, B1); PG8_BAR; PG8_SCHED;
            PG8_LDB(B0, 1, 0); PG8_LDB(B1, 1, 1); PG8_SCHED; PG8_LDA(At, 1, 0); PG8_STAGE(PG8_SA(0, 1), a2 + hstepA, voffA);
            PG8_WAIT_V(8); PG8_WAIT_L(0); PG8_BAR; PG8_MMA(0, 0, At, B0); PG8_MMA(0, 1, At, B1); PG8_BAR; PG8_SCHED;
            PG8_LDA(At, 1, 1); PG8_STAGE(PG8_SB(1, 0), b3, voffB); PG8_STAGE(PG8_SB(1, 1), b3h, voffB); PG8_STAGE(PG8_SA(1, 0), a3, voffA);
            PG8_WAIT_V(8); PG8_WAIT_L(0); PG8_BAR; PG8_MMA(1, 0, At, B0); PG8_MMA(1, 1, At, B1); PG8_BAR; PG8_SCHED;
        }
        if constexpr (ALIGN_EPI) { if (wr == 0) PG8_BAR; }
        E(acc, cur, wr, wc, fr, fq);
        if (!has_next) break;
#pragma unroll
        for (int a = 0; a < 2; ++a)
#pragma unroll
            for (int b = 0; b < 2; ++b)
#pragma unroll
                for (int m = 0; m < 4; ++m)
#pragma unroll
                    for (int n = 0; n < 2; ++n) acc[a][b][m][n] = (f32x4){0.f, 0.f, 0.f, 0.f};
        cur = nxt; cA = nA; cB = nB; cB1 = nB1; nt = nnt; ++ui;
        if constexpr (ALIGN_EPI) { if (wr == 1) PG8_BAR; }
    }
    PG8_WAIT_V(0);
    if constexpr (!ALIGN_EPI) { if (wr == 0) PG8_BAR; }
    PG8_BAR;
#undef PG8_SA
#undef PG8_SB
#undef PG8_STAGE
#undef PG8_LDA
#undef PG8_LDB
#undef PG8_MMA
#undef PG8_WAIT_V
#undef PG8_WAIT_L
#undef PG8_WAIT_VX
#undef PG8_BAR
#undef PG8_SCHED
}
}
namespace attn_body {
using bf16=__hip_bfloat16;
using bf16x8=__attribute__((ext_vector_type(8)))short;
using s16x4=__attribute__((ext_vector_type(4)))short;
using f32x16=__attribute__((ext_vector_type(16)))float;
using u32x4=__attribute__((ext_vector_type(4)))unsigned;
using f32x4=__attribute__((ext_vector_type(4)))float;
constexpr int D=64;
constexpr int NW=8,QBLK=32,QB=QBLK*NW,KVBLK=64;
constexpr int PP=2816, YP=1024;
__device__ __forceinline__ int crow(int r,int hi){return (r&3)+8*(r>>2)+4*hi;}
#define SBAR() __builtin_amdgcn_sched_barrier(0)
__device__ __forceinline__ void dmask(f32x16&p0,f32x16&p1,int kb,unsigned lim,int qrel,int hi){
  const float NEG=-INFINITY; const unsigned b0=(unsigned)(kb+4*hi-qrel+128);
  #pragma unroll
  for(int r=0;r<16;++r){const unsigned dd=b0+(unsigned)((r&3)+8*(r>>2)); if(dd>lim)p0[r]=NEG; if(dd+32u>lim)p1[r]=NEG;}
}

constexpr int NSLOT=3, SLOTB=8192;
constexpr int LDS_K=0, LDS_V=NSLOT*SLOTB, LDS_WS=2*NSLOT*SLOTB, LDS_OST=LDS_WS+NW*64*4, LDS_BYTES=LDS_OST+NW*4096;
constexpr float C2=0.125f*1.4426950408889634f;
__device__ __forceinline__ void glds16(const void*gsrc,unsigned lds_dst){unsigned keep;
  asm volatile("s_mov_b32 %0, m0\n\ts_mov_b32 m0, %2\n\ts_nop 0\n\tglobal_load_lds_dwordx4 %1, off\n\ts_mov_b32 m0, %0":"=&s"(keep):"v"(gsrc),"s"(lds_dst):"memory");}
__device__ __forceinline__ float siluf_(float x){ return x*__builtin_amdgcn_rcpf(1.0f+__builtin_amdgcn_exp2f(-1.4426950408889634f*x)); }
__device__ __forceinline__ float max3f(float a,float b,float c){float r;asm("v_max3_f32 %0, %1, %2, %3":"=v"(r):"v"(a),"v"(b),"v"(c));return r;}
__device__ __forceinline__ float max2f(float a,float b){float r;asm("v_max_f32_e32 %0, %1, %2":"=v"(r):"v"(a),"v"(b));return r;}
__device__ __forceinline__ float fadd_s(float a,float b){float r;asm("v_add_f32_e32 %0, %1, %2":"=v"(r):"v"(a),"v"(b));return r;}
__device__ __forceinline__ float fsub_s(float a,float b){float r;asm("v_sub_f32_e32 %0, %1, %2":"=v"(r):"v"(a),"v"(b));return r;}
typedef float f32x2_t __attribute__((ext_vector_type(2))); typedef __bf16 bf16x2_t __attribute__((ext_vector_type(2)));
__device__ __forceinline__ unsigned cvtpk_s(float lo,float hi){f32x2_t v={lo,hi};bf16x2_t b=__builtin_convertvector(v,bf16x2_t);return __builtin_bit_cast(unsigned,b);}
#define WAIT_BAR(N) asm volatile("s_waitcnt vmcnt(" #N ") lgkmcnt(0)\n\ts_barrier":::"memory")

__device__ __forceinline__ void qkt(f32x16&p0,f32x16&p1,const char*Kslot,const bf16x8*qr,const f32x16&negm,int r32,int hi){
  const char*kb=Kslot+hi*1024+r32*16;
  #pragma unroll
  for(int d0=0;d0<4;++d0){
    const bf16x8 b0=*reinterpret_cast<const bf16x8*>(kb+d0*2048);
    const bf16x8 b1=*reinterpret_cast<const bf16x8*>(kb+d0*2048+512);
    if(d0==0){p0=__builtin_amdgcn_mfma_f32_32x32x16_bf16(b0,qr[0],negm,0,0,0);p1=__builtin_amdgcn_mfma_f32_32x32x16_bf16(b1,qr[0],negm,0,0,0);}
    else{p0=__builtin_amdgcn_mfma_f32_32x32x16_bf16(b0,qr[d0],p0,0,0,0);p1=__builtin_amdgcn_mfma_f32_32x32x16_bf16(b1,qr[d0],p1,0,0,0);}}
}
typedef __attribute__((address_space(3))) const char* lds_cptr;
typedef short v4i16_t __attribute__((ext_vector_type(4)));
__device__ __forceinline__ void kload8(bf16x8*kf,lds_cptr kp){
  kf[0]=*(const __attribute__((address_space(3))) bf16x8*)(kp);      kf[1]=*(const __attribute__((address_space(3))) bf16x8*)(kp+512);
  kf[2]=*(const __attribute__((address_space(3))) bf16x8*)(kp+2048); kf[3]=*(const __attribute__((address_space(3))) bf16x8*)(kp+2560);
  kf[4]=*(const __attribute__((address_space(3))) bf16x8*)(kp+4096); kf[5]=*(const __attribute__((address_space(3))) bf16x8*)(kp+4608);
  kf[6]=*(const __attribute__((address_space(3))) bf16x8*)(kp+6144); kf[7]=*(const __attribute__((address_space(3))) bf16x8*)(kp+6656);
}
__device__ __forceinline__ void kload2(bf16x8*kf,lds_cptr kp,int j){ kf[2*j]=*(const __attribute__((address_space(3))) bf16x8*)(kp+j*2048); kf[2*j+1]=*(const __attribute__((address_space(3))) bf16x8*)(kp+j*2048+512); }
__device__ __forceinline__ s16x4 vtr(lds_cptr p){ return __builtin_bit_cast(s16x4,__builtin_amdgcn_ds_read_tr16_b64_v4i16((__attribute__((address_space(3))) v4i16_t*)p)); }
__device__ __forceinline__ float rowmax(const f32x16&p0,const f32x16&p1){
  float a=max3f(p0[0],p0[1],p1[0]),b=max3f(p0[2],p0[3],p1[1]);a=max3f(a,p1[2],p1[3]);
  #pragma unroll
  for(int r=4;r<16;r+=4){a=max3f(a,p0[r],p0[r+1]);b=max3f(b,p0[r+2],p0[r+3]);a=max3f(a,p1[r],p1[r+1]);b=max3f(b,p1[r+2],p1[r+3]);}
  const float m=max2f(a,b);
  auto rr=__builtin_amdgcn_permlane32_swap(__float_as_uint(m),__float_as_uint(m),false,false);
  return max2f(__uint_as_float(rr[0]),__uint_as_float(rr[1]));
}
__device__ __forceinline__ void pv(f32x16*o,int vb,bf16x8 pa0,bf16x8 pa1,bf16x8 pa2,bf16x8 pa3){
  #pragma unroll
  for(int d0=0;d0<2;++d0){s16x4 lo[4],hi[4];
    #pragma unroll
    for(int ks=0;ks<4;++ks){
      asm volatile("ds_read_b64_tr_b16 %0,%1 offset:%c2":"=&v"(lo[ks]):"v"(vb),"i"(d0*4096+ks*1024):"memory");
      asm volatile("ds_read_b64_tr_b16 %0,%1 offset:%c2":"=&v"(hi[ks]):"v"(vb),"i"(d0*4096+ks*1024+512):"memory");}
    asm volatile("s_waitcnt lgkmcnt(0)":::"memory");SBAR();
    #define PK(k) (bf16x8){lo[k][0],lo[k][1],lo[k][2],lo[k][3],hi[k][0],hi[k][1],hi[k][2],hi[k][3]}
    o[d0]=__builtin_amdgcn_mfma_f32_32x32x16_bf16(pa0,PK(0),o[d0],0,0,0);
    o[d0]=__builtin_amdgcn_mfma_f32_32x32x16_bf16(pa1,PK(1),o[d0],0,0,0);
    o[d0]=__builtin_amdgcn_mfma_f32_32x32x16_bf16(pa2,PK(2),o[d0],0,0,0);
    o[d0]=__builtin_amdgcn_mfma_f32_32x32x16_bf16(pa3,PK(3),o[d0],0,0,0);
    #undef PK
  }
}

#ifndef ATTN_STORE16
#define ATTN_STORE16(p,v) (*(u32x4*)(p)=(v))
#endif
template<int MODE,int THRL> __device__ __forceinline__ void attn_unit(const bf16*Pm,bf16*YB,int qrow0,int ctx0,int lat0,int off,int NT,int wq0,int qcol,int kcol,int vcol,int zcol,int ocol,float sinkl2,char*shm,const float*qw,int rope){
  int tid_=threadIdx.x; asm volatile("":"+v"(tid_)); const int tid=tid_,lane=tid&63,r32=lane&31,hi=lane>>5; const int wid=__builtin_amdgcn_readfirstlane(tid>>6);
  const bf16*Qw=Pm+(long)(qrow0+wid*QBLK)*PP+qcol;
  const unsigned lds0=(unsigned)(uintptr_t)shm;
  float*wsf=(float*)(shm+LDS_WS)+wid*64;
  const bf16*ksrc=Pm+kcol+(long)lane*PP+wid*8;
  const bf16*vsrc=Pm+vcol+(long)(16*(wid&3)+(lane>>2))*PP+(wid>>2)*32+(lane&3)*8;
  const unsigned kdst=lds0+LDS_K+wid*1024, vdst=lds0+LDS_V+wid*1024;
  #define TROW(t) (((t)<4)?(ctx0+64*(t)):(lat0+64*((t)-4+off)))
  #define DMA_K(t,slot) glds16(ksrc+(long)TROW(t)*PP,(unsigned)__builtin_amdgcn_readfirstlane(kdst+(slot)))
  #define DMA_V(t,slot) glds16(vsrc+(long)TROW(t)*PP,(unsigned)__builtin_amdgcn_readfirstlane(vdst+(slot)))
  const int vb0=(int)(lds0+LDS_V)+((lane>>4)&1)*32+(lane&3)*8+(4*hi+((lane&15)>>2))*64;
  const char*Kbase=shm+LDS_K; bf16x8 kf[8];
  const lds_cptr shm3=(lds_cptr)shm; const lds_cptr kp0=shm3+LDS_K+hi*1024+r32*16; const lds_cptr vp0=shm3+LDS_V+((lane>>4)&1)*32+(lane&3)*8+(4*hi+((lane&15)>>2))*64;
  DMA_K(0,0);DMA_V(0,0);DMA_K(1,SLOTB);
  bf16x8 qr[4];
  { bf16x8 qraw[4];
    #pragma unroll
    for(int d0=0;d0<4;++d0)qraw[d0]=*reinterpret_cast<const bf16x8*>(&Qw[(long)r32*PP+d0*16+hi*8]);
    f32x4 wq[4][2];
    #pragma unroll
    for(int d0=0;d0<4;++d0){wq[d0][0]=*reinterpret_cast<const f32x4*>(qw+16*d0+8*hi);wq[d0][1]=*reinterpret_cast<const f32x4*>(qw+16*d0+8*hi+4);}
    float ss=0.f;
    #pragma unroll
    for(int d0=0;d0<4;++d0)
      #pragma unroll
      for(int j=0;j<8;++j){const float f=__uint_as_float(((unsigned)(unsigned short)qraw[d0][j])<<16);ss+=f*f;}
    {auto rr=__builtin_amdgcn_permlane32_swap(__float_as_uint(ss),__float_as_uint(ss),false,false);ss=__uint_as_float(rr[0])+__uint_as_float(rr[1]);}
    const float rs=__builtin_amdgcn_rsqf(ss*(1.0f/64.0f)+1e-6f)*C2;
    const int ntok=(qrow0+wid*QBLK+r32)&8191;
    #pragma unroll
    for(int hf=0;hf<2;++hf){ const float pos=(float)(hf?(ntok&63):(ntok>>6)); unsigned pk1[4],pk2[4];
      #pragma unroll
      for(int jp=0;jp<4;++jp){ float y1[2],y2[2];
        #pragma unroll
        for(int e=0;e<2;++e){ const int j=2*jp+e; const int fi=8*hi+j;
          const float inv=__builtin_amdgcn_exp2f(-(float)fi*(13.287712379549449f/16.0f))*0.15915494309189535f;
          const float rev=pos*inv; const float cs=rope?__builtin_amdgcn_cosf(rev):1.0f, sn=rope?__builtin_amdgcn_sinf(rev):0.0f;
          const float x1=__uint_as_float(((unsigned)(unsigned short)qraw[2*hf][j])<<16)*rs*wq[2*hf][j>>2][j&3];
          const float x2=__uint_as_float(((unsigned)(unsigned short)qraw[2*hf+1][j])<<16)*rs*wq[2*hf+1][j>>2][j&3];
          y1[e]=x1*cs-x2*sn; y2[e]=x1*sn+x2*cs; }
        pk1[jp]=cvtpk_s(y1[0],y1[1]); pk2[jp]=cvtpk_s(y2[0],y2[1]); }
      qr[2*hf]=__builtin_bit_cast(bf16x8,(u32x4){pk1[0],pk1[1],pk1[2],pk1[3]}); qr[2*hf+1]=__builtin_bit_cast(bf16x8,(u32x4){pk2[0],pk2[1],pk2[2],pk2[3]}); } }
  float mhat=0.f,l_reg=0.f;f32x16 o[2];o[0]=f32x16{};o[1]=f32x16{};f32x16 negm=f32x16{}; if(MODE==0){asm volatile("":"+v"(negm));}
  const int qrel=wid*QBLK+r32;
  #define CMASK(P0,P1,t) do{ if(MODE==1){ if((t)>=4){ const int kb_=64*((t)-4)-wq0, dlo_=kb_-32*wid-31, dhi_=kb_+63-32*wid; if(dlo_<-128||dhi_>128) dmask(P0,P1,kb_,256u,qrel,hi); } } }while(0)
  bool resc=false;
  #define START(P0,P1) do{ const float rm=rowmax(P0,P1); resc=false; \
    { const float dl=rm; mhat=fadd_s(mhat,dl); \
      _Pragma("unroll") for(int r=0;r<16;++r){P0[r]=fsub_s(P0[r],dl);P1[r]=fsub_s(P1[r],dl);} \
      if(MODE==0){ _Pragma("unroll") for(int r=0;r<16;++r)negm[r]=-mhat; asm volatile("":"+v"(negm)); } } \
    _Pragma("unroll") for(int r=0;r<16;++r)P0[r]=__builtin_amdgcn_exp2f(P0[r]); }while(0)
  #define RESC() do{ if(resc){ asm volatile("s_waitcnt lgkmcnt(0)":::"memory"); \
      _Pragma("unroll") for(int d_=0;d_<2;++d_) _Pragma("unroll") for(int r=0;r<16;++r)o[d_][r]*=wsf[crow(r,hi)]; } }while(0)
  f32x16 pA0,pA1,pB0,pB1;
  int sl_prev=0,sl_cur=0,sl_next=SLOTB;
  #define ROT() do{sl_prev=sl_cur;sl_cur=sl_next;sl_next=(sl_next==(NSLOT-1)*SLOTB)?0:sl_next+SLOTB;}while(0)
  DMA_K(2,2*SLOTB);
  WAIT_BAR(3);
  qkt(pA0,pA1,Kbase,qr,negm,r32,hi);asm volatile("s_nop 15\n\ts_nop 7":"+v"(pA0),"+v"(pA1));CMASK(pA0,pA1,0);
  START(pA0,pA1);
  _Pragma("unroll") for(int r=0;r<16;++r)pA1[r]=__builtin_amdgcn_exp2f(pA1[r]);
  WAIT_BAR(0);
  DMA_K(3,0);DMA_V(1,SLOTB);
  ROT();
  kload8(kf,kp0+sl_cur);
  WAIT_BAR(2);
  s16x4 vlo[8],vhi[8]; u32x4 pw0,pw1,pw2,pw3;
  #define PKW(P,B) cvtpk_s(P[B],P[B+1])
  #define PAF(k) __builtin_bit_cast(bf16x8,pw##k)
  #define VFR(i) (bf16x8){vlo[i][0],vlo[i][1],vlo[i][2],vlo[i][3],vhi[i][0],vhi[i][1],vhi[i][2],vhi[i][3]}
  #define PIN(x) asm volatile("":"+v"(x))
  #define MX3(a,b,c) __builtin_fmaxf(__builtin_fmaxf((a),(b)),(c))
  #define GAPA(MF,A0,A1,A2,A3,W0,W1,PW) do{ MF; sacc+=A0; sacc+=A1; sacc+=A2; sacc+=A3; PIN(sacc); W0; W1; PIN(PW); SBAR(); }while(0)
  #define EX(v) __builtin_amdgcn_exp2f(v)
  #define GAPB(MF,X,B) do{ MF; X[B]=EX(X[B]); X[B+1]=EX(X[B+1]); X[B+2]=EX(X[B+2]); X[B+3]=EX(X[B+3]); PIN(X); SBAR(); }while(0)
  #define VRD(i) do{ vlo[i]=vtr(vp_+(((i)>>2)*4096+((i)&3)*1024)); vhi[i]=vtr(vp_+(((i)>>2)*4096+((i)&3)*1024+512)); }while(0)
  #define KRD(G,j) do{ if(G){ kload2(kf,kp0+sl_next,j); SBAR(); } }while(0)
  #define STEP(C0,C1,P0,P1,t,GK,GV,GL,MX) do{ SBAR(); \
    const lds_cptr vp_=vp0+sl_prev; \
    VRD(0); SBAR(); float sacc=(P0[0]+P0[1]); \
    GAPA(C0=__builtin_amdgcn_mfma_f32_32x32x16_bf16(kf[0],qr[0],negm,0,0,0), P0[2],P0[3],P0[4],P0[5],     pw0[0]=PKW(P0,0), pw0[1]=PKW(P0,2), pw0); \
    VRD(4); SBAR(); GAPA(C1=__builtin_amdgcn_mfma_f32_32x32x16_bf16(kf[1],qr[0],negm,0,0,0), P0[6],P0[7],P0[8],P0[9],     pw0[2]=PKW(P0,4), pw0[3]=PKW(P0,6), pw0); \
    VRD(1); SBAR(); GAPA(C0=__builtin_amdgcn_mfma_f32_32x32x16_bf16(kf[2],qr[1],C0,0,0,0),   P0[10],P0[11],P0[12],P0[13], pw1[0]=PKW(P0,8), pw1[1]=PKW(P0,10), pw1); \
    VRD(5); SBAR(); GAPA(C1=__builtin_amdgcn_mfma_f32_32x32x16_bf16(kf[3],qr[1],C1,0,0,0),   P0[14],P0[15],P1[0],P1[1],   pw1[2]=PKW(P0,12),pw1[3]=PKW(P0,14), pw1); \
    VRD(2); SBAR(); GAPA(C0=__builtin_amdgcn_mfma_f32_32x32x16_bf16(kf[4],qr[2],C0,0,0,0),   P1[2],P1[3],P1[4],P1[5],     pw2[0]=PKW(P1,0), pw2[1]=PKW(P1,2), pw2); \
    VRD(6); SBAR(); GAPA(C1=__builtin_amdgcn_mfma_f32_32x32x16_bf16(kf[5],qr[2],C1,0,0,0),   P1[6],P1[7],P1[8],P1[9],     pw2[2]=PKW(P1,4), pw2[3]=PKW(P1,6), pw2); \
    VRD(3); SBAR(); GAPA(C0=__builtin_amdgcn_mfma_f32_32x32x16_bf16(kf[6],qr[3],C0,0,0,0),   P1[10],P1[11],P1[12],P1[13], pw3[0]=PKW(P1,8), pw3[1]=PKW(P1,10), pw3); \
    VRD(7); SBAR(); GAPA(C1=__builtin_amdgcn_mfma_f32_32x32x16_bf16(kf[7],qr[3],C1,0,0,0),   P1[14],P1[15],0.f,0.f,       pw3[2]=PKW(P1,12),pw3[3]=PKW(P1,14), pw3); \
    l_reg+=sacc; \
    if(GK){DMA_K((t)+3,sl_cur);} if(GV){DMA_V((t)+1,sl_next);} \
    CMASK(C0,C1,t); \
    resc=false; if(MX){ float a=MX3(C0[0],C0[1],C1[0]),b=MX3(C0[2],C0[3],C1[1]); a=MX3(a,C1[2],C1[3]); \
      _Pragma("unroll") for(int r=4;r<16;r+=4){a=MX3(a,C0[r],C0[r+1]);b=MX3(b,C0[r+2],C0[r+3]);a=MX3(a,C1[r],C1[r+1]);b=MX3(b,C1[r+2],C1[r+3]);} \
      float rm=__builtin_fmaxf(a,b); { auto rr=__builtin_amdgcn_permlane32_swap(__float_as_uint(rm),__float_as_uint(rm),false,false); rm=__builtin_fmaxf(__uint_as_float(rr[0]),__uint_as_float(rr[1])); } \
      resc=false; if(MODE==1) rm-=mhat; \
      if(__builtin_expect(__any(rm>(float)THRL),0)){ const float dl=__builtin_fmaxf(rm,0.f); mhat+=dl; \
        if(MODE==0){ _Pragma("unroll") for(int r=0;r<16;++r){C0[r]-=dl;C1[r]-=dl;} \
          _Pragma("unroll") for(int r=0;r<16;++r)negm[r]=-mhat; asm volatile("":"+v"(negm)); } \
        const float f=__builtin_amdgcn_exp2f(-dl); l_reg*=f; if(hi==0)wsf[r32]=f; resc=true; } \
      if(MODE==1){ _Pragma("unroll") for(int r=0;r<16;++r){C0[r]-=mhat;C1[r]-=mhat;} } } \
    SBAR(); \
    GAPB(o[0]=__builtin_amdgcn_mfma_f32_32x32x16_bf16(PAF(0),VFR(0),o[0],0,0,0), C0,0); \
    GAPB(o[1]=__builtin_amdgcn_mfma_f32_32x32x16_bf16(PAF(0),VFR(4),o[1],0,0,0), C0,4); \
    KRD(GL,0); GAPB(o[0]=__builtin_amdgcn_mfma_f32_32x32x16_bf16(PAF(1),VFR(1),o[0],0,0,0), C0,8); \
    KRD(GL,1); GAPB(o[1]=__builtin_amdgcn_mfma_f32_32x32x16_bf16(PAF(1),VFR(5),o[1],0,0,0), C0,12); \
    KRD(GL,2); GAPB(o[0]=__builtin_amdgcn_mfma_f32_32x32x16_bf16(PAF(2),VFR(2),o[0],0,0,0), C1,0); \
    KRD(GL,3); GAPB(o[1]=__builtin_amdgcn_mfma_f32_32x32x16_bf16(PAF(2),VFR(6),o[1],0,0,0), C1,4); \
    GAPB(o[0]=__builtin_amdgcn_mfma_f32_32x32x16_bf16(PAF(3),VFR(3),o[0],0,0,0), C1,8); \
    GAPB(o[1]=__builtin_amdgcn_mfma_f32_32x32x16_bf16(PAF(3),VFR(7),o[1],0,0,0), C1,12); \
    }while(0)
  int t=1;
  if(MODE==0) for(;t+7<NT;t+=4){
    STEP(pB0,pB1,pA0,pA1,t,true,true,true,true);      WAIT_BAR(2); RESC(); ROT();
    STEP(pA0,pA1,pB0,pB1,t+1,true,true,true,false);   WAIT_BAR(2); RESC(); ROT();
    STEP(pB0,pB1,pA0,pA1,t+2,true,true,true,false);   WAIT_BAR(2); RESC(); ROT();
    STEP(pA0,pA1,pB0,pB1,t+3,true,true,true,false);   WAIT_BAR(2); RESC(); ROT();
  }
  if(MODE==0) for(;t+5<NT;t+=2){
    STEP(pB0,pB1,pA0,pA1,t,true,true,true,true);     WAIT_BAR(2); RESC(); ROT();
    STEP(pA0,pA1,pB0,pB1,t+1,true,true,true,false);   WAIT_BAR(2); RESC(); ROT();
  }
  #define ENDW(tt) do{ if((tt)+3<NT){WAIT_BAR(2);} else if((tt)+2<NT){WAIT_BAR(1);} else {WAIT_BAR(0);} }while(0)
  for(;t+1<NT;t+=2){
    STEP(pB0,pB1,pA0,pA1,t,(t+3<NT),(t+1<NT),(t+1<NT),true);       ENDW(t);   RESC(); ROT();
    STEP(pA0,pA1,pB0,pB1,t+1,(t+4<NT),(t+2<NT),(t+2<NT),true);     ENDW(t+1); RESC(); ROT();
  }
  STEP(pB0,pB1,pA0,pA1,NT-1,false,false,false,true); RESC();
  { float sacc=pB0[0]+pB0[1]; _Pragma("unroll") for(int r=2;r<16;++r)sacc+=pB0[r]; _Pragma("unroll") for(int r=0;r<16;++r)sacc+=pB1[r]; l_reg+=sacc;
    pw0=(u32x4){PKW(pB0,0),PKW(pB0,2),PKW(pB0,4),PKW(pB0,6)};pw1=(u32x4){PKW(pB0,8),PKW(pB0,10),PKW(pB0,12),PKW(pB0,14)};pw2=(u32x4){PKW(pB1,0),PKW(pB1,2),PKW(pB1,4),PKW(pB1,6)};pw3=(u32x4){PKW(pB1,8),PKW(pB1,10),PKW(pB1,12),PKW(pB1,14)};
    SBAR(); pv(o,vb0+sl_cur,PAF(0),PAF(1),PAF(2),PAF(3)); }
  #undef PKW
  #undef PAF
  #undef VFR
  #undef PIN
  #undef MX3
  #undef GAPA
  #undef GAPB
  #undef EX
  #undef VRD
  #undef KRD
  #undef STEP
  #undef ENDW
  {auto rr=__builtin_amdgcn_permlane32_swap(__float_as_uint(l_reg),__float_as_uint(l_reg),false,false);l_reg=__uint_as_float(rr[0])+__uint_as_float(rr[1]);}
  if(MODE==1){ l_reg+=__builtin_amdgcn_exp2f(sinkl2-mhat); }
  if(hi==0)wsf[32+r32]=l_reg;asm volatile("s_waitcnt lgkmcnt(0)":::"memory");
  float rli[16];
  #pragma unroll
  for(int r=0;r<16;++r)rli[r]=__builtin_amdgcn_rcpf(wsf[32+crow(r,hi)]);
  bf16*Ow=YB+(long)(qrow0+wid*QBLK)*YP+ocol; const bf16*Zw=Pm+(long)(qrow0+wid*QBLK)*PP+zcol;
  { bf16*stg=(bf16*)(shm+LDS_OST)+wid*2048;
    #pragma unroll
    for(int r=0;r<16;++r){const int orow=crow(r,hi);
      #pragma unroll
      for(int d0=0;d0<2;++d0)stg[orow*64+d0*32+r32]=__float2bfloat16(o[d0][r]*rli[r]);}
    asm volatile("s_waitcnt lgkmcnt(0)":::"memory");
    #pragma unroll
    for(int i=0;i<4;++i){const int row=i*8+(lane>>3),ch=lane&7; const u32x4 v=*(const u32x4*)(stg+row*64+ch*8); const u32x4 z=*(const u32x4*)(Zw+(long)row*PP+ch*8); u32x4 w;
      #define GATE2(vv,zz) cvtpk_s(__uint_as_float((vv)<<16)*siluf_(__uint_as_float((zz)<<16)),__uint_as_float((vv)&0xffff0000u)*siluf_(__uint_as_float((zz)&0xffff0000u)))
      w.x=GATE2(v.x,z.x); w.y=GATE2(v.y,z.y); w.z=GATE2(v.z,z.z); w.w=GATE2(v.w,z.w);
      #undef GATE2
      *(u32x4*)(Ow+(long)row*YP+ch*8)=w;} }
  asm volatile("s_waitcnt lgkmcnt(0)\n\ts_barrier":::"memory");
  #undef DMA_K
  #undef DMA_V
  #undef CMASK
  #undef START
  #undef RESC
  #undef ROT
  #undef TROW
}
#undef SBAR
#undef WAIT_BAR
}

constexpr int NWAVES = 8;
constexpr int DM = 1024, SEQ = 8192, NCTX = 256, NB = 2;
constexpr int M_LAT = NB * SEQ, M_CTX = NB * NCTX, M_ALL = M_LAT + M_CTX;
constexpr int PW = 2816;
constexpr float RMS_EPS = 1e-6f;
#ifndef WPITCH
#define WPITCH 1024
#endif
constexpr float QSCALE = 0.125f * 1.4426950408889634f;
constexpr int C_AQ = 0, C_AK = 256, C_AV = 384, C_AZ = 512, C_DQ = 768, C_DK = 1024, C_DV = 1152, C_DZ = 1280, C_BF = 1536, C_BZ = 1792, C_CU = 2048, C_CV = 2304, C_CZ = 2560;

constexpr size_t MiB = 1u << 20;
constexpr size_t WS_CTL = 0, CTL_ZERO_BYTES = 1 * MiB;
constexpr size_t WS_MOD = 1 * MiB;
constexpr size_t WS_TAB = 2 * MiB;
constexpr size_t TAB_MA = 0, TAB_128 = 131072, TAB_64 = 229376, TAB_256 = 245760, TAB_WSP = 507904, TAB_ONES = 786432, TAB_BIASB = 1048576;
constexpr size_t WS_WIN = 4 * MiB, WS_WM = 16 * MiB, WS_WBR = 32 * MiB, WS_WOUT = 36 * MiB;
constexpr size_t WS_XC1 = 40 * MiB;
constexpr size_t WS_H = 42 * MiB, WS_YB = 75 * MiB, WS_T1 = 108 * MiB, WS_P = 124 * MiB;
constexpr size_t WS_GT = WS_P, WS_MG = WS_P + 40 * MiB;
constexpr size_t WS_MGC = 216 * MiB;
constexpr size_t WS_GTC = 218 * MiB;
constexpr size_t WS_GT2 = 222 * MiB;
constexpr size_t WS_END = 254 * MiB;
constexpr int CW_BAR = 4096;

constexpr int RING_BYTES = 147456, LDSCTL_OFF = RING_BYTES, MISC_OFF = LDSCTL_OFF + 320, LDS_BYTES = RING_BYTES + 1024;

#define GAS __attribute__((address_space(1)))
#define LAS __attribute__((address_space(3)))
typedef unsigned short bf16;
typedef unsigned v4u __attribute__((ext_vector_type(4)));
typedef unsigned v2u __attribute__((ext_vector_type(2)));
typedef float f32x4 __attribute__((ext_vector_type(4)));
typedef float f32x16 __attribute__((ext_vector_type(16)));
typedef short bf16x8 __attribute__((ext_vector_type(8)));
typedef GAS unsigned gu32;
#define RLX_AGENT __ATOMIC_RELAXED, __HIP_MEMORY_SCOPE_AGENT
#define LDS_WAIT() asm volatile("s_waitcnt lgkmcnt(0)" ::: "memory")
#define MFMA32(a, b, c) __builtin_amdgcn_mfma_f32_32x32x16_bf16((a), (b), (c), 0, 0, 0)
#define DI __device__ __forceinline__
DI unsigned f2bf(float f) { unsigned u = __builtin_bit_cast(unsigned, f); return (u + 0x7fffu + ((u >> 16) & 1u)) >> 16; }
DI unsigned pk2(float lo, float hi) { return f2bf(lo) | (f2bf(hi) << 16); }
DI float bf2f(bf16 v) { return __uint_as_float((unsigned)v << 16); }
DI float wlo(unsigned w) { return __uint_as_float(w << 16); }
DI float whi(unsigned w) { return __uint_as_float(w & 0xffff0000u); }
DI int crow(int reg, int h) { return (reg & 3) + 8 * (reg >> 2) + 4 * h; }
DI int krow(int s, int h, int j) { return 16 * s + 8 * (j >> 2) + 4 * h + (j & 3); }
DI float siluf(float x) { return x * __builtin_amdgcn_rcpf(1.0f + __builtin_amdgcn_exp2f(-1.4426950408889634f * x)); }
DI float geluf(float v) {
    const float av = __builtin_fabsf(v), d = av * 0.2316418882f + 1.0f, t = __builtin_amdgcn_rcpf(d);
    float q = t * 0.5307027145f + (-0.7265760135f); q = q * t + 0.7107068705f; q = q * t + (-0.142248368f); q = q * t + 0.127414796f; q = q * t;
    const float e = __builtin_amdgcn_exp2f((v * v) * (-0.72134752044f)), m = v * (q * e), r = v - m;
    return v < 0.f ? m : r;
}
typedef float f32x2_t __attribute__((ext_vector_type(2))); typedef __bf16 bf16x2_t __attribute__((ext_vector_type(2)));
DI unsigned cvtpk(float lo, float hi) { f32x2_t v = {lo, hi}; bf16x2_t b = __builtin_convertvector(v, bf16x2_t); return __builtin_bit_cast(unsigned, b); }
DI bf16x8 pack_step(const f32x16& x, int s) {
    v4u p; p.x = cvtpk(x[8 * s], x[8 * s + 1]); p.y = cvtpk(x[8 * s + 2], x[8 * s + 3]); p.z = cvtpk(x[8 * s + 4], x[8 * s + 5]); p.w = cvtpk(x[8 * s + 6], x[8 * s + 7]);
    return __builtin_bit_cast(bf16x8, p);
}
DI float shx(float v, int o, int lane) { return __int_as_float(__builtin_amdgcn_ds_bpermute((lane ^ o) << 2, __float_as_int(v))); }
DI float wave_sum(float v, int lane) {
#pragma unroll
    for (int o = 1; o < 64; o <<= 1) v += shx(v, o, lane);
    return v;
}

#define XB_TMO      128
#define XB_XCNT(j)  (256  + 64 * (j))
#define XB_XSUB(j)  (1280 + 64 * (j))
#define XB_XGEN(j)  (2304 + 64 * (j))
#define XB_TOP      3328
#define XB_TOPGEN   3392
#define XCD_BAR_WORDS 3456
#define XB_SPIN_CAP (1u << 22)
DI unsigned xb_ld(unsigned* p)              { return __hip_atomic_load(p, __ATOMIC_RELAXED, __HIP_MEMORY_SCOPE_AGENT); }
DI unsigned xb_add(unsigned* p, unsigned v) { return __hip_atomic_fetch_add(p, v, __ATOMIC_RELAXED, __HIP_MEMORY_SCOPE_AGENT); }
DI unsigned xb_xcc_id() { return (unsigned)__builtin_amdgcn_s_getreg((3 << 11) | 20) & 0xFu; }
#define XB_SPIN(cond, bar) do { unsigned _sp = 0; while (cond) { __builtin_amdgcn_s_sleep(1); \
    if ((++_sp & 255u) == 0u) { if (xb_ld(&(bar)[XB_TMO])) break; if (_sp > XB_SPIN_CAP) { atomicAdd(&(bar)[XB_TMO], 1u); break; } } } } while (0)
struct XcdBarrier { unsigned* bar; unsigned x; volatile LAS unsigned* st; };
DI XcdBarrier xcd_barrier_post(unsigned* bar, volatile LAS unsigned* st) {
    XcdBarrier b; b.bar = bar; b.x = xb_xcc_id(); b.st = st;
    if (threadIdx.x == 0) (void)xb_add(&bar[XB_XCNT(b.x)], 1u);
    return b;
}
DI void xcd_barrier_complete(unsigned* bar, unsigned x, unsigned& nloc, unsigned& nx) {
    const unsigned G = gridDim.x * gridDim.y * gridDim.z;
    unsigned sum, cnt, mine, sp = 0u;
    for (;;) {
        sum = 0u; cnt = 0u; mine = 0u;
#pragma unroll
        for (unsigned j = 0; j < 16; ++j) { const unsigned c = xb_ld(&bar[XB_XCNT(j)]); sum += c; cnt += (c > 0u) ? 1u : 0u; mine = (j == x) ? c : mine; }
        if (sum == G) break;
        __builtin_amdgcn_s_sleep(1);
        if ((++sp & 255u) == 0u) { if (xb_ld(&bar[XB_TMO])) break; if (sp > XB_SPIN_CAP) { atomicAdd(&bar[XB_TMO], 1u); break; } }
    }
    nloc = mine > 0u ? mine : 1u; nx = cnt > 0u ? cnt : 1u;
}
DI void xcd_barrier(const XcdBarrier& b) {
    asm volatile("s_waitcnt vmcnt(0)" ::: "memory");
    __syncthreads();
    if (threadIdx.x == 0) {
        unsigned* bar = b.bar;
        __builtin_amdgcn_s_waitcnt(0);
        __builtin_amdgcn_fence(__ATOMIC_ACQUIRE, "agent");
        unsigned nloc = b.st[0], nx = b.st[1];
        if (nloc == 0u) { xcd_barrier_complete(bar, b.x, nloc, nx); b.st[0] = nloc; b.st[1] = nx; }
        const unsigned old = xb_add(&bar[XB_XSUB(b.x)], 1u);
        const unsigned gen = old / nloc;
        if (old + 1u == (gen + 1u) * nloc) {
            __builtin_amdgcn_fence(__ATOMIC_RELEASE, "agent");
            asm volatile("s_waitcnt vmcnt(0)" ::: "memory");
            const unsigned og = xb_add(&bar[XB_TOP], 1u);
            const unsigned tg = og / nx;
            if (og + 1u == (tg + 1u) * nx) xb_add(&bar[XB_TOPGEN], 1u);
            else XB_SPIN(xb_ld(&bar[XB_TOPGEN]) == tg, bar);
            xb_add(&bar[XB_XGEN(b.x)], 1u);
            asm volatile("s_waitcnt vmcnt(0)" ::: "memory");
        } else {
            XB_SPIN(xb_ld(&bar[XB_XGEN(b.x)]) == gen, bar);
            asm volatile("s_waitcnt vmcnt(0)" ::: "memory");
        }
    }
    __syncthreads();
}

struct Frame {
    LAS unsigned char* lds;
    int tid, lane, wave, vcu, G;
};

DI void p0_transpose_item(const float* W, int N, bf16* WT, int ldt, int row_off, int col_off, LAS float* scr, int item, int lane) {
    const int nblk = N / 32, kb = item / nblk, nb = item % nblk, k0 = 64 * kb, n0 = 32 * nb;
#pragma unroll 8
    for (int i = 0; i < 32; ++i) { const int kk = 2 * i + (lane >> 5); scr[kk * 33 + (lane & 31)] = W[(size_t)(k0 + kk) * N + n0 + (lane & 31)]; }
    LDS_WAIT(); asm volatile("" ::: "memory");
    const int c = lane & 7;
#pragma unroll
    for (int j = 0; j < 4; ++j) { const int n = (lane >> 3) + 8 * j; const LAS float* s = scr + (8 * c) * 33 + n;
        v4u o; o.x = pk2(s[0 * 33], s[1 * 33]); o.y = pk2(s[2 * 33], s[3 * 33]); o.z = pk2(s[4 * 33], s[5 * 33]); o.w = pk2(s[6 * 33], s[7 * 33]);
        *(GAS v4u*)(WT + (size_t)(row_off + n0 + n) * ldt + col_off + k0 + 8 * c) = o; }
    LDS_WAIT(); asm volatile("" ::: "memory");
}

struct Args { const float* in[20]; float* out; unsigned char* ws; };
enum { I_X = 0, I_C, I_CTX, I_CCTX, I_NORMW, I_WADA, I_BADA, I_WIN, I_QNA, I_KNA, I_QND, I_KND, I_SINK, I_WFNET, I_WSP, I_BSP, I_WBR, I_WMERGE, I_BMERGE, I_WOUT };

DI void p0_weights(const Frame& F, const Args& a, int l, int widx, int nworkers) {
    unsigned char* ws = a.ws;
    LAS float* scr = (LAS float*)(F.lds + F.wave * 16384);
    const int gw = widx * NWAVES + F.wave, NGW = nworkers * NWAVES;
    constexpr int I_IN = 16 * 88, I_M = 16 * 128, I_O = 16 * 32, I_B = 4 * 32, PER_L = I_IN + I_M + I_O + 4 * I_B;
    for (int it = gw; it < PER_L; it += NGW) {
        int r = it;
        if (r < I_IN) { p0_transpose_item(a.in[I_WIN] + (size_t)l * 1024 * PW, PW, (bf16*)(ws + WS_WIN) + (size_t)l * PW * WPITCH, WPITCH, 0, 0, scr, r, F.lane); continue; } r -= I_IN;
        if (r < I_M) { p0_transpose_item(a.in[I_WMERGE] + (size_t)l * 1024 * 4096, 4096, (bf16*)(ws + WS_WM) + (size_t)l * 4096 * 1024, 1024, 0, 0, scr, r, F.lane); continue; } r -= I_M;
        if (r < I_O) { p0_transpose_item(a.in[I_WOUT] + (size_t)l * 1024 * 1024, 1024, (bf16*)(ws + WS_WOUT) + (size_t)l * 1024 * 1024, 1024, 0, 0, scr, r, F.lane); continue; } r -= I_O;
        { const int br = r / I_B; r -= br * I_B;
          p0_transpose_item(a.in[I_WBR] + ((size_t)l * 4 + br) * 256 * 1024, 1024, (bf16*)(ws + WS_WBR) + (size_t)l * 1024 * 1024, 1024, 0, 256 * br, scr, r, F.lane); }
    }
}
DI void p0_prologue(const Frame& F, const Args& a) {
    unsigned char* ws = a.ws;
    for (int u = F.vcu; u < 96; u += F.G) {
        const int l = u / 48, j0 = 64 * (u % 48);
        LAS float* sl = (LAS float*)F.lds; LAS float* red = sl + 3072;
        for (int i = F.tid; i < 3072; i += 512) { const int v = i >> 10, k = i & 1023; const float cv = (v < 2) ? a.in[I_C][v * 1024 + k] : a.in[I_CCTX][k]; sl[i] = siluf(cv); }
        __syncthreads();
        float a0 = 0.f, a1 = 0.f, a2 = 0.f;
        const float* wp = a.in[I_WADA] + (size_t)l * 1024 * 3072 + (size_t)(128 * F.wave) * 3072 + j0 + F.lane;
#pragma unroll 32
        for (int kk = 0; kk < 128; ++kk) { const float w = wp[(size_t)kk * 3072]; const int k = 128 * F.wave + kk; a0 += sl[k] * w; a1 += sl[1024 + k] * w; a2 += sl[2048 + k] * w; }
        red[(F.wave * 3 + 0) * 64 + F.lane] = a0; red[(F.wave * 3 + 1) * 64 + F.lane] = a1; red[(F.wave * 3 + 2) * 64 + F.lane] = a2;
        __syncthreads();
        if (F.tid < 192) { const int v = F.tid >> 6, jj = F.tid & 63; float s = a.in[I_BADA][l * 3072 + j0 + jj];
#pragma unroll
            for (int w = 0; w < 8; ++w) s += red[(w * 3 + v) * 64 + jj];
            ((float*)(ws + WS_MOD))[(l * 3 + v) * 3072 + j0 + jj] = s; }
        __syncthreads();
    }
    p0_weights(F, a, 0, F.vcu, F.G);
    {
        const int gt = F.vcu * 512 + F.tid, NGT = F.G * 512;
        bf16* tab = (bf16*)(ws + WS_TAB);
        for (int e = gt; e < 65536; e += NGT) {
            const int l = e >> 15, g = (e >> 13) & 3, col = (e >> 6) & 127, c = e & 63, d = col & 63;
            const float* wf = a.in[I_WFNET] + ((size_t)(l * 4 + g) * 64) * 64 + d; float s = 0.f;
            for (int j = 0; j < 64; ++j) { const float rev = (float)((c * j) & 63) * (1.0f / 64.0f); const float tw = (col < 64) ? __builtin_amdgcn_cosf(rev) : -__builtin_amdgcn_sinf(rev); s += tw * wf[j * 64]; }
            tab[TAB_MA / 2 + e] = (bf16)f2bf(s);
        }
        for (int e = gt; e < 49152; e += NGT) {
            const int mat = e / 16384, rem = e % 16384, k1b = rem >> 12, nb = (rem >> 10) & 3, s = (rem >> 9) & 1, ln = (rem >> 3) & 63, j = rem & 7;
            const int n1 = 32 * nb + krow(s, ln >> 5, j), k1 = 32 * k1b + (ln & 31); const float rev = (float)((n1 * k1) & 127) * (1.0f / 128.0f);
            const float v = (mat == 0) ? __builtin_amdgcn_cosf(rev) : (mat == 1) ? __builtin_amdgcn_sinf(rev) : -__builtin_amdgcn_sinf(rev);
            tab[TAB_128 / 2 + e] = (bf16)f2bf(v);
        }
        for (int e = gt; e < 8192; e += NGT) {
            const int mat = e >> 12, k2 = (e >> 6) & 63, n2 = e & 63; const float rev = (float)((k2 * n2) & 63) * (1.0f / 64.0f);
            tab[TAB_64 / 2 + e] = (bf16)f2bf(mat == 0 ? __builtin_amdgcn_cosf(rev) : __builtin_amdgcn_sinf(rev));
        }
        for (int e = gt; e < 131072; e += NGT) {
            const int mat = e >> 16, rem = e & 65535, kb = rem >> 13, nb = (rem >> 10) & 7, s = (rem >> 9) & 1, ln = (rem >> 3) & 63, j = rem & 7;
            const int n = 32 * nb + krow(s, ln >> 5, j), k = 32 * kb + (ln & 31); const float rev = (float)((n * k) & 255) * (1.0f / 256.0f);
            tab[TAB_256 / 2 + e] = (bf16)f2bf(mat == 0 ? __builtin_amdgcn_cosf(rev) : __builtin_amdgcn_sinf(rev));
        }
        for (int e = gt; e < 131072; e += NGT) tab[TAB_WSP / 2 + e] = (bf16)f2bf(a.in[I_WSP][e]);
        for (int e = gt; e < M_CTX * 1024 / 4; e += NGT) { ((f32x4*)(ws + WS_XC1))[e] = ((const f32x4*)a.in[I_CTX])[e]; ((f32x4*)(ws + WS_MGC))[e] = (f32x4){0.f, 0.f, 0.f, 0.f}; }
        for (int e = gt; e < 4096; e += NGT) tab[TAB_ONES / 2 + e] = (bf16)(((e & 31) == 0) ? 0x3f80 : 0);
        for (int e = gt; e < 262144; e += NGT) tab[TAB_BIASB / 2 + e] = (bf16)(((e & 31) == 0) ? f2bf(a.in[I_BMERGE][e >> 5]) : 0u);
    }
}

DI void p1_modrms(const Frame& F, const Args& a, int l, const float* xlat, const float* xctx, int with_ctx) {
    const float* part = (l == 1) ? (const float*)(a.ws + WS_GT2) : nullptr;
    const float* mod = (const float*)(a.ws + WS_MOD) + (size_t)l * 3 * 3072;
    const float* nw = a.in[I_NORMW] + l * 1024;
    bf16* H = (bf16*)(a.ws + WS_H);
    const int gw = F.vcu * NWAVES + F.wave, NGW = F.G * NWAVES;
    const int nrows = with_ctx ? M_ALL : M_LAT;
    int vcur = -1; f32x4 av[4], bv[4];
    for (int row = gw; row < nrows; row += 2 * NGW) {
        const int row2 = row + NGW; const bool has2 = row2 < nrows;
        const float* xr = (row < M_LAT) ? xlat + (size_t)row * 1024 : xctx + (size_t)(row - M_LAT) * 1024;
        const float* xr2 = !has2 ? xr : (row2 < M_LAT) ? xlat + (size_t)row2 * 1024 : xctx + (size_t)(row2 - M_LAT) * 1024;
        f32x4 x[4], y[4]; float ss = 0.f, ss2 = 0.f;
#pragma unroll
        for (int j = 0; j < 4; ++j) { x[j] = *(const f32x4*)(xr + 4 * (F.lane + 64 * j)); y[j] = *(const f32x4*)(xr2 + 4 * (F.lane + 64 * j)); }
        if (part != nullptr) {
            if (row >= M_LAT) { const float* pp = part + (size_t)(row - M_LAT) * 1024;
#pragma unroll 4
                for (int q = 0; q < 16; ++q)
#pragma unroll
                    for (int j = 0; j < 4; ++j) x[j] += *(const f32x4*)(pp + (size_t)q * 512 * 1024 + 4 * (F.lane + 64 * j)); }
            if (has2 && row2 >= M_LAT) { const float* pp = part + (size_t)(row2 - M_LAT) * 1024;
#pragma unroll 4
                for (int q = 0; q < 16; ++q)
#pragma unroll
                    for (int j = 0; j < 4; ++j) y[j] += *(const f32x4*)(pp + (size_t)q * 512 * 1024 + 4 * (F.lane + 64 * j)); }
        }
#pragma unroll
        for (int j = 0; j < 4; ++j) { ss += (x[j].x * x[j].x + x[j].y * x[j].y) + (x[j].z * x[j].z + x[j].w * x[j].w); ss2 += (y[j].x * y[j].x + y[j].y * y[j].y) + (y[j].z * y[j].z + y[j].w * y[j].w); }
#pragma unroll
        for (int o = 1; o < 64; o <<= 1) { ss += shx(ss, o, F.lane); ss2 += shx(ss2, o, F.lane); }
#pragma unroll
        for (int k = 0; k < 2; ++k) { const int r_ = k ? row2 : row; if (k && !has2) break;
            const int v = r_ < SEQ ? 0 : (r_ < M_LAT ? 1 : 2);
            if (v != vcur) { vcur = v;
#pragma unroll
                for (int j = 0; j < 4; ++j) { const int c = 4 * (F.lane + 64 * j); const f32x4 w = *(const f32x4*)(nw + c), sc = *(const f32x4*)(mod + v * 3072 + 1024 + c);
                    av[j] = w * (sc + 1.0f); bv[j] = *(const f32x4*)(mod + v * 3072 + c); } }
            const float rstd = __builtin_amdgcn_rsqf((k ? ss2 : ss) * (1.0f / 1024.0f) + RMS_EPS);
#pragma unroll
            for (int j = 0; j < 4; ++j) { const f32x4 h = (k ? y[j] : x[j]) * rstd * av[j] + bv[j]; v2u o; o.x = pk2(h.x, h.y); o.y = pk2(h.z, h.w);
                *(v2u*)(H + (size_t)r_ * 1024 + 4 * (F.lane + 64 * j)) = o; } }
    }
}

DI void p3_prep(const Frame& F, const Args& a, int l, bf16* P) {
    const int gw = F.vcu * NWAVES + F.wave, NGW = F.G * NWAVES;
    const int lane = F.lane, d0 = 4 * (lane & 15);
    f32x4 wk, inv;
#pragma unroll
    for (int e = 0; e < 4; ++e) { wk[e] = (lane < 32 ? a.in[I_KNA] : a.in[I_KND])[l * 64 + d0 + e];
        inv[e] = __builtin_amdgcn_exp2f(-(float)((d0 + e) & 15) * (13.287712379549449f / 16.0f)) * 0.15915494309189535f; }
    const float sgn = (d0 & 16) ? 1.0f : -1.0f;
    const int colk = (lane < 32) ? C_AK + 4 * lane : C_DK + 4 * (lane - 32);
    for (int row = gw; row < M_ALL; row += 2 * NGW) {
        const int row2 = row + NGW; const bool has2 = row2 < M_ALL;
        bf16* pr = P + (size_t)row * PW + colk; bf16* pr2 = P + (size_t)(has2 ? row2 : row) * PW + colk;
        const v2u raw = *(const v2u*)pr, raw2 = *(const v2u*)pr2;
#pragma unroll
        for (int k = 0; k < 2; ++k) { if (k && !has2) break;
            const int r_ = k ? row2 : row; const bool isctx = r_ >= M_LAT; const int n = r_ & (SEQ - 1);
            f32x4 cs = (f32x4){1.f, 1.f, 1.f, 1.f}, sn = (f32x4){0.f, 0.f, 0.f, 0.f};
            if (!isctx) { const float pos = (float)((d0 < 32) ? (n >> 6) : (n & 63));
#pragma unroll
                for (int e = 0; e < 4; ++e) { const float rev = pos * inv[e]; cs[e] = __builtin_amdgcn_cosf(rev); sn[e] = __builtin_amdgcn_sinf(rev); } }
            const v2u rw = k ? raw2 : raw;
            f32x4 v = (f32x4){wlo(rw.x), whi(rw.x), wlo(rw.y), whi(rw.y)};
            float ss = (v[0] * v[0] + v[1] * v[1]) + (v[2] * v[2] + v[3] * v[3]);
            ss += shx(ss, 1, lane); ss += shx(ss, 2, lane); ss += shx(ss, 4, lane); ss += shx(ss, 8, lane);
            v = v * __builtin_amdgcn_rsqf(ss * (1.0f / 64.0f) + RMS_EPS) * wk;
            f32x4 pt;
#pragma unroll
            for (int e = 0; e < 4; ++e) pt[e] = shx(v[e], 4, lane);
            v = v * cs + pt * sn * sgn;
            v2u o; o.x = pk2(v[0], v[1]); o.y = pk2(v[2], v[3]);
            *(v2u*)(k ? pr2 : pr) = o; }
    }
}

DI void fnet_stepA(const bf16* xrow, const bf16* MAt, int r32, int hi, bf16x8 (&gs)[4][2]) {
    bf16x8 xa[4];
#pragma unroll
    for (int s4 = 0; s4 < 4; ++s4) xa[s4] = *(const bf16x8*)(xrow + 16 * s4 + 8 * hi);
#pragma unroll
    for (int cb = 0; cb < 4; ++cb) { f32x16 acc = f32x16{};
#pragma unroll
        for (int s4 = 0; s4 < 4; ++s4) { const bf16x8 bfr = *(const bf16x8*)(MAt + (32 * cb + r32) * 64 + 16 * s4 + 8 * hi); acc = MFMA32(xa[s4], bfr, acc); }
        gs[cb][0] = pack_step(acc, 0); gs[cb][1] = pack_step(acc, 1); }
}

DI void fnet_s1_unit(const Frame& F, const Args& a, int l, int u, const bf16* P) {
    const int b = u >> 7, n2grp = (u >> 4) & 7, g = (u >> 2) & 3, k1b = u & 3;
    const int lane = F.lane, r32 = lane & 31, hi = lane >> 5, w = F.wave, n2 = 8 * n2grp + w;
    const bf16* tab = (const bf16*)(a.ws + WS_TAB);
    const bf16* MAt = tab + TAB_MA / 2 + (size_t)(l * 4 + g) * 128 * 64;
    const bf16* T128 = tab + TAB_128 / 2;
    f32x16 Tr[2], Ti[2];
#pragma unroll
    for (int j = 0; j < 2; ++j) { Tr[j] = f32x16{}; Ti[j] = f32x16{}; }
#pragma unroll 1
    for (int nb = 0; nb < 4; ++nb) {
        const bf16* xrow = P + (size_t)(SEQ * b + 64 * (32 * nb + r32) + n2) * PW + C_BF + 64 * g;
        bf16x8 gs[4][2]; fnet_stepA(xrow, MAt, r32, hi, gs);
#pragma unroll
        for (int s = 0; s < 2; ++s) {
            const size_t fo = ((size_t)((k1b * 4 + nb) * 2 + s) * 64 + lane) * 8;
            const bf16x8 ca = *(const bf16x8*)(T128 + fo), sa = *(const bf16x8*)(T128 + 16384 + fo), na = *(const bf16x8*)(T128 + 32768 + fo);
            Tr[0] = MFMA32(ca, gs[0][s], Tr[0]); Tr[0] = MFMA32(sa, gs[2][s], Tr[0]);
            Tr[1] = MFMA32(ca, gs[1][s], Tr[1]); Tr[1] = MFMA32(sa, gs[3][s], Tr[1]);
            Ti[0] = MFMA32(ca, gs[2][s], Ti[0]); Ti[0] = MFMA32(na, gs[0][s], Ti[0]);
            Ti[1] = MFMA32(ca, gs[3][s], Ti[1]); Ti[1] = MFMA32(na, gs[1][s], Ti[1]); }
    }
    LAS bf16* tl = (LAS bf16*)F.lds;
#pragma unroll
    for (int i = 0; i < 16; ++i) { const int k1l = crow(i, hi), k1 = 32 * k1b + k1l;
        const float rev = (float)((n2 * k1) & 8191) * (1.0f / 8192.0f); const float c = __builtin_amdgcn_cosf(rev), s = __builtin_amdgcn_sinf(rev);
#pragma unroll
        for (int jb = 0; jb < 2; ++jb) { const float tr = Tr[jb][i], ti = Ti[jb][i];
            tl[(k1l * 128 + 32 * jb + r32) * 8 + w] = (bf16)f2bf(tr * c + ti * s);
            tl[(k1l * 128 + 64 + 32 * jb + r32) * 8 + w] = (bf16)f2bf(ti * c - tr * s); } }
    __syncthreads();
    bf16* T1 = (bf16*)(a.ws + WS_T1);
#pragma unroll 4
    for (int pass = 0; pass < 8; ++pass) { const int q = F.tid + 512 * pass, k1l = q >> 7, colL = q & 127;
        const v4u v = *(const LAS v4u*)(F.lds + (size_t)q * 16);
        *(v4u*)(T1 + ((((size_t)(b * 128 + 32 * k1b + k1l) * 8 + n2grp) * 512) + g * 128 + colL) * 8) = v; }
    __syncthreads();
}

DI void fnet_ctx_unit(const Frame& F, const Args& a, int l, int u, const bf16* P, bf16* YB) {
    const int b = u >> 2, g = u & 3;
    const int lane = F.lane, r32 = lane & 31, hi = lane >> 5, w = F.wave;
    const bf16* tab = (const bf16*)(a.ws + WS_TAB);
    const bf16* MAt = tab + TAB_MA / 2 + (size_t)(l * 4 + g) * 128 * 64;
    const bf16* T256 = tab + TAB_256 / 2;
    LAS bf16x8* sh = (LAS bf16x8*)F.lds;
    { const bf16* xrow = P + (size_t)(M_LAT + NCTX * b + 32 * w + r32) * PW + C_BF + 64 * g;
      bf16x8 gs[4][2]; fnet_stepA(xrow, MAt, r32, hi, gs);
#pragma unroll
      for (int cb = 0; cb < 4; ++cb)
#pragma unroll
          for (int s = 0; s < 2; ++s) sh[((w * 4 + cb) * 2 + s) * 64 + lane] = gs[cb][s]; }
    __syncthreads();
    f32x16 Y[2]; Y[0] = f32x16{}; Y[1] = f32x16{};
#pragma unroll 2
    for (int nb = 0; nb < 8; ++nb) {
#pragma unroll
        for (int s = 0; s < 2; ++s) {
            const size_t fo = ((size_t)((w * 8 + nb) * 2 + s) * 64 + lane) * 8;
            const bf16x8 ca = *(const bf16x8*)(T256 + fo), sa = *(const bf16x8*)(T256 + 65536 + fo);
            const bf16x8 gr0 = sh[((nb * 4 + 0) * 2 + s) * 64 + lane], gr1 = sh[((nb * 4 + 1) * 2 + s) * 64 + lane], gi0 = sh[((nb * 4 + 2) * 2 + s) * 64 + lane], gi1 = sh[((nb * 4 + 3) * 2 + s) * 64 + lane];
            Y[0] = MFMA32(ca, gr0, Y[0]); Y[0] = MFMA32(sa, gi0, Y[0]);
            Y[1] = MFMA32(ca, gr1, Y[1]); Y[1] = MFMA32(sa, gi1, Y[1]); }
    }
#pragma unroll
    for (int jb = 0; jb < 2; ++jb)
#pragma unroll
        for (int i = 0; i < 16; ++i) { const int k = 32 * w + crow(i, hi), d = 32 * jb + r32; const size_t row = (size_t)(M_LAT + NCTX * b + k);
            const float z = bf2f(P[row * PW + C_BZ + 64 * g + d]);
            YB[row * 1024 + 512 + 64 * g + d] = (bf16)f2bf(Y[jb][i] * (1.0f / 128.0f) * siluf(z)); }
    __syncthreads();
}

#ifndef B_SCALE
#define B_SCALE 1.0f
#endif
#ifndef C_SCALE
#define C_SCALE 1.0f
#endif
DI void fnet_s3_unit(const Frame& F, const Args& a, int u, const bf16* P, bf16* YB) {
    const int b = u >> 7, k1 = u & 127;
    const int lane = F.lane, r32 = lane & 31, hi = lane >> 5, g = F.wave >> 1, jb = F.wave & 1;
    const bf16* T64 = (const bf16*)(a.ws + WS_TAB) + TAB_64 / 2;
    const bf16* T1 = (const bf16*)(a.ws + WS_T1);
    f32x16 Y[2]; Y[0] = f32x16{}; Y[1] = f32x16{};
#pragma unroll
    for (int sc = 0; sc < 4; ++sc)
#pragma unroll
        for (int ri = 0; ri < 2; ++ri) {
            const bf16x8 afr = *(const bf16x8*)(T1 + ((((size_t)(b * 128 + k1) * 8 + 2 * sc + hi) * 512) + g * 128 + ri * 64 + 32 * jb + r32) * 8);
#pragma unroll
            for (int k2b = 0; k2b < 2; ++k2b) { const bf16x8 bfr = *(const bf16x8*)(T64 + ri * 4096 + (32 * k2b + r32) * 64 + 16 * sc + 8 * hi); Y[k2b] = MFMA32(afr, bfr, Y[k2b]); } }
#pragma unroll
    for (int k2b = 0; k2b < 2; ++k2b) { const size_t row = (size_t)(SEQ * b + k1 + 128 * (32 * k2b + r32));
#pragma unroll
        for (int q = 0; q < 4; ++q) { const int d0 = 32 * jb + 8 * q + 4 * hi;
            const v2u z = *(const v2u*)(P + row * PW + C_BZ + 64 * g + d0);
            v2u o; o.x = pk2(Y[k2b][4 * q] * (B_SCALE * 0.0013810679320049757f) * siluf(wlo(z.x)), Y[k2b][4 * q + 1] * (B_SCALE * 0.0013810679320049757f) * siluf(whi(z.x)));
            o.y = pk2(Y[k2b][4 * q + 2] * (B_SCALE * 0.0013810679320049757f) * siluf(wlo(z.y)), Y[k2b][4 * q + 3] * (B_SCALE * 0.0013810679320049757f) * siluf(whi(z.y)));
            *(v2u*)(YB + row * 1024 + 512 + 64 * g + d0) = o; } }
}

DI void sgu_unit(const Frame& F, const Args& a, int l, int u, const bf16* P, bf16* YB) {
    constexpr int VP = 136;
    LAS bf16* vt = (LAS bf16*)F.lds;
    const int ci = u >> 2, g = u & 3;
    const size_t row0 = (size_t)ci * 128;
    { const int q = F.tid & 127, cq = F.tid >> 7; const bf16* src = P + (row0 + q) * PW + C_CV + 64 * g + 16 * cq;
#pragma unroll
      for (int i = 0; i < 2; ++i) { const v4u v = *(const v4u*)(src + 8 * i); const unsigned wv[4] = {v.x, v.y, v.z, v.w};
#pragma unroll
          for (int e = 0; e < 4; ++e) { vt[(16 * cq + 8 * i + 2 * e) * VP + q] = (bf16)f2bf(geluf(wlo(wv[e]))); vt[(16 * cq + 8 * i + 2 * e + 1) * VP + q] = (bf16)f2bf(geluf(whi(wv[e]))); } } }
    __syncthreads();
    const int lane = F.lane, r32 = lane & 31, hi = lane >> 5, pb = F.wave >> 1, cb = F.wave & 1;
    const bf16* Wsp = (const bf16*)(a.ws + WS_TAB) + TAB_WSP / 2 + (size_t)(l * 4 + g) * 128 * 128;
    f32x16 acc = f32x16{};
#pragma unroll
    for (int s = 0; s < 8; ++s) {
        const bf16x8 af = *(const LAS bf16x8*)(vt + (32 * cb + r32) * VP + 16 * s + 8 * hi);
        const bf16x8 bfr = *(const bf16x8*)(Wsp + (32 * pb + r32) * 128 + 16 * s + 8 * hi);
        acc = MFMA32(af, bfr, acc);
    }
    const int p = 32 * pb + r32; const float bb = a.in[I_BSP][(l * 4 + g) * 128 + p]; const bf16* pr = P + (row0 + p) * PW;
#pragma unroll
    for (int q = 0; q < 4; ++q) { const int c0 = 64 * g + 32 * cb + 8 * q + 4 * hi;
        const v2u uu = *(const v2u*)(pr + C_CU + c0), zz = *(const v2u*)(pr + C_CZ + c0);
        v2u o; o.x = pk2(C_SCALE * geluf(wlo(uu.x)) * (acc[4 * q] + bb) * siluf(wlo(zz.x)), C_SCALE * geluf(whi(uu.x)) * (acc[4 * q + 1] + bb) * siluf(whi(zz.x)));
        o.y = pk2(C_SCALE * geluf(wlo(uu.y)) * (acc[4 * q + 2] + bb) * siluf(wlo(zz.y)), C_SCALE * geluf(whi(uu.y)) * (acc[4 * q + 3] + bb) * siluf(whi(zz.y)));
        *(v2u*)(YB + (row0 + p) * 1024 + 768 + c0) = o; }
    __syncthreads();
}

DI void p5_ctx_convert(const Frame& F, const Args& a) {
    const int gt = F.vcu * 512 + F.tid, NGT = F.G * 512;
    const f32x4* src = (const f32x4*)(a.ws + WS_MGC); v2u* dst = (v2u*)((bf16*)(a.ws + WS_MG) + (size_t)M_LAT * 1024);
    for (int e = gt; e < M_CTX * 1024 / 4; e += NGT) { const f32x4 v = src[e]; v2u o; o.x = pk2(v.x, v.y); o.y = pk2(v.z, v.w); dst[e] = o; }
}

#ifdef SELFCHECK
constexpr int CW_CHK = 8192;
DI unsigned hsh(unsigned x) { x *= 2654435761u; x ^= x >> 15; x *= 2246822519u; x ^= x >> 13; x *= 3266489917u; x ^= x >> 16; return x; }
DI void chk_acc(const Args& a, int id, float got, float want) {
    unsigned* w = (unsigned*)(a.ws + WS_CTL) + CW_CHK + 4 * id;
    float d = __builtin_fabsf(got - want); if (!(d == d) || d > 1e15f) d = 1e15f;
    atomicAdd((float*)w, d * d); atomicAdd((float*)(w + 1), want * want); atomicAdd(w + 2, 1u); atomicMax(w + 3, __float_as_uint(d));
}
DI float bfr(float x) { return __uint_as_float(f2bf(x) << 16); }
DI void chk_p0(const Frame& F, const Args& a) {
    const int gt = F.vcu * 512 + F.tid, NGT = F.G * 512;
    for (int s = gt; s < 18432; s += NGT) { const int l = s / 9216, v = (s / 3072) % 3, j = s % 3072; float acc = a.in[I_BADA][l * 3072 + j];
        for (int k = 0; k < 1024; ++k) { const float cv = (v < 2) ? a.in[I_C][v * 1024 + k] : a.in[I_CCTX][k]; acc += siluf(cv) * a.in[I_WADA][((size_t)l * 1024 + k) * 3072 + j]; }
        chk_acc(a, 0, ((const float*)(a.ws + WS_MOD))[(l * 3 + v) * 3072 + j], acc); }
    for (int s = gt; s < 65536; s += NGT) { const unsigned h = hsh(s); const int l = (s >> 2) & 1, m = s & 3, k = h & 1023; const unsigned h2 = hsh(h + 77u);
        float got, want;
        if (m == 0) { const int n = h2 % PW; want = bfr(a.in[I_WIN][((size_t)l * 1024 + k) * PW + n]); got = bf2f(((const bf16*)(a.ws + WS_WIN))[((size_t)l * PW + n) * WPITCH + k]); }
        else if (m == 1) { const int n = h2 & 4095; want = bfr(a.in[I_WMERGE][((size_t)l * 1024 + k) * 4096 + n]); got = bf2f(((const bf16*)(a.ws + WS_WM))[((size_t)l * 4096 + n) * 1024 + k]); }
        else if (m == 2) { const int n = h2 & 1023; want = bfr(a.in[I_WOUT][((size_t)l * 1024 + k) * 1024 + n]); got = bf2f(((const bf16*)(a.ws + WS_WOUT))[((size_t)l * 1024 + n) * 1024 + k]); }
        else { const int n = h2 & 1023, br = k >> 8, kk = k & 255; want = bfr(a.in[I_WBR][(((size_t)l * 4 + br) * 256 + kk) * 1024 + n]); got = bf2f(((const bf16*)(a.ws + WS_WBR))[((size_t)l * 1024 + n) * 1024 + 256 * br + kk]); }
        chk_acc(a, 1, got, want); }
}
DI int sample_row(unsigned h, int l) { const int r = h % M_ALL; (void)l; return ((h >> 20) & 7) == 0 ? M_LAT + (h % M_CTX) : r; }
DI void chk_h(const Frame& F, const Args& a, int l, int id) {
    const float* mod = (const float*)(a.ws + WS_MOD) + (size_t)l * 3 * 3072; const bf16* H = (const bf16*)(a.ws + WS_H);
    const int gw = F.vcu * NWAVES + F.wave, NGW = F.G * NWAVES;
    for (int s = gw; s < M_ALL; s += NGW) { const int row = s; const int v = row < SEQ ? 0 : (row < M_LAT ? 1 : 2);
        const float* xr = (row < M_LAT) ? ((l == 0) ? a.in[I_X] : a.out) + (size_t)row * 1024 : ((l == 0) ? a.in[I_CTX] : (const float*)(a.ws + WS_XC1)) + (size_t)(row - M_LAT) * 1024;
        float ss = 0.f; for (int j = 0; j < 16; ++j) { const float x = xr[F.lane + 64 * j]; ss += x * x; }
        const float rstd = 1.0f / sqrtf(wave_sum(ss, F.lane) * (1.0f / 1024.0f) + RMS_EPS);
        for (int j = 0; j < 16; ++j) { const int c = F.lane + 64 * j; const float want = xr[c] * rstd * a.in[I_NORMW][l * 1024 + c] * (1.0f + mod[v * 3072 + 1024 + c]) + mod[v * 3072 + c];
            chk_acc(a, id, bf2f(H[(size_t)row * 1024 + c]), want); } }
}
DI float dot_h_w(const bf16* hrow, const bf16* wrow, int K) { float acc = 0.f; for (int k = 0; k < K; ++k) acc += bf2f(hrow[k]) * bf2f(wrow[k]); return acc; }
DI void chk_p(const Frame& F, const Args& a, int l, int id) {
    const bf16* H = (const bf16*)(a.ws + WS_H); const bf16* W = (const bf16*)(a.ws + WS_WIN) + (size_t)l * PW * WPITCH; const bf16* P = (const bf16*)(a.ws + WS_P);
    const int gt = F.vcu * 512 + F.tid, NGT = F.G * 512;
    for (int s = gt; s < (1 << 20); s += NGT) { const unsigned h = hsh(s * 5 + 2); const int row = sample_row(h, l); int col = hsh(h + 9u) % PW;
        if (l == 1 && row >= M_LAT) col = ((col & 1) ? 1024 : 256) + (col & 255);
        chk_acc(a, id, bf2f(P[(size_t)row * PW + col]), dot_h_w(H + (size_t)row * 1024, W + (size_t)col * WPITCH, 1024)); }
}
DI void chk_prep(const Frame& F, const Args& a, int l, int id) {
    const bf16* H = (const bf16*)(a.ws + WS_H); const bf16* W = (const bf16*)(a.ws + WS_WIN) + (size_t)l * PW * WPITCH; const bf16* P = (const bf16*)(a.ws + WS_P);
    const int gw = F.vcu * NWAVES + F.wave, NGW = F.G * NWAVES, d = F.lane;
    for (int s = gw; s < 16384; s += NGW) { const unsigned h = hsh(s * 7 + 3); const int row = sample_row(h, l); int sl = (h >> 8) % 12; const bool isctx = row >= M_LAT;
        if (isctx && l == 1) sl = (sl & 1) ? 4 + (sl & 1) : 10 + ((sl >> 1) & 1);
        const int col = (sl < 4) ? C_AQ + 64 * sl : (sl < 6) ? C_AK + 64 * (sl - 4) : (sl < 10) ? C_DQ + 64 * (sl - 6) : C_DK + 64 * (sl - 10);
        const bool isq = (sl < 4) || (sl >= 6 && sl < 10);
        const float raw = bfr(dot_h_w(H + (size_t)row * 1024, W + (size_t)(col + d) * WPITCH, 1024));
        const float wv = ((sl < 4) ? a.in[I_QNA] : (sl < 6) ? a.in[I_KNA] : (sl < 10) ? a.in[I_QND] : a.in[I_KND])[l * 64 + d];
        const float ms = wave_sum(raw * raw, d) * (1.0f / 64.0f);
        float y = raw / sqrtf(ms + RMS_EPS) * wv;
        if (!isctx) { const int n = row & (SEQ - 1); const float pos = (float)((d < 32) ? (n >> 6) : (n & 63)); const float inv = __builtin_amdgcn_exp2f(-(float)(d & 15) * (13.287712379549449f / 16.0f)); const float rev = pos * inv * 0.15915494309189535f; const float cs = __builtin_amdgcn_cosf(rev), sn = __builtin_amdgcn_sinf(rev);
            const float p = shx(y, 16, d); y = (d & 16) ? (p * sn + y * cs) : (y * cs - p * sn); }
        if (isq) y *= QSCALE;
        chk_acc(a, id, bf2f(P[(size_t)row * PW + col + d]), y); }
}
DI void chk_attn(const Frame& F, const Args& a, int l, int id, int mode) {
    const bf16* P = (const bf16*)(a.ws + WS_P); const bf16* YB = (const bf16*)(a.ws + WS_YB);
    LAS float* qs = (LAS float*)F.lds + F.wave * 192; LAS float* os = qs + 64; LAS float* red = qs + 128;
    const int gw = F.vcu * NWAVES + F.wave, NGW = F.G * NWAVES, lane = F.lane;
    const int qc0 = mode ? C_DQ : C_AQ, kc0 = mode ? C_DK : C_AK, vc0 = mode ? C_DV : C_AV, zc0 = mode ? C_DZ : C_AZ, oc0 = mode ? 256 : 0;
    for (int s = gw; s < 8192; s += NGW) { const unsigned hh = hsh(s * 11 + 5 + mode); int row = sample_row(hh, l); if ((s & 7) == 1) row = (hh & 8192) + (hh & 255) + ((hh & 256) ? 7936 : 0); if (l == 1 && row >= M_LAT) row = hh % M_LAT; const int h = (hh >> 9) & 3, kvh = h >> 1; const bool isctx = row >= M_LAT;
        const int b = isctx ? (row - M_LAT) / NCTX : row / SEQ, pos = row & (SEQ - 1);
        qs[lane] = bf2f(P[(size_t)row * PW + qc0 + 64 * h + lane]); LDS_WAIT();
        int klo = 0, khi = -1; if (!isctx) { if (mode == 0) { klo = 0; khi = SEQ - 1; } else { klo = pos - 128 < 0 ? 0 : pos - 128; khi = pos + 128 > SEQ - 1 ? SEQ - 1 : pos + 128; } }
        const int nlat = khi - klo + 1 > 0 ? khi - klo + 1 : 0, nk = NCTX + nlat;
        float m = -1e30f, lsum = 0.f; float acc[64];
#pragma unroll
        for (int dd = 0; dd < 64; ++dd) acc[dd] = 0.f;
        for (int kk = lane; kk < nk; kk += 64) { const size_t kr = (kk < NCTX) ? (size_t)(M_LAT + NCTX * b + kk) : (size_t)(SEQ * b + klo + kk - NCTX);
            const bf16* kp = P + kr * PW + kc0 + 64 * kvh; const bf16* vp = P + kr * PW + vc0 + 64 * kvh; float sc = 0.f;
#pragma unroll
            for (int dd = 0; dd < 64; ++dd) sc += qs[dd] * bf2f(kp[dd]);
            const float mn = fmaxf(m, sc), f = __builtin_amdgcn_exp2f(m - mn), p = __builtin_amdgcn_exp2f(sc - mn); lsum = lsum * f + p; m = mn;
#pragma unroll
            for (int dd = 0; dd < 64; ++dd) acc[dd] = acc[dd] * f + p * bf2f(vp[dd]); }
        float mall = m;
#pragma unroll
        for (int o = 1; o < 64; o <<= 1) mall = fmaxf(mall, shx(mall, o, lane));
        const float f = __builtin_amdgcn_exp2f(m - mall); lsum = wave_sum(lsum * f, lane);
        if (mode == 1) lsum += __builtin_amdgcn_exp2f(a.in[I_SINK][l * 4 + h] * 1.4426950408889634f - mall);
#pragma unroll
        for (int dd = 0; dd < 64; ++dd) { const float t = wave_sum(acc[dd] * f, lane); if (lane == dd) os[dd] = t; }
        LDS_WAIT();
        const float z = bf2f(P[(size_t)row * PW + zc0 + 64 * h + lane]);
        chk_acc(a, id, bf2f(YB[(size_t)row * 1024 + oc0 + 64 * h + lane]), os[lane] / lsum * siluf(z));
        (void)red; }
}
DI void chk_fnet(const Frame& F, const Args& a, int l, int id, int ctxmode) {
    const bf16* P = (const bf16*)(a.ws + WS_P); const bf16* YB = (const bf16*)(a.ws + WS_YB);
    LAS float* ys = (LAS float*)F.lds + F.wave * 64;
    const int gw = F.vcu * NWAVES + F.wave, NGW = F.G * NWAVES, j = F.lane;
    const int N = ctxmode ? NCTX : SEQ;
    for (int s = gw; s < (ctxmode ? 256 : 1024); s += NGW) { const unsigned hh = hsh(s * 13 + 7 + ctxmode); const int b = hh & 1, g = (hh >> 1) & 3; int k = (hh >> 3) % N;
#ifdef FNET_K0
        k = (s & 7) == 0 ? 0 : (s & 7) == 1 ? N / 2 : (s & 7) == 2 ? 64 : (s & 7) == 3 ? 128 : (s & 7) == 4 ? 1 : k;
#endif
        const size_t rbase = ctxmode ? (size_t)(M_LAT + NCTX * b) : (size_t)(SEQ * b);
        float y = 0.f;
        for (int n = 0; n < N; ++n) { const bf16* fr = P + (rbase + n) * PW + C_BF + 64 * g; float A = 0.f, B = 0.f;
            for (int c = 0; c < 64; ++c) { const float fv = bf2f(fr[c]); const float ph = (float)((j * c) & 63) * (1.0f / 64.0f); A += fv * __builtin_amdgcn_cosf(ph); B += fv * __builtin_amdgcn_sinf(ph); }
            const float th = (float)((k * n) & (N - 1)) / (float)N; y += __builtin_amdgcn_cosf(th) * A - __builtin_amdgcn_sinf(th) * B; }
        ys[j] = y / sqrtf((float)N * 64.0f); LDS_WAIT();
        float o = 0.f; for (int jj = 0; jj < 64; ++jj) o += ys[jj] * a.in[I_WFNET][((size_t)(l * 4 + g) * 64 + jj) * 64 + j];
        const size_t row = rbase + k; const float z = bf2f(P[row * PW + C_BZ + 64 * g + j]);
        chk_acc(a, id, bf2f(YB[row * 1024 + 512 + 64 * g + j]), o * siluf(z)); LDS_WAIT(); }
}
DI void chk_sgu(const Frame& F, const Args& a, int l, int id) {
    const bf16* P = (const bf16*)(a.ws + WS_P); const bf16* YB = (const bf16*)(a.ws + WS_YB);
    const int gt = F.vcu * 512 + F.tid, NGT = F.G * 512;
    for (int s = gt; s < (1 << 18); s += NGT) { const unsigned hh = hsh(s * 17 + 11); int row = sample_row(hh, l); if (l == 1 && row >= M_LAT) row = hh % M_LAT; const int cc = hsh(hh + 101u) & 255, g = cc >> 6, p = row & 127; const size_t r0 = (size_t)(row - p);
        float sp = a.in[I_BSP][(l * 4 + g) * 128 + p];
        for (int q = 0; q < 128; ++q) { const float v = bf2f(P[(r0 + q) * PW + C_CV + cc]); sp += a.in[I_WSP][((size_t)(l * 4 + g) * 128 + p) * 128 + q] * (0.5f * v * (1.0f + erff(v * 0.7071067811865476f))); }
        const float u = bf2f(P[(size_t)row * PW + C_CU + cc]), z = bf2f(P[(size_t)row * PW + C_CZ + cc]);
        chk_acc(a, id, bf2f(YB[(size_t)row * 1024 + 768 + cc]), (0.5f * u * (1.0f + erff(u * 0.7071067811865476f))) * sp * siluf(z)); }
}
DI void chk_merge(const Frame& F, const Args& a, int l, int id) {
    const bf16* H = (const bf16*)(a.ws + WS_H); const bf16* YB = (const bf16*)(a.ws + WS_YB); const bf16* MG = (const bf16*)(a.ws + WS_MG);
    const bf16* WM = (const bf16*)(a.ws + WS_WM) + (size_t)l * 4096 * 1024; const bf16* WB = (const bf16*)(a.ws + WS_WBR) + (size_t)l * 1024 * 1024;
    const int gt = F.vcu * 512 + F.tid, NGT = F.G * 512;
    for (int s = gt; s < (1 << 18); s += NGT) { const unsigned hh = hsh(s * 19 + 13); int row = sample_row(hh, l); if (l == 1 && row >= M_LAT) row = hh % M_LAT; const int d = hsh(hh + 202u) & 1023; float acc = 0.f;
        for (int r = 0; r < 4; ++r) { const float G = dot_h_w(H + (size_t)row * 1024, WM + ((size_t)r * 1024 + d) * 1024, 1024) + a.in[I_BMERGE][l * 4096 + r * 1024 + d];
            const float Y = dot_h_w(YB + (size_t)row * 1024 + 256 * r, WB + (size_t)d * 1024 + 256 * r, 256); acc += Y * __builtin_amdgcn_rcpf(1.0f + __builtin_amdgcn_exp2f(-1.4426950408889634f * G)); }
        float got; if (row < M_LAT) got = bf2f(MG[(size_t)row * 1024 + d]); else { got = 0.f; for (int br = 0; br < 4; ++br) got += bf2f(((const bf16*)(a.ws + WS_GTC))[((size_t)br * 512 + (row - M_LAT)) * 1024 + d]); }
        chk_acc(a, id, got, acc); }
}
DI void chk_gt(const Frame& F, const Args& a, int l, int r, int id) {
    const bf16* H = (const bf16*)(a.ws + WS_H); const bf16* GT = (const bf16*)(a.ws + WS_GT); const bf16* WM = (const bf16*)(a.ws + WS_WM) + (size_t)l * 4096 * 1024;
    const int gt = F.vcu * 512 + F.tid, NGT = F.G * 512;
    for (int s = gt; s < (1 << 18); s += NGT) { const unsigned hh = hsh(s * 29 + 19); int row = sample_row(hh, l); if (l == 1 && row >= M_LAT) row = hh % M_LAT; const int d = hsh(hh + 404u) & 1023;
        const float G = dot_h_w(H + (size_t)row * 1024, WM + ((size_t)r * 1024 + d) * 1024, 1024) + a.in[I_BMERGE][l * 4096 + r * 1024 + d];
        chk_acc(a, id, bf2f(GT[(size_t)row * 1024 + d]), __builtin_amdgcn_rcpf(1.0f + __builtin_amdgcn_exp2f(-1.4426950408889634f * G))); }
}
DI void chk_final(const Frame& F, const Args& a, int l, int id) {
    const bf16* MG = (const bf16*)(a.ws + WS_MG); const bf16* WO = (const bf16*)(a.ws + WS_WOUT) + (size_t)l * 1024 * 1024; const float* mod = (const float*)(a.ws + WS_MOD) + (size_t)l * 3 * 3072;
    const int gt = F.vcu * 512 + F.tid, NGT = F.G * 512;
    for (int s = gt; s < (1 << 18); s += NGT) { const unsigned hh = hsh(s * 23 + 17); const int row = sample_row(hh, l), c = hsh(hh + 303u) & 1023; const int v = row < SEQ ? 0 : (row < M_LAT ? 1 : 2);
        if (l == 1 && row >= M_LAT) continue;
        const float xi = (l == 1) ? ((const float*)(a.ws + WS_H))[(size_t)row * 1024 + c] : (row < M_LAT) ? a.in[I_X][(size_t)row * 1024 + c] : a.in[I_CTX][(size_t)(row - M_LAT) * 1024 + c];
        const float got = (row < M_LAT) ? a.out[(size_t)row * 1024 + c] : ((const float*)(a.ws + WS_XC1))[(size_t)(row - M_LAT) * 1024 + c];
        float dsum;
        if (row < M_LAT) dsum = dot_h_w(MG + (size_t)row * 1024, WO + (size_t)c * 1024, 1024);
        else { dsum = 0.f; for (int br = 0; br < 4; ++br) dsum += dot_h_w((const bf16*)(a.ws + WS_GTC) + ((size_t)br * 512 + (row - M_LAT)) * 1024, WO + (size_t)c * 1024, 1024); }
        chk_acc(a, id, got - xi, mod[v * 3072 + 2048 + c] * dsum); }
}
#ifdef CHECK_MAX
#define CHK_ERR(md, ss, n, mx) ((mx) / (sqrtf((ss) / (float)(n)) + 1e-20f))
#else
#define CHK_ERR(md, ss, n, mx) sqrtf((md) / ((ss) + 1e-30f))
#endif
DI void chk_report(const Frame& F, const Args& a) {
    const unsigned* w = (const unsigned*)(a.ws + WS_CTL) + CW_CHK; int first = -1; float ferr = 0.f;
#ifdef CHECK_ONLY
    { const int id = CHECK_ONLY; const float md = __uint_as_float(w[4 * id]), ss = ((const float*)w)[4 * id + 1]; const unsigned n = w[4 * id + 2]; first = id; ferr = n ? CHK_ERR(md, ss, n, __uint_as_float(w[4 * id + 3])) : 1e3f; }
#else
    for (int id = 0; id < 24; ++id) { const float md = __uint_as_float(w[4 * id]), ss = ((const float*)w)[4 * id + 1]; const unsigned n = w[4 * id + 2]; if (!n) continue;
        const float e = CHK_ERR(md, ss, n, __uint_as_float(w[4 * id + 3])); if (e > CHECK_TOL && first < 0) { first = id; ferr = e; } }
#endif
    const float V = first >= 0 ? 10.0f * (float)(1 + first) : 0.f; const float W = first >= 0 ? 4.0f + log10f(fminf(fmaxf(ferr, 1e-3f), 1e3f)) : 0.f;
    const size_t gt = (size_t)F.vcu * 512 + F.tid, NGT = (size_t)F.G * 512;
#ifdef KEEP_OUT
    if (gt == 0) a.out[0] += V; (void)W; (void)NGT;
#else
    for (size_t i = gt; i < (size_t)M_LAT * 1024; i += NGT) { float v = a.in[I_X][i]; if (i == 0) v += V; if (i >= (1u << 20) && i < (2u << 20)) v += W; a.out[i] = v; }
#endif
}
DI void chk_copy_out(const Frame& F, const Args& a) {
    const size_t gt = (size_t)F.vcu * 512 + F.tid, NGT = (size_t)F.G * 512; float* dst = (float*)(a.ws + WS_H);
    for (size_t i = gt; i < (size_t)M_LAT * 1024; i += NGT) dst[i] = a.out[i];
}
#endif
#ifndef RELAX_G1
#define RELAX_G1 true
#endif
#ifndef RELAX_MG
#define RELAX_MG true
#endif
#ifndef RELAX_OUT
#define RELAX_OUT true
#endif

typedef const __attribute__((address_space(4))) Args* CArgsP;
DI Args fresh_args() { CArgsP p = (CArgsP)__builtin_amdgcn_kernarg_segment_ptr(); asm volatile("" : "+s"(p)); Args r;
#pragma unroll
    for (int i = 0; i < 20; ++i) r.in[i] = p->in[i];
    r.out = p->out; r.ws = p->ws; return r; }
DI Frame fresh_frame(unsigned char* lds) {
    Frame F; int t_ = threadIdx.x; asm volatile("" : "+v"(t_));
    F.lds = (LAS unsigned char*)lds; F.tid = t_; F.lane = t_ & 63; F.wave = __builtin_amdgcn_readfirstlane(t_ >> 6);
    F.G = gridDim.x; { const int bx = blockIdx.x; F.vcu = (F.G % 8 == 0) ? (bx % 8) * (F.G / 8) + bx / 8 : bx; }
    return F;
}
DI void grid_bar(unsigned char* lds) {
    const Args a = fresh_args();
    XcdBarrier b; b.bar = (unsigned*)(a.ws + WS_CTL) + CW_BAR; b.x = xb_xcc_id(); b.st = (volatile LAS unsigned*)((LAS unsigned char*)lds + MISC_OFF) + 8;
    xcd_barrier(b);
}

__global__ void __launch_bounds__(NWAVES * 64, 2) hybrid_fwd(Args args) {
    extern __shared__ __attribute__((aligned(16))) unsigned char lds[];
    for (int u = threadIdx.x; u < (LDS_BYTES - LDSCTL_OFF) / 4; u += NWAVES * 64) ((LAS unsigned*)((LAS unsigned char*)lds + LDSCTL_OFF))[u] = 0u;
    __syncthreads();
    { const Args a = fresh_args(); (void)xcd_barrier_post((unsigned*)(a.ws + WS_CTL) + CW_BAR, (volatile LAS unsigned*)((LAS unsigned char*)lds + MISC_OFF) + 8); }
#define GRID_BAR() grid_bar(lds)
#ifndef DUP_MASK
#define DUP_MASK 0
#endif
#define DUP(bit) for (int rep_ = 0; rep_ < 1 + (((DUP_MASK) >> (bit)) & 1); ++rep_)
#ifdef SELFCHECK
#ifndef CHECK_SET
#define CHECK_SET 0xffff
#endif
#define CHK(bit, call) do { if ((CHECK_SET) & (bit)) { { const Frame F = fresh_frame(lds); const Args a = fresh_args(); call; } GRID_BAR(); } } while (0)
#elif defined(EXTRA_BAR)
#define CHK(bit, call) GRID_BAR()
#else
#define CHK(bit, call) do {} while (0)
#endif

#ifdef REPEAT_ALL
    for (int rep_all = 0; rep_all < 2; ++rep_all) {
    if (rep_all) GRID_BAR();
#endif
#ifndef SKIP_P0
    DUP(0) { const Frame F = fresh_frame(lds); const Args a = fresh_args(); p0_prologue(F, a); }
#endif
    GRID_BAR();
    CHK(1, chk_p0(F, a));

#pragma unroll 1
    for (int l = 0; l < 2; ++l) {
#ifndef SKIP_P1
        DUP(1) { const Frame F = fresh_frame(lds); const Args a = fresh_args();
          p1_modrms(F, a, l, (l == 0) ? a.in[I_X] : a.out, a.in[I_CTX], 1); }
#endif
        GRID_BAR();
        CHK(2, chk_h(F, a, l, 2 + 10 * l));
#ifndef SKIP_G1
        DUP(2) { const Frame F = fresh_frame(lds); const Args a = fresh_args();
            pg8::Gemm g{(const bf16*)(a.ws + WS_H), (const bf16*)(a.ws + WS_WIN) + (size_t)l * PW * WPITCH, 1024, WPITCH, 1024};
            pg8::OrderX S; S.so.init(l == 0 ? M_ALL : M_LAT, PW, F.G, (int)blockIdx.x); S.nx = (l == 0) ? 0 : 4;
            pg8::EpiBf16<0> E{(bf16*)(a.ws + WS_P), PW, nullptr};
            pg8::gemm_phase<pg8::EpiBf16<0>, pg8::OrderX, true, RELAX_G1>(F.lds, g, S, E);
        }
#endif
        GRID_BAR();
        CHK(4, chk_p(F, a, l, 3 + 10 * l));
#ifndef SKIP_S1
        DUP(3) { const Frame F = fresh_frame(lds); const Args a = fresh_args();
          for (int u = F.vcu; u < 256; u += F.G) fnet_s1_unit(F, a, l, u, (const bf16*)(a.ws + WS_P)); }
#endif
#ifndef SKIP_PREP
        { const Frame F = fresh_frame(lds); const Args a = fresh_args(); p3_prep(F, a, l, (bf16*)(a.ws + WS_P)); }
#endif
        GRID_BAR();
        CHK(8, chk_prep(F, a, l, 4 + 10 * l));
#ifndef SKIP_ATT
        DUP(4) { const Frame F = fresh_frame(lds); const Args a = fresh_args();
            const attn_body::bf16* Pa = (const attn_body::bf16*)(a.ws + WS_P); attn_body::bf16* Ya = (attn_body::bf16*)(a.ws + WS_YB);
            for (int u = F.vcu; u < 256; u += F.G) {
                const int bk = u >> 6, b = bk >> 1, kvh = bk & 1, h = 2 * kvh + ((u >> 5) & 1), qb = u & 31;
                attn_body::attn_unit<0, 8>(Pa, Ya, SEQ * b + 256 * qb, M_LAT + NCTX * b, SEQ * b, 0, 132, 0,
                                           C_AQ + 64 * h, C_AK + 64 * kvh, C_AV + 64 * kvh, C_AZ + 64 * h, 64 * h, 0.f, (char*)lds, a.in[I_QNA] + l * 64, 1);
            }
        }
        DUP(5) { const Frame F = fresh_frame(lds); const Args a = fresh_args();
            const attn_body::bf16* Pa = (const attn_body::bf16*)(a.ws + WS_P); attn_body::bf16* Ya = (attn_body::bf16*)(a.ws + WS_YB);
            for (int u = F.vcu; u < 512; u += F.G) {
                if (u < 256) {
                    const int bk = u >> 6, b = bk >> 1, kvh = bk & 1, h = 2 * kvh + ((u >> 5) & 1), qb = u & 31;
                    const int off = (qb == 0) ? 0 : 4 * qb - 2, NT = (qb == 0 || qb == 31) ? 10 : 12;
                    const float sk = a.in[I_SINK][l * 4 + h] * 1.4426950408889634f;
                    attn_body::attn_unit<1, 8>(Pa, Ya, SEQ * b + 256 * qb, M_LAT + NCTX * b, SEQ * b, off, NT, 256 * qb - 64 * off,
                                               C_DQ + 64 * h, C_DK + 64 * kvh, C_DV + 64 * kvh, C_DZ + 64 * h, 256 + 64 * h, sk, (char*)lds, a.in[I_QND] + l * 64, 1);
                } else if (l == 0 && u >= 288 && u < 416 && ((u - 288) & 7) == 0) {
                    const int ee = (u - 288) >> 3, mode = ee >> 3, b = (ee >> 2) & 1, h = ee & 3, kvh = h >> 1;
                    const float sk = (mode == 0) ? -INFINITY : a.in[I_SINK][l * 4 + h] * 1.4426950408889634f;
                    const int qc = (mode == 0) ? C_AQ : C_DQ, kc = (mode == 0) ? C_AK : C_DK, vc = (mode == 0) ? C_AV : C_DV, zc = (mode == 0) ? C_AZ : C_DZ, oc = (mode == 0) ? 0 : 256;
                    attn_body::attn_unit<1, 8>(Pa, Ya, M_LAT + NCTX * b, M_LAT + NCTX * b, SEQ * b, 0, 4, 0,
                                               qc + 64 * h, kc + 64 * kvh, vc + 64 * kvh, zc + 64 * h, oc + 64 * h, sk, (char*)lds, ((mode == 0) ? a.in[I_QNA] : a.in[I_QND]) + l * 64, 0);
                }
            }
        }
#endif
#ifndef SKIP_S3
        DUP(6) { const Frame F = fresh_frame(lds); const Args a = fresh_args();
          for (int u = F.vcu; u < 256; u += F.G) fnet_s3_unit(F, a, u, (const bf16*)(a.ws + WS_P), (bf16*)(a.ws + WS_YB)); }
#endif
#ifndef SKIP_SGU
        DUP(7) { const Frame F = fresh_frame(lds); const Args a = fresh_args();
          const int nunit = (l == 0) ? 528 : 512;
          for (int u = F.vcu; u < nunit; u += F.G) sgu_unit(F, a, l, u, (const bf16*)(a.ws + WS_P), (bf16*)(a.ws + WS_YB)); }
#endif
#ifndef SKIP_FC
        if (l == 0) DUP(10) { const Frame F = fresh_frame(lds); const Args a = fresh_args();
          for (int e = F.vcu; e < 256; e += F.G) { if (e >= 160 && e < 224 && ((e - 160) & 7) == 0) fnet_ctx_unit(F, a, l, (e - 160) >> 3, (const bf16*)(a.ws + WS_P), (bf16*)(a.ws + WS_YB)); } }
#endif
        GRID_BAR();
        CHK(16, chk_attn(F, a, l, 5 + 10 * l, 0)); CHK(16, chk_attn(F, a, l, 6 + 10 * l, 1)); CHK(32, chk_fnet(F, a, l, 7 + 10 * l, 0); if (l == 0) chk_fnet(F, a, l, 8, 1)); CHK(64, chk_sgu(F, a, l, 9 + 10 * l));
#ifndef MERGE_V1
        for (int rep_ = 0; rep_ < 1 + ((((DUP_MASK) >> 8) & 1) && l == 1); ++rep_) { const Frame F = fresh_frame(lds); const Args a = fresh_args();
            pg8::Gemm g{(const bf16*)(a.ws + WS_H), (const bf16*)(a.ws + WS_WM), 1024, 1024, 1024};
            pg8::MergeOrder S{(const bf16*)(a.ws + WS_H), (const bf16*)(a.ws + WS_YB), (const bf16*)(a.ws + WS_WM) + (size_t)l * 4096 * 1024, (const bf16*)(a.ws + WS_WBR) + (size_t)l * 1024 * 1024, F.G, F.vcu, (l == 0) ? 32 : 0};
            pg8::EpiMerge E{(bf16*)(a.ws + WS_GT), (bf16*)(a.ws + WS_MG), (float*)(a.ws + WS_MGC), a.in[I_BMERGE] + l * 4096, (bf16*)(a.ws + WS_GTC), (bf16*)(a.ws + WS_GT2)};
            pg8::gemm_phase<pg8::EpiMerge, pg8::MergeOrder, true, RELAX_MG>(F.lds, g, S, E);
        }
        if (l == 0) { const Frame F = fresh_frame(lds); const Args a = fresh_args();
            if (F.G == 256) { if ((F.vcu & 7) != 0) p0_weights(F, a, 1, F.vcu - (F.vcu >> 3) - 1, 224); } else p0_weights(F, a, 1, F.vcu, F.G); }
        GRID_BAR();
#else
#pragma unroll 1
        for (int r = 0; r < 4; ++r) {
#ifdef ZERO_MASK
            if ((ZERO_MASK >> r) & 1) continue;
#endif
#ifndef SKIP_MG
            { const Frame F = fresh_frame(lds); const Args a = fresh_args();
                pg8::Gemm g{(const bf16*)(a.ws + WS_H), (const bf16*)(a.ws + WS_WM) + ((size_t)l * 4096 + r * 1024) * 1024, 1024, 1024, 1024};
                pg8::OrderX S; S.so.init((l == 0) ? M_ALL : M_LAT, 1024, F.G, (int)blockIdx.x); S.nx = 0;
                pg8::EpiBf16<2> E{(bf16*)(a.ws + WS_GT), 1024, a.in[I_BMERGE] + l * 4096 + r * 1024};
                pg8::gemm_phase<pg8::EpiBf16<2>, pg8::OrderX, true>(F.lds, g, S, E);
            }
#endif
            GRID_BAR();
            if (r == 3 && l == 0) CHK(512, chk_gt(F, a, l, r, 22); chk_gt(F, a, l, 2, 23));
#ifndef SKIP_MY
            { const Frame F = fresh_frame(lds); const Args a = fresh_args();
                pg8::Gemm g{(const bf16*)(a.ws + WS_YB) + r * 256, (const bf16*)(a.ws + WS_WBR) + (size_t)l * 1024 * 1024 + r * 256, 1024, 1024, 256};
                pg8::OrderX S; S.so.init((l == 0) ? M_ALL : M_LAT, 1024, F.G, (int)blockIdx.x); S.nx = 0;

#ifdef ZERO_MASK
                pg8::EpiGate E{(bf16*)(a.ws + WS_MG), (const bf16*)(a.ws + WS_GT), 1024, r == __builtin_ctz(~(ZERO_MASK)), 1.0f};
#else
#ifdef SCALE_MASK
                pg8::EpiGate E{(bf16*)(a.ws + WS_MG), (const bf16*)(a.ws + WS_GT), 1024, r == 0, ((SCALE_MASK >> r) & 1) ? (SCALE_VAL) : 1.0f};
#else
                pg8::EpiGate E{(bf16*)(a.ws + WS_MG), (const bf16*)(a.ws + WS_GT), 1024, r == 0, 1.0f};
#endif
#endif

                pg8::gemm_phase<pg8::EpiGate, pg8::OrderX, true>(F.lds, g, S, E);
            }
#endif
            GRID_BAR();
        }
#endif
        CHK(128, chk_merge(F, a, l, 10 + 10 * l));
        if (l == 1) CHK(256, chk_copy_out(F, a));
#ifndef SKIP_OUT
        { const Frame F = fresh_frame(lds); const Args a = fresh_args();
            pg8::Gemm g{(const bf16*)(a.ws + WS_MG), (const bf16*)(a.ws + WS_WOUT) + (size_t)l * 1024 * 1024, 1024, 1024, 1024};
            pg8::OrderOut S; S.so.init(M_LAT, 1024, F.G, (int)blockIdx.x); S.nx = (l == 0) ? 128 : 0; S.TERM = (const bf16*)(a.ws + WS_GTC);
            pg8::EpiRes E{(l == 0) ? a.in[I_X] : a.out, a.out, (l == 0) ? a.in[I_CTX] : (const float*)(a.ws + WS_XC1), (float*)(a.ws + WS_XC1), (const float*)(a.ws + WS_MOD) + (size_t)l * 3 * 3072, (float*)(a.ws + WS_GT2)};
            pg8::gemm_phase<pg8::EpiRes, pg8::OrderOut, true, RELAX_OUT>(F.lds, g, S, E);
        }
#endif
        if (l == 0) GRID_BAR();
        if (l == 0) CHK(256, chk_final(F, a, l, 11));
#ifdef SELFCHECK
        if (l == 1) { GRID_BAR(); CHK(256, chk_final(F, a, l, 21)); }
#endif
    }
#ifdef REPEAT_ALL
    }
#endif
#ifdef SELFCHECK
    GRID_BAR();
    { const Frame F = fresh_frame(lds); const Args a = fresh_args(); chk_report(F, a); }
#endif
#ifdef BLEND_S
    GRID_BAR();
    { const Frame F = fresh_frame(lds); const Args a = fresh_args(); const size_t gt = (size_t)F.vcu * 512 + F.tid, NGT = (size_t)F.G * 512;
      for (size_t i = gt; i < (size_t)M_LAT * 1024; i += NGT) { const float x0 = a.in[I_X][i]; a.out[i] = x0 + (BLEND_S) * (a.out[i] - x0); } }
#endif
}

extern "C" void kernel_launch(void* const* d_in, const int* in_sizes, int n_in, void* d_out, int out_size, void* d_ws, size_t ws_size, hipStream_t stream) {
    static int grid = 0;
    if (grid == 0) {
        if (n_in != 20 || out_size != M_LAT * DM || ws_size < WS_END) { fprintf(stderr, "kernel_launch: unexpected problem: n_in %d out %d ws %zu\n", n_in, out_size, ws_size); grid = -1; return; }
        { const int want[20] = {M_LAT * DM, NB * DM, M_CTX * DM, DM, 2 * DM, 2 * DM * 3 * DM, 2 * 3 * DM, 2 * DM * PW, 128, 128, 128, 128, 8, 2 * 4 * 64 * 64, 2 * 4 * 128 * 128, 2 * 4 * 128, 2 * 4 * 256 * DM, 2 * DM * 4 * DM, 2 * 4 * DM, 2 * DM * DM};
          for (int i = 0; i < 20; ++i) if (in_sizes[i] != want[i]) { fprintf(stderr, "kernel_launch: input %d has %d elements, expected %d\n", i, in_sizes[i], want[i]); grid = -1; return; } }
        int dev = 0, cus = 0, per_cu = 0;
        if (hipGetDevice(&dev) != hipSuccess || hipDeviceGetAttribute(&cus, hipDeviceAttributeMultiprocessorCount, dev) != hipSuccess) { grid = -1; return; }
        if (hipFuncSetAttribute((const void*)hybrid_fwd, hipFuncAttributeMaxDynamicSharedMemorySize, LDS_BYTES) != hipSuccess) { fprintf(stderr, "kernel_launch: hipFuncSetAttribute failed\n"); grid = -1; return; }
        if (hipOccupancyMaxActiveBlocksPerMultiprocessor(&per_cu, (const void*)hybrid_fwd, NWAVES * 64, LDS_BYTES) != hipSuccess || per_cu < 1) { fprintf(stderr, "kernel_launch: occupancy query says %d blocks per CU\n", per_cu); per_cu = 1; }
        (void)hipGetLastError();
        grid = cus;
    }
    if (grid < 0) return;
    if (hipMemsetAsync((char*)d_ws + WS_CTL, 0, CTL_ZERO_BYTES, stream) != hipSuccess) { fprintf(stderr, "kernel_launch: memset failed\n"); return; }
    Args a{};
    for (int i = 0; i < 20; ++i) a.in[i] = (const float*)d_in[i];
    a.out = (float*)d_out; a.ws = (unsigned char*)d_ws;
    hipLaunchKernelGGL(hybrid_fwd, dim3(grid), dim3(NWAVES * 64), LDS_BYTES, stream, a);
}
```

```cpp
#include <hip/hip_runtime.h>
#include <hip/hip_bf16.h>
#include <cstdio>
#include <cstdint>
#include <cmath>

namespace pg8 {

#define PG8_LAS __attribute__((address_space(3)))
typedef unsigned short bf16_t;
typedef short bf16x8 __attribute__((ext_vector_type(8)));
typedef float f32x4 __attribute__((ext_vector_type(4)));
typedef unsigned u32x4 __attribute__((ext_vector_type(4)));
constexpr int BM = 256, BK = 64, HALF = 128, HTB = HALF * BK * 2, STAGE_BYTES = 8 * HTB, NXCD = 8, WGM = 8;

__host__ __device__ __forceinline__ int lds_byte(int r, int c) { const int st = (r >> 4) * 2 + (c >> 5), rr = r & 15, cc = c & 31, ob = rr * 64 + cc * 2; return st * 1024 + (ob ^ (((ob >> 9) & 1) << 5)); }
__host__ __device__ __forceinline__ void stage_rc(int b, int& R, int& C) { const int st = b / 1024, sb = b % 1024, swz = sb ^ (((sb >> 9) & 1) << 5); R = (st >> 1) * 16 + swz / 64; C = (st & 1) * 32 + (swz % 64) / 2; }
__host__ __device__ __forceinline__ int perm32(int rho) { const int n = rho >> 4, i = rho & 15; return 8 * (i >> 2) + 4 * n + (i & 3); }

struct Unit { int pm, pn, r, kind; };
struct Gemm { const bf16_t* A; const bf16_t* Bt; int lda, ldb, K; };

struct StaticOrder {
    int nM, nN, nwg, G, c;
    __host__ __device__ void init(int M, int N, int G_, int c_) { nM = M / BM; nN = N / BM; nwg = nM * nN; G = G_; c = c_; }
    __host__ __device__ bool next(int i, Unit& u) const {
        const long L = (long)i * G + c; if (L >= nwg) return false;
        int wgid = (int)L; { const int q = nwg / NXCD, r = nwg % NXCD, xcd = wgid % NXCD, off = wgid / NXCD; wgid = (xcd < r ? xcd * (q + 1) : r * (q + 1) + (xcd - r) * q) + off; }
        const int nig = WGM * nN, gid = wgid / nig, fm = gid * WGM, gsz = (nM - fm) < WGM ? (nM - fm) : WGM;
        u.pm = fm + ((wgid % nig) % gsz); u.pn = (wgid % nig) / gsz; u.r = 0; u.kind = 0; return true;
    }
};
struct OrderX {
    StaticOrder so; int nx;
    __device__ bool next(int i, Unit& u) const {
        const long L = (long)i * so.G + so.c;
        if (L < so.nwg) return so.next(i, u);
        const int e = (int)(L - so.nwg); if (e >= nx) return false;
        u.pm = 64 + (e >> 1); u.pn = (e & 1) ? 4 : 1; u.r = 0; u.kind = 0; return true;
    }
    __device__ __forceinline__ void src(const Gemm& g, const Unit& u, const char*& pa, const char*& pb, const char*& pb1, int& nt) const {
        pa = (const char*)g.A + (size_t)u.pm * (2 * HALF) * g.lda * 2; pb = (const char*)g.Bt + (size_t)u.pn * (2 * HALF) * g.ldb * 2; pb1 = pb + (size_t)HALF * g.ldb * 2; nt = g.K / BK; }
};

typedef float f32x2_c __attribute__((ext_vector_type(2))); typedef __bf16 bf16x2_c __attribute__((ext_vector_type(2)));
__device__ __forceinline__ unsigned cvt_pk_bf16(float lo, float hi) { f32x2_c v = {lo, hi}; bf16x2_c b = __builtin_convertvector(v, bf16x2_c); return __builtin_bit_cast(unsigned, b); }
__device__ __forceinline__ float bf_lo(unsigned w) { return __uint_as_float(w << 16); }
__device__ __forceinline__ float bf_hi(unsigned w) { return __uint_as_float(w & 0xffff0000u); }
__device__ __forceinline__ float sigmoidf_(float x) { return __builtin_amdgcn_rcpf(1.0f + __builtin_amdgcn_exp2f(-1.4426950408889634f * x)); }

template <int ACT> struct EpiBf16 {
    static constexpr bool PERM = true; static constexpr int NSTORE = 16;
    bf16_t* O; int ldc; const float* bias;
    __device__ __forceinline__ void operator()(const f32x4 (&acc)[2][2][4][2], const Unit& u, int wr, int wc, int fr, int fq) const {
        const int row0 = u.pm * BM + wr * 64 + fr; const int col0 = u.pn * BM + wc * 32 + 8 * fq;
        f32x4 bv[2][2];
#pragma unroll
        for (int bj = 0; bj < 2; ++bj)
#pragma unroll
            for (int n = 0; n < 2; ++n) bv[bj][n] = bias ? *(const f32x4*)(bias + col0 + bj * HALF + 4 * n) : (f32x4){0.f, 0.f, 0.f, 0.f};
#pragma unroll
        for (int ai = 0; ai < 2; ++ai)
#pragma unroll
            for (int m = 0; m < 4; ++m) { bf16_t* rowp = O + (size_t)(row0 + ai * HALF + m * 16) * ldc + col0;
#pragma unroll
                for (int bj = 0; bj < 2; ++bj) { f32x4 v0 = acc[ai][bj][m][0] + bv[bj][0], v1 = acc[ai][bj][m][1] + bv[bj][1];
                    if (ACT == 2) {
#pragma unroll
                        for (int e = 0; e < 4; ++e) { v0[e] = sigmoidf_(v0[e]); v1[e] = sigmoidf_(v1[e]); } }
                    u32x4 w; w.x = cvt_pk_bf16(v0[0], v0[1]); w.y = cvt_pk_bf16(v0[2], v0[3]); w.z = cvt_pk_bf16(v1[0], v1[1]); w.w = cvt_pk_bf16(v1[2], v1[3]);
                    *(u32x4*)(rowp + bj * HALF) = w;
                    } }
    }
};
struct EpiGate {
    static constexpr bool PERM = true; static constexpr int NSTORE = 0;
    bf16_t* MG; const bf16_t* GT; int ldc; int first; float scl;
    typedef unsigned u32x2 __attribute__((ext_vector_type(2)));
    __device__ __forceinline__ void operator()(const f32x4 (&acc)[2][2][4][2], const Unit& u, int wr, int wc, int fr, int fq) const {
        const int row0 = u.pm * BM + wr * 64 + fr; const int col0 = u.pn * BM + wc * 32 + 8 * fq;
#pragma unroll
        for (int ai = 0; ai < 2; ++ai)
#pragma unroll
            for (int m = 0; m < 4; ++m) { const size_t off = (size_t)(row0 + ai * HALF + m * 16) * ldc + col0;
#pragma unroll
                for (int bj = 0; bj < 2; ++bj)
#pragma unroll
                    for (int n = 0; n < 2; ++n) {
                        const u32x2 g = *(const u32x2*)(GT + off + bj * HALF + 4 * n);
                        u32x2 o = (u32x2){0u, 0u}; if (!first) o = *(const u32x2*)(MG + off + bj * HALF + 4 * n);
                        const f32x4 v = acc[ai][bj][m][n] * scl;
                        u32x2 w;
                        w.x = cvt_pk_bf16(bf_lo(o.x) + bf_lo(g.x) * v[0], bf_hi(o.x) + bf_hi(g.x) * v[1]);
                        w.y = cvt_pk_bf16(bf_lo(o.y) + bf_lo(g.y) * v[2], bf_hi(o.y) + bf_hi(g.y) * v[3]);
                        *(u32x2*)(MG + off + bj * HALF + 4 * n) = w; asm volatile("" ::: "memory"); } }
    }
};
struct EpiDelta {
    static constexpr bool PERM = true; static constexpr int NSTORE = 16;
    bf16_t* d0; const float* gate; float* part;
    __device__ __forceinline__ void operator()(const f32x4 (&acc)[2][2][4][2], const Unit& u, int wr, int wc, int fr, int fq) const {
        const bool isctx = u.pm >= 64;
        const float* gv = gate + (isctx ? 2 : (u.pm >> 5)) * 3072 + 2048;
        const int col0 = u.pn * BM + wc * 32 + 8 * fq;
        f32x4 gt[2][2];
#pragma unroll
        for (int bj = 0; bj < 2; ++bj)
#pragma unroll
            for (int n = 0; n < 2; ++n) gt[bj][n] = *(const f32x4*)(gv + col0 + bj * HALF + 4 * n);
        if (u.kind == 3) {
            float* pt = part + ((size_t)u.r * 512 + (size_t)(u.pm - 64) * BM) * 1024;
#pragma unroll
            for (int ai = 0; ai < 2; ++ai)
#pragma unroll
                for (int m = 0; m < 4; ++m) { const size_t off = (size_t)(ai * HALF + wr * 64 + m * 16 + fr) * 1024 + col0;
#pragma unroll
                    for (int bj = 0; bj < 2; ++bj)
#pragma unroll
                        for (int n = 0; n < 2; ++n) *(f32x4*)(pt + off + bj * HALF + 4 * n) = gt[bj][n] * acc[ai][bj][m][n]; }
        } else {
#pragma unroll
            for (int ai = 0; ai < 2; ++ai)
#pragma unroll
                for (int m = 0; m < 4; ++m) { bf16_t* rowp = d0 + (size_t)(u.pm * BM + ai * HALF + wr * 64 + m * 16 + fr) * 1024 + col0;
#pragma unroll
                    for (int bj = 0; bj < 2; ++bj) { const f32x4 v0 = gt[bj][0] * acc[ai][bj][m][0], v1 = gt[bj][1] * acc[ai][bj][m][1];
                        u32x4 w; w.x = cvt_pk_bf16(v0[0], v0[1]); w.y = cvt_pk_bf16(v0[2], v0[3]); w.z = cvt_pk_bf16(v1[0], v1[1]); w.w = cvt_pk_bf16(v1[2], v1[3]);
                        *(u32x4*)(rowp + bj * HALF) = w; } }
        }
    }
};
struct EpiRes {
    static constexpr bool PERM = false; static constexpr int NSTORE = 32;
    const float* xin_lat; float* xout_lat; const bf16_t* d0; const float* gate;
    typedef unsigned u32x2 __attribute__((ext_vector_type(2)));
    __device__ __forceinline__ void operator()(const f32x4 (&acc)[2][2][4][2], const Unit& u, int wr, int wc, int fr, int fq) const {
        const float* xin = xin_lat + (size_t)u.pm * BM * 1024; float* xout = xout_lat + (size_t)u.pm * BM * 1024;
        const float* gv = gate + (u.pm >> 5) * 3072 + 2048;
        const int col0 = u.pn * BM + wc * 32 + 4 * fq;
        f32x4 gt[2][2];
#pragma unroll
        for (int bj = 0; bj < 2; ++bj)
#pragma unroll
            for (int n = 0; n < 2; ++n) gt[bj][n] = *(const f32x4*)(gv + col0 + bj * HALF + n * 16);
#ifndef RP_DEPTH
#define RP_DEPTH 3
#endif
        const __amdgpu_buffer_rsrc_t rx = __builtin_amdgcn_make_buffer_rsrc((void*)xin, 0, 0x7fffffff, 0x00020000), rd = __builtin_amdgcn_make_buffer_rsrc((void*)(d0 + (size_t)u.pm * BM * 1024), 0, 0x7fffffff, 0x00020000);
        const unsigned vb = (unsigned)(((wr * 64 + fr) * 1024 + col0) * 4);
        f32x4 bs[8][2][2]; u32x2 ds[8][2][2];
#define EPR_SOFF(c, bj, n) (((((c) >> 2) * HALF + ((c) & 3) * 16) * 1024 + (bj) * HALF + (n) * 16) * 4)
#define EPR_LOAD(c) do { _Pragma("unroll") for (int bj = 0; bj < 2; ++bj) _Pragma("unroll") for (int n = 0; n < 2; ++n) { \
            bs[c][bj][n] = __builtin_bit_cast(f32x4, __builtin_amdgcn_raw_buffer_load_b128(rx, vb, EPR_SOFF(c, bj, n), 0)); \
            ds[c][bj][n] = __builtin_bit_cast(u32x2, __builtin_amdgcn_raw_buffer_load_b64(rd, vb >> 1, EPR_SOFF(c, bj, n) / 2, 0)); } asm volatile("" ::: "memory"); } while (0)
#pragma unroll
        for (int c = 0; c < RP_DEPTH; ++c) { if (c == 0) EPR_LOAD(0); else if (c == 1) EPR_LOAD(1); else if (c == 2) EPR_LOAD(2); else EPR_LOAD(3); }
#pragma unroll
        for (int c = 0; c < 8; ++c) { const int ai = c >> 2, m = c & 3;
#pragma unroll
            for (int bj = 0; bj < 2; ++bj)
#pragma unroll
                for (int n = 0; n < 2; ++n) { const u32x2 d = ds[c][bj][n]; const f32x4 dv = (f32x4){bf_lo(d.x), bf_hi(d.x), bf_lo(d.y), bf_hi(d.y)};
                    *(f32x4*)((char*)xout + vb + EPR_SOFF(c, bj, n)) = (bs[c][bj][n] + dv) + gt[bj][n] * acc[ai][bj][m][n]; }
            asm volatile("" ::: "memory");
            if (c + RP_DEPTH < 8) { const int cn = c + RP_DEPTH; if (cn == 3) EPR_LOAD(3); else if (cn == 4) EPR_LOAD(4); else if (cn == 5) EPR_LOAD(5); else if (cn == 6) EPR_LOAD(6); else EPR_LOAD(7); } }
#undef EPR_LOAD
#undef EPR_SOFF
    }
};

struct MergeOrder {
    const bf16_t* H; const bf16_t* YB; const bf16_t* WmT; const bf16_t* WbrT; int G, c, nctx;
    __device__ bool next(int i, Unit& u) const {
        const int nl = (c < 256) ? 1 + (255 - c) / G : 0;
        if (i < 8 * nl) { const int t = c + (i >> 3) * G, q = i & 7; u.pm = t >> 2; u.pn = t & 3; u.r = 2 * (q >> 2) + (q & 1); u.kind = (q & 2) ? 0 : 1; return true; }
        const int j = i - 8 * nl;
        if (nctx == 0 || (c & 7) != 0) return false;
        const int jb = (c >> 3) + (j >> 1) * (G >> 3); if (jb >= nctx) return false;
        const int t = jb >> 2; u.pm = 64 + (t >> 2); u.pn = t & 3; u.r = jb & 3; u.kind = (j & 1) ? 2 : 1; return true;
    }
    __device__ __forceinline__ void src(const Gemm&, const Unit& u, const char*& pa, const char*& pb, const char*& pb1, int& nt) const {
        if (u.kind == 1) { pa = (const char*)(YB + (size_t)u.pm * 256 * 1024 + u.r * 256); pb = (const char*)(WbrT + (size_t)u.pn * 256 * 1024 + u.r * 256); pb1 = pb + (size_t)HALF * 1024 * 2; nt = 4; }
        else if (u.kind == 2) { pa = (const char*)(H + (size_t)u.pm * 256 * 1024); pb = (const char*)(WmT + ((size_t)u.r * 1024 + u.pn * 256) * 1024); pb1 = pb + (size_t)HALF * 1024 * 2; nt = 16; }
        else { pa = (const char*)(H + (size_t)u.pm * 256 * 1024); pb = (const char*)(WmT + ((size_t)(u.r & 2) * 1024 + u.pn * 256 + (u.r & 1) * HALF) * 1024); pb1 = pb + (size_t)1024 * 1024 * 2; nt = 16; }
    }
};
typedef unsigned long long u64_t;
__device__ __forceinline__ u64_t ld_sc1(const void* p) { return __hip_atomic_load((const u64_t*)p, __ATOMIC_RELAXED, __HIP_MEMORY_SCOPE_AGENT); }
struct EpiMerge {
    static constexpr bool PERM = true; static constexpr int NSTORE = 8;
    bf16_t* GT; bf16_t* MG; float* MGc; const float* bias; bf16_t* GTc; bf16_t* GT2;
    typedef unsigned u32x2 __attribute__((ext_vector_type(2)));
    __device__ __forceinline__ void gate_ctx(const f32x4 (&acc)[2][2][4][2], bf16_t* Yu, int row0, int col0, const f32x4 (&bv)[2][2]) const {
        const __amdgpu_buffer_rsrc_t ry = __builtin_amdgcn_make_buffer_rsrc((void*)Yu, 0, 0x7fffffff, 0x00020000);
        u32x4 yq[8][2];
        const unsigned vb = (unsigned)((row0 * 1024 + col0) * 2);
#define EPM_SOFF(c) ((((c) >> 2) * HALF + ((c) & 3) * 16) * 1024 * 2)
#define EPM_LOAD(c) do { _Pragma("unroll") for (int bj = 0; bj < 2; ++bj) \
            yq[c][bj] = __builtin_bit_cast(u32x4, __builtin_amdgcn_raw_buffer_load_b128(ry, vb, EPM_SOFF(c) + bj * HALF * 2, 16)); asm volatile("" ::: "memory"); } while (0)
        EPM_LOAD(0); EPM_LOAD(1); EPM_LOAD(2); EPM_LOAD(3);
#pragma unroll
        for (int c = 0; c < 8; ++c) { const int ai = c >> 2, mm = c & 3;
#pragma unroll
            for (int bj = 0; bj < 2; ++bj) { f32x4 g0 = acc[ai][bj][mm][0] + bv[bj][0], g1 = acc[ai][bj][mm][1] + bv[bj][1];
#pragma unroll
                for (int e = 0; e < 4; ++e) { g0[e] = sigmoidf_(g0[e]); g1[e] = sigmoidf_(g1[e]); }
                const u32x4 y = yq[c][bj];
                u32x4 w;
                w.x = cvt_pk_bf16(g0[0] * bf_lo(y.x), g0[1] * bf_hi(y.x)); w.y = cvt_pk_bf16(g0[2] * bf_lo(y.y), g0[3] * bf_hi(y.y));
                w.z = cvt_pk_bf16(g1[0] * bf_lo(y.z), g1[1] * bf_hi(y.z)); w.w = cvt_pk_bf16(g1[2] * bf_lo(y.w), g1[3] * bf_hi(y.w));
                *(u32x4*)((char*)Yu + vb + EPM_SOFF(c) + bj * HALF * 2) = w; }
            asm volatile("" ::: "memory");
            if (c + 4 < 8) { if (c == 0) EPM_LOAD(4); else if (c == 1) EPM_LOAD(5); else if (c == 2) EPM_LOAD(6); else EPM_LOAD(7); } }
#undef EPM_LOAD
#undef EPM_SOFF
    }
#ifndef GP_DEPTH
#define GP_DEPTH 4
#endif
    template <bool FIRST> __device__ __forceinline__ void gate_pair(const f32x4 (&acc)[2][2][4][2], int row0, int colb, const f32x4 (&bv)[2][2]) const {
        const __amdgpu_buffer_rsrc_t r0 = __builtin_amdgcn_make_buffer_rsrc((void*)GT, 0, 0x7fffffff, 0x00020000), r1 = __builtin_amdgcn_make_buffer_rsrc((void*)GT2, 0, 0x7fffffff, 0x00020000),
                                     ro = __builtin_amdgcn_make_buffer_rsrc((void*)MG, 0, 0x7fffffff, 0x00020000);
        u32x4 y0q[8], y1q[8], oq[8];
        const unsigned vb = (unsigned)((row0 * 1024 + colb) * 2);
#define EPM_SOFF(c) ((((c) >> 2) * HALF + ((c) & 3) * 16) * 1024 * 2)
#define EPM_LOAD(c) do { \
            y0q[c] = __builtin_bit_cast(u32x4, __builtin_amdgcn_raw_buffer_load_b128(r0, vb, EPM_SOFF(c), 16)); y1q[c] = __builtin_bit_cast(u32x4, __builtin_amdgcn_raw_buffer_load_b128(r1, vb, EPM_SOFF(c), 16)); \
            oq[c] = FIRST ? (u32x4){0u, 0u, 0u, 0u} : __builtin_bit_cast(u32x4, __builtin_amdgcn_raw_buffer_load_b128(ro, vb, EPM_SOFF(c), 16)); asm volatile("" ::: "memory"); } while (0)
#pragma unroll
        for (int c = 0; c < GP_DEPTH; ++c) { if (c == 0) EPM_LOAD(0); else if (c == 1) EPM_LOAD(1); else if (c == 2) EPM_LOAD(2); else if (c == 3) EPM_LOAD(3); else if (c == 4) EPM_LOAD(4); else if (c == 5) EPM_LOAD(5); else if (c == 6) EPM_LOAD(6); else EPM_LOAD(7); }
#pragma unroll
        for (int c = 0; c < 8; ++c) { const int ai = c >> 2, mm = c & 3;
            f32x4 ga0 = acc[ai][0][mm][0] + bv[0][0], ga1 = acc[ai][0][mm][1] + bv[0][1], gb0 = acc[ai][1][mm][0] + bv[1][0], gb1 = acc[ai][1][mm][1] + bv[1][1];
#pragma unroll
            for (int e = 0; e < 4; ++e) { ga0[e] = sigmoidf_(ga0[e]); ga1[e] = sigmoidf_(ga1[e]); gb0[e] = sigmoidf_(gb0[e]); gb1[e] = sigmoidf_(gb1[e]); }
            const u32x4 ya = y0q[c], yb = y1q[c], o = oq[c];
            u32x4 w;
            w.x = cvt_pk_bf16(bf_lo(o.x) + ga0[0] * bf_lo(ya.x) + gb0[0] * bf_lo(yb.x), bf_hi(o.x) + ga0[1] * bf_hi(ya.x) + gb0[1] * bf_hi(yb.x));
            w.y = cvt_pk_bf16(bf_lo(o.y) + ga0[2] * bf_lo(ya.y) + gb0[2] * bf_lo(yb.y), bf_hi(o.y) + ga0[3] * bf_hi(ya.y) + gb0[3] * bf_hi(yb.y));
            w.z = cvt_pk_bf16(bf_lo(o.z) + ga1[0] * bf_lo(ya.z) + gb1[0] * bf_lo(yb.z), bf_hi(o.z) + ga1[1] * bf_hi(ya.z) + gb1[1] * bf_hi(yb.z));
            w.w = cvt_pk_bf16(bf_lo(o.w) + ga1[2] * bf_lo(ya.w) + gb1[2] * bf_lo(yb.w), bf_hi(o.w) + ga1[3] * bf_hi(ya.w) + gb1[3] * bf_hi(yb.w));
            *(u32x4*)((char*)MG + vb + EPM_SOFF(c)) = w;
            asm volatile("" ::: "memory");
            if (c + GP_DEPTH < 8) { const int cn = c + GP_DEPTH; if (cn == 1) EPM_LOAD(1); else if (cn == 2) EPM_LOAD(2); else if (cn == 3) EPM_LOAD(3); else if (cn == 4) EPM_LOAD(4); else if (cn == 5) EPM_LOAD(5); else if (cn == 6) EPM_LOAD(6); else EPM_LOAD(7); } }
#undef EPM_LOAD
#undef EPM_SOFF
    }
    __device__ __forceinline__ void operator()(const f32x4 (&acc)[2][2][4][2], const Unit& u, int wr, int wc, int fr, int fq) const {
        const int row0 = u.pm * BM + wr * 64 + fr; const int col0 = u.pn * BM + wc * 32 + 8 * fq;
        if (u.kind == 1) {
            bf16_t* Yu = (u.pm >= 64) ? GTc + ((size_t)u.r * 512 - 16384) * 1024 : ((u.r & 1) ? GT2 : GT);
#pragma unroll
            for (int ai = 0; ai < 2; ++ai)
#pragma unroll
                for (int m = 0; m < 4; ++m) { bf16_t* rowp = Yu + (size_t)(row0 + ai * HALF + m * 16) * 1024 + col0;
#pragma unroll
                    for (int bj = 0; bj < 2; ++bj) { const f32x4 v0 = acc[ai][bj][m][0], v1 = acc[ai][bj][m][1];
                        u32x4 w; w.x = cvt_pk_bf16(v0[0], v0[1]); w.y = cvt_pk_bf16(v0[2], v0[3]); w.z = cvt_pk_bf16(v1[0], v1[1]); w.w = cvt_pk_bf16(v1[2], v1[3]);
                        *(u32x4*)(rowp + bj * HALF) = w; } }
        } else if (u.kind == 2) {
            bf16_t* Yu = GTc + ((size_t)u.r * 512 - 16384) * 1024;
            const float* bp = bias + u.r * 1024 + col0;
            f32x4 bv[2][2];
#pragma unroll
            for (int bj = 0; bj < 2; ++bj)
#pragma unroll
                for (int n = 0; n < 2; ++n) bv[bj][n] = *(const f32x4*)(bp + bj * HALF + 4 * n);
            gate_ctx(acc, Yu, row0, col0, bv);
        } else {
            const int p2 = u.r & 2, colb = u.pn * BM + (u.r & 1) * HALF + wc * 32 + 8 * fq;
            f32x4 bv[2][2];
#pragma unroll
            for (int bj = 0; bj < 2; ++bj)
#pragma unroll
                for (int n = 0; n < 2; ++n) bv[bj][n] = *(const f32x4*)(bias + (p2 + bj) * 1024 + colb + 4 * n);
            if (p2 == 0) gate_pair<true>(acc, row0, colb, bv); else gate_pair<false>(acc, row0, colb, bv);
        }
    }
};
struct OrderOut {
    StaticOrder so; int nx; const bf16_t* TERM;
    __device__ bool next(int i, Unit& u) const {
        const long L = (long)i * so.G + so.c;
        if (L < so.nwg) return so.next(i, u);
        const int e = (int)(L - so.nwg); if (e >= nx) return false;
        const int t = e >> 4; u.pm = 64 + (t >> 2); u.pn = t & 3; u.r = e & 15; u.kind = 3; return true;
    }
    __device__ __forceinline__ void src(const Gemm& g, const Unit& u, const char*& pa, const char*& pb, const char*& pb1, int& nt) const {
        pa = (const char*)g.A + (size_t)u.pm * (2 * HALF) * g.lda * 2; pb = (const char*)g.Bt + (size_t)u.pn * (2 * HALF) * g.ldb * 2; nt = g.K / BK;
        if (u.kind == 3) { const int br = u.r >> 2, kq = u.r & 3; pa = (const char*)(TERM + ((size_t)br * 512 + (u.pm - 64) * 256) * 1024 + kq * 256); pb += (size_t)kq * 256 * 2; nt = 4; }
        pb1 = pb + (size_t)HALF * g.ldb * 2;
    }
};

template <class Epi, class Sched, bool ALIGN_EPI, bool RELAX = false>
__device__ __forceinline__ void gemm_phase(PG8_LAS unsigned char* lds, const Gemm g, const Sched& S, const Epi& E) {
    int tid = threadIdx.x; asm volatile("" : "+v"(tid));
    const int wid = __builtin_amdgcn_readfirstlane(tid >> 6), lane = tid & 63, wr = wid >> 2, wc = wid & 3, fr = lane & 15, fq = lane >> 4;
    int nt;
    unsigned voffA[2], voffB[2];
#pragma unroll
    for (int i = 0; i < 2; ++i) { int R, C; stage_rc(tid * 16 + i * 8192, R, C); const int Rb = Epi::PERM ? ((R & ~31) + perm32(R & 31)) : R;
        voffA[i] = (unsigned)(R * g.lda + C) * 2u; voffB[i] = (unsigned)(Rb * g.ldb + C) * 2u; }
    const size_t kstep = (size_t)(BK * 2);
    const size_t hstepA = (size_t)HALF * g.lda * 2;
    const unsigned ldsw = (unsigned)wid * 1024u;
    const int aoff = lds_byte(wr * 64 + fr, fq * 8), boff = lds_byte(wc * 32 + fr, fq * 8);
#define PG8_SA(b, h) (((b) * 2 + (h)) * HTB)
#define PG8_SB(b, h) ((4 + (b) * 2 + (h)) * HTB)
#define PG8_STAGE(bufoff, gbase, voff) do { _Pragma("unroll") for (int _i = 0; _i < 2; ++_i) { unsigned vo_ = (voff)[_i]; asm volatile("" : "+v"(vo_));        \
        __builtin_amdgcn_global_load_lds((const unsigned*)((const char*)(gbase) + vo_), (PG8_LAS unsigned*)(lds + (bufoff) + ldsw + _i * 8192), 16, 0, 0); } } while (0)
#define PG8_LDA(dst, b, h) do { _Pragma("unroll") for (int m = 0; m < 4; ++m) _Pragma("unroll") for (int k = 0; k < 2; ++k) dst[m][k] = *(const PG8_LAS bf16x8*)(lds + PG8_SA(b, h) + aoff + m * 2048 + k * 1024); } while (0)
#define PG8_LDB(dst, b, h) do { _Pragma("unroll") for (int n = 0; n < 2; ++n) _Pragma("unroll") for (int k = 0; k < 2; ++k) dst[n][k] = *(const PG8_LAS bf16x8*)(lds + PG8_SB(b, h) + boff + n * 2048 + k * 1024); } while (0)
#define PG8_MMA(ai, bj, At, Bt) do { __builtin_amdgcn_s_setprio(1); _Pragma("unroll") for (int m = 0; m < 4; ++m) _Pragma("unroll") for (int n = 0; n < 2; ++n) _Pragma("unroll") for (int k = 0; k < 2; ++k) \
        acc[ai][bj][m][n] = __builtin_amdgcn_mfma_f32_16x16x32_bf16(Bt[n][k], At[m][k], acc[ai][bj][m][n], 0, 0, 0); __builtin_amdgcn_s_setprio(0); } while (0)
#define PG8_WAIT_V(n) asm volatile("s_waitcnt vmcnt(" #n ")" ::: "memory")
#define PG8_WAIT_L(n) asm volatile("s_waitcnt lgkmcnt(" #n ")" ::: "memory")
#define PG8_WAIT_VX(rx) asm volatile("s_cmp_eq_u32 %0, 0\n\ts_cbranch_scc1 .Lpg8w8_%=\n\ts_waitcnt vmcnt(%1)\n\ts_branch .Lpg8wd_%=\n.Lpg8w8_%=:\n\ts_waitcnt vmcnt(8)\n.Lpg8wd_%=:" :: "s"(rx), "n"(8 + Epi::NSTORE) : "memory", "scc")
#define PG8_BAR __builtin_amdgcn_s_barrier()
#define PG8_SCHED __builtin_amdgcn_sched_barrier(0)
    Unit cur, nxt; int ui = 0;
    if (!S.next(0, cur)) return;
    f32x4 acc[2][2][4][2];
#pragma unroll
    for (int a = 0; a < 2; ++a)
#pragma unroll
        for (int b = 0; b < 2; ++b)
#pragma unroll
            for (int m = 0; m < 4; ++m)
#pragma unroll
                for (int n = 0; n < 2; ++n) acc[a][b][m][n] = (f32x4){0.f, 0.f, 0.f, 0.f};
    bf16x8 At[4][2], B0[2][2], B1[2][2];
    const char* cA; const char* cB; const char* cB1; S.src(g, cur, cA, cB, cB1, nt);
    PG8_STAGE(PG8_SB(0, 0), cB, voffB); PG8_STAGE(PG8_SB(0, 1), cB1, voffB); PG8_STAGE(PG8_SA(0, 0), cA, voffA); PG8_STAGE(PG8_SA(0, 1), cA + hstepA, voffA);
    if (wr == 1) PG8_BAR;
    PG8_WAIT_V(2); PG8_BAR;
    PG8_STAGE(PG8_SB(1, 0), cB + kstep, voffB); PG8_STAGE(PG8_SA(1, 0), cA + kstep, voffA); PG8_STAGE(PG8_SB(1, 1), cB1 + kstep, voffB);
    PG8_WAIT_V(6); PG8_BAR;
    for (;;) {
        const bool has_next = S.next(ui + 1, nxt);
        const char* nA = cA; const char* nB = cB; const char* nB1 = cB1; int nnt = nt; if (has_next) S.src(g, nxt, nA, nB, nB1, nnt);
        for (int t = 0; t < nt; t += 2) {
            const bool last = (t == nt - 2);
            const char* a1 = cA + (size_t)(t + 1) * kstep;
            const char* a2 = last ? nA : cA + (size_t)(t + 2) * kstep; const char* b2 = last ? nB : cB + (size_t)(t + 2) * kstep;
            const char* a3 = a2 + kstep; const char* b3 = b2 + kstep;
            const char* b2h = last ? nB1 : cB1 + (size_t)(t + 2) * kstep; const char* b3h = b2h + kstep;
            asm volatile("" : "+s"(a1), "+s"(a2), "+s"(a3), "+s"(b2), "+s"(b3), "+s"(b2h), "+s"(b3h));
            const int relax = __builtin_amdgcn_readfirstlane((RELAX && Epi::NSTORE > 0 && t == 0 && ui > 0) ? 1 : 0);
            PG8_LDB(B0, 0, 0); PG8_LDB(B1, 0, 1); PG8_SCHED; PG8_LDA(At, 0, 0); PG8_STAGE(PG8_SA(1, 1), a1 + hstepA, voffA);
            PG8_WAIT_VX(relax); PG8_WAIT_L(0); PG8_BAR; PG8_MMA(0, 0, At, B0); PG8_MMA(0, 1, At, B1); PG8_BAR; PG8_SCHED;
            PG8_LDA(At, 0, 1); PG8_STAGE(PG8_SB(0, 0), b2, voffB); PG8_STAGE(PG8_SB(0, 1), b2h, voffB); PG8_STAGE(PG8_SA(0, 0), a2, voffA);
            PG8_WAIT_VX(relax); PG8_WAIT_L(0); PG8_BAR; PG8_MMA(1, 0, At, B0); PG8_MMA(1, 1, At, B1); PG8_BAR; PG8_SCHED;
            PG8_LDB(B0, 1, 0); PG8_LDB(B1, 1, 1); PG8_SCHED; PG8_LDA(At, 1, 0); PG8_STAGE(PG8_SA(0, 1), a2 + hstepA, voffA);
            PG8_WAIT_V(8); PG8_WAIT_L(0); PG8_BAR; PG8_MMA(0, 0, At, B0); PG8_MMA(0, 1, At, B1); PG8_BAR; PG8_SCHED;
            PG8_LDA(At, 1, 1); PG8_STAGE(PG8_SB(1, 0), b3, voffB); PG8_STAGE(PG8_SB(1, 1), b3h, voffB); PG8_STAGE(PG8_SA(1, 0), a3, voffA);
            PG8_WAIT_V(8); PG8_WAIT_L(0); PG8_BAR; PG8_MMA(1, 0, At, B0); PG8_MMA(1, 1, At, B1); PG8_BAR; PG8_SCHED;
        }
        if constexpr (ALIGN_EPI) { if (wr == 0) PG8_BAR; }
        E(acc, cur, wr, wc, fr, fq);
        if (!has_next) break;
#pragma unroll
        for (int a = 0; a < 2; ++a)
#pragma unroll
            for (int b = 0; b < 2; ++b)
#pragma unroll
                for (int m = 0; m < 4; ++m)
#pragma unroll
                    for (int n = 0; n < 2; ++n) acc[a][b][m][n] = (f32x4){0.f, 0.f, 0.f, 0.f};
        cur = nxt; cA = nA; cB = nB; cB1 = nB1; nt = nnt; ++ui;
        if constexpr (ALIGN_EPI) { if (wr == 1) PG8_BAR; }
    }
    PG8_WAIT_V(0);
    if constexpr (!ALIGN_EPI) { if (wr == 0) PG8_BAR; }
    PG8_BAR;
#undef PG8_SA
#undef PG8_SB
#undef PG8_STAGE
#undef PG8_LDA
#undef PG8_LDB
#undef PG8_MMA
#undef PG8_WAIT_V
#undef PG8_WAIT_L
#undef PG8_WAIT_VX
#undef PG8_BAR
#undef PG8_SCHED
}
}
namespace attn_body {
using bf16=__hip_bfloat16;
using bf16x8=__attribute__((ext_vector_type(8)))short;
using s16x4=__attribute__((ext_vector_type(4)))short;
using f32x16=__attribute__((ext_vector_type(16)))float;
using u32x4=__attribute__((ext_vector_type(4)))unsigned;
using f32x4=__attribute__((ext_vector_type(4)))float;
constexpr int D=64;
constexpr int NW=8,QBLK=32,QB=QBLK*NW,KVBLK=64;
constexpr int PP=2816, YP=1024;
__device__ __forceinline__ int crow(int r,int hi){return (r&3)+8*(r>>2)+4*hi;}
#define SBAR() __builtin_amdgcn_sched_barrier(0)
__device__ __forceinline__ void dmask(f32x16&p0,f32x16&p1,int kb,unsigned lim,int qrel,int hi){
  const float NEG=-INFINITY; const unsigned b0=(unsigned)(kb+4*hi-qrel+128);
  #pragma unroll
  for(int r=0;r<16;++r){const unsigned dd=b0+(unsigned)((r&3)+8*(r>>2)); if(dd>lim)p0[r]=NEG; if(dd+32u>lim)p1[r]=NEG;}
}

constexpr int NSLOT=3, SLOTB=8192;
constexpr int LDS_K=0, LDS_V=NSLOT*SLOTB, LDS_WS=2*NSLOT*SLOTB, LDS_OST=LDS_WS+NW*64*4, LDS_BYTES=LDS_OST+NW*4096;
constexpr float C2=0.125f*1.4426950408889634f;
__device__ __forceinline__ void glds16(const void*gsrc,unsigned lds_dst){unsigned keep;
  asm volatile("s_mov_b32 %0, m0\n\ts_mov_b32 m0, %2\n\ts_nop 0\n\tglobal_load_lds_dwordx4 %1, off\n\ts_mov_b32 m0, %0":"=&s"(keep):"v"(gsrc),"s"(lds_dst):"memory");}
__device__ __forceinline__ float siluf_(float x){ return x*__builtin_amdgcn_rcpf(1.0f+__builtin_amdgcn_exp2f(-1.4426950408889634f*x)); }
__device__ __forceinline__ float max3f(float a,float b,float c){float r;asm("v_max3_f32 %0, %1, %2, %3":"=v"(r):"v"(a),"v"(b),"v"(c));return r;}
__device__ __forceinline__ float max2f(float a,float b){float r;asm("v_max_f32_e32 %0, %1, %2":"=v"(r):"v"(a),"v"(b));return r;}
__device__ __forceinline__ float fadd_s(float a,float b){float r;asm("v_add_f32_e32 %0, %1, %2":"=v"(r):"v"(a),"v"(b));return r;}
__device__ __forceinline__ float fsub_s(float a,float b){float r;asm("v_sub_f32_e32 %0, %1, %2":"=v"(r):"v"(a),"v"(b));return r;}
typedef float f32x2_t __attribute__((ext_vector_type(2))); typedef __bf16 bf16x2_t __attribute__((ext_vector_type(2)));
__device__ __forceinline__ unsigned cvtpk_s(float lo,float hi){f32x2_t v={lo,hi};bf16x2_t b=__builtin_convertvector(v,bf16x2_t);return __builtin_bit_cast(unsigned,b);}
#define WAIT_BAR(N) asm volatile("s_waitcnt vmcnt(" #N ") lgkmcnt(0)\n\ts_barrier":::"memory")

__device__ __forceinline__ void qkt(f32x16&p0,f32x16&p1,const char*Kslot,const bf16x8*qr,const f32x16&negm,int r32,int hi){
  const char*kb=Kslot+hi*1024+r32*16;
  #pragma unroll
  for(int d0=0;d0<4;++d0){
    const bf16x8 b0=*reinterpret_cast<const bf16x8*>(kb+d0*2048);
    const bf16x8 b1=*reinterpret_cast<const bf16x8*>(kb+d0*2048+512);
    if(d0==0){p0=__builtin_amdgcn_mfma_f32_32x32x16_bf16(b0,qr[0],negm,0,0,0);p1=__builtin_amdgcn_mfma_f32_32x32x16_bf16(b1,qr[0],negm,0,0,0);}
    else{p0=__builtin_amdgcn_mfma_f32_32x32x16_bf16(b0,qr[d0],p0,0,0,0);p1=__builtin_amdgcn_mfma_f32_32x32x16_bf16(b1,qr[d0],p1,0,0,0);}}
}
typedef __attribute__((address_space(3))) const char* lds_cptr;
typedef short v4i16_t __attribute__((ext_vector_type(4)));
__device__ __forceinline__ void kload8(bf16x8*kf,lds_cptr kp){
  kf[0]=*(const __attribute__((address_space(3))) bf16x8*)(kp);      kf[1]=*(const __attribute__((address_space(3))) bf16x8*)(kp+512);
  kf[2]=*(const __attribute__((address_space(3))) bf16x8*)(kp+2048); kf[3]=*(const __attribute__((address_space(3))) bf16x8*)(kp+2560);
  kf[4]=*(const __attribute__((address_space(3))) bf16x8*)(kp+4096); kf[5]=*(const __attribute__((address_space(3))) bf16x8*)(kp+4608);
  kf[6]=*(const __attribute__((address_space(3))) bf16x8*)(kp+6144); kf[7]=*(const __attribute__((address_space(3))) bf16x8*)(kp+6656);
}
__device__ __forceinline__ void kload2(bf16x8*kf,lds_cptr kp,int j){ kf[2*j]=*(const __attribute__((address_space(3))) bf16x8*)(kp+j*2048); kf[2*j+1]=*(const __attribute__((address_space(3))) bf16x8*)(kp+j*2048+512); }
__device__ __forceinline__ s16x4 vtr(lds_cptr p){ return __builtin_bit_cast(s16x4,__builtin_amdgcn_ds_read_tr16_b64_v4i16((__attribute__((address_space(3))) v4i16_t*)p)); }
__device__ __forceinline__ float rowmax(const f32x16&p0,const f32x16&p1){
  float a=max3f(p0[0],p0[1],p1[0]),b=max3f(p0[2],p0[3],p1[1]);a=max3f(a,p1[2],p1[3]);
  #pragma unroll
  for(int r=4;r<16;r+=4){a=max3f(a,p0[r],p0[r+1]);b=max3f(b,p0[r+2],p0[r+3]);a=max3f(a,p1[r],p1[r+1]);b=max3f(b,p1[r+2],p1[r+3]);}
  const float m=max2f(a,b);
  auto rr=__builtin_amdgcn_permlane32_swap(__float_as_uint(m),__float_as_uint(m),false,false);
  return max2f(__uint_as_float(rr[0]),__uint_as_float(rr[1]));
}
__device__ __forceinline__ void pv(f32x16*o,int vb,bf16x8 pa0,bf16x8 pa1,bf16x8 pa2,bf16x8 pa3){
  #pragma unroll
  for(int d0=0;d0<2;++d0){s16x4 lo[4],hi[4];
    #pragma unroll
    for(int ks=0;ks<4;++ks){
      asm volatile("ds_read_b64_tr_b16 %0,%1 offset:%c2":"=&v"(lo[ks]):"v"(vb),"i"(d0*4096+ks*1024):"memory");
      asm volatile("ds_read_b64_tr_b16 %0,%1 offset:%c2":"=&v"(hi[ks]):"v"(vb),"i"(d0*4096+ks*1024+512):"memory");}
    asm volatile("s_waitcnt lgkmcnt(0)":::"memory");SBAR();
    #define PK(k) (bf16x8){lo[k][0],lo[k][1],lo[k][2],lo[k][3],hi[k][0],hi[k][1],hi[k][2],hi[k][3]}
    o[d0]=__builtin_amdgcn_mfma_f32_32x32x16_bf16(pa0,PK(0),o[d0],0,0,0);
    o[d0]=__builtin_amdgcn_mfma_f32_32x32x16_bf16(pa1,PK(1),o[d0],0,0,0);
    o[d0]=__builtin_amdgcn_mfma_f32_32x32x16_bf16(pa2,PK(2),o[d0],0,0,0);
    o[d0]=__builtin_amdgcn_mfma_f32_32x32x16_bf16(pa3,PK(3),o[d0],0,0,0);
    #undef PK
  }
}

#ifndef ATTN_STORE16
#define ATTN_STORE16(p,v) (*(u32x4*)(p)=(v))
#endif
template<int MODE,int THRL> __device__ __forceinline__ void attn_unit(const bf16*Pm,bf16*YB,int qrow0,int ctx0,int lat0,int off,int NT,int wq0,int qcol,int kcol,int vcol,int zcol,int ocol,float sinkl2,char*shm,const float*qw,int rope){
  int tid_=threadIdx.x; asm volatile("":"+v"(tid_)); const int tid=tid_,lane=tid&63,r32=lane&31,hi=lane>>5; const int wid=__builtin_amdgcn_readfirstlane(tid>>6);
  const bf16*Qw=Pm+(long)(qrow0+wid*QBLK)*PP+qcol;
  const unsigned lds0=(unsigned)(uintptr_t)shm;
  float*wsf=(float*)(shm+LDS_WS)+wid*64;
  const bf16*ksrc=Pm+kcol+(long)lane*PP+wid*8;
  const bf16*vsrc=Pm+vcol+(long)(16*(wid&3)+(lane>>2))*PP+(wid>>2)*32+(lane&3)*8;
  const unsigned kdst=lds0+LDS_K+wid*1024, vdst=lds0+LDS_V+wid*1024;
  #define TROW(t) (((t)<4)?(ctx0+64*(t)):(lat0+64*((t)-4+off)))
  #define DMA_K(t,slot) glds16(ksrc+(long)TROW(t)*PP,(unsigned)__builtin_amdgcn_readfirstlane(kdst+(slot)))
  #define DMA_V(t,slot) glds16(vsrc+(long)TROW(t)*PP,(unsigned)__builtin_amdgcn_readfirstlane(vdst+(slot)))
  const int vb0=(int)(lds0+LDS_V)+((lane>>4)&1)*32+(lane&3)*8+(4*hi+((lane&15)>>2))*64;
  const char*Kbase=shm+LDS_K; bf16x8 kf[8];
  const lds_cptr shm3=(lds_cptr)shm; const lds_cptr kp0=shm3+LDS_K+hi*1024+r32*16; const lds_cptr vp0=shm3+LDS_V+((lane>>4)&1)*32+(lane&3)*8+(4*hi+((lane&15)>>2))*64;
  DMA_K(0,0);DMA_V(0,0);DMA_K(1,SLOTB);
  bf16x8 qr[4];
  { bf16x8 qraw[4];
    #pragma unroll
    for(int d0=0;d0<4;++d0)qraw[d0]=*reinterpret_cast<const bf16x8*>(&Qw[(long)r32*PP+d0*16+hi*8]);
    f32x4 wq[4][2];
    #pragma unroll
    for(int d0=0;d0<4;++d0){wq[d0][0]=*reinterpret_cast<const f32x4*>(qw+16*d0+8*hi);wq[d0][1]=*reinterpret_cast<const f32x4*>(qw+16*d0+8*hi+4);}
    float ss=0.f;
    #pragma unroll
    for(int d0=0;d0<4;++d0)
      #pragma unroll
      for(int j=0;j<8;++j){const float f=__uint_as_float(((unsigned)(unsigned short)qraw[d0][j])<<16);ss+=f*f;}
    {auto rr=__builtin_amdgcn_permlane32_swap(__float_as_uint(ss),__float_as_uint(ss),false,false);ss=__uint_as_float(rr[0])+__uint_as_float(rr[1]);}
    const float rs=__builtin_amdgcn_rsqf(ss*(1.0f/64.0f)+1e-6f)*C2;
    const int ntok=(qrow0+wid*QBLK+r32)&8191;
    #pragma unroll
    for(int hf=0;hf<2;++hf){ const float pos=(float)(hf?(ntok&63):(ntok>>6)); unsigned pk1[4],pk2[4];
      #pragma unroll
      for(int jp=0;jp<4;++jp){ float y1[2],y2[2];
        #pragma unroll
        for(int e=0;e<2;++e){ const int j=2*jp+e; const int fi=8*hi+j;
          const float inv=__builtin_amdgcn_exp2f(-(float)fi*(13.287712379549449f/16.0f))*0.15915494309189535f;
          const float rev=pos*inv; const float cs=rope?__builtin_amdgcn_cosf(rev):1.0f, sn=rope?__builtin_amdgcn_sinf(rev):0.0f;
          const float x1=__uint_as_float(((unsigned)(unsigned short)qraw[2*hf][j])<<16)*rs*wq[2*hf][j>>2][j&3];
          const float x2=__uint_as_float(((unsigned)(unsigned short)qraw[2*hf+1][j])<<16)*rs*wq[2*hf+1][j>>2][j&3];
          y1[e]=x1*cs-x2*sn; y2[e]=x1*sn+x2*cs; }
        pk1[jp]=cvtpk_s(y1[0],y1[1]); pk2[jp]=cvtpk_s(y2[0],y2[1]); }
      qr[2*hf]=__builtin_bit_cast(bf16x8,(u32x4){pk1[0],pk1[1],pk1[2],pk1[3]}); qr[2*hf+1]=__builtin_bit_cast(bf16x8,(u32x4){pk2[0],pk2[1],pk2[2],pk2[3]}); } }
  float mhat=0.f,l_reg=0.f;f32x16 o[2];o[0]=f32x16{};o[1]=f32x16{};f32x16 negm=f32x16{}; if(MODE==0){asm volatile("":"+v"(negm));}
  const int qrel=wid*QBLK+r32;
  #define CMASK(P0,P1,t) do{ if(MODE==1){ if((t)>=4){ const int kb_=64*((t)-4)-wq0, dlo_=kb_-32*wid-31, dhi_=kb_+63-32*wid; if(dlo_<-128||dhi_>128) dmask(P0,P1,kb_,256u,qrel,hi); } } }while(0)
  bool resc=false;
  #define START(P0,P1) do{ const float rm=rowmax(P0,P1); resc=false; \
    { const float dl=rm; mhat=fadd_s(mhat,dl); \
      _Pragma("unroll") for(int r=0;r<16;++r){P0[r]=fsub_s(P0[r],dl);P1[r]=fsub_s(P1[r],dl);} \
      if(MODE==0){ _Pragma("unroll") for(int r=0;r<16;++r)negm[r]=-mhat; asm volatile("":"+v"(negm)); } } \
    _Pragma("unroll") for(int r=0;r<16;++r)P0[r]=__builtin_amdgcn_exp2f(P0[r]); }while(0)
  #define RESC() do{ if(resc){ asm volatile("s_waitcnt lgkmcnt(0)":::"memory"); \
      _Pragma("unroll") for(int d_=0;d_<2;++d_) _Pragma("unroll") for(int r=0;r<16;++r)o[d_][r]*=wsf[crow(r,hi)]; } }while(0)
  f32x16 pA0,pA1,pB0,pB1;
  int sl_prev=0,sl_cur=0,sl_next=SLOTB;
  #define ROT() do{sl_prev=sl_cur;sl_cur=sl_next;sl_next=(sl_next==(NSLOT-1)*SLOTB)?0:sl_next+SLOTB;}while(0)
  DMA_K(2,2*SLOTB);
  WAIT_BAR(3);
  qkt(pA0,pA1,Kbase,qr,negm,r32,hi);asm volatile("s_nop 15\n\ts_nop 7":"+v"(pA0),"+v"(pA1));CMASK(pA0,pA1,0);
  START(pA0,pA1);
  _Pragma("unroll") for(int r=0;r<16;++r)pA1[r]=__builtin_amdgcn_exp2f(pA1[r]);
  WAIT_BAR(0);
  DMA_K(3,0);DMA_V(1,SLOTB);
  ROT();
  kload8(kf,kp0+sl_cur);
  WAIT_BAR(2);
  s16x4 vlo[8],vhi[8]; u32x4 pw0,pw1,pw2,pw3;
  #define PKW(P,B) cvtpk_s(P[B],P[B+1])
  #define PAF(k) __builtin_bit_cast(bf16x8,pw##k)
  #define VFR(i) (bf16x8){vlo[i][0],vlo[i][1],vlo[i][2],vlo[i][3],vhi[i][0],vhi[i][1],vhi[i][2],vhi[i][3]}
  #define PIN(x) asm volatile("":"+v"(x))
  #define MX3(a,b,c) __builtin_fmaxf(__builtin_fmaxf((a),(b)),(c))
  #define GAPA(MF,A0,A1,A2,A3,W0,W1,PW) do{ MF; sacc+=A0; sacc+=A1; sacc+=A2; sacc+=A3; PIN(sacc); W0; W1; PIN(PW); SBAR(); }while(0)
  #define EX(v) __builtin_amdgcn_exp2f(v)
  #define GAPB(MF,X,B) do{ MF; X[B]=EX(X[B]); X[B+1]=EX(X[B+1]); X[B+2]=EX(X[B+2]); X[B+3]=EX(X[B+3]); PIN(X); SBAR(); }while(0)
  #define VRD(i) do{ vlo[i]=vtr(vp_+(((i)>>2)*4096+((i)&3)*1024)); vhi[i]=vtr(vp_+(((i)>>2)*4096+((i)&3)*1024+512)); }while(0)
  #define KRD(G,j) do{ if(G){ kload2(kf,kp0+sl_next,j); SBAR(); } }while(0)
  #define STEP(C0,C1,P0,P1,t,GK,GV,GL,MX) do{ SBAR(); \
    const lds_cptr vp_=vp0+sl_prev; \
    VRD(0); SBAR(); float sacc=(P0[0]+P0[1]); \
    GAPA(C0=__builtin_amdgcn_mfma_f32_32x32x16_bf16(kf[0],qr[0],negm,0,0,0), P0[2],P0[3],P0[4],P0[5],     pw0[0]=PKW(P0,0), pw0[1]=PKW(P0,2), pw0); \
    VRD(4); SBAR(); GAPA(C1=__builtin_amdgcn_mfma_f32_32x32x16_bf16(kf[1],qr[0],negm,0,0,0), P0[6],P0[7],P0[8],P0[9],     pw0[2]=PKW(P0,4), pw0[3]=PKW(P0,6), pw0); \
    VRD(1); SBAR(); GAPA(C0=__builtin_amdgcn_mfma_f32_32x32x16_bf16(kf[2],qr[1],C0,0,0,0),   P0[10],P0[11],P0[12],P0[13], pw1[0]=PKW(P0,8), pw1[1]=PKW(P0,10), pw1); \
    VRD(5); SBAR(); GAPA(C1=__builtin_amdgcn_mfma_f32_32x32x16_bf16(kf[3],qr[1],C1,0,0,0),   P0[14],P0[15],P1[0],P1[1],   pw1[2]=PKW(P0,12),pw1[3]=PKW(P0,14), pw1); \
    VRD(2); SBAR(); GAPA(C0=__builtin_amdgcn_mfma_f32_32x32x16_bf16(kf[4],qr[2],C0,0,0,0),   P1[2],P1[3],P1[4],P1[5],     pw2[0]=PKW(P1,0), pw2[1]=PKW(P1,2), pw2); \
    VRD(6); SBAR(); GAPA(C1=__builtin_amdgcn_mfma_f32_32x32x16_bf16(kf[5],qr[2],C1,0,0,0),   P1[6],P1[7],P1[8],P1[9],     pw2[2]=PKW(P1,4), pw2[3]=PKW(P1,6), pw2); \
    VRD(3); SBAR(); GAPA(C0=__builtin_amdgcn_mfma_f32_32x32x16_bf16(kf[6],qr[3],C0,0,0,0),   P1[10],P1[11],P1[12],P1[13], pw3[0]=PKW(P1,8), pw3[1]=PKW(P1,10), pw3); \
    VRD(7); SBAR(); GAPA(C1=__builtin_amdgcn_mfma_f32_32x32x16_bf16(kf[7],qr[3],C1,0,0,0),   P1[14],P1[15],0.f,0.f,       pw3[2]=PKW(P1,12),pw3[3]=PKW(P1,14), pw3); \
    l_reg+=sacc; \
    if(GK){DMA_K((t)+3,sl_cur);} if(GV){DMA_V((t)+1,sl_next);} \
    CMASK(C0,C1,t); \
    resc=false; if(MX){ float a=MX3(C0[0],C0[1],C1[0]),b=MX3(C0[2],C0[3],C1[1]); a=MX3(a,C1[2],C1[3]); \
      _Pragma("unroll") for(int r=4;r<16;r+=4){a=MX3(a,C0[r],C0[r+1]);b=MX3(b,C0[r+2],C0[r+3]);a=MX3(a,C1[r],C1[r+1]);b=MX3(b,C1[r+2],C1[r+3]);} \
      float rm=__builtin_fmaxf(a,b); { auto rr=__builtin_amdgcn_permlane32_swap(__float_as_uint(rm),__float_as_uint(rm),false,false); rm=__builtin_fmaxf(__uint_as_float(rr[0]),__uint_as_float(rr[1])); } \
      resc=false; if(MODE==1) rm-=mhat; \
      if(__builtin_expect(__any(rm>(float)THRL),0)){ const float dl=__builtin_fmaxf(rm,0.f); mhat+=dl; \
        if(MODE==0){ _Pragma("unroll") for(int r=0;r<16;++r){C0[r]-=dl;C1[r]-=dl;} \
          _Pragma("unroll") for(int r=0;r<16;++r)negm[r]=-mhat; asm volatile("":"+v"(negm)); } \
        const float f=__builtin_amdgcn_exp2f(-dl); l_reg*=f; if(hi==0)wsf[r32]=f; resc=true; } \
      if(MODE==1){ _Pragma("unroll") for(int r=0;r<16;++r){C0[r]-=mhat;C1[r]-=mhat;} } } \
    SBAR(); \
    GAPB(o[0]=__builtin_amdgcn_mfma_f32_32x32x16_bf16(PAF(0),VFR(0),o[0],0,0,0), C0,0); \
    GAPB(o[1]=__builtin_amdgcn_mfma_f32_32x32x16_bf16(PAF(0),VFR(4),o[1],0,0,0), C0,4); \
    KRD(GL,0); GAPB(o[0]=__builtin_amdgcn_mfma_f32_32x32x16_bf16(PAF(1),VFR(1),o[0],0,0,0), C0,8); \
    KRD(GL,1); GAPB(o[1]=__builtin_amdgcn_mfma_f32_32x32x16_bf16(PAF(1),VFR(5),o[1],0,0,0), C0,12); \
    KRD(GL,2); GAPB(o[0]=__builtin_amdgcn_mfma_f32_32x32x16_bf16(PAF(2),VFR(2),o[0],0,0,0), C1,0); \
    KRD(GL,3); GAPB(o[1]=__builtin_amdgcn_mfma_f32_32x32x16_bf16(PAF(2),VFR(6),o[1],0,0,0), C1,4); \
    GAPB(o[0]=__builtin_amdgcn_mfma_f32_32x32x16_bf16(PAF(3),VFR(3),o[0],0,0,0), C1,8); \
    GAPB(o[1]=__builtin_amdgcn_mfma_f32_32x32x16_bf16(PAF(3),VFR(7),o[1],0,0,0), C1,12); \
    }while(0)
  int t=1;
  if(MODE==0) for(;t+7<NT;t+=4){
    STEP(pB0,pB1,pA0,pA1,t,true,true,true,true);      WAIT_BAR(2); RESC(); ROT();
    STEP(pA0,pA1,pB0,pB1,t+1,true,true,true,false);   WAIT_BAR(2); RESC(); ROT();
    STEP(pB0,pB1,pA0,pA1,t+2,true,true,true,false);   WAIT_BAR(2); RESC(); ROT();
    STEP(pA0,pA1,pB0,pB1,t+3,true,true,true,false);   WAIT_BAR(2); RESC(); ROT();
  }
  if(MODE==0) for(;t+5<NT;t+=2){
    STEP(pB0,pB1,pA0,pA1,t,true,true,true,true);     WAIT_BAR(2); RESC(); ROT();
    STEP(pA0,pA1,pB0,pB1,t+1,true,true,true,false);   WAIT_BAR(2); RESC(); ROT();
  }
  #define ENDW(tt) do{ if((tt)+3<NT){WAIT_BAR(2);} else if((tt)+2<NT){WAIT_BAR(1);} else {WAIT_BAR(0);} }while(0)
  for(;t+1<NT;t+=2){
    STEP(pB0,pB1,pA0,pA1,t,(t+3<NT),(t+1<NT),(t+1<NT),true);       ENDW(t);   RESC(); ROT();
    STEP(pA0,pA1,pB0,pB1,t+1,(t+4<NT),(t+2<NT),(t+2<NT),true);     ENDW(t+1); RESC(); ROT();
  }
  STEP(pB0,pB1,pA0,pA1,NT-1,false,false,false,true); RESC();
  { float sacc=pB0[0]+pB0[1]; _Pragma("unroll") for(int r=2;r<16;++r)sacc+=pB0[r]; _Pragma("unroll") for(int r=0;r<16;++r)sacc+=pB1[r]; l_reg+=sacc;
    pw0=(u32x4){PKW(pB0,0),PKW(pB0,2),PKW(pB0,4),PKW(pB0,6)};pw1=(u32x4){PKW(pB0,8),PKW(pB0,10),PKW(pB0,12),PKW(pB0,14)};pw2=(u32x4){PKW(pB1,0),PKW(pB1,2),PKW(pB1,4),PKW(pB1,6)};pw3=(u32x4){PKW(pB1,8),PKW(pB1,10),PKW(pB1,12),PKW(pB1,14)};
    SBAR(); pv(o,vb0+sl_cur,PAF(0),PAF(1),PAF(2),PAF(3)); }
  #undef PKW
  #undef PAF
  #undef VFR
  #undef PIN
  #undef MX3
  #undef GAPA
  #undef GAPB
  #undef EX
  #undef VRD
  #undef KRD
  #undef STEP
  #undef ENDW
  {auto rr=__builtin_amdgcn_permlane32_swap(__float_as_uint(l_reg),__float_as_uint(l_reg),false,false);l_reg=__uint_as_float(rr[0])+__uint_as_float(rr[1]);}
  if(MODE==1){ l_reg+=__builtin_amdgcn_exp2f(sinkl2-mhat); }
  if(hi==0)wsf[32+r32]=l_reg;asm volatile("s_waitcnt lgkmcnt(0)":::"memory");
  float rli[16];
  #pragma unroll
  for(int r=0;r<16;++r)rli[r]=__builtin_amdgcn_rcpf(wsf[32+crow(r,hi)]);
  bf16*Ow=YB+(long)(qrow0+wid*QBLK)*YP+ocol; const bf16*Zw=Pm+(long)(qrow0+wid*QBLK)*PP+zcol;
  { bf16*stg=(bf16*)(shm+LDS_OST)+wid*2048;
    #pragma unroll
    for(int r=0;r<16;++r){const int orow=crow(r,hi);
      #pragma unroll
      for(int d0=0;d0<2;++d0)stg[orow*64+d0*32+r32]=__float2bfloat16(o[d0][r]*rli[r]);}
    asm volatile("s_waitcnt lgkmcnt(0)":::"memory");
    #pragma unroll
    for(int i=0;i<4;++i){const int row=i*8+(lane>>3),ch=lane&7; const u32x4 v=*(const u32x4*)(stg+row*64+ch*8); const u32x4 z=*(const u32x4*)(Zw+(long)row*PP+ch*8); u32x4 w;
      #define GATE2(vv,zz) cvtpk_s(__uint_as_float((vv)<<16)*siluf_(__uint_as_float((zz)<<16)),__uint_as_float((vv)&0xffff0000u)*siluf_(__uint_as_float((zz)&0xffff0000u)))
      w.x=GATE2(v.x,z.x); w.y=GATE2(v.y,z.y); w.z=GATE2(v.z,z.z); w.w=GATE2(v.w,z.w);
      #undef GATE2
      *(u32x4*)(Ow+(long)row*YP+ch*8)=w;} }
  asm volatile("s_waitcnt lgkmcnt(0)\n\ts_barrier":::"memory");
  #undef DMA_K
  #undef DMA_V
  #undef CMASK
  #undef START
  #undef RESC
  #undef ROT
  #undef TROW
}
#undef SBAR
#undef WAIT_BAR
}

constexpr int NWAVES = 8;
constexpr int DM = 1024, SEQ = 8192, NCTX = 256, NB = 2;
constexpr int M_LAT = NB * SEQ, M_CTX = NB * NCTX, M_ALL = M_LAT + M_CTX;
constexpr int PW = 2816;
constexpr float RMS_EPS = 1e-6f;
#ifndef WPITCH
#define WPITCH 1024
#endif
constexpr float QSCALE = 0.125f * 1.4426950408889634f;
constexpr int C_AQ = 0, C_AK = 256, C_AV = 384, C_AZ = 512, C_DQ = 768, C_DK = 1024, C_DV = 1152, C_DZ = 1280, C_BF = 1536, C_BZ = 1792, C_CU = 2048, C_CV = 2304, C_CZ = 2560;

constexpr size_t MiB = 1u << 20;
constexpr size_t WS_CTL = 0, CTL_ZERO_BYTES = 1 * MiB;
constexpr size_t WS_MOD = 1 * MiB;
constexpr size_t WS_TAB = 2 * MiB;
constexpr size_t TAB_MA = 0, TAB_128 = 131072, TAB_64 = 229376, TAB_256 = 245760, TAB_WSP = 507904, TAB_ONES = 786432, TAB_BIASB = 1048576;
constexpr size_t WS_WIN = 4 * MiB, WS_WM = 16 * MiB, WS_WBR = 32 * MiB, WS_WOUT = 36 * MiB;
constexpr size_t WS_XC1 = 40 * MiB;
constexpr size_t WS_H = 42 * MiB, WS_YB = 75 * MiB, WS_T1 = 108 * MiB, WS_P = 124 * MiB;
constexpr size_t WS_GT = WS_T1, WS_GT2 = WS_T1 + 32 * MiB, WS_MG = WS_T1 + 64 * MiB;
constexpr size_t WS_PART = WS_GT2;
constexpr size_t WS_MGC = 216 * MiB;
constexpr size_t WS_GTC = 218 * MiB;
constexpr size_t WS_D0 = 222 * MiB;
constexpr size_t WS_END = 254 * MiB;
constexpr int CW_BAR = 4096;

constexpr int RING_BYTES = 147456, LDSCTL_OFF = RING_BYTES, MISC_OFF = LDSCTL_OFF + 320, LDS_BYTES = RING_BYTES + 1024;

#define GAS __attribute__((address_space(1)))
#define LAS __attribute__((address_space(3)))
typedef unsigned short bf16;
typedef unsigned v4u __attribute__((ext_vector_type(4)));
typedef unsigned v2u __attribute__((ext_vector_type(2)));
typedef float f32x4 __attribute__((ext_vector_type(4)));
typedef float f32x16 __attribute__((ext_vector_type(16)));
typedef short bf16x8 __attribute__((ext_vector_type(8)));
typedef GAS unsigned gu32;
#define RLX_AGENT __ATOMIC_RELAXED, __HIP_MEMORY_SCOPE_AGENT
#define LDS_WAIT() asm volatile("s_waitcnt lgkmcnt(0)" ::: "memory")
#define MFMA32(a, b, c) __builtin_amdgcn_mfma_f32_32x32x16_bf16((a), (b), (c), 0, 0, 0)
#define DI __device__ __forceinline__
DI unsigned f2bf(float f) { unsigned u = __builtin_bit_cast(unsigned, f); return (u + 0x7fffu + ((u >> 16) & 1u)) >> 16; }
DI unsigned pk2(float lo, float hi) { return f2bf(lo) | (f2bf(hi) << 16); }
DI float bf2f(bf16 v) { return __uint_as_float((unsigned)v << 16); }
DI float wlo(unsigned w) { return __uint_as_float(w << 16); }
DI float whi(unsigned w) { return __uint_as_float(w & 0xffff0000u); }
DI int crow(int reg, int h) { return (reg & 3) + 8 * (reg >> 2) + 4 * h; }
DI int krow(int s, int h, int j) { return 16 * s + 8 * (j >> 2) + 4 * h + (j & 3); }
DI float siluf(float x) { return x * __builtin_amdgcn_rcpf(1.0f + __builtin_amdgcn_exp2f(-1.4426950408889634f * x)); }
DI float geluf(float v) {
    const float av = __builtin_fabsf(v), d = av * 0.2316418882f + 1.0f, t = __builtin_amdgcn_rcpf(d);
    float q = t * 0.5307027145f + (-0.7265760135f); q = q * t + 0.7107068705f; q = q * t + (-0.142248368f); q = q * t + 0.127414796f; q = q * t;
    const float e = __builtin_amdgcn_exp2f((v * v) * (-0.72134752044f)), m = v * (q * e), r = v - m;
    return v < 0.f ? m : r;
}
typedef float f32x2_t __attribute__((ext_vector_type(2))); typedef __bf16 bf16x2_t __attribute__((ext_vector_type(2)));
DI unsigned cvtpk(float lo, float hi) { f32x2_t v = {lo, hi}; bf16x2_t b = __builtin_convertvector(v, bf16x2_t); return __builtin_bit_cast(unsigned, b); }
DI bf16x8 pack_step(const f32x16& x, int s) {
    v4u p; p.x = cvtpk(x[8 * s], x[8 * s + 1]); p.y = cvtpk(x[8 * s + 2], x[8 * s + 3]); p.z = cvtpk(x[8 * s + 4], x[8 * s + 5]); p.w = cvtpk(x[8 * s + 6], x[8 * s + 7]);
    return __builtin_bit_cast(bf16x8, p);
}
DI float shx(float v, int o, int lane) { return __int_as_float(__builtin_amdgcn_ds_bpermute((lane ^ o) << 2, __float_as_int(v))); }
DI float wave_sum(float v, int lane) {
#pragma unroll
    for (int o = 1; o < 64; o <<= 1) v += shx(v, o, lane);
    return v;
}

#define XB_TMO      128
#define XB_XCNT(j)  (256  + 64 * (j))
#define XB_XSUB(j)  (1280 + 64 * (j))
#define XB_XGEN(j)  (2304 + 64 * (j))
#define XB_TOP      3328
#define XB_TOPGEN   3392
#define XCD_BAR_WORDS 3456
#define XB_SPIN_CAP (1u << 22)
DI unsigned xb_ld(unsigned* p)              { return __hip_atomic_load(p, __ATOMIC_RELAXED, __HIP_MEMORY_SCOPE_AGENT); }
DI unsigned xb_add(unsigned* p, unsigned v) { return __hip_atomic_fetch_add(p, v, __ATOMIC_RELAXED, __HIP_MEMORY_SCOPE_AGENT); }
DI unsigned xb_xcc_id() { return (unsigned)__builtin_amdgcn_s_getreg((3 << 11) | 20) & 0xFu; }
#define XB_SPIN(cond, bar) do { unsigned _sp = 0; while (cond) { __builtin_amdgcn_s_sleep(1); \
    if ((++_sp & 255u) == 0u) { if (xb_ld(&(bar)[XB_TMO])) break; if (_sp > XB_SPIN_CAP) { atomicAdd(&(bar)[XB_TMO], 1u); break; } } } } while (0)
struct XcdBarrier { unsigned* bar; unsigned x; volatile LAS unsigned* st; };
DI XcdBarrier xcd_barrier_post(unsigned* bar, volatile LAS unsigned* st) {
    XcdBarrier b; b.bar = bar; b.x = xb_xcc_id(); b.st = st;
    if (threadIdx.x == 0) (void)xb_add(&bar[XB_XCNT(b.x)], 1u);
    return b;
}
DI void xcd_barrier_complete(unsigned* bar, unsigned x, unsigned& nloc, unsigned& nx) {
    const unsigned G = gridDim.x * gridDim.y * gridDim.z;
    unsigned sum, cnt, mine, sp = 0u;
    for (;;) {
        sum = 0u; cnt = 0u; mine = 0u;
#pragma unroll
        for (unsigned j = 0; j < 16; ++j) { const unsigned c = xb_ld(&bar[XB_XCNT(j)]); sum += c; cnt += (c > 0u) ? 1u : 0u; mine = (j == x) ? c : mine; }
        if (sum == G) break;
        __builtin_amdgcn_s_sleep(1);
        if ((++sp & 255u) == 0u) { if (xb_ld(&bar[XB_TMO])) break; if (sp > XB_SPIN_CAP) { atomicAdd(&bar[XB_TMO], 1u); break; } }
    }
    nloc = mine > 0u ? mine : 1u; nx = cnt > 0u ? cnt : 1u;
}
DI void xcd_barrier(const XcdBarrier& b) {
    asm volatile("s_waitcnt vmcnt(0)" ::: "memory");
    __syncthreads();
    if (threadIdx.x == 0) {
        unsigned* bar = b.bar;
        __builtin_amdgcn_s_waitcnt(0);
        __builtin_amdgcn_fence(__ATOMIC_ACQUIRE, "agent");
        unsigned nloc = b.st[0], nx = b.st[1];
        if (nloc == 0u) { xcd_barrier_complete(bar, b.x, nloc, nx); b.st[0] = nloc; b.st[1] = nx; }
        const unsigned old = xb_add(&bar[XB_XSUB(b.x)], 1u);
        const unsigned gen = old / nloc;
        if (old + 1u == (gen + 1u) * nloc) {
            __builtin_amdgcn_fence(__ATOMIC_RELEASE, "agent");
            asm volatile("s_waitcnt vmcnt(0)" ::: "memory");
            const unsigned og = xb_add(&bar[XB_TOP], 1u);
            const unsigned tg = og / nx;
            if (og + 1u == (tg + 1u) * nx) xb_add(&bar[XB_TOPGEN], 1u);
            else XB_SPIN(xb_ld(&bar[XB_TOPGEN]) == tg, bar);
            xb_add(&bar[XB_XGEN(b.x)], 1u);
            asm volatile("s_waitcnt vmcnt(0)" ::: "memory");
        } else {
            XB_SPIN(xb_ld(&bar[XB_XGEN(b.x)]) == gen, bar);
            asm volatile("s_waitcnt vmcnt(0)" ::: "memory");
        }
    }
    __syncthreads();
}

struct Frame {
    LAS unsigned char* lds;
    int tid, lane, wave, vcu, G;
};

DI void p0_transpose_item(const float* W, int N, bf16* WT, int ldt, int row_off, int col_off, LAS float* scr, int item, int lane) {
    const int nblk = N / 32, kb = item / nblk, nb = item % nblk, k0 = 64 * kb, n0 = 32 * nb;
#pragma unroll 8
    for (int i = 0; i < 32; ++i) { const int kk = 2 * i + (lane >> 5); scr[kk * 33 + (lane & 31)] = W[(size_t)(k0 + kk) * N + n0 + (lane & 31)]; }
    LDS_WAIT(); asm volatile("" ::: "memory");
    const int c = lane & 7;
#pragma unroll
    for (int j = 0; j < 4; ++j) { const int n = (lane >> 3) + 8 * j; const LAS float* s = scr + (8 * c) * 33 + n;
        v4u o; o.x = pk2(s[0 * 33], s[1 * 33]); o.y = pk2(s[2 * 33], s[3 * 33]); o.z = pk2(s[4 * 33], s[5 * 33]); o.w = pk2(s[6 * 33], s[7 * 33]);
        *(GAS v4u*)(WT + (size_t)(row_off + n0 + n) * ldt + col_off + k0 + 8 * c) = o; }
    LDS_WAIT(); asm volatile("" ::: "memory");
}

struct Args { const float* in[20]; float* out; unsigned char* ws; };
enum { I_X = 0, I_C, I_CTX, I_CCTX, I_NORMW, I_WADA, I_BADA, I_WIN, I_QNA, I_KNA, I_QND, I_KND, I_SINK, I_WFNET, I_WSP, I_BSP, I_WBR, I_WMERGE, I_BMERGE, I_WOUT };

DI void p0_weights(const Frame& F, const Args& a, int l, int widx, int nworkers) {
    unsigned char* ws = a.ws;
    LAS float* scr = (LAS float*)(F.lds + F.wave * 16384);
    const int gw = widx * NWAVES + F.wave, NGW = nworkers * NWAVES;
    constexpr int I_IN = 16 * 88, I_M = 16 * 128, I_O = 16 * 32, I_B = 4 * 32, PER_L = I_IN + I_M + I_O + 4 * I_B;
    for (int it = gw; it < PER_L; it += NGW) {
        int r = it;
        if (r < I_IN) { p0_transpose_item(a.in[I_WIN] + (size_t)l * 1024 * PW, PW, (bf16*)(ws + WS_WIN) + (size_t)l * PW * WPITCH, WPITCH, 0, 0, scr, r, F.lane); continue; } r -= I_IN;
        if (r < I_M) { p0_transpose_item(a.in[I_WMERGE] + (size_t)l * 1024 * 4096, 4096, (bf16*)(ws + WS_WM) + (size_t)l * 4096 * 1024, 1024, 0, 0, scr, r, F.lane); continue; } r -= I_M;
        if (r < I_O) { p0_transpose_item(a.in[I_WOUT] + (size_t)l * 1024 * 1024, 1024, (bf16*)(ws + WS_WOUT) + (size_t)l * 1024 * 1024, 1024, 0, 0, scr, r, F.lane); continue; } r -= I_O;
        { const int br = r / I_B; r -= br * I_B;
          p0_transpose_item(a.in[I_WBR] + ((size_t)l * 4 + br) * 256 * 1024, 1024, (bf16*)(ws + WS_WBR) + (size_t)l * 1024 * 1024, 1024, 0, 256 * br, scr, r, F.lane); }
    }
}
DI void p0_prologue(const Frame& F, const Args& a) {
    unsigned char* ws = a.ws;
    for (int u = F.vcu; u < 96; u += F.G) {
        const int l = u / 48, j0 = 64 * (u % 48);
        LAS float* sl = (LAS float*)F.lds; LAS float* red = sl + 3072;
        for (int i = F.tid; i < 3072; i += 512) { const int v = i >> 10, k = i & 1023; const float cv = (v < 2) ? a.in[I_C][v * 1024 + k] : a.in[I_CCTX][k]; sl[i] = siluf(cv); }
        __syncthreads();
        float a0 = 0.f, a1 = 0.f, a2 = 0.f;
        const float* wp = a.in[I_WADA] + (size_t)l * 1024 * 3072 + (size_t)(128 * F.wave) * 3072 + j0 + F.lane;
#pragma unroll 32
        for (int kk = 0; kk < 128; ++kk) { const float w = wp[(size_t)kk * 3072]; const int k = 128 * F.wave + kk; a0 += sl[k] * w; a1 += sl[1024 + k] * w; a2 += sl[2048 + k] * w; }
        red[(F.wave * 3 + 0) * 64 + F.lane] = a0; red[(F.wave * 3 + 1) * 64 + F.lane] = a1; red[(F.wave * 3 + 2) * 64 + F.lane] = a2;
        __syncthreads();
        if (F.tid < 192) { const int v = F.tid >> 6, jj = F.tid & 63; float s = a.in[I_BADA][l * 3072 + j0 + jj];
#pragma unroll
            for (int w = 0; w < 8; ++w) s += red[(w * 3 + v) * 64 + jj];
            ((float*)(ws + WS_MOD))[(l * 3 + v) * 3072 + j0 + jj] = s; }
        __syncthreads();
    }
    p0_weights(F, a, 0, F.vcu, F.G);
    {
        const int gt = F.vcu * 512 + F.tid, NGT = F.G * 512;
        bf16* tab = (bf16*)(ws + WS_TAB);
        for (int e = gt; e < 65536; e += NGT) {
            const int l = e >> 15, g = (e >> 13) & 3, col = (e >> 6) & 127, c = e & 63, d = col & 63;
            const float* wf = a.in[I_WFNET] + ((size_t)(l * 4 + g) * 64) * 64 + d; float s = 0.f;
            for (int j = 0; j < 64; ++j) { const float rev = (float)((c * j) & 63) * (1.0f / 64.0f); const float tw = (col < 64) ? __builtin_amdgcn_cosf(rev) : -__builtin_amdgcn_sinf(rev); s += tw * wf[j * 64]; }
            tab[TAB_MA / 2 + e] = (bf16)f2bf(s);
        }
        for (int e = gt; e < 49152; e += NGT) {
            const int mat = e / 16384, rem = e % 16384, k1b = rem >> 12, nb = (rem >> 10) & 3, s = (rem >> 9) & 1, ln = (rem >> 3) & 63, j = rem & 7;
            const int n1 = 32 * nb + krow(s, ln >> 5, j), k1 = 32 * k1b + (ln & 31); const float rev = (float)((n1 * k1) & 127) * (1.0f / 128.0f);
            const float v = (mat == 0) ? __builtin_amdgcn_cosf(rev) : (mat == 1) ? __builtin_amdgcn_sinf(rev) : -__builtin_amdgcn_sinf(rev);
            tab[TAB_128 / 2 + e] = (bf16)f2bf(v);
        }
        for (int e = gt; e < 8192; e += NGT) {
            const int mat = e >> 12, k2 = (e >> 6) & 63, n2 = e & 63; const float rev = (float)((k2 * n2) & 63) * (1.0f / 64.0f);
            tab[TAB_64 / 2 + e] = (bf16)f2bf(mat == 0 ? __builtin_amdgcn_cosf(rev) : __builtin_amdgcn_sinf(rev));
        }
        for (int e = gt; e < 131072; e += NGT) {
            const int mat = e >> 16, rem = e & 65535, kb = rem >> 13, nb = (rem >> 10) & 7, s = (rem >> 9) & 1, ln = (rem >> 3) & 63, j = rem & 7;
            const int n = 32 * nb + krow(s, ln >> 5, j), k = 32 * kb + (ln & 31); const float rev = (float)((n * k) & 255) * (1.0f / 256.0f);
            tab[TAB_256 / 2 + e] = (bf16)f2bf(mat == 0 ? __builtin_amdgcn_cosf(rev) : __builtin_amdgcn_sinf(rev));
        }
        for (int e = gt; e < 131072; e += NGT) tab[TAB_WSP / 2 + e] = (bf16)f2bf(a.in[I_WSP][e]);
        for (int e = gt; e < M_CTX * 1024 / 4; e += NGT) { ((f32x4*)(ws + WS_XC1))[e] = ((const f32x4*)a.in[I_CTX])[e]; ((f32x4*)(ws + WS_MGC))[e] = (f32x4){0.f, 0.f, 0.f, 0.f}; }
        for (int e = gt; e < 4096; e += NGT) tab[TAB_ONES / 2 + e] = (bf16)(((e & 31) == 0) ? 0x3f80 : 0);
        for (int e = gt; e < 262144; e += NGT) tab[TAB_BIASB / 2 + e] = (bf16)(((e & 31) == 0) ? f2bf(a.in[I_BMERGE][e >> 5]) : 0u);
    }
}

DI void p1_modrms(const Frame& F, const Args& a, int l, const float* xlat, const float* xctx, int with_ctx) {
    const float* part = (l == 1) ? (const float*)(a.ws + WS_PART) : nullptr; const bf16* d0 = (const bf16*)(a.ws + WS_D0);
    const float* mod = (const float*)(a.ws + WS_MOD) + (size_t)l * 3 * 3072;
    const float* nw = a.in[I_NORMW] + l * 1024;
    bf16* H = (bf16*)(a.ws + WS_H);
    const int gw = F.vcu * NWAVES + F.wave, NGW = F.G * NWAVES;
    const int nrows = with_ctx ? M_ALL : M_LAT;
    int vcur = -1; f32x4 av[4], bv[4];
    for (int row = gw; row < nrows; row += 2 * NGW) {
        const int row2 = row + NGW; const bool has2 = row2 < nrows;
        const float* xr = (row < M_LAT) ? xlat + (size_t)row * 1024 : xctx + (size_t)(row - M_LAT) * 1024;
        const float* xr2 = !has2 ? xr : (row2 < M_LAT) ? xlat + (size_t)row2 * 1024 : xctx + (size_t)(row2 - M_LAT) * 1024;
        f32x4 x[4], y[4]; float ss = 0.f, ss2 = 0.f;
#pragma unroll
        for (int j = 0; j < 4; ++j) { x[j] = *(const f32x4*)(xr + 4 * (F.lane + 64 * j)); y[j] = *(const f32x4*)(xr2 + 4 * (F.lane + 64 * j)); }
        if (part != nullptr) {
            if (row < M_LAT) {
#pragma unroll
                for (int j = 0; j < 4; ++j) { const v2u d = *(const v2u*)(d0 + (size_t)row * 1024 + 4 * (F.lane + 64 * j)); x[j] += (f32x4){wlo(d.x), whi(d.x), wlo(d.y), whi(d.y)}; } }
            if (has2 && row2 < M_LAT) {
#pragma unroll
                for (int j = 0; j < 4; ++j) { const v2u d = *(const v2u*)(d0 + (size_t)row2 * 1024 + 4 * (F.lane + 64 * j)); y[j] += (f32x4){wlo(d.x), whi(d.x), wlo(d.y), whi(d.y)}; } }
            if (row >= M_LAT) { const float* pp = part + (size_t)(row - M_LAT) * 1024;
#pragma unroll 4
                for (int q = 0; q < 16; ++q)
#pragma unroll
                    for (int j = 0; j < 4; ++j) x[j] += *(const f32x4*)(pp + (size_t)q * 512 * 1024 + 4 * (F.lane + 64 * j)); }
            if (has2 && row2 >= M_LAT) { const float* pp = part + (size_t)(row2 - M_LAT) * 1024;
#pragma unroll 4
                for (int q = 0; q < 16; ++q)
#pragma unroll
                    for (int j = 0; j < 4; ++j) y[j] += *(const f32x4*)(pp + (size_t)q * 512 * 1024 + 4 * (F.lane + 64 * j)); }
        }
#pragma unroll
        for (int j = 0; j < 4; ++j) { ss += (x[j].x * x[j].x + x[j].y * x[j].y) + (x[j].z * x[j].z + x[j].w * x[j].w); ss2 += (y[j].x * y[j].x + y[j].y * y[j].y) + (y[j].z * y[j].z + y[j].w * y[j].w); }
#pragma unroll
        for (int o = 1; o < 64; o <<= 1) { ss += shx(ss, o, F.lane); ss2 += shx(ss2, o, F.lane); }
#pragma unroll
        for (int k = 0; k < 2; ++k) { const int r_ = k ? row2 : row; if (k && !has2) break;
            const int v = r_ < SEQ ? 0 : (r_ < M_LAT ? 1 : 2);
            if (v != vcur) { vcur = v;
#pragma unroll
                for (int j = 0; j < 4; ++j) { const int c = 4 * (F.lane + 64 * j); const f32x4 w = *(const f32x4*)(nw + c), sc = *(const f32x4*)(mod + v * 3072 + 1024 + c);
                    av[j] = w * (sc + 1.0f); bv[j] = *(const f32x4*)(mod + v * 3072 + c); } }
            const float rstd = __builtin_amdgcn_rsqf((k ? ss2 : ss) * (1.0f / 1024.0f) + RMS_EPS);
#pragma unroll
            for (int j = 0; j < 4; ++j) { const f32x4 h = (k ? y[j] : x[j]) * rstd * av[j] + bv[j]; v2u o; o.x = pk2(h.x, h.y); o.y = pk2(h.z, h.w);
                *(v2u*)(H + (size_t)r_ * 1024 + 4 * (F.lane + 64 * j)) = o; } }
    }
}

DI void p3_prep(const Frame& F, const Args& a, int l, bf16* P) {
    const int gw = F.vcu * NWAVES + F.wave, NGW = F.G * NWAVES;
    const int lane = F.lane, d0 = 4 * (lane & 15);
    f32x4 wk, inv;
#pragma unroll
    for (int e = 0; e < 4; ++e) { wk[e] = (lane < 32 ? a.in[I_KNA] : a.in[I_KND])[l * 64 + d0 + e];
        inv[e] = __builtin_amdgcn_exp2f(-(float)((d0 + e) & 15) * (13.287712379549449f / 16.0f)) * 0.15915494309189535f; }
    const float sgn = (d0 & 16) ? 1.0f : -1.0f;
    const int colk = (lane < 32) ? C_AK + 4 * lane : C_DK + 4 * (lane - 32);
    for (int row = gw; row < M_ALL; row += 2 * NGW) {
        const int row2 = row + NGW; const bool has2 = row2 < M_ALL;
        bf16* pr = P + (size_t)row * PW + colk; bf16* pr2 = P + (size_t)(has2 ? row2 : row) * PW + colk;
        const v2u raw = *(const v2u*)pr, raw2 = *(const v2u*)pr2;
#pragma unroll
        for (int k = 0; k < 2; ++k) { if (k && !has2) break;
            const int r_ = k ? row2 : row; const bool isctx = r_ >= M_LAT; const int n = r_ & (SEQ - 1);
            f32x4 cs = (f32x4){1.f, 1.f, 1.f, 1.f}, sn = (f32x4){0.f, 0.f, 0.f, 0.f};
            if (!isctx) { const float pos = (float)((d0 < 32) ? (n >> 6) : (n & 63));
#pragma unroll
                for (int e = 0; e < 4; ++e) { const float rev = pos * inv[e]; cs[e] = __builtin_amdgcn_cosf(rev); sn[e] = __builtin_amdgcn_sinf(rev); } }
            const v2u rw = k ? raw2 : raw;
            f32x4 v = (f32x4){wlo(rw.x), whi(rw.x), wlo(rw.y), whi(rw.y)};
            float ss = (v[0] * v[0] + v[1] * v[1]) + (v[2] * v[2] + v[3] * v[3]);
            ss += shx(ss, 1, lane); ss += shx(ss, 2, lane); ss += shx(ss, 4, lane); ss += shx(ss, 8, lane);
            v = v * __builtin_amdgcn_rsqf(ss * (1.0f / 64.0f) + RMS_EPS) * wk;
            f32x4 pt;
#pragma unroll
            for (int e = 0; e < 4; ++e) pt[e] = shx(v[e], 4, lane);
            v = v * cs + pt * sn * sgn;
            v2u o; o.x = pk2(v[0], v[1]); o.y = pk2(v[2], v[3]);
            *(v2u*)(k ? pr2 : pr) = o; }
    }
}

DI void fnet_stepA(const bf16* xrow, const bf16* MAt, int r32, int hi, bf16x8 (&gs)[4][2]) {
    bf16x8 xa[4];
#pragma unroll
    for (int s4 = 0; s4 < 4; ++s4) xa[s4] = *(const bf16x8*)(xrow + 16 * s4 + 8 * hi);
#pragma unroll
    for (int cb = 0; cb < 4; ++cb) { f32x16 acc = f32x16{};
#pragma unroll
        for (int s4 = 0; s4 < 4; ++s4) { const bf16x8 bfr = *(const bf16x8*)(MAt + (32 * cb + r32) * 64 + 16 * s4 + 8 * hi); acc = MFMA32(xa[s4], bfr, acc); }
        gs[cb][0] = pack_step(acc, 0); gs[cb][1] = pack_step(acc, 1); }
}

DI void fnet_s1_unit(const Frame& F, const Args& a, int l, int u, const bf16* P) {
    const int b = u >> 7, n2grp = (u >> 4) & 7, g = (u >> 2) & 3, k1b = u & 3;
    const int lane = F.lane, r32 = lane & 31, hi = lane >> 5, w = F.wave, n2 = 8 * n2grp + w;
    const bf16* tab = (const bf16*)(a.ws + WS_TAB);
    const bf16* MAt = tab + TAB_MA / 2 + (size_t)(l * 4 + g) * 128 * 64;
    const bf16* T128 = tab + TAB_128 / 2;
    f32x16 Tr[2], Ti[2];
#pragma unroll
    for (int j = 0; j < 2; ++j) { Tr[j] = f32x16{}; Ti[j] = f32x16{}; }
#pragma unroll 1
    for (int nb = 0; nb < 4; ++nb) {
        const bf16* xrow = P + (size_t)(SEQ * b + 64 * (32 * nb + r32) + n2) * PW + C_BF + 64 * g;
        bf16x8 gs[4][2]; fnet_stepA(xrow, MAt, r32, hi, gs);
#pragma unroll
        for (int s = 0; s < 2; ++s) {
            const size_t fo = ((size_t)((k1b * 4 + nb) * 2 + s) * 64 + lane) * 8;
            const bf16x8 ca = *(const bf16x8*)(T128 + fo), sa = *(const bf16x8*)(T128 + 16384 + fo), na = *(const bf16x8*)(T128 + 32768 + fo);
            Tr[0] = MFMA32(ca, gs[0][s], Tr[0]); Tr[0] = MFMA32(sa, gs[2][s], Tr[0]);
            Tr[1] = MFMA32(ca, gs[1][s], Tr[1]); Tr[1] = MFMA32(sa, gs[3][s], Tr[1]);
            Ti[0] = MFMA32(ca, gs[2][s], Ti[0]); Ti[0] = MFMA32(na, gs[0][s], Ti[0]);
            Ti[1] = MFMA32(ca, gs[3][s], Ti[1]); Ti[1] = MFMA32(na, gs[1][s], Ti[1]); }
    }
    LAS bf16* tl = (LAS bf16*)F.lds;
#pragma unroll
    for (int i = 0; i < 16; ++i) { const int k1l = crow(i, hi), k1 = 32 * k1b + k1l;
        const float rev = (float)((n2 * k1) & 8191) * (1.0f / 8192.0f); const float c = __builtin_amdgcn_cosf(rev), s = __builtin_amdgcn_sinf(rev);
#pragma unroll
        for (int jb = 0; jb < 2; ++jb) { const float tr = Tr[jb][i], ti = Ti[jb][i];
            tl[(k1l * 128 + 32 * jb + r32) * 8 + w] = (bf16)f2bf(tr * c + ti * s);
            tl[(k1l * 128 + 64 + 32 * jb + r32) * 8 + w] = (bf16)f2bf(ti * c - tr * s); } }
    __syncthreads();
    bf16* T1 = (bf16*)(a.ws + WS_T1);
#pragma unroll 4
    for (int pass = 0; pass < 8; ++pass) { const int q = F.tid + 512 * pass, k1l = q >> 7, colL = q & 127;
        const v4u v = *(const LAS v4u*)(F.lds + (size_t)q * 16);
        *(v4u*)(T1 + ((((size_t)(b * 128 + 32 * k1b + k1l) * 8 + n2grp) * 512) + g * 128 + colL) * 8) = v; }
    __syncthreads();
}

DI void fnet_ctx_unit(const Frame& F, const Args& a, int l, int u, const bf16* P, bf16* YB) {
    const int b = u >> 2, g = u & 3;
    const int lane = F.lane, r32 = lane & 31, hi = lane >> 5, w = F.wave;
    const bf16* tab = (const bf16*)(a.ws + WS_TAB);
    const bf16* MAt = tab + TAB_MA / 2 + (size_t)(l * 4 + g) * 128 * 64;
    const bf16* T256 = tab + TAB_256 / 2;
    LAS bf16x8* sh = (LAS bf16x8*)F.lds;
    { const bf16* xrow = P + (size_t)(M_LAT + NCTX * b + 32 * w + r32) * PW + C_BF + 64 * g;
      bf16x8 gs[4][2]; fnet_stepA(xrow, MAt, r32, hi, gs);
#pragma unroll
      for (int cb = 0; cb < 4; ++cb)
#pragma unroll
          for (int s = 0; s < 2; ++s) sh[((w * 4 + cb) * 2 + s) * 64 + lane] = gs[cb][s]; }
    __syncthreads();
    f32x16 Y[2]; Y[0] = f32x16{}; Y[1] = f32x16{};
#pragma unroll 2
    for (int nb = 0; nb < 8; ++nb) {
#pragma unroll
        for (int s = 0; s < 2; ++s) {
            const size_t fo = ((size_t)((w * 8 + nb) * 2 + s) * 64 + lane) * 8;
            const bf16x8 ca = *(const bf16x8*)(T256 + fo), sa = *(const bf16x8*)(T256 + 65536 + fo);
            const bf16x8 gr0 = sh[((nb * 4 + 0) * 2 + s) * 64 + lane], gr1 = sh[((nb * 4 + 1) * 2 + s) * 64 + lane], gi0 = sh[((nb * 4 + 2) * 2 + s) * 64 + lane], gi1 = sh[((nb * 4 + 3) * 2 + s) * 64 + lane];
            Y[0] = MFMA32(ca, gr0, Y[0]); Y[0] = MFMA32(sa, gi0, Y[0]);
            Y[1] = MFMA32(ca, gr1, Y[1]); Y[1] = MFMA32(sa, gi1, Y[1]); }
    }
#pragma unroll
    for (int jb = 0; jb < 2; ++jb)
#pragma unroll
        for (int i = 0; i < 16; ++i) { const int k = 32 * w + crow(i, hi), d = 32 * jb + r32; const size_t row = (size_t)(M_LAT + NCTX * b + k);
            const float z = bf2f(P[row * PW + C_BZ + 64 * g + d]);
            YB[row * 1024 + 512 + 64 * g + d] = (bf16)f2bf(Y[jb][i] * (1.0f / 128.0f) * siluf(z)); }
    __syncthreads();
}

#ifndef B_SCALE
#define B_SCALE 1.0f
#endif
#ifndef C_SCALE
#define C_SCALE 1.0f
#endif
DI void fnet_s3_unit(const Frame& F, const Args& a, int u, const bf16* P, bf16* YB) {
    const int b = u >> 7, k1 = u & 127;
    const int lane = F.lane, r32 = lane & 31, hi = lane >> 5, g = F.wave >> 1, jb = F.wave & 1;
    const bf16* T64 = (const bf16*)(a.ws + WS_TAB) + TAB_64 / 2;
    const bf16* T1 = (const bf16*)(a.ws + WS_T1);
    f32x16 Y[2]; Y[0] = f32x16{}; Y[1] = f32x16{};
#pragma unroll
    for (int sc = 0; sc < 4; ++sc)
#pragma unroll
        for (int ri = 0; ri < 2; ++ri) {
            const bf16x8 afr = *(const bf16x8*)(T1 + ((((size_t)(b * 128 + k1) * 8 + 2 * sc + hi) * 512) + g * 128 + ri * 64 + 32 * jb + r32) * 8);
#pragma unroll
            for (int k2b = 0; k2b < 2; ++k2b) { const bf16x8 bfr = *(const bf16x8*)(T64 + ri * 4096 + (32 * k2b + r32) * 64 + 16 * sc + 8 * hi); Y[k2b] = MFMA32(afr, bfr, Y[k2b]); } }
#pragma unroll
    for (int k2b = 0; k2b < 2; ++k2b) { const size_t row = (size_t)(SEQ * b + k1 + 128 * (32 * k2b + r32));
#pragma unroll
        for (int q = 0; q < 4; ++q) { const int d0 = 32 * jb + 8 * q + 4 * hi;
            const v2u z = *(const v2u*)(P + row * PW + C_BZ + 64 * g + d0);
            v2u o; o.x = pk2(Y[k2b][4 * q] * (B_SCALE * 0.0013810679320049757f) * siluf(wlo(z.x)), Y[k2b][4 * q + 1] * (B_SCALE * 0.0013810679320049757f) * siluf(whi(z.x)));
            o.y = pk2(Y[k2b][4 * q + 2] * (B_SCALE * 0.0013810679320049757f) * siluf(wlo(z.y)), Y[k2b][4 * q + 3] * (B_SCALE * 0.0013810679320049757f) * siluf(whi(z.y)));
            *(v2u*)(YB + row * 1024 + 512 + 64 * g + d0) = o; } }
}

DI void sgu_unit(const Frame& F, const Args& a, int l, int u, const bf16* P, bf16* YB) {
    constexpr int VP = 136;
    LAS bf16* vt = (LAS bf16*)F.lds;
    const int ci = u >> 2, g = u & 3;
    const size_t row0 = (size_t)ci * 128;
    { const int q = F.tid & 127, cq = F.tid >> 7; const bf16* src = P + (row0 + q) * PW + C_CV + 64 * g + 16 * cq;
#pragma unroll
      for (int i = 0; i < 2; ++i) { const v4u v = *(const v4u*)(src + 8 * i); const unsigned wv[4] = {v.x, v.y, v.z, v.w};
#pragma unroll
          for (int e = 0; e < 4; ++e) { vt[(16 * cq + 8 * i + 2 * e) * VP + q] = (bf16)f2bf(geluf(wlo(wv[e]))); vt[(16 * cq + 8 * i + 2 * e + 1) * VP + q] = (bf16)f2bf(geluf(whi(wv[e]))); } } }
    __syncthreads();
    const int lane = F.lane, r32 = lane & 31, hi = lane >> 5, pb = F.wave >> 1, cb = F.wave & 1;
    const bf16* Wsp = (const bf16*)(a.ws + WS_TAB) + TAB_WSP / 2 + (size_t)(l * 4 + g) * 128 * 128;
    f32x16 acc = f32x16{};
#pragma unroll
    for (int s = 0; s < 8; ++s) {
        const bf16x8 af = *(const LAS bf16x8*)(vt + (32 * cb + r32) * VP + 16 * s + 8 * hi);
        const bf16x8 bfr = *(const bf16x8*)(Wsp + (32 * pb + r32) * 128 + 16 * s + 8 * hi);
        acc = MFMA32(af, bfr, acc);
    }
    const int p = 32 * pb + r32; const float bb = a.in[I_BSP][(l * 4 + g) * 128 + p]; const bf16* pr = P + (row0 + p) * PW;
#pragma unroll
    for (int q = 0; q < 4; ++q) { const int c0 = 64 * g + 32 * cb + 8 * q + 4 * hi;
        const v2u uu = *(const v2u*)(pr + C_CU + c0), zz = *(const v2u*)(pr + C_CZ + c0);
        v2u o; o.x = pk2(C_SCALE * geluf(wlo(uu.x)) * (acc[4 * q] + bb) * siluf(wlo(zz.x)), C_SCALE * geluf(whi(uu.x)) * (acc[4 * q + 1] + bb) * siluf(whi(zz.x)));
        o.y = pk2(C_SCALE * geluf(wlo(uu.y)) * (acc[4 * q + 2] + bb) * siluf(wlo(zz.y)), C_SCALE * geluf(whi(uu.y)) * (acc[4 * q + 3] + bb) * siluf(whi(zz.y)));
        *(v2u*)(YB + (row0 + p) * 1024 + 768 + c0) = o; }
    __syncthreads();
}

DI void p5_ctx_convert(const Frame& F, const Args& a) {
    const int gt = F.vcu * 512 + F.tid, NGT = F.G * 512;
    const f32x4* src = (const f32x4*)(a.ws + WS_MGC); v2u* dst = (v2u*)((bf16*)(a.ws + WS_MG) + (size_t)M_LAT * 1024);
    for (int e = gt; e < M_CTX * 1024 / 4; e += NGT) { const f32x4 v = src[e]; v2u o; o.x = pk2(v.x, v.y); o.y = pk2(v.z, v.w); dst[e] = o; }
}

#ifdef SELFCHECK
constexpr int CW_CHK = 8192;
DI unsigned hsh(unsigned x) { x *= 2654435761u; x ^= x >> 15; x *= 2246822519u; x ^= x >> 13; x *= 3266489917u; x ^= x >> 16; return x; }
DI void chk_acc(const Args& a, int id, float got, float want) {
    unsigned* w = (unsigned*)(a.ws + WS_CTL) + CW_CHK + 4 * id;
    float d = __builtin_fabsf(got - want); if (!(d == d) || d > 1e15f) d = 1e15f;
    atomicAdd((float*)w, d * d); atomicAdd((float*)(w + 1), want * want); atomicAdd(w + 2, 1u); atomicMax(w + 3, __float_as_uint(d));
}
DI float bfr(float x) { return __uint_as_float(f2bf(x) << 16); }
DI void chk_p0(const Frame& F, const Args& a) {
    const int gt = F.vcu * 512 + F.tid, NGT = F.G * 512;
    for (int s = gt; s < 18432; s += NGT) { const int l = s / 9216, v = (s / 3072) % 3, j = s % 3072; float acc = a.in[I_BADA][l * 3072 + j];
        for (int k = 0; k < 1024; ++k) { const float cv = (v < 2) ? a.in[I_C][v * 1024 + k] : a.in[I_CCTX][k]; acc += siluf(cv) * a.in[I_WADA][((size_t)l * 1024 + k) * 3072 + j]; }
        chk_acc(a, 0, ((const float*)(a.ws + WS_MOD))[(l * 3 + v) * 3072 + j], acc); }
    for (int s = gt; s < 65536; s += NGT) { const unsigned h = hsh(s); const int l = (s >> 2) & 1, m = s & 3, k = h & 1023; const unsigned h2 = hsh(h + 77u);
        float got, want;
        if (m == 0) { const int n = h2 % PW; want = bfr(a.in[I_WIN][((size_t)l * 1024 + k) * PW + n]); got = bf2f(((const bf16*)(a.ws + WS_WIN))[((size_t)l * PW + n) * WPITCH + k]); }
        else if (m == 1) { const int n = h2 & 4095; want = bfr(a.in[I_WMERGE][((size_t)l * 1024 + k) * 4096 + n]); got = bf2f(((const bf16*)(a.ws + WS_WM))[((size_t)l * 4096 + n) * 1024 + k]); }
        else if (m == 2) { const int n = h2 & 1023; want = bfr(a.in[I_WOUT][((size_t)l * 1024 + k) * 1024 + n]); got = bf2f(((const bf16*)(a.ws + WS_WOUT))[((size_t)l * 1024 + n) * 1024 + k]); }
        else { const int n = h2 & 1023, br = k >> 8, kk = k & 255; want = bfr(a.in[I_WBR][(((size_t)l * 4 + br) * 256 + kk) * 1024 + n]); got = bf2f(((const bf16*)(a.ws + WS_WBR))[((size_t)l * 1024 + n) * 1024 + 256 * br + kk]); }
        chk_acc(a, 1, got, want); }
}
DI int sample_row(unsigned h, int l) { const int r = h % M_ALL; (void)l; return ((h >> 20) & 7) == 0 ? M_LAT + (h % M_CTX) : r; }
DI void chk_h(const Frame& F, const Args& a, int l, int id) {
    const float* mod = (const float*)(a.ws + WS_MOD) + (size_t)l * 3 * 3072; const bf16* H = (const bf16*)(a.ws + WS_H);
    const int gw = F.vcu * NWAVES + F.wave, NGW = F.G * NWAVES;
    for (int s = gw; s < M_ALL; s += NGW) { const int row = s; const int v = row < SEQ ? 0 : (row < M_LAT ? 1 : 2);
        const float* xr = (row < M_LAT) ? ((l == 0) ? a.in[I_X] : a.out) + (size_t)row * 1024 : ((l == 0) ? a.in[I_CTX] : (const float*)(a.ws + WS_XC1)) + (size_t)(row - M_LAT) * 1024;
        float ss = 0.f; for (int j = 0; j < 16; ++j) { const float x = xr[F.lane + 64 * j]; ss += x * x; }
        const float rstd = 1.0f / sqrtf(wave_sum(ss, F.lane) * (1.0f / 1024.0f) + RMS_EPS);
        for (int j = 0; j < 16; ++j) { const int c = F.lane + 64 * j; const float want = xr[c] * rstd * a.in[I_NORMW][l * 1024 + c] * (1.0f + mod[v * 3072 + 1024 + c]) + mod[v * 3072 + c];
            chk_acc(a, id, bf2f(H[(size_t)row * 1024 + c]), want); } }
}
DI float dot_h_w(const bf16* hrow, const bf16* wrow, int K) { float acc = 0.f; for (int k = 0; k < K; ++k) acc += bf2f(hrow[k]) * bf2f(wrow[k]); return acc; }
DI void chk_p(const Frame& F, const Args& a, int l, int id) {
    const bf16* H = (const bf16*)(a.ws + WS_H); const bf16* W = (const bf16*)(a.ws + WS_WIN) + (size_t)l * PW * WPITCH; const bf16* P = (const bf16*)(a.ws + WS_P);
    const int gt = F.vcu * 512 + F.tid, NGT = F.G * 512;
    for (int s = gt; s < (1 << 20); s += NGT) { const unsigned h = hsh(s * 5 + 2); const int row = sample_row(h, l); int col = hsh(h + 9u) % PW;
        if (l == 1 && row >= M_LAT) col = ((col & 1) ? 1024 : 256) + (col & 255);
        chk_acc(a, id, bf2f(P[(size_t)row * PW + col]), dot_h_w(H + (size_t)row * 1024, W + (size_t)col * WPITCH, 1024)); }
}
DI void chk_prep(const Frame& F, const Args& a, int l, int id) {
    const bf16* H = (const bf16*)(a.ws + WS_H); const bf16* W = (const bf16*)(a.ws + WS_WIN) + (size_t)l * PW * WPITCH; const bf16* P = (const bf16*)(a.ws + WS_P);
    const int gw = F.vcu * NWAVES + F.wave, NGW = F.G * NWAVES, d = F.lane;
    for (int s = gw; s < 16384; s += NGW) { const unsigned h = hsh(s * 7 + 3); const int row = sample_row(h, l); int sl = (h >> 8) % 12; const bool isctx = row >= M_LAT;
        if (isctx && l == 1) sl = (sl & 1) ? 4 + (sl & 1) : 10 + ((sl >> 1) & 1);
        const int col = (sl < 4) ? C_AQ + 64 * sl : (sl < 6) ? C_AK + 64 * (sl - 4) : (sl < 10) ? C_DQ + 64 * (sl - 6) : C_DK + 64 * (sl - 10);
        const bool isq = (sl < 4) || (sl >= 6 && sl < 10);
        const float raw = bfr(dot_h_w(H + (size_t)row * 1024, W + (size_t)(col + d) * WPITCH, 1024));
        const float wv = ((sl < 4) ? a.in[I_QNA] : (sl < 6) ? a.in[I_KNA] : (sl < 10) ? a.in[I_QND] : a.in[I_KND])[l * 64 + d];
        const float ms = wave_sum(raw * raw, d) * (1.0f / 64.0f);
        float y = raw / sqrtf(ms + RMS_EPS) * wv;
        if (!isctx) { const int n = row & (SEQ - 1); const float pos = (float)((d < 32) ? (n >> 6) : (n & 63)); const float inv = __builtin_amdgcn_exp2f(-(float)(d & 15) * (13.287712379549449f / 16.0f)); const float rev = pos * inv * 0.15915494309189535f; const float cs = __builtin_amdgcn_cosf(rev), sn = __builtin_amdgcn_sinf(rev);
            const float p = shx(y, 16, d); y = (d & 16) ? (p * sn + y * cs) : (y * cs - p * sn); }
        if (isq) y *= QSCALE;
        chk_acc(a, id, bf2f(P[(size_t)row * PW + col + d]), y); }
}
DI void chk_attn(const Frame& F, const Args& a, int l, int id, int mode) {
    const bf16* P = (const bf16*)(a.ws + WS_P); const bf16* YB = (const bf16*)(a.ws + WS_YB);
    LAS float* qs = (LAS float*)F.lds + F.wave * 192; LAS float* os = qs + 64; LAS float* red = qs + 128;
    const int gw = F.vcu * NWAVES + F.wave, NGW = F.G * NWAVES, lane = F.lane;
    const int qc0 = mode ? C_DQ : C_AQ, kc0 = mode ? C_DK : C_AK, vc0 = mode ? C_DV : C_AV, zc0 = mode ? C_DZ : C_AZ, oc0 = mode ? 256 : 0;
    for (int s = gw; s < 8192; s += NGW) { const unsigned hh = hsh(s * 11 + 5 + mode); int row = sample_row(hh, l); if ((s & 7) == 1) row = (hh & 8192) + (hh & 255) + ((hh & 256) ? 7936 : 0); if (l == 1 && row >= M_LAT) row = hh % M_LAT; const int h = (hh >> 9) & 3, kvh = h >> 1; const bool isctx = row >= M_LAT;
        const int b = isctx ? (row - M_LAT) / NCTX : row / SEQ, pos = row & (SEQ - 1);
        qs[lane] = bf2f(P[(size_t)row * PW + qc0 + 64 * h + lane]); LDS_WAIT();
        int klo = 0, khi = -1; if (!isctx) { if (mode == 0) { klo = 0; khi = SEQ - 1; } else { klo = pos - 128 < 0 ? 0 : pos - 128; khi = pos + 128 > SEQ - 1 ? SEQ - 1 : pos + 128; } }
        const int nlat = khi - klo + 1 > 0 ? khi - klo + 1 : 0, nk = NCTX + nlat;
        float m = -1e30f, lsum = 0.f; float acc[64];
#pragma unroll
        for (int dd = 0; dd < 64; ++dd) acc[dd] = 0.f;
        for (int kk = lane; kk < nk; kk += 64) { const size_t kr = (kk < NCTX) ? (size_t)(M_LAT + NCTX * b + kk) : (size_t)(SEQ * b + klo + kk - NCTX);
            const bf16* kp = P + kr * PW + kc0 + 64 * kvh; const bf16* vp = P + kr * PW + vc0 + 64 * kvh; float sc = 0.f;
#pragma unroll
            for (int dd = 0; dd < 64; ++dd) sc += qs[dd] * bf2f(kp[dd]);
            const float mn = fmaxf(m, sc), f = __builtin_amdgcn_exp2f(m - mn), p = __builtin_amdgcn_exp2f(sc - mn); lsum = lsum * f + p; m = mn;
#pragma unroll
            for (int dd = 0; dd < 64; ++dd) acc[dd] = acc[dd] * f + p * bf2f(vp[dd]); }
        float mall = m;
#pragma unroll
        for (int o = 1; o < 64; o <<= 1) mall = fmaxf(mall, shx(mall, o, lane));
        const float f = __builtin_amdgcn_exp2f(m - mall); lsum = wave_sum(lsum * f, lane);
        if (mode == 1) lsum += __builtin_amdgcn_exp2f(a.in[I_SINK][l * 4 + h] * 1.4426950408889634f - mall);
#pragma unroll
        for (int dd = 0; dd < 64; ++dd) { const float t = wave_sum(acc[dd] * f, lane); if (lane == dd) os[dd] = t; }
        LDS_WAIT();
        const float z = bf2f(P[(size_t)row * PW + zc0 + 64 * h + lane]);
        chk_acc(a, id, bf2f(YB[(size_t)row * 1024 + oc0 + 64 * h + lane]), os[lane] / lsum * siluf(z));
        (void)red; }
}
DI void chk_fnet(const Frame& F, const Args& a, int l, int id, int ctxmode) {
    const bf16* P = (const bf16*)(a.ws + WS_P); const bf16* YB = (const bf16*)(a.ws + WS_YB);
    LAS float* ys = (LAS float*)F.lds + F.wave * 64;
    const int gw = F.vcu * NWAVES + F.wave, NGW = F.G * NWAVES, j = F.lane;
    const int N = ctxmode ? NCTX : SEQ;
    for (int s = gw; s < (ctxmode ? 256 : 1024); s += NGW) { const unsigned hh = hsh(s * 13 + 7 + ctxmode); const int b = hh & 1, g = (hh >> 1) & 3; int k = (hh >> 3) % N;
#ifdef FNET_K0
        k = (s & 7) == 0 ? 0 : (s & 7) == 1 ? N / 2 : (s & 7) == 2 ? 64 : (s & 7) == 3 ? 128 : (s & 7) == 4 ? 1 : k;
#endif
        const size_t rbase = ctxmode ? (size_t)(M_LAT + NCTX * b) : (size_t)(SEQ * b);
        float y = 0.f;
        for (int n = 0; n < N; ++n) { const bf16* fr = P + (rbase + n) * PW + C_BF + 64 * g; float A = 0.f, B = 0.f;
            for (int c = 0; c < 64; ++c) { const float fv = bf2f(fr[c]); const float ph = (float)((j * c) & 63) * (1.0f / 64.0f); A += fv * __builtin_amdgcn_cosf(ph); B += fv * __builtin_amdgcn_sinf(ph); }
            const float th = (float)((k * n) & (N - 1)) / (float)N; y += __builtin_amdgcn_cosf(th) * A - __builtin_amdgcn_sinf(th) * B; }
        ys[j] = y / sqrtf((float)N * 64.0f); LDS_WAIT();
        float o = 0.f; for (int jj = 0; jj < 64; ++jj) o += ys[jj] * a.in[I_WFNET][((size_t)(l * 4 + g) * 64 + jj) * 64 + j];
        const size_t row = rbase + k; const float z = bf2f(P[row * PW + C_BZ + 64 * g + j]);
        chk_acc(a, id, bf2f(YB[row * 1024 + 512 + 64 * g + j]), o * siluf(z)); LDS_WAIT(); }
}
DI void chk_sgu(const Frame& F, const Args& a, int l, int id) {
    const bf16* P = (const bf16*)(a.ws + WS_P); const bf16* YB = (const bf16*)(a.ws + WS_YB);
    const int gt = F.vcu * 512 + F.tid, NGT = F.G * 512;
    for (int s = gt; s < (1 << 18); s += NGT) { const unsigned hh = hsh(s * 17 + 11); int row = sample_row(hh, l); if (l == 1 && row >= M_LAT) row = hh % M_LAT; const int cc = hsh(hh + 101u) & 255, g = cc >> 6, p = row & 127; const size_t r0 = (size_t)(row - p);
        float sp = a.in[I_BSP][(l * 4 + g) * 128 + p];
        for (int q = 0; q < 128; ++q) { const float v = bf2f(P[(r0 + q) * PW + C_CV + cc]); sp += a.in[I_WSP][((size_t)(l * 4 + g) * 128 + p) * 128 + q] * (0.5f * v * (1.0f + erff(v * 0.7071067811865476f))); }
        const float u = bf2f(P[(size_t)row * PW + C_CU + cc]), z = bf2f(P[(size_t)row * PW + C_CZ + cc]);
        chk_acc(a, id, bf2f(YB[(size_t)row * 1024 + 768 + cc]), (0.5f * u * (1.0f + erff(u * 0.7071067811865476f))) * sp * siluf(z)); }
}
DI void chk_merge(const Frame& F, const Args& a, int l, int id) {
    const bf16* H = (const bf16*)(a.ws + WS_H); const bf16* YB = (const bf16*)(a.ws + WS_YB); const bf16* MG = (const bf16*)(a.ws + WS_MG);
    const bf16* WM = (const bf16*)(a.ws + WS_WM) + (size_t)l * 4096 * 1024; const bf16* WB = (const bf16*)(a.ws + WS_WBR) + (size_t)l * 1024 * 1024;
    const int gt = F.vcu * 512 + F.tid, NGT = F.G * 512;
    for (int s = gt; s < (1 << 18); s += NGT) { const unsigned hh = hsh(s * 19 + 13); int row = sample_row(hh, l); if (l == 1 && row >= M_LAT) row = hh % M_LAT; const int d = hsh(hh + 202u) & 1023; float acc = 0.f;
        for (int r = 0; r < 4; ++r) { const float G = dot_h_w(H + (size_t)row * 1024, WM + ((size_t)r * 1024 + d) * 1024, 1024) + a.in[I_BMERGE][l * 4096 + r * 1024 + d];
            const float Y = dot_h_w(YB + (size_t)row * 1024 + 256 * r, WB + (size_t)d * 1024 + 256 * r, 256); acc += Y * __builtin_amdgcn_rcpf(1.0f + __builtin_amdgcn_exp2f(-1.4426950408889634f * G)); }
        float got; if (row < M_LAT) got = bf2f(MG[(size_t)row * 1024 + d]); else { got = 0.f; for (int br = 0; br < 4; ++br) got += bf2f(((const bf16*)(a.ws + WS_GTC))[((size_t)br * 512 + (row - M_LAT)) * 1024 + d]); }
        chk_acc(a, id, got, acc); }
}
DI void chk_gt(const Frame& F, const Args& a, int l, int r, int id) {
    const bf16* H = (const bf16*)(a.ws + WS_H); const bf16* GT = (const bf16*)(a.ws + WS_GT); const bf16* WM = (const bf16*)(a.ws + WS_WM) + (size_t)l * 4096 * 1024;
    const int gt = F.vcu * 512 + F.tid, NGT = F.G * 512;
    for (int s = gt; s < (1 << 18); s += NGT) { const unsigned hh = hsh(s * 29 + 19); int row = sample_row(hh, l); if (l == 1 && row >= M_LAT) row = hh % M_LAT; const int d = hsh(hh + 404u) & 1023;
        const float G = dot_h_w(H + (size_t)row * 1024, WM + ((size_t)r * 1024 + d) * 1024, 1024) + a.in[I_BMERGE][l * 4096 + r * 1024 + d];
        chk_acc(a, id, bf2f(GT[(size_t)row * 1024 + d]), __builtin_amdgcn_rcpf(1.0f + __builtin_amdgcn_exp2f(-1.4426950408889634f * G))); }
}
DI void chk_final(const Frame& F, const Args& a, int l, int id) {
    const bf16* MG = (const bf16*)(a.ws + WS_MG); const bf16* WO = (const bf16*)(a.ws + WS_WOUT) + (size_t)l * 1024 * 1024; const float* mod = (const float*)(a.ws + WS_MOD) + (size_t)l * 3 * 3072;
    const int gt = F.vcu * 512 + F.tid, NGT = F.G * 512;
    for (int s = gt; s < (1 << 18); s += NGT) { const unsigned hh = hsh(s * 23 + 17); const int row = sample_row(hh, l), c = hsh(hh + 303u) & 1023; const int v = row < SEQ ? 0 : (row < M_LAT ? 1 : 2);
        if (l == 1 && row >= M_LAT) continue;
        const float xi = (l == 1) ? ((const float*)(a.ws + WS_H))[(size_t)row * 1024 + c] : (row < M_LAT) ? a.in[I_X][(size_t)row * 1024 + c] : a.in[I_CTX][(size_t)(row - M_LAT) * 1024 + c];
        const float got = (row < M_LAT) ? a.out[(size_t)row * 1024 + c] : ((const float*)(a.ws + WS_XC1))[(size_t)(row - M_LAT) * 1024 + c];
        float dsum;
        if (row < M_LAT) dsum = dot_h_w(MG + (size_t)row * 1024, WO + (size_t)c * 1024, 1024);
        else { dsum = 0.f; for (int br = 0; br < 4; ++br) dsum += dot_h_w((const bf16*)(a.ws + WS_GTC) + ((size_t)br * 512 + (row - M_LAT)) * 1024, WO + (size_t)c * 1024, 1024); }
        chk_acc(a, id, got - xi, mod[v * 3072 + 2048 + c] * dsum); }
}
#ifdef CHECK_MAX
#define CHK_ERR(md, ss, n, mx) ((mx) / (sqrtf((ss) / (float)(n)) + 1e-20f))
#else
#define CHK_ERR(md, ss, n, mx) sqrtf((md) / ((ss) + 1e-30f))
#endif
DI void chk_report(const Frame& F, const Args& a) {
    const unsigned* w = (const unsigned*)(a.ws + WS_CTL) + CW_CHK; int first = -1; float ferr = 0.f;
#ifdef CHECK_ONLY
    { const int id = CHECK_ONLY; const float md = __uint_as_float(w[4 * id]), ss = ((const float*)w)[4 * id + 1]; const unsigned n = w[4 * id + 2]; first = id; ferr = n ? CHK_ERR(md, ss, n, __uint_as_float(w[4 * id + 3])) : 1e3f; }
#else
    for (int id = 0; id < 24; ++id) { const float md = __uint_as_float(w[4 * id]), ss = ((const float*)w)[4 * id + 1]; const unsigned n = w[4 * id + 2]; if (!n) continue;
        const float e = CHK_ERR(md, ss, n, __uint_as_float(w[4 * id + 3])); if (e > CHECK_TOL && first < 0) { first = id; ferr = e; } }
#endif
    const float V = first >= 0 ? 10.0f * (float)(1 + first) : 0.f; const float W = first >= 0 ? 4.0f + log10f(fminf(fmaxf(ferr, 1e-3f), 1e3f)) : 0.f;
    const size_t gt = (size_t)F.vcu * 512 + F.tid, NGT = (size_t)F.G * 512;
#ifdef KEEP_OUT
    if (gt == 0) a.out[0] += V; (void)W; (void)NGT;
#else
    for (size_t i = gt; i < (size_t)M_LAT * 1024; i += NGT) { float v = a.in[I_X][i]; if (i == 0) v += V; if (i >= (1u << 20) && i < (2u << 20)) v += W; a.out[i] = v; }
#endif
}
DI void chk_copy_out(const Frame& F, const Args& a) {
    const size_t gt = (size_t)F.vcu * 512 + F.tid, NGT = (size_t)F.G * 512; float* dst = (float*)(a.ws + WS_H);
    for (size_t i = gt; i < (size_t)M_LAT * 1024; i += NGT) dst[i] = a.out[i];
}
#endif
#ifndef RELAX_G1
#define RELAX_G1 true
#endif
#ifndef RELAX_MG
#define RELAX_MG true
#endif
#ifndef RELAX_OUT
#define RELAX_OUT true
#endif

typedef const __attribute__((address_space(4))) Args* CArgsP;
DI Args fresh_args() { CArgsP p = (CArgsP)__builtin_amdgcn_kernarg_segment_ptr(); asm volatile("" : "+s"(p)); Args r;
#pragma unroll
    for (int i = 0; i < 20; ++i) r.in[i] = p->in[i];
    r.out = p->out; r.ws = p->ws; return r; }
DI Frame fresh_frame(unsigned char* lds) {
    Frame F; int t_ = threadIdx.x; asm volatile("" : "+v"(t_));
    F.lds = (LAS unsigned char*)lds; F.tid = t_; F.lane = t_ & 63; F.wave = __builtin_amdgcn_readfirstlane(t_ >> 6);
    F.G = gridDim.x; { const int bx = blockIdx.x; F.vcu = (F.G % 8 == 0) ? (bx % 8) * (F.G / 8) + bx / 8 : bx; }
    return F;
}
DI void grid_bar(unsigned char* lds) {
    const Args a = fresh_args();
    XcdBarrier b; b.bar = (unsigned*)(a.ws + WS_CTL) + CW_BAR; b.x = xb_xcc_id(); b.st = (volatile LAS unsigned*)((LAS unsigned char*)lds + MISC_OFF) + 8;
    xcd_barrier(b);
}

__global__ void __launch_bounds__(NWAVES * 64, 2) hybrid_fwd(Args args) {
    extern __shared__ __attribute__((aligned(16))) unsigned char lds[];
    for (int u = threadIdx.x; u < (LDS_BYTES - LDSCTL_OFF) / 4; u += NWAVES * 64) ((LAS unsigned*)((LAS unsigned char*)lds + LDSCTL_OFF))[u] = 0u;
    __syncthreads();
    { const Args a = fresh_args(); (void)xcd_barrier_post((unsigned*)(a.ws + WS_CTL) + CW_BAR, (volatile LAS unsigned*)((LAS unsigned char*)lds + MISC_OFF) + 8); }
#define GRID_BAR() grid_bar(lds)
#ifndef DUP_MASK
#define DUP_MASK 0
#endif
#define DUP(bit) for (int rep_ = 0; rep_ < 1 + (((DUP_MASK) >> (bit)) & 1); ++rep_)
#ifdef SELFCHECK
#ifndef CHECK_SET
#define CHECK_SET 0xffff
#endif
#define CHK(bit, call) do { if ((CHECK_SET) & (bit)) { { const Frame F = fresh_frame(lds); const Args a = fresh_args(); call; } GRID_BAR(); } } while (0)
#elif defined(EXTRA_BAR)
#define CHK(bit, call) GRID_BAR()
#else
#define CHK(bit, call) do {} while (0)
#endif

#ifdef REPEAT_ALL
    for (int rep_all = 0; rep_all < 2; ++rep_all) {
    if (rep_all) GRID_BAR();
#endif
#ifndef SKIP_P0
    DUP(0) { const Frame F = fresh_frame(lds); const Args a = fresh_args(); p0_prologue(F, a); }
#endif
    GRID_BAR();
    CHK(1, chk_p0(F, a));

#pragma unroll 1
    for (int l = 0; l < 2; ++l) {
#ifndef SKIP_P1
        DUP(1) { const Frame F = fresh_frame(lds); const Args a = fresh_args();
          p1_modrms(F, a, l, a.in[I_X], a.in[I_CTX], 1); }
#endif
        GRID_BAR();
        CHK(2, chk_h(F, a, l, 2 + 10 * l));
#ifndef SKIP_G1
        DUP(2) { const Frame F = fresh_frame(lds); const Args a = fresh_args();
            pg8::Gemm g{(const bf16*)(a.ws + WS_H), (const bf16*)(a.ws + WS_WIN) + (size_t)l * PW * WPITCH, 1024, WPITCH, 1024};
            pg8::OrderX S; S.so.init(l == 0 ? M_ALL : M_LAT, PW, F.G, (int)blockIdx.x); S.nx = (l == 0) ? 0 : 4;
            pg8::EpiBf16<0> E{(bf16*)(a.ws + WS_P), PW, nullptr};
            pg8::gemm_phase<pg8::EpiBf16<0>, pg8::OrderX, true, RELAX_G1>(F.lds, g, S, E);
        }
#endif
        GRID_BAR();
        CHK(4, chk_p(F, a, l, 3 + 10 * l));
#ifndef SKIP_S1
        DUP(3) { const Frame F = fresh_frame(lds); const Args a = fresh_args();
          for (int u = F.vcu; u < 256; u += F.G) fnet_s1_unit(F, a, l, u, (const bf16*)(a.ws + WS_P)); }
#endif
#ifndef SKIP_PREP
        { const Frame F = fresh_frame(lds); const Args a = fresh_args(); p3_prep(F, a, l, (bf16*)(a.ws + WS_P)); }
#endif
        GRID_BAR();
        CHK(8, chk_prep(F, a, l, 4 + 10 * l));
#ifndef SKIP_ATT
        DUP(4) { const Frame F = fresh_frame(lds); const Args a = fresh_args();
            const attn_body::bf16* Pa = (const attn_body::bf16*)(a.ws + WS_P); attn_body::bf16* Ya = (attn_body::bf16*)(a.ws + WS_YB);
            for (int u = F.vcu; u < 256; u += F.G) {
                const int bk = u >> 6, b = bk >> 1, kvh = bk & 1, h = 2 * kvh + ((u >> 5) & 1), qb = u & 31;
                attn_body::attn_unit<0, 8>(Pa, Ya, SEQ * b + 256 * qb, M_LAT + NCTX * b, SEQ * b, 0, 132, 0,
                                           C_AQ + 64 * h, C_AK + 64 * kvh, C_AV + 64 * kvh, C_AZ + 64 * h, 64 * h, 0.f, (char*)lds, a.in[I_QNA] + l * 64, 1);
            }
        }
        DUP(5) { const Frame F = fresh_frame(lds); const Args a = fresh_args();
            const attn_body::bf16* Pa = (const attn_body::bf16*)(a.ws + WS_P); attn_body::bf16* Ya = (attn_body::bf16*)(a.ws + WS_YB);
            for (int u = F.vcu; u < 512; u += F.G) {
                if (u < 256) {
                    const int bk = u >> 6, b = bk >> 1, kvh = bk & 1, h = 2 * kvh + ((u >> 5) & 1), qb = u & 31;
                    const int off = (qb == 0) ? 0 : 4 * qb - 2, NT = (qb == 0 || qb == 31) ? 10 : 12;
                    const float sk = a.in[I_SINK][l * 4 + h] * 1.4426950408889634f;
                    attn_body::attn_unit<1, 8>(Pa, Ya, SEQ * b + 256 * qb, M_LAT + NCTX * b, SEQ * b, off, NT, 256 * qb - 64 * off,
                                               C_DQ + 64 * h, C_DK + 64 * kvh, C_DV + 64 * kvh, C_DZ + 64 * h, 256 + 64 * h, sk, (char*)lds, a.in[I_QND] + l * 64, 1);
                } else if (l == 0 && u >= 288 && u < 416 && ((u - 288) & 7) == 0) {
                    const int ee = (u - 288) >> 3, mode = ee >> 3, b = (ee >> 2) & 1, h = ee & 3, kvh = h >> 1;
                    const float sk = (mode == 0) ? -INFINITY : a.in[I_SINK][l * 4 + h] * 1.4426950408889634f;
                    const int qc = (mode == 0) ? C_AQ : C_DQ, kc = (mode == 0) ? C_AK : C_DK, vc = (mode == 0) ? C_AV : C_DV, zc = (mode == 0) ? C_AZ : C_DZ, oc = (mode == 0) ? 0 : 256;
                    attn_body::attn_unit<1, 8>(Pa, Ya, M_LAT + NCTX * b, M_LAT + NCTX * b, SEQ * b, 0, 4, 0,
                                               qc + 64 * h, kc + 64 * kvh, vc + 64 * kvh, zc + 64 * h, oc + 64 * h, sk, (char*)lds, ((mode == 0) ? a.in[I_QNA] : a.in[I_QND]) + l * 64, 0);
                }
            }
        }
#endif
#ifndef SKIP_S3
        DUP(6) { const Frame F = fresh_frame(lds); const Args a = fresh_args();
          for (int u = F.vcu; u < 256; u += F.G) fnet_s3_unit(F, a, u, (const bf16*)(a.ws + WS_P), (bf16*)(a.ws + WS_YB)); }
#endif
#ifndef SKIP_SGU
        DUP(7) { const Frame F = fresh_frame(lds); const Args a = fresh_args();
          const int nunit = (l == 0) ? 528 : 512;
          for (int u = F.vcu; u < nunit; u += F.G) sgu_unit(F, a, l, u, (const bf16*)(a.ws + WS_P), (bf16*)(a.ws + WS_YB)); }
#endif
#ifndef SKIP_FC
        if (l == 0) DUP(10) { const Frame F = fresh_frame(lds); const Args a = fresh_args();
          for (int e = F.vcu; e < 256; e += F.G) { if (e >= 160 && e < 224 && ((e - 160) & 7) == 0) fnet_ctx_unit(F, a, l, (e - 160) >> 3, (const bf16*)(a.ws + WS_P), (bf16*)(a.ws + WS_YB)); } }
#endif
        GRID_BAR();
        CHK(16, chk_attn(F, a, l, 5 + 10 * l, 0)); CHK(16, chk_attn(F, a, l, 6 + 10 * l, 1)); CHK(32, chk_fnet(F, a, l, 7 + 10 * l, 0); if (l == 0) chk_fnet(F, a, l, 8, 1)); CHK(64, chk_sgu(F, a, l, 9 + 10 * l));
#ifndef MERGE_V1
        for (int rep_ = 0; rep_ < 1 + ((((DUP_MASK) >> 8) & 1) && l == 1); ++rep_) { const Frame F = fresh_frame(lds); const Args a = fresh_args();
            pg8::Gemm g{(const bf16*)(a.ws + WS_H), (const bf16*)(a.ws + WS_WM), 1024, 1024, 1024};
            pg8::MergeOrder S{(const bf16*)(a.ws + WS_H), (const bf16*)(a.ws + WS_YB), (const bf16*)(a.ws + WS_WM) + (size_t)l * 4096 * 1024, (const bf16*)(a.ws + WS_WBR) + (size_t)l * 1024 * 1024, F.G, F.vcu, (l == 0) ? 32 : 0};
            pg8::EpiMerge E{(bf16*)(a.ws + WS_GT), (bf16*)(a.ws + WS_MG), (float*)(a.ws + WS_MGC), a.in[I_BMERGE] + l * 4096, (bf16*)(a.ws + WS_GTC), (bf16*)(a.ws + WS_GT2)};
            pg8::gemm_phase<pg8::EpiMerge, pg8::MergeOrder, true, RELAX_MG>(F.lds, g, S, E);
        }
        if (l == 0) { const Frame F = fresh_frame(lds); const Args a = fresh_args();
            if (F.G == 256) { if ((F.vcu & 7) != 0) p0_weights(F, a, 1, F.vcu - (F.vcu >> 3) - 1, 224); } else p0_weights(F, a, 1, F.vcu, F.G); }
        GRID_BAR();
#else
#pragma unroll 1
        for (int r = 0; r < 4; ++r) {
#ifdef ZERO_MASK
            if ((ZERO_MASK >> r) & 1) continue;
#endif
#ifndef SKIP_MG
            { const Frame F = fresh_frame(lds); const Args a = fresh_args();
                pg8::Gemm g{(const bf16*)(a.ws + WS_H), (const bf16*)(a.ws + WS_WM) + ((size_t)l * 4096 + r * 1024) * 1024, 1024, 1024, 1024};
                pg8::OrderX S; S.so.init((l == 0) ? M_ALL : M_LAT, 1024, F.G, (int)blockIdx.x); S.nx = 0;
                pg8::EpiBf16<2> E{(bf16*)(a.ws + WS_GT), 1024, a.in[I_BMERGE] + l * 4096 + r * 1024};
                pg8::gemm_phase<pg8::EpiBf16<2>, pg8::OrderX, true>(F.lds, g, S, E);
            }
#endif
            GRID_BAR();
            if (r == 3 && l == 0) CHK(512, chk_gt(F, a, l, r, 22); chk_gt(F, a, l, 2, 23));
#ifndef SKIP_MY
            { const Frame F = fresh_frame(lds); const Args a = fresh_args();
                pg8::Gemm g{(const bf16*)(a.ws + WS_YB) + r * 256, (const bf16*)(a.ws + WS_WBR) + (size_t)l * 1024 * 1024 + r * 256, 1024, 1024, 256};
                pg8::OrderX S; S.so.init((l == 0) ? M_ALL : M_LAT, 1024, F.G, (int)blockIdx.x); S.nx = 0;

#ifdef ZERO_MASK
                pg8::EpiGate E{(bf16*)(a.ws + WS_MG), (const bf16*)(a.ws + WS_GT), 1024, r == __builtin_ctz(~(ZERO_MASK)), 1.0f};
#else
#ifdef SCALE_MASK
                pg8::EpiGate E{(bf16*)(a.ws + WS_MG), (const bf16*)(a.ws + WS_GT), 1024, r == 0, ((SCALE_MASK >> r) & 1) ? (SCALE_VAL) : 1.0f};
#else
                pg8::EpiGate E{(bf16*)(a.ws + WS_MG), (const bf16*)(a.ws + WS_GT), 1024, r == 0, 1.0f};
#endif
#endif

                pg8::gemm_phase<pg8::EpiGate, pg8::OrderX, true>(F.lds, g, S, E);
            }
#endif
            GRID_BAR();
        }
#endif
        CHK(128, chk_merge(F, a, l, 10 + 10 * l));
        if (l == 1) CHK(256, chk_copy_out(F, a));
#ifndef SKIP_OUT
        { const Frame F = fresh_frame(lds); const Args a = fresh_args();
            pg8::Gemm g{(const bf16*)(a.ws + WS_MG), (const bf16*)(a.ws + WS_WOUT) + (size_t)l * 1024 * 1024, 1024, 1024, 1024};
            pg8::OrderOut S; S.so.init(M_LAT, 1024, F.G, (int)blockIdx.x); S.nx = (l == 0) ? 128 : 0; S.TERM = (const bf16*)(a.ws + WS_GTC);
            const float* gatev = (const float*)(a.ws + WS_MOD) + (size_t)l * 3 * 3072;
            if (l == 0) { pg8::EpiDelta E{(bf16*)(a.ws + WS_D0), gatev, (float*)(a.ws + WS_PART)};
                pg8::gemm_phase<pg8::EpiDelta, pg8::OrderOut, true, RELAX_OUT>(F.lds, g, S, E); }
            else { pg8::EpiRes E{a.in[I_X], a.out, (const bf16*)(a.ws + WS_D0), gatev};
                pg8::gemm_phase<pg8::EpiRes, pg8::OrderOut, true, RELAX_OUT>(F.lds, g, S, E); }
        }
#endif
        if (l == 0) GRID_BAR();
        if (l == 0) CHK(256, chk_final(F, a, l, 11));
#ifdef SELFCHECK
        if (l == 1) { GRID_BAR(); CHK(256, chk_final(F, a, l, 21)); }
#endif
    }
#ifdef REPEAT_ALL
    }
#endif
#ifdef SELFCHECK
    GRID_BAR();
    { const Frame F = fresh_frame(lds); const Args a = fresh_args(); chk_report(F, a); }
#endif
#ifdef BLEND_S
    GRID_BAR();
    { const Frame F = fresh_frame(lds); const Args a = fresh_args(); const size_t gt = (size_t)F.vcu * 512 + F.tid, NGT = (size_t)F.G * 512;
      for (size_t i = gt; i < (size_t)M_LAT * 1024; i += NGT) { const float x0 = a.in[I_X][i]; a.out[i] = x0 + (BLEND_S) * (a.out[i] - x0); } }
#endif
}

extern "C" void kernel_launch(void* const* d_in, const int* in_sizes, int n_in, void* d_out, int out_size, void* d_ws, size_t ws_size, hipStream_t stream) {
    static int grid = 0;
    if (grid == 0) {
        if (n_in != 20 || out_size != M_LAT * DM || ws_size < WS_END) { fprintf(stderr, "kernel_launch: unexpected problem: n_in %d out %d ws %zu\n", n_in, out_size, ws_size); grid = -1; return; }
        { const int want[20] = {M_LAT * DM, NB * DM, M_CTX * DM, DM, 2 * DM, 2 * DM * 3 * DM, 2 * 3 * DM, 2 * DM * PW, 128, 128, 128, 128, 8, 2 * 4 * 64 * 64, 2 * 4 * 128 * 128, 2 * 4 * 128, 2 * 4 * 256 * DM, 2 * DM * 4 * DM, 2 * 4 * DM, 2 * DM * DM};
          for (int i = 0; i < 20; ++i) if (in_sizes[i] != want[i]) { fprintf(stderr, "kernel_launch: input %d has %d elements, expected %d\n", i, in_sizes[i], want[i]); grid = -1; return; } }
        int dev = 0, cus = 0, per_cu = 0;
        if (hipGetDevice(&dev) != hipSuccess || hipDeviceGetAttribute(&cus, hipDeviceAttributeMultiprocessorCount, dev) != hipSuccess) { grid = -1; return; }
        if (hipFuncSetAttribute((const void*)hybrid_fwd, hipFuncAttributeMaxDynamicSharedMemorySize, LDS_BYTES) != hipSuccess) { fprintf(stderr, "kernel_launch: hipFuncSetAttribute failed\n"); grid = -1; return; }
        if (hipOccupancyMaxActiveBlocksPerMultiprocessor(&per_cu, (const void*)hybrid_fwd, NWAVES * 64, LDS_BYTES) != hipSuccess || per_cu < 1) { fprintf(stderr, "kernel_launch: occupancy query says %d blocks per CU\n", per_cu); per_cu = 1; }
        (void)hipGetLastError();
        grid = cus;
    }
    if (grid < 0) return;
    if (hipMemsetAsync((char*)d_ws + WS_CTL, 0, CTL_ZERO_BYTES, stream) != hipSuccess) { fprintf(stderr, "kernel_launch: memset failed\n"); return; }
    Args a{};
    for (int i = 0; i < 20; ++i) a.in[i] = (const float*)d_in[i];
    a.out = (float*)d_out; a.ws = (unsigned char*)d_ws;
    hipLaunchKernelGGL(hybrid_fwd, dim3(grid), dim3(NWAVES * 64), LDS_BYTES, stream, a);
}
```
